# Optimizing an MI355X kernel written in HIP

```python
import math
import jax, jax.numpy as jnp
from jax import lax
import numpy as np

D_MODEL = 1024
BATCH = 8
SEQ = 4096
DEPTH = 2

CTX_LEN = 256
GRID_W = 64

A_HEADS = 4
A_DK = 128
A_DV = A_DK
CONV_K = 5
A_CHUNK = 64
B_HEADS = 4
B_DH = 64
WIN_R = 8
WIN_C = 16
C_HEADS = 4
C_DK = 32
C_DV = 64
C_RANK = 16
C_GATE_NORM = 16.0
C_CHUNK = 16
ROPE_THETA = 10000.0

MIX_WIDTH = A_HEADS * A_DV + B_HEADS * B_DH + C_HEADS * C_DV
DN_ALPHA = (2 * DEPTH) ** 0.25
DN_BETA = (8 * DEPTH) ** -0.25
LN_EPS = 1e-6
NEG_INF = -1e30

PROJ_SIZES = (
    3 * A_HEADS * A_DK,
    4 * A_HEADS,
    A_HEADS * A_DV,
    B_HEADS * B_DH,
    B_HEADS * B_DH,
    B_HEADS * B_DH,
    B_HEADS * B_DH,
    C_HEADS * C_DK,
    C_HEADS * C_DK,
    C_HEADS * C_DV,
    2 * C_RANK,
    C_HEADS * C_DV,
)
PROJ_SPLITS = tuple(int(s) for s in np.cumsum(PROJ_SIZES)[:-1])
PROJ_TOTAL = int(sum(PROJ_SIZES))

kernel_name = 'hybrid_gdn_natten_gla_diffusion_block'

F32 = jnp.float32


def layer_norm(x):
    xf = x.astype(F32)
    mu = jnp.mean(xf, -1, keepdims=True)
    var = jnp.mean(jnp.square(xf - mu), -1, keepdims=True)
    return (xf - mu) * lax.rsqrt(var + LN_EPS)


def post_norm(h, g, b, dtype):
    return (layer_norm(h) * g.astype(F32) + b.astype(F32)).astype(dtype)


def ada_modulation(cond, w_mod, b_mod):
    h = (jax.nn.silu(cond) @ w_mod + b_mod)[..., None, :]
    return jnp.split(h, 3, axis=-1)


def l2norm(x):
    return x * lax.rsqrt(jnp.sum(x * x, -1, keepdims=True) + 1e-6)


def head_rmsnorm_gate(o, w, z):
    b_, h, l, dv = o.shape
    o = jnp.transpose(o, (0, 2, 1, 3))
    o = o * lax.rsqrt(jnp.mean(o * o, -1, keepdims=True) + 1e-6) * w.astype(F32)
    return (o.reshape(b_, l, h * dv) * jax.nn.silu(z.astype(F32))).astype(z.dtype)


def short_conv(x, w):
    ch = x.shape[-1]
    return lax.conv_general_dilated(
        x, w[:, None, :].astype(x.dtype), window_strides=(1,),
        padding=[(CONV_K // 2, CONV_K // 2)],
        dimension_numbers=('NWC', 'WIO', 'NWC'), feature_group_count=ch)


def axial_rope(x):
    l = x.shape[1]
    t = jnp.arange(l)
    half = x.shape[-1] // 2
    nf = half // 2
    inv = ROPE_THETA ** (-jnp.arange(nf, dtype=F32) / nf)

    def rotate(xp, pos):
        ang = pos.astype(F32)[:, None] * inv
        cos = jnp.cos(ang)[None, :, None, :]
        sin = jnp.sin(ang)[None, :, None, :]
        x1, x2 = xp[..., :nf], xp[..., nf:]
        return jnp.concatenate([x1 * cos - x2 * sin, x1 * sin + x2 * cos], -1)

    xf = x.astype(F32)
    return jnp.concatenate([rotate(xf[..., :half], t // GRID_W),
                            rotate(xf[..., half:], t % GRID_W)], -1)


def _orient(t, reverse):
    return jnp.flip(t, axis=2) if reverse else t


def bidirectional(core, seq_c, gates_c, seq_l, gates_l, s0):
    out_c, out_l = 0.0, 0.0
    for d, rev in enumerate((False, True)):
        o_c, s_c = core(*[_orient(t, rev) for t in seq_c], *[_orient(g[d], rev) for g in gates_c], s0)
        o_l, _ = core(*[_orient(t, rev) for t in seq_l], *[_orient(g[d], rev) for g in gates_l], s_c)
        out_c = out_c + _orient(o_c, rev)
        out_l = out_l + _orient(o_l, rev)
    return out_c, out_l


def gated_delta_chunked(q, k, v, g, beta, s0):
    b_, h, l, dk = q.shape
    dv = v.shape[-1]
    c = A_CHUNK
    n = l // c
    q, k, v = (t.reshape(b_, h, n, c, -1) for t in (q, k, v))
    g = jnp.cumsum(g.reshape(b_, h, n, c), axis=-1)
    beta = beta.reshape(b_, h, n, c)
    tril = jnp.tril(jnp.ones((c, c), bool))
    strict = jnp.tril(jnp.ones((c, c), bool), -1)
    diff = g[..., :, None] - g[..., None, :]
    decay = jnp.where(tril, jnp.exp(jnp.where(tril, diff, 0.0)), 0.0)
    kb = k * beta[..., None]
    lmat = jnp.where(strict, jnp.einsum('bhnid,bhnjd->bhnij', kb, k) * decay, 0.0)
    amat = jnp.eye(c, dtype=F32) + lmat
    rhs = jnp.concatenate([v * beta[..., None], kb * jnp.exp(g)[..., None]], -1)
    sol = lax.linalg.triangular_solve(amat, rhs, left_side=True, lower=True, unit_diagonal=True)
    u, w = sol[..., :dv], sol[..., dv:]
    qk = jnp.einsum('bhnid,bhnjd->bhnij', q, k) * decay
    q_dec = q * jnp.exp(g)[..., None]
    k_dec = k * jnp.exp(g[..., -1:] - g)[..., None]
    g_last = jnp.exp(g[..., -1])

    def step(s, inp):
        qk_i, qd_i, kd_i, u_i, w_i, gl_i = inp
        v_new = u_i - jnp.einsum('bhck,bhkv->bhcv', w_i, s)
        o = jnp.einsum('bhck,bhkv->bhcv', qd_i, s) + jnp.einsum('bhij,bhjv->bhiv', qk_i, v_new)
        s = s * gl_i[..., None, None] + jnp.einsum('bhck,bhcv->bhkv', kd_i, v_new)
        return s, o

    xs = tuple(jnp.moveaxis(t, 2, 0) for t in (qk, q_dec, k_dec, u, w, g_last))
    s_fin, o = lax.scan(step, s0, xs)
    return jnp.moveaxis(o, 0, 2).reshape(b_, h, l, dv), s_fin


def gdn_heads(qkv, conv_w):
    b_, l, _ = qkv.shape
    qkv = jax.nn.silu(short_conv(qkv, conv_w)).astype(F32)
    qkv = jnp.transpose(qkv.reshape(b_, l, 3, A_HEADS, A_DK), (2, 0, 3, 1, 4))
    q = l2norm(qkv[0]) * (A_DK ** -0.5)
    k = l2norm(qkv[1])
    return q, k, qkv[2]


def gdn_gates(ab, a_log, dt_bias):
    b_, l, _ = ab.shape
    ab = ab.astype(F32).reshape(b_, l, 4, A_HEADS)
    g = -jnp.exp(a_log.astype(F32)) * jax.nn.softplus(ab[:, :, :2] + dt_bias.astype(F32))
    beta = jax.nn.sigmoid(ab[:, :, 2:])
    return jnp.transpose(g, (2, 0, 3, 1)), jnp.transpose(beta, (2, 0, 3, 1))


def gdn_branch(qkv_c, ab_c, qkv_l, ab_l, conv_w, a_log, dt_bias):
    qc, kc, vc = gdn_heads(qkv_c, conv_w)
    ql, kl, vl = gdn_heads(qkv_l, conv_w)
    gc, bc = gdn_gates(ab_c, a_log, dt_bias)
    gl, bl = gdn_gates(ab_l, a_log, dt_bias)
    s0 = jnp.zeros(qc.shape[:2] + (A_DK, A_DV), F32)
    return bidirectional(gated_delta_chunked, (qc, kc, vc), (gc, bc), (ql, kl, vl), (gl, bl), s0)


def na_branch(q_c, k_c, v_c, q_l, k_l, v_l, rpb, ctx_out):
    b_, s, _ = q_l.shape
    lc = q_c.shape[1]
    rows = s // GRID_W
    wr = min(WIN_R, rows)
    scale = B_DH ** -0.5
    qc = q_c.reshape(b_, lc, B_HEADS, B_DH) * scale
    kc = k_c.reshape(b_, lc, B_HEADS, B_DH)
    vc = v_c.reshape(b_, lc, B_HEADS, B_DH)
    o_c = None
    if ctx_out:
        p_cc = jax.nn.softmax(jnp.einsum('bqhd,bkhd->bhqk', qc, kc).astype(F32), axis=-1)
        o_c = jnp.einsum('bhqk,bkhd->bqhd', p_cc.astype(vc.dtype), vc).reshape(b_, lc, B_HEADS * B_DH)
    qg = q_l.reshape(b_, rows, GRID_W, B_HEADS, B_DH) * scale
    kg = k_l.reshape(b_, rows, GRID_W, B_HEADS, B_DH)
    vg = v_l.reshape(b_, rows, GRID_W, B_HEADS, B_DH)
    r = jnp.arange(rows)
    r0 = jnp.clip(r - wr // 2, 0, rows - wr)
    row_idx = r0[:, None] + jnp.arange(wr)
    k_rows = kg[:, row_idx]
    v_rows = vg[:, row_idx]
    s_win = jnp.einsum('brqhd,brikhd->bhrqik', qg, k_rows).astype(F32)
    cq = jnp.arange(GRID_W)
    c0 = jnp.clip(cq - WIN_C // 2, 0, GRID_W - WIN_C)
    col_ok = (cq[None, :] >= c0[:, None]) & (cq[None, :] < c0[:, None] + WIN_C)
    di = row_idx - r[:, None] + (WIN_R - 1)
    dj = jnp.clip(cq[None, :] - cq[:, None] + (WIN_C - 1), 0, 2 * WIN_C - 2)
    bias = rpb.astype(F32)[:, di[:, None, :, None], dj[None, :, None, :]]
    s_win = jnp.where(col_ok[:, None, :], s_win + bias, NEG_INF)
    s_lc = jnp.einsum('brqhd,bkhd->bhrqk', qg, kc).astype(F32)
    n_win = wr * GRID_W
    p = jax.nn.softmax(jnp.concatenate([s_win.reshape(b_, B_HEADS, rows, GRID_W, n_win), s_lc], -1), axis=-1)
    p = p.astype(v_l.dtype)
    p_win = p[..., :n_win].reshape(b_, B_HEADS, rows, GRID_W, wr, GRID_W)
    o_l = (jnp.einsum('bhrqik,brikhd->brqhd', p_win, v_rows)
           + jnp.einsum('bhrqk,bkhd->brqhd', p[..., n_win:], vc))
    return o_c, o_l.reshape(b_, s, B_HEADS * B_DH)


def gla_chunked(q, k, v, gk, s0):
    b_, h, l, dk = q.shape
    dv = v.shape[-1]
    c = C_CHUNK
    n = l // c
    q, k, v, gk = (t.reshape(b_, h, n, c, -1) for t in (q, k, v, gk))
    bcum = jnp.cumsum(gk, axis=3)
    tril = jnp.tril(jnp.ones((c, c), bool))[:, :, None]
    diff = bcum[..., :, None, :] - bcum[..., None, :, :]
    decay = jnp.where(tril, jnp.exp(jnp.where(tril, diff, 0.0)), 0.0)
    amat = jnp.einsum('bhnid,bhnjd,bhnijd->bhnij', q, k, decay)
    o_intra = jnp.einsum('bhnij,bhnjv->bhniv', amat, v)
    q_dec = q * jnp.exp(bcum)
    k_dec = k * jnp.exp(bcum[..., -1:, :] - bcum)
    g_last = jnp.exp(bcum[..., -1, :])

    def step(s, inp):
        qd_i, kd_i, v_i, gl_i = inp
        o = jnp.einsum('bhck,bhkv->bhcv', qd_i, s)
        s = s * gl_i[..., None] + jnp.einsum('bhck,bhcv->bhkv', kd_i, v_i)
        return s, o

    xs = tuple(jnp.moveaxis(t, 2, 0) for t in (q_dec, k_dec, v, g_last))
    s_fin, o_inter = lax.scan(step, s0, xs)
    o = o_intra + jnp.moveaxis(o_inter, 0, 2)
    return o.reshape(b_, h, l, dv), s_fin


def gla_gates(r, w2, b2):
    b_, l, _ = r.shape
    r = r.astype(F32).reshape(b_, l, 2, C_RANK)
    gk = jax.nn.log_sigmoid(jnp.einsum('bldr,drk->dblk', r, w2.astype(F32))
                            + b2.astype(F32)[:, None, None, :]) / C_GATE_NORM
    return jnp.transpose(gk.reshape(2, b_, l, C_HEADS, C_DK), (0, 1, 3, 2, 4))


def gla_heads(t, d, rope):
    t = t.reshape(t.shape[0], t.shape[1], C_HEADS, d)
    t = axial_rope(t) if rope else t.astype(F32)
    return jnp.transpose(t, (0, 2, 1, 3))


def gla_branch(q_c, k_c, v_c, r_c, q_l, k_l, v_l, r_l, w2, b2):
    scale = C_DK ** -0.5
    qc = gla_heads(q_c, C_DK, False) * scale
    kc = gla_heads(k_c, C_DK, False)
    vc = gla_heads(v_c, C_DV, False)
    ql = gla_heads(q_l, C_DK, True) * scale
    kl = gla_heads(k_l, C_DK, True)
    vl = gla_heads(v_l, C_DV, False)
    s0 = jnp.zeros(qc.shape[:2] + (C_DK, C_DV), F32)
    return bidirectional(gla_chunked, (qc, kc, vc), (gla_gates(r_c, w2, b2),),
                         (ql, kl, vl), (gla_gates(r_l, w2, b2),), s0)


def setup_inputs(seed: int = 0) -> dict:
    key = jax.random.key(seed)
    ks = jax.random.split(key, 18)

    def nrm(k, shape, s):
        return jax.random.normal(k, shape, F32) * s

    x = nrm(ks[0], (BATCH, SEQ, D_MODEL), 1.0)
    c = nrm(ks[1], (BATCH, D_MODEL), 1.0)
    ctx = nrm(ks[2], (BATCH, CTX_LEN, D_MODEL), 1.0)
    c_ctx = nrm(ks[3], (D_MODEL,), 1.0)
    w_mod = nrm(ks[4], (DEPTH, D_MODEL, 3 * D_MODEL), 0.25 * D_MODEL ** -0.5)
    b_mod = nrm(ks[5], (DEPTH, 3 * D_MODEL), 0.01)
    w_in = nrm(ks[6], (DEPTH, D_MODEL, PROJ_TOTAL), D_MODEL ** -0.5)
    conv_w = nrm(ks[7], (DEPTH, CONV_K, 3 * A_HEADS * A_DK), CONV_K ** -0.5)
    a_log = jnp.log(jax.random.uniform(ks[8], (DEPTH, 2, A_HEADS), F32, 1.0, 16.0))
    dt = jnp.exp(jax.random.uniform(ks[9], (DEPTH, 2, A_HEADS), F32, math.log(1e-3), math.log(1e-1)))
    dt_bias = dt + jnp.log(-jnp.expm1(-dt))
    gdn_norm = 1.0 + nrm(ks[10], (DEPTH, A_DV), 0.02)
    rpb = nrm(ks[11], (DEPTH, B_HEADS, 2 * WIN_R - 1, 2 * WIN_C - 1), 0.1)
    gla_w2 = nrm(ks[12], (DEPTH, 2, C_RANK, C_HEADS * C_DK), C_RANK ** -0.5)
    gla_b2 = nrm(ks[13], (DEPTH, 2, C_HEADS * C_DK), 0.1)
    gla_norm = 1.0 + nrm(ks[14], (DEPTH, C_DV), 0.02)
    w_out = nrm(ks[15], (DEPTH, MIX_WIDTH, D_MODEL), DN_BETA * MIX_WIDTH ** -0.5)
    ln_g = 1.0 + nrm(ks[16], (DEPTH, D_MODEL), 0.02)
    ln_b = nrm(ks[17], (DEPTH, D_MODEL), 0.01)
    return {'x': x, 'c': c, 'ctx': ctx, 'c_ctx': c_ctx, 'w_mod': w_mod, 'b_mod': b_mod,
            'w_in': w_in, 'conv_w': conv_w, 'a_log': a_log, 'dt_bias': dt_bias,
            'gdn_norm': gdn_norm, 'rpb': rpb, 'gla_w2': gla_w2, 'gla_b2': gla_b2,
            'gla_norm': gla_norm, 'w_out': w_out, 'ln_g': ln_g, 'ln_b': ln_b}


def reference(x, c, ctx, c_ctx, w_mod, b_mod, w_in, conv_w, a_log, dt_bias, gdn_norm, rpb,
              gla_w2, gla_b2, gla_norm, w_out, ln_g, ln_b):
    xl, xc = x, ctx
    for i in range(DEPTH):
        ctx_out = i < DEPTH - 1
        sh_l, sc_l, gt_l = ada_modulation(c, w_mod[i], b_mod[i])
        sh_c, sc_c, gt_c = ada_modulation(c_ctx, w_mod[i], b_mod[i])
        ml = (layer_norm(xl) * (1.0 + sc_l) + sh_l).astype(xl.dtype)
        mc = (layer_norm(xc) * (1.0 + sc_c) + sh_c).astype(xc.dtype)
        (a_qkv_l, a_ab_l, a_z_l, b_q_l, b_k_l, b_v_l, b_z_l,
         c_q_l, c_k_l, c_v_l, c_r_l, c_z_l) = jnp.split(ml @ w_in[i], PROJ_SPLITS, axis=-1)
        (a_qkv_c, a_ab_c, a_z_c, b_q_c, b_k_c, b_v_c, b_z_c,
         c_q_c, c_k_c, c_v_c, c_r_c, c_z_c) = jnp.split(mc @ w_in[i], PROJ_SPLITS, axis=-1)
        oa_c, oa_l = gdn_branch(a_qkv_c, a_ab_c, a_qkv_l, a_ab_l, conv_w[i], a_log[i], dt_bias[i])
        ob_c, ob_l = na_branch(b_q_c, b_k_c, b_v_c, b_q_l, b_k_l, b_v_l, rpb[i], ctx_out)
        oc_c, oc_l = gla_branch(c_q_c, c_k_c, c_v_c, c_r_c, c_q_l, c_k_l, c_v_l, c_r_l,
                                gla_w2[i], gla_b2[i])
        y_l = jnp.concatenate([head_rmsnorm_gate(oa_l, gdn_norm[i], a_z_l),
                               ob_l * jax.nn.silu(b_z_l),
                               head_rmsnorm_gate(oc_l, gla_norm[i], c_z_l)], -1) @ w_out[i]
        if ctx_out:
            y_c = jnp.concatenate([head_rmsnorm_gate(oa_c, gdn_norm[i], a_z_c),
                                   ob_c * jax.nn.silu(b_z_c),
                                   head_rmsnorm_gate(oc_c, gla_norm[i], c_z_c)], -1) @ w_out[i]
            xc = post_norm(DN_ALPHA * xc + gt_c * y_c, ln_g[i], ln_b[i], xc.dtype)
        xl = post_norm(DN_ALPHA * xl + gt_l * y_l, ln_g[i], ln_b[i], xl.dtype)
    return xl
```

```cpp
#include <hip/hip_runtime.h>
#include <hip/hip_cooperative_groups.h>
#include <cstdio>
#include <cstdint>
namespace cg = cooperative_groups;

#ifndef ONE_LAUNCH
#define ONE_LAUNCH 0
#endif

constexpr int D = 1024, BATCH = 8, SEQ = 4096, CTX = 256, TOK = 4352, NPROJ = 3888;
constexpr int NBG = 2;
constexpr int ROWS = NBG * TOK;
constexpr float ALPHA = 1.4142135623730951f;

struct P {
    const float *x, *c, *ctx, *c_ctx, *w_mod, *b_mod, *w_in, *conv_w, *a_log, *dt_bias, *gdn_norm, *rpb,
        *gla_w2, *gla_b2, *gla_norm, *w_out, *ln_g, *ln_b;
    float* out;
    float *mods, *xc1, *ml, *proj, *qkvn, *mix, *oa, *oc, *ob, *cq, *ck, *cdec;
};

__device__ __forceinline__ float silu_f(float x) { return x / (1.f + expf(-x)); }
__device__ __forceinline__ float wave_sum(float v) {
#pragma unroll
    for (int o = 32; o > 0; o >>= 1) v += __shfl_xor(v, o);
    return v;
}
__device__ __forceinline__ float wave_max(float v) {
#pragma unroll
    for (int o = 32; o > 0; o >>= 1) v = fmaxf(v, __shfl_xor(v, o));
    return v;
}
__device__ __forceinline__ float block_sum(float v, float* red) {
    v = wave_sum(v);
    __syncthreads();
    if ((threadIdx.x & 63) == 0) red[threadIdx.x >> 6] = v;
    __syncthreads();
    return red[0] + red[1] + red[2] + red[3];
}
__device__ __forceinline__ int tok_of(int dir, int s) { return dir == 0 ? s : (s < CTX ? CTX - 1 - s : TOK + CTX - 1 - s); }

__device__ void ph_mods(const P& p, float* sm, int bid, int nblk) {
    for (int i = threadIdx.x; i < 9 * 1024; i += 256) {
        int s = i >> 10, d = i & 1023;
        float cv = s < 8 ? p.c[s * 1024 + d] : p.c_ctx[d];
        sm[i] = silu_f(cv);
    }
    __syncthreads();
    for (int o = bid * 256 + threadIdx.x; o < 2 * 3072; o += nblk * 256) {
        int l = o / 3072, j = o % 3072;
        const float* w = p.w_mod + (size_t)l * 1024 * 3072 + j;
        float acc[9];
#pragma unroll
        for (int s = 0; s < 9; ++s) acc[s] = 0.f;
        for (int i = 0; i < 1024; ++i) {
            float wv = w[(size_t)i * 3072];
#pragma unroll
            for (int s = 0; s < 9; ++s) acc[s] += sm[s * 1024 + i] * wv;
        }
        float bb = p.b_mod[l * 3072 + j];
#pragma unroll
        for (int s = 0; s < 9; ++s) p.mods[(size_t)(l * 9 + s) * 3072 + j] = acc[s] + bb;
    }
    __syncthreads();
}

__device__ void ph_lnmod(const P& p, float* sm, int l, int b0, int bid, int nblk) {
    for (int r = bid; r < ROWS; r += nblk) {
        int bl = r / TOK, t = r % TOK, b = b0 + bl;
        const float* src; int s;
        if (t < CTX) { src = (l == 0 ? p.ctx : p.xc1) + ((size_t)b * CTX + t) * D; s = 8; }
        else { src = (l == 0 ? p.x : p.out) + ((size_t)b * SEQ + (t - CTX)) * D; s = b; }
        float4 v = ((const float4*)src)[threadIdx.x];
        float mu = block_sum(v.x + v.y + v.z + v.w, sm) * (1.f / 1024.f);
        float4 d = make_float4(v.x - mu, v.y - mu, v.z - mu, v.w - mu);
        float var = block_sum(d.x * d.x + d.y * d.y + d.z * d.z + d.w * d.w, sm) * (1.f / 1024.f);
        float rs = 1.f / sqrtf(var + 1e-6f);
        const float* md = p.mods + (size_t)(l * 9 + s) * 3072;
        float4 sh = ((const float4*)md)[threadIdx.x], sc = ((const float4*)(md + 1024))[threadIdx.x];
        float4 o = make_float4(d.x * rs * (1.f + sc.x) + sh.x, d.y * rs * (1.f + sc.y) + sh.y,
                               d.z * rs * (1.f + sc.z) + sh.z, d.w * rs * (1.f + sc.w) + sh.w);
        ((float4*)(p.ml + (size_t)r * D))[threadIdx.x] = o;
    }
}

__device__ void ph_gemm(const float* A, const float* B, float* C, int M, int N, int K, float* sm, int bid, int nblk) {
    float (*As)[128] = (float (*)[128])sm;
    float (*Bs)[128] = (float (*)[128])(sm + 2048);
    const int tilesN = (N + 127) / 128, tilesM = M / 128;
    const int tx = threadIdx.x & 15, ty = threadIdx.x >> 4;
    for (int tile = bid; tile < tilesM * tilesN; tile += nblk) {
        const int tm = tile / tilesN, tn = tile % tilesN;
        const int m0 = tm * 128, n0 = tn * 128;
        float acc[8][8];
#pragma unroll
        for (int i = 0; i < 8; ++i)
#pragma unroll
            for (int j = 0; j < 8; ++j) acc[i][j] = 0.f;
        for (int k0 = 0; k0 < K; k0 += 16) {
#pragma unroll
            for (int rep = 0; rep < 2; ++rep) {
                int id = threadIdx.x + rep * 256;
                int row = id >> 2, kq = (id & 3) * 4;
                float4 a = *(const float4*)(A + (size_t)(m0 + row) * K + k0 + kq);
                As[kq][row] = a.x; As[kq + 1][row] = a.y; As[kq + 2][row] = a.z; As[kq + 3][row] = a.w;
                int kk = id >> 5, c4 = (id & 31) * 4;
                float4 b = make_float4(0.f, 0.f, 0.f, 0.f);
                if (n0 + c4 < N) b = *(const float4*)(B + (size_t)(k0 + kk) * N + n0 + c4);
                *(float4*)&Bs[kk][c4] = b;
            }
            __syncthreads();
#pragma unroll 4
            for (int kk = 0; kk < 16; ++kk) {
                float4 a0 = *(float4*)&As[kk][ty * 4], a1 = *(float4*)&As[kk][64 + ty * 4];
                float4 b0 = *(float4*)&Bs[kk][tx * 4], b1 = *(float4*)&Bs[kk][64 + tx * 4];
                float a[8] = {a0.x, a0.y, a0.z, a0.w, a1.x, a1.y, a1.z, a1.w};
                float b[8] = {b0.x, b0.y, b0.z, b0.w, b1.x, b1.y, b1.z, b1.w};
#pragma unroll
                for (int i = 0; i < 8; ++i)
#pragma unroll
                    for (int j = 0; j < 8; ++j) acc[i][j] += a[i] * b[j];
            }
            __syncthreads();
        }
#pragma unroll
        for (int i = 0; i < 8; ++i) {
            int row = m0 + (i < 4 ? ty * 4 + i : 64 + ty * 4 + (i - 4));
#pragma unroll
            for (int hf = 0; hf < 2; ++hf) {
                int col = n0 + hf * 64 + tx * 4;
                if (col < N) *(float4*)(C + (size_t)row * N + col) = make_float4(acc[i][hf * 4], acc[i][hf * 4 + 1], acc[i][hf * 4 + 2], acc[i][hf * 4 + 3]);
            }
        }
    }
}

__device__ void ph_conv(const P& p, float* sm, int l, int bid, int nblk) {
    const float* cw = p.conv_w + (size_t)l * 5 * 1536;
    for (int r = bid; r < ROWS; r += nblk) {
        int t = r % TOK;
        int lo = t < CTX ? 0 : CTX, hi = t < CTX ? CTX : TOK;
        __syncthreads();
        for (int ch = threadIdx.x; ch < 1536; ch += 256) {
            float acc = 0.f;
#pragma unroll
            for (int j = 0; j < 5; ++j) {
                int tt = t + j - 2;
                if (tt >= lo && tt < hi) acc += cw[j * 1536 + ch] * p.proj[(size_t)(r + j - 2) * NPROJ + ch];
            }
            sm[ch] = silu_f(acc);
        }
        __syncthreads();
        int w = threadIdx.x >> 6, lane = threadIdx.x & 63;
#pragma unroll
        for (int gi = 0; gi < 2; ++gi) {
            int g = w * 2 + gi;
            float a = sm[g * 128 + lane], b = sm[g * 128 + 64 + lane];
            float ss = wave_sum(a * a + b * b);
            float sc = 1.f / sqrtf(ss + 1e-6f);
            if (g < 4) sc *= 0.08838834764831845f;
            p.qkvn[(size_t)r * 1536 + g * 128 + lane] = a * sc;
            p.qkvn[(size_t)r * 1536 + g * 128 + 64 + lane] = b * sc;
        }
        for (int ch = 1024 + threadIdx.x; ch < 1536; ch += 256) p.qkvn[(size_t)r * 1536 + ch] = sm[ch];
    }
}

__device__ void ph_prepc(const P& p, int l, int bid, int nblk) {
    for (int r = bid; r < ROWS; r += nblk) {
        int t = r % TOK;
        const float* pr = p.proj + (size_t)r * NPROJ;
        {
            int isk = threadIdx.x >> 7, col = threadIdx.x & 127, d = col & 31;
            const float* src = pr + (isk ? 3216 : 3088);
            float val = src[col];
            if (t >= CTX) {
                int pidx = t - CTX;
                int pos = d < 16 ? (pidx >> 6) : (pidx & 63);
                int dd = d & 15, f = dd & 7;
                float inv = powf(10000.f, -(float)f / 8.f);
                float ang = (float)pos * inv;
                float cs = cosf(ang), sn = sinf(ang);
                if (dd < 8) { float x2 = src[col + 8]; val = val * cs - x2 * sn; }
                else { float x1 = src[col - 8]; val = x1 * sn + val * cs; }
            }
            if (!isk) val *= 0.17677669529663687f;
            (isk ? p.ck : p.cq)[(size_t)r * 128 + col] = val;
        }
        {
            int dir = threadIdx.x >> 7, k = threadIdx.x & 127;
            const float* rr = pr + 3600 + dir * 16;
            const float* w2 = p.gla_w2 + ((size_t)(l * 2 + dir) * 16) * 128 + k;
            float xg = p.gla_b2[(l * 2 + dir) * 128 + k];
#pragma unroll
            for (int j = 0; j < 16; ++j) xg += rr[j] * w2[j * 128];
            float ls = fminf(xg, 0.f) - log1pf(expf(-fabsf(xg)));
            p.cdec[((size_t)dir * ROWS + r) * 128 + k] = expf(ls * (1.f / 16.f));
        }
    }
}

__device__ void gdn_scan(const P& p, float* sm, int l, int bl, int h) {
    float* skq = sm;
    float* sv = sm + 8192;
    float* sg = sm + 8192 + 4096;
    float* sb = sg + 32;
    const int dir = threadIdx.x >> 7, col = threadIdx.x & 127;
    float S[128];
#pragma unroll
    for (int i = 0; i < 128; ++i) S[i] = 0.f;
    for (int s0 = 0; s0 < TOK; s0 += 16) {
        __syncthreads();
        for (int i = threadIdx.x; i < 2 * 16 * 96; i += 256) {
            int sd = i / (16 * 96), rem = i % (16 * 96), j = rem / 96, q4 = rem % 96;
            int t = tok_of(sd, s0 + j);
            size_t row = (size_t)bl * TOK + t;
            if (q4 < 64) {
                const float* src = p.qkvn + row * 1536 + (q4 < 32 ? h * 128 + q4 * 4 : 512 + h * 128 + (q4 - 32) * 4);
                *(float4*)(skq + (sd * 16 + j) * 256 + q4 * 4) = *(const float4*)src;
            } else {
                const float* src = p.qkvn + row * 1536 + 1024 + h * 128 + (q4 - 64) * 4;
                *(float4*)(sv + (sd * 16 + j) * 128 + (q4 - 64) * 4) = *(const float4*)src;
            }
        }
        if (threadIdx.x < 32) {
            int sd = threadIdx.x >> 4, j = threadIdx.x & 15;
            int t = tok_of(sd, s0 + j);
            const float* ab = p.proj + ((size_t)bl * TOK + t) * NPROJ + 1536;
            float a = ab[sd * 4 + h] + p.dt_bias[(l * 2 + sd) * 4 + h];
            float sp = fmaxf(a, 0.f) + log1pf(expf(-fabsf(a)));
            float g = -expf(p.a_log[(l * 2 + sd) * 4 + h]) * sp;
            sg[sd * 16 + j] = expf(g);
            float bx = ab[(2 + sd) * 4 + h];
            sb[sd * 16 + j] = 1.f / (1.f + expf(-bx));
        }
        __syncthreads();
#pragma unroll 1
        for (int j = 0; j < 16; ++j) {
            const float* qp = skq + (dir * 16 + j) * 256;
            const float* kp = qp + 128;
            const float dec = sg[dir * 16 + j], bt = sb[dir * 16 + j];
            const float v = sv[(dir * 16 + j) * 128 + col];
            float d0 = 0.f, d1 = 0.f, d2 = 0.f, d3 = 0.f;
#pragma unroll
            for (int k4 = 0; k4 < 32; ++k4) {
                float4 kv = *(const float4*)(kp + k4 * 4);
                d0 += S[k4 * 4] * kv.x; d1 += S[k4 * 4 + 1] * kv.y; d2 += S[k4 * 4 + 2] * kv.z; d3 += S[k4 * 4 + 3] * kv.w;
                if ((k4 & 7) == 7) __builtin_amdgcn_sched_barrier(0);
            }
            const float dot = (d0 + d1) + (d2 + d3);
            const float vn = bt * (v - dec * dot);
            float o0 = 0.f, o1 = 0.f, o2 = 0.f, o3 = 0.f;
#pragma unroll
            for (int k4 = 0; k4 < 32; ++k4) {
                float4 kv = *(const float4*)(kp + k4 * 4);
                float4 qv = *(const float4*)(qp + k4 * 4);
                S[k4 * 4] = dec * S[k4 * 4] + kv.x * vn; o0 += S[k4 * 4] * qv.x;
                S[k4 * 4 + 1] = dec * S[k4 * 4 + 1] + kv.y * vn; o1 += S[k4 * 4 + 1] * qv.y;
                S[k4 * 4 + 2] = dec * S[k4 * 4 + 2] + kv.z * vn; o2 += S[k4 * 4 + 2] * qv.z;
                S[k4 * 4 + 3] = dec * S[k4 * 4 + 3] + kv.w * vn; o3 += S[k4 * 4 + 3] * qv.w;
                if ((k4 & 3) == 3) __builtin_amdgcn_sched_barrier(0);
            }
            int t = tok_of(dir, s0 + j);
            p.oa[((size_t)dir * ROWS + (size_t)bl * TOK + t) * 512 + h * 128 + col] = (o0 + o1) + (o2 + o3);
        }
    }
    __syncthreads();
}

__device__ void gla_scan(const P& p, float* sm, int l, int bl, int hp) {
    float* sq = sm;
    float* sv = sm + 4 * 16 * 96;
    const int grp = threadIdx.x >> 6, lane = threadIdx.x & 63, hh = grp >> 1, dir = grp & 1, h = hp * 2 + hh;
    float S[32];
#pragma unroll
    for (int i = 0; i < 32; ++i) S[i] = 0.f;
    for (int s0 = 0; s0 < TOK; s0 += 16) {
        __syncthreads();
        for (int i = lane; i < 16 * 40; i += 64) {
            int j = i / 40, q4 = i % 40;
            int t = tok_of(dir, s0 + j);
            size_t row = (size_t)bl * TOK + t;
            const float* src; float* dst;
            if (q4 < 8) { src = p.cq + row * 128 + h * 32 + q4 * 4; dst = sq + (grp * 16 + j) * 96 + q4 * 4; }
            else if (q4 < 16) { src = p.ck + row * 128 + h * 32 + (q4 - 8) * 4; dst = sq + (grp * 16 + j) * 96 + 32 + (q4 - 8) * 4; }
            else if (q4 < 24) { src = p.cdec + ((size_t)dir * ROWS + row) * 128 + h * 32 + (q4 - 16) * 4; dst = sq + (grp * 16 + j) * 96 + 64 + (q4 - 16) * 4; }
            else { src = p.proj + row * NPROJ + 3344 + h * 64 + (q4 - 24) * 4; dst = sv + (grp * 16 + j) * 64 + (q4 - 24) * 4; }
            *(float4*)dst = *(const float4*)src;
        }
        __syncthreads();
#pragma unroll 1
        for (int j = 0; j < 16; ++j) {
            const float* qp = sq + (grp * 16 + j) * 96;
            const float* kp = qp + 32;
            const float* dp = qp + 64;
            const float v = sv[(grp * 16 + j) * 64 + lane];
            float o0 = 0.f, o1 = 0.f;
#pragma unroll
            for (int d = 0; d < 32; d += 2) {
                S[d] = dp[d] * S[d] + kp[d] * v; o0 += S[d] * qp[d];
                S[d + 1] = dp[d + 1] * S[d + 1] + kp[d + 1] * v; o1 += S[d + 1] * qp[d + 1];
            }
            int t = tok_of(dir, s0 + j);
            p.oc[((size_t)dir * ROWS + (size_t)bl * TOK + t) * 256 + h * 64 + lane] = o0 + o1;
        }
    }
    __syncthreads();
}

__device__ void na_query(const P& p, float* sm, int l, int bl, int t) {
    const int h = threadIdx.x >> 6, lane = threadIdx.x & 63;
    float* pw = sm + h * 384;
    const size_t rowq = (size_t)bl * TOK + t;
    float qv[64];
    {
        const float* qs = p.proj + rowq * NPROJ + 2064 + h * 64;
#pragma unroll
        for (int i = 0; i < 16; ++i) {
            float4 a = *(const float4*)(qs + i * 4);
            qv[i * 4] = a.x * 0.125f; qv[i * 4 + 1] = a.y * 0.125f; qv[i * 4 + 2] = a.z * 0.125f; qv[i * 4 + 3] = a.w * 0.125f;
        }
    }
    const bool lat = t >= CTX;
    const int nk = lat ? 384 : 256;
    int r = 0, c = 0, r0 = 0, c0 = 0;
    if (lat) { int pi = t - CTX; r = pi >> 6; c = pi & 63; r0 = min(max(r - 4, 0), 56); c0 = min(max(c - 8, 0), 48); }
    float m = -1e30f;
    __syncthreads();
#pragma unroll 1
    for (int j = 0; j < 6; ++j) {
        int idx = lane + 64 * j;
        float s = -1e30f;
        if (idx < nk) {
            int tk; float bias = 0.f;
            if (lat && idx < 128) {
                int i = idx >> 4, kc = c0 + (idx & 15);
                tk = CTX + (r0 + i) * 64 + kc;
                bias = p.rpb[((size_t)(l * 4 + h) * 15 + (r0 + i - r + 7)) * 31 + (kc - c + 15)];
            } else tk = lat ? idx - 128 : idx;
            const float* ks = p.proj + ((size_t)bl * TOK + tk) * NPROJ + 2320 + h * 64;
            float d0 = 0.f, d1 = 0.f, d2 = 0.f, d3 = 0.f;
#pragma unroll
            for (int i = 0; i < 16; ++i) {
                float4 a = *(const float4*)(ks + i * 4);
                d0 += qv[i * 4] * a.x; d1 += qv[i * 4 + 1] * a.y; d2 += qv[i * 4 + 2] * a.z; d3 += qv[i * 4 + 3] * a.w;
            }
            s = (d0 + d1) + (d2 + d3) + bias;
        }
        pw[idx] = s;
        m = fmaxf(m, s);
    }
    m = wave_max(m);
    float sum = 0.f;
#pragma unroll 1
    for (int j = 0; j < 6; ++j) { float e = expf(pw[lane + 64 * j] - m); pw[lane + 64 * j] = e; sum += e; }
    sum = wave_sum(sum);
    const float inv = 1.f / sum;
    __syncthreads();
    float o0 = 0.f, o1 = 0.f;
    for (int idx = 0; idx < nk; idx += 2) {
        int tk0, tk1;
        if (lat && idx < 128) { tk0 = CTX + (r0 + (idx >> 4)) * 64 + c0 + (idx & 15); tk1 = tk0 + 1; }
        else { tk0 = lat ? idx - 128 : idx; tk1 = tk0 + 1; }
        o0 += inv * pw[idx] * p.proj[((size_t)bl * TOK + tk0) * NPROJ + 2576 + h * 64 + lane];
        o1 += inv * pw[idx + 1] * p.proj[((size_t)bl * TOK + tk1) * NPROJ + 2576 + h * 64 + lane];
    }
    p.ob[rowq * 256 + h * 64 + lane] = o0 + o1;
}

__device__ void ph_mix(const P& p, float* sm, int l, int bid, int nblk) {
    const int nGDN = NBG * 4, nGLA = NBG * 2;
    const int nq = (l == 0) ? TOK : SEQ;
    const int total = nGDN + nGLA + NBG * nq;
    for (int it = bid; it < total; it += nblk) {
        if (it < nGDN) gdn_scan(p, sm, l, it >> 2, it & 3);
        else if (it < nGDN + nGLA) { int i2 = it - nGDN; gla_scan(p, sm, l, i2 >> 1, i2 & 1); }
        else {
            int i3 = it - nGDN - nGLA; int bl = i3 / nq, tq = i3 % nq;
            na_query(p, sm, l, bl, (l == 0) ? tq : tq + CTX);
        }
    }
}

__device__ void ph_gate(const P& p, int l, int bid, int nblk) {
    for (int r = bid; r < ROWS; r += nblk) {
        const int tq = threadIdx.x;
        const float* pr = p.proj + (size_t)r * NPROJ;
        float4 res; int oc;
        if (tq < 128) {
            int cb = tq * 4;
            float4 a = *(const float4*)(p.oa + ((size_t)r) * 512 + cb);
            float4 b = *(const float4*)(p.oa + ((size_t)ROWS + r) * 512 + cb);
            float4 o = make_float4(a.x + b.x, a.y + b.y, a.z + b.z, a.w + b.w);
            float ss = o.x * o.x + o.y * o.y + o.z * o.z + o.w * o.w;
#pragma unroll
            for (int m = 16; m > 0; m >>= 1) ss += __shfl_xor(ss, m);
            float rs = 1.f / sqrtf(ss * (1.f / 128.f) + 1e-6f);
            float4 gn = *(const float4*)(p.gdn_norm + l * 128 + (cb & 127));
            float4 z = *(const float4*)(pr + 1552 + cb);
            res = make_float4(o.x * rs * gn.x * silu_f(z.x), o.y * rs * gn.y * silu_f(z.y), o.z * rs * gn.z * silu_f(z.z), o.w * rs * gn.w * silu_f(z.w));
            oc = cb;
        } else if (tq < 192) {
            int cb = (tq - 128) * 4;
            float4 o = *(const float4*)(p.ob + (size_t)r * 256 + cb);
            float4 z = *(const float4*)(pr + 2832 + cb);
            res = make_float4(o.x * silu_f(z.x), o.y * silu_f(z.y), o.z * silu_f(z.z), o.w * silu_f(z.w));
            oc = 512 + cb;
        } else {
            int cb = (tq - 192) * 4;
            float4 a = *(const float4*)(p.oc + ((size_t)r) * 256 + cb);
            float4 b = *(const float4*)(p.oc + ((size_t)ROWS + r) * 256 + cb);
            float4 o = make_float4(a.x + b.x, a.y + b.y, a.z + b.z, a.w + b.w);
            float ss = o.x * o.x + o.y * o.y + o.z * o.z + o.w * o.w;
#pragma unroll
            for (int m = 8; m > 0; m >>= 1) ss += __shfl_xor(ss, m);
            float rs = 1.f / sqrtf(ss * (1.f / 64.f) + 1e-6f);
            float4 gn = *(const float4*)(p.gla_norm + l * 64 + (cb & 63));
            float4 z = *(const float4*)(pr + 3632 + cb);
            res = make_float4(o.x * rs * gn.x * silu_f(z.x), o.y * rs * gn.y * silu_f(z.y), o.z * rs * gn.z * silu_f(z.z), o.w * rs * gn.w * silu_f(z.w));
            oc = 768 + cb;
        }
        *(float4*)(p.mix + (size_t)r * D + oc) = res;
    }
}

__device__ void ph_post(const P& p, float* sm, int l, int b0, int bid, int nblk) {
    for (int r = bid; r < ROWS; r += nblk) {
        int bl = r / TOK, t = r % TOK, b = b0 + bl;
        if (t < CTX && l == 1) continue;
        const float* src; float* dst; int s;
        if (t < CTX) { src = (l == 0 ? p.ctx : p.xc1) + ((size_t)b * CTX + t) * D; dst = p.xc1 + ((size_t)b * CTX + t) * D; s = 8; }
        else { src = (l == 0 ? p.x : p.out) + ((size_t)b * SEQ + (t - CTX)) * D; dst = p.out + ((size_t)b * SEQ + (t - CTX)) * D; s = b; }
        float4 xv = ((const float4*)src)[threadIdx.x];
        float4 yv = ((const float4*)(p.ml + (size_t)r * D))[threadIdx.x];
        float4 gt = ((const float4*)(p.mods + (size_t)(l * 9 + s) * 3072 + 2048))[threadIdx.x];
        float4 hv = make_float4(ALPHA * xv.x + gt.x * yv.x, ALPHA * xv.y + gt.y * yv.y, ALPHA * xv.z + gt.z * yv.z, ALPHA * xv.w + gt.w * yv.w);
        float mu = block_sum(hv.x + hv.y + hv.z + hv.w, sm) * (1.f / 1024.f);
        float4 d = make_float4(hv.x - mu, hv.y - mu, hv.z - mu, hv.w - mu);
        float var = block_sum(d.x * d.x + d.y * d.y + d.z * d.z + d.w * d.w, sm) * (1.f / 1024.f);
        float rs = 1.f / sqrtf(var + 1e-6f);
        float4 g = ((const float4*)(p.ln_g + l * 1024))[threadIdx.x], bb = ((const float4*)(p.ln_b + l * 1024))[threadIdx.x];
        ((float4*)dst)[threadIdx.x] = make_float4(d.x * rs * g.x + bb.x, d.y * rs * g.y + bb.y, d.z * rs * g.z + bb.z, d.w * rs * g.w + bb.w);
    }
}

__device__ void run_phase(const P& p, float* sm, int ph, int l, int b0, int bid, int nblk) {
    switch (ph) {
        case 0: ph_mods(p, sm, bid, nblk); break;
        case 1: ph_lnmod(p, sm, l, b0, bid, nblk); break;
        case 2: ph_gemm(p.ml, p.w_in + (size_t)l * D * NPROJ, p.proj, ROWS, NPROJ, D, sm, bid, nblk); break;
        case 3: ph_conv(p, sm, l, bid, nblk); ph_prepc(p, l, bid, nblk); break;
        case 4: ph_mix(p, sm, l, bid, nblk); break;
        case 5: ph_gate(p, l, bid, nblk); break;
        case 6: ph_gemm(p.mix, p.w_out + (size_t)l * D * D, p.ml, ROWS, D, D, sm, bid, nblk); break;
        case 7: ph_post(p, sm, l, b0, bid, nblk); break;
    }
}

constexpr int SM_FLOATS = 8192 + 4096 + 64;

__global__ void __launch_bounds__(256) k_run(P p, int ph, int l, int b0) {
    __shared__ __attribute__((aligned(16))) float sm[SM_FLOATS];
    run_phase(p, sm, ph, l, b0, blockIdx.x, gridDim.x);
}

__global__ void __launch_bounds__(256) k_mega(P p) {
    __shared__ __attribute__((aligned(16))) float sm[SM_FLOATS];
    cg::grid_group grid = cg::this_grid();
    const int bid = blockIdx.x, nblk = gridDim.x;
    constexpr int NSTEP = 1 + (BATCH / NBG) * 2 * 7;
#pragma unroll 1
    for (int step = 0; step < NSTEP; ++step) {
        int ph = 0, l = 0, g = 0;
        if (step > 0) { int s1 = step - 1; ph = 1 + s1 % 7; l = (s1 / 7) & 1; g = s1 / 14; }
        run_phase(p, sm, ph, l, g * NBG, bid, nblk);
        grid.sync();
    }
}

extern "C" void kernel_launch(void* const* d_in, const int* in_sizes, int n_in, void* d_out, int out_size, void* d_ws, size_t ws_size,
                              hipStream_t stream) {
    P p{};
    p.x = (const float*)d_in[0]; p.c = (const float*)d_in[1]; p.ctx = (const float*)d_in[2]; p.c_ctx = (const float*)d_in[3];
    p.w_mod = (const float*)d_in[4]; p.b_mod = (const float*)d_in[5]; p.w_in = (const float*)d_in[6]; p.conv_w = (const float*)d_in[7];
    p.a_log = (const float*)d_in[8]; p.dt_bias = (const float*)d_in[9]; p.gdn_norm = (const float*)d_in[10]; p.rpb = (const float*)d_in[11];
    p.gla_w2 = (const float*)d_in[12]; p.gla_b2 = (const float*)d_in[13]; p.gla_norm = (const float*)d_in[14]; p.w_out = (const float*)d_in[15];
    p.ln_g = (const float*)d_in[16]; p.ln_b = (const float*)d_in[17];
    p.out = (float*)d_out;
    float* w = (float*)d_ws;
    size_t off = 0;
    auto take = [&](size_t n) { float* r = w + off; off += (n + 63) & ~(size_t)63; return r; };
    p.mods = take((size_t)2 * 9 * 3072);
    p.xc1 = take((size_t)BATCH * CTX * D);
    p.ml = take((size_t)ROWS * D);
    p.proj = take((size_t)ROWS * NPROJ);
    p.qkvn = take((size_t)ROWS * 1536);
    p.mix = take((size_t)ROWS * D);
    p.oa = take((size_t)2 * ROWS * 512);
    p.oc = take((size_t)2 * ROWS * 256);
    p.ob = take((size_t)ROWS * 256);
    p.cq = take((size_t)ROWS * 128);
    p.ck = take((size_t)ROWS * 128);
    p.cdec = take((size_t)2 * ROWS * 128);
    if (off * sizeof(float) > ws_size) { fprintf(stderr, "workspace too small: need %zu have %zu\n", off * sizeof(float), ws_size); return; }
#if ONE_LAUNCH
    static int grid_blocks = 0;
    if (!grid_blocks) {
        int dev = 0, cus = 0, per_cu = 0;
        hipGetDevice(&dev);
        hipDeviceGetAttribute(&cus, hipDeviceAttributeMultiprocessorCount, dev);
        hipOccupancyMaxActiveBlocksPerMultiprocessor(&per_cu, k_mega, 256, 0);
        if (per_cu > 2) per_cu = 2;
        grid_blocks = cus * per_cu;
    }
    void* args[] = {&p};
    hipError_t e = hipLaunchCooperativeKernel((void*)k_mega, dim3(grid_blocks), dim3(256), args, 0, stream);
    if (e != hipSuccess) fprintf(stderr, "cooperative launch failed: %s (grid %d)\n", hipGetErrorString(e), grid_blocks);
#else
    const int G = 1024;
    k_run<<<G, 256, 0, stream>>>(p, 0, 0, 0);
    for (int g = 0; g < BATCH / NBG; ++g)
        for (int l = 0; l < 2; ++l)
            for (int ph = 1; ph <= 7; ++ph) k_run<<<G, 256, 0, stream>>>(p, ph, l, g * NBG);
#endif
}
```

```cpp
#include <hip/hip_runtime.h>
#include <hip/hip_cooperative_groups.h>
#include <cstdio>
#include <cstdint>
namespace cg = cooperative_groups;

#ifndef ONE_LAUNCH
#define ONE_LAUNCH 1
#endif

constexpr int D = 1024, BATCH = 8, SEQ = 4096, CTX = 256, TOK = 4352, NPROJ = 3888;
constexpr int NBG = 2;
constexpr int ROWS = NBG * TOK;
constexpr float ALPHA = 1.4142135623730951f;

struct P {
    const float *x, *c, *ctx, *c_ctx, *w_mod, *b_mod, *w_in, *conv_w, *a_log, *dt_bias, *gdn_norm, *rpb,
        *gla_w2, *gla_b2, *gla_norm, *w_out, *ln_g, *ln_b;
    float* out;
    float *mods, *xc1, *ml, *proj, *qkvn, *mix, *oa, *oc, *ob, *cq, *ck, *cdec;
};

__device__ __forceinline__ float silu_f(float x) { return x / (1.f + expf(-x)); }
__device__ __forceinline__ float wave_sum(float v) {
#pragma unroll
    for (int o = 32; o > 0; o >>= 1) v += __shfl_xor(v, o);
    return v;
}
__device__ __forceinline__ float wave_max(float v) {
#pragma unroll
    for (int o = 32; o > 0; o >>= 1) v = fmaxf(v, __shfl_xor(v, o));
    return v;
}
__device__ __forceinline__ float block_sum(float v, float* red) {
    v = wave_sum(v);
    __syncthreads();
    if ((threadIdx.x & 63) == 0) red[threadIdx.x >> 6] = v;
    __syncthreads();
    return red[0] + red[1] + red[2] + red[3];
}
__device__ __forceinline__ int tok_of(int dir, int s) { return dir == 0 ? s : (s < CTX ? CTX - 1 - s : TOK + CTX - 1 - s); }

__device__ void ph_mods(const P& p, float* sm, int bid, int nblk) {
    for (int i = threadIdx.x; i < 9 * 1024; i += 256) {
        int s = i >> 10, d = i & 1023;
        float cv = s < 8 ? p.c[s * 1024 + d] : p.c_ctx[d];
        sm[i] = silu_f(cv);
    }
    __syncthreads();
    for (int o = bid * 256 + threadIdx.x; o < 2 * 3072; o += nblk * 256) {
        int l = o / 3072, j = o % 3072;
        const float* w = p.w_mod + (size_t)l * 1024 * 3072 + j;
        float acc[9];
#pragma unroll
        for (int s = 0; s < 9; ++s) acc[s] = 0.f;
        for (int i = 0; i < 1024; ++i) {
            float wv = w[(size_t)i * 3072];
#pragma unroll
            for (int s = 0; s < 9; ++s) acc[s] += sm[s * 1024 + i] * wv;
        }
        float bb = p.b_mod[l * 3072 + j];
#pragma unroll
        for (int s = 0; s < 9; ++s) p.mods[(size_t)(l * 9 + s) * 3072 + j] = acc[s] + bb;
    }
    __syncthreads();
}

__device__ void ph_lnmod(const P& p, float* sm, int l, int b0, int bid, int nblk) {
    for (int r = bid; r < ROWS; r += nblk) {
        int bl = r / TOK, t = r % TOK, b = b0 + bl;
        const float* src; int s;
        if (t < CTX) { src = (l == 0 ? p.ctx : p.xc1) + ((size_t)b * CTX + t) * D; s = 8; }
        else { src = (l == 0 ? p.x : p.out) + ((size_t)b * SEQ + (t - CTX)) * D; s = b; }
        float4 v = ((const float4*)src)[threadIdx.x];
        float mu = block_sum(v.x + v.y + v.z + v.w, sm) * (1.f / 1024.f);
        float4 d = make_float4(v.x - mu, v.y - mu, v.z - mu, v.w - mu);
        float var = block_sum(d.x * d.x + d.y * d.y + d.z * d.z + d.w * d.w, sm) * (1.f / 1024.f);
        float rs = 1.f / sqrtf(var + 1e-6f);
        const float* md = p.mods + (size_t)(l * 9 + s) * 3072;
        float4 sh = ((const float4*)md)[threadIdx.x], sc = ((const float4*)(md + 1024))[threadIdx.x];
        float4 o = make_float4(d.x * rs * (1.f + sc.x) + sh.x, d.y * rs * (1.f + sc.y) + sh.y,
                               d.z * rs * (1.f + sc.z) + sh.z, d.w * rs * (1.f + sc.w) + sh.w);
        ((float4*)(p.ml + (size_t)r * D))[threadIdx.x] = o;
    }
}

__device__ void ph_gemm(const float* A, const float* B, float* C, int M, int N, int K, float* sm, int bid, int nblk) {
    float (*As)[128] = (float (*)[128])sm;
    float (*Bs)[128] = (float (*)[128])(sm + 2048);
    const int tilesN = (N + 127) / 128, tilesM = M / 128;
    const int tx = threadIdx.x & 15, ty = threadIdx.x >> 4;
    for (int tile = bid; tile < tilesM * tilesN; tile += nblk) {
        const int tm = tile / tilesN, tn = tile % tilesN;
        const int m0 = tm * 128, n0 = tn * 128;
        float acc[8][8];
#pragma unroll
        for (int i = 0; i < 8; ++i)
#pragma unroll
            for (int j = 0; j < 8; ++j) acc[i][j] = 0.f;
        for (int k0 = 0; k0 < K; k0 += 16) {
#pragma unroll
            for (int rep = 0; rep < 2; ++rep) {
                int id = threadIdx.x + rep * 256;
                int row = id >> 2, kq = (id & 3) * 4;
                float4 a = *(const float4*)(A + (size_t)(m0 + row) * K + k0 + kq);
                As[kq][row] = a.x; As[kq + 1][row] = a.y; As[kq + 2][row] = a.z; As[kq + 3][row] = a.w;
                int kk = id >> 5, c4 = (id & 31) * 4;
                float4 b = make_float4(0.f, 0.f, 0.f, 0.f);
                if (n0 + c4 < N) b = *(const float4*)(B + (size_t)(k0 + kk) * N + n0 + c4);
                *(float4*)&Bs[kk][c4] = b;
            }
            __syncthreads();
#pragma unroll 4
            for (int kk = 0; kk < 16; ++kk) {
                float4 a0 = *(float4*)&As[kk][ty * 4], a1 = *(float4*)&As[kk][64 + ty * 4];
                float4 b0 = *(float4*)&Bs[kk][tx * 4], b1 = *(float4*)&Bs[kk][64 + tx * 4];
                float a[8] = {a0.x, a0.y, a0.z, a0.w, a1.x, a1.y, a1.z, a1.w};
                float b[8] = {b0.x, b0.y, b0.z, b0.w, b1.x, b1.y, b1.z, b1.w};
#pragma unroll
                for (int i = 0; i < 8; ++i)
#pragma unroll
                    for (int j = 0; j < 8; ++j) acc[i][j] += a[i] * b[j];
            }
            __syncthreads();
        }
#pragma unroll
        for (int i = 0; i < 8; ++i) {
            int row = m0 + (i < 4 ? ty * 4 + i : 64 + ty * 4 + (i - 4));
#pragma unroll
            for (int hf = 0; hf < 2; ++hf) {
                int col = n0 + hf * 64 + tx * 4;
                if (col < N) *(float4*)(C + (size_t)row * N + col) = make_float4(acc[i][hf * 4], acc[i][hf * 4 + 1], acc[i][hf * 4 + 2], acc[i][hf * 4 + 3]);
            }
        }
    }
}

__device__ void ph_conv(const P& p, float* sm, int l, int bid, int nblk) {
    const float* cw = p.conv_w + (size_t)l * 5 * 1536;
    for (int r = bid; r < ROWS; r += nblk) {
        int t = r % TOK;
        int lo = t < CTX ? 0 : CTX, hi = t < CTX ? CTX : TOK;
        __syncthreads();
        for (int ch = threadIdx.x; ch < 1536; ch += 256) {
            float acc = 0.f;
#pragma unroll
            for (int j = 0; j < 5; ++j) {
                int tt = t + j - 2;
                if (tt >= lo && tt < hi) acc += cw[j * 1536 + ch] * p.proj[(size_t)(r + j - 2) * NPROJ + ch];
            }
            sm[ch] = silu_f(acc);
        }
        __syncthreads();
        int w = threadIdx.x >> 6, lane = threadIdx.x & 63;
#pragma unroll
        for (int gi = 0; gi < 2; ++gi) {
            int g = w * 2 + gi;
            float a = sm[g * 128 + lane], b = sm[g * 128 + 64 + lane];
            float ss = wave_sum(a * a + b * b);
            float sc = 1.f / sqrtf(ss + 1e-6f);
            if (g < 4) sc *= 0.08838834764831845f;
            p.qkvn[(size_t)r * 1536 + g * 128 + lane] = a * sc;
            p.qkvn[(size_t)r * 1536 + g * 128 + 64 + lane] = b * sc;
        }
        for (int ch = 1024 + threadIdx.x; ch < 1536; ch += 256) p.qkvn[(size_t)r * 1536 + ch] = sm[ch];
    }
}

__device__ void ph_prepc(const P& p, int l, int bid, int nblk) {
    for (int r = bid; r < ROWS; r += nblk) {
        int t = r % TOK;
        const float* pr = p.proj + (size_t)r * NPROJ;
        {
            int isk = threadIdx.x >> 7, col = threadIdx.x & 127, d = col & 31;
            const float* src = pr + (isk ? 3216 : 3088);
            float val = src[col];
            if (t >= CTX) {
                int pidx = t - CTX;
                int pos = d < 16 ? (pidx >> 6) : (pidx & 63);
                int dd = d & 15, f = dd & 7;
                float inv = powf(10000.f, -(float)f / 8.f);
                float ang = (float)pos * inv;
                float cs = cosf(ang), sn = sinf(ang);
                if (dd < 8) { float x2 = src[col + 8]; val = val * cs - x2 * sn; }
                else { float x1 = src[col - 8]; val = x1 * sn + val * cs; }
            }
            if (!isk) val *= 0.17677669529663687f;
            (isk ? p.ck : p.cq)[(size_t)r * 128 + col] = val;
        }
        {
            int dir = threadIdx.x >> 7, k = threadIdx.x & 127;
            const float* rr = pr + 3600 + dir * 16;
            const float* w2 = p.gla_w2 + ((size_t)(l * 2 + dir) * 16) * 128 + k;
            float xg = p.gla_b2[(l * 2 + dir) * 128 + k];
#pragma unroll
            for (int j = 0; j < 16; ++j) xg += rr[j] * w2[j * 128];
            float ls = fminf(xg, 0.f) - log1pf(expf(-fabsf(xg)));
            p.cdec[((size_t)dir * ROWS + r) * 128 + k] = expf(ls * (1.f / 16.f));
        }
    }
}

__device__ void gdn_scan(const P& p, float* sm, int l, int bl, int h) {
    float* skq = sm;
    float* sv = sm + 8192;
    float* sg = sm + 8192 + 4096;
    float* sb = sg + 32;
    const int dir = threadIdx.x >> 7, col = threadIdx.x & 127;
    float S[128];
#pragma unroll
    for (int i = 0; i < 128; ++i) S[i] = 0.f;
    for (int s0 = 0; s0 < TOK; s0 += 16) {
        __syncthreads();
        for (int i = threadIdx.x; i < 2 * 16 * 96; i += 256) {
            int sd = i / (16 * 96), rem = i % (16 * 96), j = rem / 96, q4 = rem % 96;
            int t = tok_of(sd, s0 + j);
            size_t row = (size_t)bl * TOK + t;
            if (q4 < 64) {
                const float* src = p.qkvn + row * 1536 + (q4 < 32 ? h * 128 + q4 * 4 : 512 + h * 128 + (q4 - 32) * 4);
                *(float4*)(skq + (sd * 16 + j) * 256 + q4 * 4) = *(const float4*)src;
            } else {
                const float* src = p.qkvn + row * 1536 + 1024 + h * 128 + (q4 - 64) * 4;
                *(float4*)(sv + (sd * 16 + j) * 128 + (q4 - 64) * 4) = *(const float4*)src;
            }
        }
        if (threadIdx.x < 32) {
            int sd = threadIdx.x >> 4, j = threadIdx.x & 15;
            int t = tok_of(sd, s0 + j);
            const float* ab = p.proj + ((size_t)bl * TOK + t) * NPROJ + 1536;
            float a = ab[sd * 4 + h] + p.dt_bias[(l * 2 + sd) * 4 + h];
            float sp = fmaxf(a, 0.f) + log1pf(expf(-fabsf(a)));
            float g = -expf(p.a_log[(l * 2 + sd) * 4 + h]) * sp;
            sg[sd * 16 + j] = expf(g);
            float bx = ab[(2 + sd) * 4 + h];
            sb[sd * 16 + j] = 1.f / (1.f + expf(-bx));
        }
        __syncthreads();
#pragma unroll 1
        for (int j = 0; j < 16; ++j) {
            const float* qp = skq + (dir * 16 + j) * 256;
            const float* kp = qp + 128;
            const float dec = sg[dir * 16 + j], bt = sb[dir * 16 + j];
            const float v = sv[(dir * 16 + j) * 128 + col];
            float d0 = 0.f, d1 = 0.f, d2 = 0.f, d3 = 0.f;
#pragma unroll
            for (int k4 = 0; k4 < 32; ++k4) {
                float4 kv = *(const float4*)(kp + k4 * 4);
                d0 += S[k4 * 4] * kv.x; d1 += S[k4 * 4 + 1] * kv.y; d2 += S[k4 * 4 + 2] * kv.z; d3 += S[k4 * 4 + 3] * kv.w;
                if ((k4 & 7) == 7) __builtin_amdgcn_sched_barrier(0);
            }
            const float dot = (d0 + d1) + (d2 + d3);
            const float vn = bt * (v - dec * dot);
            float o0 = 0.f, o1 = 0.f, o2 = 0.f, o3 = 0.f;
#pragma unroll
            for (int k4 = 0; k4 < 32; ++k4) {
                float4 kv = *(const float4*)(kp + k4 * 4);
                float4 qv = *(const float4*)(qp + k4 * 4);
                S[k4 * 4] = dec * S[k4 * 4] + kv.x * vn; o0 += S[k4 * 4] * qv.x;
                S[k4 * 4 + 1] = dec * S[k4 * 4 + 1] + kv.y * vn; o1 += S[k4 * 4 + 1] * qv.y;
                S[k4 * 4 + 2] = dec * S[k4 * 4 + 2] + kv.z * vn; o2 += S[k4 * 4 + 2] * qv.z;
                S[k4 * 4 + 3] = dec * S[k4 * 4 + 3] + kv.w * vn; o3 += S[k4 * 4 + 3] * qv.w;
                if ((k4 & 3) == 3) __builtin_amdgcn_sched_barrier(0);
            }
            int t = tok_of(dir, s0 + j);
            p.oa[((size_t)dir * ROWS + (size_t)bl * TOK + t) * 512 + h * 128 + col] = (o0 + o1) + (o2 + o3);
        }
    }
    __syncthreads();
}

__device__ void gla_scan(const P& p, float* sm, int l, int bl, int hp) {
    float* sq = sm;
    float* sv = sm + 4 * 16 * 96;
    const int grp = threadIdx.x >> 6, lane = threadIdx.x & 63, hh = grp >> 1, dir = grp & 1, h = hp * 2 + hh;
    float S[32];
#pragma unroll
    for (int i = 0; i < 32; ++i) S[i] = 0.f;
    for (int s0 = 0; s0 < TOK; s0 += 16) {
        __syncthreads();
        for (int i = lane; i < 16 * 40; i += 64) {
            int j = i / 40, q4 = i % 40;
            int t = tok_of(dir, s0 + j);
            size_t row = (size_t)bl * TOK + t;
            const float* src; float* dst;
            if (q4 < 8) { src = p.cq + row * 128 + h * 32 + q4 * 4; dst = sq + (grp * 16 + j) * 96 + q4 * 4; }
            else if (q4 < 16) { src = p.ck + row * 128 + h * 32 + (q4 - 8) * 4; dst = sq + (grp * 16 + j) * 96 + 32 + (q4 - 8) * 4; }
            else if (q4 < 24) { src = p.cdec + ((size_t)dir * ROWS + row) * 128 + h * 32 + (q4 - 16) * 4; dst = sq + (grp * 16 + j) * 96 + 64 + (q4 - 16) * 4; }
            else { src = p.proj + row * NPROJ + 3344 + h * 64 + (q4 - 24) * 4; dst = sv + (grp * 16 + j) * 64 + (q4 - 24) * 4; }
            *(float4*)dst = *(const float4*)src;
        }
        __syncthreads();
#pragma unroll 1
        for (int j = 0; j < 16; ++j) {
            const float* qp = sq + (grp * 16 + j) * 96;
            const float* kp = qp + 32;
            const float* dp = qp + 64;
            const float v = sv[(grp * 16 + j) * 64 + lane];
            float o0 = 0.f, o1 = 0.f;
#pragma unroll
            for (int d = 0; d < 32; d += 2) {
                S[d] = dp[d] * S[d] + kp[d] * v; o0 += S[d] * qp[d];
                S[d + 1] = dp[d + 1] * S[d + 1] + kp[d + 1] * v; o1 += S[d + 1] * qp[d + 1];
            }
            int t = tok_of(dir, s0 + j);
            p.oc[((size_t)dir * ROWS + (size_t)bl * TOK + t) * 256 + h * 64 + lane] = o0 + o1;
        }
    }
    __syncthreads();
}

__device__ void na_query(const P& p, float* sm, int l, int bl, int t) {
    const int h = threadIdx.x >> 6, lane = threadIdx.x & 63;
    float* pw = sm + h * 384;
    const size_t rowq = (size_t)bl * TOK + t;
    float qv[64];
    {
        const float* qs = p.proj + rowq * NPROJ + 2064 + h * 64;
#pragma unroll
        for (int i = 0; i < 16; ++i) {
            float4 a = *(const float4*)(qs + i * 4);
            qv[i * 4] = a.x * 0.125f; qv[i * 4 + 1] = a.y * 0.125f; qv[i * 4 + 2] = a.z * 0.125f; qv[i * 4 + 3] = a.w * 0.125f;
        }
    }
    const bool lat = t >= CTX;
    const int nk = lat ? 384 : 256;
    int r = 0, c = 0, r0 = 0, c0 = 0;
    if (lat) { int pi = t - CTX; r = pi >> 6; c = pi & 63; r0 = min(max(r - 4, 0), 56); c0 = min(max(c - 8, 0), 48); }
    float m = -1e30f;
    __syncthreads();
#pragma unroll 1
    for (int j = 0; j < 6; ++j) {
        int idx = lane + 64 * j;
        float s = -1e30f;
        if (idx < nk) {
            int tk; float bias = 0.f;
            if (lat && idx < 128) {
                int i = idx >> 4, kc = c0 + (idx & 15);
                tk = CTX + (r0 + i) * 64 + kc;
                bias = p.rpb[((size_t)(l * 4 + h) * 15 + (r0 + i - r + 7)) * 31 + (kc - c + 15)];
            } else tk = lat ? idx - 128 : idx;
            const float* ks = p.proj + ((size_t)bl * TOK + tk) * NPROJ + 2320 + h * 64;
            float d0 = 0.f, d1 = 0.f, d2 = 0.f, d3 = 0.f;
#pragma unroll
            for (int i = 0; i < 16; ++i) {
                float4 a = *(const float4*)(ks + i * 4);
                d0 += qv[i * 4] * a.x; d1 += qv[i * 4 + 1] * a.y; d2 += qv[i * 4 + 2] * a.z; d3 += qv[i * 4 + 3] * a.w;
            }
            s = (d0 + d1) + (d2 + d3) + bias;
        }
        pw[idx] = s;
        m = fmaxf(m, s);
    }
    m = wave_max(m);
    float sum = 0.f;
#pragma unroll 1
    for (int j = 0; j < 6; ++j) { float e = expf(pw[lane + 64 * j] - m); pw[lane + 64 * j] = e; sum += e; }
    sum = wave_sum(sum);
    const float inv = 1.f / sum;
    __syncthreads();
    float o0 = 0.f, o1 = 0.f;
    for (int idx = 0; idx < nk; idx += 2) {
        int tk0, tk1;
        if (lat && idx < 128) { tk0 = CTX + (r0 + (idx >> 4)) * 64 + c0 + (idx & 15); tk1 = tk0 + 1; }
        else { tk0 = lat ? idx - 128 : idx; tk1 = tk0 + 1; }
        o0 += inv * pw[idx] * p.proj[((size_t)bl * TOK + tk0) * NPROJ + 2576 + h * 64 + lane];
        o1 += inv * pw[idx + 1] * p.proj[((size_t)bl * TOK + tk1) * NPROJ + 2576 + h * 64 + lane];
    }
    p.ob[rowq * 256 + h * 64 + lane] = o0 + o1;
}

__device__ void ph_mix(const P& p, float* sm, int l, int bid, int nblk) {
    const int nGDN = NBG * 4, nGLA = NBG * 2;
    const int nq = (l == 0) ? TOK : SEQ;
    const int total = nGDN + nGLA + NBG * nq;
    for (int it = bid; it < total; it += nblk) {
        if (it < nGDN) gdn_scan(p, sm, l, it >> 2, it & 3);
        else if (it < nGDN + nGLA) { int i2 = it - nGDN; gla_scan(p, sm, l, i2 >> 1, i2 & 1); }
        else {
            int i3 = it - nGDN - nGLA; int bl = i3 / nq, tq = i3 % nq;
            na_query(p, sm, l, bl, (l == 0) ? tq : tq + CTX);
        }
    }
}

__device__ void ph_gate(const P& p, int l, int bid, int nblk) {
    for (int r = bid; r < ROWS; r += nblk) {
        const int tq = threadIdx.x;
        const float* pr = p.proj + (size_t)r * NPROJ;
        float4 res; int oc;
        if (tq < 128) {
            int cb = tq * 4;
            float4 a = *(const float4*)(p.oa + ((size_t)r) * 512 + cb);
            float4 b = *(const float4*)(p.oa + ((size_t)ROWS + r) * 512 + cb);
            float4 o = make_float4(a.x + b.x, a.y + b.y, a.z + b.z, a.w + b.w);
            float ss = o.x * o.x + o.y * o.y + o.z * o.z + o.w * o.w;
#pragma unroll
            for (int m = 16; m > 0; m >>= 1) ss += __shfl_xor(ss, m);
            float rs = 1.f / sqrtf(ss * (1.f / 128.f) + 1e-6f);
            float4 gn = *(const float4*)(p.gdn_norm + l * 128 + (cb & 127));
            float4 z = *(const float4*)(pr + 1552 + cb);
            res = make_float4(o.x * rs * gn.x * silu_f(z.x), o.y * rs * gn.y * silu_f(z.y), o.z * rs * gn.z * silu_f(z.z), o.w * rs * gn.w * silu_f(z.w));
            oc = cb;
        } else if (tq < 192) {
            int cb = (tq - 128) * 4;
            float4 o = *(const float4*)(p.ob + (size_t)r * 256 + cb);
            float4 z = *(const float4*)(pr + 2832 + cb);
            res = make_float4(o.x * silu_f(z.x), o.y * silu_f(z.y), o.z * silu_f(z.z), o.w * silu_f(z.w));
            oc = 512 + cb;
        } else {
            int cb = (tq - 192) * 4;
            float4 a = *(const float4*)(p.oc + ((size_t)r) * 256 + cb);
            float4 b = *(const float4*)(p.oc + ((size_t)ROWS + r) * 256 + cb);
            float4 o = make_float4(a.x + b.x, a.y + b.y, a.z + b.z, a.w + b.w);
            float ss = o.x * o.x + o.y * o.y + o.z * o.z + o.w * o.w;
#pragma unroll
            for (int m = 8; m > 0; m >>= 1) ss += __shfl_xor(ss, m);
            float rs = 1.f / sqrtf(ss * (1.f / 64.f) + 1e-6f);
            float4 gn = *(const float4*)(p.gla_norm + l * 64 + (cb & 63));
            float4 z = *(const float4*)(pr + 3632 + cb);
            res = make_float4(o.x * rs * gn.x * silu_f(z.x), o.y * rs * gn.y * silu_f(z.y), o.z * rs * gn.z * silu_f(z.z), o.w * rs * gn.w * silu_f(z.w));
            oc = 768 + cb;
        }
        *(float4*)(p.mix + (size_t)r * D + oc) = res;
    }
}

__device__ void ph_post(const P& p, float* sm, int l, int b0, int bid, int nblk) {
    for (int r = bid; r < ROWS; r += nblk) {
        int bl = r / TOK, t = r % TOK, b = b0 + bl;
        if (t < CTX && l == 1) continue;
        const float* src; float* dst; int s;
        if (t < CTX) { src = (l == 0 ? p.ctx : p.xc1) + ((size_t)b * CTX + t) * D; dst = p.xc1 + ((size_t)b * CTX + t) * D; s = 8; }
        else { src = (l == 0 ? p.x : p.out) + ((size_t)b * SEQ + (t - CTX)) * D; dst = p.out + ((size_t)b * SEQ + (t - CTX)) * D; s = b; }
        float4 xv = ((const float4*)src)[threadIdx.x];
        float4 yv = ((const float4*)(p.ml + (size_t)r * D))[threadIdx.x];
        float4 gt = ((const float4*)(p.mods + (size_t)(l * 9 + s) * 3072 + 2048))[threadIdx.x];
        float4 hv = make_float4(ALPHA * xv.x + gt.x * yv.x, ALPHA * xv.y + gt.y * yv.y, ALPHA * xv.z + gt.z * yv.z, ALPHA * xv.w + gt.w * yv.w);
        float mu = block_sum(hv.x + hv.y + hv.z + hv.w, sm) * (1.f / 1024.f);
        float4 d = make_float4(hv.x - mu, hv.y - mu, hv.z - mu, hv.w - mu);
        float var = block_sum(d.x * d.x + d.y * d.y + d.z * d.z + d.w * d.w, sm) * (1.f / 1024.f);
        float rs = 1.f / sqrtf(var + 1e-6f);
        float4 g = ((const float4*)(p.ln_g + l * 1024))[threadIdx.x], bb = ((const float4*)(p.ln_b + l * 1024))[threadIdx.x];
        ((float4*)dst)[threadIdx.x] = make_float4(d.x * rs * g.x + bb.x, d.y * rs * g.y + bb.y, d.z * rs * g.z + bb.z, d.w * rs * g.w + bb.w);
    }
}

__device__ void run_phase(const P& p, float* sm, int ph, int l, int b0, int bid, int nblk) {
    switch (ph) {
        case 0: ph_mods(p, sm, bid, nblk); break;
        case 1: ph_lnmod(p, sm, l, b0, bid, nblk); break;
        case 2: ph_gemm(p.ml, p.w_in + (size_t)l * D * NPROJ, p.proj, ROWS, NPROJ, D, sm, bid, nblk); break;
        case 3: ph_conv(p, sm, l, bid, nblk); ph_prepc(p, l, bid, nblk); break;
        case 4: ph_mix(p, sm, l, bid, nblk); break;
        case 5: ph_gate(p, l, bid, nblk); break;
        case 6: ph_gemm(p.mix, p.w_out + (size_t)l * D * D, p.ml, ROWS, D, D, sm, bid, nblk); break;
        case 7: ph_post(p, sm, l, b0, bid, nblk); break;
    }
}

constexpr int SM_FLOATS = 8192 + 4096 + 64;

__global__ void __launch_bounds__(256) k_run(P p, int ph, int l, int b0) {
    __shared__ __attribute__((aligned(16))) float sm[SM_FLOATS];
    run_phase(p, sm, ph, l, b0, blockIdx.x, gridDim.x);
}

__global__ void __launch_bounds__(256) k_mega(P p) {
    __shared__ __attribute__((aligned(16))) float sm[SM_FLOATS];
    cg::grid_group grid = cg::this_grid();
    const int bid = blockIdx.x, nblk = gridDim.x;
    constexpr int NSTEP = 1 + (BATCH / NBG) * 2 * 7;
#pragma unroll 1
    for (int step = 0; step < NSTEP; ++step) {
        int ph = 0, l = 0, g = 0;
        if (step > 0) { int s1 = step - 1; ph = 1 + s1 % 7; l = (s1 / 7) & 1; g = s1 / 14; }
        run_phase(p, sm, ph, l, g * NBG, bid, nblk);
        grid.sync();
    }
}

extern "C" void kernel_launch(void* const* d_in, const int* in_sizes, int n_in, void* d_out, int out_size, void* d_ws, size_t ws_size,
                              hipStream_t stream) {
    P p{};
    p.x = (const float*)d_in[0]; p.c = (const float*)d_in[1]; p.ctx = (const float*)d_in[2]; p.c_ctx = (const float*)d_in[3];
    p.w_mod = (const float*)d_in[4]; p.b_mod = (const float*)d_in[5]; p.w_in = (const float*)d_in[6]; p.conv_w = (const float*)d_in[7];
    p.a_log = (const float*)d_in[8]; p.dt_bias = (const float*)d_in[9]; p.gdn_norm = (const float*)d_in[10]; p.rpb = (const float*)d_in[11];
    p.gla_w2 = (const float*)d_in[12]; p.gla_b2 = (const float*)d_in[13]; p.gla_norm = (const float*)d_in[14]; p.w_out = (const float*)d_in[15];
    p.ln_g = (const float*)d_in[16]; p.ln_b = (const float*)d_in[17];
    p.out = (float*)d_out;
    float* w = (float*)d_ws;
    size_t off = 0;
    auto take = [&](size_t n) { float* r = w + off; off += (n + 63) & ~(size_t)63; return r; };
    p.mods = take((size_t)2 * 9 * 3072);
    p.xc1 = take((size_t)BATCH * CTX * D);
    p.ml = take((size_t)ROWS * D);
    p.proj = take((size_t)ROWS * NPROJ);
    p.qkvn = take((size_t)ROWS * 1536);
    p.mix = take((size_t)ROWS * D);
    p.oa = take((size_t)2 * ROWS * 512);
    p.oc = take((size_t)2 * ROWS * 256);
    p.ob = take((size_t)ROWS * 256);
    p.cq = take((size_t)ROWS * 128);
    p.ck = take((size_t)ROWS * 128);
    p.cdec = take((size_t)2 * ROWS * 128);
    if (off * sizeof(float) > ws_size) { fprintf(stderr, "workspace too small: need %zu have %zu\n", off * sizeof(float), ws_size); return; }
#if ONE_LAUNCH
    static int grid_blocks = 0;
    if (!grid_blocks) {
        int dev = 0, cus = 0, per_cu = 0;
        hipGetDevice(&dev);
        hipDeviceGetAttribute(&cus, hipDeviceAttributeMultiprocessorCount, dev);
        hipOccupancyMaxActiveBlocksPerMultiprocessor(&per_cu, k_mega, 256, 0);
        if (per_cu > 2) per_cu = 2;
        grid_blocks = cus * per_cu;
    }
    void* args[] = {&p};
    hipError_t e = hipLaunchCooperativeKernel((void*)k_mega, dim3(grid_blocks), dim3(256), args, 0, stream);
    if (e != hipSuccess) fprintf(stderr, "cooperative launch failed: %s (grid %d)\n", hipGetErrorString(e), grid_blocks);
#else
    const int G = 1024;
    k_run<<<G, 256, 0, stream>>>(p, 0, 0, 0);
    for (int g = 0; g < BATCH / NBG; ++g)
        for (int l = 0; l < 2; ++l)
            for (int ph = 1; ph <= 7; ++ph) k_run<<<G, 256, 0, stream>>>(p, ph, l, g * NBG);
#endif
}
```

```cpp
#include <hip/hip_runtime.h>
#include <hip/hip_cooperative_groups.h>
#include <cstdio>
#include <cstdint>
namespace cg = cooperative_groups;

constexpr int D = 1024, BATCH = 8, SEQ = 4096, CTX = 256, TOK = 4352, NPROJ = 3888;
constexpr int ROWS = BATCH * TOK;
constexpr int NRAW = 1536, NREST = 2352, NPAD = 4096;
constexpr int NTHREADS = 512, NWAVES = 8;
constexpr int LDS_BYTES = 147456;
constexpr float ALPHA = 1.4142135623730951f;
constexpr int RC_AB = 0, RC_AZ = 16, RC_BQ = 528, RC_BK = 784, RC_BV = 1040, RC_BZ = 1296, RC_CQ = 1552, RC_CK = 1680, RC_CV = 1808, RC_CR = 2064, RC_CZ = 2096;

typedef unsigned short bf16;
typedef float f32x4_t __attribute__((ext_vector_type(4)));

struct P {
    const float *x, *c, *ctx, *c_ctx, *w_mod, *b_mod, *w_in, *conv_w, *a_log, *dt_bias, *gdn_norm, *rpb,
        *gla_w2, *gla_b2, *gla_norm, *w_out, *ln_g, *ln_b;
    float* out;
    float *mods, *xc1;
    bf16 *wi_t, *wo_t, *rest, *raw, *qkvn, *mix, *ml, *oa, *oc, *ob;
};

__device__ __forceinline__ float bf2f(unsigned short u) { return __uint_as_float((unsigned)u << 16); }
__device__ __forceinline__ unsigned short f2bf(float f) { unsigned u = __float_as_uint(f); return (unsigned short)((u + 0x7fffu + ((u >> 16) & 1u)) >> 16); }
__device__ __forceinline__ unsigned pk2(float lo, float hi) { return (unsigned)f2bf(lo) | ((unsigned)f2bf(hi) << 16); }
__device__ __forceinline__ float bflo(unsigned w) { return __uint_as_float(w << 16); }
__device__ __forceinline__ float bfhi(unsigned w) { return __uint_as_float(w & 0xffff0000u); }
__device__ __forceinline__ void unpack8(uint4 w, float* f) {
    f[0] = bflo(w.x); f[1] = bfhi(w.x); f[2] = bflo(w.y); f[3] = bfhi(w.y); f[4] = bflo(w.z); f[5] = bfhi(w.z); f[6] = bflo(w.w); f[7] = bfhi(w.w);
}
__device__ __forceinline__ float silu_f(float x) { return x / (1.f + expf(-x)); }
__device__ __forceinline__ float wave_sum(float v) {
#pragma unroll
    for (int o = 32; o > 0; o >>= 1) v += __shfl_xor(v, o);
    return v;
}
__device__ __forceinline__ float wave_max(float v) {
#pragma unroll
    for (int o = 32; o > 0; o >>= 1) v = fmaxf(v, __shfl_xor(v, o));
    return v;
}
__device__ __forceinline__ int mk_tid() { int t = threadIdx.x; asm volatile("" : "+v"(t)); return t; }
__device__ __forceinline__ int tok_of(int dir, int s) { return dir == 0 ? s : (s < CTX ? CTX - 1 - s : TOK + CTX - 1 - s); }

namespace pg8 {
#define PG8_LAS __attribute__((address_space(3)))
typedef unsigned short bf16_t;
typedef short bf16x8 __attribute__((ext_vector_type(8)));
typedef float f32x4 __attribute__((ext_vector_type(4)));
typedef unsigned u32x4 __attribute__((ext_vector_type(4)));
constexpr int BM = 256, BK = 64, HALF = 128, HTB = HALF * BK * 2  , STAGE_BYTES = 8 * HTB, NXCD = 8, WGM = 8;

__host__ __device__ __forceinline__ int lds_byte(int r, int c) { const int st = (r >> 4) * 2 + (c >> 5), rr = r & 15, cc = c & 31, ob = rr * 64 + cc * 2; return st * 1024 + (ob ^ (((ob >> 9) & 1) << 5)); }
__host__ __device__ __forceinline__ void stage_rc(int b, int& R, int& C) { const int st = b / 1024, sb = b % 1024, swz = sb ^ (((sb >> 9) & 1) << 5); R = (st >> 1) * 16 + swz / 64; C = (st & 1) * 32 + (swz % 64) / 2; }
__host__ __device__ __forceinline__ int perm32(int rho) { const int n = rho >> 4, i = rho & 15; return 8 * (i >> 2) + 4 * n + (i & 3); }

struct Unit { int pm, pn; };
struct Gemm { const bf16_t* A; const bf16_t* Bt; int M, N, K; };

struct StaticOrder {
    int nM, nN, nwg, G, c;
    __host__ __device__ void init(int M, int N, int G_, int c_) { nM = M / BM; nN = N / BM; nwg = nM * nN; G = G_; c = c_; }
    __host__ __device__ bool next(int i, Unit& u) const {
        const long L = (long)i * G + c; if (L >= nwg) return false;
        int wgid = (int)L; { const int q = nwg / NXCD, r = nwg % NXCD, xcd = wgid % NXCD, off = wgid / NXCD; wgid = (xcd < r ? xcd * (q + 1) : r * (q + 1) + (xcd - r) * q) + off; }
        const int nig = WGM * nN, gid = wgid / nig, fm = gid * WGM, gsz = (nM - fm) < WGM ? (nM - fm) : WGM;
        u.pm = fm + ((wgid % nig) % gsz); u.pn = (wgid % nig) / gsz; return true;
    }
    __device__ __forceinline__ void a_ready(const Unit&) const {}
    __device__ __forceinline__ void done(const Unit&) const {}
};

__device__ __forceinline__ unsigned cvt_pk_bf16(float lo, float hi) { unsigned r; asm volatile("v_cvt_pk_bf16_f32 %0, %1, %2" : "=v"(r) : "v"(lo), "v"(hi)); return r; }
template <class Epi, class Sched, bool ALIGN_EPI = false, bool SP2 = false>
__device__ __forceinline__ void gemm_phase(PG8_LAS unsigned char* lds, const Gemm g, const Sched& S, const Epi& E) {
    const int tid = mk_tid(), wid = __builtin_amdgcn_readfirstlane(tid >> 6), lane = tid & 63, wr = wid >> 2, wc = wid & 3, fr = lane & 15, fq = lane >> 4;
    const int K = g.K, nt = K / BK;
    unsigned voffA[2], voffB[2];
#pragma unroll
    for (int i = 0; i < 2; ++i) { int R, C; stage_rc(tid * 16 + i * 8192, R, C); const int Rb = Epi::PERM ? ((R & ~31) + perm32(R & 31)) : R;
        voffA[i] = (unsigned)(R * K + C) * 2u; voffB[i] = (unsigned)(Rb * K + C) * 2u; }
    const size_t kstep = (size_t)(BK * 2);
    const size_t hstep = (size_t)HALF * K * 2;
    const size_t tstep = 2 * hstep;
    const unsigned ldsw = (unsigned)wid * 1024u;
    const int aoff = lds_byte(wr * 64 + fr, fq * 8), boff = lds_byte(wc * 32 + fr, fq * 8);
#define PG8_SA(b, h) (((b) * 2 + (h)) * HTB)
#define PG8_SB(b, h) ((4 + (b) * 2 + (h)) * HTB)
#define PG8_STAGE(bufoff, gbase, voff) do { _Pragma("unroll") for (int _i = 0; _i < 2; ++_i) \
        __builtin_amdgcn_global_load_lds((const unsigned*)((const char*)(gbase) + (voff)[_i]), (PG8_LAS unsigned*)(lds + (bufoff) + ldsw + _i * 8192), 16, 0, 0); } while (0)
#define PG8_LDA(dst, b, h) do { _Pragma("unroll") for (int m = 0; m < 4; ++m) _Pragma("unroll") for (int k = 0; k < 2; ++k) dst[m][k] = *(const PG8_LAS bf16x8*)(lds + PG8_SA(b, h) + aoff + m * 2048 + k * 1024); } while (0)
#define PG8_LDB(dst, b, h) do { _Pragma("unroll") for (int n = 0; n < 2; ++n) _Pragma("unroll") for (int k = 0; k < 2; ++k) dst[n][k] = *(const PG8_LAS bf16x8*)(lds + PG8_SB(b, h) + boff + n * 2048 + k * 1024); } while (0)
#define PG8_MMA(ai, bj, At, Bt) do { __builtin_amdgcn_s_setprio(1); _Pragma("unroll") for (int m = 0; m < 4; ++m) _Pragma("unroll") for (int n = 0; n < 2; ++n) _Pragma("unroll") for (int k = 0; k < 2; ++k) \
        acc[ai][bj][m][n] = __builtin_amdgcn_mfma_f32_16x16x32_bf16(Bt[n][k], At[m][k], acc[ai][bj][m][n], 0, 0, 0); __builtin_amdgcn_s_setprio(0); } while (0)
#define PG8_WAIT_V(n) asm volatile("s_waitcnt vmcnt(" #n ")" ::: "memory")
#define PG8_WAIT_L(n) asm volatile("s_waitcnt lgkmcnt(" #n ")" ::: "memory")
#define PG8_BAR __builtin_amdgcn_s_barrier()
#define PG8_SCHED __builtin_amdgcn_sched_barrier(0)
    Unit cur, nxt; int ui = 0;
    if (!S.next(0, cur)) return;
    f32x4 acc[2][2][4][2];
#pragma unroll
    for (int a = 0; a < 2; ++a)
#pragma unroll
        for (int b = 0; b < 2; ++b)
#pragma unroll
            for (int m = 0; m < 4; ++m)
#pragma unroll
                for (int n = 0; n < 2; ++n) acc[a][b][m][n] = (f32x4){0.f, 0.f, 0.f, 0.f};
    bf16x8 At[4][2], B0[2][2], B1[2][2];
    const char* cA = (const char*)g.A + (size_t)cur.pm * tstep; const char* cB = (const char*)g.Bt + (size_t)cur.pn * tstep;
    S.a_ready(cur);
    if constexpr (SP2) {
        PG8_STAGE(PG8_SB(0, 0), cB, voffB); PG8_STAGE(PG8_SB(0, 1), cB + hstep, voffB); PG8_STAGE(PG8_SA(0, 0), cA, voffA); PG8_STAGE(PG8_SA(0, 1), cA + hstep, voffA);
        if (wr == 1) PG8_BAR;
        PG8_WAIT_V(2); PG8_BAR;
        PG8_STAGE(PG8_SB(1, 0), cB + kstep, voffB); PG8_STAGE(PG8_SA(1, 0), cA + kstep, voffA); PG8_STAGE(PG8_SB(1, 1), cB + hstep + kstep, voffB);
        PG8_WAIT_V(6); PG8_BAR;
    } else {
        PG8_STAGE(PG8_SB(0, 0), cB, voffB); PG8_STAGE(PG8_SA(0, 0), cA, voffA); PG8_STAGE(PG8_SB(0, 1), cB + hstep, voffB); PG8_STAGE(PG8_SA(0, 1), cA + hstep, voffA);
        if (wr == 1) PG8_BAR;
        PG8_WAIT_V(4); PG8_BAR;
        PG8_STAGE(PG8_SB(1, 0), cB + kstep, voffB); PG8_STAGE(PG8_SA(1, 0), cA + kstep, voffA); PG8_STAGE(PG8_SB(1, 1), cB + hstep + kstep, voffB);
        PG8_WAIT_V(6); PG8_BAR;
    }
    for (;;) {
        const bool has_next = S.next(ui + 1, nxt);
        const char* nA = has_next ? (const char*)g.A + (size_t)nxt.pm * tstep : cA; const char* nB = has_next ? (const char*)g.Bt + (size_t)nxt.pn * tstep : cB;
        for (int t = 0; t < nt; t += 2) {
            const bool last = (t == nt - 2);
            const char* a1 = cA + (size_t)(t + 1) * kstep;
            const char* a2 = last ? nA : cA + (size_t)(t + 2) * kstep; const char* b2 = last ? nB : cB + (size_t)(t + 2) * kstep;
            const char* a3 = a2 + kstep; const char* b3 = b2 + kstep;
            if (last && has_next) S.a_ready(nxt);
            if constexpr (SP2) {
            PG8_LDB(B0, 0, 0); PG8_LDB(B1, 0, 1); PG8_SCHED; PG8_LDA(At, 0, 0); PG8_STAGE(PG8_SA(1, 1), a1 + hstep, voffA);
            PG8_WAIT_V(8); PG8_WAIT_L(0); PG8_BAR; PG8_MMA(0, 0, At, B0); PG8_MMA(0, 1, At, B1); PG8_BAR; PG8_SCHED;
            PG8_LDA(At, 0, 1); PG8_STAGE(PG8_SB(0, 0), b2, voffB); PG8_STAGE(PG8_SB(0, 1), b2 + hstep, voffB); PG8_STAGE(PG8_SA(0, 0), a2, voffA);
            PG8_WAIT_V(8); PG8_WAIT_L(0); PG8_BAR; PG8_MMA(1, 0, At, B0); PG8_MMA(1, 1, At, B1); PG8_BAR; PG8_SCHED;
            PG8_LDB(B0, 1, 0); PG8_LDB(B1, 1, 1); PG8_SCHED; PG8_LDA(At, 1, 0); PG8_STAGE(PG8_SA(0, 1), a2 + hstep, voffA);
            PG8_WAIT_V(8); PG8_WAIT_L(0); PG8_BAR; PG8_MMA(0, 0, At, B0); PG8_MMA(0, 1, At, B1); PG8_BAR; PG8_SCHED;
            PG8_LDA(At, 1, 1); PG8_STAGE(PG8_SB(1, 0), b3, voffB); PG8_STAGE(PG8_SB(1, 1), b3 + hstep, voffB); PG8_STAGE(PG8_SA(1, 0), a3, voffA);
            PG8_WAIT_V(8); PG8_WAIT_L(0); PG8_BAR; PG8_MMA(1, 0, At, B0); PG8_MMA(1, 1, At, B1); PG8_BAR; PG8_SCHED;
            } else {
            PG8_LDB(B0, 0, 0); PG8_SCHED; PG8_LDA(At, 0, 0); PG8_STAGE(PG8_SA(1, 1), a1 + hstep, voffA);
            PG8_WAIT_L(8); PG8_BAR; PG8_WAIT_L(0); PG8_MMA(0, 0, At, B0); PG8_BAR; PG8_SCHED;
            PG8_LDB(B1, 0, 1); PG8_STAGE(PG8_SB(0, 0), b2, voffB);
            PG8_BAR; PG8_WAIT_L(0); PG8_MMA(0, 1, At, B1); PG8_BAR;
            PG8_LDA(At, 0, 1); PG8_STAGE(PG8_SA(0, 0), a2, voffA);
            PG8_BAR; PG8_WAIT_L(0); PG8_MMA(1, 0, At, B0); PG8_BAR; PG8_SCHED;
            PG8_STAGE(PG8_SB(0, 1), b2 + hstep, voffB);
            PG8_WAIT_V(6); PG8_BAR; PG8_MMA(1, 1, At, B1); PG8_BAR;
            PG8_LDB(B0, 1, 0); PG8_SCHED; PG8_LDA(At, 1, 0); PG8_STAGE(PG8_SA(0, 1), a2 + hstep, voffA);
            PG8_WAIT_L(8); PG8_BAR; PG8_WAIT_L(0); PG8_MMA(0, 0, At, B0); PG8_BAR; PG8_SCHED;
            PG8_LDB(B1, 1, 1); PG8_STAGE(PG8_SB(1, 0), b3, voffB);
            PG8_BAR; PG8_WAIT_L(0); PG8_MMA(0, 1, At, B1); PG8_BAR;
            PG8_LDA(At, 1, 1); PG8_STAGE(PG8_SA(1, 0), a3, voffA);
            PG8_BAR; PG8_WAIT_L(0); PG8_MMA(1, 0, At, B0); PG8_BAR; PG8_SCHED;
            PG8_STAGE(PG8_SB(1, 1), b3 + hstep, voffB);
            PG8_WAIT_V(6); PG8_BAR; PG8_MMA(1, 1, At, B1); PG8_BAR;
            }
        }
        if constexpr (ALIGN_EPI) { if (wr == 0) PG8_BAR; }
        if constexpr (!Epi::AFTER_DRAIN) { E(acc, cur, wr, wc, fr, fq); S.done(cur); }
        if (!has_next) break;
#pragma unroll
        for (int a = 0; a < 2; ++a)
#pragma unroll
            for (int b = 0; b < 2; ++b)
#pragma unroll
                for (int m = 0; m < 4; ++m)
#pragma unroll
                    for (int n = 0; n < 2; ++n) acc[a][b][m][n] = (f32x4){0.f, 0.f, 0.f, 0.f};
        cur = nxt; cA = nA; cB = nB; ++ui;
        if constexpr (ALIGN_EPI) { if (wr == 1) PG8_BAR; }
    }
    PG8_WAIT_V(0);
    if constexpr (!ALIGN_EPI) { if (wr == 0) PG8_BAR; }
    PG8_BAR;
    if constexpr (Epi::AFTER_DRAIN) { E.fused(acc, cur, wr, wc, fr, fq, lds, wid, lane); S.done(cur); }
#undef PG8_SA
#undef PG8_SB
#undef PG8_STAGE
#undef PG8_LDA
#undef PG8_LDB
#undef PG8_MMA
#undef PG8_WAIT_V
#undef PG8_WAIT_L
#undef PG8_BAR
#undef PG8_SCHED
}
}

#define LASP __attribute__((address_space(3)))

struct EpiProj {
    static constexpr bool PERM = true, AFTER_DRAIN = false;
    bf16* raw; bf16* rest;
    __device__ __forceinline__ void operator()(const pg8::f32x4 (&acc)[2][2][4][2], const pg8::Unit& u, int wr, int wc, int fr, int fq) const {
        const int row0 = u.pm * 256 + wr * 64 + fr;
        const int colb = u.pn * 256 + wc * 32 + 8 * fq;
#pragma unroll
        for (int bj = 0; bj < 2; ++bj) {
            const int col = colb + bj * 128;
            if (col >= NPROJ) continue;
            bf16* base; int ld;
            if (col < NRAW) { base = raw + col; ld = NRAW; } else { base = rest + (col - NRAW); ld = NREST; }
#pragma unroll
            for (int ai = 0; ai < 2; ++ai)
#pragma unroll
                for (int m = 0; m < 4; ++m) {
                    const pg8::f32x4 v0 = acc[ai][bj][m][0], v1 = acc[ai][bj][m][1];
                    pg8::u32x4 w; w.x = pg8::cvt_pk_bf16(v0[0], v0[1]); w.y = pg8::cvt_pk_bf16(v0[2], v0[3]); w.z = pg8::cvt_pk_bf16(v1[0], v1[1]); w.w = pg8::cvt_pk_bf16(v1[2], v1[3]);
                    *(pg8::u32x4*)(base + (size_t)(row0 + ai * 128 + m * 16) * ld) = w;
                }
        }
    }
};
struct EpiRes {
    static constexpr bool PERM = false, AFTER_DRAIN = false;
    const float* xl_src; const float* xc_src; float* out; float* xc1; const float* mods; int l;
    __device__ __forceinline__ void operator()(const pg8::f32x4 (&acc)[2][2][4][2], const pg8::Unit& u, int wr, int wc, int fr, int fq) const {
        const int row0 = u.pm * 256 + wr * 64 + fr, col0 = u.pn * 256 + wc * 32 + 4 * fq;
#pragma unroll
        for (int ai = 0; ai < 2; ++ai)
#pragma unroll
            for (int m = 0; m < 4; ++m) {
                const int r = row0 + ai * 128 + m * 16;
                const int b = r / TOK, t = r - b * TOK;
                const float* src; float* dst; int s;
                if (t < CTX) { if (l != 0) continue; src = xc_src + ((size_t)b * CTX + t) * D; dst = xc1 + ((size_t)b * CTX + t) * D; s = 8; }
                else { src = xl_src + ((size_t)b * SEQ + (t - CTX)) * D; dst = out + ((size_t)b * SEQ + (t - CTX)) * D; s = b; }
                const float* gt = mods + (size_t)(l * 9 + s) * 3072 + 2048;
#pragma unroll
                for (int bj = 0; bj < 2; ++bj)
#pragma unroll
                    for (int n = 0; n < 2; ++n) {
                        const int c = col0 + bj * 128 + n * 16;
                        const pg8::f32x4 xv = *(const pg8::f32x4*)(src + c), g = *(const pg8::f32x4*)(gt + c);
                        *(pg8::f32x4*)(dst + c) = xv * ALPHA + g * acc[ai][bj][m][n];
                    }
            }
    }
};

__device__ __forceinline__ void transpose_item(const float* W, int K, int N, bf16* WT, LASP float* scr, int item, int lane) {
    const int nblk = (N + 31) / 32, kb = item / nblk, nb = item % nblk, k0 = 64 * kb, n0 = 32 * nb;
    const bool nok = (n0 + (lane & 31)) < N;
#pragma unroll 8
    for (int i = 0; i < 32; ++i) { const int kk = 2 * i + (lane >> 5); scr[kk * 33 + (lane & 31)] = nok ? W[(size_t)(k0 + kk) * N + n0 + (lane & 31)] : 0.f; }
    asm volatile("s_waitcnt lgkmcnt(0)" ::: "memory");
    const int c = lane & 7;
#pragma unroll
    for (int j = 0; j < 4; ++j) {
        const int n = (lane >> 3) + 8 * j; const LASP float* s = scr + (8 * c) * 33 + n;
        uint4 o; o.x = pk2(s[0 * 33], s[1 * 33]); o.y = pk2(s[2 * 33], s[3 * 33]); o.z = pk2(s[4 * 33], s[5 * 33]); o.w = pk2(s[6 * 33], s[7 * 33]);
        *(uint4*)(WT + (size_t)(n0 + n) * K + k0 + 8 * c) = o;
    }
    asm volatile("s_waitcnt lgkmcnt(0)" ::: "memory");
}

__device__ void ph_prologue(const P& p, LASP unsigned char* lds, int bid, int nblk) {
    const int tid = mk_tid(), lane = tid & 63, wave = tid >> 6;
    LASP float* sm = (LASP float*)lds;
    if (bid * NTHREADS < 2 * 3072) {
        for (int i = tid; i < 9 * 1024; i += NTHREADS) {
            int s = i >> 10, d = i & 1023;
            float cv = s < 8 ? p.c[s * 1024 + d] : p.c_ctx[d];
            sm[i] = silu_f(cv);
        }
        __syncthreads();
        for (int o = bid * NTHREADS + tid; o < 2 * 3072; o += nblk * NTHREADS) {
            int l = o / 3072, j = o % 3072;
            const float* w = p.w_mod + (size_t)l * 1024 * 3072 + j;
            float acc[9];
#pragma unroll
            for (int s = 0; s < 9; ++s) acc[s] = 0.f;
            for (int i = 0; i < 1024; ++i) {
                float wv = w[(size_t)i * 3072];
#pragma unroll
                for (int s = 0; s < 9; ++s) acc[s] += sm[s * 1024 + i] * wv;
            }
            float bb = p.b_mod[l * 3072 + j];
#pragma unroll
            for (int s = 0; s < 9; ++s) p.mods[(size_t)(l * 9 + s) * 3072 + j] = acc[s] + bb;
        }
        __syncthreads();
    }
    LASP float* scr = (LASP float*)(lds + 40960 + wave * 8704);
    const int gw = (nblk - 1 - bid) * NWAVES + wave, NGW = nblk * NWAVES;
    constexpr int I_IN = 16 * 122, I_OUT = 16 * 32;
    for (int it = gw; it < 2 * (I_IN + I_OUT); it += NGW) {
        int l = it / (I_IN + I_OUT), r = it % (I_IN + I_OUT);
        if (r < I_IN) transpose_item(p.w_in + (size_t)l * D * NPROJ, D, NPROJ, p.wi_t + (size_t)l * NPAD * D, scr, r, lane);
        else transpose_item(p.w_out + (size_t)l * D * D, D, D, p.wo_t + (size_t)l * D * D, scr, r - I_IN, lane);
    }
    for (int i = bid * NTHREADS + tid; i < 2 * 192 * 128; i += nblk * NTHREADS) {
        int l = i / (192 * 128), r = i % (192 * 128);
        *(uint4*)(p.wi_t + (size_t)l * NPAD * D + (size_t)3904 * D + (size_t)r * 8) = make_uint4(0, 0, 0, 0);
    }
}

__device__ void ph_lnpass(const P& p, int mode, int bid, int nblk) {
    const int tid = mk_tid();
    const int lane = tid & 63, wave = tid >> 6;
    for (int r = bid * NWAVES + wave; r < ROWS; r += nblk * NWAVES) {
        const int b = r / TOK, t = r - b * TOK;
        const bool isc = t < CTX;
        if (mode == 2 && isc) continue;
        float* buf; const float* src; int s;
        if (isc) { buf = p.xc1 + ((size_t)b * CTX + t) * D; src = (mode == 0) ? p.ctx + ((size_t)b * CTX + t) * D : buf; s = 8; }
        else { buf = p.out + ((size_t)b * SEQ + (t - CTX)) * D; src = (mode == 0) ? p.x + ((size_t)b * SEQ + (t - CTX)) * D : buf; s = b; }
        f32x4_t v[4];
#pragma unroll
        for (int j = 0; j < 4; ++j) v[j] = *(const f32x4_t*)(src + 256 * j + 4 * lane);
        if (mode >= 1) {
            const int lp = mode - 1;
            float sum = 0.f;
#pragma unroll
            for (int j = 0; j < 4; ++j) sum += (v[j].x + v[j].y) + (v[j].z + v[j].w);
            const float mu = wave_sum(sum) * (1.f / 1024.f);
            float sq = 0.f;
#pragma unroll
            for (int j = 0; j < 4; ++j) { v[j] = v[j] - mu; sq += (v[j].x * v[j].x + v[j].y * v[j].y) + (v[j].z * v[j].z + v[j].w * v[j].w); }
            const float rs = 1.f / sqrtf(wave_sum(sq) * (1.f / 1024.f) + 1e-6f);
#pragma unroll
            for (int j = 0; j < 4; ++j) {
                const f32x4_t g = *(const f32x4_t*)(p.ln_g + lp * 1024 + 256 * j + 4 * lane), bb = *(const f32x4_t*)(p.ln_b + lp * 1024 + 256 * j + 4 * lane);
                v[j] = v[j] * rs * g + bb;
                *(f32x4_t*)(buf + 256 * j + 4 * lane) = v[j];
            }
            if (mode == 2) continue;
        }
        const int l = mode;
        float sum = 0.f;
#pragma unroll
        for (int j = 0; j < 4; ++j) sum += (v[j].x + v[j].y) + (v[j].z + v[j].w);
        const float mu = wave_sum(sum) * (1.f / 1024.f);
        float sq = 0.f;
#pragma unroll
        for (int j = 0; j < 4; ++j) { v[j] = v[j] - mu; sq += (v[j].x * v[j].x + v[j].y * v[j].y) + (v[j].z * v[j].z + v[j].w * v[j].w); }
        const float rs = 1.f / sqrtf(wave_sum(sq) * (1.f / 1024.f) + 1e-6f);
        const float* md = p.mods + (size_t)(l * 9 + s) * 3072;
#pragma unroll
        for (int j = 0; j < 4; ++j) {
            const f32x4_t sh = *(const f32x4_t*)(md + 256 * j + 4 * lane), sc = *(const f32x4_t*)(md + 1024 + 256 * j + 4 * lane);
            const f32x4_t o = v[j] * rs * (sc + 1.f) + sh;
            uint2 w; w.x = pk2(o.x, o.y); w.y = pk2(o.z, o.w);
            *(uint2*)(p.ml + (size_t)r * D + 256 * j + 4 * lane) = w;
        }
    }
}

__device__ void ph_conv(const P& p, int l, int bid, int nblk) {
    const int tid = mk_tid();
    const int lane = tid & 63, wave = tid >> 6;
    const float* cw = p.conv_w + (size_t)l * 5 * 1536;
    for (int it = bid * NWAVES + wave; it < ROWS * 12; it += nblk * NWAVES) {
        const int r = it / 12, g = it - r * 12;
        const int t = r % TOK;
        const int lo = t < CTX ? 0 : CTX, hi = t < CTX ? CTX : TOK;
        const int ch = g * 128 + lane * 2;
        float a0 = 0.f, a1 = 0.f;
#pragma unroll
        for (int j = 0; j < 5; ++j) {
            const int tt = t + j - 2;
            if (tt >= lo && tt < hi) {
                const unsigned w = *(const unsigned*)(p.raw + (size_t)(r + j - 2) * NRAW + ch);
                a0 += cw[j * 1536 + ch] * bflo(w); a1 += cw[j * 1536 + ch + 1] * bfhi(w);
            }
        }
        a0 = silu_f(a0); a1 = silu_f(a1);
        if (g < 8) {
            const float ss = wave_sum(a0 * a0 + a1 * a1);
            float sc = 1.f / sqrtf(ss + 1e-6f);
            if (g < 4) sc *= 0.08838834764831845f;
            a0 *= sc; a1 *= sc;
        }
        *(unsigned*)(p.qkvn + (size_t)r * NRAW + ch) = pk2(a0, a1);
    }
}

__device__ void gdn_scan_naive(const P& p, LASP float* sm, int l, int b, int hp) {
    const int tid = mk_tid();
    LASP float* skq = sm;
    LASP float* sv = sm + 4 * 16 * 256;
    LASP float* sg = sv + 4 * 16 * 128;
    LASP float* sb = sg + 64;
    const int sub = tid >> 7, col = tid & 127, dir = sub & 1, h = hp * 2 + (sub >> 1);
    float S[128];
#pragma unroll
    for (int i = 0; i < 128; ++i) S[i] = 0.f;
    for (int s0 = 0; s0 < TOK; s0 += 16) {
        __syncthreads();
        for (int i = tid; i < 4 * 16 * 48; i += NTHREADS) {
            const int su = i / (16 * 48), rem = i % (16 * 48), j = rem / 48, chunk = rem % 48;
            const int sd = su & 1, hh = hp * 2 + (su >> 1);
            const int t = tok_of(sd, s0 + j);
            const size_t row = (size_t)b * TOK + t;
            const int part = chunk >> 4, c8 = chunk & 15;
            const uint4 w = *(const uint4*)(p.qkvn + row * NRAW + part * 512 + hh * 128 + c8 * 8);
            float f[8]; unpack8(w, f);
            LASP float* dst = (part < 2) ? skq + (su * 16 + j) * 256 + part * 128 + c8 * 8 : sv + (su * 16 + j) * 128 + c8 * 8;
#pragma unroll
            for (int e = 0; e < 8; ++e) dst[e] = f[e];
        }
        if (tid < 64) {
            const int su = tid >> 4, j = tid & 15, sd = su & 1, hh = hp * 2 + (su >> 1);
            const int t = tok_of(sd, s0 + j);
            const bf16* ab = p.rest + ((size_t)b * TOK + t) * NREST + RC_AB;
            const float a = bf2f(ab[sd * 4 + hh]) + p.dt_bias[(l * 2 + sd) * 4 + hh];
            const float sp = fmaxf(a, 0.f) + log1pf(expf(-fabsf(a)));
            const float g = -expf(p.a_log[(l * 2 + sd) * 4 + hh]) * sp;
            sg[su * 16 + j] = expf(g);
            const float bx = bf2f(ab[(2 + sd) * 4 + hh]);
            sb[su * 16 + j] = 1.f / (1.f + expf(-bx));
        }
        __syncthreads();
#pragma unroll 1
        for (int j = 0; j < 16; ++j) {
            const LASP float* qp = skq + (sub * 16 + j) * 256;
            const LASP float* kp = qp + 128;
            const float dec = sg[sub * 16 + j], bt = sb[sub * 16 + j];
            const float v = sv[(sub * 16 + j) * 128 + col];
            float d0 = 0.f, d1 = 0.f, d2 = 0.f, d3 = 0.f;
#pragma unroll
            for (int k4 = 0; k4 < 32; ++k4) {
                const f32x4_t kv = *(const LASP f32x4_t*)(kp + k4 * 4);
                d0 += S[k4 * 4] * kv.x; d1 += S[k4 * 4 + 1] * kv.y; d2 += S[k4 * 4 + 2] * kv.z; d3 += S[k4 * 4 + 3] * kv.w;
                if ((k4 & 7) == 7) __builtin_amdgcn_sched_barrier(0);
            }
            const float dot = (d0 + d1) + (d2 + d3);
            const float vn = bt * (v - dec * dot);
            float o0 = 0.f, o1 = 0.f, o2 = 0.f, o3 = 0.f;
#pragma unroll
            for (int k4 = 0; k4 < 32; ++k4) {
                const f32x4_t kv = *(const LASP f32x4_t*)(kp + k4 * 4);
                const f32x4_t qv = *(const LASP f32x4_t*)(qp + k4 * 4);
                S[k4 * 4] = dec * S[k4 * 4] + kv.x * vn; o0 += S[k4 * 4] * qv.x;
                S[k4 * 4 + 1] = dec * S[k4 * 4 + 1] + kv.y * vn; o1 += S[k4 * 4 + 1] * qv.y;
                S[k4 * 4 + 2] = dec * S[k4 * 4 + 2] + kv.z * vn; o2 += S[k4 * 4 + 2] * qv.z;
                S[k4 * 4 + 3] = dec * S[k4 * 4 + 3] + kv.w * vn; o3 += S[k4 * 4 + 3] * qv.w;
                if ((k4 & 3) == 3) __builtin_amdgcn_sched_barrier(0);
            }
            const int t = tok_of(dir, s0 + j);
            p.oa[((size_t)dir * ROWS + (size_t)b * TOK + t) * 512 + h * 128 + col] = f2bf((o0 + o1) + (o2 + o3));
        }
    }
    __syncthreads();
}

__device__ void gla_scan_naive(const P& p, LASP float* sm, int l, int b) {
    const int tid = mk_tid();
    LASP float* sq = sm;
    LASP float* sv = sm + 8 * 16 * 96;
    const int grp = tid >> 6, lane = tid & 63, h = grp >> 1, dir = grp & 1;
    const int d = lane & 31, par = lane >> 5;
    float w2c[16];
#pragma unroll
    for (int j = 0; j < 16; ++j) w2c[j] = p.gla_w2[((size_t)(l * 2 + dir) * 16 + j) * 128 + h * 32 + d];
    const float b2v = p.gla_b2[(l * 2 + dir) * 128 + h * 32 + d];
    const int dd = d & 15, f = dd & 7;
    const float inv = powf(10000.f, -(float)f / 8.f);
    const int pd = dd < 8 ? d + 8 : d - 8;
    float S[32];
#pragma unroll
    for (int i = 0; i < 32; ++i) S[i] = 0.f;
    for (int s0 = 0; s0 < TOK; s0 += 16) {
        __syncthreads();
#pragma unroll 1
        for (int jj = 0; jj < 8; ++jj) {
            const int j = par + 2 * jj;
            const int t = tok_of(dir, s0 + j);
            const bf16* base = p.rest + ((size_t)b * TOK + t) * NREST;
            float qv = bf2f(base[RC_CQ + h * 32 + d]), kv = bf2f(base[RC_CK + h * 32 + d]);
            if (t >= CTX) {
                const int pidx = t - CTX;
                const int pos = d < 16 ? (pidx >> 6) : (pidx & 63);
                const float ang = (float)pos * inv;
                const float cs = cosf(ang), sn = sinf(ang);
                const float qp = bf2f(base[RC_CQ + h * 32 + pd]), kp = bf2f(base[RC_CK + h * 32 + pd]);
                if (dd < 8) { qv = qv * cs - qp * sn; kv = kv * cs - kp * sn; }
                else { qv = qp * sn + qv * cs; kv = kp * sn + kv * cs; }
            }
            qv *= 0.17677669529663687f;
            float xg = b2v;
#pragma unroll
            for (int jr = 0; jr < 16; ++jr) xg += bf2f(base[RC_CR + dir * 16 + jr]) * w2c[jr];
            const float ls = fminf(xg, 0.f) - log1pf(expf(-fabsf(xg)));
            LASP float* dst = sq + (grp * 16 + j) * 96;
            dst[d] = qv; dst[32 + d] = kv; dst[64 + d] = expf(ls * (1.f / 16.f));
        }
        for (int i = lane; i < 16 * 64; i += 64) {
            const int j = i >> 6, c = i & 63;
            const int t = tok_of(dir, s0 + j);
            sv[(grp * 16 + j) * 64 + c] = bf2f(p.rest[((size_t)b * TOK + t) * NREST + RC_CV + h * 64 + c]);
        }
        __syncthreads();
#pragma unroll 1
        for (int j = 0; j < 16; ++j) {
            const LASP float* qp = sq + (grp * 16 + j) * 96;
            const LASP float* kp = qp + 32;
            const LASP float* dp = qp + 64;
            const float v = sv[(grp * 16 + j) * 64 + lane];
            float o0 = 0.f, o1 = 0.f;
#pragma unroll
            for (int e = 0; e < 32; e += 2) {
                S[e] = dp[e] * S[e] + kp[e] * v; o0 += S[e] * qp[e];
                S[e + 1] = dp[e + 1] * S[e + 1] + kp[e + 1] * v; o1 += S[e + 1] * qp[e + 1];
            }
            const int t = tok_of(dir, s0 + j);
            p.oc[((size_t)dir * ROWS + (size_t)b * TOK + t) * 256 + h * 64 + lane] = f2bf(o0 + o1);
        }
    }
    __syncthreads();
}

__device__ void na_query_naive(const P& p, LASP float* sm, int l, int b, int t0) {
    const int tid = mk_tid();
    const int wave = tid >> 6, lane = tid & 63, h = wave & 3, t = t0 + (wave >> 2);
    LASP float* pw = sm + wave * 384;
    const size_t rowq = (size_t)b * TOK + t;
    float qv[64];
    {
        const bf16* qs = p.rest + rowq * NREST + RC_BQ + h * 64;
#pragma unroll
        for (int i = 0; i < 8; ++i) {
            float f[8]; unpack8(*(const uint4*)(qs + i * 8), f);
#pragma unroll
            for (int e = 0; e < 8; ++e) qv[i * 8 + e] = f[e] * 0.125f;
        }
    }
    const bool lat = t >= CTX;
    const int nk = lat ? 384 : 256;
    int r = 0, c = 0, r0 = 0, c0 = 0;
    if (lat) { int pi = t - CTX; r = pi >> 6; c = pi & 63; r0 = min(max(r - 4, 0), 56); c0 = min(max(c - 8, 0), 48); }
    float m = -1e30f;
    __syncthreads();
#pragma unroll 1
    for (int j = 0; j < 6; ++j) {
        const int idx = lane + 64 * j;
        float s = -1e30f;
        if (idx < nk) {
            int tk; float bias = 0.f;
            if (lat && idx < 128) {
                const int i = idx >> 4, kc = c0 + (idx & 15);
                tk = CTX + (r0 + i) * 64 + kc;
                bias = p.rpb[((size_t)(l * 4 + h) * 15 + (r0 + i - r + 7)) * 31 + (kc - c + 15)];
            } else tk = lat ? idx - 128 : idx;
            const bf16* ks = p.rest + ((size_t)b * TOK + tk) * NREST + RC_BK + h * 64;
            float d0 = 0.f, d1 = 0.f;
#pragma unroll
            for (int i = 0; i < 8; ++i) {
                float f[8]; unpack8(*(const uint4*)(ks + i * 8), f);
#pragma unroll
                for (int e = 0; e < 8; e += 2) { d0 += qv[i * 8 + e] * f[e]; d1 += qv[i * 8 + e + 1] * f[e + 1]; }
            }
            s = d0 + d1 + bias;
        }
        pw[idx] = s;
        m = fmaxf(m, s);
    }
    m = wave_max(m);
    float sum = 0.f;
#pragma unroll 1
    for (int j = 0; j < 6; ++j) { const float e = expf(pw[lane + 64 * j] - m); pw[lane + 64 * j] = e; sum += e; }
    sum = wave_sum(sum);
    const float inv = 1.f / sum;
    __syncthreads();
    float o0 = 0.f, o1 = 0.f;
    for (int idx = 0; idx < nk; idx += 2) {
        int tk0;
        if (lat && idx < 128) tk0 = CTX + (r0 + (idx >> 4)) * 64 + c0 + (idx & 15);
        else tk0 = lat ? idx - 128 : idx;
        o0 += pw[idx] * bf2f(p.rest[((size_t)b * TOK + tk0) * NREST + RC_BV + h * 64 + lane]);
        o1 += pw[idx + 1] * bf2f(p.rest[((size_t)b * TOK + tk0 + 1) * NREST + RC_BV + h * 64 + lane]);
    }
    p.ob[rowq * 256 + h * 64 + lane] = f2bf((o0 + o1) * inv);
}

__device__ void ph_mix_naive(const P& p, LASP float* sm, int l, int bid, int nblk) {
    const int nGDN = BATCH * 2, nGLA = BATCH;
    const int nq2 = ((l == 0) ? TOK : SEQ) / 2;
    const int total = nGDN + nGLA + BATCH * nq2;
    for (int it = bid; it < total; it += nblk) {
        if (it < nGDN) gdn_scan_naive(p, sm, l, it >> 1, it & 1);
        else if (it < nGDN + nGLA) gla_scan_naive(p, sm, l, it - nGDN);
        else {
            const int i3 = it - nGDN - nGLA; const int b = i3 / nq2, tq = (i3 % nq2) * 2;
            na_query_naive(p, sm, l, b, (l == 0) ? tq : tq + CTX);
        }
    }
}

__device__ void ph_gate(const P& p, int l, int bid, int nblk) {
    const int tid = mk_tid();
    const int tq = tid & 127, rsub = tid >> 7;
    for (int r = bid * 4 + rsub; r < ROWS; r += nblk * 4) {
        const bf16* pr = p.rest + (size_t)r * NREST;
        float o[8], z[8], res[8]; int oc;
        if (tq < 64) {
            const int cb = tq * 8;
            float a[8], bb[8];
            unpack8(*(const uint4*)(p.oa + (size_t)r * 512 + cb), a);
            unpack8(*(const uint4*)(p.oa + ((size_t)ROWS + r) * 512 + cb), bb);
            float ss = 0.f;
#pragma unroll
            for (int e = 0; e < 8; ++e) { o[e] = a[e] + bb[e]; ss += o[e] * o[e]; }
#pragma unroll
            for (int m = 8; m > 0; m >>= 1) ss += __shfl_xor(ss, m);
            const float rs = 1.f / sqrtf(ss * (1.f / 128.f) + 1e-6f);
            unpack8(*(const uint4*)(pr + RC_AZ + cb), z);
#pragma unroll
            for (int e = 0; e < 8; ++e) res[e] = o[e] * rs * p.gdn_norm[l * 128 + ((cb + e) & 127)] * silu_f(z[e]);
            oc = cb;
        } else if (tq < 96) {
            const int cb = (tq - 64) * 8;
            unpack8(*(const uint4*)(p.ob + (size_t)r * 256 + cb), o);
            unpack8(*(const uint4*)(pr + RC_BZ + cb), z);
#pragma unroll
            for (int e = 0; e < 8; ++e) res[e] = o[e] * silu_f(z[e]);
            oc = 512 + cb;
        } else {
            const int cb = (tq - 96) * 8;
            float a[8], bb[8];
            unpack8(*(const uint4*)(p.oc + (size_t)r * 256 + cb), a);
            unpack8(*(const uint4*)(p.oc + ((size_t)ROWS + r) * 256 + cb), bb);
            float ss = 0.f;
#pragma unroll
            for (int e = 0; e < 8; ++e) { o[e] = a[e] + bb[e]; ss += o[e] * o[e]; }
#pragma unroll
            for (int m = 4; m > 0; m >>= 1) ss += __shfl_xor(ss, m);
            const float rs = 1.f / sqrtf(ss * (1.f / 64.f) + 1e-6f);
            unpack8(*(const uint4*)(pr + RC_CZ + cb), z);
#pragma unroll
            for (int e = 0; e < 8; ++e) res[e] = o[e] * rs * p.gla_norm[l * 64 + ((cb + e) & 63)] * silu_f(z[e]);
            oc = 768 + cb;
        }
        uint4 w; w.x = pk2(res[0], res[1]); w.y = pk2(res[2], res[3]); w.z = pk2(res[4], res[5]); w.w = pk2(res[6], res[7]);
        *(uint4*)(p.mix + (size_t)r * D + oc) = w;
    }
}

constexpr int NSTEP = 1 + 2 * 6 + 1;
__global__ void __launch_bounds__(NTHREADS, 2) k_mega(P p) {
    extern __shared__ __attribute__((aligned(16))) unsigned char lds_raw[];
    LASP unsigned char* lds = (LASP unsigned char*)lds_raw;
    cg::grid_group grid = cg::this_grid();
    const int bid = blockIdx.x, nblk = gridDim.x;
#pragma unroll 1
    for (int step = 0; step < NSTEP; ++step) {
        int ph = 0, l = 0;
        if (step > 0) { const int s1 = step - 1; l = s1 / 6; ph = 1 + s1 % 6; }
        if (ph == 0) ph_prologue(p, lds, bid, nblk);
        else if (ph == 1) ph_lnpass(p, l, bid, nblk);
        else if (l < 2) {
            if (ph == 2) {
                pg8::Gemm g{p.ml, p.wi_t + (size_t)l * NPAD * D, ROWS, NPAD, D}; pg8::StaticOrder S; S.init(ROWS, NPAD, nblk, bid);
                EpiProj E{p.raw, p.rest};
                pg8::gemm_phase<EpiProj, pg8::StaticOrder, true, true>(lds, g, S, E);
            } else if (ph == 3) ph_conv(p, l, bid, nblk);
            else if (ph == 4) ph_mix_naive(p, (LASP float*)lds, l, bid, nblk);
            else if (ph == 5) ph_gate(p, l, bid, nblk);
            else {
                pg8::Gemm g{p.mix, p.wo_t + (size_t)l * D * D, ROWS, D, D}; pg8::StaticOrder S; S.init(ROWS, D, nblk, bid);
                EpiRes E{l == 0 ? p.x : p.out, p.ctx, p.out, p.xc1, p.mods, l};
                pg8::gemm_phase<EpiRes, pg8::StaticOrder, true, true>(lds, g, S, E);
            }
        }
        grid.sync();
    }
}

extern "C" void kernel_launch(void* const* d_in, const int* in_sizes, int n_in, void* d_out, int out_size, void* d_ws, size_t ws_size,
                              hipStream_t stream) {
    P p{};
    p.x = (const float*)d_in[0]; p.c = (const float*)d_in[1]; p.ctx = (const float*)d_in[2]; p.c_ctx = (const float*)d_in[3];
    p.w_mod = (const float*)d_in[4]; p.b_mod = (const float*)d_in[5]; p.w_in = (const float*)d_in[6]; p.conv_w = (const float*)d_in[7];
    p.a_log = (const float*)d_in[8]; p.dt_bias = (const float*)d_in[9]; p.gdn_norm = (const float*)d_in[10]; p.rpb = (const float*)d_in[11];
    p.gla_w2 = (const float*)d_in[12]; p.gla_b2 = (const float*)d_in[13]; p.gla_norm = (const float*)d_in[14]; p.w_out = (const float*)d_in[15];
    p.ln_g = (const float*)d_in[16]; p.ln_b = (const float*)d_in[17];
    p.out = (float*)d_out;
    unsigned char* w = (unsigned char*)d_ws;
    size_t off = 0;
    auto take = [&](size_t bytes) { unsigned char* r = w + off; off += (bytes + 255) & ~(size_t)255; return r; };
    p.mods = (float*)take((size_t)2 * 9 * 3072 * 4);
    p.xc1 = (float*)take((size_t)BATCH * CTX * D * 4);
    p.wi_t = (bf16*)take((size_t)2 * NPAD * D * 2);
    p.wo_t = (bf16*)take((size_t)2 * D * D * 2);
    p.rest = (bf16*)take((size_t)ROWS * NREST * 2);
    p.raw = (bf16*)take((size_t)ROWS * NRAW * 2);
    p.qkvn = (bf16*)take((size_t)ROWS * NRAW * 2);
    p.mix = p.qkvn;
    p.oa = (bf16*)take((size_t)2 * ROWS * 512 * 2);
    p.oc = (bf16*)take((size_t)2 * ROWS * 256 * 2);
    p.ml = p.oa;
    p.ob = (bf16*)take((size_t)ROWS * 256 * 2);
    static int grid_blocks = 0;
    if (!grid_blocks) {
        if (off > ws_size) { fprintf(stderr, "workspace too small: need %zu have %zu\n", off, ws_size); grid_blocks = -1; return; }
        int dev = 0, cus = 0, per_cu = 0;
        hipGetDevice(&dev);
        hipDeviceGetAttribute(&cus, hipDeviceAttributeMultiprocessorCount, dev);
        if (hipFuncSetAttribute((const void*)k_mega, hipFuncAttributeMaxDynamicSharedMemorySize, LDS_BYTES) != hipSuccess) { fprintf(stderr, "hipFuncSetAttribute failed\n"); grid_blocks = -1; return; }
        hipOccupancyMaxActiveBlocksPerMultiprocessor(&per_cu, (const void*)k_mega, NTHREADS, LDS_BYTES);
        if (per_cu < 1) { fprintf(stderr, "occupancy query says %d blocks per CU\n", per_cu); grid_blocks = -1; return; }
        grid_blocks = cus;
    }
    if (grid_blocks < 0) return;
    void* args[] = {&p};
    hipError_t e = hipLaunchCooperativeKernel((void*)k_mega, dim3(grid_blocks), dim3(NTHREADS), args, LDS_BYTES, stream);
    if (e != hipSuccess) fprintf(stderr, "cooperative launch failed: %s (grid %d)\n", hipGetErrorString(e), grid_blocks);
}
```

```cpp
#include <hip/hip_runtime.h>
#include <hip/hip_cooperative_groups.h>
#include <cstdio>
#include <cstdint>
namespace cg = cooperative_groups;

constexpr int D = 1024, BATCH = 8, SEQ = 4096, CTX = 256, TOK = 4352, NPROJ = 3888;
constexpr int ROWS = BATCH * TOK;
constexpr int NRAW = 1536, NREST = 2352, NPAD = 4096;
constexpr int NTHREADS = 512, NWAVES = 8;
constexpr int LDS_BYTES = 147456;
constexpr float ALPHA = 1.4142135623730951f;
constexpr int RC_AB = 0, RC_AZ = 16, RC_BQ = 528, RC_BK = 784, RC_BV = 1040, RC_BZ = 1296, RC_CQ = 1552, RC_CK = 1680, RC_CV = 1808, RC_CR = 2064, RC_CZ = 2096;

typedef unsigned short bf16;
typedef float f32x4_t __attribute__((ext_vector_type(4)));

struct P {
    const float *x, *c, *ctx, *c_ctx, *w_mod, *b_mod, *w_in, *conv_w, *a_log, *dt_bias, *gdn_norm, *rpb,
        *gla_w2, *gla_b2, *gla_norm, *w_out, *ln_g, *ln_b;
    float* out;
    float *mods, *xc1;
    bf16 *wi_t, *wo_t, *rest, *raw, *qkvn, *mix, *ml, *oa, *oc, *ob;
};

__device__ __forceinline__ float bf2f(unsigned short u) { return __uint_as_float((unsigned)u << 16); }
__device__ __forceinline__ unsigned short f2bf(float f) { unsigned u = __float_as_uint(f); return (unsigned short)((u + 0x7fffu + ((u >> 16) & 1u)) >> 16); }
__device__ __forceinline__ unsigned pk2(float lo, float hi) { return (unsigned)f2bf(lo) | ((unsigned)f2bf(hi) << 16); }
__device__ __forceinline__ float bflo(unsigned w) { return __uint_as_float(w << 16); }
__device__ __forceinline__ float bfhi(unsigned w) { return __uint_as_float(w & 0xffff0000u); }
__device__ __forceinline__ void unpack8(uint4 w, float* f) {
    f[0] = bflo(w.x); f[1] = bfhi(w.x); f[2] = bflo(w.y); f[3] = bfhi(w.y); f[4] = bflo(w.z); f[5] = bfhi(w.z); f[6] = bflo(w.w); f[7] = bfhi(w.w);
}
__device__ __forceinline__ float silu_f(float x) { return x / (1.f + expf(-x)); }
__device__ __forceinline__ float wave_sum(float v) {
#pragma unroll
    for (int o = 32; o > 0; o >>= 1) v += __shfl_xor(v, o);
    return v;
}
__device__ __forceinline__ float wave_max(float v) {
#pragma unroll
    for (int o = 32; o > 0; o >>= 1) v = fmaxf(v, __shfl_xor(v, o));
    return v;
}
__device__ __forceinline__ int mk_tid() { int t = threadIdx.x; asm volatile("" : "+v"(t)); return t; }
__device__ __forceinline__ int tok_of(int dir, int s) { return dir == 0 ? s : (s < CTX ? CTX - 1 - s : TOK + CTX - 1 - s); }

namespace pg8 {
#define PG8_LAS __attribute__((address_space(3)))
typedef unsigned short bf16_t;
typedef short bf16x8 __attribute__((ext_vector_type(8)));
typedef float f32x4 __attribute__((ext_vector_type(4)));
typedef unsigned u32x4 __attribute__((ext_vector_type(4)));
constexpr int BM = 256, BK = 64, HALF = 128, HTB = HALF * BK * 2  , STAGE_BYTES = 8 * HTB, NXCD = 8, WGM = 8;

__host__ __device__ __forceinline__ int lds_byte(int r, int c) { const int st = (r >> 4) * 2 + (c >> 5), rr = r & 15, cc = c & 31, ob = rr * 64 + cc * 2; return st * 1024 + (ob ^ (((ob >> 9) & 1) << 5)); }
__host__ __device__ __forceinline__ void stage_rc(int b, int& R, int& C) { const int st = b / 1024, sb = b % 1024, swz = sb ^ (((sb >> 9) & 1) << 5); R = (st >> 1) * 16 + swz / 64; C = (st & 1) * 32 + (swz % 64) / 2; }
__host__ __device__ __forceinline__ int perm32(int rho) { const int n = rho >> 4, i = rho & 15; return 8 * (i >> 2) + 4 * n + (i & 3); }

struct Unit { int pm, pn; };
struct Gemm { const bf16_t* A; const bf16_t* Bt; int M, N, K; };

struct StaticOrder {
    int nM, nN, nwg, G, c;
    __host__ __device__ void init(int M, int N, int G_, int c_) { nM = M / BM; nN = N / BM; nwg = nM * nN; G = G_; c = c_; }
    __host__ __device__ bool next(int i, Unit& u) const {
        const long L = (long)i * G + c; if (L >= nwg) return false;
        int wgid = (int)L; { const int q = nwg / NXCD, r = nwg % NXCD, xcd = wgid % NXCD, off = wgid / NXCD; wgid = (xcd < r ? xcd * (q + 1) : r * (q + 1) + (xcd - r) * q) + off; }
        const int nig = WGM * nN, gid = wgid / nig, fm = gid * WGM, gsz = (nM - fm) < WGM ? (nM - fm) : WGM;
        u.pm = fm + ((wgid % nig) % gsz); u.pn = (wgid % nig) / gsz; return true;
    }
    __device__ __forceinline__ void a_ready(const Unit&) const {}
    __device__ __forceinline__ void done(const Unit&) const {}
};

__device__ __forceinline__ unsigned cvt_pk_bf16(float lo, float hi) { unsigned r; asm volatile("v_cvt_pk_bf16_f32 %0, %1, %2" : "=v"(r) : "v"(lo), "v"(hi)); return r; }
template <class Epi, class Sched, bool ALIGN_EPI = false, bool SP2 = false>
__device__ __forceinline__ void gemm_phase(PG8_LAS unsigned char* lds, const Gemm g, const Sched& S, const Epi& E) {
    const int tid = mk_tid(), wid = __builtin_amdgcn_readfirstlane(tid >> 6), lane = tid & 63, wr = wid >> 2, wc = wid & 3, fr = lane & 15, fq = lane >> 4;
    const int K = g.K, nt = K / BK;
    unsigned voffA[2], voffB[2];
#pragma unroll
    for (int i = 0; i < 2; ++i) { int R, C; stage_rc(tid * 16 + i * 8192, R, C); const int Rb = Epi::PERM ? ((R & ~31) + perm32(R & 31)) : R;
        voffA[i] = (unsigned)(R * K + C) * 2u; voffB[i] = (unsigned)(Rb * K + C) * 2u; }
    const size_t kstep = (size_t)(BK * 2);
    const size_t hstep = (size_t)HALF * K * 2;
    const size_t tstep = 2 * hstep;
    const unsigned ldsw = (unsigned)wid * 1024u;
    const int aoff = lds_byte(wr * 64 + fr, fq * 8), boff = lds_byte(wc * 32 + fr, fq * 8);
#define PG8_SA(b, h) (((b) * 2 + (h)) * HTB)
#define PG8_SB(b, h) ((4 + (b) * 2 + (h)) * HTB)
#define PG8_STAGE(bufoff, gbase, voff) do { _Pragma("unroll") for (int _i = 0; _i < 2; ++_i) \
        __builtin_amdgcn_global_load_lds((const unsigned*)((const char*)(gbase) + (voff)[_i]), (PG8_LAS unsigned*)(lds + (bufoff) + ldsw + _i * 8192), 16, 0, 0); } while (0)
#define PG8_LDA(dst, b, h) do { _Pragma("unroll") for (int m = 0; m < 4; ++m) _Pragma("unroll") for (int k = 0; k < 2; ++k) dst[m][k] = *(const PG8_LAS bf16x8*)(lds + PG8_SA(b, h) + aoff + m * 2048 + k * 1024); } while (0)
#define PG8_LDB(dst, b, h) do { _Pragma("unroll") for (int n = 0; n < 2; ++n) _Pragma("unroll") for (int k = 0; k < 2; ++k) dst[n][k] = *(const PG8_LAS bf16x8*)(lds + PG8_SB(b, h) + boff + n * 2048 + k * 1024); } while (0)
#define PG8_MMA(ai, bj, At, Bt) do { __builtin_amdgcn_s_setprio(1); _Pragma("unroll") for (int m = 0; m < 4; ++m) _Pragma("unroll") for (int n = 0; n < 2; ++n) _Pragma("unroll") for (int k = 0; k < 2; ++k) \
        acc[ai][bj][m][n] = __builtin_amdgcn_mfma_f32_16x16x32_bf16(Bt[n][k], At[m][k], acc[ai][bj][m][n], 0, 0, 0); __builtin_amdgcn_s_setprio(0); } while (0)
#define PG8_WAIT_V(n) asm volatile("s_waitcnt vmcnt(" #n ")" ::: "memory")
#define PG8_WAIT_L(n) asm volatile("s_waitcnt lgkmcnt(" #n ")" ::: "memory")
#define PG8_BAR __builtin_amdgcn_s_barrier()
#define PG8_SCHED __builtin_amdgcn_sched_barrier(0)
    Unit cur, nxt; int ui = 0;
    if (!S.next(0, cur)) return;
    f32x4 acc[2][2][4][2];
#pragma unroll
    for (int a = 0; a < 2; ++a)
#pragma unroll
        for (int b = 0; b < 2; ++b)
#pragma unroll
            for (int m = 0; m < 4; ++m)
#pragma unroll
                for (int n = 0; n < 2; ++n) acc[a][b][m][n] = (f32x4){0.f, 0.f, 0.f, 0.f};
    bf16x8 At[4][2], B0[2][2], B1[2][2];
    const char* cA = (const char*)g.A + (size_t)cur.pm * tstep; const char* cB = (const char*)g.Bt + (size_t)cur.pn * tstep;
    S.a_ready(cur);
    if constexpr (SP2) {
        PG8_STAGE(PG8_SB(0, 0), cB, voffB); PG8_STAGE(PG8_SB(0, 1), cB + hstep, voffB); PG8_STAGE(PG8_SA(0, 0), cA, voffA); PG8_STAGE(PG8_SA(0, 1), cA + hstep, voffA);
        if (wr == 1) PG8_BAR;
        PG8_WAIT_V(2); PG8_BAR;
        PG8_STAGE(PG8_SB(1, 0), cB + kstep, voffB); PG8_STAGE(PG8_SA(1, 0), cA + kstep, voffA); PG8_STAGE(PG8_SB(1, 1), cB + hstep + kstep, voffB);
        PG8_WAIT_V(6); PG8_BAR;
    } else {
        PG8_STAGE(PG8_SB(0, 0), cB, voffB); PG8_STAGE(PG8_SA(0, 0), cA, voffA); PG8_STAGE(PG8_SB(0, 1), cB + hstep, voffB); PG8_STAGE(PG8_SA(0, 1), cA + hstep, voffA);
        if (wr == 1) PG8_BAR;
        PG8_WAIT_V(4); PG8_BAR;
        PG8_STAGE(PG8_SB(1, 0), cB + kstep, voffB); PG8_STAGE(PG8_SA(1, 0), cA + kstep, voffA); PG8_STAGE(PG8_SB(1, 1), cB + hstep + kstep, voffB);
        PG8_WAIT_V(6); PG8_BAR;
    }
    for (;;) {
        const bool has_next = S.next(ui + 1, nxt);
        const char* nA = has_next ? (const char*)g.A + (size_t)nxt.pm * tstep : cA; const char* nB = has_next ? (const char*)g.Bt + (size_t)nxt.pn * tstep : cB;
        for (int t = 0; t < nt; t += 2) {
            const bool last = (t == nt - 2);
            const char* a1 = cA + (size_t)(t + 1) * kstep;
            const char* a2 = last ? nA : cA + (size_t)(t + 2) * kstep; const char* b2 = last ? nB : cB + (size_t)(t + 2) * kstep;
            const char* a3 = a2 + kstep; const char* b3 = b2 + kstep;
            if (last && has_next) S.a_ready(nxt);
            if constexpr (SP2) {
            PG8_LDB(B0, 0, 0); PG8_LDB(B1, 0, 1); PG8_SCHED; PG8_LDA(At, 0, 0); PG8_STAGE(PG8_SA(1, 1), a1 + hstep, voffA);
            PG8_WAIT_V(8); PG8_WAIT_L(0); PG8_BAR; PG8_MMA(0, 0, At, B0); PG8_MMA(0, 1, At, B1); PG8_BAR; PG8_SCHED;
            PG8_LDA(At, 0, 1); PG8_STAGE(PG8_SB(0, 0), b2, voffB); PG8_STAGE(PG8_SB(0, 1), b2 + hstep, voffB); PG8_STAGE(PG8_SA(0, 0), a2, voffA);
            PG8_WAIT_V(8); PG8_WAIT_L(0); PG8_BAR; PG8_MMA(1, 0, At, B0); PG8_MMA(1, 1, At, B1); PG8_BAR; PG8_SCHED;
            PG8_LDB(B0, 1, 0); PG8_LDB(B1, 1, 1); PG8_SCHED; PG8_LDA(At, 1, 0); PG8_STAGE(PG8_SA(0, 1), a2 + hstep, voffA);
            PG8_WAIT_V(8); PG8_WAIT_L(0); PG8_BAR; PG8_MMA(0, 0, At, B0); PG8_MMA(0, 1, At, B1); PG8_BAR; PG8_SCHED;
            PG8_LDA(At, 1, 1); PG8_STAGE(PG8_SB(1, 0), b3, voffB); PG8_STAGE(PG8_SB(1, 1), b3 + hstep, voffB); PG8_STAGE(PG8_SA(1, 0), a3, voffA);
            PG8_WAIT_V(8); PG8_WAIT_L(0); PG8_BAR; PG8_MMA(1, 0, At, B0); PG8_MMA(1, 1, At, B1); PG8_BAR; PG8_SCHED;
            } else {
            PG8_LDB(B0, 0, 0); PG8_SCHED; PG8_LDA(At, 0, 0); PG8_STAGE(PG8_SA(1, 1), a1 + hstep, voffA);
            PG8_WAIT_L(8); PG8_BAR; PG8_WAIT_L(0); PG8_MMA(0, 0, At, B0); PG8_BAR; PG8_SCHED;
            PG8_LDB(B1, 0, 1); PG8_STAGE(PG8_SB(0, 0), b2, voffB);
            PG8_BAR; PG8_WAIT_L(0); PG8_MMA(0, 1, At, B1); PG8_BAR;
            PG8_LDA(At, 0, 1); PG8_STAGE(PG8_SA(0, 0), a2, voffA);
            PG8_BAR; PG8_WAIT_L(0); PG8_MMA(1, 0, At, B0); PG8_BAR; PG8_SCHED;
            PG8_STAGE(PG8_SB(0, 1), b2 + hstep, voffB);
            PG8_WAIT_V(6); PG8_BAR; PG8_MMA(1, 1, At, B1); PG8_BAR;
            PG8_LDB(B0, 1, 0); PG8_SCHED; PG8_LDA(At, 1, 0); PG8_STAGE(PG8_SA(0, 1), a2 + hstep, voffA);
            PG8_WAIT_L(8); PG8_BAR; PG8_WAIT_L(0); PG8_MMA(0, 0, At, B0); PG8_BAR; PG8_SCHED;
            PG8_LDB(B1, 1, 1); PG8_STAGE(PG8_SB(1, 0), b3, voffB);
            PG8_BAR; PG8_WAIT_L(0); PG8_MMA(0, 1, At, B1); PG8_BAR;
            PG8_LDA(At, 1, 1); PG8_STAGE(PG8_SA(1, 0), a3, voffA);
            PG8_BAR; PG8_WAIT_L(0); PG8_MMA(1, 0, At, B0); PG8_BAR; PG8_SCHED;
            PG8_STAGE(PG8_SB(1, 1), b3 + hstep, voffB);
            PG8_WAIT_V(6); PG8_BAR; PG8_MMA(1, 1, At, B1); PG8_BAR;
            }
        }
        if constexpr (ALIGN_EPI) { if (wr == 0) PG8_BAR; }
        if constexpr (!Epi::AFTER_DRAIN) { E(acc, cur, wr, wc, fr, fq); S.done(cur); }
        if (!has_next) break;
#pragma unroll
        for (int a = 0; a < 2; ++a)
#pragma unroll
            for (int b = 0; b < 2; ++b)
#pragma unroll
                for (int m = 0; m < 4; ++m)
#pragma unroll
                    for (int n = 0; n < 2; ++n) acc[a][b][m][n] = (f32x4){0.f, 0.f, 0.f, 0.f};
        cur = nxt; cA = nA; cB = nB; ++ui;
        if constexpr (ALIGN_EPI) { if (wr == 1) PG8_BAR; }
    }
    PG8_WAIT_V(0);
    if constexpr (!ALIGN_EPI) { if (wr == 0) PG8_BAR; }
    PG8_BAR;
    if constexpr (Epi::AFTER_DRAIN) { E.fused(acc, cur, wr, wc, fr, fq, lds, wid, lane); S.done(cur); }
#undef PG8_SA
#undef PG8_SB
#undef PG8_STAGE
#undef PG8_LDA
#undef PG8_LDB
#undef PG8_MMA
#undef PG8_WAIT_V
#undef PG8_WAIT_L
#undef PG8_BAR
#undef PG8_SCHED
}
}

#define LASP __attribute__((address_space(3)))

struct EpiProj {
    static constexpr bool PERM = true, AFTER_DRAIN = false;
    bf16* raw; bf16* rest;
    __device__ __forceinline__ void operator()(const pg8::f32x4 (&acc)[2][2][4][2], const pg8::Unit& u, int wr, int wc, int fr, int fq) const {
        const int row0 = u.pm * 256 + wr * 64 + fr;
        const int colb = u.pn * 256 + wc * 32 + 8 * fq;
#pragma unroll
        for (int bj = 0; bj < 2; ++bj) {
            const int col = colb + bj * 128;
            if (col >= NPROJ) continue;
            bf16* base; int ld;
            if (col < NRAW) { base = raw + col; ld = NRAW; } else { base = rest + (col - NRAW); ld = NREST; }
#pragma unroll
            for (int ai = 0; ai < 2; ++ai)
#pragma unroll
                for (int m = 0; m < 4; ++m) {
                    const pg8::f32x4 v0 = acc[ai][bj][m][0], v1 = acc[ai][bj][m][1];
                    pg8::u32x4 w; w.x = pg8::cvt_pk_bf16(v0[0], v0[1]); w.y = pg8::cvt_pk_bf16(v0[2], v0[3]); w.z = pg8::cvt_pk_bf16(v1[0], v1[1]); w.w = pg8::cvt_pk_bf16(v1[2], v1[3]);
                    *(pg8::u32x4*)(base + (size_t)(row0 + ai * 128 + m * 16) * ld) = w;
                }
        }
    }
};
struct EpiRes {
    static constexpr bool PERM = false, AFTER_DRAIN = false;
    const float* xl_src; const float* xc_src; float* out; float* xc1; const float* mods; int l;
    __device__ __forceinline__ void operator()(const pg8::f32x4 (&acc)[2][2][4][2], const pg8::Unit& u, int wr, int wc, int fr, int fq) const {
        const int row0 = u.pm * 256 + wr * 64 + fr, col0 = u.pn * 256 + wc * 32 + 4 * fq;
#pragma unroll
        for (int ai = 0; ai < 2; ++ai)
#pragma unroll
            for (int m = 0; m < 4; ++m) {
                const int r = row0 + ai * 128 + m * 16;
                const int b = r / TOK, t = r - b * TOK;
                const float* src; float* dst; int s;
                if (t < CTX) { if (l != 0) continue; src = xc_src + ((size_t)b * CTX + t) * D; dst = xc1 + ((size_t)b * CTX + t) * D; s = 8; }
                else { src = xl_src + ((size_t)b * SEQ + (t - CTX)) * D; dst = out + ((size_t)b * SEQ + (t - CTX)) * D; s = b; }
                const float* gt = mods + (size_t)(l * 9 + s) * 3072 + 2048;
#pragma unroll
                for (int bj = 0; bj < 2; ++bj)
#pragma unroll
                    for (int n = 0; n < 2; ++n) {
                        const int c = col0 + bj * 128 + n * 16;
                        const pg8::f32x4 xv = *(const pg8::f32x4*)(src + c), g = *(const pg8::f32x4*)(gt + c);
                        *(pg8::f32x4*)(dst + c) = xv * ALPHA + g * acc[ai][bj][m][n];
                    }
            }
    }
};

__device__ __forceinline__ void transpose_item(const float* W, int K, int N, bf16* WT, LASP float* scr, int item, int lane) {
    const int nblk = (N + 31) / 32, kb = item / nblk, nb = item % nblk, k0 = 64 * kb, n0 = 32 * nb;
    const bool nok = (n0 + (lane & 31)) < N;
#pragma unroll 8
    for (int i = 0; i < 32; ++i) { const int kk = 2 * i + (lane >> 5); scr[kk * 33 + (lane & 31)] = nok ? W[(size_t)(k0 + kk) * N + n0 + (lane & 31)] : 0.f; }
    asm volatile("s_waitcnt lgkmcnt(0)" ::: "memory");
    const int c = lane & 7;
#pragma unroll
    for (int j = 0; j < 4; ++j) {
        const int n = (lane >> 3) + 8 * j; const LASP float* s = scr + (8 * c) * 33 + n;
        uint4 o; o.x = pk2(s[0 * 33], s[1 * 33]); o.y = pk2(s[2 * 33], s[3 * 33]); o.z = pk2(s[4 * 33], s[5 * 33]); o.w = pk2(s[6 * 33], s[7 * 33]);
        *(uint4*)(WT + (size_t)(n0 + n) * K + k0 + 8 * c) = o;
    }
    asm volatile("s_waitcnt lgkmcnt(0)" ::: "memory");
}

__device__ void ph_prologue(const P& p, LASP unsigned char* lds, int bid, int nblk) {
    const int tid = mk_tid(), lane = tid & 63, wave = tid >> 6;
    LASP float* sm = (LASP float*)lds;
    if (bid * NTHREADS < 2 * 3072) {
        for (int i = tid; i < 9 * 1024; i += NTHREADS) {
            int s = i >> 10, d = i & 1023;
            float cv = s < 8 ? p.c[s * 1024 + d] : p.c_ctx[d];
            sm[i] = silu_f(cv);
        }
        __syncthreads();
        for (int o = bid * NTHREADS + tid; o < 2 * 3072; o += nblk * NTHREADS) {
            int l = o / 3072, j = o % 3072;
            const float* w = p.w_mod + (size_t)l * 1024 * 3072 + j;
            float acc[9];
#pragma unroll
            for (int s = 0; s < 9; ++s) acc[s] = 0.f;
            for (int i = 0; i < 1024; ++i) {
                float wv = w[(size_t)i * 3072];
#pragma unroll
                for (int s = 0; s < 9; ++s) acc[s] += sm[s * 1024 + i] * wv;
            }
            float bb = p.b_mod[l * 3072 + j];
#pragma unroll
            for (int s = 0; s < 9; ++s) p.mods[(size_t)(l * 9 + s) * 3072 + j] = acc[s] + bb;
        }
        __syncthreads();
    }
    LASP float* scr = (LASP float*)(lds + 40960 + wave * 8704);
    const int gw = (nblk - 1 - bid) * NWAVES + wave, NGW = nblk * NWAVES;
    constexpr int I_IN = 16 * 122, I_OUT = 16 * 32;
    for (int it = gw; it < 2 * (I_IN + I_OUT); it += NGW) {
        int l = it / (I_IN + I_OUT), r = it % (I_IN + I_OUT);
        if (r < I_IN) transpose_item(p.w_in + (size_t)l * D * NPROJ, D, NPROJ, p.wi_t + (size_t)l * NPAD * D, scr, r, lane);
        else transpose_item(p.w_out + (size_t)l * D * D, D, D, p.wo_t + (size_t)l * D * D, scr, r - I_IN, lane);
    }
    for (int i = bid * NTHREADS + tid; i < 2 * 192 * 128; i += nblk * NTHREADS) {
        int l = i / (192 * 128), r = i % (192 * 128);
        *(uint4*)(p.wi_t + (size_t)l * NPAD * D + (size_t)3904 * D + (size_t)r * 8) = make_uint4(0, 0, 0, 0);
    }
}

__device__ void ph_lnpass(const P& p, int mode, int bid, int nblk) {
    const int tid = mk_tid();
    const int lane = tid & 63, wave = tid >> 6;
    for (int r = bid * NWAVES + wave; r < ROWS; r += nblk * NWAVES) {
        const int b = r / TOK, t = r - b * TOK;
        const bool isc = t < CTX;
        if (mode == 2 && isc) continue;
        float* buf; const float* src; int s;
        if (isc) { buf = p.xc1 + ((size_t)b * CTX + t) * D; src = (mode == 0) ? p.ctx + ((size_t)b * CTX + t) * D : buf; s = 8; }
        else { buf = p.out + ((size_t)b * SEQ + (t - CTX)) * D; src = (mode == 0) ? p.x + ((size_t)b * SEQ + (t - CTX)) * D : buf; s = b; }
        f32x4_t v[4];
#pragma unroll
        for (int j = 0; j < 4; ++j) v[j] = *(const f32x4_t*)(src + 256 * j + 4 * lane);
        if (mode >= 1) {
            const int lp = mode - 1;
            float sum = 0.f;
#pragma unroll
            for (int j = 0; j < 4; ++j) sum += (v[j].x + v[j].y) + (v[j].z + v[j].w);
            const float mu = wave_sum(sum) * (1.f / 1024.f);
            float sq = 0.f;
#pragma unroll
            for (int j = 0; j < 4; ++j) { v[j] = v[j] - mu; sq += (v[j].x * v[j].x + v[j].y * v[j].y) + (v[j].z * v[j].z + v[j].w * v[j].w); }
            const float rs = 1.f / sqrtf(wave_sum(sq) * (1.f / 1024.f) + 1e-6f);
#pragma unroll
            for (int j = 0; j < 4; ++j) {
                const f32x4_t g = *(const f32x4_t*)(p.ln_g + lp * 1024 + 256 * j + 4 * lane), bb = *(const f32x4_t*)(p.ln_b + lp * 1024 + 256 * j + 4 * lane);
                v[j] = v[j] * rs * g + bb;
                *(f32x4_t*)(buf + 256 * j + 4 * lane) = v[j];
            }
            if (mode == 2) continue;
        }
        const int l = mode;
        float sum = 0.f;
#pragma unroll
        for (int j = 0; j < 4; ++j) sum += (v[j].x + v[j].y) + (v[j].z + v[j].w);
        const float mu = wave_sum(sum) * (1.f / 1024.f);
        float sq = 0.f;
#pragma unroll
        for (int j = 0; j < 4; ++j) { v[j] = v[j] - mu; sq += (v[j].x * v[j].x + v[j].y * v[j].y) + (v[j].z * v[j].z + v[j].w * v[j].w); }
        const float rs = 1.f / sqrtf(wave_sum(sq) * (1.f / 1024.f) + 1e-6f);
        const float* md = p.mods + (size_t)(l * 9 + s) * 3072;
#pragma unroll
        for (int j = 0; j < 4; ++j) {
            const f32x4_t sh = *(const f32x4_t*)(md + 256 * j + 4 * lane), sc = *(const f32x4_t*)(md + 1024 + 256 * j + 4 * lane);
            const f32x4_t o = v[j] * rs * (sc + 1.f) + sh;
            uint2 w; w.x = pk2(o.x, o.y); w.y = pk2(o.z, o.w);
            *(uint2*)(p.ml + (size_t)r * D + 256 * j + 4 * lane) = w;
        }
    }
}

__device__ void ph_conv(const P& p, int l, int bid, int nblk) {
    const int tid = mk_tid();
    const int lane = tid & 63, wave = tid >> 6;
    const float* cw = p.conv_w + (size_t)l * 5 * 1536;
    for (int it = bid * NWAVES + wave; it < ROWS * 12; it += nblk * NWAVES) {
        const int r = it / 12, g = it - r * 12;
        const int t = r % TOK;
        const int lo = t < CTX ? 0 : CTX, hi = t < CTX ? CTX : TOK;
        const int ch = g * 128 + lane * 2;
        float a0 = 0.f, a1 = 0.f;
#pragma unroll
        for (int j = 0; j < 5; ++j) {
            const int tt = t + j - 2;
            if (tt >= lo && tt < hi) {
                const unsigned w = *(const unsigned*)(p.raw + (size_t)(r + j - 2) * NRAW + ch);
                a0 += cw[j * 1536 + ch] * bflo(w); a1 += cw[j * 1536 + ch + 1] * bfhi(w);
            }
        }
        a0 = silu_f(a0); a1 = silu_f(a1);
        if (g < 8) {
            const float ss = wave_sum(a0 * a0 + a1 * a1);
            float sc = 1.f / sqrtf(ss + 1e-6f);
            if (g < 4) sc *= 0.08838834764831845f;
            a0 *= sc; a1 *= sc;
        }
        *(unsigned*)(p.qkvn + (size_t)r * NRAW + ch) = pk2(a0, a1);
    }
}


typedef short bf16x8_t __attribute__((ext_vector_type(8)));
typedef float f32x16_t __attribute__((ext_vector_type(16)));
typedef float f32x2_t __attribute__((ext_vector_type(2)));
typedef __bf16 bf16x2_t __attribute__((ext_vector_type(2)));
typedef unsigned u32x4_t __attribute__((ext_vector_type(4)));
#define MFMA32(a, b, c) __builtin_amdgcn_mfma_f32_32x32x16_bf16((a), (b), (c), 0, 0, 0)
__device__ __forceinline__ unsigned cvtpk(float lo, float hi) { f32x2_t v = {lo, hi}; bf16x2_t q = __builtin_convertvector(v, bf16x2_t); return __builtin_bit_cast(unsigned, q); }
__device__ __forceinline__ int crow(int reg, int h) { return (reg & 3) + 8 * (reg >> 2) + 4 * h; }
__device__ __forceinline__ int perm16(int a) { const int x = a & 15; return (a & ~15) + (x < 4 ? x : x < 8 ? x + 4 : x < 12 ? x - 4 : x); }
#define PACK8(x, s) __builtin_bit_cast(bf16x8_t, (u32x4_t){cvtpk((x)[8 * (s)], (x)[8 * (s) + 1]), cvtpk((x)[8 * (s) + 2], (x)[8 * (s) + 3]), cvtpk((x)[8 * (s) + 4], (x)[8 * (s) + 5]), cvtpk((x)[8 * (s) + 6], (x)[8 * (s) + 7])})
constexpr int GCH = 32, NCH = TOK / GCH;
constexpr int GP_ITEM = 4416;

__device__ void ph_gdnprep(const P& p, LASP unsigned char* lds, int l, int bid, int nblk) {
    const int tid = mk_tid();
    const int lane = tid & 63, wave = tid >> 6, r = lane & 31, hh = lane >> 5;
    LASP float* Lm = (LASP float*)(lds + wave * 16384);
    LASP float* Xs = Lm + 2048;
    for (int it = bid * NWAVES + wave; it < BATCH * 4 * NCH; it += nblk * NWAVES) {
        const int c = it % NCH, bh = it / NCH, h = bh & 3, b = bh >> 2;
        const size_t row0 = (size_t)b * TOK + (size_t)c * GCH;
        f32x16_t KK, QK;
#pragma unroll
        for (int i = 0; i < 16; ++i) { KK[i] = 0.f; QK[i] = 0.f; }
        const bf16* kbase = p.qkvn + (row0 + r) * NRAW + 512 + h * 128 + 8 * hh;
        const bf16* qbase = p.qkvn + (row0 + r) * NRAW + h * 128 + 8 * hh;
#pragma unroll
        for (int s = 0; s < 8; ++s) {
            const bf16x8_t kf = *(const bf16x8_t*)(kbase + 16 * s), qf = *(const bf16x8_t*)(qbase + 16 * s);
            KK = MFMA32(kf, kf, KK);
            QK = MFMA32(qf, kf, QK);
        }
        float Gd, bd;
        {
            const bf16* ab = p.rest + (row0 + r) * NREST + RC_AB;
            const float a = bf2f(ab[hh * 4 + h]) + p.dt_bias[(l * 2 + hh) * 4 + h];
            const float sp = fmaxf(a, 0.f) + log1pf(expf(-fabsf(a)));
            Gd = -expf(p.a_log[(l * 2 + hh) * 4 + h]) * sp;
            bd = 1.f / (1.f + expf(-bf2f(ab[(2 + hh) * 4 + h])));
        }
#pragma unroll
        for (int off = 1; off < 32; off <<= 1) {
            const float up = __shfl_up(Gd, off, 32), dn = __shfl_down(Gd, off, 32);
            if (hh == 0) { if (r >= off) Gd += up; } else { if (r + off < 32) Gd += dn; }
        }
        unsigned char* gout = (unsigned char*)p.raw + ((size_t)(bh * 2) * NCH + c) * GP_ITEM;
        {
            const float Glast = __shfl(Gd, hh == 0 ? 31 : 32);
            float* sc = (float*)(gout + (size_t)hh * NCH * GP_ITEM + 4096);
            sc[r] = expf(Gd); sc[32 + r] = expf(Glast - Gd);
            if (r == 0) sc[64] = expf(Glast);
        }
        asm volatile("s_waitcnt lgkmcnt(0)" ::: "memory");
#pragma unroll
        for (int d = 0; d < 2; ++d) {
            const float Gcol = __shfl(Gd, d * 32 + r);
            bf16* qko = (bf16*)(gout + (size_t)d * NCH * GP_ITEM + 2048);
#pragma unroll
            for (int i = 0; i < 16; ++i) {
                const int n = crow(i, hh);
                const float Grow = __shfl(Gd, d * 32 + n), brow = __shfl(bd, d * 32 + n);
                const bool incl = d == 0 ? (r <= n) : (r >= n), strict = d == 0 ? (r < n) : (r > n);
                const float dec = expf(incl ? Grow - Gcol : 0.f);
                const float lv = strict ? brow * KK[i] * dec : 0.f;
                const float qv = incl ? QK[i] * dec : 0.f;
                const int n2 = d == 0 ? n : 31 - n, m2 = d == 0 ? r : 31 - r;
                Lm[(d * 32 + n2) * 32 + m2] = lv;
                qko[n * 32 + perm16(r)] = f2bf(qv);
                if ((i & 3) == 3) __builtin_amdgcn_sched_barrier(0);
            }
        }
        asm volatile("s_waitcnt lgkmcnt(0)" ::: "memory");
        {
            const LASP float* Lr = Lm + hh * 1024;
            LASP float* xc = Xs + lane;
#pragma unroll 4
            for (int j = 0; j < 32; ++j) xc[j * 64] = (j == r) ? 1.f : 0.f;
#pragma unroll 1
            for (int n = 1; n < 32; ++n) {
                float a0 = 0.f, a1 = 0.f;
#pragma unroll 1
                for (int j4 = 0; j4 < n; j4 += 4) {
                    const f32x4_t lv = *(const LASP f32x4_t*)(Lr + n * 32 + j4);
                    a0 += lv.x * xc[(j4 + 0) * 64]; a1 += lv.y * xc[(j4 + 1) * 64];
                    a0 += lv.z * xc[(j4 + 2) * 64]; a1 += lv.w * xc[(j4 + 3) * 64];
                }
                xc[n * 64] -= (a0 + a1);
            }
            const int mtok = hh == 0 ? r : 31 - r;
            const float bcol = __shfl(bd, hh * 32 + mtok);
            bf16* tq = (bf16*)(gout + (size_t)hh * NCH * GP_ITEM) + perm16(mtok) + (hh == 0 ? 0 : 31 * 32);
            const int tstep = hh == 0 ? 32 : -32;
#pragma unroll 4
            for (int n = 0; n < 32; ++n) { *tq = f2bf(xc[n * 64] * bcol); tq += tstep; }
        }
        asm volatile("s_waitcnt lgkmcnt(0)" ::: "memory");
    }
}

constexpr int ST_KA = 0, ST_QA = 8704, ST_KT = 17408, ST_V = 27648, ST_TP = 35840, ST_QK = 38400, ST_SC = 40960, ST_BYTES = 41344;
typedef unsigned u32x2_t __attribute__((ext_vector_type(2)));
struct GSlot { u32x4_t k0, k1, q0, q1, v0, v1, t; f32x4_t sc; };

__device__ __forceinline__ int gdn_chunk(int dir, int s) { return dir == 0 ? s : (s < 8 ? 7 - s : 143 - s); }
__device__ __forceinline__ void gdn_issue(const P& p, GSlot& g, int b, int h, int dir, int step, int tl) {
    const int c = gdn_chunk(dir, step);
    const size_t row0 = (size_t)b * TOK + (size_t)c * GCH;
    const int r0 = tl >> 4, c16 = tl & 15;
    const bf16* a0 = p.qkvn + (row0 + r0) * NRAW + h * 128 + 8 * c16;
    const bf16* a1 = a0 + (size_t)16 * NRAW;
    g.q0 = *(const u32x4_t*)a0; g.q1 = *(const u32x4_t*)a1;
    g.k0 = *(const u32x4_t*)(a0 + 512); g.k1 = *(const u32x4_t*)(a1 + 512);
    g.v0 = *(const u32x4_t*)(a0 + 1024); g.v1 = *(const u32x4_t*)(a1 + 1024);
    const unsigned char* gp = (const unsigned char*)p.raw + ((size_t)((b * 4 + h) * 2 + dir) * NCH + c) * GP_ITEM;
    g.t = *(const u32x4_t*)(gp + tl * 16);
    if (tl < 20) g.sc = *(const f32x4_t*)(gp + 4096 + tl * 16);
}
__device__ __forceinline__ void gdn_put_rows(LASP unsigned char* st, int row, int c16, u32x4_t kq, int off) {
    const int g = c16 >> 1, odd = c16 & 1;
    *(LASP u32x2_t*)(st + off + row * 272 + (16 * g + (odd ? 4 : 0)) * 2) = (u32x2_t){kq.x, kq.y};
    *(LASP u32x2_t*)(st + off + row * 272 + (16 * g + (odd ? 12 : 8)) * 2) = (u32x2_t){kq.z, kq.w};
}
__device__ __forceinline__ void gdn_put_kt(LASP unsigned char* st, int row, int c16, u32x4_t k) {
    LASP unsigned short* kt = (LASP unsigned short*)(st + ST_KT) + perm16(row);
    const int d0 = 8 * c16;
    kt[(d0 + 0) * 40] = (unsigned short)(k.x & 0xffffu); kt[(d0 + 1) * 40] = (unsigned short)(k.x >> 16);
    kt[(d0 + 2) * 40] = (unsigned short)(k.y & 0xffffu); kt[(d0 + 3) * 40] = (unsigned short)(k.y >> 16);
    kt[(d0 + 4) * 40] = (unsigned short)(k.z & 0xffffu); kt[(d0 + 5) * 40] = (unsigned short)(k.z >> 16);
    kt[(d0 + 6) * 40] = (unsigned short)(k.w & 0xffffu); kt[(d0 + 7) * 40] = (unsigned short)(k.w >> 16);
}
__device__ __forceinline__ void gdn_write(LASP unsigned char* st, const GSlot& g, int tl) {
    const int r0 = tl >> 4, c16 = tl & 15;
    gdn_put_rows(st, r0, c16, g.k0, ST_KA); gdn_put_rows(st, r0 + 16, c16, g.k1, ST_KA);
    gdn_put_rows(st, r0, c16, g.q0, ST_QA); gdn_put_rows(st, r0 + 16, c16, g.q1, ST_QA);
    gdn_put_kt(st, r0, c16, g.k0); gdn_put_kt(st, r0 + 16, c16, g.k1);
    *(LASP u32x4_t*)(st + ST_V + r0 * 256 + c16 * 16) = g.v0;
    *(LASP u32x4_t*)(st + ST_V + (r0 + 16) * 256 + c16 * 16) = g.v1;
    { const int t2 = tl & 127; *(LASP u32x4_t*)(st + (tl < 128 ? ST_TP : ST_QK) + (t2 >> 2) * 80 + (t2 & 3) * 16) = g.t; }
    if (tl < 20) *(LASP f32x4_t*)(st + ST_SC + tl * 16) = g.sc;
}

__device__ void gdn_scan_fast(const P& p, LASP unsigned char* lds, int chain) {
    const int tid = mk_tid();
    const int lane = tid & 63, wave = __builtin_amdgcn_readfirstlane(tid >> 6);
    const int dir = chain & 1, h = (chain >> 1) & 3, b = chain >> 3;
    constexpr int NS = NCH;
    if (wave >= 4) {
        const int tl = tid - 256;
        GSlot g0, g1, g2, g3;
        gdn_issue(p, g0, b, h, dir, 0, tl); gdn_issue(p, g1, b, h, dir, 1, tl); gdn_issue(p, g2, b, h, dir, 2, tl); gdn_issue(p, g3, b, h, dir, 3, tl);
        gdn_write(lds, g0, tl); gdn_issue(p, g0, b, h, dir, 4, tl);
        __syncthreads();
#pragma unroll 1
        for (int s = 0; s < NS; s += 4) {
            gdn_write(lds + ((s + 1) & 1) * ST_BYTES, g1, tl); if (s + 5 < NS) gdn_issue(p, g1, b, h, dir, s + 5, tl);
            __syncthreads();
            gdn_write(lds + ((s + 2) & 1) * ST_BYTES, g2, tl); if (s + 6 < NS) gdn_issue(p, g2, b, h, dir, s + 6, tl);
            __syncthreads();
            gdn_write(lds + ((s + 3) & 1) * ST_BYTES, g3, tl); if (s + 7 < NS) gdn_issue(p, g3, b, h, dir, s + 7, tl);
            __syncthreads();
            if (s + 4 < NS) { gdn_write(lds + ((s + 4) & 1) * ST_BYTES, g0, tl); if (s + 8 < NS) gdn_issue(p, g0, b, h, dir, s + 8, tl); }
            __syncthreads();
        }
    } else {
        const int r = lane & 31, hh = lane >> 5, w = wave;
        f32x16_t S0, S1, S2, S3;
#pragma unroll
        for (int i = 0; i < 16; ++i) { S0[i] = 0.f; S1[i] = 0.f; S2[i] = 0.f; S3[i] = 0.f; }
        __syncthreads();
#pragma unroll 1
        for (int s = 0; s < NS; ++s) {
            LASP unsigned char* st = lds + (s & 1) * ST_BYTES;
            const bf16x8_t Sb00 = PACK8(S0, 0), Sb01 = PACK8(S0, 1), Sb10 = PACK8(S1, 0), Sb11 = PACK8(S1, 1);
            const bf16x8_t Sb20 = PACK8(S2, 0), Sb21 = PACK8(S2, 1), Sb30 = PACK8(S3, 0), Sb31 = PACK8(S3, 1);
            f32x16_t ak, aq;
#pragma unroll
            for (int i = 0; i < 16; ++i) { ak[i] = 0.f; aq[i] = 0.f; }
            const LASP unsigned char* ka = st + ST_KA + r * 272 + hh * 16;
            const LASP unsigned char* qa = st + ST_QA + r * 272 + hh * 16;
#define GDN_KQ(ks, SB) { const bf16x8_t A = *(const LASP bf16x8_t*)(ka + (ks) * 32); ak = MFMA32(A, SB, ak); const bf16x8_t A2 = *(const LASP bf16x8_t*)(qa + (ks) * 32); aq = MFMA32(A2, SB, aq); }
            GDN_KQ(0, Sb00) GDN_KQ(1, Sb01) GDN_KQ(2, Sb10) GDN_KQ(3, Sb11) GDN_KQ(4, Sb20) GDN_KQ(5, Sb21) GDN_KQ(6, Sb30) GDN_KQ(7, Sb31)
#undef GDN_KQ
            const LASP float* sc = (const LASP float*)(st + ST_SC);
            float ev[16], fv[16];
#pragma unroll
            for (int g = 0; g < 4; ++g) {
                const f32x4_t e4 = *(const LASP f32x4_t*)(sc + 8 * g + 4 * hh), f4 = *(const LASP f32x4_t*)(sc + 32 + 8 * g + 4 * hh);
                ev[4 * g] = e4.x; ev[4 * g + 1] = e4.y; ev[4 * g + 2] = e4.z; ev[4 * g + 3] = e4.w;
                fv[4 * g] = f4.x; fv[4 * g + 1] = f4.y; fv[4 * g + 2] = f4.z; fv[4 * g + 3] = f4.w;
            }
            const float gl = sc[64];
            const LASP unsigned short* vl = (const LASP unsigned short*)(st + ST_V) + 32 * w + r;
            f32x16_t rr;
#pragma unroll
            for (int i = 0; i < 16; ++i) rr[i] = bf2f(vl[crow(i, hh) * 128]) - ev[i] * ak[i];
            const bf16x8_t rb0 = PACK8(rr, 0), rb1 = PACK8(rr, 1);
            f32x16_t vn;
#pragma unroll
            for (int i = 0; i < 16; ++i) vn[i] = 0.f;
            const LASP unsigned char* tp = st + ST_TP + r * 80 + hh * 16;
            vn = MFMA32(*(const LASP bf16x8_t*)(tp), rb0, vn);
            vn = MFMA32(*(const LASP bf16x8_t*)(tp + 32), rb1, vn);
#pragma unroll
            for (int i = 0; i < 16; ++i) aq[i] *= ev[i];
            const bf16x8_t vb0 = PACK8(vn, 0), vb1 = PACK8(vn, 1);
            const LASP unsigned char* qk = st + ST_QK + r * 80 + hh * 16;
            aq = MFMA32(*(const LASP bf16x8_t*)(qk), vb0, aq);
            aq = MFMA32(*(const LASP bf16x8_t*)(qk + 32), vb1, aq);
            {
                const int c = gdn_chunk(dir, s);
                bf16* op = p.oa + ((size_t)dir * ROWS + (size_t)b * TOK + (size_t)c * GCH) * 512 + h * 128 + 32 * w + r;
#pragma unroll
                for (int i = 0; i < 16; ++i) op[(size_t)crow(i, hh) * 512] = f2bf(aq[i]);
            }
            f32x16_t vf;
#pragma unroll
            for (int i = 0; i < 16; ++i) vf[i] = vn[i] * fv[i];
            const bf16x8_t fb0 = PACK8(vf, 0), fb1 = PACK8(vf, 1);
            const LASP unsigned char* kt = st + ST_KT + r * 80 + hh * 16;
#define GDN_UPD(SX, mt) { _Pragma("unroll") for (int i = 0; i < 16; ++i) SX[i] *= gl; SX = MFMA32(*(const LASP bf16x8_t*)(kt + (mt) * 32 * 80), fb0, SX); SX = MFMA32(*(const LASP bf16x8_t*)(kt + (mt) * 32 * 80 + 32), fb1, SX); }
            GDN_UPD(S0, 0) GDN_UPD(S1, 1) GDN_UPD(S2, 2) GDN_UPD(S3, 3)
#undef GDN_UPD
            __syncthreads();
        }
    }
}

__device__ void gla_scan_naive(const P& p, LASP float* sm, int l, int b) {
    const int tid = mk_tid();
    LASP float* sq = sm;
    LASP float* sv = sm + 8 * 16 * 96;
    const int grp = tid >> 6, lane = tid & 63, h = grp >> 1, dir = grp & 1;
    const int d = lane & 31, par = lane >> 5;
    float w2c[16];
#pragma unroll
    for (int j = 0; j < 16; ++j) w2c[j] = p.gla_w2[((size_t)(l * 2 + dir) * 16 + j) * 128 + h * 32 + d];
    const float b2v = p.gla_b2[(l * 2 + dir) * 128 + h * 32 + d];
    const int dd = d & 15, f = dd & 7;
    const float inv = powf(10000.f, -(float)f / 8.f);
    const int pd = dd < 8 ? d + 8 : d - 8;
    float S[32];
#pragma unroll
    for (int i = 0; i < 32; ++i) S[i] = 0.f;
    for (int s0 = 0; s0 < TOK; s0 += 16) {
        __syncthreads();
#pragma unroll 1
        for (int jj = 0; jj < 8; ++jj) {
            const int j = par + 2 * jj;
            const int t = tok_of(dir, s0 + j);
            const bf16* base = p.rest + ((size_t)b * TOK + t) * NREST;
            float qv = bf2f(base[RC_CQ + h * 32 + d]), kv = bf2f(base[RC_CK + h * 32 + d]);
            if (t >= CTX) {
                const int pidx = t - CTX;
                const int pos = d < 16 ? (pidx >> 6) : (pidx & 63);
                const float ang = (float)pos * inv;
                const float cs = cosf(ang), sn = sinf(ang);
                const float qp = bf2f(base[RC_CQ + h * 32 + pd]), kp = bf2f(base[RC_CK + h * 32 + pd]);
                if (dd < 8) { qv = qv * cs - qp * sn; kv = kv * cs - kp * sn; }
                else { qv = qp * sn + qv * cs; kv = kp * sn + kv * cs; }
            }
            qv *= 0.17677669529663687f;
            float xg = b2v;
#pragma unroll
            for (int jr = 0; jr < 16; ++jr) xg += bf2f(base[RC_CR + dir * 16 + jr]) * w2c[jr];
            const float ls = fminf(xg, 0.f) - log1pf(expf(-fabsf(xg)));
            LASP float* dst = sq + (grp * 16 + j) * 96;
            dst[d] = qv; dst[32 + d] = kv; dst[64 + d] = expf(ls * (1.f / 16.f));
        }
        for (int i = lane; i < 16 * 64; i += 64) {
            const int j = i >> 6, c = i & 63;
            const int t = tok_of(dir, s0 + j);
            sv[(grp * 16 + j) * 64 + c] = bf2f(p.rest[((size_t)b * TOK + t) * NREST + RC_CV + h * 64 + c]);
        }
        __syncthreads();
#pragma unroll 1
        for (int j = 0; j < 16; ++j) {
            const LASP float* qp = sq + (grp * 16 + j) * 96;
            const LASP float* kp = qp + 32;
            const LASP float* dp = qp + 64;
            const float v = sv[(grp * 16 + j) * 64 + lane];
            float o0 = 0.f, o1 = 0.f;
#pragma unroll
            for (int e = 0; e < 32; e += 2) {
                S[e] = dp[e] * S[e] + kp[e] * v; o0 += S[e] * qp[e];
                S[e + 1] = dp[e + 1] * S[e + 1] + kp[e + 1] * v; o1 += S[e + 1] * qp[e + 1];
            }
            const int t = tok_of(dir, s0 + j);
            p.oc[((size_t)dir * ROWS + (size_t)b * TOK + t) * 256 + h * 64 + lane] = f2bf(o0 + o1);
        }
    }
    __syncthreads();
}

__device__ void na_query_naive(const P& p, LASP float* sm, int l, int b, int t0) {
    const int tid = mk_tid();
    const int wave = tid >> 6, lane = tid & 63, h = wave & 3, t = t0 + (wave >> 2);
    LASP float* pw = sm + wave * 384;
    const size_t rowq = (size_t)b * TOK + t;
    float qv[64];
    {
        const bf16* qs = p.rest + rowq * NREST + RC_BQ + h * 64;
#pragma unroll
        for (int i = 0; i < 8; ++i) {
            float f[8]; unpack8(*(const uint4*)(qs + i * 8), f);
#pragma unroll
            for (int e = 0; e < 8; ++e) qv[i * 8 + e] = f[e] * 0.125f;
        }
    }
    const bool lat = t >= CTX;
    const int nk = lat ? 384 : 256;
    int r = 0, c = 0, r0 = 0, c0 = 0;
    if (lat) { int pi = t - CTX; r = pi >> 6; c = pi & 63; r0 = min(max(r - 4, 0), 56); c0 = min(max(c - 8, 0), 48); }
    float m = -1e30f;
    __syncthreads();
#pragma unroll 1
    for (int j = 0; j < 6; ++j) {
        const int idx = lane + 64 * j;
        float s = -1e30f;
        if (idx < nk) {
            int tk; float bias = 0.f;
            if (lat && idx < 128) {
                const int i = idx >> 4, kc = c0 + (idx & 15);
                tk = CTX + (r0 + i) * 64 + kc;
                bias = p.rpb[((size_t)(l * 4 + h) * 15 + (r0 + i - r + 7)) * 31 + (kc - c + 15)];
            } else tk = lat ? idx - 128 : idx;
            const bf16* ks = p.rest + ((size_t)b * TOK + tk) * NREST + RC_BK + h * 64;
            float d0 = 0.f, d1 = 0.f;
#pragma unroll
            for (int i = 0; i < 8; ++i) {
                float f[8]; unpack8(*(const uint4*)(ks + i * 8), f);
#pragma unroll
                for (int e = 0; e < 8; e += 2) { d0 += qv[i * 8 + e] * f[e]; d1 += qv[i * 8 + e + 1] * f[e + 1]; }
            }
            s = d0 + d1 + bias;
        }
        pw[idx] = s;
        m = fmaxf(m, s);
    }
    m = wave_max(m);
    float sum = 0.f;
#pragma unroll 1
    for (int j = 0; j < 6; ++j) { const float e = expf(pw[lane + 64 * j] - m); pw[lane + 64 * j] = e; sum += e; }
    sum = wave_sum(sum);
    const float inv = 1.f / sum;
    __syncthreads();
    float o0 = 0.f, o1 = 0.f;
    for (int idx = 0; idx < nk; idx += 2) {
        int tk0;
        if (lat && idx < 128) tk0 = CTX + (r0 + (idx >> 4)) * 64 + c0 + (idx & 15);
        else tk0 = lat ? idx - 128 : idx;
        o0 += pw[idx] * bf2f(p.rest[((size_t)b * TOK + tk0) * NREST + RC_BV + h * 64 + lane]);
        o1 += pw[idx + 1] * bf2f(p.rest[((size_t)b * TOK + tk0 + 1) * NREST + RC_BV + h * 64 + lane]);
    }
    p.ob[rowq * 256 + h * 64 + lane] = f2bf((o0 + o1) * inv);
}

__device__ void ph_mix(const P& p, LASP unsigned char* lds, int l, int bid, int nblk) {
    constexpr int NGDN = BATCH * 4 * 2;
    if (bid < NGDN) { gdn_scan_fast(p, lds, bid); return; }
    LASP float* sm = (LASP float*)lds;
    const int nGLA = BATCH;
    const int nq2 = ((l == 0) ? TOK : SEQ) / 2;
    const int total = nGLA + BATCH * nq2;
    for (int it = bid - NGDN; it < total; it += nblk - NGDN) {
        if (it < nGLA) gla_scan_naive(p, sm, l, it);
        else {
            const int i3 = it - nGLA; const int b = i3 / nq2, tq = (i3 % nq2) * 2;
            na_query_naive(p, sm, l, b, (l == 0) ? tq : tq + CTX);
        }
    }
}

__device__ void ph_gate(const P& p, int l, int bid, int nblk) {
    const int tid = mk_tid();
    const int tq = tid & 127, rsub = tid >> 7;
    for (int r = bid * 4 + rsub; r < ROWS; r += nblk * 4) {
        const bf16* pr = p.rest + (size_t)r * NREST;
        float o[8], z[8], res[8]; int oc;
        if (tq < 64) {
            const int cb = tq * 8;
            float a[8], bb[8];
            unpack8(*(const uint4*)(p.oa + (size_t)r * 512 + cb), a);
            unpack8(*(const uint4*)(p.oa + ((size_t)ROWS + r) * 512 + cb), bb);
            float ss = 0.f;
#pragma unroll
            for (int e = 0; e < 8; ++e) { o[e] = a[e] + bb[e]; ss += o[e] * o[e]; }
#pragma unroll
            for (int m = 8; m > 0; m >>= 1) ss += __shfl_xor(ss, m);
            const float rs = 1.f / sqrtf(ss * (1.f / 128.f) + 1e-6f);
            unpack8(*(const uint4*)(pr + RC_AZ + cb), z);
#pragma unroll
            for (int e = 0; e < 8; ++e) res[e] = o[e] * rs * p.gdn_norm[l * 128 + ((cb + e) & 127)] * silu_f(z[e]);
            oc = cb;
        } else if (tq < 96) {
            const int cb = (tq - 64) * 8;
            unpack8(*(const uint4*)(p.ob + (size_t)r * 256 + cb), o);
            unpack8(*(const uint4*)(pr + RC_BZ + cb), z);
#pragma unroll
            for (int e = 0; e < 8; ++e) res[e] = o[e] * silu_f(z[e]);
            oc = 512 + cb;
        } else {
            const int cb = (tq - 96) * 8;
            float a[8], bb[8];
            unpack8(*(const uint4*)(p.oc + (size_t)r * 256 + cb), a);
            unpack8(*(const uint4*)(p.oc + ((size_t)ROWS + r) * 256 + cb), bb);
            float ss = 0.f;
#pragma unroll
            for (int e = 0; e < 8; ++e) { o[e] = a[e] + bb[e]; ss += o[e] * o[e]; }
#pragma unroll
            for (int m = 4; m > 0; m >>= 1) ss += __shfl_xor(ss, m);
            const float rs = 1.f / sqrtf(ss * (1.f / 64.f) + 1e-6f);
            unpack8(*(const uint4*)(pr + RC_CZ + cb), z);
#pragma unroll
            for (int e = 0; e < 8; ++e) res[e] = o[e] * rs * p.gla_norm[l * 64 + ((cb + e) & 63)] * silu_f(z[e]);
            oc = 768 + cb;
        }
        uint4 w; w.x = pk2(res[0], res[1]); w.y = pk2(res[2], res[3]); w.z = pk2(res[4], res[5]); w.w = pk2(res[6], res[7]);
        *(uint4*)(p.mix + (size_t)r * D + oc) = w;
    }
}

constexpr int NSTEP = 1 + 2 * 7 + 1;
__global__ void __launch_bounds__(NTHREADS, 2) k_mega(P p) {
    extern __shared__ __attribute__((aligned(16))) unsigned char lds_raw[];
    LASP unsigned char* lds = (LASP unsigned char*)lds_raw;
    cg::grid_group grid = cg::this_grid();
    const int bid = blockIdx.x, nblk = gridDim.x;
#pragma unroll 1
    for (int step = 0; step < NSTEP; ++step) {
        int ph = 0, l = 0;
        if (step > 0) { const int s1 = step - 1; l = s1 / 7; ph = 1 + s1 % 7; }
        if (ph == 0) ph_prologue(p, lds, bid, nblk);
        else if (ph == 1) ph_lnpass(p, l, bid, nblk);
        else if (l < 2) {
            if (ph == 2) {
                pg8::Gemm g{p.ml, p.wi_t + (size_t)l * NPAD * D, ROWS, NPAD, D}; pg8::StaticOrder S; S.init(ROWS, NPAD, nblk, bid);
                EpiProj E{p.raw, p.rest};
                pg8::gemm_phase<EpiProj, pg8::StaticOrder, true, true>(lds, g, S, E);
            } else if (ph == 3) ph_conv(p, l, bid, nblk);
            else if (ph == 4) ph_gdnprep(p, lds, l, bid, nblk);
            else if (ph == 5) ph_mix(p, lds, l, bid, nblk);
            else if (ph == 6) ph_gate(p, l, bid, nblk);
            else {
                pg8::Gemm g{p.mix, p.wo_t + (size_t)l * D * D, ROWS, D, D}; pg8::StaticOrder S; S.init(ROWS, D, nblk, bid);
                EpiRes E{l == 0 ? p.x : p.out, p.ctx, p.out, p.xc1, p.mods, l};
                pg8::gemm_phase<EpiRes, pg8::StaticOrder, true, true>(lds, g, S, E);
            }
        }
        grid.sync();
    }
}

extern "C" void kernel_launch(void* const* d_in, const int* in_sizes, int n_in, void* d_out, int out_size, void* d_ws, size_t ws_size,
                              hipStream_t stream) {
    P p{};
    p.x = (const float*)d_in[0]; p.c = (const float*)d_in[1]; p.ctx = (const float*)d_in[2]; p.c_ctx = (const float*)d_in[3];
    p.w_mod = (const float*)d_in[4]; p.b_mod = (const float*)d_in[5]; p.w_in = (const float*)d_in[6]; p.conv_w = (const float*)d_in[7];
    p.a_log = (const float*)d_in[8]; p.dt_bias = (const float*)d_in[9]; p.gdn_norm = (const float*)d_in[10]; p.rpb = (const float*)d_in[11];
    p.gla_w2 = (const float*)d_in[12]; p.gla_b2 = (const float*)d_in[13]; p.gla_norm = (const float*)d_in[14]; p.w_out = (const float*)d_in[15];
    p.ln_g = (const float*)d_in[16]; p.ln_b = (const float*)d_in[17];
    p.out = (float*)d_out;
    unsigned char* w = (unsigned char*)d_ws;
    size_t off = 0;
    auto take = [&](size_t bytes) { unsigned char* r = w + off; off += (bytes + 255) & ~(size_t)255; return r; };
    p.mods = (float*)take((size_t)2 * 9 * 3072 * 4);
    p.xc1 = (float*)take((size_t)BATCH * CTX * D * 4);
    p.wi_t = (bf16*)take((size_t)2 * NPAD * D * 2);
    p.wo_t = (bf16*)take((size_t)2 * D * D * 2);
    p.rest = (bf16*)take((size_t)ROWS * NREST * 2);
    p.raw = (bf16*)take((size_t)ROWS * NRAW * 2);
    p.qkvn = (bf16*)take((size_t)ROWS * NRAW * 2);
    p.mix = p.qkvn;
    p.oa = (bf16*)take((size_t)2 * ROWS * 512 * 2);
    p.oc = (bf16*)take((size_t)2 * ROWS * 256 * 2);
    p.ml = p.oa;
    p.ob = (bf16*)take((size_t)ROWS * 256 * 2);
    static int grid_blocks = 0;
    if (!grid_blocks) {
        if (off > ws_size) { fprintf(stderr, "workspace too small: need %zu have %zu\n", off, ws_size); grid_blocks = -1; return; }
        int dev = 0, cus = 0, per_cu = 0;
        hipGetDevice(&dev);
        hipDeviceGetAttribute(&cus, hipDeviceAttributeMultiprocessorCount, dev);
        if (hipFuncSetAttribute((const void*)k_mega, hipFuncAttributeMaxDynamicSharedMemorySize, LDS_BYTES) != hipSuccess) { fprintf(stderr, "hipFuncSetAttribute failed\n"); grid_blocks = -1; return; }
        hipOccupancyMaxActiveBlocksPerMultiprocessor(&per_cu, (const void*)k_mega, NTHREADS, LDS_BYTES);
        if (per_cu < 1) { fprintf(stderr, "occupancy query says %d blocks per CU\n", per_cu); grid_blocks = -1; return; }
        grid_blocks = cus;
    }
    if (grid_blocks < 0) return;
    void* args[] = {&p};
    hipError_t e = hipLaunchCooperativeKernel((void*)k_mega, dim3(grid_blocks), dim3(NTHREADS), args, LDS_BYTES, stream);
    if (e != hipSuccess) fprintf(stderr, "cooperative launch failed: %s (grid %d)\n", hipGetErrorString(e), grid_blocks);
}
```

```cpp
#include <hip/hip_runtime.h>
#include <hip/hip_cooperative_groups.h>
#include <cstdio>
#include <cstdint>
namespace cg = cooperative_groups;

constexpr int D = 1024, BATCH = 8, SEQ = 4096, CTX = 256, TOK = 4352, NPROJ = 3888;
constexpr int ROWS = BATCH * TOK;
constexpr int NRAW = 1536, NREST = 2352, NPAD = 4096;
constexpr int NTHREADS = 512, NWAVES = 8;
constexpr int LDS_BYTES = 147456;
constexpr float ALPHA = 1.4142135623730951f;
constexpr int RC_AB = 0, RC_AZ = 16, RC_BQ = 528, RC_BK = 784, RC_BV = 1040, RC_BZ = 1296, RC_CQ = 1552, RC_CK = 1680, RC_CV = 1808, RC_CR = 2064, RC_CZ = 2096;

typedef unsigned short bf16;
typedef float f32x4_t __attribute__((ext_vector_type(4)));

struct P {
    const float *x, *c, *ctx, *c_ctx, *w_mod, *b_mod, *w_in, *conv_w, *a_log, *dt_bias, *gdn_norm, *rpb,
        *gla_w2, *gla_b2, *gla_norm, *w_out, *ln_g, *ln_b;
    float* out;
    float *mods, *xc1;
    bf16 *wi_t, *wo_t, *rest, *raw, *qkvn, *mix, *ml, *oa, *oc, *ob;
};

__device__ __forceinline__ float bf2f(unsigned short u) { return __uint_as_float((unsigned)u << 16); }
__device__ __forceinline__ unsigned short f2bf(float f) { unsigned u = __float_as_uint(f); return (unsigned short)((u + 0x7fffu + ((u >> 16) & 1u)) >> 16); }
__device__ __forceinline__ unsigned pk2(float lo, float hi) { return (unsigned)f2bf(lo) | ((unsigned)f2bf(hi) << 16); }
__device__ __forceinline__ float bflo(unsigned w) { return __uint_as_float(w << 16); }
__device__ __forceinline__ float bfhi(unsigned w) { return __uint_as_float(w & 0xffff0000u); }
__device__ __forceinline__ void unpack8(uint4 w, float* f) {
    f[0] = bflo(w.x); f[1] = bfhi(w.x); f[2] = bflo(w.y); f[3] = bfhi(w.y); f[4] = bflo(w.z); f[5] = bfhi(w.z); f[6] = bflo(w.w); f[7] = bfhi(w.w);
}
__device__ __forceinline__ float silu_f(float x) { return x / (1.f + expf(-x)); }
__device__ __forceinline__ float wave_sum(float v) {
#pragma unroll
    for (int o = 32; o > 0; o >>= 1) v += __shfl_xor(v, o);
    return v;
}
__device__ __forceinline__ float wave_max(float v) {
#pragma unroll
    for (int o = 32; o > 0; o >>= 1) v = fmaxf(v, __shfl_xor(v, o));
    return v;
}
__device__ __forceinline__ int mk_tid() { int t = threadIdx.x; asm volatile("" : "+v"(t)); return t; }
__device__ __forceinline__ int tok_of(int dir, int s) { return dir == 0 ? s : (s < CTX ? CTX - 1 - s : TOK + CTX - 1 - s); }

namespace pg8 {
#define PG8_LAS __attribute__((address_space(3)))
typedef unsigned short bf16_t;
typedef short bf16x8 __attribute__((ext_vector_type(8)));
typedef float f32x4 __attribute__((ext_vector_type(4)));
typedef unsigned u32x4 __attribute__((ext_vector_type(4)));
constexpr int BM = 256, BK = 64, HALF = 128, HTB = HALF * BK * 2  , STAGE_BYTES = 8 * HTB, NXCD = 8, WGM = 8;

__host__ __device__ __forceinline__ int lds_byte(int r, int c) { const int st = (r >> 4) * 2 + (c >> 5), rr = r & 15, cc = c & 31, ob = rr * 64 + cc * 2; return st * 1024 + (ob ^ (((ob >> 9) & 1) << 5)); }
__host__ __device__ __forceinline__ void stage_rc(int b, int& R, int& C) { const int st = b / 1024, sb = b % 1024, swz = sb ^ (((sb >> 9) & 1) << 5); R = (st >> 1) * 16 + swz / 64; C = (st & 1) * 32 + (swz % 64) / 2; }
__host__ __device__ __forceinline__ int perm32(int rho) { const int n = rho >> 4, i = rho & 15; return 8 * (i >> 2) + 4 * n + (i & 3); }

struct Unit { int pm, pn; };
struct Gemm { const bf16_t* A; const bf16_t* Bt; int M, N, K; };

struct StaticOrder {
    int nM, nN, nwg, G, c;
    __host__ __device__ void init(int M, int N, int G_, int c_) { nM = M / BM; nN = N / BM; nwg = nM * nN; G = G_; c = c_; }
    __host__ __device__ bool next(int i, Unit& u) const {
        const long L = (long)i * G + c; if (L >= nwg) return false;
        int wgid = (int)L; { const int q = nwg / NXCD, r = nwg % NXCD, xcd = wgid % NXCD, off = wgid / NXCD; wgid = (xcd < r ? xcd * (q + 1) : r * (q + 1) + (xcd - r) * q) + off; }
        const int nig = WGM * nN, gid = wgid / nig, fm = gid * WGM, gsz = (nM - fm) < WGM ? (nM - fm) : WGM;
        u.pm = fm + ((wgid % nig) % gsz); u.pn = (wgid % nig) / gsz; return true;
    }
    __device__ __forceinline__ void a_ready(const Unit&) const {}
    __device__ __forceinline__ void done(const Unit&) const {}
};

__device__ __forceinline__ unsigned cvt_pk_bf16(float lo, float hi) { unsigned r; asm volatile("v_cvt_pk_bf16_f32 %0, %1, %2" : "=v"(r) : "v"(lo), "v"(hi)); return r; }
template <class Epi, class Sched, bool ALIGN_EPI = false, bool SP2 = false>
__device__ __forceinline__ void gemm_phase(PG8_LAS unsigned char* lds, const Gemm g, const Sched& S, const Epi& E) {
    const int tid = mk_tid(), wid = __builtin_amdgcn_readfirstlane(tid >> 6), lane = tid & 63, wr = wid >> 2, wc = wid & 3, fr = lane & 15, fq = lane >> 4;
    const int K = g.K, nt = K / BK;
    unsigned voffA[2], voffB[2];
#pragma unroll
    for (int i = 0; i < 2; ++i) { int R, C; stage_rc(tid * 16 + i * 8192, R, C); const int Rb = Epi::PERM ? ((R & ~31) + perm32(R & 31)) : R;
        voffA[i] = (unsigned)(R * K + C) * 2u; voffB[i] = (unsigned)(Rb * K + C) * 2u; }
    const size_t kstep = (size_t)(BK * 2);
    const size_t hstep = (size_t)HALF * K * 2;
    const size_t tstep = 2 * hstep;
    const unsigned ldsw = (unsigned)wid * 1024u;
    const int aoff = lds_byte(wr * 64 + fr, fq * 8), boff = lds_byte(wc * 32 + fr, fq * 8);
#define PG8_SA(b, h) (((b) * 2 + (h)) * HTB)
#define PG8_SB(b, h) ((4 + (b) * 2 + (h)) * HTB)
#define PG8_STAGE(bufoff, gbase, voff) do { _Pragma("unroll") for (int _i = 0; _i < 2; ++_i) \
        __builtin_amdgcn_global_load_lds((const unsigned*)((const char*)(gbase) + (voff)[_i]), (PG8_LAS unsigned*)(lds + (bufoff) + ldsw + _i * 8192), 16, 0, 0); } while (0)
#define PG8_LDA(dst, b, h) do { _Pragma("unroll") for (int m = 0; m < 4; ++m) _Pragma("unroll") for (int k = 0; k < 2; ++k) dst[m][k] = *(const PG8_LAS bf16x8*)(lds + PG8_SA(b, h) + aoff + m * 2048 + k * 1024); } while (0)
#define PG8_LDB(dst, b, h) do { _Pragma("unroll") for (int n = 0; n < 2; ++n) _Pragma("unroll") for (int k = 0; k < 2; ++k) dst[n][k] = *(const PG8_LAS bf16x8*)(lds + PG8_SB(b, h) + boff + n * 2048 + k * 1024); } while (0)
#define PG8_MMA(ai, bj, At, Bt) do { __builtin_amdgcn_s_setprio(1); _Pragma("unroll") for (int m = 0; m < 4; ++m) _Pragma("unroll") for (int n = 0; n < 2; ++n) _Pragma("unroll") for (int k = 0; k < 2; ++k) \
        acc[ai][bj][m][n] = __builtin_amdgcn_mfma_f32_16x16x32_bf16(Bt[n][k], At[m][k], acc[ai][bj][m][n], 0, 0, 0); __builtin_amdgcn_s_setprio(0); } while (0)
#define PG8_WAIT_V(n) asm volatile("s_waitcnt vmcnt(" #n ")" ::: "memory")
#define PG8_WAIT_L(n) asm volatile("s_waitcnt lgkmcnt(" #n ")" ::: "memory")
#define PG8_BAR __builtin_amdgcn_s_barrier()
#define PG8_SCHED __builtin_amdgcn_sched_barrier(0)
    Unit cur, nxt; int ui = 0;
    if (!S.next(0, cur)) return;
    f32x4 acc[2][2][4][2];
#pragma unroll
    for (int a = 0; a < 2; ++a)
#pragma unroll
        for (int b = 0; b < 2; ++b)
#pragma unroll
            for (int m = 0; m < 4; ++m)
#pragma unroll
                for (int n = 0; n < 2; ++n) acc[a][b][m][n] = (f32x4){0.f, 0.f, 0.f, 0.f};
    bf16x8 At[4][2], B0[2][2], B1[2][2];
    const char* cA = (const char*)g.A + (size_t)cur.pm * tstep; const char* cB = (const char*)g.Bt + (size_t)cur.pn * tstep;
    S.a_ready(cur);
    if constexpr (SP2) {
        PG8_STAGE(PG8_SB(0, 0), cB, voffB); PG8_STAGE(PG8_SB(0, 1), cB + hstep, voffB); PG8_STAGE(PG8_SA(0, 0), cA, voffA); PG8_STAGE(PG8_SA(0, 1), cA + hstep, voffA);
        if (wr == 1) PG8_BAR;
        PG8_WAIT_V(2); PG8_BAR;
        PG8_STAGE(PG8_SB(1, 0), cB + kstep, voffB); PG8_STAGE(PG8_SA(1, 0), cA + kstep, voffA); PG8_STAGE(PG8_SB(1, 1), cB + hstep + kstep, voffB);
        PG8_WAIT_V(6); PG8_BAR;
    } else {
        PG8_STAGE(PG8_SB(0, 0), cB, voffB); PG8_STAGE(PG8_SA(0, 0), cA, voffA); PG8_STAGE(PG8_SB(0, 1), cB + hstep, voffB); PG8_STAGE(PG8_SA(0, 1), cA + hstep, voffA);
        if (wr == 1) PG8_BAR;
        PG8_WAIT_V(4); PG8_BAR;
        PG8_STAGE(PG8_SB(1, 0), cB + kstep, voffB); PG8_STAGE(PG8_SA(1, 0), cA + kstep, voffA); PG8_STAGE(PG8_SB(1, 1), cB + hstep + kstep, voffB);
        PG8_WAIT_V(6); PG8_BAR;
    }
    for (;;) {
        const bool has_next = S.next(ui + 1, nxt);
        const char* nA = has_next ? (const char*)g.A + (size_t)nxt.pm * tstep : cA; const char* nB = has_next ? (const char*)g.Bt + (size_t)nxt.pn * tstep : cB;
        for (int t = 0; t < nt; t += 2) {
            const bool last = (t == nt - 2);
            const char* a1 = cA + (size_t)(t + 1) * kstep;
            const char* a2 = last ? nA : cA + (size_t)(t + 2) * kstep; const char* b2 = last ? nB : cB + (size_t)(t + 2) * kstep;
            const char* a3 = a2 + kstep; const char* b3 = b2 + kstep;
            if (last && has_next) S.a_ready(nxt);
            if constexpr (SP2) {
            PG8_LDB(B0, 0, 0); PG8_LDB(B1, 0, 1); PG8_SCHED; PG8_LDA(At, 0, 0); PG8_STAGE(PG8_SA(1, 1), a1 + hstep, voffA);
            PG8_WAIT_V(8); PG8_WAIT_L(0); PG8_BAR; PG8_MMA(0, 0, At, B0); PG8_MMA(0, 1, At, B1); PG8_BAR; PG8_SCHED;
            PG8_LDA(At, 0, 1); PG8_STAGE(PG8_SB(0, 0), b2, voffB); PG8_STAGE(PG8_SB(0, 1), b2 + hstep, voffB); PG8_STAGE(PG8_SA(0, 0), a2, voffA);
            PG8_WAIT_V(8); PG8_WAIT_L(0); PG8_BAR; PG8_MMA(1, 0, At, B0); PG8_MMA(1, 1, At, B1); PG8_BAR; PG8_SCHED;
            PG8_LDB(B0, 1, 0); PG8_LDB(B1, 1, 1); PG8_SCHED; PG8_LDA(At, 1, 0); PG8_STAGE(PG8_SA(0, 1), a2 + hstep, voffA);
            PG8_WAIT_V(8); PG8_WAIT_L(0); PG8_BAR; PG8_MMA(0, 0, At, B0); PG8_MMA(0, 1, At, B1); PG8_BAR; PG8_SCHED;
            PG8_LDA(At, 1, 1); PG8_STAGE(PG8_SB(1, 0), b3, voffB); PG8_STAGE(PG8_SB(1, 1), b3 + hstep, voffB); PG8_STAGE(PG8_SA(1, 0), a3, voffA);
            PG8_WAIT_V(8); PG8_WAIT_L(0); PG8_BAR; PG8_MMA(1, 0, At, B0); PG8_MMA(1, 1, At, B1); PG8_BAR; PG8_SCHED;
            } else {
            PG8_LDB(B0, 0, 0); PG8_SCHED; PG8_LDA(At, 0, 0); PG8_STAGE(PG8_SA(1, 1), a1 + hstep, voffA);
            PG8_WAIT_L(8); PG8_BAR; PG8_WAIT_L(0); PG8_MMA(0, 0, At, B0); PG8_BAR; PG8_SCHED;
            PG8_LDB(B1, 0, 1); PG8_STAGE(PG8_SB(0, 0), b2, voffB);
            PG8_BAR; PG8_WAIT_L(0); PG8_MMA(0, 1, At, B1); PG8_BAR;
            PG8_LDA(At, 0, 1); PG8_STAGE(PG8_SA(0, 0), a2, voffA);
            PG8_BAR; PG8_WAIT_L(0); PG8_MMA(1, 0, At, B0); PG8_BAR; PG8_SCHED;
            PG8_STAGE(PG8_SB(0, 1), b2 + hstep, voffB);
            PG8_WAIT_V(6); PG8_BAR; PG8_MMA(1, 1, At, B1); PG8_BAR;
            PG8_LDB(B0, 1, 0); PG8_SCHED; PG8_LDA(At, 1, 0); PG8_STAGE(PG8_SA(0, 1), a2 + hstep, voffA);
            PG8_WAIT_L(8); PG8_BAR; PG8_WAIT_L(0); PG8_MMA(0, 0, At, B0); PG8_BAR; PG8_SCHED;
            PG8_LDB(B1, 1, 1); PG8_STAGE(PG8_SB(1, 0), b3, voffB);
            PG8_BAR; PG8_WAIT_L(0); PG8_MMA(0, 1, At, B1); PG8_BAR;
            PG8_LDA(At, 1, 1); PG8_STAGE(PG8_SA(1, 0), a3, voffA);
            PG8_BAR; PG8_WAIT_L(0); PG8_MMA(1, 0, At, B0); PG8_BAR; PG8_SCHED;
            PG8_STAGE(PG8_SB(1, 1), b3 + hstep, voffB);
            PG8_WAIT_V(6); PG8_BAR; PG8_MMA(1, 1, At, B1); PG8_BAR;
            }
        }
        if constexpr (ALIGN_EPI) { if (wr == 0) PG8_BAR; }
        if constexpr (!Epi::AFTER_DRAIN) { E(acc, cur, wr, wc, fr, fq); S.done(cur); }
        if (!has_next) break;
#pragma unroll
        for (int a = 0; a < 2; ++a)
#pragma unroll
            for (int b = 0; b < 2; ++b)
#pragma unroll
                for (int m = 0; m < 4; ++m)
#pragma unroll
                    for (int n = 0; n < 2; ++n) acc[a][b][m][n] = (f32x4){0.f, 0.f, 0.f, 0.f};
        cur = nxt; cA = nA; cB = nB; ++ui;
        if constexpr (ALIGN_EPI) { if (wr == 1) PG8_BAR; }
    }
    PG8_WAIT_V(0);
    if constexpr (!ALIGN_EPI) { if (wr == 0) PG8_BAR; }
    PG8_BAR;
    if constexpr (Epi::AFTER_DRAIN) { E.fused(acc, cur, wr, wc, fr, fq, lds, wid, lane); S.done(cur); }
#undef PG8_SA
#undef PG8_SB
#undef PG8_STAGE
#undef PG8_LDA
#undef PG8_LDB
#undef PG8_MMA
#undef PG8_WAIT_V
#undef PG8_WAIT_L
#undef PG8_BAR
#undef PG8_SCHED
}
}

#define LASP __attribute__((address_space(3)))

struct EpiProj {
    static constexpr bool PERM = true, AFTER_DRAIN = false;
    bf16* raw; bf16* rest;
    __device__ __forceinline__ void operator()(const pg8::f32x4 (&acc)[2][2][4][2], const pg8::Unit& u, int wr, int wc, int fr, int fq) const {
        const int row0 = u.pm * 256 + wr * 64 + fr;
        const int colb = u.pn * 256 + wc * 32 + 8 * fq;
#pragma unroll
        for (int bj = 0; bj < 2; ++bj) {
            const int col = colb + bj * 128;
            if (col >= NPROJ) continue;
            bf16* base; int ld;
            if (col < NRAW) { base = raw + col; ld = NRAW; } else { base = rest + (col - NRAW); ld = NREST; }
#pragma unroll
            for (int ai = 0; ai < 2; ++ai)
#pragma unroll
                for (int m = 0; m < 4; ++m) {
                    const pg8::f32x4 v0 = acc[ai][bj][m][0], v1 = acc[ai][bj][m][1];
                    pg8::u32x4 w; w.x = pg8::cvt_pk_bf16(v0[0], v0[1]); w.y = pg8::cvt_pk_bf16(v0[2], v0[3]); w.z = pg8::cvt_pk_bf16(v1[0], v1[1]); w.w = pg8::cvt_pk_bf16(v1[2], v1[3]);
                    *(pg8::u32x4*)(base + (size_t)(row0 + ai * 128 + m * 16) * ld) = w;
                }
        }
    }
};
struct EpiRes {
    static constexpr bool PERM = false, AFTER_DRAIN = false;
    const float* xl_src; const float* xc_src; float* out; float* xc1; const float* mods; int l;
    __device__ __forceinline__ void operator()(const pg8::f32x4 (&acc)[2][2][4][2], const pg8::Unit& u, int wr, int wc, int fr, int fq) const {
        const int row0 = u.pm * 256 + wr * 64 + fr, col0 = u.pn * 256 + wc * 32 + 4 * fq;
#pragma unroll
        for (int ai = 0; ai < 2; ++ai)
#pragma unroll
            for (int m = 0; m < 4; ++m) {
                const int r = row0 + ai * 128 + m * 16;
                const int b = r / TOK, t = r - b * TOK;
                const float* src; float* dst; int s;
                if (t < CTX) { if (l != 0) continue; src = xc_src + ((size_t)b * CTX + t) * D; dst = xc1 + ((size_t)b * CTX + t) * D; s = 8; }
                else { src = xl_src + ((size_t)b * SEQ + (t - CTX)) * D; dst = out + ((size_t)b * SEQ + (t - CTX)) * D; s = b; }
                const float* gt = mods + (size_t)(l * 9 + s) * 3072 + 2048;
#pragma unroll
                for (int bj = 0; bj < 2; ++bj)
#pragma unroll
                    for (int n = 0; n < 2; ++n) {
                        const int c = col0 + bj * 128 + n * 16;
                        const pg8::f32x4 xv = *(const pg8::f32x4*)(src + c), g = *(const pg8::f32x4*)(gt + c);
                        *(pg8::f32x4*)(dst + c) = xv * ALPHA + g * acc[ai][bj][m][n];
                    }
            }
    }
};

__device__ __forceinline__ void transpose_item(const float* W, int K, int N, bf16* WT, LASP float* scr, int item, int lane) {
    const int nblk = (N + 31) / 32, kb = item / nblk, nb = item % nblk, k0 = 64 * kb, n0 = 32 * nb;
    const bool nok = (n0 + (lane & 31)) < N;
#pragma unroll 8
    for (int i = 0; i < 32; ++i) { const int kk = 2 * i + (lane >> 5); scr[kk * 33 + (lane & 31)] = nok ? W[(size_t)(k0 + kk) * N + n0 + (lane & 31)] : 0.f; }
    asm volatile("s_waitcnt lgkmcnt(0)" ::: "memory");
    const int c = lane & 7;
#pragma unroll
    for (int j = 0; j < 4; ++j) {
        const int n = (lane >> 3) + 8 * j; const LASP float* s = scr + (8 * c) * 33 + n;
        uint4 o; o.x = pk2(s[0 * 33], s[1 * 33]); o.y = pk2(s[2 * 33], s[3 * 33]); o.z = pk2(s[4 * 33], s[5 * 33]); o.w = pk2(s[6 * 33], s[7 * 33]);
        *(uint4*)(WT + (size_t)(n0 + n) * K + k0 + 8 * c) = o;
    }
    asm volatile("s_waitcnt lgkmcnt(0)" ::: "memory");
}

__device__ void ph_prologue(const P& p, LASP unsigned char* lds, int bid, int nblk) {
    const int tid = mk_tid(), lane = tid & 63, wave = tid >> 6;
    LASP float* sm = (LASP float*)lds;
    if (bid * NTHREADS < 2 * 3072) {
        for (int i = tid; i < 9 * 1024; i += NTHREADS) {
            int s = i >> 10, d = i & 1023;
            float cv = s < 8 ? p.c[s * 1024 + d] : p.c_ctx[d];
            sm[i] = silu_f(cv);
        }
        __syncthreads();
        for (int o = bid * NTHREADS + tid; o < 2 * 3072; o += nblk * NTHREADS) {
            int l = o / 3072, j = o % 3072;
            const float* w = p.w_mod + (size_t)l * 1024 * 3072 + j;
            float acc[9];
#pragma unroll
            for (int s = 0; s < 9; ++s) acc[s] = 0.f;
            for (int i = 0; i < 1024; ++i) {
                float wv = w[(size_t)i * 3072];
#pragma unroll
                for (int s = 0; s < 9; ++s) acc[s] += sm[s * 1024 + i] * wv;
            }
            float bb = p.b_mod[l * 3072 + j];
#pragma unroll
            for (int s = 0; s < 9; ++s) p.mods[(size_t)(l * 9 + s) * 3072 + j] = acc[s] + bb;
        }
        __syncthreads();
    }
    LASP float* scr = (LASP float*)(lds + 40960 + wave * 8704);
    const int gw = (nblk - 1 - bid) * NWAVES + wave, NGW = nblk * NWAVES;
    constexpr int I_IN = 16 * 122, I_OUT = 16 * 32;
    for (int it = gw; it < 2 * (I_IN + I_OUT); it += NGW) {
        int l = it / (I_IN + I_OUT), r = it % (I_IN + I_OUT);
        if (r < I_IN) transpose_item(p.w_in + (size_t)l * D * NPROJ, D, NPROJ, p.wi_t + (size_t)l * NPAD * D, scr, r, lane);
        else transpose_item(p.w_out + (size_t)l * D * D, D, D, p.wo_t + (size_t)l * D * D, scr, r - I_IN, lane);
    }
    for (int i = bid * NTHREADS + tid; i < 2 * 192 * 128; i += nblk * NTHREADS) {
        int l = i / (192 * 128), r = i % (192 * 128);
        *(uint4*)(p.wi_t + (size_t)l * NPAD * D + (size_t)3904 * D + (size_t)r * 8) = make_uint4(0, 0, 0, 0);
    }
}

__device__ void ph_lnpass(const P& p, int mode, int bid, int nblk) {
    const int tid = mk_tid();
    const int lane = tid & 63, wave = tid >> 6;
    for (int r = bid * NWAVES + wave; r < ROWS; r += nblk * NWAVES) {
        const int b = r / TOK, t = r - b * TOK;
        const bool isc = t < CTX;
        if (mode == 2 && isc) continue;
        float* buf; const float* src; int s;
        if (isc) { buf = p.xc1 + ((size_t)b * CTX + t) * D; src = (mode == 0) ? p.ctx + ((size_t)b * CTX + t) * D : buf; s = 8; }
        else { buf = p.out + ((size_t)b * SEQ + (t - CTX)) * D; src = (mode == 0) ? p.x + ((size_t)b * SEQ + (t - CTX)) * D : buf; s = b; }
        f32x4_t v[4];
#pragma unroll
        for (int j = 0; j < 4; ++j) v[j] = *(const f32x4_t*)(src + 256 * j + 4 * lane);
        if (mode >= 1) {
            const int lp = mode - 1;
            float sum = 0.f;
#pragma unroll
            for (int j = 0; j < 4; ++j) sum += (v[j].x + v[j].y) + (v[j].z + v[j].w);
            const float mu = wave_sum(sum) * (1.f / 1024.f);
            float sq = 0.f;
#pragma unroll
            for (int j = 0; j < 4; ++j) { v[j] = v[j] - mu; sq += (v[j].x * v[j].x + v[j].y * v[j].y) + (v[j].z * v[j].z + v[j].w * v[j].w); }
            const float rs = 1.f / sqrtf(wave_sum(sq) * (1.f / 1024.f) + 1e-6f);
#pragma unroll
            for (int j = 0; j < 4; ++j) {
                const f32x4_t g = *(const f32x4_t*)(p.ln_g + lp * 1024 + 256 * j + 4 * lane), bb = *(const f32x4_t*)(p.ln_b + lp * 1024 + 256 * j + 4 * lane);
                v[j] = v[j] * rs * g + bb;
                *(f32x4_t*)(buf + 256 * j + 4 * lane) = v[j];
            }
            if (mode == 2) continue;
        }
        const int l = mode;
        float sum = 0.f;
#pragma unroll
        for (int j = 0; j < 4; ++j) sum += (v[j].x + v[j].y) + (v[j].z + v[j].w);
        const float mu = wave_sum(sum) * (1.f / 1024.f);
        float sq = 0.f;
#pragma unroll
        for (int j = 0; j < 4; ++j) { v[j] = v[j] - mu; sq += (v[j].x * v[j].x + v[j].y * v[j].y) + (v[j].z * v[j].z + v[j].w * v[j].w); }
        const float rs = 1.f / sqrtf(wave_sum(sq) * (1.f / 1024.f) + 1e-6f);
        const float* md = p.mods + (size_t)(l * 9 + s) * 3072;
#pragma unroll
        for (int j = 0; j < 4; ++j) {
            const f32x4_t sh = *(const f32x4_t*)(md + 256 * j + 4 * lane), sc = *(const f32x4_t*)(md + 1024 + 256 * j + 4 * lane);
            const f32x4_t o = v[j] * rs * (sc + 1.f) + sh;
            uint2 w; w.x = pk2(o.x, o.y); w.y = pk2(o.z, o.w);
            *(uint2*)(p.ml + (size_t)r * D + 256 * j + 4 * lane) = w;
        }
    }
}

__device__ void ph_conv(const P& p, int l, int bid, int nblk) {
    const int tid = mk_tid();
    const int lane = tid & 63, wave = tid >> 6;
    const float* cw = p.conv_w + (size_t)l * 5 * 1536;
    for (int it = bid * NWAVES + wave; it < ROWS * 12; it += nblk * NWAVES) {
        const int r = it / 12, g = it - r * 12;
        const int t = r % TOK;
        const int lo = t < CTX ? 0 : CTX, hi = t < CTX ? CTX : TOK;
        const int ch = g * 128 + lane * 2;
        float a0 = 0.f, a1 = 0.f;
#pragma unroll
        for (int j = 0; j < 5; ++j) {
            const int tt = t + j - 2;
            if (tt >= lo && tt < hi) {
                const unsigned w = *(const unsigned*)(p.raw + (size_t)(r + j - 2) * NRAW + ch);
                a0 += cw[j * 1536 + ch] * bflo(w); a1 += cw[j * 1536 + ch + 1] * bfhi(w);
            }
        }
        a0 = silu_f(a0); a1 = silu_f(a1);
        if (g < 8) {
            const float ss = wave_sum(a0 * a0 + a1 * a1);
            float sc = 1.f / sqrtf(ss + 1e-6f);
            if (g < 4) sc *= 0.08838834764831845f;
            a0 *= sc; a1 *= sc;
        }
        *(unsigned*)(p.qkvn + (size_t)r * NRAW + ch) = pk2(a0, a1);
    }
}


typedef short bf16x8_t __attribute__((ext_vector_type(8)));
typedef float f32x16_t __attribute__((ext_vector_type(16)));
typedef float f32x2_t __attribute__((ext_vector_type(2)));
typedef __bf16 bf16x2_t __attribute__((ext_vector_type(2)));
typedef unsigned u32x4_t __attribute__((ext_vector_type(4)));
#define MFMA32(a, b, c) __builtin_amdgcn_mfma_f32_32x32x16_bf16((a), (b), (c), 0, 0, 0)
__device__ __forceinline__ unsigned cvtpk(float lo, float hi) { f32x2_t v = {lo, hi}; bf16x2_t q = __builtin_convertvector(v, bf16x2_t); return __builtin_bit_cast(unsigned, q); }
__device__ __forceinline__ int crow(int reg, int h) { return (reg & 3) + 8 * (reg >> 2) + 4 * h; }
__device__ __forceinline__ int perm16(int a) { const int x = a & 15; return (a & ~15) + (x < 4 ? x : x < 8 ? x + 4 : x < 12 ? x - 4 : x); }
#define PACK8(x, s) __builtin_bit_cast(bf16x8_t, (u32x4_t){cvtpk((x)[8 * (s)], (x)[8 * (s) + 1]), cvtpk((x)[8 * (s) + 2], (x)[8 * (s) + 3]), cvtpk((x)[8 * (s) + 4], (x)[8 * (s) + 5]), cvtpk((x)[8 * (s) + 6], (x)[8 * (s) + 7])})
constexpr int GCH = 32, NCH = TOK / GCH;
constexpr int GP_ITEM = 4416;

__device__ void ph_gdnprep(const P& p, LASP unsigned char* lds, int l, int bid, int nblk, int tid) {
    const int lane = tid & 63, wave = tid >> 6, r = lane & 31, hh = lane >> 5;
    LASP float* Lm = (LASP float*)(lds + wave * 16384);
    LASP float* Xs = Lm + 2048;
    for (int it = bid * NWAVES + wave; it < BATCH * 4 * NCH; it += nblk * NWAVES) {
        const int c = it % NCH, bh = it / NCH, h = bh & 3, b = bh >> 2;
        const size_t row0 = (size_t)b * TOK + (size_t)c * GCH;
        f32x16_t KK, QK;
#pragma unroll
        for (int i = 0; i < 16; ++i) { KK[i] = 0.f; QK[i] = 0.f; }
        const bf16* kbase = p.qkvn + (row0 + r) * NRAW + 512 + h * 128 + 8 * hh;
        const bf16* qbase = p.qkvn + (row0 + r) * NRAW + h * 128 + 8 * hh;
#pragma unroll
        for (int s = 0; s < 8; ++s) {
            const bf16x8_t kf = *(const bf16x8_t*)(kbase + 16 * s), qf = *(const bf16x8_t*)(qbase + 16 * s);
            KK = MFMA32(kf, kf, KK);
            QK = MFMA32(qf, kf, QK);
        }
        float Gd, bd;
        {
            const bf16* ab = p.rest + (row0 + r) * NREST + RC_AB;
            const float a = bf2f(ab[hh * 4 + h]) + p.dt_bias[(l * 2 + hh) * 4 + h];
            const float sp = fmaxf(a, 0.f) + log1pf(expf(-fabsf(a)));
            Gd = -expf(p.a_log[(l * 2 + hh) * 4 + h]) * sp;
            bd = 1.f / (1.f + expf(-bf2f(ab[(2 + hh) * 4 + h])));
        }
#pragma unroll
        for (int off = 1; off < 32; off <<= 1) {
            const float up = __shfl_up(Gd, off, 32), dn = __shfl_down(Gd, off, 32);
            if (hh == 0) { if (r >= off) Gd += up; } else { if (r + off < 32) Gd += dn; }
        }
        unsigned char* gout = (unsigned char*)p.raw + ((size_t)(bh * 2) * NCH + c) * GP_ITEM;
        {
            const float Glast = __shfl(Gd, hh == 0 ? 31 : 32);
            float* sc = (float*)(gout + (size_t)hh * NCH * GP_ITEM + 4096);
            sc[r] = expf(Gd); sc[32 + r] = expf(Glast - Gd);
            if (r == 0) sc[64] = expf(Glast);
        }
        asm volatile("s_waitcnt lgkmcnt(0)" ::: "memory");
#pragma unroll
        for (int d = 0; d < 2; ++d) {
            const float Gcol = __shfl(Gd, d * 32 + r);
            bf16* qko = (bf16*)(gout + (size_t)d * NCH * GP_ITEM + 2048);
#pragma unroll
            for (int i = 0; i < 16; ++i) {
                const int n = crow(i, hh);
                const float Grow = __shfl(Gd, d * 32 + n), brow = __shfl(bd, d * 32 + n);
                const bool incl = d == 0 ? (r <= n) : (r >= n), strict = d == 0 ? (r < n) : (r > n);
                const float dec = expf(incl ? Grow - Gcol : 0.f);
                const float lv = strict ? brow * KK[i] * dec : 0.f;
                const float qv = incl ? QK[i] * dec : 0.f;
                const int n2 = d == 0 ? n : 31 - n, m2 = d == 0 ? r : 31 - r;
                Lm[(d * 32 + n2) * 32 + m2] = lv;
                qko[n * 32 + perm16(r)] = f2bf(qv);
                if ((i & 3) == 3) __builtin_amdgcn_sched_barrier(0);
            }
        }
        asm volatile("s_waitcnt lgkmcnt(0)" ::: "memory");
        {
            const LASP float* Lr = Lm + hh * 1024;
            LASP float* xc = Xs + lane;
#pragma unroll 4
            for (int j = 0; j < 32; ++j) xc[j * 64] = (j == r) ? 1.f : 0.f;
#pragma unroll 1
            for (int n = 1; n < 32; ++n) {
                float a0 = 0.f, a1 = 0.f;
#pragma unroll 1
                for (int j4 = 0; j4 < n; j4 += 4) {
                    const f32x4_t lv = *(const LASP f32x4_t*)(Lr + n * 32 + j4);
                    a0 += lv.x * xc[(j4 + 0) * 64]; a1 += lv.y * xc[(j4 + 1) * 64];
                    a0 += lv.z * xc[(j4 + 2) * 64]; a1 += lv.w * xc[(j4 + 3) * 64];
                }
                xc[n * 64] -= (a0 + a1);
            }
            const int mtok = hh == 0 ? r : 31 - r;
            const float bcol = __shfl(bd, hh * 32 + mtok);
            bf16* tq = (bf16*)(gout + (size_t)hh * NCH * GP_ITEM) + perm16(mtok) + (hh == 0 ? 0 : 31 * 32);
            const int tstep = hh == 0 ? 32 : -32;
#pragma unroll 4
            for (int n = 0; n < 32; ++n) { *tq = f2bf(xc[n * 64] * bcol); tq += tstep; }
        }
        asm volatile("s_waitcnt lgkmcnt(0)" ::: "memory");
    }
}


constexpr int ST_KA = 0, ST_QA = 8704, ST_KT = 17408, ST_V = 27648, ST_TP = 35840, ST_QK = 38400, ST_SC = 40960, ST_BYTES = 41344;
typedef unsigned u32x2_t __attribute__((ext_vector_type(2)));
struct GSlot { u32x4_t k0, k1, q0, q1, v0, v1, t; f32x4_t sc; };

__device__ __forceinline__ int gdn_chunk(int dir, int s) { return dir == 0 ? s : (s < 8 ? 7 - s : 143 - s); }
__device__ __forceinline__ void gdn_issue(const P& p, GSlot& g, int b, int h, int dir, int step, int tl) {
    const int c = gdn_chunk(dir, step);
    const size_t row0 = (size_t)b * TOK + (size_t)c * GCH;
    const int r0 = tl >> 4, c16 = tl & 15;
    const bf16* a0 = p.qkvn + (row0 + r0) * NRAW + h * 128 + 8 * c16;
    const bf16* a1 = a0 + (size_t)16 * NRAW;
    g.q0 = *(const u32x4_t*)a0; g.q1 = *(const u32x4_t*)a1;
    g.k0 = *(const u32x4_t*)(a0 + 512); g.k1 = *(const u32x4_t*)(a1 + 512);
    g.v0 = *(const u32x4_t*)(a0 + 1024); g.v1 = *(const u32x4_t*)(a1 + 1024);
    const unsigned char* gp = (const unsigned char*)p.raw + ((size_t)((b * 4 + h) * 2 + dir) * NCH + c) * GP_ITEM;
    g.t = *(const u32x4_t*)(gp + tl * 16);
    if (tl < 20) g.sc = *(const f32x4_t*)(gp + 4096 + tl * 16);
}
__device__ __forceinline__ void gdn_put_rows(LASP unsigned char* st, int row, int c16, u32x4_t kq, int off) {
    const int g = c16 >> 1, odd = c16 & 1;
    *(LASP u32x2_t*)(st + off + row * 272 + (16 * g + (odd ? 4 : 0)) * 2) = (u32x2_t){kq.x, kq.y};
    *(LASP u32x2_t*)(st + off + row * 272 + (16 * g + (odd ? 12 : 8)) * 2) = (u32x2_t){kq.z, kq.w};
}
__device__ __forceinline__ void gdn_put_kt(LASP unsigned char* st, int row, int c16, u32x4_t k) {
    LASP unsigned short* kt = (LASP unsigned short*)(st + ST_KT) + perm16(row);
    const int d0 = 8 * c16;
    kt[(d0 + 0) * 40] = (unsigned short)(k.x & 0xffffu); kt[(d0 + 1) * 40] = (unsigned short)(k.x >> 16);
    kt[(d0 + 2) * 40] = (unsigned short)(k.y & 0xffffu); kt[(d0 + 3) * 40] = (unsigned short)(k.y >> 16);
    kt[(d0 + 4) * 40] = (unsigned short)(k.z & 0xffffu); kt[(d0 + 5) * 40] = (unsigned short)(k.z >> 16);
    kt[(d0 + 6) * 40] = (unsigned short)(k.w & 0xffffu); kt[(d0 + 7) * 40] = (unsigned short)(k.w >> 16);
}
__device__ __forceinline__ void gdn_write(LASP unsigned char* st, const GSlot& g, int tl) {
    const int r0 = tl >> 4, c16 = tl & 15;
    gdn_put_rows(st, r0, c16, g.k0, ST_KA); gdn_put_rows(st, r0 + 16, c16, g.k1, ST_KA);
    gdn_put_rows(st, r0, c16, g.q0, ST_QA); gdn_put_rows(st, r0 + 16, c16, g.q1, ST_QA);
    gdn_put_kt(st, r0, c16, g.k0); gdn_put_kt(st, r0 + 16, c16, g.k1);
    *(LASP u32x4_t*)(st + ST_V + r0 * 256 + c16 * 16) = g.v0;
    *(LASP u32x4_t*)(st + ST_V + (r0 + 16) * 256 + c16 * 16) = g.v1;
    { const int t2 = tl & 127; *(LASP u32x4_t*)(st + (tl < 128 ? ST_TP : ST_QK) + (t2 >> 2) * 80 + (t2 & 3) * 16) = g.t; }
    if (tl < 20) *(LASP f32x4_t*)(st + ST_SC + tl * 16) = g.sc;
}

__device__ void gdn_scan_fast(const P& p, LASP unsigned char* lds, int chain) {
    const int tid = mk_tid();
    const int lane = tid & 63, wave = __builtin_amdgcn_readfirstlane(tid >> 6);
    const int dir = chain & 1, h = (chain >> 1) & 3, b = chain >> 3;
    constexpr int NS = NCH;
    if (wave >= 4) {
        const int tl = tid - 256;
        GSlot g0, g1, g2, g3;
        gdn_issue(p, g0, b, h, dir, 0, tl); gdn_issue(p, g1, b, h, dir, 1, tl); gdn_issue(p, g2, b, h, dir, 2, tl); gdn_issue(p, g3, b, h, dir, 3, tl);
        gdn_write(lds, g0, tl); gdn_issue(p, g0, b, h, dir, 4, tl);
        __syncthreads();
#pragma unroll 1
        for (int s = 0; s < NS; s += 4) {
            gdn_write(lds + ((s + 1) & 1) * ST_BYTES, g1, tl); if (s + 5 < NS) gdn_issue(p, g1, b, h, dir, s + 5, tl);
            __syncthreads();
            gdn_write(lds + ((s + 2) & 1) * ST_BYTES, g2, tl); if (s + 6 < NS) gdn_issue(p, g2, b, h, dir, s + 6, tl);
            __syncthreads();
            gdn_write(lds + ((s + 3) & 1) * ST_BYTES, g3, tl); if (s + 7 < NS) gdn_issue(p, g3, b, h, dir, s + 7, tl);
            __syncthreads();
            if (s + 4 < NS) { gdn_write(lds + ((s + 4) & 1) * ST_BYTES, g0, tl); if (s + 8 < NS) gdn_issue(p, g0, b, h, dir, s + 8, tl); }
            __syncthreads();
        }
    } else {
        const int r = lane & 31, hh = lane >> 5, w = wave;
        f32x16_t S0, S1, S2, S3;
#pragma unroll
        for (int i = 0; i < 16; ++i) { S0[i] = 0.f; S1[i] = 0.f; S2[i] = 0.f; S3[i] = 0.f; }
        __syncthreads();
#pragma unroll 1
        for (int s = 0; s < NS; ++s) {
            LASP unsigned char* st = lds + (s & 1) * ST_BYTES;
            const bf16x8_t Sb00 = PACK8(S0, 0), Sb01 = PACK8(S0, 1), Sb10 = PACK8(S1, 0), Sb11 = PACK8(S1, 1);
            const bf16x8_t Sb20 = PACK8(S2, 0), Sb21 = PACK8(S2, 1), Sb30 = PACK8(S3, 0), Sb31 = PACK8(S3, 1);
            f32x16_t ak, aq;
#pragma unroll
            for (int i = 0; i < 16; ++i) { ak[i] = 0.f; aq[i] = 0.f; }
            const LASP unsigned char* ka = st + ST_KA + r * 272 + hh * 16;
            const LASP unsigned char* qa = st + ST_QA + r * 272 + hh * 16;
#define GDN_KQ(ks, SB) { const bf16x8_t A = *(const LASP bf16x8_t*)(ka + (ks) * 32); ak = MFMA32(A, SB, ak); const bf16x8_t A2 = *(const LASP bf16x8_t*)(qa + (ks) * 32); aq = MFMA32(A2, SB, aq); }
            GDN_KQ(0, Sb00) GDN_KQ(1, Sb01) GDN_KQ(2, Sb10) GDN_KQ(3, Sb11) GDN_KQ(4, Sb20) GDN_KQ(5, Sb21) GDN_KQ(6, Sb30) GDN_KQ(7, Sb31)
#undef GDN_KQ
            const LASP float* sc = (const LASP float*)(st + ST_SC);
            float ev[16], fv[16];
#pragma unroll
            for (int g = 0; g < 4; ++g) {
                const f32x4_t e4 = *(const LASP f32x4_t*)(sc + 8 * g + 4 * hh), f4 = *(const LASP f32x4_t*)(sc + 32 + 8 * g + 4 * hh);
                ev[4 * g] = e4.x; ev[4 * g + 1] = e4.y; ev[4 * g + 2] = e4.z; ev[4 * g + 3] = e4.w;
                fv[4 * g] = f4.x; fv[4 * g + 1] = f4.y; fv[4 * g + 2] = f4.z; fv[4 * g + 3] = f4.w;
            }
            const float gl = sc[64];
            const LASP unsigned short* vl = (const LASP unsigned short*)(st + ST_V) + 32 * w + r;
            f32x16_t rr;
#pragma unroll
            for (int i = 0; i < 16; ++i) rr[i] = bf2f(vl[crow(i, hh) * 128]) - ev[i] * ak[i];
            const bf16x8_t rb0 = PACK8(rr, 0), rb1 = PACK8(rr, 1);
            f32x16_t vn;
#pragma unroll
            for (int i = 0; i < 16; ++i) vn[i] = 0.f;
            const LASP unsigned char* tp = st + ST_TP + r * 80 + hh * 16;
            vn = MFMA32(*(const LASP bf16x8_t*)(tp), rb0, vn);
            vn = MFMA32(*(const LASP bf16x8_t*)(tp + 32), rb1, vn);
#pragma unroll
            for (int i = 0; i < 16; ++i) aq[i] *= ev[i];
            const bf16x8_t vb0 = PACK8(vn, 0), vb1 = PACK8(vn, 1);
            const LASP unsigned char* qk = st + ST_QK + r * 80 + hh * 16;
            aq = MFMA32(*(const LASP bf16x8_t*)(qk), vb0, aq);
            aq = MFMA32(*(const LASP bf16x8_t*)(qk + 32), vb1, aq);
            {
                const int c = gdn_chunk(dir, s);
                bf16* op = p.oa + ((size_t)dir * ROWS + (size_t)b * TOK + (size_t)c * GCH) * 512 + h * 128 + 32 * w + r;
#pragma unroll
                for (int i = 0; i < 16; ++i) op[(size_t)crow(i, hh) * 512] = f2bf(aq[i]);
            }
            f32x16_t vf;
#pragma unroll
            for (int i = 0; i < 16; ++i) vf[i] = vn[i] * fv[i];
            const bf16x8_t fb0 = PACK8(vf, 0), fb1 = PACK8(vf, 1);
            const LASP unsigned char* kt = st + ST_KT + r * 80 + hh * 16;
#define GDN_UPD(SX, mt) { _Pragma("unroll") for (int i = 0; i < 16; ++i) SX[i] *= gl; SX = MFMA32(*(const LASP bf16x8_t*)(kt + (mt) * 32 * 80), fb0, SX); SX = MFMA32(*(const LASP bf16x8_t*)(kt + (mt) * 32 * 80 + 32), fb1, SX); }
            GDN_UPD(S0, 0) GDN_UPD(S1, 1) GDN_UPD(S2, 2) GDN_UPD(S3, 3)
#undef GDN_UPD
            __syncthreads();
        }
    }
}


constexpr int GL_ITEM = 6272;
constexpr size_t GLA_PREP_OFF = (size_t)BATCH * 4 * 2 * NCH * GP_ITEM;

__device__ __forceinline__ void gla_prep_item(const P& p, LASP unsigned char* wl, const LASP float* cstab, int l, int it, int lane) {
    const int r = lane & 31, hh = lane >> 5;
    const int c = it % NCH, bh = it / NCH, h = bh & 3, b = bh >> 2;
    const size_t row0 = (size_t)b * TOK + (size_t)c * GCH;
    float qv[16], kv[16];
    {
        const bf16* qb = p.rest + (row0 + 4 * hh) * NREST + RC_CQ + h * 32 + r;
#pragma unroll
        for (int i = 0; i < 16; ++i) { const int no = (i & 3) + 8 * (i >> 2); qv[i] = bf2f(qb[(size_t)no * NREST]); kv[i] = bf2f(qb[(size_t)no * NREST + 128]); }
    }
    if (c >= 8) {
        const int dd = r & 15, f = dd & 7;
        const int prow = (c - 8) >> 1, pcol0 = 32 * ((c - 8) & 1);
#pragma unroll
        for (int i = 0; i < 16; ++i) {
            const int n = crow(i, hh);
            const int pos = r < 16 ? prow : pcol0 + n;
            const float cs = cstab[(pos * 8 + f) * 2], sn = cstab[(pos * 8 + f) * 2 + 1];
            const float qp = __shfl_xor(qv[i], 8), kp = __shfl_xor(kv[i], 8);
            if (dd < 8) { qv[i] = qv[i] * cs - qp * sn; kv[i] = kv[i] * cs - kp * sn; }
            else { qv[i] = qp * sn + qv[i] * cs; kv[i] = kp * sn + kv[i] * cs; }
        }
    }
#pragma unroll
    for (int i = 0; i < 16; ++i) qv[i] *= 0.17677669529663687f;
#pragma unroll 1
    for (int dir = 0; dir < 2; ++dir) {
        f32x16_t X;
#pragma unroll
        for (int i = 0; i < 16; ++i) X[i] = 0.f;
        {
            const bf16x8_t A = *(const bf16x8_t*)(p.rest + (row0 + r) * NREST + RC_CR + dir * 16 + 8 * hh);
            const float* w2p = p.gla_w2 + ((size_t)(l * 2 + dir) * 16 + 8 * hh) * 128 + h * 32 + r;
            const bf16x8_t Bf = __builtin_bit_cast(bf16x8_t, (u32x4_t){cvtpk(w2p[0], w2p[128]), cvtpk(w2p[256], w2p[384]), cvtpk(w2p[512], w2p[640]), cvtpk(w2p[768], w2p[896])});
            X = MFMA32(A, Bf, X);
        }
        const float b2v = p.gla_b2[(l * 2 + dir) * 128 + h * 32 + r];
        float Bc[16];
#pragma unroll
        for (int i = 0; i < 16; ++i) { const float xg = X[i] + b2v; Bc[i] = (fminf(xg, 0.f) - log1pf(expf(-fabsf(xg)))) * (1.f / 16.f); }
        float tot;
        {
            float sg[4], ps[4];
#pragma unroll
            for (int g = 0; g < 4; ++g) { sg[g] = (Bc[4 * g] + Bc[4 * g + 1]) + (Bc[4 * g + 2] + Bc[4 * g + 3]); ps[g] = __shfl_xor(sg[g], 32); }
            tot = ((sg[0] + ps[0]) + (sg[1] + ps[1])) + ((sg[2] + ps[2]) + (sg[3] + ps[3]));
            if (dir == 0) {
                float base = 0.f;
#pragma unroll
                for (int g = 0; g < 4; ++g) {
                    float o = base + (hh ? ps[g] : 0.f);
#pragma unroll
                    for (int k = 0; k < 4; ++k) { o += Bc[4 * g + k]; Bc[4 * g + k] = o; }
                    base += sg[g] + ps[g];
                }
            } else {
                float base = 0.f;
#pragma unroll
                for (int g = 3; g >= 0; --g) {
                    float o = base + (hh ? 0.f : ps[g]);
#pragma unroll
                    for (int k = 3; k >= 0; --k) { o += Bc[4 * g + k]; Bc[4 * g + k] = o; }
                    base += sg[g] + ps[g];
                }
            }
        }
        unsigned char* gout = (unsigned char*)p.raw + GLA_PREP_OFF + ((size_t)(bh * 2 + dir) * NCH + c) * GL_ITEM;
        LASP bf16* ql = (LASP bf16*)wl;
        LASP bf16* kl = ql + 32 * 40;
        {
            bf16* qpo = (bf16*)gout + perm16(r);
            bf16* kdo = (bf16*)(gout + 4096) + r * 32 + 4 * hh;
#pragma unroll
            for (int g = 0; g < 4; ++g) {
                float kd[4];
#pragma unroll
                for (int k = 0; k < 4; ++k) {
                    const int i = 4 * g + k, n = crow(i, hh);
                    const float eb = expf(Bc[i]);
                    const float qs = qv[i] * eb, ks = kv[i] / eb;
                    kd[k] = kv[i] * expf(tot - Bc[i]);
                    const bf16 qsb = f2bf(qs);
                    qpo[n * 32] = qsb;
                    ql[n * 40 + r] = qsb; kl[n * 40 + r] = f2bf(ks);
                }
                *(u32x2_t*)(kdo + 8 * g) = (u32x2_t){cvtpk(kd[0], kd[1]), cvtpk(kd[2], kd[3])};
            }
            if (hh == 0) ((float*)(gout + 6144))[r] = expf(tot);
        }
        asm volatile("s_waitcnt lgkmcnt(0)" ::: "memory");
        f32x16_t AT;
#pragma unroll
        for (int i = 0; i < 16; ++i) AT[i] = 0.f;
        AT = MFMA32(*(const LASP bf16x8_t*)((const LASP unsigned char*)kl + r * 80 + hh * 16), *(const LASP bf16x8_t*)((const LASP unsigned char*)ql + r * 80 + hh * 16), AT);
        AT = MFMA32(*(const LASP bf16x8_t*)((const LASP unsigned char*)kl + r * 80 + hh * 16 + 32), *(const LASP bf16x8_t*)((const LASP unsigned char*)ql + r * 80 + hh * 16 + 32), AT);
        {
            bf16* amo = (bf16*)(gout + 2048) + r * 32 + 4 * hh;
#pragma unroll
            for (int g = 0; g < 4; ++g) {
                float a[4];
#pragma unroll
                for (int k = 0; k < 4; ++k) { const int m = crow(4 * g + k, hh); const bool keep = dir == 0 ? (m <= r) : (m >= r); a[k] = keep ? AT[4 * g + k] : 0.f; }
                *(u32x2_t*)(amo + 8 * g) = (u32x2_t){cvtpk(a[0], a[1]), cvtpk(a[2], a[3])};
            }
        }
        asm volatile("s_waitcnt lgkmcnt(0)" ::: "memory");
    }
}

constexpr int LS_QP = 0, LS_AM = 2560, LS_KD = 5120, LS_VT = 7680, LS_GL = 12800, LS_BYTES = 12928;
struct LSlot { u32x4_t a0, a1, a2, v0, v1; f32x4_t gl; };
__device__ __forceinline__ void gla_issue(const P& p, LSlot& g, int b, int h, int dir, int step, int t2) {
    const int c = gdn_chunk(dir, step);
    const unsigned char* gp = (const unsigned char*)p.raw + GLA_PREP_OFF + ((size_t)((b * 4 + h) * 2 + dir) * NCH + c) * GL_ITEM;
    g.a0 = *(const u32x4_t*)(gp + t2 * 16); g.a1 = *(const u32x4_t*)(gp + 2048 + t2 * 16); g.a2 = *(const u32x4_t*)(gp + 4096 + t2 * 16);
    if (t2 < 8) g.gl = *(const f32x4_t*)(gp + 6144 + t2 * 16);
    const size_t row0 = (size_t)b * TOK + (size_t)c * GCH;
    const bf16* vp = p.rest + (row0 + (t2 >> 3)) * NREST + RC_CV + h * 64 + 8 * (t2 & 7);
    g.v0 = *(const u32x4_t*)vp; g.v1 = *(const u32x4_t*)(vp + (size_t)16 * NREST);
}
__device__ __forceinline__ void gla_put_vt(LASP unsigned char* st, int m, int dv0, u32x4_t v) {
    LASP unsigned short* vt = (LASP unsigned short*)(st + LS_VT) + m;
    vt[(dv0 + 0) * 40] = (unsigned short)(v.x & 0xffffu); vt[(dv0 + 1) * 40] = (unsigned short)(v.x >> 16);
    vt[(dv0 + 2) * 40] = (unsigned short)(v.y & 0xffffu); vt[(dv0 + 3) * 40] = (unsigned short)(v.y >> 16);
    vt[(dv0 + 4) * 40] = (unsigned short)(v.z & 0xffffu); vt[(dv0 + 5) * 40] = (unsigned short)(v.z >> 16);
    vt[(dv0 + 6) * 40] = (unsigned short)(v.w & 0xffffu); vt[(dv0 + 7) * 40] = (unsigned short)(v.w >> 16);
}
__device__ __forceinline__ void gla_write(LASP unsigned char* st, const LSlot& g, int t2) {
    const int row = t2 >> 2, ch = t2 & 3;
    *(LASP u32x4_t*)(st + LS_QP + row * 80 + ch * 16) = g.a0;
    *(LASP u32x4_t*)(st + LS_AM + row * 80 + ch * 16) = g.a1;
    *(LASP u32x4_t*)(st + LS_KD + row * 80 + ch * 16) = g.a2;
    if (t2 < 8) *(LASP f32x4_t*)(st + LS_GL + t2 * 16) = g.gl;
    gla_put_vt(st, t2 >> 3, 8 * (t2 & 7), g.v0); gla_put_vt(st, 16 + (t2 >> 3), 8 * (t2 & 7), g.v1);
}
__device__ void gla_scan_fast(const P& p, LASP unsigned char* lds, int bh) {
    const int tid = mk_tid();
    const int lane = tid & 63, wave = __builtin_amdgcn_readfirstlane(tid >> 6);
    const int h = bh & 3, b = bh >> 2;
    constexpr int NS = NCH;
    if (wave >= 4) {
        const int dir = (wave - 4) >> 1, t2 = tid & 127;
        LASP unsigned char* base = lds + dir * 2 * LS_BYTES;
        LSlot g0, g1, g2, g3;
        gla_issue(p, g0, b, h, dir, 0, t2); gla_issue(p, g1, b, h, dir, 1, t2); gla_issue(p, g2, b, h, dir, 2, t2); gla_issue(p, g3, b, h, dir, 3, t2);
        gla_write(base, g0, t2); gla_issue(p, g0, b, h, dir, 4, t2);
        __syncthreads();
#pragma unroll 1
        for (int s = 0; s < NS; s += 4) {
            gla_write(base + ((s + 1) & 1) * LS_BYTES, g1, t2); if (s + 5 < NS) gla_issue(p, g1, b, h, dir, s + 5, t2);
            __syncthreads();
            gla_write(base + ((s + 2) & 1) * LS_BYTES, g2, t2); if (s + 6 < NS) gla_issue(p, g2, b, h, dir, s + 6, t2);
            __syncthreads();
            gla_write(base + ((s + 3) & 1) * LS_BYTES, g3, t2); if (s + 7 < NS) gla_issue(p, g3, b, h, dir, s + 7, t2);
            __syncthreads();
            if (s + 4 < NS) { gla_write(base + ((s + 4) & 1) * LS_BYTES, g0, t2); if (s + 8 < NS) gla_issue(p, g0, b, h, dir, s + 8, t2); }
            __syncthreads();
        }
    } else {
        const int r = lane & 31, hh = lane >> 5, dir = wave >> 1, blk = wave & 1;
        LASP unsigned char* base = lds + dir * 2 * LS_BYTES;
        f32x16_t S;
#pragma unroll
        for (int i = 0; i < 16; ++i) S[i] = 0.f;
        __syncthreads();
#pragma unroll 1
        for (int s = 0; s < NS; ++s) {
            const LASP unsigned char* st = base + (s & 1) * LS_BYTES;
            const bf16x8_t Sb0 = PACK8(S, 0), Sb1 = PACK8(S, 1);
            f32x16_t oT;
#pragma unroll
            for (int i = 0; i < 16; ++i) oT[i] = 0.f;
            const LASP unsigned char* qp = st + LS_QP + r * 80 + hh * 16;
            oT = MFMA32(Sb0, *(const LASP bf16x8_t*)(qp), oT);
            oT = MFMA32(Sb1, *(const LASP bf16x8_t*)(qp + 32), oT);
            const LASP unsigned char* vt = st + LS_VT + (32 * blk + r) * 80 + hh * 16;
            const LASP unsigned char* am = st + LS_AM + r * 80 + hh * 16;
            const bf16x8_t V0 = *(const LASP bf16x8_t*)(vt), V1 = *(const LASP bf16x8_t*)(vt + 32);
            oT = MFMA32(V0, *(const LASP bf16x8_t*)(am), oT);
            oT = MFMA32(V1, *(const LASP bf16x8_t*)(am + 32), oT);
            {
                const int c = gdn_chunk(dir, s);
                bf16* op = p.oc + ((size_t)dir * ROWS + (size_t)b * TOK + (size_t)c * GCH + r) * 256 + h * 64 + 32 * blk + 4 * hh;
#pragma unroll
                for (int g = 0; g < 4; ++g) *(u32x2_t*)(op + 8 * g) = (u32x2_t){cvtpk(oT[4 * g], oT[4 * g + 1]), cvtpk(oT[4 * g + 2], oT[4 * g + 3])};
            }
            const LASP float* glp = (const LASP float*)(st + LS_GL);
#pragma unroll
            for (int g = 0; g < 4; ++g) {
                const f32x4_t g4 = *(const LASP f32x4_t*)(glp + 8 * g + 4 * hh);
                S[4 * g] *= g4.x; S[4 * g + 1] *= g4.y; S[4 * g + 2] *= g4.z; S[4 * g + 3] *= g4.w;
            }
            const LASP unsigned char* kd = st + LS_KD + r * 80 + hh * 16;
            S = MFMA32(*(const LASP bf16x8_t*)(kd), V0, S);
            S = MFMA32(*(const LASP bf16x8_t*)(kd + 32), V1, S);
            __syncthreads();
        }
    }
}


__device__ void ph_prep(const P& p, LASP unsigned char* lds, int l, int bid, int nblk) {
    const int tid = mk_tid();
    LASP float* cstab = (LASP float*)(lds + 131072);
    {
        const int pos = tid >> 3, f = tid & 7;
        const float ang = (float)pos * powf(10000.f, -(float)f / 8.f);
        cstab[tid * 2] = cosf(ang); cstab[tid * 2 + 1] = sinf(ang);
    }
    __syncthreads();
    ph_gdnprep(p, lds, l, bid, nblk, tid);
    const int lane = tid & 63, wave = tid >> 6;
    for (int it = (nblk - 1 - bid) * NWAVES + wave; it < BATCH * 4 * NCH; it += nblk * NWAVES) gla_prep_item(p, lds + wave * 16384, cstab, l, it, lane);
}


__device__ void na_query_naive(const P& p, LASP float* sm, int l, int b, int t0) {
    const int tid = mk_tid();
    const int wave = tid >> 6, lane = tid & 63, h = wave & 3, t = t0 + (wave >> 2);
    LASP float* pw = sm + wave * 384;
    const size_t rowq = (size_t)b * TOK + t;
    float qv[64];
    {
        const bf16* qs = p.rest + rowq * NREST + RC_BQ + h * 64;
#pragma unroll
        for (int i = 0; i < 8; ++i) {
            float f[8]; unpack8(*(const uint4*)(qs + i * 8), f);
#pragma unroll
            for (int e = 0; e < 8; ++e) qv[i * 8 + e] = f[e] * 0.125f;
        }
    }
    const bool lat = t >= CTX;
    const int nk = lat ? 384 : 256;
    int r = 0, c = 0, r0 = 0, c0 = 0;
    if (lat) { int pi = t - CTX; r = pi >> 6; c = pi & 63; r0 = min(max(r - 4, 0), 56); c0 = min(max(c - 8, 0), 48); }
    float m = -1e30f;
    __syncthreads();
#pragma unroll 1
    for (int j = 0; j < 6; ++j) {
        const int idx = lane + 64 * j;
        float s = -1e30f;
        if (idx < nk) {
            int tk; float bias = 0.f;
            if (lat && idx < 128) {
                const int i = idx >> 4, kc = c0 + (idx & 15);
                tk = CTX + (r0 + i) * 64 + kc;
                bias = p.rpb[((size_t)(l * 4 + h) * 15 + (r0 + i - r + 7)) * 31 + (kc - c + 15)];
            } else tk = lat ? idx - 128 : idx;
            const bf16* ks = p.rest + ((size_t)b * TOK + tk) * NREST + RC_BK + h * 64;
            float d0 = 0.f, d1 = 0.f;
#pragma unroll
            for (int i = 0; i < 8; ++i) {
                float f[8]; unpack8(*(const uint4*)(ks + i * 8), f);
#pragma unroll
                for (int e = 0; e < 8; e += 2) { d0 += qv[i * 8 + e] * f[e]; d1 += qv[i * 8 + e + 1] * f[e + 1]; }
            }
            s = d0 + d1 + bias;
        }
        pw[idx] = s;
        m = fmaxf(m, s);
    }
    m = wave_max(m);
    float sum = 0.f;
#pragma unroll 1
    for (int j = 0; j < 6; ++j) { const float e = expf(pw[lane + 64 * j] - m); pw[lane + 64 * j] = e; sum += e; }
    sum = wave_sum(sum);
    const float inv = 1.f / sum;
    __syncthreads();
    float o0 = 0.f, o1 = 0.f;
    for (int idx = 0; idx < nk; idx += 2) {
        int tk0;
        if (lat && idx < 128) tk0 = CTX + (r0 + (idx >> 4)) * 64 + c0 + (idx & 15);
        else tk0 = lat ? idx - 128 : idx;
        o0 += pw[idx] * bf2f(p.rest[((size_t)b * TOK + tk0) * NREST + RC_BV + h * 64 + lane]);
        o1 += pw[idx + 1] * bf2f(p.rest[((size_t)b * TOK + tk0 + 1) * NREST + RC_BV + h * 64 + lane]);
    }
    p.ob[rowq * 256 + h * 64 + lane] = f2bf((o0 + o1) * inv);
}

__device__ void ph_mix(const P& p, LASP unsigned char* lds, int l, int bid, int nblk) {
    constexpr int NGDN = BATCH * 4 * 2;
    constexpr int NGLA = BATCH * 4;
    if (bid < NGDN) { gdn_scan_fast(p, lds, bid); return; }
    if (bid < NGDN + NGLA) { gla_scan_fast(p, lds, bid - NGDN); return; }
    LASP float* sm = (LASP float*)lds;
    const int nq2 = ((l == 0) ? TOK : SEQ) / 2;
    const int total = BATCH * nq2;
    for (int it = bid - NGDN - NGLA; it < total; it += nblk - NGDN - NGLA) {
        const int b = it / nq2, tq = (it % nq2) * 2;
        na_query_naive(p, sm, l, b, (l == 0) ? tq : tq + CTX);
    }
}

__device__ void ph_gate(const P& p, int l, int bid, int nblk) {
    const int tid = mk_tid();
    const int tq = tid & 127, rsub = tid >> 7;
    for (int r = bid * 4 + rsub; r < ROWS; r += nblk * 4) {
        const bf16* pr = p.rest + (size_t)r * NREST;
        float o[8], z[8], res[8]; int oc;
        if (tq < 64) {
            const int cb = tq * 8;
            float a[8], bb[8];
            unpack8(*(const uint4*)(p.oa + (size_t)r * 512 + cb), a);
            unpack8(*(const uint4*)(p.oa + ((size_t)ROWS + r) * 512 + cb), bb);
            float ss = 0.f;
#pragma unroll
            for (int e = 0; e < 8; ++e) { o[e] = a[e] + bb[e]; ss += o[e] * o[e]; }
#pragma unroll
            for (int m = 8; m > 0; m >>= 1) ss += __shfl_xor(ss, m);
            const float rs = 1.f / sqrtf(ss * (1.f / 128.f) + 1e-6f);
            unpack8(*(const uint4*)(pr + RC_AZ + cb), z);
#pragma unroll
            for (int e = 0; e < 8; ++e) res[e] = o[e] * rs * p.gdn_norm[l * 128 + ((cb + e) & 127)] * silu_f(z[e]);
            oc = cb;
        } else if (tq < 96) {
            const int cb = (tq - 64) * 8;
            unpack8(*(const uint4*)(p.ob + (size_t)r * 256 + cb), o);
            unpack8(*(const uint4*)(pr + RC_BZ + cb), z);
#pragma unroll
            for (int e = 0; e < 8; ++e) res[e] = o[e] * silu_f(z[e]);
            oc = 512 + cb;
        } else {
            const int cb = (tq - 96) * 8;
            float a[8], bb[8];
            unpack8(*(const uint4*)(p.oc + (size_t)r * 256 + cb), a);
            unpack8(*(const uint4*)(p.oc + ((size_t)ROWS + r) * 256 + cb), bb);
            float ss = 0.f;
#pragma unroll
            for (int e = 0; e < 8; ++e) { o[e] = a[e] + bb[e]; ss += o[e] * o[e]; }
#pragma unroll
            for (int m = 4; m > 0; m >>= 1) ss += __shfl_xor(ss, m);
            const float rs = 1.f / sqrtf(ss * (1.f / 64.f) + 1e-6f);
            unpack8(*(const uint4*)(pr + RC_CZ + cb), z);
#pragma unroll
            for (int e = 0; e < 8; ++e) res[e] = o[e] * rs * p.gla_norm[l * 64 + ((cb + e) & 63)] * silu_f(z[e]);
            oc = 768 + cb;
        }
        uint4 w; w.x = pk2(res[0], res[1]); w.y = pk2(res[2], res[3]); w.z = pk2(res[4], res[5]); w.w = pk2(res[6], res[7]);
        *(uint4*)(p.mix + (size_t)r * D + oc) = w;
    }
}

constexpr int NSTEP = 1 + 2 * 7 + 1;
__global__ void __launch_bounds__(NTHREADS, 2) k_mega(P p) {
    extern __shared__ __attribute__((aligned(16))) unsigned char lds_raw[];
    LASP unsigned char* lds = (LASP unsigned char*)lds_raw;
    cg::grid_group grid = cg::this_grid();
    const int bid = blockIdx.x, nblk = gridDim.x;
#pragma unroll 1
    for (int step = 0; step < NSTEP; ++step) {
        int ph = 0, l = 0;
        if (step > 0) { const int s1 = step - 1; l = s1 / 7; ph = 1 + s1 % 7; }
        if (ph == 0) ph_prologue(p, lds, bid, nblk);
        else if (ph == 1) ph_lnpass(p, l, bid, nblk);
        else if (l < 2) {
            if (ph == 2) {
                pg8::Gemm g{p.ml, p.wi_t + (size_t)l * NPAD * D, ROWS, NPAD, D}; pg8::StaticOrder S; S.init(ROWS, NPAD, nblk, bid);
                EpiProj E{p.raw, p.rest};
                pg8::gemm_phase<EpiProj, pg8::StaticOrder, true, true>(lds, g, S, E);
            } else if (ph == 3) ph_conv(p, l, bid, nblk);
            else if (ph == 4) ph_prep(p, lds, l, bid, nblk);
            else if (ph == 5) ph_mix(p, lds, l, bid, nblk);
            else if (ph == 6) ph_gate(p, l, bid, nblk);
            else {
                pg8::Gemm g{p.mix, p.wo_t + (size_t)l * D * D, ROWS, D, D}; pg8::StaticOrder S; S.init(ROWS, D, nblk, bid);
                EpiRes E{l == 0 ? p.x : p.out, p.ctx, p.out, p.xc1, p.mods, l};
                pg8::gemm_phase<EpiRes, pg8::StaticOrder, true, true>(lds, g, S, E);
            }
        }
        grid.sync();
    }
}

extern "C" void kernel_launch(void* const* d_in, const int* in_sizes, int n_in, void* d_out, int out_size, void* d_ws, size_t ws_size,
                              hipStream_t stream) {
    P p{};
    p.x = (const float*)d_in[0]; p.c = (const float*)d_in[1]; p.ctx = (const float*)d_in[2]; p.c_ctx = (const float*)d_in[3];
    p.w_mod = (const float*)d_in[4]; p.b_mod = (const float*)d_in[5]; p.w_in = (const float*)d_in[6]; p.conv_w = (const float*)d_in[7];
    p.a_log = (const float*)d_in[8]; p.dt_bias = (const float*)d_in[9]; p.gdn_norm = (const float*)d_in[10]; p.rpb = (const float*)d_in[11];
    p.gla_w2 = (const float*)d_in[12]; p.gla_b2 = (const float*)d_in[13]; p.gla_norm = (const float*)d_in[14]; p.w_out = (const float*)d_in[15];
    p.ln_g = (const float*)d_in[16]; p.ln_b = (const float*)d_in[17];
    p.out = (float*)d_out;
    unsigned char* w = (unsigned char*)d_ws;
    size_t off = 0;
    auto take = [&](size_t bytes) { unsigned char* r = w + off; off += (bytes + 255) & ~(size_t)255; return r; };
    p.mods = (float*)take((size_t)2 * 9 * 3072 * 4);
    p.xc1 = (float*)take((size_t)BATCH * CTX * D * 4);
    p.wi_t = (bf16*)take((size_t)2 * NPAD * D * 2);
    p.wo_t = (bf16*)take((size_t)2 * D * D * 2);
    p.rest = (bf16*)take((size_t)ROWS * NREST * 2);
    p.raw = (bf16*)take((size_t)ROWS * NRAW * 2);
    p.qkvn = (bf16*)take((size_t)ROWS * NRAW * 2);
    p.mix = p.qkvn;
    p.oa = (bf16*)take((size_t)2 * ROWS * 512 * 2);
    p.oc = (bf16*)take((size_t)2 * ROWS * 256 * 2);
    p.ml = p.oa;
    p.ob = (bf16*)take((size_t)ROWS * 256 * 2);
    static int grid_blocks = 0;
    if (!grid_blocks) {
        if (off > ws_size) { fprintf(stderr, "workspace too small: need %zu have %zu\n", off, ws_size); grid_blocks = -1; return; }
        int dev = 0, cus = 0, per_cu = 0;
        hipGetDevice(&dev);
        hipDeviceGetAttribute(&cus, hipDeviceAttributeMultiprocessorCount, dev);
        if (hipFuncSetAttribute((const void*)k_mega, hipFuncAttributeMaxDynamicSharedMemorySize, LDS_BYTES) != hipSuccess) { fprintf(stderr, "hipFuncSetAttribute failed\n"); grid_blocks = -1; return; }
        hipOccupancyMaxActiveBlocksPerMultiprocessor(&per_cu, (const void*)k_mega, NTHREADS, LDS_BYTES);
        if (per_cu < 1) { fprintf(stderr, "occupancy query says %d blocks per CU\n", per_cu); grid_blocks = -1; return; }
        grid_blocks = cus;
    }
    if (grid_blocks < 0) return;
    void* args[] = {&p};
    hipError_t e = hipLaunchCooperativeKernel((void*)k_mega, dim3(grid_blocks), dim3(NTHREADS), args, LDS_BYTES, stream);
    if (e != hipSuccess) fprintf(stderr, "cooperative launch failed: %s (grid %d)\n", hipGetErrorString(e), grid_blocks);
}
```

```cpp
#include <hip/hip_runtime.h>
#include <hip/hip_cooperative_groups.h>
#include <cstdio>
#include <cstdint>
namespace cg = cooperative_groups;

constexpr int D = 1024, BATCH = 8, SEQ = 4096, CTX = 256, TOK = 4352, NPROJ = 3888;
constexpr int ROWS = BATCH * TOK;
constexpr int NRAW = 1536, NREST = 2352, NPAD = 4096;
constexpr int NTHREADS = 512, NWAVES = 8;
constexpr int LDS_BYTES = 147456;
constexpr float ALPHA = 1.4142135623730951f;
constexpr int RC_AB = 0, RC_AZ = 16, RC_BQ = 528, RC_BK = 784, RC_BV = 1040, RC_BZ = 1296, RC_CQ = 1552, RC_CK = 1680, RC_CV = 1808, RC_CR = 2064, RC_CZ = 2096;

typedef unsigned short bf16;
typedef float f32x4_t __attribute__((ext_vector_type(4)));

struct P {
    const float *x, *c, *ctx, *c_ctx, *w_mod, *b_mod, *w_in, *conv_w, *a_log, *dt_bias, *gdn_norm, *rpb,
        *gla_w2, *gla_b2, *gla_norm, *w_out, *ln_g, *ln_b;
    float* out;
    float *mods, *xc1;
    bf16 *wi_t, *wo_t, *rest, *raw, *qkvn, *mix, *ml, *oa, *oc, *vtb;
};

__device__ __forceinline__ float bf2f(unsigned short u) { return __uint_as_float((unsigned)u << 16); }
__device__ __forceinline__ unsigned short f2bf(float f) { unsigned u = __float_as_uint(f); return (unsigned short)((u + 0x7fffu + ((u >> 16) & 1u)) >> 16); }
__device__ __forceinline__ unsigned pk2(float lo, float hi) { return (unsigned)f2bf(lo) | ((unsigned)f2bf(hi) << 16); }
__device__ __forceinline__ float bflo(unsigned w) { return __uint_as_float(w << 16); }
__device__ __forceinline__ float bfhi(unsigned w) { return __uint_as_float(w & 0xffff0000u); }
__device__ __forceinline__ void unpack8(uint4 w, float* f) {
    f[0] = bflo(w.x); f[1] = bfhi(w.x); f[2] = bflo(w.y); f[3] = bfhi(w.y); f[4] = bflo(w.z); f[5] = bfhi(w.z); f[6] = bflo(w.w); f[7] = bfhi(w.w);
}
__device__ __forceinline__ float silu_f(float x) { return x / (1.f + expf(-x)); }
__device__ __forceinline__ float wave_sum(float v) {
#pragma unroll
    for (int o = 32; o > 0; o >>= 1) v += __shfl_xor(v, o);
    return v;
}
__device__ __forceinline__ float wave_max(float v) {
#pragma unroll
    for (int o = 32; o > 0; o >>= 1) v = fmaxf(v, __shfl_xor(v, o));
    return v;
}
__device__ __forceinline__ int mk_tid() { int t = threadIdx.x; asm volatile("" : "+v"(t)); return t; }
__device__ __forceinline__ int tok_of(int dir, int s) { return dir == 0 ? s : (s < CTX ? CTX - 1 - s : TOK + CTX - 1 - s); }

namespace pg8 {
#define PG8_LAS __attribute__((address_space(3)))
typedef unsigned short bf16_t;
typedef short bf16x8 __attribute__((ext_vector_type(8)));
typedef float f32x4 __attribute__((ext_vector_type(4)));
typedef unsigned u32x4 __attribute__((ext_vector_type(4)));
constexpr int BM = 256, BK = 64, HALF = 128, HTB = HALF * BK * 2  , STAGE_BYTES = 8 * HTB, NXCD = 8, WGM = 8;

__host__ __device__ __forceinline__ int lds_byte(int r, int c) { const int st = (r >> 4) * 2 + (c >> 5), rr = r & 15, cc = c & 31, ob = rr * 64 + cc * 2; return st * 1024 + (ob ^ (((ob >> 9) & 1) << 5)); }
__host__ __device__ __forceinline__ void stage_rc(int b, int& R, int& C) { const int st = b / 1024, sb = b % 1024, swz = sb ^ (((sb >> 9) & 1) << 5); R = (st >> 1) * 16 + swz / 64; C = (st & 1) * 32 + (swz % 64) / 2; }
__host__ __device__ __forceinline__ int perm32(int rho) { const int n = rho >> 4, i = rho & 15; return 8 * (i >> 2) + 4 * n + (i & 3); }

struct Unit { int pm, pn; };
struct Gemm { const bf16_t* A; const bf16_t* Bt; int M, N, K; };

struct StaticOrder {
    int nM, nN, nwg, G, c;
    __host__ __device__ void init(int M, int N, int G_, int c_) { nM = M / BM; nN = N / BM; nwg = nM * nN; G = G_; c = c_; }
    __host__ __device__ bool next(int i, Unit& u) const {
        const long L = (long)i * G + c; if (L >= nwg) return false;
        int wgid = (int)L; { const int q = nwg / NXCD, r = nwg % NXCD, xcd = wgid % NXCD, off = wgid / NXCD; wgid = (xcd < r ? xcd * (q + 1) : r * (q + 1) + (xcd - r) * q) + off; }
        const int nig = WGM * nN, gid = wgid / nig, fm = gid * WGM, gsz = (nM - fm) < WGM ? (nM - fm) : WGM;
        u.pm = fm + ((wgid % nig) % gsz); u.pn = (wgid % nig) / gsz; return true;
    }
    __device__ __forceinline__ void a_ready(const Unit&) const {}
    __device__ __forceinline__ void done(const Unit&) const {}
};

__device__ __forceinline__ unsigned cvt_pk_bf16(float lo, float hi) { unsigned r; asm volatile("v_cvt_pk_bf16_f32 %0, %1, %2" : "=v"(r) : "v"(lo), "v"(hi)); return r; }
template <class Epi, class Sched, bool ALIGN_EPI = false, bool SP2 = false>
__device__ __forceinline__ void gemm_phase(PG8_LAS unsigned char* lds, const Gemm g, const Sched& S, const Epi& E) {
    const int tid = mk_tid(), wid = __builtin_amdgcn_readfirstlane(tid >> 6), lane = tid & 63, wr = wid >> 2, wc = wid & 3, fr = lane & 15, fq = lane >> 4;
    const int K = g.K, nt = K / BK;
    unsigned voffA[2], voffB[2];
#pragma unroll
    for (int i = 0; i < 2; ++i) { int R, C; stage_rc(tid * 16 + i * 8192, R, C); const int Rb = Epi::PERM ? ((R & ~31) + perm32(R & 31)) : R;
        voffA[i] = (unsigned)(R * K + C) * 2u; voffB[i] = (unsigned)(Rb * K + C) * 2u; }
    const size_t kstep = (size_t)(BK * 2);
    const size_t hstep = (size_t)HALF * K * 2;
    const size_t tstep = 2 * hstep;
    const unsigned ldsw = (unsigned)wid * 1024u;
    const int aoff = lds_byte(wr * 64 + fr, fq * 8), boff = lds_byte(wc * 32 + fr, fq * 8);
#define PG8_SA(b, h) (((b) * 2 + (h)) * HTB)
#define PG8_SB(b, h) ((4 + (b) * 2 + (h)) * HTB)
#define PG8_STAGE(bufoff, gbase, voff) do { _Pragma("unroll") for (int _i = 0; _i < 2; ++_i) \
        __builtin_amdgcn_global_load_lds((const unsigned*)((const char*)(gbase) + (voff)[_i]), (PG8_LAS unsigned*)(lds + (bufoff) + ldsw + _i * 8192), 16, 0, 0); } while (0)
#define PG8_LDA(dst, b, h) do { _Pragma("unroll") for (int m = 0; m < 4; ++m) _Pragma("unroll") for (int k = 0; k < 2; ++k) dst[m][k] = *(const PG8_LAS bf16x8*)(lds + PG8_SA(b, h) + aoff + m * 2048 + k * 1024); } while (0)
#define PG8_LDB(dst, b, h) do { _Pragma("unroll") for (int n = 0; n < 2; ++n) _Pragma("unroll") for (int k = 0; k < 2; ++k) dst[n][k] = *(const PG8_LAS bf16x8*)(lds + PG8_SB(b, h) + boff + n * 2048 + k * 1024); } while (0)
#define PG8_MMA(ai, bj, At, Bt) do { __builtin_amdgcn_s_setprio(1); _Pragma("unroll") for (int m = 0; m < 4; ++m) _Pragma("unroll") for (int n = 0; n < 2; ++n) _Pragma("unroll") for (int k = 0; k < 2; ++k) \
        acc[ai][bj][m][n] = __builtin_amdgcn_mfma_f32_16x16x32_bf16(Bt[n][k], At[m][k], acc[ai][bj][m][n], 0, 0, 0); __builtin_amdgcn_s_setprio(0); } while (0)
#define PG8_WAIT_V(n) asm volatile("s_waitcnt vmcnt(" #n ")" ::: "memory")
#define PG8_WAIT_L(n) asm volatile("s_waitcnt lgkmcnt(" #n ")" ::: "memory")
#define PG8_BAR __builtin_amdgcn_s_barrier()
#define PG8_SCHED __builtin_amdgcn_sched_barrier(0)
    Unit cur, nxt; int ui = 0;
    if (!S.next(0, cur)) return;
    f32x4 acc[2][2][4][2];
#pragma unroll
    for (int a = 0; a < 2; ++a)
#pragma unroll
        for (int b = 0; b < 2; ++b)
#pragma unroll
            for (int m = 0; m < 4; ++m)
#pragma unroll
                for (int n = 0; n < 2; ++n) acc[a][b][m][n] = (f32x4){0.f, 0.f, 0.f, 0.f};
    bf16x8 At[4][2], B0[2][2], B1[2][2];
    const char* cA = (const char*)g.A + (size_t)cur.pm * tstep; const char* cB = (const char*)g.Bt + (size_t)cur.pn * tstep;
    S.a_ready(cur);
    if constexpr (SP2) {
        PG8_STAGE(PG8_SB(0, 0), cB, voffB); PG8_STAGE(PG8_SB(0, 1), cB + hstep, voffB); PG8_STAGE(PG8_SA(0, 0), cA, voffA); PG8_STAGE(PG8_SA(0, 1), cA + hstep, voffA);
        if (wr == 1) PG8_BAR;
        PG8_WAIT_V(2); PG8_BAR;
        PG8_STAGE(PG8_SB(1, 0), cB + kstep, voffB); PG8_STAGE(PG8_SA(1, 0), cA + kstep, voffA); PG8_STAGE(PG8_SB(1, 1), cB + hstep + kstep, voffB);
        PG8_WAIT_V(6); PG8_BAR;
    } else {
        PG8_STAGE(PG8_SB(0, 0), cB, voffB); PG8_STAGE(PG8_SA(0, 0), cA, voffA); PG8_STAGE(PG8_SB(0, 1), cB + hstep, voffB); PG8_STAGE(PG8_SA(0, 1), cA + hstep, voffA);
        if (wr == 1) PG8_BAR;
        PG8_WAIT_V(4); PG8_BAR;
        PG8_STAGE(PG8_SB(1, 0), cB + kstep, voffB); PG8_STAGE(PG8_SA(1, 0), cA + kstep, voffA); PG8_STAGE(PG8_SB(1, 1), cB + hstep + kstep, voffB);
        PG8_WAIT_V(6); PG8_BAR;
    }
    for (;;) {
        const bool has_next = S.next(ui + 1, nxt);
        const char* nA = has_next ? (const char*)g.A + (size_t)nxt.pm * tstep : cA; const char* nB = has_next ? (const char*)g.Bt + (size_t)nxt.pn * tstep : cB;
        for (int t = 0; t < nt; t += 2) {
            const bool last = (t == nt - 2);
            const char* a1 = cA + (size_t)(t + 1) * kstep;
            const char* a2 = last ? nA : cA + (size_t)(t + 2) * kstep; const char* b2 = last ? nB : cB + (size_t)(t + 2) * kstep;
            const char* a3 = a2 + kstep; const char* b3 = b2 + kstep;
            if (last && has_next) S.a_ready(nxt);
            if constexpr (SP2) {
            PG8_LDB(B0, 0, 0); PG8_LDB(B1, 0, 1); PG8_SCHED; PG8_LDA(At, 0, 0); PG8_STAGE(PG8_SA(1, 1), a1 + hstep, voffA);
            PG8_WAIT_V(8); PG8_WAIT_L(0); PG8_BAR; PG8_MMA(0, 0, At, B0); PG8_MMA(0, 1, At, B1); PG8_BAR; PG8_SCHED;
            PG8_LDA(At, 0, 1); PG8_STAGE(PG8_SB(0, 0), b2, voffB); PG8_STAGE(PG8_SB(0, 1), b2 + hstep, voffB); PG8_STAGE(PG8_SA(0, 0), a2, voffA);
            PG8_WAIT_V(8); PG8_WAIT_L(0); PG8_BAR; PG8_MMA(1, 0, At, B0); PG8_MMA(1, 1, At, B1); PG8_BAR; PG8_SCHED;
            PG8_LDB(B0, 1, 0); PG8_LDB(B1, 1, 1); PG8_SCHED; PG8_LDA(At, 1, 0); PG8_STAGE(PG8_SA(0, 1), a2 + hstep, voffA);
            PG8_WAIT_V(8); PG8_WAIT_L(0); PG8_BAR; PG8_MMA(0, 0, At, B0); PG8_MMA(0, 1, At, B1); PG8_BAR; PG8_SCHED;
            PG8_LDA(At, 1, 1); PG8_STAGE(PG8_SB(1, 0), b3, voffB); PG8_STAGE(PG8_SB(1, 1), b3 + hstep, voffB); PG8_STAGE(PG8_SA(1, 0), a3, voffA);
            PG8_WAIT_V(8); PG8_WAIT_L(0); PG8_BAR; PG8_MMA(1, 0, At, B0); PG8_MMA(1, 1, At, B1); PG8_BAR; PG8_SCHED;
            } else {
            PG8_LDB(B0, 0, 0); PG8_SCHED; PG8_LDA(At, 0, 0); PG8_STAGE(PG8_SA(1, 1), a1 + hstep, voffA);
            PG8_WAIT_L(8); PG8_BAR; PG8_WAIT_L(0); PG8_MMA(0, 0, At, B0); PG8_BAR; PG8_SCHED;
            PG8_LDB(B1, 0, 1); PG8_STAGE(PG8_SB(0, 0), b2, voffB);
            PG8_BAR; PG8_WAIT_L(0); PG8_MMA(0, 1, At, B1); PG8_BAR;
            PG8_LDA(At, 0, 1); PG8_STAGE(PG8_SA(0, 0), a2, voffA);
            PG8_BAR; PG8_WAIT_L(0); PG8_MMA(1, 0, At, B0); PG8_BAR; PG8_SCHED;
            PG8_STAGE(PG8_SB(0, 1), b2 + hstep, voffB);
            PG8_WAIT_V(6); PG8_BAR; PG8_MMA(1, 1, At, B1); PG8_BAR;
            PG8_LDB(B0, 1, 0); PG8_SCHED; PG8_LDA(At, 1, 0); PG8_STAGE(PG8_SA(0, 1), a2 + hstep, voffA);
            PG8_WAIT_L(8); PG8_BAR; PG8_WAIT_L(0); PG8_MMA(0, 0, At, B0); PG8_BAR; PG8_SCHED;
            PG8_LDB(B1, 1, 1); PG8_STAGE(PG8_SB(1, 0), b3, voffB);
            PG8_BAR; PG8_WAIT_L(0); PG8_MMA(0, 1, At, B1); PG8_BAR;
            PG8_LDA(At, 1, 1); PG8_STAGE(PG8_SA(1, 0), a3, voffA);
            PG8_BAR; PG8_WAIT_L(0); PG8_MMA(1, 0, At, B0); PG8_BAR; PG8_SCHED;
            PG8_STAGE(PG8_SB(1, 1), b3 + hstep, voffB);
            PG8_WAIT_V(6); PG8_BAR; PG8_MMA(1, 1, At, B1); PG8_BAR;
            }
        }
        if constexpr (ALIGN_EPI) { if (wr == 0) PG8_BAR; }
        if constexpr (!Epi::AFTER_DRAIN) { E(acc, cur, wr, wc, fr, fq); S.done(cur); }
        if (!has_next) break;
#pragma unroll
        for (int a = 0; a < 2; ++a)
#pragma unroll
            for (int b = 0; b < 2; ++b)
#pragma unroll
                for (int m = 0; m < 4; ++m)
#pragma unroll
                    for (int n = 0; n < 2; ++n) acc[a][b][m][n] = (f32x4){0.f, 0.f, 0.f, 0.f};
        cur = nxt; cA = nA; cB = nB; ++ui;
        if constexpr (ALIGN_EPI) { if (wr == 1) PG8_BAR; }
    }
    PG8_WAIT_V(0);
    if constexpr (!ALIGN_EPI) { if (wr == 0) PG8_BAR; }
    PG8_BAR;
    if constexpr (Epi::AFTER_DRAIN) { E.fused(acc, cur, wr, wc, fr, fq, lds, wid, lane); S.done(cur); }
#undef PG8_SA
#undef PG8_SB
#undef PG8_STAGE
#undef PG8_LDA
#undef PG8_LDB
#undef PG8_MMA
#undef PG8_WAIT_V
#undef PG8_WAIT_L
#undef PG8_BAR
#undef PG8_SCHED
}
}

#define LASP __attribute__((address_space(3)))

struct EpiProj {
    static constexpr bool PERM = true, AFTER_DRAIN = false;
    bf16* raw; bf16* rest;
    __device__ __forceinline__ void operator()(const pg8::f32x4 (&acc)[2][2][4][2], const pg8::Unit& u, int wr, int wc, int fr, int fq) const {
        const int row0 = u.pm * 256 + wr * 64 + fr;
        const int colb = u.pn * 256 + wc * 32 + 8 * fq;
#pragma unroll
        for (int bj = 0; bj < 2; ++bj) {
            const int col = colb + bj * 128;
            if (col >= NPROJ) continue;
            bf16* base; int ld;
            if (col < NRAW) { base = raw + col; ld = NRAW; } else { base = rest + (col - NRAW); ld = NREST; }
#pragma unroll
            for (int ai = 0; ai < 2; ++ai)
#pragma unroll
                for (int m = 0; m < 4; ++m) {
                    const pg8::f32x4 v0 = acc[ai][bj][m][0], v1 = acc[ai][bj][m][1];
                    pg8::u32x4 w; w.x = pg8::cvt_pk_bf16(v0[0], v0[1]); w.y = pg8::cvt_pk_bf16(v0[2], v0[3]); w.z = pg8::cvt_pk_bf16(v1[0], v1[1]); w.w = pg8::cvt_pk_bf16(v1[2], v1[3]);
                    *(pg8::u32x4*)(base + (size_t)(row0 + ai * 128 + m * 16) * ld) = w;
                }
        }
    }
};
struct EpiRes {
    static constexpr bool PERM = false, AFTER_DRAIN = false;
    const float* xl_src; const float* xc_src; float* out; float* xc1; const float* mods; int l;
    __device__ __forceinline__ void operator()(const pg8::f32x4 (&acc)[2][2][4][2], const pg8::Unit& u, int wr, int wc, int fr, int fq) const {
        const int row0 = u.pm * 256 + wr * 64 + fr, col0 = u.pn * 256 + wc * 32 + 4 * fq;
#pragma unroll
        for (int ai = 0; ai < 2; ++ai)
#pragma unroll
            for (int m = 0; m < 4; ++m) {
                const int r = row0 + ai * 128 + m * 16;
                const int b = r / TOK, t = r - b * TOK;
                const float* src; float* dst; int s;
                if (t < CTX) { if (l != 0) continue; src = xc_src + ((size_t)b * CTX + t) * D; dst = xc1 + ((size_t)b * CTX + t) * D; s = 8; }
                else { src = xl_src + ((size_t)b * SEQ + (t - CTX)) * D; dst = out + ((size_t)b * SEQ + (t - CTX)) * D; s = b; }
                const float* gt = mods + (size_t)(l * 9 + s) * 3072 + 2048;
#pragma unroll
                for (int bj = 0; bj < 2; ++bj)
#pragma unroll
                    for (int n = 0; n < 2; ++n) {
                        const int c = col0 + bj * 128 + n * 16;
                        const pg8::f32x4 xv = *(const pg8::f32x4*)(src + c), g = *(const pg8::f32x4*)(gt + c);
                        *(pg8::f32x4*)(dst + c) = xv * ALPHA + g * acc[ai][bj][m][n];
                    }
            }
    }
};

__device__ __forceinline__ void transpose_item(const float* W, int K, int N, bf16* WT, LASP float* scr, int item, int lane) {
    const int nblk = (N + 31) / 32, kb = item / nblk, nb = item % nblk, k0 = 64 * kb, n0 = 32 * nb;
    const bool nok = (n0 + (lane & 31)) < N;
#pragma unroll 8
    for (int i = 0; i < 32; ++i) { const int kk = 2 * i + (lane >> 5); scr[kk * 33 + (lane & 31)] = nok ? W[(size_t)(k0 + kk) * N + n0 + (lane & 31)] : 0.f; }
    asm volatile("s_waitcnt lgkmcnt(0)" ::: "memory");
    const int c = lane & 7;
#pragma unroll
    for (int j = 0; j < 4; ++j) {
        const int n = (lane >> 3) + 8 * j; const LASP float* s = scr + (8 * c) * 33 + n;
        uint4 o; o.x = pk2(s[0 * 33], s[1 * 33]); o.y = pk2(s[2 * 33], s[3 * 33]); o.z = pk2(s[4 * 33], s[5 * 33]); o.w = pk2(s[6 * 33], s[7 * 33]);
        *(uint4*)(WT + (size_t)(n0 + n) * K + k0 + 8 * c) = o;
    }
    asm volatile("s_waitcnt lgkmcnt(0)" ::: "memory");
}

__device__ void ph_prologue(const P& p, LASP unsigned char* lds, int bid, int nblk) {
    const int tid = mk_tid(), lane = tid & 63, wave = tid >> 6;
    LASP float* sm = (LASP float*)lds;
    if (bid * NTHREADS < 2 * 3072) {
        for (int i = tid; i < 9 * 1024; i += NTHREADS) {
            int s = i >> 10, d = i & 1023;
            float cv = s < 8 ? p.c[s * 1024 + d] : p.c_ctx[d];
            sm[i] = silu_f(cv);
        }
        __syncthreads();
        for (int o = bid * NTHREADS + tid; o < 2 * 3072; o += nblk * NTHREADS) {
            int l = o / 3072, j = o % 3072;
            const float* w = p.w_mod + (size_t)l * 1024 * 3072 + j;
            float acc[9];
#pragma unroll
            for (int s = 0; s < 9; ++s) acc[s] = 0.f;
            for (int i = 0; i < 1024; ++i) {
                float wv = w[(size_t)i * 3072];
#pragma unroll
                for (int s = 0; s < 9; ++s) acc[s] += sm[s * 1024 + i] * wv;
            }
            float bb = p.b_mod[l * 3072 + j];
#pragma unroll
            for (int s = 0; s < 9; ++s) p.mods[(size_t)(l * 9 + s) * 3072 + j] = acc[s] + bb;
        }
        __syncthreads();
    }
    LASP float* scr = (LASP float*)(lds + 40960 + wave * 8704);
    const int gw = (nblk - 1 - bid) * NWAVES + wave, NGW = nblk * NWAVES;
    constexpr int I_IN = 16 * 122, I_OUT = 16 * 32;
    for (int it = gw; it < 2 * (I_IN + I_OUT); it += NGW) {
        int l = it / (I_IN + I_OUT), r = it % (I_IN + I_OUT);
        if (r < I_IN) transpose_item(p.w_in + (size_t)l * D * NPROJ, D, NPROJ, p.wi_t + (size_t)l * NPAD * D, scr, r, lane);
        else transpose_item(p.w_out + (size_t)l * D * D, D, D, p.wo_t + (size_t)l * D * D, scr, r - I_IN, lane);
    }
    for (int i = bid * NTHREADS + tid; i < 2 * 192 * 128; i += nblk * NTHREADS) {
        int l = i / (192 * 128), r = i % (192 * 128);
        *(uint4*)(p.wi_t + (size_t)l * NPAD * D + (size_t)3904 * D + (size_t)r * 8) = make_uint4(0, 0, 0, 0);
    }
}

__device__ void ph_lnpass(const P& p, int mode, int bid, int nblk) {
    const int tid = mk_tid();
    const int lane = tid & 63, wave = tid >> 6;
    for (int r = bid * NWAVES + wave; r < ROWS; r += nblk * NWAVES) {
        const int b = r / TOK, t = r - b * TOK;
        const bool isc = t < CTX;
        if (mode == 2 && isc) continue;
        float* buf; const float* src; int s;
        if (isc) { buf = p.xc1 + ((size_t)b * CTX + t) * D; src = (mode == 0) ? p.ctx + ((size_t)b * CTX + t) * D : buf; s = 8; }
        else { buf = p.out + ((size_t)b * SEQ + (t - CTX)) * D; src = (mode == 0) ? p.x + ((size_t)b * SEQ + (t - CTX)) * D : buf; s = b; }
        f32x4_t v[4];
#pragma unroll
        for (int j = 0; j < 4; ++j) v[j] = *(const f32x4_t*)(src + 256 * j + 4 * lane);
        if (mode >= 1) {
            const int lp = mode - 1;
            float sum = 0.f;
#pragma unroll
            for (int j = 0; j < 4; ++j) sum += (v[j].x + v[j].y) + (v[j].z + v[j].w);
            const float mu = wave_sum(sum) * (1.f / 1024.f);
            float sq = 0.f;
#pragma unroll
            for (int j = 0; j < 4; ++j) { v[j] = v[j] - mu; sq += (v[j].x * v[j].x + v[j].y * v[j].y) + (v[j].z * v[j].z + v[j].w * v[j].w); }
            const float rs = 1.f / sqrtf(wave_sum(sq) * (1.f / 1024.f) + 1e-6f);
#pragma unroll
            for (int j = 0; j < 4; ++j) {
                const f32x4_t g = *(const f32x4_t*)(p.ln_g + lp * 1024 + 256 * j + 4 * lane), bb = *(const f32x4_t*)(p.ln_b + lp * 1024 + 256 * j + 4 * lane);
                v[j] = v[j] * rs * g + bb;
                *(f32x4_t*)(buf + 256 * j + 4 * lane) = v[j];
            }
            if (mode == 2) continue;
        }
        const int l = mode;
        float sum = 0.f;
#pragma unroll
        for (int j = 0; j < 4; ++j) sum += (v[j].x + v[j].y) + (v[j].z + v[j].w);
        const float mu = wave_sum(sum) * (1.f / 1024.f);
        float sq = 0.f;
#pragma unroll
        for (int j = 0; j < 4; ++j) { v[j] = v[j] - mu; sq += (v[j].x * v[j].x + v[j].y * v[j].y) + (v[j].z * v[j].z + v[j].w * v[j].w); }
        const float rs = 1.f / sqrtf(wave_sum(sq) * (1.f / 1024.f) + 1e-6f);
        const float* md = p.mods + (size_t)(l * 9 + s) * 3072;
#pragma unroll
        for (int j = 0; j < 4; ++j) {
            const f32x4_t sh = *(const f32x4_t*)(md + 256 * j + 4 * lane), sc = *(const f32x4_t*)(md + 1024 + 256 * j + 4 * lane);
            const f32x4_t o = v[j] * rs * (sc + 1.f) + sh;
            uint2 w; w.x = pk2(o.x, o.y); w.y = pk2(o.z, o.w);
            *(uint2*)(p.ml + (size_t)r * D + 256 * j + 4 * lane) = w;
        }
    }
}

__device__ void ph_conv(const P& p, int l, int bid, int nblk) {
    const int tid = mk_tid();
    const int lane = tid & 63, wave = tid >> 6;
    const float* cw = p.conv_w + (size_t)l * 5 * 1536;
    for (int it = bid * NWAVES + wave; it < ROWS * 12; it += nblk * NWAVES) {
        const int r = it / 12, g = it - r * 12;
        const int t = r % TOK;
        const int lo = t < CTX ? 0 : CTX, hi = t < CTX ? CTX : TOK;
        const int ch = g * 128 + lane * 2;
        float a0 = 0.f, a1 = 0.f;
#pragma unroll
        for (int j = 0; j < 5; ++j) {
            const int tt = t + j - 2;
            if (tt >= lo && tt < hi) {
                const unsigned w = *(const unsigned*)(p.raw + (size_t)(r + j - 2) * NRAW + ch);
                a0 += cw[j * 1536 + ch] * bflo(w); a1 += cw[j * 1536 + ch + 1] * bfhi(w);
            }
        }
        a0 = silu_f(a0); a1 = silu_f(a1);
        if (g < 8) {
            const float ss = wave_sum(a0 * a0 + a1 * a1);
            float sc = 1.f / sqrtf(ss + 1e-6f);
            if (g < 4) sc *= 0.08838834764831845f;
            a0 *= sc; a1 *= sc;
        }
        *(unsigned*)(p.qkvn + (size_t)r * NRAW + ch) = pk2(a0, a1);
    }
}


typedef short bf16x8_t __attribute__((ext_vector_type(8)));
typedef float f32x16_t __attribute__((ext_vector_type(16)));
typedef float f32x2_t __attribute__((ext_vector_type(2)));
typedef __bf16 bf16x2_t __attribute__((ext_vector_type(2)));
typedef unsigned u32x4_t __attribute__((ext_vector_type(4)));
#define MFMA32(a, b, c) __builtin_amdgcn_mfma_f32_32x32x16_bf16((a), (b), (c), 0, 0, 0)
__device__ __forceinline__ unsigned cvtpk(float lo, float hi) { f32x2_t v = {lo, hi}; bf16x2_t q = __builtin_convertvector(v, bf16x2_t); return __builtin_bit_cast(unsigned, q); }
__device__ __forceinline__ int crow(int reg, int h) { return (reg & 3) + 8 * (reg >> 2) + 4 * h; }
__device__ __forceinline__ int perm16(int a) { const int x = a & 15; return (a & ~15) + (x < 4 ? x : x < 8 ? x + 4 : x < 12 ? x - 4 : x); }
#define PACK8(x, s) __builtin_bit_cast(bf16x8_t, (u32x4_t){cvtpk((x)[8 * (s)], (x)[8 * (s) + 1]), cvtpk((x)[8 * (s) + 2], (x)[8 * (s) + 3]), cvtpk((x)[8 * (s) + 4], (x)[8 * (s) + 5]), cvtpk((x)[8 * (s) + 6], (x)[8 * (s) + 7])})
constexpr int GCH = 32, NCH = TOK / GCH;
constexpr int GP_ITEM = 4416;

__device__ void ph_gdnprep(const P& p, LASP unsigned char* lds, int l, int bid, int nblk, int tid) {
    const int lane = tid & 63, wave = tid >> 6, r = lane & 31, hh = lane >> 5;
    LASP float* Lm = (LASP float*)(lds + wave * 16384);
    LASP float* Xs = Lm + 2048;
    for (int it = bid * NWAVES + wave; it < BATCH * 4 * NCH; it += nblk * NWAVES) {
        const int c = it % NCH, bh = it / NCH, h = bh & 3, b = bh >> 2;
        const size_t row0 = (size_t)b * TOK + (size_t)c * GCH;
        f32x16_t KK, QK;
#pragma unroll
        for (int i = 0; i < 16; ++i) { KK[i] = 0.f; QK[i] = 0.f; }
        const bf16* kbase = p.qkvn + (row0 + r) * NRAW + 512 + h * 128 + 8 * hh;
        const bf16* qbase = p.qkvn + (row0 + r) * NRAW + h * 128 + 8 * hh;
#pragma unroll
        for (int s = 0; s < 8; ++s) {
            const bf16x8_t kf = *(const bf16x8_t*)(kbase + 16 * s), qf = *(const bf16x8_t*)(qbase + 16 * s);
            KK = MFMA32(kf, kf, KK);
            QK = MFMA32(qf, kf, QK);
        }
        float Gd, bd;
        {
            const bf16* ab = p.rest + (row0 + r) * NREST + RC_AB;
            const float a = bf2f(ab[hh * 4 + h]) + p.dt_bias[(l * 2 + hh) * 4 + h];
            const float sp = fmaxf(a, 0.f) + log1pf(expf(-fabsf(a)));
            Gd = -expf(p.a_log[(l * 2 + hh) * 4 + h]) * sp;
            bd = 1.f / (1.f + expf(-bf2f(ab[(2 + hh) * 4 + h])));
        }
#pragma unroll
        for (int off = 1; off < 32; off <<= 1) {
            const float up = __shfl_up(Gd, off, 32), dn = __shfl_down(Gd, off, 32);
            if (hh == 0) { if (r >= off) Gd += up; } else { if (r + off < 32) Gd += dn; }
        }
        unsigned char* gout = (unsigned char*)p.raw + ((size_t)(bh * 2) * NCH + c) * GP_ITEM;
        {
            const float Glast = __shfl(Gd, hh == 0 ? 31 : 32);
            float* sc = (float*)(gout + (size_t)hh * NCH * GP_ITEM + 4096);
            sc[r] = expf(Gd); sc[32 + r] = expf(Glast - Gd);
            if (r == 0) sc[64] = expf(Glast);
        }
        asm volatile("s_waitcnt lgkmcnt(0)" ::: "memory");
#pragma unroll
        for (int d = 0; d < 2; ++d) {
            const float Gcol = __shfl(Gd, d * 32 + r);
            bf16* qko = (bf16*)(gout + (size_t)d * NCH * GP_ITEM + 2048);
#pragma unroll
            for (int i = 0; i < 16; ++i) {
                const int n = crow(i, hh);
                const float Grow = __shfl(Gd, d * 32 + n), brow = __shfl(bd, d * 32 + n);
                const bool incl = d == 0 ? (r <= n) : (r >= n), strict = d == 0 ? (r < n) : (r > n);
                const float dec = expf(incl ? Grow - Gcol : 0.f);
                const float lv = strict ? brow * KK[i] * dec : 0.f;
                const float qv = incl ? QK[i] * dec : 0.f;
                const int n2 = d == 0 ? n : 31 - n, m2 = d == 0 ? r : 31 - r;
                Lm[(d * 32 + n2) * 32 + m2] = lv;
                qko[n * 32 + perm16(r)] = f2bf(qv);
                if ((i & 3) == 3) __builtin_amdgcn_sched_barrier(0);
            }
        }
        asm volatile("s_waitcnt lgkmcnt(0)" ::: "memory");
        {
            const LASP float* Lr = Lm + hh * 1024;
            LASP float* xc = Xs + lane;
#pragma unroll 4
            for (int j = 0; j < 32; ++j) xc[j * 64] = (j == r) ? 1.f : 0.f;
#pragma unroll 1
            for (int n = 1; n < 32; ++n) {
                float a0 = 0.f, a1 = 0.f;
#pragma unroll 1
                for (int j4 = 0; j4 < n; j4 += 4) {
                    const f32x4_t lv = *(const LASP f32x4_t*)(Lr + n * 32 + j4);
                    a0 += lv.x * xc[(j4 + 0) * 64]; a1 += lv.y * xc[(j4 + 1) * 64];
                    a0 += lv.z * xc[(j4 + 2) * 64]; a1 += lv.w * xc[(j4 + 3) * 64];
                }
                xc[n * 64] -= (a0 + a1);
            }
            const int mtok = hh == 0 ? r : 31 - r;
            const float bcol = __shfl(bd, hh * 32 + mtok);
            bf16* tq = (bf16*)(gout + (size_t)hh * NCH * GP_ITEM) + perm16(mtok) + (hh == 0 ? 0 : 31 * 32);
            const int tstep = hh == 0 ? 32 : -32;
#pragma unroll 4
            for (int n = 0; n < 32; ++n) { *tq = f2bf(xc[n * 64] * bcol); tq += tstep; }
        }
        asm volatile("s_waitcnt lgkmcnt(0)" ::: "memory");
    }
}


constexpr int ST_KA = 0, ST_QA = 8704, ST_KT = 17408, ST_V = 27648, ST_TP = 35840, ST_QK = 38400, ST_SC = 40960, ST_BYTES = 41344;
typedef unsigned u32x2_t __attribute__((ext_vector_type(2)));
struct GSlot { u32x4_t k0, k1, q0, q1, v0, v1, t; f32x4_t sc; };

__device__ __forceinline__ int gdn_chunk(int dir, int s) { return dir == 0 ? s : (s < 8 ? 7 - s : 143 - s); }
__device__ __forceinline__ void gdn_issue(const P& p, GSlot& g, int b, int h, int dir, int step, int tl) {
    const int c = gdn_chunk(dir, step);
    const size_t row0 = (size_t)b * TOK + (size_t)c * GCH;
    const int r0 = tl >> 4, c16 = tl & 15;
    const bf16* a0 = p.qkvn + (row0 + r0) * NRAW + h * 128 + 8 * c16;
    const bf16* a1 = a0 + (size_t)16 * NRAW;
    g.q0 = *(const u32x4_t*)a0; g.q1 = *(const u32x4_t*)a1;
    g.k0 = *(const u32x4_t*)(a0 + 512); g.k1 = *(const u32x4_t*)(a1 + 512);
    g.v0 = *(const u32x4_t*)(a0 + 1024); g.v1 = *(const u32x4_t*)(a1 + 1024);
    const unsigned char* gp = (const unsigned char*)p.raw + ((size_t)((b * 4 + h) * 2 + dir) * NCH + c) * GP_ITEM;
    g.t = *(const u32x4_t*)(gp + tl * 16);
    if (tl < 20) g.sc = *(const f32x4_t*)(gp + 4096 + tl * 16);
}
__device__ __forceinline__ void gdn_put_rows(LASP unsigned char* st, int row, int c16, u32x4_t kq, int off) {
    const int g = c16 >> 1, odd = c16 & 1;
    *(LASP u32x2_t*)(st + off + row * 272 + (16 * g + (odd ? 4 : 0)) * 2) = (u32x2_t){kq.x, kq.y};
    *(LASP u32x2_t*)(st + off + row * 272 + (16 * g + (odd ? 12 : 8)) * 2) = (u32x2_t){kq.z, kq.w};
}
__device__ __forceinline__ void gdn_put_kt(LASP unsigned char* st, int row, int c16, u32x4_t k) {
    LASP unsigned short* kt = (LASP unsigned short*)(st + ST_KT) + perm16(row);
    const int d0 = 8 * c16;
    kt[(d0 + 0) * 40] = (unsigned short)(k.x & 0xffffu); kt[(d0 + 1) * 40] = (unsigned short)(k.x >> 16);
    kt[(d0 + 2) * 40] = (unsigned short)(k.y & 0xffffu); kt[(d0 + 3) * 40] = (unsigned short)(k.y >> 16);
    kt[(d0 + 4) * 40] = (unsigned short)(k.z & 0xffffu); kt[(d0 + 5) * 40] = (unsigned short)(k.z >> 16);
    kt[(d0 + 6) * 40] = (unsigned short)(k.w & 0xffffu); kt[(d0 + 7) * 40] = (unsigned short)(k.w >> 16);
}
__device__ __forceinline__ void gdn_write(LASP unsigned char* st, const GSlot& g, int tl) {
    const int r0 = tl >> 4, c16 = tl & 15;
    gdn_put_rows(st, r0, c16, g.k0, ST_KA); gdn_put_rows(st, r0 + 16, c16, g.k1, ST_KA);
    gdn_put_rows(st, r0, c16, g.q0, ST_QA); gdn_put_rows(st, r0 + 16, c16, g.q1, ST_QA);
    gdn_put_kt(st, r0, c16, g.k0); gdn_put_kt(st, r0 + 16, c16, g.k1);
    *(LASP u32x4_t*)(st + ST_V + r0 * 256 + c16 * 16) = g.v0;
    *(LASP u32x4_t*)(st + ST_V + (r0 + 16) * 256 + c16 * 16) = g.v1;
    { const int t2 = tl & 127; *(LASP u32x4_t*)(st + (tl < 128 ? ST_TP : ST_QK) + (t2 >> 2) * 80 + (t2 & 3) * 16) = g.t; }
    if (tl < 20) *(LASP f32x4_t*)(st + ST_SC + tl * 16) = g.sc;
}

__device__ void gdn_scan_fast(const P& p, LASP unsigned char* lds, int chain) {
    const int tid = mk_tid();
    const int lane = tid & 63, wave = __builtin_amdgcn_readfirstlane(tid >> 6);
    const int dir = chain & 1, h = (chain >> 1) & 3, b = chain >> 3;
    constexpr int NS = NCH;
    if (wave >= 4) {
        const int tl = tid - 256;
        GSlot g0, g1, g2, g3;
        gdn_issue(p, g0, b, h, dir, 0, tl); gdn_issue(p, g1, b, h, dir, 1, tl); gdn_issue(p, g2, b, h, dir, 2, tl); gdn_issue(p, g3, b, h, dir, 3, tl);
        gdn_write(lds, g0, tl); gdn_issue(p, g0, b, h, dir, 4, tl);
        __syncthreads();
#pragma unroll 1
        for (int s = 0; s < NS; s += 4) {
            gdn_write(lds + ((s + 1) & 1) * ST_BYTES, g1, tl); if (s + 5 < NS) gdn_issue(p, g1, b, h, dir, s + 5, tl);
            __syncthreads();
            gdn_write(lds + ((s + 2) & 1) * ST_BYTES, g2, tl); if (s + 6 < NS) gdn_issue(p, g2, b, h, dir, s + 6, tl);
            __syncthreads();
            gdn_write(lds + ((s + 3) & 1) * ST_BYTES, g3, tl); if (s + 7 < NS) gdn_issue(p, g3, b, h, dir, s + 7, tl);
            __syncthreads();
            if (s + 4 < NS) { gdn_write(lds + ((s + 4) & 1) * ST_BYTES, g0, tl); if (s + 8 < NS) gdn_issue(p, g0, b, h, dir, s + 8, tl); }
            __syncthreads();
        }
    } else {
        const int r = lane & 31, hh = lane >> 5, w = wave;
        f32x16_t S0, S1, S2, S3;
#pragma unroll
        for (int i = 0; i < 16; ++i) { S0[i] = 0.f; S1[i] = 0.f; S2[i] = 0.f; S3[i] = 0.f; }
        __syncthreads();
#pragma unroll 1
        for (int s = 0; s < NS; ++s) {
            LASP unsigned char* st = lds + (s & 1) * ST_BYTES;
            const bf16x8_t Sb00 = PACK8(S0, 0), Sb01 = PACK8(S0, 1), Sb10 = PACK8(S1, 0), Sb11 = PACK8(S1, 1);
            const bf16x8_t Sb20 = PACK8(S2, 0), Sb21 = PACK8(S2, 1), Sb30 = PACK8(S3, 0), Sb31 = PACK8(S3, 1);
            f32x16_t ak, aq;
#pragma unroll
            for (int i = 0; i < 16; ++i) { ak[i] = 0.f; aq[i] = 0.f; }
            const LASP unsigned char* ka = st + ST_KA + r * 272 + hh * 16;
            const LASP unsigned char* qa = st + ST_QA + r * 272 + hh * 16;
#define GDN_KQ(ks, SB) { const bf16x8_t A = *(const LASP bf16x8_t*)(ka + (ks) * 32); ak = MFMA32(A, SB, ak); const bf16x8_t A2 = *(const LASP bf16x8_t*)(qa + (ks) * 32); aq = MFMA32(A2, SB, aq); }
            GDN_KQ(0, Sb00) GDN_KQ(1, Sb01) GDN_KQ(2, Sb10) GDN_KQ(3, Sb11) GDN_KQ(4, Sb20) GDN_KQ(5, Sb21) GDN_KQ(6, Sb30) GDN_KQ(7, Sb31)
#undef GDN_KQ
            const LASP float* sc = (const LASP float*)(st + ST_SC);
            float ev[16], fv[16];
#pragma unroll
            for (int g = 0; g < 4; ++g) {
                const f32x4_t e4 = *(const LASP f32x4_t*)(sc + 8 * g + 4 * hh), f4 = *(const LASP f32x4_t*)(sc + 32 + 8 * g + 4 * hh);
                ev[4 * g] = e4.x; ev[4 * g + 1] = e4.y; ev[4 * g + 2] = e4.z; ev[4 * g + 3] = e4.w;
                fv[4 * g] = f4.x; fv[4 * g + 1] = f4.y; fv[4 * g + 2] = f4.z; fv[4 * g + 3] = f4.w;
            }
            const float gl = sc[64];
            const LASP unsigned short* vl = (const LASP unsigned short*)(st + ST_V) + 32 * w + r;
            f32x16_t rr;
#pragma unroll
            for (int i = 0; i < 16; ++i) rr[i] = bf2f(vl[crow(i, hh) * 128]) - ev[i] * ak[i];
            const bf16x8_t rb0 = PACK8(rr, 0), rb1 = PACK8(rr, 1);
            f32x16_t vn;
#pragma unroll
            for (int i = 0; i < 16; ++i) vn[i] = 0.f;
            const LASP unsigned char* tp = st + ST_TP + r * 80 + hh * 16;
            vn = MFMA32(*(const LASP bf16x8_t*)(tp), rb0, vn);
            vn = MFMA32(*(const LASP bf16x8_t*)(tp + 32), rb1, vn);
#pragma unroll
            for (int i = 0; i < 16; ++i) aq[i] *= ev[i];
            const bf16x8_t vb0 = PACK8(vn, 0), vb1 = PACK8(vn, 1);
            const LASP unsigned char* qk = st + ST_QK + r * 80 + hh * 16;
            aq = MFMA32(*(const LASP bf16x8_t*)(qk), vb0, aq);
            aq = MFMA32(*(const LASP bf16x8_t*)(qk + 32), vb1, aq);
            {
                const int c = gdn_chunk(dir, s);
                bf16* op = p.oa + ((size_t)dir * ROWS + (size_t)b * TOK + (size_t)c * GCH) * 512 + h * 128 + 32 * w + r;
#pragma unroll
                for (int i = 0; i < 16; ++i) op[(size_t)crow(i, hh) * 512] = f2bf(aq[i]);
            }
            f32x16_t vf;
#pragma unroll
            for (int i = 0; i < 16; ++i) vf[i] = vn[i] * fv[i];
            const bf16x8_t fb0 = PACK8(vf, 0), fb1 = PACK8(vf, 1);
            const LASP unsigned char* kt = st + ST_KT + r * 80 + hh * 16;
#define GDN_UPD(SX, mt) { _Pragma("unroll") for (int i = 0; i < 16; ++i) SX[i] *= gl; SX = MFMA32(*(const LASP bf16x8_t*)(kt + (mt) * 32 * 80), fb0, SX); SX = MFMA32(*(const LASP bf16x8_t*)(kt + (mt) * 32 * 80 + 32), fb1, SX); }
            GDN_UPD(S0, 0) GDN_UPD(S1, 1) GDN_UPD(S2, 2) GDN_UPD(S3, 3)
#undef GDN_UPD
            __syncthreads();
        }
    }
}


constexpr int GL_ITEM = 6272;
constexpr size_t GLA_PREP_OFF = (size_t)BATCH * 4 * 2 * NCH * GP_ITEM;

__device__ __forceinline__ void gla_prep_item(const P& p, LASP unsigned char* wl, const LASP float* cstab, int l, int it, int lane) {
    const int r = lane & 31, hh = lane >> 5;
    const int c = it % NCH, bh = it / NCH, h = bh & 3, b = bh >> 2;
    const size_t row0 = (size_t)b * TOK + (size_t)c * GCH;
    float qv[16], kv[16];
    {
        const bf16* qb = p.rest + (row0 + 4 * hh) * NREST + RC_CQ + h * 32 + r;
#pragma unroll
        for (int i = 0; i < 16; ++i) { const int no = (i & 3) + 8 * (i >> 2); qv[i] = bf2f(qb[(size_t)no * NREST]); kv[i] = bf2f(qb[(size_t)no * NREST + 128]); }
    }
    if (c >= 8) {
        const int dd = r & 15, f = dd & 7;
        const int prow = (c - 8) >> 1, pcol0 = 32 * ((c - 8) & 1);
#pragma unroll
        for (int i = 0; i < 16; ++i) {
            const int n = crow(i, hh);
            const int pos = r < 16 ? prow : pcol0 + n;
            const float cs = cstab[(pos * 8 + f) * 2], sn = cstab[(pos * 8 + f) * 2 + 1];
            const float qp = __shfl_xor(qv[i], 8), kp = __shfl_xor(kv[i], 8);
            if (dd < 8) { qv[i] = qv[i] * cs - qp * sn; kv[i] = kv[i] * cs - kp * sn; }
            else { qv[i] = qp * sn + qv[i] * cs; kv[i] = kp * sn + kv[i] * cs; }
        }
    }
#pragma unroll
    for (int i = 0; i < 16; ++i) qv[i] *= 0.17677669529663687f;
#pragma unroll 1
    for (int dir = 0; dir < 2; ++dir) {
        f32x16_t X;
#pragma unroll
        for (int i = 0; i < 16; ++i) X[i] = 0.f;
        {
            const bf16x8_t A = *(const bf16x8_t*)(p.rest + (row0 + r) * NREST + RC_CR + dir * 16 + 8 * hh);
            const float* w2p = p.gla_w2 + ((size_t)(l * 2 + dir) * 16 + 8 * hh) * 128 + h * 32 + r;
            const bf16x8_t Bf = __builtin_bit_cast(bf16x8_t, (u32x4_t){cvtpk(w2p[0], w2p[128]), cvtpk(w2p[256], w2p[384]), cvtpk(w2p[512], w2p[640]), cvtpk(w2p[768], w2p[896])});
            X = MFMA32(A, Bf, X);
        }
        const float b2v = p.gla_b2[(l * 2 + dir) * 128 + h * 32 + r];
        float Bc[16];
#pragma unroll
        for (int i = 0; i < 16; ++i) { const float xg = X[i] + b2v; Bc[i] = (fminf(xg, 0.f) - log1pf(expf(-fabsf(xg)))) * (1.f / 16.f); }
        float tot;
        {
            float sg[4], ps[4];
#pragma unroll
            for (int g = 0; g < 4; ++g) { sg[g] = (Bc[4 * g] + Bc[4 * g + 1]) + (Bc[4 * g + 2] + Bc[4 * g + 3]); ps[g] = __shfl_xor(sg[g], 32); }
            tot = ((sg[0] + ps[0]) + (sg[1] + ps[1])) + ((sg[2] + ps[2]) + (sg[3] + ps[3]));
            if (dir == 0) {
                float base = 0.f;
#pragma unroll
                for (int g = 0; g < 4; ++g) {
                    float o = base + (hh ? ps[g] : 0.f);
#pragma unroll
                    for (int k = 0; k < 4; ++k) { o += Bc[4 * g + k]; Bc[4 * g + k] = o; }
                    base += sg[g] + ps[g];
                }
            } else {
                float base = 0.f;
#pragma unroll
                for (int g = 3; g >= 0; --g) {
                    float o = base + (hh ? 0.f : ps[g]);
#pragma unroll
                    for (int k = 3; k >= 0; --k) { o += Bc[4 * g + k]; Bc[4 * g + k] = o; }
                    base += sg[g] + ps[g];
                }
            }
        }
        unsigned char* gout = (unsigned char*)p.raw + GLA_PREP_OFF + ((size_t)(bh * 2 + dir) * NCH + c) * GL_ITEM;
        LASP bf16* ql = (LASP bf16*)wl;
        LASP bf16* kl = ql + 32 * 40;
        {
            bf16* qpo = (bf16*)gout + perm16(r);
            bf16* kdo = (bf16*)(gout + 4096) + r * 32 + 4 * hh;
#pragma unroll
            for (int g = 0; g < 4; ++g) {
                float kd[4];
#pragma unroll
                for (int k = 0; k < 4; ++k) {
                    const int i = 4 * g + k, n = crow(i, hh);
                    const float eb = expf(Bc[i]);
                    const float qs = qv[i] * eb, ks = kv[i] / eb;
                    kd[k] = kv[i] * expf(tot - Bc[i]);
                    const bf16 qsb = f2bf(qs);
                    qpo[n * 32] = qsb;
                    ql[n * 40 + r] = qsb; kl[n * 40 + r] = f2bf(ks);
                }
                *(u32x2_t*)(kdo + 8 * g) = (u32x2_t){cvtpk(kd[0], kd[1]), cvtpk(kd[2], kd[3])};
            }
            if (hh == 0) ((float*)(gout + 6144))[r] = expf(tot);
        }
        asm volatile("s_waitcnt lgkmcnt(0)" ::: "memory");
        f32x16_t AT;
#pragma unroll
        for (int i = 0; i < 16; ++i) AT[i] = 0.f;
        AT = MFMA32(*(const LASP bf16x8_t*)((const LASP unsigned char*)kl + r * 80 + hh * 16), *(const LASP bf16x8_t*)((const LASP unsigned char*)ql + r * 80 + hh * 16), AT);
        AT = MFMA32(*(const LASP bf16x8_t*)((const LASP unsigned char*)kl + r * 80 + hh * 16 + 32), *(const LASP bf16x8_t*)((const LASP unsigned char*)ql + r * 80 + hh * 16 + 32), AT);
        {
            bf16* amo = (bf16*)(gout + 2048) + r * 32 + 4 * hh;
#pragma unroll
            for (int g = 0; g < 4; ++g) {
                float a[4];
#pragma unroll
                for (int k = 0; k < 4; ++k) { const int m = crow(4 * g + k, hh); const bool keep = dir == 0 ? (m <= r) : (m >= r); a[k] = keep ? AT[4 * g + k] : 0.f; }
                *(u32x2_t*)(amo + 8 * g) = (u32x2_t){cvtpk(a[0], a[1]), cvtpk(a[2], a[3])};
            }
        }
        asm volatile("s_waitcnt lgkmcnt(0)" ::: "memory");
    }
}

constexpr int LS_QP = 0, LS_AM = 2560, LS_KD = 5120, LS_VT = 7680, LS_GL = 12800, LS_BYTES = 12928;
struct LSlot { u32x4_t a0, a1, a2, v0, v1; f32x4_t gl; };
__device__ __forceinline__ void gla_issue(const P& p, LSlot& g, int b, int h, int dir, int step, int t2) {
    const int c = gdn_chunk(dir, step);
    const unsigned char* gp = (const unsigned char*)p.raw + GLA_PREP_OFF + ((size_t)((b * 4 + h) * 2 + dir) * NCH + c) * GL_ITEM;
    g.a0 = *(const u32x4_t*)(gp + t2 * 16); g.a1 = *(const u32x4_t*)(gp + 2048 + t2 * 16); g.a2 = *(const u32x4_t*)(gp + 4096 + t2 * 16);
    if (t2 < 8) g.gl = *(const f32x4_t*)(gp + 6144 + t2 * 16);
    const size_t row0 = (size_t)b * TOK + (size_t)c * GCH;
    const bf16* vp = p.rest + (row0 + (t2 >> 3)) * NREST + RC_CV + h * 64 + 8 * (t2 & 7);
    g.v0 = *(const u32x4_t*)vp; g.v1 = *(const u32x4_t*)(vp + (size_t)16 * NREST);
}
__device__ __forceinline__ void gla_put_vt(LASP unsigned char* st, int m, int dv0, u32x4_t v) {
    LASP unsigned short* vt = (LASP unsigned short*)(st + LS_VT) + m;
    vt[(dv0 + 0) * 40] = (unsigned short)(v.x & 0xffffu); vt[(dv0 + 1) * 40] = (unsigned short)(v.x >> 16);
    vt[(dv0 + 2) * 40] = (unsigned short)(v.y & 0xffffu); vt[(dv0 + 3) * 40] = (unsigned short)(v.y >> 16);
    vt[(dv0 + 4) * 40] = (unsigned short)(v.z & 0xffffu); vt[(dv0 + 5) * 40] = (unsigned short)(v.z >> 16);
    vt[(dv0 + 6) * 40] = (unsigned short)(v.w & 0xffffu); vt[(dv0 + 7) * 40] = (unsigned short)(v.w >> 16);
}
__device__ __forceinline__ void gla_write(LASP unsigned char* st, const LSlot& g, int t2) {
    const int row = t2 >> 2, ch = t2 & 3;
    *(LASP u32x4_t*)(st + LS_QP + row * 80 + ch * 16) = g.a0;
    *(LASP u32x4_t*)(st + LS_AM + row * 80 + ch * 16) = g.a1;
    *(LASP u32x4_t*)(st + LS_KD + row * 80 + ch * 16) = g.a2;
    if (t2 < 8) *(LASP f32x4_t*)(st + LS_GL + t2 * 16) = g.gl;
    gla_put_vt(st, t2 >> 3, 8 * (t2 & 7), g.v0); gla_put_vt(st, 16 + (t2 >> 3), 8 * (t2 & 7), g.v1);
}
__device__ void gla_scan_fast(const P& p, LASP unsigned char* lds, int bh) {
    const int tid = mk_tid();
    const int lane = tid & 63, wave = __builtin_amdgcn_readfirstlane(tid >> 6);
    const int h = bh & 3, b = bh >> 2;
    constexpr int NS = NCH;
    if (wave >= 4) {
        const int dir = (wave - 4) >> 1, t2 = tid & 127;
        LASP unsigned char* base = lds + dir * 2 * LS_BYTES;
        LSlot g0, g1, g2, g3;
        gla_issue(p, g0, b, h, dir, 0, t2); gla_issue(p, g1, b, h, dir, 1, t2); gla_issue(p, g2, b, h, dir, 2, t2); gla_issue(p, g3, b, h, dir, 3, t2);
        gla_write(base, g0, t2); gla_issue(p, g0, b, h, dir, 4, t2);
        __syncthreads();
#pragma unroll 1
        for (int s = 0; s < NS; s += 4) {
            gla_write(base + ((s + 1) & 1) * LS_BYTES, g1, t2); if (s + 5 < NS) gla_issue(p, g1, b, h, dir, s + 5, t2);
            __syncthreads();
            gla_write(base + ((s + 2) & 1) * LS_BYTES, g2, t2); if (s + 6 < NS) gla_issue(p, g2, b, h, dir, s + 6, t2);
            __syncthreads();
            gla_write(base + ((s + 3) & 1) * LS_BYTES, g3, t2); if (s + 7 < NS) gla_issue(p, g3, b, h, dir, s + 7, t2);
            __syncthreads();
            if (s + 4 < NS) { gla_write(base + ((s + 4) & 1) * LS_BYTES, g0, t2); if (s + 8 < NS) gla_issue(p, g0, b, h, dir, s + 8, t2); }
            __syncthreads();
        }
    } else {
        const int r = lane & 31, hh = lane >> 5, dir = wave >> 1, blk = wave & 1;
        LASP unsigned char* base = lds + dir * 2 * LS_BYTES;
        f32x16_t S;
#pragma unroll
        for (int i = 0; i < 16; ++i) S[i] = 0.f;
        __syncthreads();
#pragma unroll 1
        for (int s = 0; s < NS; ++s) {
            const LASP unsigned char* st = base + (s & 1) * LS_BYTES;
            const bf16x8_t Sb0 = PACK8(S, 0), Sb1 = PACK8(S, 1);
            f32x16_t oT;
#pragma unroll
            for (int i = 0; i < 16; ++i) oT[i] = 0.f;
            const LASP unsigned char* qp = st + LS_QP + r * 80 + hh * 16;
            oT = MFMA32(Sb0, *(const LASP bf16x8_t*)(qp), oT);
            oT = MFMA32(Sb1, *(const LASP bf16x8_t*)(qp + 32), oT);
            const LASP unsigned char* vt = st + LS_VT + (32 * blk + r) * 80 + hh * 16;
            const LASP unsigned char* am = st + LS_AM + r * 80 + hh * 16;
            const bf16x8_t V0 = *(const LASP bf16x8_t*)(vt), V1 = *(const LASP bf16x8_t*)(vt + 32);
            oT = MFMA32(V0, *(const LASP bf16x8_t*)(am), oT);
            oT = MFMA32(V1, *(const LASP bf16x8_t*)(am + 32), oT);
            {
                const int c = gdn_chunk(dir, s);
                bf16* op = p.oc + ((size_t)dir * ROWS + (size_t)b * TOK + (size_t)c * GCH + r) * 256 + h * 64 + 32 * blk + 4 * hh;
#pragma unroll
                for (int g = 0; g < 4; ++g) *(u32x2_t*)(op + 8 * g) = (u32x2_t){cvtpk(oT[4 * g], oT[4 * g + 1]), cvtpk(oT[4 * g + 2], oT[4 * g + 3])};
            }
            const LASP float* glp = (const LASP float*)(st + LS_GL);
#pragma unroll
            for (int g = 0; g < 4; ++g) {
                const f32x4_t g4 = *(const LASP f32x4_t*)(glp + 8 * g + 4 * hh);
                S[4 * g] *= g4.x; S[4 * g + 1] *= g4.y; S[4 * g + 2] *= g4.z; S[4 * g + 3] *= g4.w;
            }
            const LASP unsigned char* kd = st + LS_KD + r * 80 + hh * 16;
            S = MFMA32(*(const LASP bf16x8_t*)(kd), V0, S);
            S = MFMA32(*(const LASP bf16x8_t*)(kd + 32), V1, S);
            __syncthreads();
        }
    }
}


__device__ __forceinline__ void vt_item(const P& p, int it, int lane) {
    const int r = lane & 31, hh = lane >> 5;
    const int tb = it % NCH, bh = it / NCH, h = bh & 3, b = bh >> 2;
    const bf16* vp = p.rest + ((size_t)b * TOK + 32 * tb + r) * NREST + RC_BV + h * 64 + 32 * hh;
    bf16* op = p.vtb + ((size_t)bh * 64 + 32 * hh) * TOK + 32 * tb + perm16(r);
#pragma unroll
    for (int q = 0; q < 4; ++q) {
        const u32x4_t w = *(const u32x4_t*)(vp + 8 * q);
        op[(size_t)(8 * q + 0) * TOK] = (bf16)(w.x & 0xffffu); op[(size_t)(8 * q + 1) * TOK] = (bf16)(w.x >> 16);
        op[(size_t)(8 * q + 2) * TOK] = (bf16)(w.y & 0xffffu); op[(size_t)(8 * q + 3) * TOK] = (bf16)(w.y >> 16);
        op[(size_t)(8 * q + 4) * TOK] = (bf16)(w.z & 0xffffu); op[(size_t)(8 * q + 5) * TOK] = (bf16)(w.z >> 16);
        op[(size_t)(8 * q + 6) * TOK] = (bf16)(w.w & 0xffffu); op[(size_t)(8 * q + 7) * TOK] = (bf16)(w.w >> 16);
    }
}

__device__ __forceinline__ void na_item(const P& p, const LASP float* rpbL, int it, int lane) {
    const int r = lane & 31, hh = lane >> 5;
    int b, h, ry, qb; bool lat;
    if (it < 4096) { lat = true; qb = it & 1; ry = (it >> 1) & 63; h = (it >> 7) & 3; b = it >> 9; }
    else { const int j = it - 4096; lat = false; qb = j & 7; h = (j >> 3) & 3; b = j >> 5; ry = 0; }
    const size_t brow = (size_t)b * TOK;
    const int q0 = lat ? CTX + ry * 64 + qb * 32 : qb * 32;
    bf16* qp = p.rest + (brow + q0 + r) * NREST + RC_BQ + h * 64;
    bf16x8_t Qf0 = *(const bf16x8_t*)(qp + 8 * hh), Qf1 = *(const bf16x8_t*)(qp + 16 + 8 * hh), Qf2 = *(const bf16x8_t*)(qp + 32 + 8 * hh), Qf3 = *(const bf16x8_t*)(qp + 48 + 8 * hh);
    f32x16_t O0, O1;
#pragma unroll
    for (int i = 0; i < 16; ++i) { O0[i] = 0.f; O1[i] = 0.f; }
    float m = -1e30f, lsum = 0.f;
    const bf16* vtb = p.vtb + ((size_t)(b * 4 + h) * 64 + r) * TOK + 8 * hh;
    const int nkb = lat ? 24 : 8;
    const int c = qb * 32 + r, c0 = min(max(c - 8, 0), 48), r0 = min(max(ry - 4, 0), 56);
    constexpr float SC = 0.125f * 1.4426950408889634f;
#pragma unroll 1
    for (int kb = 0; kb < nkb; ++kb) {
        int t0, ky = 0, cb = 0; const bool win = kb >= 8;
        if (!win) t0 = kb * 32; else { const int w = kb - 8; ky = r0 + (w >> 1); cb = w & 1; t0 = CTX + ky * 64 + cb * 32; }
        const bf16* kp = p.rest + (brow + t0 + r) * NREST + RC_BK + h * 64 + 8 * hh;
        f32x16_t S;
#pragma unroll
        for (int i = 0; i < 16; ++i) S[i] = 0.f;
        S = MFMA32(*(const bf16x8_t*)(kp), Qf0, S); S = MFMA32(*(const bf16x8_t*)(kp + 16), Qf1, S);
        S = MFMA32(*(const bf16x8_t*)(kp + 32), Qf2, S); S = MFMA32(*(const bf16x8_t*)(kp + 48), Qf3, S);
        const bf16* vp = vtb + t0;
        const bf16x8_t V00 = *(const bf16x8_t*)(vp), V01 = *(const bf16x8_t*)(vp + 16), V10 = *(const bf16x8_t*)(vp + (size_t)32 * TOK), V11 = *(const bf16x8_t*)(vp + (size_t)32 * TOK + 16);
        float bm = -1e30f;
        if (win) {
            const LASP float* rb = rpbL + (h * 15 + (ky - ry + 7)) * 31 + 15 - c;
#pragma unroll
            for (int i = 0; i < 16; ++i) {
                const int kc = cb * 32 + crow(i, hh);
                const bool valid = (kc >= c0) && (kc < c0 + 16);
                const float bias = rb[valid ? kc : c];
                S[i] = valid ? S[i] * SC + bias : -1e30f;
                bm = fmaxf(bm, S[i]);
            }
        } else {
#pragma unroll
            for (int i = 0; i < 16; ++i) { S[i] *= SC; bm = fmaxf(bm, S[i]); }
        }
        bm = fmaxf(bm, __shfl_xor(bm, 32));
        const float mn = fmaxf(m, bm);
        const float alpha = __builtin_amdgcn_exp2f(m - mn);
        m = mn;
        float ps = 0.f;
#pragma unroll
        for (int i = 0; i < 16; ++i) { S[i] = __builtin_amdgcn_exp2f(S[i] - mn); ps += S[i]; }
        lsum = lsum * alpha + ps;
#pragma unroll
        for (int i = 0; i < 16; ++i) { O0[i] *= alpha; O1[i] *= alpha; }
        const bf16x8_t Pb0 = PACK8(S, 0), Pb1 = PACK8(S, 1);
        O0 = MFMA32(V00, Pb0, O0); O0 = MFMA32(V01, Pb1, O0);
        O1 = MFMA32(V10, Pb0, O1); O1 = MFMA32(V11, Pb1, O1);
    }
    const float inv = 1.f / (lsum + __shfl_xor(lsum, 32));
    bf16* op = qp + 4 * hh;
#pragma unroll
    for (int g = 0; g < 4; ++g) {
        *(u32x2_t*)(op + 8 * g) = (u32x2_t){cvtpk(O0[4 * g] * inv, O0[4 * g + 1] * inv), cvtpk(O0[4 * g + 2] * inv, O0[4 * g + 3] * inv)};
        *(u32x2_t*)(op + 32 + 8 * g) = (u32x2_t){cvtpk(O1[4 * g] * inv, O1[4 * g + 1] * inv), cvtpk(O1[4 * g + 2] * inv, O1[4 * g + 3] * inv)};
    }
}

__device__ void ph_prep(const P& p, LASP unsigned char* lds, int l, int bid, int nblk) {
    const int tid = mk_tid();
    LASP float* cstab = (LASP float*)(lds + 131072);
    {
        const int pos = tid >> 3, f = tid & 7;
        const float ang = (float)pos * powf(10000.f, -(float)f / 8.f);
        cstab[tid * 2] = cosf(ang); cstab[tid * 2 + 1] = sinf(ang);
    }
    __syncthreads();
    ph_gdnprep(p, lds, l, bid, nblk, tid);
    const int lane = tid & 63, wave = tid >> 6;
    for (int it = (nblk - 1 - bid) * NWAVES + wave; it < BATCH * 4 * NCH; it += nblk * NWAVES) gla_prep_item(p, lds + wave * 16384, cstab, l, it, lane);
    for (int it = bid * NWAVES + wave; it < BATCH * 4 * NCH; it += nblk * NWAVES) vt_item(p, it, lane);
}


__device__ void ph_mix(const P& p, LASP unsigned char* lds, int l, int bid, int nblk) {
    constexpr int NGDN = BATCH * 4 * 2;
    constexpr int NGLA = BATCH * 4;
    if (bid < NGDN) { gdn_scan_fast(p, lds, bid); return; }
    if (bid < NGDN + NGLA) { gla_scan_fast(p, lds, bid - NGDN); return; }
    const int tid = mk_tid();
    const int lane = tid & 63, wave = tid >> 6;
    LASP float* rpbL = (LASP float*)lds;
    for (int i = tid; i < 4 * 15 * 31; i += NTHREADS) rpbL[i] = p.rpb[(size_t)l * 4 * 15 * 31 + i] * 1.4426950408889634f;
    __syncthreads();
    const int total = 4096 + (l == 0 ? 256 : 0);
    for (int it = (bid - NGDN - NGLA) * NWAVES + wave; it < total; it += (nblk - NGDN - NGLA) * NWAVES) na_item(p, rpbL, it, lane);
}

__device__ void ph_gate(const P& p, int l, int bid, int nblk) {
    const int tid = mk_tid();
    const int tq = tid & 127, rsub = tid >> 7;
    for (int r = bid * 4 + rsub; r < ROWS; r += nblk * 4) {
        const bf16* pr = p.rest + (size_t)r * NREST;
        float o[8], z[8], res[8]; int oc;
        if (tq < 64) {
            const int cb = tq * 8;
            float a[8], bb[8];
            unpack8(*(const uint4*)(p.oa + (size_t)r * 512 + cb), a);
            unpack8(*(const uint4*)(p.oa + ((size_t)ROWS + r) * 512 + cb), bb);
            float ss = 0.f;
#pragma unroll
            for (int e = 0; e < 8; ++e) { o[e] = a[e] + bb[e]; ss += o[e] * o[e]; }
#pragma unroll
            for (int m = 8; m > 0; m >>= 1) ss += __shfl_xor(ss, m);
            const float rs = 1.f / sqrtf(ss * (1.f / 128.f) + 1e-6f);
            unpack8(*(const uint4*)(pr + RC_AZ + cb), z);
#pragma unroll
            for (int e = 0; e < 8; ++e) res[e] = o[e] * rs * p.gdn_norm[l * 128 + ((cb + e) & 127)] * silu_f(z[e]);
            oc = cb;
        } else if (tq < 96) {
            const int cb = (tq - 64) * 8;
            unpack8(*(const uint4*)(pr + RC_BQ + cb), o);
            unpack8(*(const uint4*)(pr + RC_BZ + cb), z);
#pragma unroll
            for (int e = 0; e < 8; ++e) res[e] = o[e] * silu_f(z[e]);
            oc = 512 + cb;
        } else {
            const int cb = (tq - 96) * 8;
            float a[8], bb[8];
            unpack8(*(const uint4*)(p.oc + (size_t)r * 256 + cb), a);
            unpack8(*(const uint4*)(p.oc + ((size_t)ROWS + r) * 256 + cb), bb);
            float ss = 0.f;
#pragma unroll
            for (int e = 0; e < 8; ++e) { o[e] = a[e] + bb[e]; ss += o[e] * o[e]; }
#pragma unroll
            for (int m = 4; m > 0; m >>= 1) ss += __shfl_xor(ss, m);
            const float rs = 1.f / sqrtf(ss * (1.f / 64.f) + 1e-6f);
            unpack8(*(const uint4*)(pr + RC_CZ + cb), z);
#pragma unroll
            for (int e = 0; e < 8; ++e) res[e] = o[e] * rs * p.gla_norm[l * 64 + ((cb + e) & 63)] * silu_f(z[e]);
            oc = 768 + cb;
        }
        uint4 w; w.x = pk2(res[0], res[1]); w.y = pk2(res[2], res[3]); w.z = pk2(res[4], res[5]); w.w = pk2(res[6], res[7]);
        *(uint4*)(p.mix + (size_t)r * D + oc) = w;
    }
}

constexpr int NSTEP = 1 + 2 * 7 + 1;
__global__ void __launch_bounds__(NTHREADS, 2) k_mega(P p) {
    extern __shared__ __attribute__((aligned(16))) unsigned char lds_raw[];
    LASP unsigned char* lds = (LASP unsigned char*)lds_raw;
    cg::grid_group grid = cg::this_grid();
    const int bid = blockIdx.x, nblk = gridDim.x;
#pragma unroll 1
    for (int step = 0; step < NSTEP; ++step) {
        int ph = 0, l = 0;
        if (step > 0) { const int s1 = step - 1; l = s1 / 7; ph = 1 + s1 % 7; }
        if (ph == 0) ph_prologue(p, lds, bid, nblk);
        else if (ph == 1) ph_lnpass(p, l, bid, nblk);
        else if (l < 2) {
            if (ph == 2) {
                pg8::Gemm g{p.ml, p.wi_t + (size_t)l * NPAD * D, ROWS, NPAD, D}; pg8::StaticOrder S; S.init(ROWS, NPAD, nblk, bid);
                EpiProj E{p.raw, p.rest};
                pg8::gemm_phase<EpiProj, pg8::StaticOrder, true, true>(lds, g, S, E);
            } else if (ph == 3) ph_conv(p, l, bid, nblk);
            else if (ph == 4) ph_prep(p, lds, l, bid, nblk);
            else if (ph == 5) ph_mix(p, lds, l, bid, nblk);
            else if (ph == 6) ph_gate(p, l, bid, nblk);
            else {
                pg8::Gemm g{p.mix, p.wo_t + (size_t)l * D * D, ROWS, D, D}; pg8::StaticOrder S; S.init(ROWS, D, nblk, bid);
                EpiRes E{l == 0 ? p.x : p.out, p.ctx, p.out, p.xc1, p.mods, l};
                pg8::gemm_phase<EpiRes, pg8::StaticOrder, true, true>(lds, g, S, E);
            }
        }
        grid.sync();
    }
}

extern "C" void kernel_launch(void* const* d_in, const int* in_sizes, int n_in, void* d_out, int out_size, void* d_ws, size_t ws_size,
                              hipStream_t stream) {
    P p{};
    p.x = (const float*)d_in[0]; p.c = (const float*)d_in[1]; p.ctx = (const float*)d_in[2]; p.c_ctx = (const float*)d_in[3];
    p.w_mod = (const float*)d_in[4]; p.b_mod = (const float*)d_in[5]; p.w_in = (const float*)d_in[6]; p.conv_w = (const float*)d_in[7];
    p.a_log = (const float*)d_in[8]; p.dt_bias = (const float*)d_in[9]; p.gdn_norm = (const float*)d_in[10]; p.rpb = (const float*)d_in[11];
    p.gla_w2 = (const float*)d_in[12]; p.gla_b2 = (const float*)d_in[13]; p.gla_norm = (const float*)d_in[14]; p.w_out = (const float*)d_in[15];
    p.ln_g = (const float*)d_in[16]; p.ln_b = (const float*)d_in[17];
    p.out = (float*)d_out;
    unsigned char* w = (unsigned char*)d_ws;
    size_t off = 0;
    auto take = [&](size_t bytes) { unsigned char* r = w + off; off += (bytes + 255) & ~(size_t)255; return r; };
    p.mods = (float*)take((size_t)2 * 9 * 3072 * 4);
    p.xc1 = (float*)take((size_t)BATCH * CTX * D * 4);
    p.wi_t = (bf16*)take((size_t)2 * NPAD * D * 2);
    p.wo_t = (bf16*)take((size_t)2 * D * D * 2);
    p.rest = (bf16*)take((size_t)ROWS * NREST * 2);
    p.raw = (bf16*)take((size_t)ROWS * NRAW * 2);
    p.qkvn = (bf16*)take((size_t)ROWS * NRAW * 2);
    p.mix = p.qkvn;
    p.oa = (bf16*)take((size_t)2 * ROWS * 512 * 2);
    p.oc = (bf16*)take((size_t)2 * ROWS * 256 * 2);
    p.ml = p.oa;
    p.vtb = (bf16*)take((size_t)ROWS * 256 * 2);
    static int grid_blocks = 0;
    if (!grid_blocks) {
        if (off > ws_size) { fprintf(stderr, "workspace too small: need %zu have %zu\n", off, ws_size); grid_blocks = -1; return; }
        int dev = 0, cus = 0, per_cu = 0;
        hipGetDevice(&dev);
        hipDeviceGetAttribute(&cus, hipDeviceAttributeMultiprocessorCount, dev);
        if (hipFuncSetAttribute((const void*)k_mega, hipFuncAttributeMaxDynamicSharedMemorySize, LDS_BYTES) != hipSuccess) { fprintf(stderr, "hipFuncSetAttribute failed\n"); grid_blocks = -1; return; }
        hipOccupancyMaxActiveBlocksPerMultiprocessor(&per_cu, (const void*)k_mega, NTHREADS, LDS_BYTES);
        if (per_cu < 1) { fprintf(stderr, "occupancy query says %d blocks per CU\n", per_cu); grid_blocks = -1; return; }
        grid_blocks = cus;
    }
    if (grid_blocks < 0) return;
    void* args[] = {&p};
    hipError_t e = hipLaunchCooperativeKernel((void*)k_mega, dim3(grid_blocks), dim3(NTHREADS), args, LDS_BYTES, stream);
    if (e != hipSuccess) fprintf(stderr, "cooperative launch failed: %s (grid %d)\n", hipGetErrorString(e), grid_blocks);
}
```

```cpp
#include <hip/hip_runtime.h>
#include <hip/hip_cooperative_groups.h>
#include <cstdio>
#include <cstdint>
namespace cg = cooperative_groups;
#ifndef PROBE
#define PROBE 0
#endif
#ifndef TPROBE
#define TPROBE -1
#endif

constexpr int D = 1024, BATCH = 8, SEQ = 4096, CTX = 256, TOK = 4352, NPROJ = 3888;
constexpr int ROWS = BATCH * TOK;
constexpr int NRAW = 1536, NREST = 2352, NPAD = 4096;
constexpr int NTHREADS = 512, NWAVES = 8;
constexpr int LDS_BYTES = 147456;
constexpr float ALPHA = 1.4142135623730951f;
constexpr int RC_AB = 0, RC_AZ = 16, RC_BQ = 528, RC_BK = 784, RC_BV = 1040, RC_BZ = 1296, RC_CQ = 1552, RC_CK = 1680, RC_CV = 1808, RC_CR = 2064, RC_CZ = 2096;

typedef unsigned short bf16;
typedef float f32x4_t __attribute__((ext_vector_type(4)));

struct P {
    const float *x, *c, *ctx, *c_ctx, *w_mod, *b_mod, *w_in, *conv_w, *a_log, *dt_bias, *gdn_norm, *rpb,
        *gla_w2, *gla_b2, *gla_norm, *w_out, *ln_g, *ln_b;
    float* out;
    float *mods, *xc1, *stats;
    bf16 *wi_t, *wo_t, *rest, *raw, *qkvn, *mix, *ml, *oa, *oc, *vtb;
};

__device__ __forceinline__ float bf2f(unsigned short u) { return __uint_as_float((unsigned)u << 16); }
__device__ __forceinline__ unsigned short f2bf(float f) { unsigned u = __float_as_uint(f); return (unsigned short)((u + 0x7fffu + ((u >> 16) & 1u)) >> 16); }
__device__ __forceinline__ unsigned pk2(float lo, float hi) { return (unsigned)f2bf(lo) | ((unsigned)f2bf(hi) << 16); }
__device__ __forceinline__ float bflo(unsigned w) { return __uint_as_float(w << 16); }
__device__ __forceinline__ float bfhi(unsigned w) { return __uint_as_float(w & 0xffff0000u); }
__device__ __forceinline__ void unpack8(uint4 w, float* f) {
    f[0] = bflo(w.x); f[1] = bfhi(w.x); f[2] = bflo(w.y); f[3] = bfhi(w.y); f[4] = bflo(w.z); f[5] = bfhi(w.z); f[6] = bflo(w.w); f[7] = bfhi(w.w);
}
__device__ __forceinline__ float silu_f(float x) { return x / (1.f + expf(-x)); }
__device__ __forceinline__ float wave_sum(float v) {
#pragma unroll
    for (int o = 32; o > 0; o >>= 1) v += __shfl_xor(v, o);
    return v;
}
__device__ __forceinline__ float wave_max(float v) {
#pragma unroll
    for (int o = 32; o > 0; o >>= 1) v = fmaxf(v, __shfl_xor(v, o));
    return v;
}
__device__ __forceinline__ int mk_tid() { int t = threadIdx.x; asm volatile("" : "+v"(t)); return t; }
__device__ __forceinline__ int tok_of(int dir, int s) { return dir == 0 ? s : (s < CTX ? CTX - 1 - s : TOK + CTX - 1 - s); }

namespace pg8 {
#define PG8_LAS __attribute__((address_space(3)))
typedef unsigned short bf16_t;
typedef short bf16x8 __attribute__((ext_vector_type(8)));
typedef float f32x4 __attribute__((ext_vector_type(4)));
typedef unsigned u32x4 __attribute__((ext_vector_type(4)));
constexpr int BM = 256, BK = 64, HALF = 128, HTB = HALF * BK * 2  , STAGE_BYTES = 8 * HTB, NXCD = 8, WGM = 8;

__host__ __device__ __forceinline__ int lds_byte(int r, int c) { const int st = (r >> 4) * 2 + (c >> 5), rr = r & 15, cc = c & 31, ob = rr * 64 + cc * 2; return st * 1024 + (ob ^ (((ob >> 9) & 1) << 5)); }
__host__ __device__ __forceinline__ void stage_rc(int b, int& R, int& C) { const int st = b / 1024, sb = b % 1024, swz = sb ^ (((sb >> 9) & 1) << 5); R = (st >> 1) * 16 + swz / 64; C = (st & 1) * 32 + (swz % 64) / 2; }
__host__ __device__ __forceinline__ int perm32(int rho) { const int n = rho >> 4, i = rho & 15; return 8 * (i >> 2) + 4 * n + (i & 3); }

struct Unit { int pm, pn; };
struct Gemm { const bf16_t* A; const bf16_t* Bt; int M, N, K; };

struct StaticOrder {
    int nM, nN, nwg, G, c;
    __host__ __device__ void init(int M, int N, int G_, int c_) { nM = M / BM; nN = N / BM; nwg = nM * nN; G = G_; c = c_; }
    __host__ __device__ bool next(int i, Unit& u) const {
        const long L = (long)i * G + c; if (L >= nwg) return false;
        int wgid = (int)L; { const int q = nwg / NXCD, r = nwg % NXCD, xcd = wgid % NXCD, off = wgid / NXCD; wgid = (xcd < r ? xcd * (q + 1) : r * (q + 1) + (xcd - r) * q) + off; }
        const int nig = WGM * nN, gid = wgid / nig, fm = gid * WGM, gsz = (nM - fm) < WGM ? (nM - fm) : WGM;
        u.pm = fm + ((wgid % nig) % gsz); u.pn = (wgid % nig) / gsz; return true;
    }
    __device__ __forceinline__ void a_ready(const Unit&) const {}
    __device__ __forceinline__ void done(const Unit&) const {}
};

__device__ __forceinline__ unsigned cvt_pk_bf16(float lo, float hi) { unsigned r; asm volatile("v_cvt_pk_bf16_f32 %0, %1, %2" : "=v"(r) : "v"(lo), "v"(hi)); return r; }
template <class Epi, class Sched, bool ALIGN_EPI = false, bool SP2 = false>
__device__ __forceinline__ void gemm_phase(PG8_LAS unsigned char* lds, const Gemm g, const Sched& S, const Epi& E) {
    const int tid = mk_tid(), wid = __builtin_amdgcn_readfirstlane(tid >> 6), lane = tid & 63, wr = wid >> 2, wc = wid & 3, fr = lane & 15, fq = lane >> 4;
    const int K = g.K, nt = K / BK;
    unsigned voffA[2], voffB[2];
#pragma unroll
    for (int i = 0; i < 2; ++i) { int R, C; stage_rc(tid * 16 + i * 8192, R, C); const int Rb = Epi::PERM ? ((R & ~31) + perm32(R & 31)) : R;
        voffA[i] = (unsigned)(R * K + C) * 2u; voffB[i] = (unsigned)(Rb * K + C) * 2u; }
    const size_t kstep = (size_t)(BK * 2);
    const size_t hstep = (size_t)HALF * K * 2;
    const size_t tstep = 2 * hstep;
    const unsigned ldsw = (unsigned)wid * 1024u;
    const int aoff = lds_byte(wr * 64 + fr, fq * 8), boff = lds_byte(wc * 32 + fr, fq * 8);
#define PG8_SA(b, h) (((b) * 2 + (h)) * HTB)
#define PG8_SB(b, h) ((4 + (b) * 2 + (h)) * HTB)
#define PG8_STAGE(bufoff, gbase, voff) do { _Pragma("unroll") for (int _i = 0; _i < 2; ++_i) \
        __builtin_amdgcn_global_load_lds((const unsigned*)((const char*)(gbase) + (voff)[_i]), (PG8_LAS unsigned*)(lds + (bufoff) + ldsw + _i * 8192), 16, 0, 0); } while (0)
#define PG8_LDA(dst, b, h) do { _Pragma("unroll") for (int m = 0; m < 4; ++m) _Pragma("unroll") for (int k = 0; k < 2; ++k) dst[m][k] = *(const PG8_LAS bf16x8*)(lds + PG8_SA(b, h) + aoff + m * 2048 + k * 1024); } while (0)
#define PG8_LDB(dst, b, h) do { _Pragma("unroll") for (int n = 0; n < 2; ++n) _Pragma("unroll") for (int k = 0; k < 2; ++k) dst[n][k] = *(const PG8_LAS bf16x8*)(lds + PG8_SB(b, h) + boff + n * 2048 + k * 1024); } while (0)
#define PG8_MMA(ai, bj, At, Bt) do { __builtin_amdgcn_s_setprio(1); _Pragma("unroll") for (int m = 0; m < 4; ++m) _Pragma("unroll") for (int n = 0; n < 2; ++n) _Pragma("unroll") for (int k = 0; k < 2; ++k) \
        acc[ai][bj][m][n] = __builtin_amdgcn_mfma_f32_16x16x32_bf16(Bt[n][k], At[m][k], acc[ai][bj][m][n], 0, 0, 0); __builtin_amdgcn_s_setprio(0); } while (0)
#define PG8_WAIT_V(n) asm volatile("s_waitcnt vmcnt(" #n ")" ::: "memory")
#define PG8_WAIT_L(n) asm volatile("s_waitcnt lgkmcnt(" #n ")" ::: "memory")
#define PG8_BAR __builtin_amdgcn_s_barrier()
#define PG8_SCHED __builtin_amdgcn_sched_barrier(0)
    Unit cur, nxt; int ui = 0;
    if (!S.next(0, cur)) return;
    f32x4 acc[2][2][4][2];
#pragma unroll
    for (int a = 0; a < 2; ++a)
#pragma unroll
        for (int b = 0; b < 2; ++b)
#pragma unroll
            for (int m = 0; m < 4; ++m)
#pragma unroll
                for (int n = 0; n < 2; ++n) acc[a][b][m][n] = (f32x4){0.f, 0.f, 0.f, 0.f};
    bf16x8 At[4][2], B0[2][2], B1[2][2];
    const char* cA = (const char*)g.A + (size_t)cur.pm * tstep; const char* cB = (const char*)g.Bt + (size_t)cur.pn * tstep;
    S.a_ready(cur);
    if constexpr (SP2) {
        PG8_STAGE(PG8_SB(0, 0), cB, voffB); PG8_STAGE(PG8_SB(0, 1), cB + hstep, voffB); PG8_STAGE(PG8_SA(0, 0), cA, voffA); PG8_STAGE(PG8_SA(0, 1), cA + hstep, voffA);
        if (wr == 1) PG8_BAR;
        PG8_WAIT_V(2); PG8_BAR;
        PG8_STAGE(PG8_SB(1, 0), cB + kstep, voffB); PG8_STAGE(PG8_SA(1, 0), cA + kstep, voffA); PG8_STAGE(PG8_SB(1, 1), cB + hstep + kstep, voffB);
        PG8_WAIT_V(6); PG8_BAR;
    } else {
        PG8_STAGE(PG8_SB(0, 0), cB, voffB); PG8_STAGE(PG8_SA(0, 0), cA, voffA); PG8_STAGE(PG8_SB(0, 1), cB + hstep, voffB); PG8_STAGE(PG8_SA(0, 1), cA + hstep, voffA);
        if (wr == 1) PG8_BAR;
        PG8_WAIT_V(4); PG8_BAR;
        PG8_STAGE(PG8_SB(1, 0), cB + kstep, voffB); PG8_STAGE(PG8_SA(1, 0), cA + kstep, voffA); PG8_STAGE(PG8_SB(1, 1), cB + hstep + kstep, voffB);
        PG8_WAIT_V(6); PG8_BAR;
    }
    for (;;) {
        const bool has_next = S.next(ui + 1, nxt);
        const char* nA = has_next ? (const char*)g.A + (size_t)nxt.pm * tstep : cA; const char* nB = has_next ? (const char*)g.Bt + (size_t)nxt.pn * tstep : cB;
        for (int t = 0; t < nt; t += 2) {
            const bool last = (t == nt - 2);
            const char* a1 = cA + (size_t)(t + 1) * kstep;
            const char* a2 = last ? nA : cA + (size_t)(t + 2) * kstep; const char* b2 = last ? nB : cB + (size_t)(t + 2) * kstep;
            const char* a3 = a2 + kstep; const char* b3 = b2 + kstep;
            if (last && has_next) S.a_ready(nxt);
            if constexpr (SP2) {
            PG8_LDB(B0, 0, 0); PG8_LDB(B1, 0, 1); PG8_SCHED; PG8_LDA(At, 0, 0); PG8_STAGE(PG8_SA(1, 1), a1 + hstep, voffA);
            PG8_WAIT_V(8); PG8_WAIT_L(0); PG8_BAR; PG8_MMA(0, 0, At, B0); PG8_MMA(0, 1, At, B1); PG8_BAR; PG8_SCHED;
            PG8_LDA(At, 0, 1); PG8_STAGE(PG8_SB(0, 0), b2, voffB); PG8_STAGE(PG8_SB(0, 1), b2 + hstep, voffB); PG8_STAGE(PG8_SA(0, 0), a2, voffA);
            PG8_WAIT_V(8); PG8_WAIT_L(0); PG8_BAR; PG8_MMA(1, 0, At, B0); PG8_MMA(1, 1, At, B1); PG8_BAR; PG8_SCHED;
            PG8_LDB(B0, 1, 0); PG8_LDB(B1, 1, 1); PG8_SCHED; PG8_LDA(At, 1, 0); PG8_STAGE(PG8_SA(0, 1), a2 + hstep, voffA);
            PG8_WAIT_V(8); PG8_WAIT_L(0); PG8_BAR; PG8_MMA(0, 0, At, B0); PG8_MMA(0, 1, At, B1); PG8_BAR; PG8_SCHED;
            PG8_LDA(At, 1, 1); PG8_STAGE(PG8_SB(1, 0), b3, voffB); PG8_STAGE(PG8_SB(1, 1), b3 + hstep, voffB); PG8_STAGE(PG8_SA(1, 0), a3, voffA);
            PG8_WAIT_V(8); PG8_WAIT_L(0); PG8_BAR; PG8_MMA(1, 0, At, B0); PG8_MMA(1, 1, At, B1); PG8_BAR; PG8_SCHED;
            } else {
            PG8_LDB(B0, 0, 0); PG8_SCHED; PG8_LDA(At, 0, 0); PG8_STAGE(PG8_SA(1, 1), a1 + hstep, voffA);
            PG8_WAIT_L(8); PG8_BAR; PG8_WAIT_L(0); PG8_MMA(0, 0, At, B0); PG8_BAR; PG8_SCHED;
            PG8_LDB(B1, 0, 1); PG8_STAGE(PG8_SB(0, 0), b2, voffB);
            PG8_BAR; PG8_WAIT_L(0); PG8_MMA(0, 1, At, B1); PG8_BAR;
            PG8_LDA(At, 0, 1); PG8_STAGE(PG8_SA(0, 0), a2, voffA);
            PG8_BAR; PG8_WAIT_L(0); PG8_MMA(1, 0, At, B0); PG8_BAR; PG8_SCHED;
            PG8_STAGE(PG8_SB(0, 1), b2 + hstep, voffB);
            PG8_WAIT_V(6); PG8_BAR; PG8_MMA(1, 1, At, B1); PG8_BAR;
            PG8_LDB(B0, 1, 0); PG8_SCHED; PG8_LDA(At, 1, 0); PG8_STAGE(PG8_SA(0, 1), a2 + hstep, voffA);
            PG8_WAIT_L(8); PG8_BAR; PG8_WAIT_L(0); PG8_MMA(0, 0, At, B0); PG8_BAR; PG8_SCHED;
            PG8_LDB(B1, 1, 1); PG8_STAGE(PG8_SB(1, 0), b3, voffB);
            PG8_BAR; PG8_WAIT_L(0); PG8_MMA(0, 1, At, B1); PG8_BAR;
            PG8_LDA(At, 1, 1); PG8_STAGE(PG8_SA(1, 0), a3, voffA);
            PG8_BAR; PG8_WAIT_L(0); PG8_MMA(1, 0, At, B0); PG8_BAR; PG8_SCHED;
            PG8_STAGE(PG8_SB(1, 1), b3 + hstep, voffB);
            PG8_WAIT_V(6); PG8_BAR; PG8_MMA(1, 1, At, B1); PG8_BAR;
            }
        }
        if constexpr (ALIGN_EPI) { if (wr == 0) PG8_BAR; }
        if constexpr (!Epi::AFTER_DRAIN) { E(acc, cur, wr, wc, fr, fq); S.done(cur); }
        if (!has_next) break;
#pragma unroll
        for (int a = 0; a < 2; ++a)
#pragma unroll
            for (int b = 0; b < 2; ++b)
#pragma unroll
                for (int m = 0; m < 4; ++m)
#pragma unroll
                    for (int n = 0; n < 2; ++n) acc[a][b][m][n] = (f32x4){0.f, 0.f, 0.f, 0.f};
        cur = nxt; cA = nA; cB = nB; ++ui;
        if constexpr (ALIGN_EPI) { if (wr == 1) PG8_BAR; }
    }
    PG8_WAIT_V(0);
    if constexpr (!ALIGN_EPI) { if (wr == 0) PG8_BAR; }
    PG8_BAR;
    if constexpr (Epi::AFTER_DRAIN) { E.fused(acc, cur, wr, wc, fr, fq, lds, wid, lane); S.done(cur); }
#undef PG8_SA
#undef PG8_SB
#undef PG8_STAGE
#undef PG8_LDA
#undef PG8_LDB
#undef PG8_MMA
#undef PG8_WAIT_V
#undef PG8_WAIT_L
#undef PG8_BAR
#undef PG8_SCHED
}
}

#define LASP __attribute__((address_space(3)))

struct EpiProj {
    static constexpr bool PERM = true, AFTER_DRAIN = false;
    bf16* raw; bf16* rest;
    __device__ __forceinline__ void operator()(const pg8::f32x4 (&acc)[2][2][4][2], const pg8::Unit& u, int wr, int wc, int fr, int fq) const {
        const int row0 = u.pm * 256 + wr * 64 + fr;
        const int colb = u.pn * 256 + wc * 32 + 8 * fq;
#pragma unroll
        for (int bj = 0; bj < 2; ++bj) {
            const int col = colb + bj * 128;
            if (col >= NPROJ) continue;
            bf16* base; int ld;
            if (col < NRAW) { base = raw + col; ld = NRAW; } else { base = rest + (col - NRAW); ld = NREST; }
#pragma unroll
            for (int ai = 0; ai < 2; ++ai)
#pragma unroll
                for (int m = 0; m < 4; ++m) {
                    const pg8::f32x4 v0 = acc[ai][bj][m][0], v1 = acc[ai][bj][m][1];
                    pg8::u32x4 w; w.x = pg8::cvt_pk_bf16(v0[0], v0[1]); w.y = pg8::cvt_pk_bf16(v0[2], v0[3]); w.z = pg8::cvt_pk_bf16(v1[0], v1[1]); w.w = pg8::cvt_pk_bf16(v1[2], v1[3]);
                    *(pg8::u32x4*)(base + (size_t)(row0 + ai * 128 + m * 16) * ld) = w;
                }
        }
    }
};
struct EpiRes {
    static constexpr bool PERM = false, AFTER_DRAIN = false;
    const float* xl_src; const float* xc_src; float* out; float* xc1; const float* mods; int l;
    __device__ __forceinline__ void operator()(const pg8::f32x4 (&acc)[2][2][4][2], const pg8::Unit& u, int wr, int wc, int fr, int fq) const {
        const int row0 = u.pm * 256 + wr * 64 + fr, col0 = u.pn * 256 + wc * 32 + 4 * fq;
#pragma unroll
        for (int ai = 0; ai < 2; ++ai)
#pragma unroll
            for (int m = 0; m < 4; ++m) {
                const int r = row0 + ai * 128 + m * 16;
                const int b = r / TOK, t = r - b * TOK;
                const float* src; float* dst; int s;
                if (t < CTX) { if (l != 0) continue; src = xc_src + ((size_t)b * CTX + t) * D; dst = xc1 + ((size_t)b * CTX + t) * D; s = 8; }
                else { src = xl_src + ((size_t)b * SEQ + (t - CTX)) * D; dst = out + ((size_t)b * SEQ + (t - CTX)) * D; s = b; }
                const float* gt = mods + (size_t)(l * 9 + s) * 3072 + 2048;
#pragma unroll
                for (int bj = 0; bj < 2; ++bj)
#pragma unroll
                    for (int n = 0; n < 2; ++n) {
                        const int c = col0 + bj * 128 + n * 16;
                        const pg8::f32x4 xv = *(const pg8::f32x4*)(src + c), g = *(const pg8::f32x4*)(gt + c);
                        *(pg8::f32x4*)(dst + c) = xv * ALPHA + g * acc[ai][bj][m][n];
                    }
            }
    }
};

__device__ __forceinline__ void transpose_item(const float* W, int K, int N, bf16* WT, LASP float* scr, int item, int lane) {
    const int nblk = (N + 31) / 32, kb = item / nblk, nb = item % nblk, k0 = 64 * kb, n0 = 32 * nb;
    const bool nok = (n0 + (lane & 31)) < N;
#pragma unroll 8
    for (int i = 0; i < 32; ++i) { const int kk = 2 * i + (lane >> 5); scr[kk * 33 + (lane & 31)] = nok ? W[(size_t)(k0 + kk) * N + n0 + (lane & 31)] : 0.f; }
    asm volatile("s_waitcnt lgkmcnt(0)" ::: "memory");
    const int c = lane & 7;
#pragma unroll
    for (int j = 0; j < 4; ++j) {
        const int n = (lane >> 3) + 8 * j; const LASP float* s = scr + (8 * c) * 33 + n;
        uint4 o; o.x = pk2(s[0 * 33], s[1 * 33]); o.y = pk2(s[2 * 33], s[3 * 33]); o.z = pk2(s[4 * 33], s[5 * 33]); o.w = pk2(s[6 * 33], s[7 * 33]);
        *(uint4*)(WT + (size_t)(n0 + n) * K + k0 + 8 * c) = o;
    }
    asm volatile("s_waitcnt lgkmcnt(0)" ::: "memory");
}

__device__ void ph_prologue(const P& p, LASP unsigned char* lds, int bid, int nblk) {
    const int tid = mk_tid(), lane = tid & 63, wave = tid >> 6;
    LASP float* sm = (LASP float*)lds;
    if (bid * NTHREADS < 2 * 3072) {
        for (int i = tid; i < 9 * 1024; i += NTHREADS) {
            int s = i >> 10, d = i & 1023;
            float cv = s < 8 ? p.c[s * 1024 + d] : p.c_ctx[d];
            sm[i] = silu_f(cv);
        }
        __syncthreads();
        for (int o = bid * NTHREADS + tid; o < 2 * 3072; o += nblk * NTHREADS) {
            int l = o / 3072, j = o % 3072;
            const float* w = p.w_mod + (size_t)l * 1024 * 3072 + j;
            float acc[9];
#pragma unroll
            for (int s = 0; s < 9; ++s) acc[s] = 0.f;
            for (int i = 0; i < 1024; ++i) {
                float wv = w[(size_t)i * 3072];
#pragma unroll
                for (int s = 0; s < 9; ++s) acc[s] += sm[s * 1024 + i] * wv;
            }
            float bb = p.b_mod[l * 3072 + j];
#pragma unroll
            for (int s = 0; s < 9; ++s) p.mods[(size_t)(l * 9 + s) * 3072 + j] = acc[s] + bb;
        }
        __syncthreads();
    }
#if PROBE
    if (bid == 0 && tid < 4) p.stats[tid] = 0.f;
#endif
    LASP float* scr = (LASP float*)(lds + 40960 + wave * 8704);
    const int gw = (nblk - 1 - bid) * NWAVES + wave, NGW = nblk * NWAVES;
    constexpr int I_IN = 16 * 122, I_OUT = 16 * 32;
    for (int it = gw; it < 2 * (I_IN + I_OUT); it += NGW) {
        int l = it / (I_IN + I_OUT), r = it % (I_IN + I_OUT);
        if (r < I_IN) transpose_item(p.w_in + (size_t)l * D * NPROJ, D, NPROJ, p.wi_t + (size_t)l * NPAD * D, scr, r, lane);
        else transpose_item(p.w_out + (size_t)l * D * D, D, D, p.wo_t + (size_t)l * D * D, scr, r - I_IN, lane);
    }
    for (int i = bid * NTHREADS + tid; i < 2 * 192 * 128; i += nblk * NTHREADS) {
        int l = i / (192 * 128), r = i % (192 * 128);
        *(uint4*)(p.wi_t + (size_t)l * NPAD * D + (size_t)3904 * D + (size_t)r * 8) = make_uint4(0, 0, 0, 0);
    }
}

__device__ void ph_lnpass(const P& p, int mode, int bid, int nblk) {
    const int tid = mk_tid();
    const int lane = tid & 63, wave = tid >> 6;
    for (int r = bid * NWAVES + wave; r < ROWS; r += nblk * NWAVES) {
        const int b = r / TOK, t = r - b * TOK;
        const bool isc = t < CTX;
        if (mode == 2 && isc) continue;
        float* buf; const float* src; int s;
        if (isc) { buf = p.xc1 + ((size_t)b * CTX + t) * D; src = (mode == 0) ? p.ctx + ((size_t)b * CTX + t) * D : buf; s = 8; }
        else { buf = p.out + ((size_t)b * SEQ + (t - CTX)) * D; src = (mode == 0) ? p.x + ((size_t)b * SEQ + (t - CTX)) * D : buf; s = b; }
        f32x4_t v[4];
#pragma unroll
        for (int j = 0; j < 4; ++j) v[j] = *(const f32x4_t*)(src + 256 * j + 4 * lane);
        if (mode >= 1) {
            const int lp = mode - 1;
            float sum = 0.f;
#pragma unroll
            for (int j = 0; j < 4; ++j) sum += (v[j].x + v[j].y) + (v[j].z + v[j].w);
            const float mu = wave_sum(sum) * (1.f / 1024.f);
            float sq = 0.f;
#pragma unroll
            for (int j = 0; j < 4; ++j) { v[j] = v[j] - mu; sq += (v[j].x * v[j].x + v[j].y * v[j].y) + (v[j].z * v[j].z + v[j].w * v[j].w); }
            const float rs = 1.f / sqrtf(wave_sum(sq) * (1.f / 1024.f) + 1e-6f);
#pragma unroll
            for (int j = 0; j < 4; ++j) {
                const f32x4_t g = *(const f32x4_t*)(p.ln_g + lp * 1024 + 256 * j + 4 * lane), bb = *(const f32x4_t*)(p.ln_b + lp * 1024 + 256 * j + 4 * lane);
                v[j] = v[j] * rs * g + bb;
#if PROBE
                if (mode == 2) v[j] = v[j] + (p.stats[0] / fmaxf(p.stats[1], 1e-20f));
#endif
#if TPROBE >= 0
                if (mode == 2) v[j] = v[j] + exp2f(rintf(log2f(fmaxf(p.stats[2], 1.f)) * 6.f) * (1.f / 6.f)) * 1e-4f;
#endif
                *(f32x4_t*)(buf + 256 * j + 4 * lane) = v[j];
            }
            if (mode == 2) continue;
        }
        const int l = mode;
        float sum = 0.f;
#pragma unroll
        for (int j = 0; j < 4; ++j) sum += (v[j].x + v[j].y) + (v[j].z + v[j].w);
        const float mu = wave_sum(sum) * (1.f / 1024.f);
        float sq = 0.f;
#pragma unroll
        for (int j = 0; j < 4; ++j) { v[j] = v[j] - mu; sq += (v[j].x * v[j].x + v[j].y * v[j].y) + (v[j].z * v[j].z + v[j].w * v[j].w); }
        const float rs = 1.f / sqrtf(wave_sum(sq) * (1.f / 1024.f) + 1e-6f);
        const float* md = p.mods + (size_t)(l * 9 + s) * 3072;
#pragma unroll
        for (int j = 0; j < 4; ++j) {
            const f32x4_t sh = *(const f32x4_t*)(md + 256 * j + 4 * lane), sc = *(const f32x4_t*)(md + 1024 + 256 * j + 4 * lane);
            const f32x4_t o = v[j] * rs * (sc + 1.f) + sh;
            uint2 w; w.x = pk2(o.x, o.y); w.y = pk2(o.z, o.w);
            *(uint2*)(p.ml + (size_t)r * D + 256 * j + 4 * lane) = w;
        }
    }
}

__device__ void ph_conv(const P& p, int l, int bid, int nblk) {
    const int tid = mk_tid();
    const int lane = tid & 63, wave = tid >> 6;
    const float* cw = p.conv_w + (size_t)l * 5 * 1536;
    constexpr int NSTRIP = TOK / 16;
    for (int it = bid * NWAVES + wave; it < BATCH * NSTRIP * 3; it += nblk * NWAVES) {
        const int third = it % 3, rest_i = it / 3, strip = rest_i % NSTRIP, b = rest_i / NSTRIP;
        const int t0 = strip * 16;
        const int lo = t0 < CTX ? 0 : CTX, hi = t0 < CTX ? CTX : TOK;
        const int ch = third * 512 + lane * 8;
        float w[5][8];
#pragma unroll
        for (int j = 0; j < 5; ++j) {
            const f32x4_t a = *(const f32x4_t*)(cw + j * 1536 + ch), c = *(const f32x4_t*)(cw + j * 1536 + ch + 4);
            w[j][0] = a.x; w[j][1] = a.y; w[j][2] = a.z; w[j][3] = a.w; w[j][4] = c.x; w[j][5] = c.y; w[j][6] = c.z; w[j][7] = c.w;
        }
        const bf16* src = p.raw + ((size_t)b * TOK + t0) * NRAW + ch;
        bf16* dst = p.qkvn + ((size_t)b * TOK + t0) * NRAW + ch;
        uint4 rw[20];
#pragma unroll
        for (int i = 0; i < 20; ++i) {
            const int tt = t0 + i - 2;
            rw[i] = (tt >= lo && tt < hi) ? *(const uint4*)(src + (ptrdiff_t)(i - 2) * NRAW) : make_uint4(0, 0, 0, 0);
        }
        const int g = (ch >> 7);
        const float qs = g < 4 ? 0.08838834764831845f : 1.f;
#pragma unroll
        for (int n = 0; n < 16; ++n) {
            float acc[8];
#pragma unroll
            for (int e = 0; e < 8; ++e) acc[e] = 0.f;
#pragma unroll
            for (int j = 0; j < 5; ++j) {
                float f[8]; unpack8(rw[n + j], f);
#pragma unroll
                for (int e = 0; e < 8; ++e) acc[e] += w[j][e] * f[e];
            }
            float ss = 0.f;
#pragma unroll
            for (int e = 0; e < 8; ++e) { acc[e] = silu_f(acc[e]); ss += acc[e] * acc[e]; }
            if (g < 8) {
#pragma unroll
                for (int m = 8; m > 0; m >>= 1) ss += __shfl_xor(ss, m);
                const float sc = qs / sqrtf(ss + 1e-6f);
#pragma unroll
                for (int e = 0; e < 8; ++e) acc[e] *= sc;
            }
            uint4 o; o.x = pk2(acc[0], acc[1]); o.y = pk2(acc[2], acc[3]); o.z = pk2(acc[4], acc[5]); o.w = pk2(acc[6], acc[7]);
            *(uint4*)(dst + (size_t)n * NRAW) = o;
        }
    }
}

typedef short bf16x8_t __attribute__((ext_vector_type(8)));
typedef float f32x16_t __attribute__((ext_vector_type(16)));
typedef float f32x2_t __attribute__((ext_vector_type(2)));
typedef __bf16 bf16x2_t __attribute__((ext_vector_type(2)));
typedef unsigned u32x4_t __attribute__((ext_vector_type(4)));
#define MFMA32(a, b, c) __builtin_amdgcn_mfma_f32_32x32x16_bf16((a), (b), (c), 0, 0, 0)
__device__ __forceinline__ unsigned cvtpk(float lo, float hi) { f32x2_t v = {lo, hi}; bf16x2_t q = __builtin_convertvector(v, bf16x2_t); return __builtin_bit_cast(unsigned, q); }
__device__ __forceinline__ int crow(int reg, int h) { return (reg & 3) + 8 * (reg >> 2) + 4 * h; }
__device__ __forceinline__ int perm16(int a) { const int x = a & 15; return (a & ~15) + (x < 4 ? x : x < 8 ? x + 4 : x < 12 ? x - 4 : x); }
#define PACK8(x, s) __builtin_bit_cast(bf16x8_t, (u32x4_t){cvtpk((x)[8 * (s)], (x)[8 * (s) + 1]), cvtpk((x)[8 * (s) + 2], (x)[8 * (s) + 3]), cvtpk((x)[8 * (s) + 4], (x)[8 * (s) + 5]), cvtpk((x)[8 * (s) + 6], (x)[8 * (s) + 7])})
constexpr int GCH = 32, NCH = TOK / GCH;
constexpr int GP_ITEM = 4416;

__device__ void ph_gdnprep(const P& p, LASP unsigned char* lds, int l, int bid, int nblk, int tid) {
    const int lane = tid & 63, wave = tid >> 6, r = lane & 31, hh = lane >> 5;
    LASP float* Lm = (LASP float*)(lds + wave * 16384);
    LASP float* Xs = Lm + 2048;
    for (int it = bid * NWAVES + wave; it < BATCH * 4 * NCH; it += nblk * NWAVES) {
        const int c = it % NCH, bh = it / NCH, h = bh & 3, b = bh >> 2;
        const size_t row0 = (size_t)b * TOK + (size_t)c * GCH;
        f32x16_t KK, QK;
#pragma unroll
        for (int i = 0; i < 16; ++i) { KK[i] = 0.f; QK[i] = 0.f; }
        const bf16* kbase = p.qkvn + (row0 + r) * NRAW + 512 + h * 128 + 8 * hh;
        const bf16* qbase = p.qkvn + (row0 + r) * NRAW + h * 128 + 8 * hh;
#pragma unroll
        for (int s = 0; s < 8; ++s) {
            const bf16x8_t kf = *(const bf16x8_t*)(kbase + 16 * s), qf = *(const bf16x8_t*)(qbase + 16 * s);
            KK = MFMA32(kf, kf, KK);
            QK = MFMA32(qf, kf, QK);
        }
        float Gd, bd;
        {
            const bf16* ab = p.rest + (row0 + r) * NREST + RC_AB;
            const float a = bf2f(ab[hh * 4 + h]) + p.dt_bias[(l * 2 + hh) * 4 + h];
            const float sp = fmaxf(a, 0.f) + log1pf(expf(-fabsf(a)));
            Gd = -expf(p.a_log[(l * 2 + hh) * 4 + h]) * sp;
            bd = 1.f / (1.f + expf(-bf2f(ab[(2 + hh) * 4 + h])));
        }
#pragma unroll
        for (int off = 1; off < 32; off <<= 1) {
            const float up = __shfl_up(Gd, off, 32), dn = __shfl_down(Gd, off, 32);
            if (hh == 0) { if (r >= off) Gd += up; } else { if (r + off < 32) Gd += dn; }
        }
        unsigned char* gout = (unsigned char*)p.raw + ((size_t)(bh * 2) * NCH + c) * GP_ITEM;
        {
            const float Glast = __shfl(Gd, hh == 0 ? 31 : 32);
            float* sc = (float*)(gout + (size_t)hh * NCH * GP_ITEM + 4096);
            sc[r] = expf(Gd); sc[32 + r] = expf(Glast - Gd);
            if (r == 0) sc[64] = expf(Glast);
        }
        asm volatile("s_waitcnt lgkmcnt(0)" ::: "memory");
#pragma unroll
        for (int d = 0; d < 2; ++d) {
            const float Gcol = __shfl(Gd, d * 32 + r);
            bf16* qko = (bf16*)(gout + (size_t)d * NCH * GP_ITEM + 2048);
#pragma unroll
            for (int i = 0; i < 16; ++i) {
                const int n = crow(i, hh);
                const float Grow = __shfl(Gd, d * 32 + n), brow = __shfl(bd, d * 32 + n);
                const bool incl = d == 0 ? (r <= n) : (r >= n), strict = d == 0 ? (r < n) : (r > n);
                const float dec = expf(incl ? Grow - Gcol : 0.f);
                const float lv = strict ? brow * KK[i] * dec : 0.f;
                const float qv = incl ? QK[i] * dec : 0.f;
                const int n2 = d == 0 ? n : 31 - n, m2 = d == 0 ? r : 31 - r;
                Lm[(d * 32 + n2) * 32 + m2] = lv;
                qko[n * 32 + perm16(r)] = f2bf(qv);
                if ((i & 3) == 3) __builtin_amdgcn_sched_barrier(0);
            }
        }
        asm volatile("s_waitcnt lgkmcnt(0)" ::: "memory");
        {
            const LASP float* Lr = Lm + hh * 1024;
            LASP float* xc = Xs + lane;
#pragma unroll 4
            for (int j = 0; j < 32; ++j) xc[j * 64] = (j == r) ? 1.f : 0.f;
#pragma unroll 1
            for (int n = 1; n < 32; ++n) {
                float a0 = 0.f, a1 = 0.f;
#pragma unroll 1
                for (int j4 = 0; j4 < n; j4 += 4) {
                    const f32x4_t lv = *(const LASP f32x4_t*)(Lr + n * 32 + j4);
                    a0 += lv.x * xc[(j4 + 0) * 64]; a1 += lv.y * xc[(j4 + 1) * 64];
                    a0 += lv.z * xc[(j4 + 2) * 64]; a1 += lv.w * xc[(j4 + 3) * 64];
                }
                xc[n * 64] -= (a0 + a1);
            }
            const int mtok = hh == 0 ? r : 31 - r;
            const float bcol = __shfl(bd, hh * 32 + mtok);
            bf16* tq = (bf16*)(gout + (size_t)hh * NCH * GP_ITEM) + perm16(mtok) + (hh == 0 ? 0 : 31 * 32);
            const int tstep = hh == 0 ? 32 : -32;
#pragma unroll 4
            for (int n = 0; n < 32; ++n) { *tq = f2bf(xc[n * 64] * bcol); tq += tstep; }
        }
        asm volatile("s_waitcnt lgkmcnt(0)" ::: "memory");
    }
}


constexpr int ST_KA = 0, ST_QA = 8704, ST_KT = 17408, ST_V = 27648, ST_TP = 35840, ST_QK = 38400, ST_SC = 40960, ST_BYTES = 41344;
typedef unsigned u32x2_t __attribute__((ext_vector_type(2)));
struct GSlot { u32x4_t k0, k1, q0, q1, v0, v1, t; f32x4_t sc; };

__device__ __forceinline__ int gdn_chunk(int dir, int s) { return dir == 0 ? s : (s < 8 ? 7 - s : 143 - s); }
__device__ __forceinline__ void gdn_issue(const P& p, GSlot& g, int b, int h, int dir, int step, int tl) {
    const int c = gdn_chunk(dir, step);
    const size_t row0 = (size_t)b * TOK + (size_t)c * GCH;
    const int r0 = tl >> 4, c16 = tl & 15;
    const bf16* a0 = p.qkvn + (row0 + r0) * NRAW + h * 128 + 8 * c16;
    const bf16* a1 = a0 + (size_t)16 * NRAW;
    g.q0 = *(const u32x4_t*)a0; g.q1 = *(const u32x4_t*)a1;
    g.k0 = *(const u32x4_t*)(a0 + 512); g.k1 = *(const u32x4_t*)(a1 + 512);
    g.v0 = *(const u32x4_t*)(a0 + 1024); g.v1 = *(const u32x4_t*)(a1 + 1024);
    const unsigned char* gp = (const unsigned char*)p.raw + ((size_t)((b * 4 + h) * 2 + dir) * NCH + c) * GP_ITEM;
    g.t = *(const u32x4_t*)(gp + tl * 16);
    if (tl < 20) g.sc = *(const f32x4_t*)(gp + 4096 + tl * 16);
}
__device__ __forceinline__ void gdn_put_rows(LASP unsigned char* st, int row, int c16, u32x4_t kq, int off) {
    const int g = c16 >> 1, odd = c16 & 1;
    *(LASP u32x2_t*)(st + off + row * 272 + (16 * g + (odd ? 4 : 0)) * 2) = (u32x2_t){kq.x, kq.y};
    *(LASP u32x2_t*)(st + off + row * 272 + (16 * g + (odd ? 12 : 8)) * 2) = (u32x2_t){kq.z, kq.w};
}
__device__ __forceinline__ void gdn_put_kt(LASP unsigned char* st, int row, int c16, u32x4_t k) {
    LASP unsigned short* kt = (LASP unsigned short*)(st + ST_KT) + perm16(row);
    const int d0 = 8 * c16;
    kt[(d0 + 0) * 40] = (unsigned short)(k.x & 0xffffu); kt[(d0 + 1) * 40] = (unsigned short)(k.x >> 16);
    kt[(d0 + 2) * 40] = (unsigned short)(k.y & 0xffffu); kt[(d0 + 3) * 40] = (unsigned short)(k.y >> 16);
    kt[(d0 + 4) * 40] = (unsigned short)(k.z & 0xffffu); kt[(d0 + 5) * 40] = (unsigned short)(k.z >> 16);
    kt[(d0 + 6) * 40] = (unsigned short)(k.w & 0xffffu); kt[(d0 + 7) * 40] = (unsigned short)(k.w >> 16);
}
__device__ __forceinline__ void gdn_write(LASP unsigned char* st, const GSlot& g, int tl) {
    const int r0 = tl >> 4, c16 = tl & 15;
    gdn_put_rows(st, r0, c16, g.k0, ST_KA); gdn_put_rows(st, r0 + 16, c16, g.k1, ST_KA);
    gdn_put_rows(st, r0, c16, g.q0, ST_QA); gdn_put_rows(st, r0 + 16, c16, g.q1, ST_QA);
    gdn_put_kt(st, r0, c16, g.k0); gdn_put_kt(st, r0 + 16, c16, g.k1);
    *(LASP u32x4_t*)(st + ST_V + r0 * 256 + c16 * 16) = g.v0;
    *(LASP u32x4_t*)(st + ST_V + (r0 + 16) * 256 + c16 * 16) = g.v1;
    { const int t2 = tl & 127; *(LASP u32x4_t*)(st + (tl < 128 ? ST_TP : ST_QK) + (t2 >> 2) * 80 + (t2 & 3) * 16) = g.t; }
    if (tl < 20) *(LASP f32x4_t*)(st + ST_SC + tl * 16) = g.sc;
}

__device__ void gdn_scan_fast(const P& p, LASP unsigned char* lds, int chain) {
    const int tid = mk_tid();
    const int lane = tid & 63, wave = __builtin_amdgcn_readfirstlane(tid >> 6);
    const int dir = chain & 1, h = (chain >> 1) & 3, b = chain >> 3;
    constexpr int NS = NCH;
    if (wave >= 4) {
        const int tl = tid - 256;
        GSlot g0, g1, g2, g3;
        gdn_issue(p, g0, b, h, dir, 0, tl); gdn_issue(p, g1, b, h, dir, 1, tl); gdn_issue(p, g2, b, h, dir, 2, tl); gdn_issue(p, g3, b, h, dir, 3, tl);
        gdn_write(lds, g0, tl); gdn_issue(p, g0, b, h, dir, 4, tl);
        __syncthreads();
#pragma unroll 1
        for (int s = 0; s < NS; s += 4) {
            gdn_write(lds + ((s + 1) & 1) * ST_BYTES, g1, tl); if (s + 5 < NS) gdn_issue(p, g1, b, h, dir, s + 5, tl);
            __syncthreads();
            gdn_write(lds + ((s + 2) & 1) * ST_BYTES, g2, tl); if (s + 6 < NS) gdn_issue(p, g2, b, h, dir, s + 6, tl);
            __syncthreads();
            gdn_write(lds + ((s + 3) & 1) * ST_BYTES, g3, tl); if (s + 7 < NS) gdn_issue(p, g3, b, h, dir, s + 7, tl);
            __syncthreads();
            if (s + 4 < NS) { gdn_write(lds + ((s + 4) & 1) * ST_BYTES, g0, tl); if (s + 8 < NS) gdn_issue(p, g0, b, h, dir, s + 8, tl); }
            __syncthreads();
        }
    } else {
        const int r = lane & 31, hh = lane >> 5, w = wave;
        f32x16_t S0, S1, S2, S3;
#pragma unroll
        for (int i = 0; i < 16; ++i) { S0[i] = 0.f; S1[i] = 0.f; S2[i] = 0.f; S3[i] = 0.f; }
        __syncthreads();
#pragma unroll 1
        for (int s = 0; s < NS; ++s) {
            LASP unsigned char* st = lds + (s & 1) * ST_BYTES;
            const bf16x8_t Sb00 = PACK8(S0, 0), Sb01 = PACK8(S0, 1), Sb10 = PACK8(S1, 0), Sb11 = PACK8(S1, 1);
            const bf16x8_t Sb20 = PACK8(S2, 0), Sb21 = PACK8(S2, 1), Sb30 = PACK8(S3, 0), Sb31 = PACK8(S3, 1);
            f32x16_t ak, aq;
#pragma unroll
            for (int i = 0; i < 16; ++i) { ak[i] = 0.f; aq[i] = 0.f; }
            const LASP unsigned char* ka = st + ST_KA + r * 272 + hh * 16;
            const LASP unsigned char* qa = st + ST_QA + r * 272 + hh * 16;
#define GDN_KQ(ks, SB) { const bf16x8_t A = *(const LASP bf16x8_t*)(ka + (ks) * 32); ak = MFMA32(A, SB, ak); const bf16x8_t A2 = *(const LASP bf16x8_t*)(qa + (ks) * 32); aq = MFMA32(A2, SB, aq); }
            GDN_KQ(0, Sb00) GDN_KQ(1, Sb01) GDN_KQ(2, Sb10) GDN_KQ(3, Sb11) GDN_KQ(4, Sb20) GDN_KQ(5, Sb21) GDN_KQ(6, Sb30) GDN_KQ(7, Sb31)
#undef GDN_KQ
            const LASP float* sc = (const LASP float*)(st + ST_SC);
            float ev[16], fv[16];
#pragma unroll
            for (int g = 0; g < 4; ++g) {
                const f32x4_t e4 = *(const LASP f32x4_t*)(sc + 8 * g + 4 * hh), f4 = *(const LASP f32x4_t*)(sc + 32 + 8 * g + 4 * hh);
                ev[4 * g] = e4.x; ev[4 * g + 1] = e4.y; ev[4 * g + 2] = e4.z; ev[4 * g + 3] = e4.w;
                fv[4 * g] = f4.x; fv[4 * g + 1] = f4.y; fv[4 * g + 2] = f4.z; fv[4 * g + 3] = f4.w;
            }
            const float gl = sc[64];
            const LASP unsigned short* vl = (const LASP unsigned short*)(st + ST_V) + 32 * w + r;
            f32x16_t rr;
#pragma unroll
            for (int i = 0; i < 16; ++i) rr[i] = bf2f(vl[crow(i, hh) * 128]) - ev[i] * ak[i];
            const bf16x8_t rb0 = PACK8(rr, 0), rb1 = PACK8(rr, 1);
            f32x16_t vn;
#pragma unroll
            for (int i = 0; i < 16; ++i) vn[i] = 0.f;
            const LASP unsigned char* tp = st + ST_TP + r * 80 + hh * 16;
            vn = MFMA32(*(const LASP bf16x8_t*)(tp), rb0, vn);
            vn = MFMA32(*(const LASP bf16x8_t*)(tp + 32), rb1, vn);
#pragma unroll
            for (int i = 0; i < 16; ++i) aq[i] *= ev[i];
            const bf16x8_t vb0 = PACK8(vn, 0), vb1 = PACK8(vn, 1);
            const LASP unsigned char* qk = st + ST_QK + r * 80 + hh * 16;
            aq = MFMA32(*(const LASP bf16x8_t*)(qk), vb0, aq);
            aq = MFMA32(*(const LASP bf16x8_t*)(qk + 32), vb1, aq);
            {
                const int c = gdn_chunk(dir, s);
                bf16* op = p.oa + ((size_t)dir * ROWS + (size_t)b * TOK + (size_t)c * GCH) * 512 + h * 128 + 32 * w + r;
#pragma unroll
                for (int i = 0; i < 16; ++i) op[(size_t)crow(i, hh) * 512] = f2bf(aq[i]);
            }
            f32x16_t vf;
#pragma unroll
            for (int i = 0; i < 16; ++i) vf[i] = vn[i] * fv[i];
            const bf16x8_t fb0 = PACK8(vf, 0), fb1 = PACK8(vf, 1);
            const LASP unsigned char* kt = st + ST_KT + r * 80 + hh * 16;
#define GDN_UPD(SX, mt) { _Pragma("unroll") for (int i = 0; i < 16; ++i) SX[i] *= gl; SX = MFMA32(*(const LASP bf16x8_t*)(kt + (mt) * 32 * 80), fb0, SX); SX = MFMA32(*(const LASP bf16x8_t*)(kt + (mt) * 32 * 80 + 32), fb1, SX); }
            GDN_UPD(S0, 0) GDN_UPD(S1, 1) GDN_UPD(S2, 2) GDN_UPD(S3, 3)
#undef GDN_UPD
            __syncthreads();
        }
    }
}


constexpr int GL_ITEM = 6272;
constexpr size_t GLA_PREP_OFF = (size_t)BATCH * 4 * 2 * NCH * GP_ITEM;

__device__ __forceinline__ void gla_prep_item(const P& p, LASP unsigned char* wl, const LASP float* cstab, int l, int it, int lane) {
    const int r = lane & 31, hh = lane >> 5;
    const int c = it % NCH, bh = it / NCH, h = bh & 3, b = bh >> 2;
    const size_t row0 = (size_t)b * TOK + (size_t)c * GCH;
    float qv[16], kv[16];
    {
        const bf16* qb = p.rest + (row0 + 4 * hh) * NREST + RC_CQ + h * 32 + r;
#pragma unroll
        for (int i = 0; i < 16; ++i) { const int no = (i & 3) + 8 * (i >> 2); qv[i] = bf2f(qb[(size_t)no * NREST]); kv[i] = bf2f(qb[(size_t)no * NREST + 128]); }
    }
    if (c >= 8) {
        const int dd = r & 15, f = dd & 7;
        const int prow = (c - 8) >> 1, pcol0 = 32 * ((c - 8) & 1);
#pragma unroll
        for (int i = 0; i < 16; ++i) {
            const int n = crow(i, hh);
            const int pos = r < 16 ? prow : pcol0 + n;
            const float cs = cstab[(pos * 8 + f) * 2], sn = cstab[(pos * 8 + f) * 2 + 1];
            const float qp = __shfl_xor(qv[i], 8), kp = __shfl_xor(kv[i], 8);
            if (dd < 8) { qv[i] = qv[i] * cs - qp * sn; kv[i] = kv[i] * cs - kp * sn; }
            else { qv[i] = qp * sn + qv[i] * cs; kv[i] = kp * sn + kv[i] * cs; }
        }
    }
#pragma unroll
    for (int i = 0; i < 16; ++i) qv[i] *= 0.17677669529663687f;
#pragma unroll 1
    for (int dir = 0; dir < 2; ++dir) {
        f32x16_t X;
#pragma unroll
        for (int i = 0; i < 16; ++i) X[i] = 0.f;
        {
            const bf16x8_t A = *(const bf16x8_t*)(p.rest + (row0 + r) * NREST + RC_CR + dir * 16 + 8 * hh);
            const float* w2p = p.gla_w2 + ((size_t)(l * 2 + dir) * 16 + 8 * hh) * 128 + h * 32 + r;
            const bf16x8_t Bf = __builtin_bit_cast(bf16x8_t, (u32x4_t){cvtpk(w2p[0], w2p[128]), cvtpk(w2p[256], w2p[384]), cvtpk(w2p[512], w2p[640]), cvtpk(w2p[768], w2p[896])});
            X = MFMA32(A, Bf, X);
        }
        const float b2v = p.gla_b2[(l * 2 + dir) * 128 + h * 32 + r];
        float Bc[16];
#pragma unroll
        for (int i = 0; i < 16; ++i) { const float xg = X[i] + b2v; Bc[i] = (fminf(xg, 0.f) - log1pf(expf(-fabsf(xg)))) * (1.f / 16.f); }
        float tot;
        {
            float sg[4], ps[4];
#pragma unroll
            for (int g = 0; g < 4; ++g) { sg[g] = (Bc[4 * g] + Bc[4 * g + 1]) + (Bc[4 * g + 2] + Bc[4 * g + 3]); ps[g] = __shfl_xor(sg[g], 32); }
            tot = ((sg[0] + ps[0]) + (sg[1] + ps[1])) + ((sg[2] + ps[2]) + (sg[3] + ps[3]));
            if (dir == 0) {
                float base = 0.f;
#pragma unroll
                for (int g = 0; g < 4; ++g) {
                    float o = base + (hh ? ps[g] : 0.f);
#pragma unroll
                    for (int k = 0; k < 4; ++k) { o += Bc[4 * g + k]; Bc[4 * g + k] = o; }
                    base += sg[g] + ps[g];
                }
            } else {
                float base = 0.f;
#pragma unroll
                for (int g = 3; g >= 0; --g) {
                    float o = base + (hh ? 0.f : ps[g]);
#pragma unroll
                    for (int k = 3; k >= 0; --k) { o += Bc[4 * g + k]; Bc[4 * g + k] = o; }
                    base += sg[g] + ps[g];
                }
            }
        }
        unsigned char* gout = (unsigned char*)p.raw + GLA_PREP_OFF + ((size_t)(bh * 2 + dir) * NCH + c) * GL_ITEM;
        LASP bf16* ql = (LASP bf16*)wl;
        LASP bf16* kl = ql + 32 * 40;
        {
            bf16* qpo = (bf16*)gout + perm16(r);
            bf16* kdo = (bf16*)(gout + 4096) + r * 32 + 4 * hh;
#pragma unroll
            for (int g = 0; g < 4; ++g) {
                float kd[4];
#pragma unroll
                for (int k = 0; k < 4; ++k) {
                    const int i = 4 * g + k, n = crow(i, hh);
                    const float eb = expf(Bc[i]);
                    const float qs = qv[i] * eb, ks = kv[i] / eb;
                    kd[k] = kv[i] * expf(tot - Bc[i]);
                    const bf16 qsb = f2bf(qs);
                    qpo[n * 32] = qsb;
                    ql[n * 40 + r] = qsb; kl[n * 40 + r] = f2bf(ks);
                }
                *(u32x2_t*)(kdo + 8 * g) = (u32x2_t){cvtpk(kd[0], kd[1]), cvtpk(kd[2], kd[3])};
            }
            if (hh == 0) ((float*)(gout + 6144))[r] = expf(tot);
        }
        asm volatile("s_waitcnt lgkmcnt(0)" ::: "memory");
        f32x16_t AT;
#pragma unroll
        for (int i = 0; i < 16; ++i) AT[i] = 0.f;
        AT = MFMA32(*(const LASP bf16x8_t*)((const LASP unsigned char*)kl + r * 80 + hh * 16), *(const LASP bf16x8_t*)((const LASP unsigned char*)ql + r * 80 + hh * 16), AT);
        AT = MFMA32(*(const LASP bf16x8_t*)((const LASP unsigned char*)kl + r * 80 + hh * 16 + 32), *(const LASP bf16x8_t*)((const LASP unsigned char*)ql + r * 80 + hh * 16 + 32), AT);
        {
            bf16* amo = (bf16*)(gout + 2048) + r * 32 + 4 * hh;
#pragma unroll
            for (int g = 0; g < 4; ++g) {
                float a[4];
#pragma unroll
                for (int k = 0; k < 4; ++k) { const int m = crow(4 * g + k, hh); const bool keep = dir == 0 ? (m <= r) : (m >= r); a[k] = keep ? AT[4 * g + k] : 0.f; }
                *(u32x2_t*)(amo + 8 * g) = (u32x2_t){cvtpk(a[0], a[1]), cvtpk(a[2], a[3])};
            }
        }
        asm volatile("s_waitcnt lgkmcnt(0)" ::: "memory");
    }
}

constexpr int LS_QP = 0, LS_AM = 2560, LS_KD = 5120, LS_VT = 7680, LS_GL = 12800, LS_BYTES = 12928;
struct LSlot { u32x4_t a0, a1, a2, v0, v1; f32x4_t gl; };
__device__ __forceinline__ void gla_issue(const P& p, LSlot& g, int b, int h, int dir, int step, int t2) {
    const int c = gdn_chunk(dir, step);
    const unsigned char* gp = (const unsigned char*)p.raw + GLA_PREP_OFF + ((size_t)((b * 4 + h) * 2 + dir) * NCH + c) * GL_ITEM;
    g.a0 = *(const u32x4_t*)(gp + t2 * 16); g.a1 = *(const u32x4_t*)(gp + 2048 + t2 * 16); g.a2 = *(const u32x4_t*)(gp + 4096 + t2 * 16);
    if (t2 < 8) g.gl = *(const f32x4_t*)(gp + 6144 + t2 * 16);
    const size_t row0 = (size_t)b * TOK + (size_t)c * GCH;
    const bf16* vp = p.rest + (row0 + (t2 >> 3)) * NREST + RC_CV + h * 64 + 8 * (t2 & 7);
    g.v0 = *(const u32x4_t*)vp; g.v1 = *(const u32x4_t*)(vp + (size_t)16 * NREST);
}
__device__ __forceinline__ void gla_put_vt(LASP unsigned char* st, int m, int dv0, u32x4_t v) {
    LASP unsigned short* vt = (LASP unsigned short*)(st + LS_VT) + m;
    vt[(dv0 + 0) * 40] = (unsigned short)(v.x & 0xffffu); vt[(dv0 + 1) * 40] = (unsigned short)(v.x >> 16);
    vt[(dv0 + 2) * 40] = (unsigned short)(v.y & 0xffffu); vt[(dv0 + 3) * 40] = (unsigned short)(v.y >> 16);
    vt[(dv0 + 4) * 40] = (unsigned short)(v.z & 0xffffu); vt[(dv0 + 5) * 40] = (unsigned short)(v.z >> 16);
    vt[(dv0 + 6) * 40] = (unsigned short)(v.w & 0xffffu); vt[(dv0 + 7) * 40] = (unsigned short)(v.w >> 16);
}
__device__ __forceinline__ void gla_write(LASP unsigned char* st, const LSlot& g, int t2) {
    const int row = t2 >> 2, ch = t2 & 3;
    *(LASP u32x4_t*)(st + LS_QP + row * 80 + ch * 16) = g.a0;
    *(LASP u32x4_t*)(st + LS_AM + row * 80 + ch * 16) = g.a1;
    *(LASP u32x4_t*)(st + LS_KD + row * 80 + ch * 16) = g.a2;
    if (t2 < 8) *(LASP f32x4_t*)(st + LS_GL + t2 * 16) = g.gl;
    gla_put_vt(st, t2 >> 3, 8 * (t2 & 7), g.v0); gla_put_vt(st, 16 + (t2 >> 3), 8 * (t2 & 7), g.v1);
}
__device__ void gla_scan_fast(const P& p, LASP unsigned char* lds, int bh) {
    const int tid = mk_tid();
    const int lane = tid & 63, wave = __builtin_amdgcn_readfirstlane(tid >> 6);
    const int h = bh & 3, b = bh >> 2;
    constexpr int NS = NCH;
    if (wave >= 4) {
        const int dir = (wave - 4) >> 1, t2 = tid & 127;
        LASP unsigned char* base = lds + dir * 2 * LS_BYTES;
        LSlot g0, g1, g2, g3;
        gla_issue(p, g0, b, h, dir, 0, t2); gla_issue(p, g1, b, h, dir, 1, t2); gla_issue(p, g2, b, h, dir, 2, t2); gla_issue(p, g3, b, h, dir, 3, t2);
        gla_write(base, g0, t2); gla_issue(p, g0, b, h, dir, 4, t2);
        __syncthreads();
#pragma unroll 1
        for (int s = 0; s < NS; s += 4) {
            gla_write(base + ((s + 1) & 1) * LS_BYTES, g1, t2); if (s + 5 < NS) gla_issue(p, g1, b, h, dir, s + 5, t2);
            __syncthreads();
            gla_write(base + ((s + 2) & 1) * LS_BYTES, g2, t2); if (s + 6 < NS) gla_issue(p, g2, b, h, dir, s + 6, t2);
            __syncthreads();
            gla_write(base + ((s + 3) & 1) * LS_BYTES, g3, t2); if (s + 7 < NS) gla_issue(p, g3, b, h, dir, s + 7, t2);
            __syncthreads();
            if (s + 4 < NS) { gla_write(base + ((s + 4) & 1) * LS_BYTES, g0, t2); if (s + 8 < NS) gla_issue(p, g0, b, h, dir, s + 8, t2); }
            __syncthreads();
        }
    } else {
        const int r = lane & 31, hh = lane >> 5, dir = wave >> 1, blk = wave & 1;
        LASP unsigned char* base = lds + dir * 2 * LS_BYTES;
        f32x16_t S;
#pragma unroll
        for (int i = 0; i < 16; ++i) S[i] = 0.f;
        __syncthreads();
#pragma unroll 1
        for (int s = 0; s < NS; ++s) {
            const LASP unsigned char* st = base + (s & 1) * LS_BYTES;
            const bf16x8_t Sb0 = PACK8(S, 0), Sb1 = PACK8(S, 1);
            f32x16_t oT;
#pragma unroll
            for (int i = 0; i < 16; ++i) oT[i] = 0.f;
            const LASP unsigned char* qp = st + LS_QP + r * 80 + hh * 16;
            oT = MFMA32(Sb0, *(const LASP bf16x8_t*)(qp), oT);
            oT = MFMA32(Sb1, *(const LASP bf16x8_t*)(qp + 32), oT);
            const LASP unsigned char* vt = st + LS_VT + (32 * blk + r) * 80 + hh * 16;
            const LASP unsigned char* am = st + LS_AM + r * 80 + hh * 16;
            const bf16x8_t V0 = *(const LASP bf16x8_t*)(vt), V1 = *(const LASP bf16x8_t*)(vt + 32);
            oT = MFMA32(V0, *(const LASP bf16x8_t*)(am), oT);
            oT = MFMA32(V1, *(const LASP bf16x8_t*)(am + 32), oT);
            {
                const int c = gdn_chunk(dir, s);
                bf16* op = p.oc + ((size_t)dir * ROWS + (size_t)b * TOK + (size_t)c * GCH + r) * 256 + h * 64 + 32 * blk + 4 * hh;
#pragma unroll
                for (int g = 0; g < 4; ++g) *(u32x2_t*)(op + 8 * g) = (u32x2_t){cvtpk(oT[4 * g], oT[4 * g + 1]), cvtpk(oT[4 * g + 2], oT[4 * g + 3])};
            }
            const LASP float* glp = (const LASP float*)(st + LS_GL);
#pragma unroll
            for (int g = 0; g < 4; ++g) {
                const f32x4_t g4 = *(const LASP f32x4_t*)(glp + 8 * g + 4 * hh);
                S[4 * g] *= g4.x; S[4 * g + 1] *= g4.y; S[4 * g + 2] *= g4.z; S[4 * g + 3] *= g4.w;
            }
            const LASP unsigned char* kd = st + LS_KD + r * 80 + hh * 16;
            S = MFMA32(*(const LASP bf16x8_t*)(kd), V0, S);
            S = MFMA32(*(const LASP bf16x8_t*)(kd + 32), V1, S);
            __syncthreads();
        }
    }
}


__device__ __forceinline__ void vt_item(const P& p, int it, int lane) {
    const int r = lane & 31, hh = lane >> 5;
    const int tb = it % NCH, bh = it / NCH, h = bh & 3, b = bh >> 2;
    const bf16* vp = p.rest + ((size_t)b * TOK + 32 * tb + r) * NREST + RC_BV + h * 64 + 32 * hh;
    bf16* op = p.vtb + ((size_t)bh * 64 + 32 * hh) * TOK + 32 * tb + perm16(r);
#pragma unroll
    for (int q = 0; q < 4; ++q) {
        const u32x4_t w = *(const u32x4_t*)(vp + 8 * q);
        op[(size_t)(8 * q + 0) * TOK] = (bf16)(w.x & 0xffffu); op[(size_t)(8 * q + 1) * TOK] = (bf16)(w.x >> 16);
        op[(size_t)(8 * q + 2) * TOK] = (bf16)(w.y & 0xffffu); op[(size_t)(8 * q + 3) * TOK] = (bf16)(w.y >> 16);
        op[(size_t)(8 * q + 4) * TOK] = (bf16)(w.z & 0xffffu); op[(size_t)(8 * q + 5) * TOK] = (bf16)(w.z >> 16);
        op[(size_t)(8 * q + 6) * TOK] = (bf16)(w.w & 0xffffu); op[(size_t)(8 * q + 7) * TOK] = (bf16)(w.w >> 16);
    }
}

__device__ __forceinline__ void na_item(const P& p, const LASP float* rpbL, int it, int lane) {
    const int r = lane & 31, hh = lane >> 5;
    int b, h, ry, qb; bool lat;
    if (it < 4096) { lat = true; qb = it & 1; ry = (it >> 1) & 63; h = (it >> 7) & 3; b = it >> 9; }
    else { const int j = it - 4096; lat = false; qb = j & 7; h = (j >> 3) & 3; b = j >> 5; ry = 0; }
    const size_t brow = (size_t)b * TOK;
    const int q0 = lat ? CTX + ry * 64 + qb * 32 : qb * 32;
    bf16* qp = p.rest + (brow + q0 + r) * NREST + RC_BQ + h * 64;
    bf16x8_t Qf0 = *(const bf16x8_t*)(qp + 8 * hh), Qf1 = *(const bf16x8_t*)(qp + 16 + 8 * hh), Qf2 = *(const bf16x8_t*)(qp + 32 + 8 * hh), Qf3 = *(const bf16x8_t*)(qp + 48 + 8 * hh);
    f32x16_t O0, O1;
#pragma unroll
    for (int i = 0; i < 16; ++i) { O0[i] = 0.f; O1[i] = 0.f; }
    float m = -1e30f, lsum = 0.f;
    const bf16* vtb = p.vtb + ((size_t)(b * 4 + h) * 64 + r) * TOK + 8 * hh;
    const int nkb = lat ? 24 : 8;
    const int c = qb * 32 + r, c0 = min(max(c - 8, 0), 48), r0 = min(max(ry - 4, 0), 56);
    constexpr float SC = 0.125f * 1.4426950408889634f;
#pragma unroll 1
    for (int kb = 0; kb < nkb; ++kb) {
        int t0, ky = 0, cb = 0; const bool win = kb >= 8;
        if (!win) t0 = kb * 32; else { const int w = kb - 8; ky = r0 + (w >> 1); cb = w & 1; t0 = CTX + ky * 64 + cb * 32; }
        const bf16* kp = p.rest + (brow + t0 + r) * NREST + RC_BK + h * 64 + 8 * hh;
        f32x16_t S;
#pragma unroll
        for (int i = 0; i < 16; ++i) S[i] = 0.f;
        S = MFMA32(*(const bf16x8_t*)(kp), Qf0, S); S = MFMA32(*(const bf16x8_t*)(kp + 16), Qf1, S);
        S = MFMA32(*(const bf16x8_t*)(kp + 32), Qf2, S); S = MFMA32(*(const bf16x8_t*)(kp + 48), Qf3, S);
        const bf16* vp = vtb + t0;
        const bf16x8_t V00 = *(const bf16x8_t*)(vp), V01 = *(const bf16x8_t*)(vp + 16), V10 = *(const bf16x8_t*)(vp + (size_t)32 * TOK), V11 = *(const bf16x8_t*)(vp + (size_t)32 * TOK + 16);
        float bm = -1e30f;
        if (win) {
            const LASP float* rb = rpbL + (h * 15 + (ky - ry + 7)) * 31 + 15 - c;
#pragma unroll
            for (int i = 0; i < 16; ++i) {
                const int kc = cb * 32 + crow(i, hh);
                const bool valid = (kc >= c0) && (kc < c0 + 16);
                const float bias = rb[valid ? kc : c];
                S[i] = valid ? S[i] * SC + bias : -1e30f;
                bm = fmaxf(bm, S[i]);
            }
        } else {
#pragma unroll
            for (int i = 0; i < 16; ++i) { S[i] *= SC; bm = fmaxf(bm, S[i]); }
        }
        bm = fmaxf(bm, __shfl_xor(bm, 32));
        const float mn = fmaxf(m, bm);
        const float alpha = __builtin_amdgcn_exp2f(m - mn);
        m = mn;
        float ps = 0.f;
#pragma unroll
        for (int i = 0; i < 16; ++i) { S[i] = __builtin_amdgcn_exp2f(S[i] - mn); ps += S[i]; }
        lsum = lsum * alpha + ps;
#pragma unroll
        for (int i = 0; i < 16; ++i) { O0[i] *= alpha; O1[i] *= alpha; }
        const bf16x8_t Pb0 = PACK8(S, 0), Pb1 = PACK8(S, 1);
        O0 = MFMA32(V00, Pb0, O0); O0 = MFMA32(V01, Pb1, O0);
        O1 = MFMA32(V10, Pb0, O1); O1 = MFMA32(V11, Pb1, O1);
    }
    const float inv = 1.f / (lsum + __shfl_xor(lsum, 32));
    bf16* op = qp + 4 * hh;
#pragma unroll
    for (int g = 0; g < 4; ++g) {
        *(u32x2_t*)(op + 8 * g) = (u32x2_t){cvtpk(O0[4 * g] * inv, O0[4 * g + 1] * inv), cvtpk(O0[4 * g + 2] * inv, O0[4 * g + 3] * inv)};
        *(u32x2_t*)(op + 32 + 8 * g) = (u32x2_t){cvtpk(O1[4 * g] * inv, O1[4 * g + 1] * inv), cvtpk(O1[4 * g + 2] * inv, O1[4 * g + 3] * inv)};
    }
}

__device__ void ph_prep(const P& p, LASP unsigned char* lds, int l, int bid, int nblk) {
    const int tid = mk_tid();
    LASP float* cstab = (LASP float*)(lds + 131072);
    {
        const int pos = tid >> 3, f = tid & 7;
        const float ang = (float)pos * powf(10000.f, -(float)f / 8.f);
        cstab[tid * 2] = cosf(ang); cstab[tid * 2 + 1] = sinf(ang);
    }
    __syncthreads();
    ph_gdnprep(p, lds, l, bid, nblk, tid);
    const int lane = tid & 63, wave = tid >> 6;
    for (int it = (nblk - 1 - bid) * NWAVES + wave; it < BATCH * 4 * NCH; it += nblk * NWAVES) gla_prep_item(p, lds + wave * 16384, cstab, l, it, lane);
    for (int it = bid * NWAVES + wave; it < BATCH * 4 * NCH; it += nblk * NWAVES) vt_item(p, it, lane);
}


__device__ void ph_mix(const P& p, LASP unsigned char* lds, int l, int bid, int nblk) {
    constexpr int NGDN = BATCH * 4 * 2;
    constexpr int NGLA = BATCH * 4;
    if (bid < NGDN) { gdn_scan_fast(p, lds, bid); return; }
    if (bid < NGDN + NGLA) { gla_scan_fast(p, lds, bid - NGDN); return; }
    const int tid = mk_tid();
    const int lane = tid & 63, wave = tid >> 6;
    LASP float* rpbL = (LASP float*)lds;
    for (int i = tid; i < 4 * 15 * 31; i += NTHREADS) rpbL[i] = p.rpb[(size_t)l * 4 * 15 * 31 + i] * 1.4426950408889634f;
    __syncthreads();
    const int total = 4096 + (l == 0 ? 256 : 0);
    for (int it = (bid - NGDN - NGLA) * NWAVES + wave; it < total; it += (nblk - NGDN - NGLA) * NWAVES) na_item(p, rpbL, it, lane);
}

__device__ void ph_gate(const P& p, int l, int bid, int nblk) {
    const int tid = mk_tid();
    const int tq = tid & 127, rsub = tid >> 7;
    for (int r = bid * 4 + rsub; r < ROWS; r += nblk * 4) {
        const bf16* pr = p.rest + (size_t)r * NREST;
        float o[8], z[8], res[8]; int oc;
        if (tq < 64) {
            const int cb = tq * 8;
            float a[8], bb[8];
            unpack8(*(const uint4*)(p.oa + (size_t)r * 512 + cb), a);
            unpack8(*(const uint4*)(p.oa + ((size_t)ROWS + r) * 512 + cb), bb);
            float ss = 0.f;
#pragma unroll
            for (int e = 0; e < 8; ++e) { o[e] = a[e] + bb[e]; ss += o[e] * o[e]; }
#pragma unroll
            for (int m = 8; m > 0; m >>= 1) ss += __shfl_xor(ss, m);
            const float rs = 1.f / sqrtf(ss * (1.f / 128.f) + 1e-6f);
            unpack8(*(const uint4*)(pr + RC_AZ + cb), z);
#pragma unroll
            for (int e = 0; e < 8; ++e) res[e] = o[e] * rs * p.gdn_norm[l * 128 + ((cb + e) & 127)] * silu_f(z[e]);
            oc = cb;
        } else if (tq < 96) {
            const int cb = (tq - 64) * 8;
            unpack8(*(const uint4*)(pr + RC_BQ + cb), o);
            unpack8(*(const uint4*)(pr + RC_BZ + cb), z);
#pragma unroll
            for (int e = 0; e < 8; ++e) res[e] = o[e] * silu_f(z[e]);
            oc = 512 + cb;
        } else {
            const int cb = (tq - 96) * 8;
            float a[8], bb[8];
            unpack8(*(const uint4*)(p.oc + (size_t)r * 256 + cb), a);
            unpack8(*(const uint4*)(p.oc + ((size_t)ROWS + r) * 256 + cb), bb);
            float ss = 0.f;
#pragma unroll
            for (int e = 0; e < 8; ++e) { o[e] = a[e] + bb[e]; ss += o[e] * o[e]; }
#pragma unroll
            for (int m = 4; m > 0; m >>= 1) ss += __shfl_xor(ss, m);
            const float rs = 1.f / sqrtf(ss * (1.f / 64.f) + 1e-6f);
            unpack8(*(const uint4*)(pr + RC_CZ + cb), z);
#pragma unroll
            for (int e = 0; e < 8; ++e) res[e] = o[e] * rs * p.gla_norm[l * 64 + ((cb + e) & 63)] * silu_f(z[e]);
            oc = 768 + cb;
        }
        uint4 w; w.x = pk2(res[0], res[1]); w.y = pk2(res[2], res[3]); w.z = pk2(res[4], res[5]); w.w = pk2(res[6], res[7]);
        *(uint4*)(p.mix + (size_t)r * D + oc) = w;
    }
}


#if PROBE
__device__ void gdn_scan_naive(const P& p, LASP float* sm, int l, int b, int hp, bf16* nb) {
    const int tid = mk_tid();
    LASP float* skq = sm;
    LASP float* sv = sm + 4 * 16 * 256;
    LASP float* sg = sv + 4 * 16 * 128;
    LASP float* sb = sg + 64;
    const int sub = tid >> 7, col = tid & 127, dir = sub & 1, h = hp * 2 + (sub >> 1);
    float S[128];
#pragma unroll
    for (int i = 0; i < 128; ++i) S[i] = 0.f;
    for (int s0 = 0; s0 < TOK; s0 += 16) {
        __syncthreads();
        for (int i = tid; i < 4 * 16 * 48; i += NTHREADS) {
            const int su = i / (16 * 48), rem = i % (16 * 48), j = rem / 48, chunk = rem % 48;
            const int sd = su & 1, hh = hp * 2 + (su >> 1);
            const int t = tok_of(sd, s0 + j);
            const size_t row = (size_t)b * TOK + t;
            const int part = chunk >> 4, c8 = chunk & 15;
            const uint4 w = *(const uint4*)(p.qkvn + row * NRAW + part * 512 + hh * 128 + c8 * 8);
            float f[8]; unpack8(w, f);
            LASP float* dst = (part < 2) ? skq + (su * 16 + j) * 256 + part * 128 + c8 * 8 : sv + (su * 16 + j) * 128 + c8 * 8;
#pragma unroll
            for (int e = 0; e < 8; ++e) dst[e] = f[e];
        }
        if (tid < 64) {
            const int su = tid >> 4, j = tid & 15, sd = su & 1, hh = hp * 2 + (su >> 1);
            const int t = tok_of(sd, s0 + j);
            const bf16* ab = p.rest + ((size_t)b * TOK + t) * NREST + RC_AB;
            const float a = bf2f(ab[sd * 4 + hh]) + p.dt_bias[(l * 2 + sd) * 4 + hh];
            const float sp = fmaxf(a, 0.f) + log1pf(expf(-fabsf(a)));
            const float g = -expf(p.a_log[(l * 2 + sd) * 4 + hh]) * sp;
            sg[su * 16 + j] = expf(g);
            const float bx = bf2f(ab[(2 + sd) * 4 + hh]);
            sb[su * 16 + j] = 1.f / (1.f + expf(-bx));
        }
        __syncthreads();
#pragma unroll 1
        for (int j = 0; j < 16; ++j) {
            const LASP float* qp = skq + (sub * 16 + j) * 256;
            const LASP float* kp = qp + 128;
            const float dec = sg[sub * 16 + j], bt = sb[sub * 16 + j];
            const float v = sv[(sub * 16 + j) * 128 + col];
            float d0 = 0.f, d1 = 0.f, d2 = 0.f, d3 = 0.f;
#pragma unroll
            for (int k4 = 0; k4 < 32; ++k4) {
                const f32x4_t kv = *(const LASP f32x4_t*)(kp + k4 * 4);
                d0 += S[k4 * 4] * kv.x; d1 += S[k4 * 4 + 1] * kv.y; d2 += S[k4 * 4 + 2] * kv.z; d3 += S[k4 * 4 + 3] * kv.w;
                if ((k4 & 7) == 7) __builtin_amdgcn_sched_barrier(0);
            }
            const float dot = (d0 + d1) + (d2 + d3);
            const float vn = bt * (v - dec * dot);
            float o0 = 0.f, o1 = 0.f, o2 = 0.f, o3 = 0.f;
#pragma unroll
            for (int k4 = 0; k4 < 32; ++k4) {
                const f32x4_t kv = *(const LASP f32x4_t*)(kp + k4 * 4);
                const f32x4_t qv = *(const LASP f32x4_t*)(qp + k4 * 4);
                S[k4 * 4] = dec * S[k4 * 4] + kv.x * vn; o0 += S[k4 * 4] * qv.x;
                S[k4 * 4 + 1] = dec * S[k4 * 4 + 1] + kv.y * vn; o1 += S[k4 * 4 + 1] * qv.y;
                S[k4 * 4 + 2] = dec * S[k4 * 4 + 2] + kv.z * vn; o2 += S[k4 * 4 + 2] * qv.z;
                S[k4 * 4 + 3] = dec * S[k4 * 4 + 3] + kv.w * vn; o3 += S[k4 * 4 + 3] * qv.w;
                if ((k4 & 3) == 3) __builtin_amdgcn_sched_barrier(0);
            }
            const int t = tok_of(dir, s0 + j);
            nb[((size_t)dir * TOK + t) * 256 + (h & 1) * 128 + col] = f2bf((o0 + o1) + (o2 + o3));
        }
    }
    __syncthreads();
}

__device__ void gla_scan_naive(const P& p, LASP float* sm, int l, int b, bf16* nb) {
    const int tid = mk_tid();
    LASP float* sq = sm;
    LASP float* sv = sm + 8 * 16 * 96;
    const int grp = tid >> 6, lane = tid & 63, h = grp >> 1, dir = grp & 1;
    const int d = lane & 31, par = lane >> 5;
    float w2c[16];
#pragma unroll
    for (int j = 0; j < 16; ++j) w2c[j] = p.gla_w2[((size_t)(l * 2 + dir) * 16 + j) * 128 + h * 32 + d];
    const float b2v = p.gla_b2[(l * 2 + dir) * 128 + h * 32 + d];
    const int dd = d & 15, f = dd & 7;
    const float inv = powf(10000.f, -(float)f / 8.f);
    const int pd = dd < 8 ? d + 8 : d - 8;
    float S[32];
#pragma unroll
    for (int i = 0; i < 32; ++i) S[i] = 0.f;
    for (int s0 = 0; s0 < TOK; s0 += 16) {
        __syncthreads();
#pragma unroll 1
        for (int jj = 0; jj < 8; ++jj) {
            const int j = par + 2 * jj;
            const int t = tok_of(dir, s0 + j);
            const bf16* base = p.rest + ((size_t)b * TOK + t) * NREST;
            float qv = bf2f(base[RC_CQ + h * 32 + d]), kv = bf2f(base[RC_CK + h * 32 + d]);
            if (t >= CTX) {
                const int pidx = t - CTX;
                const int pos = d < 16 ? (pidx >> 6) : (pidx & 63);
                const float ang = (float)pos * inv;
                const float cs = cosf(ang), sn = sinf(ang);
                const float qp = bf2f(base[RC_CQ + h * 32 + pd]), kp = bf2f(base[RC_CK + h * 32 + pd]);
                if (dd < 8) { qv = qv * cs - qp * sn; kv = kv * cs - kp * sn; }
                else { qv = qp * sn + qv * cs; kv = kp * sn + kv * cs; }
            }
            qv *= 0.17677669529663687f;
            float xg = b2v;
#pragma unroll
            for (int jr = 0; jr < 16; ++jr) xg += bf2f(base[RC_CR + dir * 16 + jr]) * w2c[jr];
            const float ls = fminf(xg, 0.f) - log1pf(expf(-fabsf(xg)));
            LASP float* dst = sq + (grp * 16 + j) * 96;
            dst[d] = qv; dst[32 + d] = kv; dst[64 + d] = expf(ls * (1.f / 16.f));
        }
        for (int i = lane; i < 16 * 64; i += 64) {
            const int j = i >> 6, c = i & 63;
            const int t = tok_of(dir, s0 + j);
            sv[(grp * 16 + j) * 64 + c] = bf2f(p.rest[((size_t)b * TOK + t) * NREST + RC_CV + h * 64 + c]);
        }
        __syncthreads();
#pragma unroll 1
        for (int j = 0; j < 16; ++j) {
            const LASP float* qp = sq + (grp * 16 + j) * 96;
            const LASP float* kp = qp + 32;
            const LASP float* dp = qp + 64;
            const float v = sv[(grp * 16 + j) * 64 + lane];
            float o0 = 0.f, o1 = 0.f;
#pragma unroll
            for (int e = 0; e < 32; e += 2) {
                S[e] = dp[e] * S[e] + kp[e] * v; o0 += S[e] * qp[e];
                S[e + 1] = dp[e + 1] * S[e + 1] + kp[e + 1] * v; o1 += S[e + 1] * qp[e + 1];
            }
            const int t = tok_of(dir, s0 + j);
            nb[((size_t)dir * TOK + t) * 256 + h * 64 + lane] = f2bf(o0 + o1);
        }
    }
    __syncthreads();
}

__device__ void na_query_naive(const P& p, LASP float* sm, int l, int b, int t0, bf16* nb) {
    const int tid = mk_tid();
    const int wave = tid >> 6, lane = tid & 63, h = wave & 3, t = t0 + (wave >> 2);
    LASP float* pw = sm + wave * 384;
    const size_t rowq = (size_t)b * TOK + t;
    float qv[64];
    {
        const bf16* qs = p.rest + rowq * NREST + RC_BQ + h * 64;
#pragma unroll
        for (int i = 0; i < 8; ++i) {
            float f[8]; unpack8(*(const uint4*)(qs + i * 8), f);
#pragma unroll
            for (int e = 0; e < 8; ++e) qv[i * 8 + e] = f[e] * 0.125f;
        }
    }
    const bool lat = t >= CTX;
    const int nk = lat ? 384 : 256;
    int r = 0, c = 0, r0 = 0, c0 = 0;
    if (lat) { int pi = t - CTX; r = pi >> 6; c = pi & 63; r0 = min(max(r - 4, 0), 56); c0 = min(max(c - 8, 0), 48); }
    float m = -1e30f;
    __syncthreads();
#pragma unroll 1
    for (int j = 0; j < 6; ++j) {
        const int idx = lane + 64 * j;
        float s = -1e30f;
        if (idx < nk) {
            int tk; float bias = 0.f;
            if (lat && idx < 128) {
                const int i = idx >> 4, kc = c0 + (idx & 15);
                tk = CTX + (r0 + i) * 64 + kc;
                bias = p.rpb[((size_t)(l * 4 + h) * 15 + (r0 + i - r + 7)) * 31 + (kc - c + 15)];
            } else tk = lat ? idx - 128 : idx;
            const bf16* ks = p.rest + ((size_t)b * TOK + tk) * NREST + RC_BK + h * 64;
            float d0 = 0.f, d1 = 0.f;
#pragma unroll
            for (int i = 0; i < 8; ++i) {
                float f[8]; unpack8(*(const uint4*)(ks + i * 8), f);
#pragma unroll
                for (int e = 0; e < 8; e += 2) { d0 += qv[i * 8 + e] * f[e]; d1 += qv[i * 8 + e + 1] * f[e + 1]; }
            }
            s = d0 + d1 + bias;
        }
        pw[idx] = s;
        m = fmaxf(m, s);
    }
    m = wave_max(m);
    float sum = 0.f;
#pragma unroll 1
    for (int j = 0; j < 6; ++j) { const float e = expf(pw[lane + 64 * j] - m); pw[lane + 64 * j] = e; sum += e; }
    sum = wave_sum(sum);
    const float inv = 1.f / sum;
    __syncthreads();
    float o0 = 0.f, o1 = 0.f;
    for (int idx = 0; idx < nk; idx += 2) {
        int tk0;
        if (lat && idx < 128) tk0 = CTX + (r0 + (idx >> 4)) * 64 + c0 + (idx & 15);
        else tk0 = lat ? idx - 128 : idx;
        o0 += pw[idx] * bf2f(p.rest[((size_t)b * TOK + tk0) * NREST + RC_BV + h * 64 + lane]);
        o1 += pw[idx + 1] * bf2f(p.rest[((size_t)b * TOK + tk0 + 1) * NREST + RC_BV + h * 64 + lane]);
    }
    nb[(size_t)t * 256 + h * 64 + lane] = f2bf((o0 + o1) * inv);
}


__device__ void ph_probe_naive(const P& p, LASP float* sm, int l, int bid, int nblk) {
    bf16* nb = (bf16*)p.xc1;
    if (PROBE == 1) { if (bid == 0) gdn_scan_naive(p, sm, l, 0, 0, nb); }
    else if (PROBE == 3) { if (bid == 0) gla_scan_naive(p, sm, l, 0, nb); }
    else { for (int it = bid; it < TOK / 2; it += nblk) na_query_naive(p, sm, l, 0, it * 2, nb); }
}
__device__ void ph_probe_cmp(const P& p, int bid, int nblk) {
    const int tid = mk_tid();
    const bf16* nb = (const bf16*)p.xc1;
    float md = 0.f, mr = 0.f;
    const int n = (PROBE == 2) ? TOK * 256 : 2 * TOK * 256;
    for (int i = bid * NTHREADS + tid; i < n; i += nblk * NTHREADS) {
        float a, r = bf2f(nb[i]);
        if (PROBE == 1) { const int dir = i / (TOK * 256), rem = i % (TOK * 256), t = rem >> 8, c = rem & 255; a = bf2f(p.oa[((size_t)dir * ROWS + t) * 512 + c]); }
        else if (PROBE == 3) { const int dir = i / (TOK * 256), rem = i % (TOK * 256); a = bf2f(p.oc[(size_t)dir * ROWS * 256 + rem]); }
        else { const int t = i >> 8, c = i & 255; a = bf2f(p.rest[(size_t)t * NREST + RC_BQ + c]); }
        md = fmaxf(md, fabsf(a - r)); mr = fmaxf(mr, fabsf(r));
    }
    md = wave_max(md); mr = wave_max(mr);
    if ((tid & 63) == 0) { atomicMax((unsigned*)p.stats, __float_as_uint(md)); atomicMax((unsigned*)p.stats + 1, __float_as_uint(mr)); }
}
#endif

constexpr int NSTEP = 1 + 2 * 7 + 1;
__global__ void __launch_bounds__(NTHREADS, 2) k_mega(P p) {
    extern __shared__ __attribute__((aligned(16))) unsigned char lds_raw[];
    LASP unsigned char* lds = (LASP unsigned char*)lds_raw;
    cg::grid_group grid = cg::this_grid();
    const int bid = blockIdx.x, nblk = gridDim.x;
#pragma unroll 1
    for (int step = 0; step < NSTEP; ++step) {
        int ph = 0, l = 0;
        if (step > 0) { const int s1 = step - 1; l = s1 / 7; ph = 1 + s1 % 7; }
#if TPROBE >= 0
        unsigned long long tp0 = 0;
        if (bid == 0 && threadIdx.x == 0) { if (step == 0) p.stats[2] = 0.f; tp0 = __builtin_amdgcn_s_memrealtime(); }
#endif
        if (ph == 0) ph_prologue(p, lds, bid, nblk);
        else if (ph == 1) ph_lnpass(p, l, bid, nblk);
        else if (l < 2) {
            if (ph == 2) {
                pg8::Gemm g{p.ml, p.wi_t + (size_t)l * NPAD * D, ROWS, NPAD, D}; pg8::StaticOrder S; S.init(ROWS, NPAD, nblk, bid);
                EpiProj E{p.raw, p.rest};
                pg8::gemm_phase<EpiProj, pg8::StaticOrder, true, true>(lds, g, S, E);
            } else if (ph == 3) ph_conv(p, l, bid, nblk);
            else if (ph == 4) ph_prep(p, lds, l, bid, nblk);
            else if (ph == 5) {
#if PROBE
                if (l == 0) { ph_probe_naive(p, (LASP float*)lds, l, bid, nblk); grid.sync(); }
#endif
                ph_mix(p, lds, l, bid, nblk);
#if PROBE
                if (l == 0) { grid.sync(); ph_probe_cmp(p, bid, nblk); }
#endif
            }
            else if (ph == 6) ph_gate(p, l, bid, nblk);
            else {
                pg8::Gemm g{p.mix, p.wo_t + (size_t)l * D * D, ROWS, D, D}; pg8::StaticOrder S; S.init(ROWS, D, nblk, bid);
                EpiRes E{l == 0 ? p.x : p.out, p.ctx, p.out, p.xc1, p.mods, l};
                pg8::gemm_phase<EpiRes, pg8::StaticOrder, true, true>(lds, g, S, E);
            }
        }
        grid.sync();
#if TPROBE >= 0
        if (bid == 0 && threadIdx.x == 0 && ph == TPROBE) p.stats[2] += (float)(__builtin_amdgcn_s_memrealtime() - tp0) * 0.01f;
#endif
    }
}

extern "C" void kernel_launch(void* const* d_in, const int* in_sizes, int n_in, void* d_out, int out_size, void* d_ws, size_t ws_size,
                              hipStream_t stream) {
    P p{};
    p.x = (const float*)d_in[0]; p.c = (const float*)d_in[1]; p.ctx = (const float*)d_in[2]; p.c_ctx = (const float*)d_in[3];
    p.w_mod = (const float*)d_in[4]; p.b_mod = (const float*)d_in[5]; p.w_in = (const float*)d_in[6]; p.conv_w = (const float*)d_in[7];
    p.a_log = (const float*)d_in[8]; p.dt_bias = (const float*)d_in[9]; p.gdn_norm = (const float*)d_in[10]; p.rpb = (const float*)d_in[11];
    p.gla_w2 = (const float*)d_in[12]; p.gla_b2 = (const float*)d_in[13]; p.gla_norm = (const float*)d_in[14]; p.w_out = (const float*)d_in[15];
    p.ln_g = (const float*)d_in[16]; p.ln_b = (const float*)d_in[17];
    p.out = (float*)d_out;
    unsigned char* w = (unsigned char*)d_ws;
    size_t off = 0;
    auto take = [&](size_t bytes) { unsigned char* r = w + off; off += (bytes + 255) & ~(size_t)255; return r; };
    p.mods = (float*)take((size_t)2 * 9 * 3072 * 4);
    p.xc1 = (float*)take((size_t)BATCH * CTX * D * 4);
    p.wi_t = (bf16*)take((size_t)2 * NPAD * D * 2);
    p.wo_t = (bf16*)take((size_t)2 * D * D * 2);
    p.rest = (bf16*)take((size_t)ROWS * NREST * 2);
    p.raw = (bf16*)take((size_t)ROWS * NRAW * 2);
    p.qkvn = (bf16*)take((size_t)ROWS * NRAW * 2);
    p.mix = p.qkvn;
    p.oa = (bf16*)take((size_t)2 * ROWS * 512 * 2);
    p.oc = (bf16*)take((size_t)2 * ROWS * 256 * 2);
    p.ml = p.oa;
    p.vtb = (bf16*)take((size_t)ROWS * 256 * 2);
    p.stats = (float*)take(256);
    static int grid_blocks = 0;
    if (!grid_blocks) {
        if (off > ws_size) { fprintf(stderr, "workspace too small: need %zu have %zu\n", off, ws_size); grid_blocks = -1; return; }
        int dev = 0, cus = 0, per_cu = 0;
        hipGetDevice(&dev);
        hipDeviceGetAttribute(&cus, hipDeviceAttributeMultiprocessorCount, dev);
        if (hipFuncSetAttribute((const void*)k_mega, hipFuncAttributeMaxDynamicSharedMemorySize, LDS_BYTES) != hipSuccess) { fprintf(stderr, "hipFuncSetAttribute failed\n"); grid_blocks = -1; return; }
        hipOccupancyMaxActiveBlocksPerMultiprocessor(&per_cu, (const void*)k_mega, NTHREADS, LDS_BYTES);
        if (per_cu < 1) { fprintf(stderr, "occupancy query says %d blocks per CU\n", per_cu); grid_blocks = -1; return; }
        grid_blocks = cus;
    }
    if (grid_blocks < 0) return;
    void* args[] = {&p};
    hipError_t e = hipLaunchCooperativeKernel((void*)k_mega, dim3(grid_blocks), dim3(NTHREADS), args, LDS_BYTES, stream);
    if (e != hipSuccess) fprintf(stderr, "cooperative launch failed: %s (grid %d)\n", hipGetErrorString(e), grid_blocks);
}
```

```cpp
#include <hip/hip_runtime.h>
#include <hip/hip_cooperative_groups.h>
#include <cstdio>
#include <cstdint>
namespace cg = cooperative_groups;
#ifndef PROBE
#define PROBE 0
#endif
#ifndef TPROBE
#define TPROBE -1
#endif
#ifndef TSHIFT
#define TSHIFT 0
#endif

constexpr int D = 1024, BATCH = 8, SEQ = 4096, CTX = 256, TOK = 4352, NPROJ = 3888;
constexpr int ROWS = BATCH * TOK;
constexpr int NRAW = 1536, NREST = 2352, NPAD = 4096;
constexpr int NTHREADS = 512, NWAVES = 8;
constexpr int LDS_BYTES = 147456;
constexpr float ALPHA = 1.4142135623730951f;
constexpr int RC_AB = 0, RC_AZ = 16, RC_BQ = 528, RC_BK = 784, RC_BV = 1040, RC_BZ = 1296, RC_CQ = 1552, RC_CK = 1680, RC_CV = 1808, RC_CR = 2064, RC_CZ = 2096;

typedef unsigned short bf16;
typedef float f32x4_t __attribute__((ext_vector_type(4)));

struct P {
    const float *x, *c, *ctx, *c_ctx, *w_mod, *b_mod, *w_in, *conv_w, *a_log, *dt_bias, *gdn_norm, *rpb,
        *gla_w2, *gla_b2, *gla_norm, *w_out, *ln_g, *ln_b;
    float* out;
    float *mods, *xc1, *stats; unsigned* ctl;
    bf16 *wi_t, *wo_t, *rest, *raw, *qkvn, *mix, *ml, *oa, *oc, *vtb;
};

__device__ __forceinline__ float bf2f(unsigned short u) { return __uint_as_float((unsigned)u << 16); }
__device__ __forceinline__ unsigned short f2bf(float f) { unsigned u = __float_as_uint(f); return (unsigned short)((u + 0x7fffu + ((u >> 16) & 1u)) >> 16); }
__device__ __forceinline__ unsigned pk2(float lo, float hi) { return (unsigned)f2bf(lo) | ((unsigned)f2bf(hi) << 16); }
__device__ __forceinline__ float bflo(unsigned w) { return __uint_as_float(w << 16); }
__device__ __forceinline__ float bfhi(unsigned w) { return __uint_as_float(w & 0xffff0000u); }
__device__ __forceinline__ void unpack8(uint4 w, float* f) {
    f[0] = bflo(w.x); f[1] = bfhi(w.x); f[2] = bflo(w.y); f[3] = bfhi(w.y); f[4] = bflo(w.z); f[5] = bfhi(w.z); f[6] = bflo(w.w); f[7] = bfhi(w.w);
}
__device__ __forceinline__ float silu_f(float x) { return x / (1.f + expf(-x)); }
__device__ __forceinline__ float wave_sum(float v) {
#pragma unroll
    for (int o = 32; o > 0; o >>= 1) v += __shfl_xor(v, o);
    return v;
}
__device__ __forceinline__ float wave_max(float v) {
#pragma unroll
    for (int o = 32; o > 0; o >>= 1) v = fmaxf(v, __shfl_xor(v, o));
    return v;
}
__device__ __forceinline__ int mk_tid() { int t = threadIdx.x; asm volatile("" : "+v"(t)); return t; }
__device__ __forceinline__ int tok_of(int dir, int s) { return dir == 0 ? s : (s < CTX ? CTX - 1 - s : TOK + CTX - 1 - s); }

namespace pg8 {
#define PG8_LAS __attribute__((address_space(3)))
typedef unsigned short bf16_t;
typedef short bf16x8 __attribute__((ext_vector_type(8)));
typedef float f32x4 __attribute__((ext_vector_type(4)));
typedef unsigned u32x4 __attribute__((ext_vector_type(4)));
constexpr int BM = 256, BK = 64, HALF = 128, HTB = HALF * BK * 2  , STAGE_BYTES = 8 * HTB, NXCD = 8, WGM = 8;

__host__ __device__ __forceinline__ int lds_byte(int r, int c) { const int st = (r >> 4) * 2 + (c >> 5), rr = r & 15, cc = c & 31, ob = rr * 64 + cc * 2; return st * 1024 + (ob ^ (((ob >> 9) & 1) << 5)); }
__host__ __device__ __forceinline__ void stage_rc(int b, int& R, int& C) { const int st = b / 1024, sb = b % 1024, swz = sb ^ (((sb >> 9) & 1) << 5); R = (st >> 1) * 16 + swz / 64; C = (st & 1) * 32 + (swz % 64) / 2; }
__host__ __device__ __forceinline__ int perm32(int rho) { const int n = rho >> 4, i = rho & 15; return 8 * (i >> 2) + 4 * n + (i & 3); }

struct Unit { int pm, pn; };
struct Gemm { const bf16_t* A; const bf16_t* Bt; int M, N, K; };

struct StaticOrder {
    int nM, nN, nwg, G, c;
    __host__ __device__ void init(int M, int N, int G_, int c_) { nM = M / BM; nN = N / BM; nwg = nM * nN; G = G_; c = c_; }
    __host__ __device__ bool next(int i, Unit& u) const {
        const long L = (long)i * G + c; if (L >= nwg) return false;
        int wgid = (int)L; { const int q = nwg / NXCD, r = nwg % NXCD, xcd = wgid % NXCD, off = wgid / NXCD; wgid = (xcd < r ? xcd * (q + 1) : r * (q + 1) + (xcd - r) * q) + off; }
        const int nig = WGM * nN, gid = wgid / nig, fm = gid * WGM, gsz = (nM - fm) < WGM ? (nM - fm) : WGM;
        u.pm = fm + ((wgid % nig) % gsz); u.pn = (wgid % nig) / gsz; return true;
    }
    __device__ __forceinline__ void a_ready(const Unit&) const {}
    __device__ __forceinline__ void done(const Unit&) const {}
};

__device__ __forceinline__ unsigned cvt_pk_bf16(float lo, float hi) { unsigned r; asm volatile("v_cvt_pk_bf16_f32 %0, %1, %2" : "=v"(r) : "v"(lo), "v"(hi)); return r; }
template <class Epi, class Sched, bool ALIGN_EPI = false, bool SP2 = false>
__device__ __forceinline__ void gemm_phase(PG8_LAS unsigned char* lds, const Gemm g, const Sched& S, const Epi& E) {
    const int tid = mk_tid(), wid = __builtin_amdgcn_readfirstlane(tid >> 6), lane = tid & 63, wr = wid >> 2, wc = wid & 3, fr = lane & 15, fq = lane >> 4;
    const int K = g.K, nt = K / BK;
    unsigned voffA[2], voffB[2];
#pragma unroll
    for (int i = 0; i < 2; ++i) { int R, C; stage_rc(tid * 16 + i * 8192, R, C); const int Rb = Epi::PERM ? ((R & ~31) + perm32(R & 31)) : R;
        voffA[i] = (unsigned)(R * K + C) * 2u; voffB[i] = (unsigned)(Rb * K + C) * 2u; }
    const size_t kstep = (size_t)(BK * 2);
    const size_t hstep = (size_t)HALF * K * 2;
    const size_t tstep = 2 * hstep;
    const unsigned ldsw = (unsigned)wid * 1024u;
    const int aoff = lds_byte(wr * 64 + fr, fq * 8), boff = lds_byte(wc * 32 + fr, fq * 8);
#define PG8_SA(b, h) (((b) * 2 + (h)) * HTB)
#define PG8_SB(b, h) ((4 + (b) * 2 + (h)) * HTB)
#define PG8_STAGE(bufoff, gbase, voff) do { _Pragma("unroll") for (int _i = 0; _i < 2; ++_i) \
        __builtin_amdgcn_global_load_lds((const unsigned*)((const char*)(gbase) + (voff)[_i]), (PG8_LAS unsigned*)(lds + (bufoff) + ldsw + _i * 8192), 16, 0, 0); } while (0)
#define PG8_LDA(dst, b, h) do { _Pragma("unroll") for (int m = 0; m < 4; ++m) _Pragma("unroll") for (int k = 0; k < 2; ++k) dst[m][k] = *(const PG8_LAS bf16x8*)(lds + PG8_SA(b, h) + aoff + m * 2048 + k * 1024); } while (0)
#define PG8_LDB(dst, b, h) do { _Pragma("unroll") for (int n = 0; n < 2; ++n) _Pragma("unroll") for (int k = 0; k < 2; ++k) dst[n][k] = *(const PG8_LAS bf16x8*)(lds + PG8_SB(b, h) + boff + n * 2048 + k * 1024); } while (0)
#define PG8_MMA(ai, bj, At, Bt) do { __builtin_amdgcn_s_setprio(1); _Pragma("unroll") for (int m = 0; m < 4; ++m) _Pragma("unroll") for (int n = 0; n < 2; ++n) _Pragma("unroll") for (int k = 0; k < 2; ++k) \
        acc[ai][bj][m][n] = __builtin_amdgcn_mfma_f32_16x16x32_bf16(Bt[n][k], At[m][k], acc[ai][bj][m][n], 0, 0, 0); __builtin_amdgcn_s_setprio(0); } while (0)
#define PG8_WAIT_V(n) asm volatile("s_waitcnt vmcnt(" #n ")" ::: "memory")
#define PG8_WAIT_L(n) asm volatile("s_waitcnt lgkmcnt(" #n ")" ::: "memory")
#define PG8_BAR __builtin_amdgcn_s_barrier()
#define PG8_SCHED __builtin_amdgcn_sched_barrier(0)
    Unit cur, nxt; int ui = 0;
    if (!S.next(0, cur)) return;
    f32x4 acc[2][2][4][2];
#pragma unroll
    for (int a = 0; a < 2; ++a)
#pragma unroll
        for (int b = 0; b < 2; ++b)
#pragma unroll
            for (int m = 0; m < 4; ++m)
#pragma unroll
                for (int n = 0; n < 2; ++n) acc[a][b][m][n] = (f32x4){0.f, 0.f, 0.f, 0.f};
    bf16x8 At[4][2], B0[2][2], B1[2][2];
    const char* cA = (const char*)g.A + (size_t)cur.pm * tstep; const char* cB = (const char*)g.Bt + (size_t)cur.pn * tstep;
    S.a_ready(cur);
    if constexpr (SP2) {
        PG8_STAGE(PG8_SB(0, 0), cB, voffB); PG8_STAGE(PG8_SB(0, 1), cB + hstep, voffB); PG8_STAGE(PG8_SA(0, 0), cA, voffA); PG8_STAGE(PG8_SA(0, 1), cA + hstep, voffA);
        if (wr == 1) PG8_BAR;
        PG8_WAIT_V(2); PG8_BAR;
        PG8_STAGE(PG8_SB(1, 0), cB + kstep, voffB); PG8_STAGE(PG8_SA(1, 0), cA + kstep, voffA); PG8_STAGE(PG8_SB(1, 1), cB + hstep + kstep, voffB);
        PG8_WAIT_V(6); PG8_BAR;
    } else {
        PG8_STAGE(PG8_SB(0, 0), cB, voffB); PG8_STAGE(PG8_SA(0, 0), cA, voffA); PG8_STAGE(PG8_SB(0, 1), cB + hstep, voffB); PG8_STAGE(PG8_SA(0, 1), cA + hstep, voffA);
        if (wr == 1) PG8_BAR;
        PG8_WAIT_V(4); PG8_BAR;
        PG8_STAGE(PG8_SB(1, 0), cB + kstep, voffB); PG8_STAGE(PG8_SA(1, 0), cA + kstep, voffA); PG8_STAGE(PG8_SB(1, 1), cB + hstep + kstep, voffB);
        PG8_WAIT_V(6); PG8_BAR;
    }
    for (;;) {
        const bool has_next = S.next(ui + 1, nxt);
        const char* nA = has_next ? (const char*)g.A + (size_t)nxt.pm * tstep : cA; const char* nB = has_next ? (const char*)g.Bt + (size_t)nxt.pn * tstep : cB;
        for (int t = 0; t < nt; t += 2) {
            const bool last = (t == nt - 2);
            const char* a1 = cA + (size_t)(t + 1) * kstep;
            const char* a2 = last ? nA : cA + (size_t)(t + 2) * kstep; const char* b2 = last ? nB : cB + (size_t)(t + 2) * kstep;
            const char* a3 = a2 + kstep; const char* b3 = b2 + kstep;
            if (last && has_next) S.a_ready(nxt);
            if constexpr (SP2) {
            PG8_LDB(B0, 0, 0); PG8_LDB(B1, 0, 1); PG8_SCHED; PG8_LDA(At, 0, 0); PG8_STAGE(PG8_SA(1, 1), a1 + hstep, voffA);
            PG8_WAIT_V(8); PG8_WAIT_L(0); PG8_BAR; PG8_MMA(0, 0, At, B0); PG8_MMA(0, 1, At, B1); PG8_BAR; PG8_SCHED;
            PG8_LDA(At, 0, 1); PG8_STAGE(PG8_SB(0, 0), b2, voffB); PG8_STAGE(PG8_SB(0, 1), b2 + hstep, voffB); PG8_STAGE(PG8_SA(0, 0), a2, voffA);
            PG8_WAIT_V(8); PG8_WAIT_L(0); PG8_BAR; PG8_MMA(1, 0, At, B0); PG8_MMA(1, 1, At, B1); PG8_BAR; PG8_SCHED;
            PG8_LDB(B0, 1, 0); PG8_LDB(B1, 1, 1); PG8_SCHED; PG8_LDA(At, 1, 0); PG8_STAGE(PG8_SA(0, 1), a2 + hstep, voffA);
            PG8_WAIT_V(8); PG8_WAIT_L(0); PG8_BAR; PG8_MMA(0, 0, At, B0); PG8_MMA(0, 1, At, B1); PG8_BAR; PG8_SCHED;
            PG8_LDA(At, 1, 1); PG8_STAGE(PG8_SB(1, 0), b3, voffB); PG8_STAGE(PG8_SB(1, 1), b3 + hstep, voffB); PG8_STAGE(PG8_SA(1, 0), a3, voffA);
            PG8_WAIT_V(8); PG8_WAIT_L(0); PG8_BAR; PG8_MMA(1, 0, At, B0); PG8_MMA(1, 1, At, B1); PG8_BAR; PG8_SCHED;
            } else {
            PG8_LDB(B0, 0, 0); PG8_SCHED; PG8_LDA(At, 0, 0); PG8_STAGE(PG8_SA(1, 1), a1 + hstep, voffA);
            PG8_WAIT_L(8); PG8_BAR; PG8_WAIT_L(0); PG8_MMA(0, 0, At, B0); PG8_BAR; PG8_SCHED;
            PG8_LDB(B1, 0, 1); PG8_STAGE(PG8_SB(0, 0), b2, voffB);
            PG8_BAR; PG8_WAIT_L(0); PG8_MMA(0, 1, At, B1); PG8_BAR;
            PG8_LDA(At, 0, 1); PG8_STAGE(PG8_SA(0, 0), a2, voffA);
            PG8_BAR; PG8_WAIT_L(0); PG8_MMA(1, 0, At, B0); PG8_BAR; PG8_SCHED;
            PG8_STAGE(PG8_SB(0, 1), b2 + hstep, voffB);
            PG8_WAIT_V(6); PG8_BAR; PG8_MMA(1, 1, At, B1); PG8_BAR;
            PG8_LDB(B0, 1, 0); PG8_SCHED; PG8_LDA(At, 1, 0); PG8_STAGE(PG8_SA(0, 1), a2 + hstep, voffA);
            PG8_WAIT_L(8); PG8_BAR; PG8_WAIT_L(0); PG8_MMA(0, 0, At, B0); PG8_BAR; PG8_SCHED;
            PG8_LDB(B1, 1, 1); PG8_STAGE(PG8_SB(1, 0), b3, voffB);
            PG8_BAR; PG8_WAIT_L(0); PG8_MMA(0, 1, At, B1); PG8_BAR;
            PG8_LDA(At, 1, 1); PG8_STAGE(PG8_SA(1, 0), a3, voffA);
            PG8_BAR; PG8_WAIT_L(0); PG8_MMA(1, 0, At, B0); PG8_BAR; PG8_SCHED;
            PG8_STAGE(PG8_SB(1, 1), b3 + hstep, voffB);
            PG8_WAIT_V(6); PG8_BAR; PG8_MMA(1, 1, At, B1); PG8_BAR;
            }
        }
        if constexpr (ALIGN_EPI) { if (wr == 0) PG8_BAR; }
        if constexpr (!Epi::AFTER_DRAIN) { E(acc, cur, wr, wc, fr, fq); S.done(cur); }
        if (!has_next) break;
#pragma unroll
        for (int a = 0; a < 2; ++a)
#pragma unroll
            for (int b = 0; b < 2; ++b)
#pragma unroll
                for (int m = 0; m < 4; ++m)
#pragma unroll
                    for (int n = 0; n < 2; ++n) acc[a][b][m][n] = (f32x4){0.f, 0.f, 0.f, 0.f};
        cur = nxt; cA = nA; cB = nB; ++ui;
        if constexpr (ALIGN_EPI) { if (wr == 1) PG8_BAR; }
    }
    PG8_WAIT_V(0);
    if constexpr (!ALIGN_EPI) { if (wr == 0) PG8_BAR; }
    PG8_BAR;
    if constexpr (Epi::AFTER_DRAIN) { E.fused(acc, cur, wr, wc, fr, fq, lds, wid, lane); S.done(cur); }
#undef PG8_SA
#undef PG8_SB
#undef PG8_STAGE
#undef PG8_LDA
#undef PG8_LDB
#undef PG8_MMA
#undef PG8_WAIT_V
#undef PG8_WAIT_L
#undef PG8_BAR
#undef PG8_SCHED
}
}

#define LASP __attribute__((address_space(3)))

struct EpiProj {
    static constexpr bool PERM = true, AFTER_DRAIN = false;
    bf16* raw; bf16* rest;
    __device__ __forceinline__ void operator()(const pg8::f32x4 (&acc)[2][2][4][2], const pg8::Unit& u, int wr, int wc, int fr, int fq) const {
        const int row0 = u.pm * 256 + wr * 64 + fr;
        const int colb = u.pn * 256 + wc * 32 + 8 * fq;
#pragma unroll
        for (int bj = 0; bj < 2; ++bj) {
            const int col = colb + bj * 128;
            if (col >= NPROJ) continue;
            bf16* base; int ld;
            if (col < NRAW) { base = raw + col; ld = NRAW; } else { base = rest + (col - NRAW); ld = NREST; }
#pragma unroll
            for (int ai = 0; ai < 2; ++ai)
#pragma unroll
                for (int m = 0; m < 4; ++m) {
                    const pg8::f32x4 v0 = acc[ai][bj][m][0], v1 = acc[ai][bj][m][1];
                    pg8::u32x4 w; w.x = pg8::cvt_pk_bf16(v0[0], v0[1]); w.y = pg8::cvt_pk_bf16(v0[2], v0[3]); w.z = pg8::cvt_pk_bf16(v1[0], v1[1]); w.w = pg8::cvt_pk_bf16(v1[2], v1[3]);
                    *(pg8::u32x4*)(base + (size_t)(row0 + ai * 128 + m * 16) * ld) = w;
                }
        }
    }
};
struct EpiRes {
    static constexpr bool PERM = false, AFTER_DRAIN = false;
    const float* xl_src; const float* xc_src; float* out; float* xc1; const float* mods; int l;
    __device__ __forceinline__ void operator()(const pg8::f32x4 (&acc)[2][2][4][2], const pg8::Unit& u, int wr, int wc, int fr, int fq) const {
        const int row0 = u.pm * 256 + wr * 64 + fr, col0 = u.pn * 256 + wc * 32 + 4 * fq;
#pragma unroll
        for (int ai = 0; ai < 2; ++ai)
#pragma unroll
            for (int m = 0; m < 4; ++m) {
                const int r = row0 + ai * 128 + m * 16;
                const int b = r / TOK, t = r - b * TOK;
                const float* src; float* dst; int s;
                if (t < CTX) { if (l != 0) continue; src = xc_src + ((size_t)b * CTX + t) * D; dst = xc1 + ((size_t)b * CTX + t) * D; s = 8; }
                else { src = xl_src + ((size_t)b * SEQ + (t - CTX)) * D; dst = out + ((size_t)b * SEQ + (t - CTX)) * D; s = b; }
                const float* gt = mods + (size_t)(l * 9 + s) * 3072 + 2048;
#pragma unroll
                for (int bj = 0; bj < 2; ++bj)
#pragma unroll
                    for (int n = 0; n < 2; ++n) {
                        const int c = col0 + bj * 128 + n * 16;
                        const pg8::f32x4 xv = *(const pg8::f32x4*)(src + c), g = *(const pg8::f32x4*)(gt + c);
                        *(pg8::f32x4*)(dst + c) = xv * ALPHA + g * acc[ai][bj][m][n];
                    }
            }
    }
};

__device__ __forceinline__ void transpose_item(const float* W, int K, int N, bf16* WT, LASP float* scr, int item, int lane) {
    const int nblk = (N + 31) / 32, kb = item / nblk, nb = item % nblk, k0 = 64 * kb, n0 = 32 * nb;
    const bool nok = (n0 + (lane & 31)) < N;
#pragma unroll 8
    for (int i = 0; i < 32; ++i) { const int kk = 2 * i + (lane >> 5); scr[kk * 33 + (lane & 31)] = nok ? W[(size_t)(k0 + kk) * N + n0 + (lane & 31)] : 0.f; }
    asm volatile("s_waitcnt lgkmcnt(0)" ::: "memory");
    const int c = lane & 7;
#pragma unroll
    for (int j = 0; j < 4; ++j) {
        const int n = (lane >> 3) + 8 * j; const LASP float* s = scr + (8 * c) * 33 + n;
        uint4 o; o.x = pk2(s[0 * 33], s[1 * 33]); o.y = pk2(s[2 * 33], s[3 * 33]); o.z = pk2(s[4 * 33], s[5 * 33]); o.w = pk2(s[6 * 33], s[7 * 33]);
        *(uint4*)(WT + (size_t)(n0 + n) * K + k0 + 8 * c) = o;
    }
    asm volatile("s_waitcnt lgkmcnt(0)" ::: "memory");
}

__device__ void ph_prologue(const P& p, LASP unsigned char* lds, int bid, int nblk) {
    const int tid = mk_tid(), lane = tid & 63, wave = tid >> 6;
    LASP float* sm = (LASP float*)lds;
    if (bid * NTHREADS < 2 * 3072) {
        for (int i = tid; i < 9 * 1024; i += NTHREADS) {
            int s = i >> 10, d = i & 1023;
            float cv = s < 8 ? p.c[s * 1024 + d] : p.c_ctx[d];
            sm[i] = silu_f(cv);
        }
        __syncthreads();
        for (int o = bid * NTHREADS + tid; o < 2 * 3072; o += nblk * NTHREADS) {
            int l = o / 3072, j = o % 3072;
            const float* w = p.w_mod + (size_t)l * 1024 * 3072 + j;
            float acc[9];
#pragma unroll
            for (int s = 0; s < 9; ++s) acc[s] = 0.f;
            for (int i = 0; i < 1024; ++i) {
                float wv = w[(size_t)i * 3072];
#pragma unroll
                for (int s = 0; s < 9; ++s) acc[s] += sm[s * 1024 + i] * wv;
            }
            float bb = p.b_mod[l * 3072 + j];
#pragma unroll
            for (int s = 0; s < 9; ++s) p.mods[(size_t)(l * 9 + s) * 3072 + j] = acc[s] + bb;
        }
        __syncthreads();
    }
#if PROBE
    if (bid == 0 && tid < 4) p.stats[tid] = 0.f;
#endif
    LASP float* scr = (LASP float*)(lds + 40960 + wave * 8704);
    const int gw = (nblk - 1 - bid) * NWAVES + wave, NGW = nblk * NWAVES;
    constexpr int I_IN = 16 * 122, I_OUT = 16 * 32;
    for (int it = gw; it < 2 * (I_IN + I_OUT); it += NGW) {
        int l = it / (I_IN + I_OUT), r = it % (I_IN + I_OUT);
        if (r < I_IN) transpose_item(p.w_in + (size_t)l * D * NPROJ, D, NPROJ, p.wi_t + (size_t)l * NPAD * D, scr, r, lane);
        else transpose_item(p.w_out + (size_t)l * D * D, D, D, p.wo_t + (size_t)l * D * D, scr, r - I_IN, lane);
    }
    for (int i = bid * NTHREADS + tid; i < 2 * 192 * 128; i += nblk * NTHREADS) {
        int l = i / (192 * 128), r = i % (192 * 128);
        *(uint4*)(p.wi_t + (size_t)l * NPAD * D + (size_t)3904 * D + (size_t)r * 8) = make_uint4(0, 0, 0, 0);
    }
}

__device__ void ph_lnpass(const P& p, int mode, int bid, int nblk) {
    const int tid = mk_tid();
    const int lane = tid & 63, wave = tid >> 6;
    for (int r = bid * NWAVES + wave; r < ROWS; r += nblk * NWAVES) {
        const int b = r / TOK, t = r - b * TOK;
        const bool isc = t < CTX;
        if (mode == 2 && isc) continue;
        float* buf; const float* src; int s;
        if (isc) { buf = p.xc1 + ((size_t)b * CTX + t) * D; src = (mode == 0) ? p.ctx + ((size_t)b * CTX + t) * D : buf; s = 8; }
        else { buf = p.out + ((size_t)b * SEQ + (t - CTX)) * D; src = (mode == 0) ? p.x + ((size_t)b * SEQ + (t - CTX)) * D : buf; s = b; }
        f32x4_t v[4];
#pragma unroll
        for (int j = 0; j < 4; ++j) v[j] = *(const f32x4_t*)(src + 256 * j + 4 * lane);
        if (mode >= 1) {
            const int lp = mode - 1;
            float sum = 0.f;
#pragma unroll
            for (int j = 0; j < 4; ++j) sum += (v[j].x + v[j].y) + (v[j].z + v[j].w);
            const float mu = wave_sum(sum) * (1.f / 1024.f);
            float sq = 0.f;
#pragma unroll
            for (int j = 0; j < 4; ++j) { v[j] = v[j] - mu; sq += (v[j].x * v[j].x + v[j].y * v[j].y) + (v[j].z * v[j].z + v[j].w * v[j].w); }
            const float rs = 1.f / sqrtf(wave_sum(sq) * (1.f / 1024.f) + 1e-6f);
#pragma unroll
            for (int j = 0; j < 4; ++j) {
                const f32x4_t g = *(const f32x4_t*)(p.ln_g + lp * 1024 + 256 * j + 4 * lane), bb = *(const f32x4_t*)(p.ln_b + lp * 1024 + 256 * j + 4 * lane);
                v[j] = v[j] * rs * g + bb;
#if PROBE
                if (mode == 2) v[j] = v[j] + (p.stats[0] / fmaxf(p.stats[1], 1e-20f));
#endif
#if TPROBE >= 0
                if (mode == 2) v[j] = v[j] + exp2f((rintf(log2f(fmaxf(p.stats[2], 1.f)) * 6.f + TSHIFT * 0.5f) - TSHIFT * 0.5f) * (1.f / 6.f)) * 1e-4f;
#endif
                *(f32x4_t*)(buf + 256 * j + 4 * lane) = v[j];
            }
            if (mode == 2) continue;
        }
        const int l = mode;
        float sum = 0.f;
#pragma unroll
        for (int j = 0; j < 4; ++j) sum += (v[j].x + v[j].y) + (v[j].z + v[j].w);
        const float mu = wave_sum(sum) * (1.f / 1024.f);
        float sq = 0.f;
#pragma unroll
        for (int j = 0; j < 4; ++j) { v[j] = v[j] - mu; sq += (v[j].x * v[j].x + v[j].y * v[j].y) + (v[j].z * v[j].z + v[j].w * v[j].w); }
        const float rs = 1.f / sqrtf(wave_sum(sq) * (1.f / 1024.f) + 1e-6f);
        const float* md = p.mods + (size_t)(l * 9 + s) * 3072;
#pragma unroll
        for (int j = 0; j < 4; ++j) {
            const f32x4_t sh = *(const f32x4_t*)(md + 256 * j + 4 * lane), sc = *(const f32x4_t*)(md + 1024 + 256 * j + 4 * lane);
            const f32x4_t o = v[j] * rs * (sc + 1.f) + sh;
            uint2 w; w.x = pk2(o.x, o.y); w.y = pk2(o.z, o.w);
            *(uint2*)(p.ml + (size_t)r * D + 256 * j + 4 * lane) = w;
        }
    }
}

__device__ void ph_conv(const P& p, int l, int bid, int nblk) {
    const int tid = mk_tid();
    const int lane = tid & 63, wave = tid >> 6;
    const float* cw = p.conv_w + (size_t)l * 5 * 1536;
    constexpr int NSTRIP = TOK / 16;
    for (int it = bid * NWAVES + wave; it < BATCH * NSTRIP * 3; it += nblk * NWAVES) {
        const int third = it % 3, rest_i = it / 3, strip = rest_i % NSTRIP, b = rest_i / NSTRIP;
        const int t0 = strip * 16;
        const int lo = t0 < CTX ? 0 : CTX, hi = t0 < CTX ? CTX : TOK;
        const int ch = third * 512 + lane * 8;
        float w[5][8];
#pragma unroll
        for (int j = 0; j < 5; ++j) {
            const f32x4_t a = *(const f32x4_t*)(cw + j * 1536 + ch), c = *(const f32x4_t*)(cw + j * 1536 + ch + 4);
            w[j][0] = a.x; w[j][1] = a.y; w[j][2] = a.z; w[j][3] = a.w; w[j][4] = c.x; w[j][5] = c.y; w[j][6] = c.z; w[j][7] = c.w;
        }
        const bf16* src = p.raw + ((size_t)b * TOK + t0) * NRAW + ch;
        bf16* dst = p.qkvn + ((size_t)b * TOK + t0) * NRAW + ch;
        uint4 rw[20];
#pragma unroll
        for (int i = 0; i < 20; ++i) {
            const int tt = t0 + i - 2;
            rw[i] = (tt >= lo && tt < hi) ? *(const uint4*)(src + (ptrdiff_t)(i - 2) * NRAW) : make_uint4(0, 0, 0, 0);
        }
        const int g = (ch >> 7);
        const float qs = g < 4 ? 0.08838834764831845f : 1.f;
#pragma unroll
        for (int n = 0; n < 16; ++n) {
            float acc[8];
#pragma unroll
            for (int e = 0; e < 8; ++e) acc[e] = 0.f;
#pragma unroll
            for (int j = 0; j < 5; ++j) {
                float f[8]; unpack8(rw[n + j], f);
#pragma unroll
                for (int e = 0; e < 8; ++e) acc[e] += w[j][e] * f[e];
            }
            float ss = 0.f;
#pragma unroll
            for (int e = 0; e < 8; ++e) { acc[e] = silu_f(acc[e]); ss += acc[e] * acc[e]; }
            if (g < 8) {
#pragma unroll
                for (int m = 8; m > 0; m >>= 1) ss += __shfl_xor(ss, m);
                const float sc = qs / sqrtf(ss + 1e-6f);
#pragma unroll
                for (int e = 0; e < 8; ++e) acc[e] *= sc;
            }
            uint4 o; o.x = pk2(acc[0], acc[1]); o.y = pk2(acc[2], acc[3]); o.z = pk2(acc[4], acc[5]); o.w = pk2(acc[6], acc[7]);
            *(uint4*)(dst + (size_t)n * NRAW) = o;
        }
    }
}

typedef short bf16x8_t __attribute__((ext_vector_type(8)));
typedef float f32x16_t __attribute__((ext_vector_type(16)));
typedef float f32x2_t __attribute__((ext_vector_type(2)));
typedef __bf16 bf16x2_t __attribute__((ext_vector_type(2)));
typedef unsigned u32x4_t __attribute__((ext_vector_type(4)));
#define MFMA32(a, b, c) __builtin_amdgcn_mfma_f32_32x32x16_bf16((a), (b), (c), 0, 0, 0)
__device__ __forceinline__ unsigned cvtpk(float lo, float hi) { f32x2_t v = {lo, hi}; bf16x2_t q = __builtin_convertvector(v, bf16x2_t); return __builtin_bit_cast(unsigned, q); }
__device__ __forceinline__ int crow(int reg, int h) { return (reg & 3) + 8 * (reg >> 2) + 4 * h; }
__device__ __forceinline__ int perm16(int a) { const int x = a & 15; return (a & ~15) + (x < 4 ? x : x < 8 ? x + 4 : x < 12 ? x - 4 : x); }
#define PACK8(x, s) __builtin_bit_cast(bf16x8_t, (u32x4_t){cvtpk((x)[8 * (s)], (x)[8 * (s) + 1]), cvtpk((x)[8 * (s) + 2], (x)[8 * (s) + 3]), cvtpk((x)[8 * (s) + 4], (x)[8 * (s) + 5]), cvtpk((x)[8 * (s) + 6], (x)[8 * (s) + 7])})
constexpr int GCH = 32, NCH = TOK / GCH;
constexpr int GP_ITEM = 4416;

__device__ void ph_gdnprep(const P& p, LASP unsigned char* lds, int l, int bid, int nblk, int tid) {
    const int lane = tid & 63, wave = tid >> 6, r = lane & 31, hh = lane >> 5;
    LASP float* Lm = (LASP float*)(lds + wave * 16384);
    LASP float* Xs = Lm + 2048;
    for (int it = bid * NWAVES + wave; it < BATCH * 4 * NCH; it += nblk * NWAVES) {
        const int c = it % NCH, bh = it / NCH, h = bh & 3, b = bh >> 2;
        const size_t row0 = (size_t)b * TOK + (size_t)c * GCH;
        f32x16_t KK, QK;
#pragma unroll
        for (int i = 0; i < 16; ++i) { KK[i] = 0.f; QK[i] = 0.f; }
        const bf16* kbase = p.qkvn + (row0 + r) * NRAW + 512 + h * 128 + 8 * hh;
        const bf16* qbase = p.qkvn + (row0 + r) * NRAW + h * 128 + 8 * hh;
#pragma unroll
        for (int s = 0; s < 8; ++s) {
            const bf16x8_t kf = *(const bf16x8_t*)(kbase + 16 * s), qf = *(const bf16x8_t*)(qbase + 16 * s);
            KK = MFMA32(kf, kf, KK);
            QK = MFMA32(qf, kf, QK);
        }
        float Gd, bd;
        {
            const bf16* ab = p.rest + (row0 + r) * NREST + RC_AB;
            const float a = bf2f(ab[hh * 4 + h]) + p.dt_bias[(l * 2 + hh) * 4 + h];
            const float sp = fmaxf(a, 0.f) + log1pf(expf(-fabsf(a)));
            Gd = -expf(p.a_log[(l * 2 + hh) * 4 + h]) * sp;
            bd = 1.f / (1.f + expf(-bf2f(ab[(2 + hh) * 4 + h])));
        }
#pragma unroll
        for (int off = 1; off < 32; off <<= 1) {
            const float up = __shfl_up(Gd, off, 32), dn = __shfl_down(Gd, off, 32);
            if (hh == 0) { if (r >= off) Gd += up; } else { if (r + off < 32) Gd += dn; }
        }
        unsigned char* gout = (unsigned char*)p.raw + ((size_t)(bh * 2) * NCH + c) * GP_ITEM;
        {
            const float Glast = __shfl(Gd, hh == 0 ? 31 : 32);
            float* sc = (float*)(gout + (size_t)hh * NCH * GP_ITEM + 4096);
            sc[r] = expf(Gd); sc[32 + r] = expf(Glast - Gd);
            if (r == 0) sc[64] = expf(Glast);
        }
        asm volatile("s_waitcnt lgkmcnt(0)" ::: "memory");
#pragma unroll
        for (int d = 0; d < 2; ++d) {
            const float Gcol = __shfl(Gd, d * 32 + r);
            bf16* qko = (bf16*)(gout + (size_t)d * NCH * GP_ITEM + 2048);
#pragma unroll
            for (int i = 0; i < 16; ++i) {
                const int n = crow(i, hh);
                const float Grow = __shfl(Gd, d * 32 + n), brow = __shfl(bd, d * 32 + n);
                const bool incl = d == 0 ? (r <= n) : (r >= n), strict = d == 0 ? (r < n) : (r > n);
                const float dec = expf(incl ? Grow - Gcol : 0.f);
                const float lv = strict ? brow * KK[i] * dec : 0.f;
                const float qv = incl ? QK[i] * dec : 0.f;
                const int n2 = d == 0 ? n : 31 - n, m2 = d == 0 ? r : 31 - r;
                Lm[(d * 32 + n2) * 32 + m2] = lv;
                qko[n * 32 + perm16(r)] = f2bf(qv);
                if ((i & 3) == 3) __builtin_amdgcn_sched_barrier(0);
            }
        }
        asm volatile("s_waitcnt lgkmcnt(0)" ::: "memory");
        {
            const LASP float* Lr = Lm + hh * 1024;
            LASP float* xc = Xs + lane;
#pragma unroll 4
            for (int j = 0; j < 32; ++j) xc[j * 64] = (j == r) ? 1.f : 0.f;
#pragma unroll 1
            for (int n = 1; n < 32; ++n) {
                float a0 = 0.f, a1 = 0.f;
#pragma unroll 1
                for (int j4 = 0; j4 < n; j4 += 4) {
                    const f32x4_t lv = *(const LASP f32x4_t*)(Lr + n * 32 + j4);
                    a0 += lv.x * xc[(j4 + 0) * 64]; a1 += lv.y * xc[(j4 + 1) * 64];
                    a0 += lv.z * xc[(j4 + 2) * 64]; a1 += lv.w * xc[(j4 + 3) * 64];
                }
                xc[n * 64] -= (a0 + a1);
            }
            const int mtok = hh == 0 ? r : 31 - r;
            const float bcol = __shfl(bd, hh * 32 + mtok);
            bf16* tq = (bf16*)(gout + (size_t)hh * NCH * GP_ITEM) + perm16(mtok) + (hh == 0 ? 0 : 31 * 32);
            const int tstep = hh == 0 ? 32 : -32;
#pragma unroll 4
            for (int n = 0; n < 32; ++n) { *tq = f2bf(xc[n * 64] * bcol); tq += tstep; }
        }
        asm volatile("s_waitcnt lgkmcnt(0)" ::: "memory");
    }
}


constexpr int ST_KA = 0, ST_QA = 8704, ST_V = 17408, ST_TP = 25600, ST_QK = 28160, ST_SC = 30720, ST_BYTES = 31104;
typedef unsigned u32x2_t __attribute__((ext_vector_type(2)));
struct GSlot { u32x4_t k0, k1, q0, q1, v0, v1, t; f32x4_t sc; };

__device__ __forceinline__ int gdn_chunk(int dir, int s) { return dir == 0 ? s : (s < 8 ? 7 - s : 143 - s); }
__device__ __forceinline__ void gdn_issue(const P& p, GSlot& g, int b, int h, int dir, int step, int tl) {
    const int c = gdn_chunk(dir, step);
    const size_t row0 = (size_t)b * TOK + (size_t)c * GCH;
    const int r0 = tl >> 4, c16 = tl & 15;
    const bf16* a0 = p.qkvn + (row0 + r0) * NRAW + h * 128 + 8 * c16;
    const bf16* a1 = a0 + (size_t)16 * NRAW;
    g.q0 = *(const u32x4_t*)a0; g.q1 = *(const u32x4_t*)a1;
    g.k0 = *(const u32x4_t*)(a0 + 512); g.k1 = *(const u32x4_t*)(a1 + 512);
    g.v0 = *(const u32x4_t*)(a0 + 1024); g.v1 = *(const u32x4_t*)(a1 + 1024);
    const unsigned char* gp = (const unsigned char*)p.raw + ((size_t)((b * 4 + h) * 2 + dir) * NCH + c) * GP_ITEM;
    g.t = *(const u32x4_t*)(gp + tl * 16);
    g.sc = *(const f32x4_t*)(gp + 4096 + (tl < 20 ? tl : 0) * 16);
}
__device__ __forceinline__ void gdn_put_rows(LASP unsigned char* st, int row, int c16, u32x4_t kq, int off) {
    const int g = c16 >> 1, odd = c16 & 1;
    *(LASP u32x2_t*)(st + off + row * 272 + (16 * g + (odd ? 4 : 0)) * 2) = (u32x2_t){kq.x, kq.y};
    *(LASP u32x2_t*)(st + off + row * 272 + (16 * g + (odd ? 12 : 8)) * 2) = (u32x2_t){kq.z, kq.w};
}
__device__ __forceinline__ void gdn_write(LASP unsigned char* st, const GSlot& g, int tl) {
    const int r0 = tl >> 4, c16 = tl & 15;
    gdn_put_rows(st, r0, c16, g.k0, ST_KA); gdn_put_rows(st, r0 + 16, c16, g.k1, ST_KA);
    gdn_put_rows(st, r0, c16, g.q0, ST_QA); gdn_put_rows(st, r0 + 16, c16, g.q1, ST_QA);
    *(LASP u32x4_t*)(st + ST_V + r0 * 256 + c16 * 16) = g.v0;
    *(LASP u32x4_t*)(st + ST_V + (r0 + 16) * 256 + c16 * 16) = g.v1;
    { const int t2 = tl & 127; *(LASP u32x4_t*)(st + (tl < 128 ? ST_TP : ST_QK) + (t2 >> 2) * 80 + (t2 & 3) * 16) = g.t; }
    if (tl < 20) *(LASP f32x4_t*)(st + ST_SC + tl * 16) = g.sc;
}

#if TPROBE == 60
#define GDN_SYNC_C() do { unsigned long long t_ = __builtin_amdgcn_s_memrealtime(); __syncthreads(); if (chain == 0 && tid == 0) p.stats[2] += (float)(__builtin_amdgcn_s_memrealtime() - t_) * 0.01f; } while (0)
#define GDN_SYNC_L() __syncthreads()
#elif TPROBE == 61
#define GDN_SYNC_L() do { unsigned long long t_ = __builtin_amdgcn_s_memrealtime(); __syncthreads(); if (chain == 0 && tid == 256) p.stats[2] += (float)(__builtin_amdgcn_s_memrealtime() - t_) * 0.01f; } while (0)
#define GDN_SYNC_C() __syncthreads()
#else
#define GDN_SYNC_C() __syncthreads()
#define GDN_SYNC_L() __syncthreads()
#endif
__device__ void gdn_scan_fast(const P& p, LASP unsigned char* lds, int chain) {
    const int tid = mk_tid();
    const int lane = tid & 63, wave = __builtin_amdgcn_readfirstlane(tid >> 6);
    const int dir = chain & 1, h = (chain >> 1) & 3, b = chain >> 3;
    constexpr int NS = NCH;
    if (wave >= 4) {
        const int tl = tid - 256;
        GSlot g0, g1, g2, g3;
        gdn_issue(p, g0, b, h, dir, 0, tl); gdn_issue(p, g1, b, h, dir, 1, tl); gdn_issue(p, g2, b, h, dir, 2, tl); gdn_issue(p, g3, b, h, dir, 3, tl);
        gdn_write(lds, g0, tl); gdn_issue(p, g0, b, h, dir, 4, tl);
        __syncthreads();
#pragma unroll 1
        for (int s = 0; s < NS; s += 4) {
            gdn_write(lds + ((s + 1) & 1) * ST_BYTES, g1, tl); gdn_issue(p, g1, b, h, dir, min(s + 5, NS - 1), tl);
            GDN_SYNC_L();
            gdn_write(lds + ((s + 2) & 1) * ST_BYTES, g2, tl); gdn_issue(p, g2, b, h, dir, min(s + 6, NS - 1), tl);
            GDN_SYNC_L();
            gdn_write(lds + ((s + 3) & 1) * ST_BYTES, g3, tl); gdn_issue(p, g3, b, h, dir, min(s + 7, NS - 1), tl);
            GDN_SYNC_L();
            gdn_write(lds + ((s + 4) & 1) * ST_BYTES, g0, tl); gdn_issue(p, g0, b, h, dir, min(s + 8, NS - 1), tl);
            GDN_SYNC_L();
        }
    } else {
        const int r = lane & 31, hh = lane >> 5, w = wave;
        f32x16_t S0, S1, S2, S3;
#pragma unroll
        for (int i = 0; i < 16; ++i) { S0[i] = 0.f; S1[i] = 0.f; S2[i] = 0.f; S3[i] = 0.f; }
        __syncthreads();
#pragma unroll 1
        for (int s = 0; s < NS; ++s) {
            LASP unsigned char* st = lds + (s & 1) * ST_BYTES;
            const bf16x8_t Sb00 = PACK8(S0, 0), Sb01 = PACK8(S0, 1), Sb10 = PACK8(S1, 0), Sb11 = PACK8(S1, 1);
            const bf16x8_t Sb20 = PACK8(S2, 0), Sb21 = PACK8(S2, 1), Sb30 = PACK8(S3, 0), Sb31 = PACK8(S3, 1);
            f32x16_t ak, aq;
#pragma unroll
            for (int i = 0; i < 16; ++i) { ak[i] = 0.f; aq[i] = 0.f; }
            const LASP unsigned char* ka = st + ST_KA + r * 272 + hh * 16;
            const LASP unsigned char* qa = st + ST_QA + r * 272 + hh * 16;
#define GDN_KQ(ks, SB) { const bf16x8_t A = *(const LASP bf16x8_t*)(ka + (ks) * 32); ak = MFMA32(A, SB, ak); const bf16x8_t A2 = *(const LASP bf16x8_t*)(qa + (ks) * 32); aq = MFMA32(A2, SB, aq); }
            GDN_KQ(0, Sb00) GDN_KQ(1, Sb01) GDN_KQ(2, Sb10) GDN_KQ(3, Sb11) GDN_KQ(4, Sb20) GDN_KQ(5, Sb21) GDN_KQ(6, Sb30) GDN_KQ(7, Sb31)
#undef GDN_KQ
            const LASP float* sc = (const LASP float*)(st + ST_SC);
            float ev[16], fv[16];
#pragma unroll
            for (int g = 0; g < 4; ++g) {
                const f32x4_t e4 = *(const LASP f32x4_t*)(sc + 8 * g + 4 * hh), f4 = *(const LASP f32x4_t*)(sc + 32 + 8 * g + 4 * hh);
                ev[4 * g] = e4.x; ev[4 * g + 1] = e4.y; ev[4 * g + 2] = e4.z; ev[4 * g + 3] = e4.w;
                fv[4 * g] = f4.x; fv[4 * g + 1] = f4.y; fv[4 * g + 2] = f4.z; fv[4 * g + 3] = f4.w;
            }
            const float gl = sc[64];
            const LASP unsigned short* vl = (const LASP unsigned short*)(st + ST_V) + 32 * w + r;
            f32x16_t rr;
#pragma unroll
            for (int i = 0; i < 16; ++i) rr[i] = bf2f(vl[crow(i, hh) * 128]) - ev[i] * ak[i];
            const bf16x8_t rb0 = PACK8(rr, 0), rb1 = PACK8(rr, 1);
            f32x16_t vn;
#pragma unroll
            for (int i = 0; i < 16; ++i) vn[i] = 0.f;
            const LASP unsigned char* tp = st + ST_TP + r * 80 + hh * 16;
            vn = MFMA32(*(const LASP bf16x8_t*)(tp), rb0, vn);
            vn = MFMA32(*(const LASP bf16x8_t*)(tp + 32), rb1, vn);
#pragma unroll
            for (int i = 0; i < 16; ++i) aq[i] *= ev[i];
            const bf16x8_t vb0 = PACK8(vn, 0), vb1 = PACK8(vn, 1);
            const LASP unsigned char* qk = st + ST_QK + r * 80 + hh * 16;
            aq = MFMA32(*(const LASP bf16x8_t*)(qk), vb0, aq);
            aq = MFMA32(*(const LASP bf16x8_t*)(qk + 32), vb1, aq);
            {
                LASP unsigned short* ost = (LASP unsigned short*)(lds + 2 * ST_BYTES + 256 + w * 2560);
#pragma unroll
                for (int i = 0; i < 16; ++i) ost[crow(i, hh) * 40 + r] = f2bf(aq[i]);
                asm volatile("s_waitcnt lgkmcnt(0)" ::: "memory");
                const int c = gdn_chunk(dir, s);
                const int orow = lane >> 1, oh = lane & 1;
                const u32x4_t o0 = *(const LASP u32x4_t*)((const LASP unsigned char*)ost + orow * 80 + oh * 32);
                const u32x4_t o1 = *(const LASP u32x4_t*)((const LASP unsigned char*)ost + orow * 80 + oh * 32 + 16);
                bf16* op = p.oa + ((size_t)dir * ROWS + (size_t)b * TOK + (size_t)c * GCH + orow) * 512 + h * 128 + 32 * w + oh * 16;
                *(u32x4_t*)op = o0; *(u32x4_t*)(op + 8) = o1;
            }
            f32x16_t vf;
#pragma unroll
            for (int i = 0; i < 16; ++i) vf[i] = vn[i] * fv[i];
            const bf16x8_t fb0 = PACK8(vf, 0), fb1 = PACK8(vf, 1);
            const LASP unsigned short* kc = (const LASP unsigned short*)(st + ST_KA) + perm16(r) + (4 * hh) * 136;
#define KPAIR(mt, t) ((unsigned)kc[(t) * 136 + 32 * (mt)] | ((unsigned)kc[((t) + 1) * 136 + 32 * (mt)] << 16))
#define KTFRAG(mt, u) __builtin_bit_cast(bf16x8_t, (u32x4_t){KPAIR(mt, 16 * (u)), KPAIR(mt, 16 * (u) + 2), KPAIR(mt, 16 * (u) + 8), KPAIR(mt, 16 * (u) + 10)})
#define GDN_UPD(SX, mt) { _Pragma("unroll") for (int i = 0; i < 16; ++i) SX[i] *= gl; SX = MFMA32(KTFRAG(mt, 0), fb0, SX); SX = MFMA32(KTFRAG(mt, 1), fb1, SX); }
            GDN_UPD(S0, 0) GDN_UPD(S1, 1) GDN_UPD(S2, 2) GDN_UPD(S3, 3)
#undef GDN_UPD
#undef KTFRAG
#undef KPAIR
            GDN_SYNC_C();
        }
    }
}


constexpr int GL_ITEM = 6272;
constexpr size_t GLA_PREP_OFF = (size_t)BATCH * 4 * 2 * NCH * GP_ITEM;

__device__ __forceinline__ void gla_prep_item(const P& p, LASP unsigned char* wl, const LASP float* cstab, int l, int it, int lane) {
    const int r = lane & 31, hh = lane >> 5;
    const int c = it % NCH, bh = it / NCH, h = bh & 3, b = bh >> 2;
    const size_t row0 = (size_t)b * TOK + (size_t)c * GCH;
    float qv[16], kv[16];
    {
        const bf16* qb = p.rest + (row0 + 4 * hh) * NREST + RC_CQ + h * 32 + r;
#pragma unroll
        for (int i = 0; i < 16; ++i) { const int no = (i & 3) + 8 * (i >> 2); qv[i] = bf2f(qb[(size_t)no * NREST]); kv[i] = bf2f(qb[(size_t)no * NREST + 128]); }
    }
    if (c >= 8) {
        const int dd = r & 15, f = dd & 7;
        const int prow = (c - 8) >> 1, pcol0 = 32 * ((c - 8) & 1);
#pragma unroll
        for (int i = 0; i < 16; ++i) {
            const int n = crow(i, hh);
            const int pos = r < 16 ? prow : pcol0 + n;
            const float cs = cstab[(pos * 8 + f) * 2], sn = cstab[(pos * 8 + f) * 2 + 1];
            const float qp = __shfl_xor(qv[i], 8), kp = __shfl_xor(kv[i], 8);
            if (dd < 8) { qv[i] = qv[i] * cs - qp * sn; kv[i] = kv[i] * cs - kp * sn; }
            else { qv[i] = qp * sn + qv[i] * cs; kv[i] = kp * sn + kv[i] * cs; }
        }
    }
#pragma unroll
    for (int i = 0; i < 16; ++i) qv[i] *= 0.17677669529663687f;
#pragma unroll 1
    for (int dir = 0; dir < 2; ++dir) {
        f32x16_t X;
#pragma unroll
        for (int i = 0; i < 16; ++i) X[i] = 0.f;
        {
            const bf16x8_t A = *(const bf16x8_t*)(p.rest + (row0 + r) * NREST + RC_CR + dir * 16 + 8 * hh);
            const float* w2p = p.gla_w2 + ((size_t)(l * 2 + dir) * 16 + 8 * hh) * 128 + h * 32 + r;
            const bf16x8_t Bf = __builtin_bit_cast(bf16x8_t, (u32x4_t){cvtpk(w2p[0], w2p[128]), cvtpk(w2p[256], w2p[384]), cvtpk(w2p[512], w2p[640]), cvtpk(w2p[768], w2p[896])});
            X = MFMA32(A, Bf, X);
        }
        const float b2v = p.gla_b2[(l * 2 + dir) * 128 + h * 32 + r];
        float Bc[16];
#pragma unroll
        for (int i = 0; i < 16; ++i) { const float xg = X[i] + b2v; Bc[i] = (fminf(xg, 0.f) - log1pf(expf(-fabsf(xg)))) * (1.f / 16.f); }
        float tot;
        {
            float sg[4], ps[4];
#pragma unroll
            for (int g = 0; g < 4; ++g) { sg[g] = (Bc[4 * g] + Bc[4 * g + 1]) + (Bc[4 * g + 2] + Bc[4 * g + 3]); ps[g] = __shfl_xor(sg[g], 32); }
            tot = ((sg[0] + ps[0]) + (sg[1] + ps[1])) + ((sg[2] + ps[2]) + (sg[3] + ps[3]));
            if (dir == 0) {
                float base = 0.f;
#pragma unroll
                for (int g = 0; g < 4; ++g) {
                    float o = base + (hh ? ps[g] : 0.f);
#pragma unroll
                    for (int k = 0; k < 4; ++k) { o += Bc[4 * g + k]; Bc[4 * g + k] = o; }
                    base += sg[g] + ps[g];
                }
            } else {
                float base = 0.f;
#pragma unroll
                for (int g = 3; g >= 0; --g) {
                    float o = base + (hh ? 0.f : ps[g]);
#pragma unroll
                    for (int k = 3; k >= 0; --k) { o += Bc[4 * g + k]; Bc[4 * g + k] = o; }
                    base += sg[g] + ps[g];
                }
            }
        }
        unsigned char* gout = (unsigned char*)p.raw + GLA_PREP_OFF + ((size_t)(bh * 2 + dir) * NCH + c) * GL_ITEM;
        LASP bf16* ql = (LASP bf16*)wl;
        LASP bf16* kl = ql + 32 * 40;
        {
            bf16* qpo = (bf16*)gout + perm16(r);
            bf16* kdo = (bf16*)(gout + 4096) + r * 32;
#pragma unroll
            for (int g = 0; g < 4; ++g) {
                float kd[4];
#pragma unroll
                for (int k = 0; k < 4; ++k) {
                    const int i = 4 * g + k, n = crow(i, hh);
                    const float eb = expf(Bc[i]);
                    const float qs = qv[i] * eb, ks = kv[i] / eb;
                    kd[k] = kv[i] * expf(tot - Bc[i]);
                    const bf16 qsb = f2bf(qs);
                    qpo[n * 32] = qsb;
                    ql[n * 40 + r] = qsb; kl[n * 40 + r] = f2bf(ks);
                }
                *(u32x2_t*)(kdo + perm16(8 * g + 4 * hh)) = (u32x2_t){cvtpk(kd[0], kd[1]), cvtpk(kd[2], kd[3])};
            }
            if (hh == 0) ((float*)(gout + 6144))[r] = expf(tot);
        }
        asm volatile("s_waitcnt lgkmcnt(0)" ::: "memory");
        f32x16_t AT;
#pragma unroll
        for (int i = 0; i < 16; ++i) AT[i] = 0.f;
        AT = MFMA32(*(const LASP bf16x8_t*)((const LASP unsigned char*)kl + r * 80 + hh * 16), *(const LASP bf16x8_t*)((const LASP unsigned char*)ql + r * 80 + hh * 16), AT);
        AT = MFMA32(*(const LASP bf16x8_t*)((const LASP unsigned char*)kl + r * 80 + hh * 16 + 32), *(const LASP bf16x8_t*)((const LASP unsigned char*)ql + r * 80 + hh * 16 + 32), AT);
        {
            bf16* amo = (bf16*)(gout + 2048) + r * 32;
#pragma unroll
            for (int g = 0; g < 4; ++g) {
                float a[4];
#pragma unroll
                for (int k = 0; k < 4; ++k) { const int m = crow(4 * g + k, hh); const bool keep = dir == 0 ? (m <= r) : (m >= r); a[k] = keep ? AT[4 * g + k] : 0.f; }
                *(u32x2_t*)(amo + perm16(8 * g + 4 * hh)) = (u32x2_t){cvtpk(a[0], a[1]), cvtpk(a[2], a[3])};
            }
        }
        asm volatile("s_waitcnt lgkmcnt(0)" ::: "memory");
    }
}

constexpr int LS_QP = 0, LS_AM = 2560, LS_KD = 5120, LS_V = 7680, LS_GL = 12288, LS_BYTES = 12416;
struct LSlot { u32x4_t a0, a1, a2, v0, v1; f32x4_t gl; };
__device__ __forceinline__ void gla_issue(const P& p, LSlot& g, int b, int h, int dir, int step, int t2) {
    const int c = gdn_chunk(dir, step);
    const unsigned char* gp = (const unsigned char*)p.raw + GLA_PREP_OFF + ((size_t)((b * 4 + h) * 2 + dir) * NCH + c) * GL_ITEM;
    g.a0 = *(const u32x4_t*)(gp + t2 * 16); g.a1 = *(const u32x4_t*)(gp + 2048 + t2 * 16); g.a2 = *(const u32x4_t*)(gp + 4096 + t2 * 16);
    g.gl = *(const f32x4_t*)(gp + 6144 + (t2 < 8 ? t2 : 0) * 16);
    const size_t row0 = (size_t)b * TOK + (size_t)c * GCH;
    const bf16* vp = p.rest + (row0 + (t2 >> 3)) * NREST + RC_CV + h * 64 + 8 * (t2 & 7);
    g.v0 = *(const u32x4_t*)vp; g.v1 = *(const u32x4_t*)(vp + (size_t)16 * NREST);
}
__device__ __forceinline__ void gla_write(LASP unsigned char* st, const LSlot& g, int t2) {
    const int row = t2 >> 2, ch = t2 & 3;
    *(LASP u32x4_t*)(st + LS_QP + row * 80 + ch * 16) = g.a0;
    *(LASP u32x4_t*)(st + LS_AM + row * 80 + ch * 16) = g.a1;
    *(LASP u32x4_t*)(st + LS_KD + row * 80 + ch * 16) = g.a2;
    if (t2 < 8) *(LASP f32x4_t*)(st + LS_GL + t2 * 16) = g.gl;
    *(LASP u32x4_t*)(st + LS_V + (t2 >> 3) * 144 + (t2 & 7) * 16) = g.v0; *(LASP u32x4_t*)(st + LS_V + (16 + (t2 >> 3)) * 144 + (t2 & 7) * 16) = g.v1;
}
__device__ void gla_scan_fast(const P& p, LASP unsigned char* lds, int bh) {
    const int tid = mk_tid();
    const int lane = tid & 63, wave = __builtin_amdgcn_readfirstlane(tid >> 6);
    const int h = bh & 3, b = bh >> 2;
    constexpr int NS = NCH;
    if (wave >= 4) {
        const int dir = (wave - 4) >> 1, t2 = tid & 127;
        LASP unsigned char* base = lds + dir * 2 * LS_BYTES;
        LSlot g0, g1, g2, g3;
        gla_issue(p, g0, b, h, dir, 0, t2); gla_issue(p, g1, b, h, dir, 1, t2); gla_issue(p, g2, b, h, dir, 2, t2); gla_issue(p, g3, b, h, dir, 3, t2);
        gla_write(base, g0, t2); gla_issue(p, g0, b, h, dir, 4, t2);
        __syncthreads();
#pragma unroll 1
        for (int s = 0; s < NS; s += 4) {
            gla_write(base + ((s + 1) & 1) * LS_BYTES, g1, t2); gla_issue(p, g1, b, h, dir, min(s + 5, NS - 1), t2);
            __syncthreads();
            gla_write(base + ((s + 2) & 1) * LS_BYTES, g2, t2); gla_issue(p, g2, b, h, dir, min(s + 6, NS - 1), t2);
            __syncthreads();
            gla_write(base + ((s + 3) & 1) * LS_BYTES, g3, t2); gla_issue(p, g3, b, h, dir, min(s + 7, NS - 1), t2);
            __syncthreads();
            gla_write(base + ((s + 4) & 1) * LS_BYTES, g0, t2); gla_issue(p, g0, b, h, dir, min(s + 8, NS - 1), t2);
            __syncthreads();
        }
    } else {
        const int r = lane & 31, hh = lane >> 5, dir = wave >> 1, blk = wave & 1;
        LASP unsigned char* base = lds + dir * 2 * LS_BYTES;
        f32x16_t S;
#pragma unroll
        for (int i = 0; i < 16; ++i) S[i] = 0.f;
        __syncthreads();
#pragma unroll 1
        for (int s = 0; s < NS; ++s) {
            const LASP unsigned char* st = base + (s & 1) * LS_BYTES;
            const bf16x8_t Sb0 = PACK8(S, 0), Sb1 = PACK8(S, 1);
            f32x16_t oT;
#pragma unroll
            for (int i = 0; i < 16; ++i) oT[i] = 0.f;
            const LASP unsigned char* qp = st + LS_QP + r * 80 + hh * 16;
            oT = MFMA32(Sb0, *(const LASP bf16x8_t*)(qp), oT);
            oT = MFMA32(Sb1, *(const LASP bf16x8_t*)(qp + 32), oT);
            const LASP unsigned char* am = st + LS_AM + r * 80 + hh * 16;
            const LASP unsigned short* vc = (const LASP unsigned short*)(st + LS_V) + 32 * blk + r + (4 * hh) * 72;
#define VPAIR(t) ((unsigned)vc[(t) * 72] | ((unsigned)vc[((t) + 1) * 72] << 16))
            const bf16x8_t V0 = __builtin_bit_cast(bf16x8_t, (u32x4_t){VPAIR(0), VPAIR(2), VPAIR(8), VPAIR(10)});
            const bf16x8_t V1 = __builtin_bit_cast(bf16x8_t, (u32x4_t){VPAIR(16), VPAIR(18), VPAIR(24), VPAIR(26)});
#undef VPAIR
            oT = MFMA32(V0, *(const LASP bf16x8_t*)(am), oT);
            oT = MFMA32(V1, *(const LASP bf16x8_t*)(am + 32), oT);
            {
                const int c = gdn_chunk(dir, s);
                bf16* op = p.oc + ((size_t)dir * ROWS + (size_t)b * TOK + (size_t)c * GCH + r) * 256 + h * 64 + 32 * blk + 4 * hh;
#pragma unroll
                for (int g = 0; g < 4; ++g) *(u32x2_t*)(op + 8 * g) = (u32x2_t){cvtpk(oT[4 * g], oT[4 * g + 1]), cvtpk(oT[4 * g + 2], oT[4 * g + 3])};
            }
            const LASP float* glp = (const LASP float*)(st + LS_GL);
#pragma unroll
            for (int g = 0; g < 4; ++g) {
                const f32x4_t g4 = *(const LASP f32x4_t*)(glp + 8 * g + 4 * hh);
                S[4 * g] *= g4.x; S[4 * g + 1] *= g4.y; S[4 * g + 2] *= g4.z; S[4 * g + 3] *= g4.w;
            }
            const LASP unsigned char* kd = st + LS_KD + r * 80 + hh * 16;
            S = MFMA32(*(const LASP bf16x8_t*)(kd), V0, S);
            S = MFMA32(*(const LASP bf16x8_t*)(kd + 32), V1, S);
            __syncthreads();
        }
    }
}


__device__ __forceinline__ void vt_item(const P& p, int it, int lane) {
    const int r = lane & 31, hh = lane >> 5;
    const int tb = it % NCH, bh = it / NCH, h = bh & 3, b = bh >> 2;
    const bf16* vp = p.rest + ((size_t)b * TOK + 32 * tb + r) * NREST + RC_BV + h * 64 + 32 * hh;
    bf16* op = p.vtb + ((size_t)bh * 64 + 32 * hh) * TOK + 32 * tb + perm16(r);
#pragma unroll
    for (int q = 0; q < 4; ++q) {
        const u32x4_t w = *(const u32x4_t*)(vp + 8 * q);
        op[(size_t)(8 * q + 0) * TOK] = (bf16)(w.x & 0xffffu); op[(size_t)(8 * q + 1) * TOK] = (bf16)(w.x >> 16);
        op[(size_t)(8 * q + 2) * TOK] = (bf16)(w.y & 0xffffu); op[(size_t)(8 * q + 3) * TOK] = (bf16)(w.y >> 16);
        op[(size_t)(8 * q + 4) * TOK] = (bf16)(w.z & 0xffffu); op[(size_t)(8 * q + 5) * TOK] = (bf16)(w.z >> 16);
        op[(size_t)(8 * q + 6) * TOK] = (bf16)(w.w & 0xffffu); op[(size_t)(8 * q + 7) * TOK] = (bf16)(w.w >> 16);
    }
}

__device__ __forceinline__ void na_item(const P& p, const LASP float* rpbL, int it, int lane) {
    const int r = lane & 31, hh = lane >> 5;
    int b, h, ry, qb; bool lat;
    if (it < 4096) { lat = true; qb = it & 1; ry = (it >> 1) & 63; h = (it >> 7) & 3; b = it >> 9; }
    else { const int j = it - 4096; lat = false; qb = j & 7; h = (j >> 3) & 3; b = j >> 5; ry = 0; }
    const size_t brow = (size_t)b * TOK;
    const int q0 = lat ? CTX + ry * 64 + qb * 32 : qb * 32;
    bf16* qp = p.rest + (brow + q0 + r) * NREST + RC_BQ + h * 64;
    bf16x8_t Qf0 = *(const bf16x8_t*)(qp + 8 * hh), Qf1 = *(const bf16x8_t*)(qp + 16 + 8 * hh), Qf2 = *(const bf16x8_t*)(qp + 32 + 8 * hh), Qf3 = *(const bf16x8_t*)(qp + 48 + 8 * hh);
    f32x16_t O0, O1;
#pragma unroll
    for (int i = 0; i < 16; ++i) { O0[i] = 0.f; O1[i] = 0.f; }
    float m = -1e30f, lsum = 0.f;
    const bf16* vtb = p.vtb + ((size_t)(b * 4 + h) * 64 + r) * TOK + 8 * hh;
    const int nkb = lat ? 24 : 8;
    const int c = qb * 32 + r, c0 = min(max(c - 8, 0), 48), r0 = min(max(ry - 4, 0), 56);
    constexpr float SC = 0.125f * 1.4426950408889634f;
    const bf16* kbase = p.rest + (brow + r) * NREST + RC_BK + h * 64 + 8 * hh;
    bf16x8_t nK0, nK1, nK2, nK3, nV00, nV01, nV10, nV11;
    {
        const bf16* kp = kbase;
        nK0 = *(const bf16x8_t*)(kp); nK1 = *(const bf16x8_t*)(kp + 16); nK2 = *(const bf16x8_t*)(kp + 32); nK3 = *(const bf16x8_t*)(kp + 48);
        nV00 = *(const bf16x8_t*)(vtb); nV01 = *(const bf16x8_t*)(vtb + 16); nV10 = *(const bf16x8_t*)(vtb + (size_t)32 * TOK); nV11 = *(const bf16x8_t*)(vtb + (size_t)32 * TOK + 16);
    }
#pragma unroll 1
    for (int kb = 0; kb < nkb; ++kb) {
        int ky = 0, cb = 0; const bool win = kb >= 8;
        if (win) { const int w = kb - 8; ky = r0 + (w >> 1); cb = w & 1; }
        const bf16x8_t K0 = nK0, K1 = nK1, K2 = nK2, K3 = nK3, V00 = nV00, V01 = nV01, V10 = nV10, V11 = nV11;
        {
            const int kn = min(kb + 1, nkb - 1);
            const int wn = kn - 8;
            const int t0n = kn < 8 ? kn * 32 : CTX + (r0 + (wn >> 1)) * 64 + (wn & 1) * 32;
            const bf16* kp = kbase + (size_t)t0n * NREST;
            nK0 = *(const bf16x8_t*)(kp); nK1 = *(const bf16x8_t*)(kp + 16); nK2 = *(const bf16x8_t*)(kp + 32); nK3 = *(const bf16x8_t*)(kp + 48);
            const bf16* vp = vtb + t0n;
            nV00 = *(const bf16x8_t*)(vp); nV01 = *(const bf16x8_t*)(vp + 16); nV10 = *(const bf16x8_t*)(vp + (size_t)32 * TOK); nV11 = *(const bf16x8_t*)(vp + (size_t)32 * TOK + 16);
        }
        f32x16_t S;
#pragma unroll
        for (int i = 0; i < 16; ++i) S[i] = 0.f;
        S = MFMA32(K0, Qf0, S); S = MFMA32(K1, Qf1, S); S = MFMA32(K2, Qf2, S); S = MFMA32(K3, Qf3, S);
        float bm = -1e30f;
        if (win) {
            const LASP float* rb = rpbL + (h * 15 + (ky - ry + 7)) * 31 + 15 - c;
#pragma unroll
            for (int i = 0; i < 16; ++i) {
                const int kc = cb * 32 + crow(i, hh);
                const bool valid = (kc >= c0) && (kc < c0 + 16);
                const float bias = rb[valid ? kc : c];
                S[i] = valid ? S[i] * SC + bias : -1e30f;
                bm = fmaxf(bm, S[i]);
            }
        } else {
#pragma unroll
            for (int i = 0; i < 16; ++i) { S[i] *= SC; bm = fmaxf(bm, S[i]); }
        }
        bm = fmaxf(bm, __shfl_xor(bm, 32));
        const float mn = fmaxf(m, bm);
        const float alpha = __builtin_amdgcn_exp2f(m - mn);
        m = mn;
        float ps = 0.f;
#pragma unroll
        for (int i = 0; i < 16; ++i) { S[i] = __builtin_amdgcn_exp2f(S[i] - mn); ps += S[i]; }
        lsum = lsum * alpha + ps;
#pragma unroll
        for (int i = 0; i < 16; ++i) { O0[i] *= alpha; O1[i] *= alpha; }
        const bf16x8_t Pb0 = PACK8(S, 0), Pb1 = PACK8(S, 1);
        O0 = MFMA32(V00, Pb0, O0); O0 = MFMA32(V01, Pb1, O0);
        O1 = MFMA32(V10, Pb0, O1); O1 = MFMA32(V11, Pb1, O1);
    }
    const float inv = 1.f / (lsum + __shfl_xor(lsum, 32));
    bf16* op = qp + 4 * hh;
#pragma unroll
    for (int g = 0; g < 4; ++g) {
        *(u32x2_t*)(op + 8 * g) = (u32x2_t){cvtpk(O0[4 * g] * inv, O0[4 * g + 1] * inv), cvtpk(O0[4 * g + 2] * inv, O0[4 * g + 3] * inv)};
        *(u32x2_t*)(op + 32 + 8 * g) = (u32x2_t){cvtpk(O1[4 * g] * inv, O1[4 * g + 1] * inv), cvtpk(O1[4 * g + 2] * inv, O1[4 * g + 3] * inv)};
    }
}

__device__ void ph_prep(const P& p, LASP unsigned char* lds, int l, int bid, int nblk) {
    const int tid = mk_tid();
    LASP float* cstab = (LASP float*)(lds + 131072);
    {
        const int pos = tid >> 3, f = tid & 7;
        const float ang = (float)pos * powf(10000.f, -(float)f / 8.f);
        cstab[tid * 2] = cosf(ang); cstab[tid * 2 + 1] = sinf(ang);
    }
    __syncthreads();
    ph_gdnprep(p, lds, l, bid, nblk, tid);
    const int lane = tid & 63, wave = tid >> 6;
    for (int it = (nblk - 1 - bid) * NWAVES + wave; it < BATCH * 4 * NCH; it += nblk * NWAVES) gla_prep_item(p, lds + wave * 16384, cstab, l, it, lane);
    for (int it = bid * NWAVES + wave; it < BATCH * 4 * NCH; it += nblk * NWAVES) vt_item(p, it, lane);
}


__device__ void ph_mix(const P& p, LASP unsigned char* lds, int l, int bid, int nblk) {
    constexpr int NGDN = BATCH * 4 * 2;
    constexpr int NGLA = BATCH * 4;
    if (bid < NGDN) { gdn_scan_fast(p, lds, bid); return; }
    if (bid < NGDN + NGLA) { gla_scan_fast(p, lds, bid - NGDN); return; }
    const int tid = mk_tid();
    const int lane = tid & 63, wave = tid >> 6;
    LASP float* rpbL = (LASP float*)lds;
    for (int i = tid; i < 4 * 15 * 31; i += NTHREADS) rpbL[i] = p.rpb[(size_t)l * 4 * 15 * 31 + i] * 1.4426950408889634f;
    __syncthreads();
    const int total = 4096 + (l == 0 ? 256 : 0);
    for (int it = (bid - NGDN - NGLA) * NWAVES + wave; it < total; it += (nblk - NGDN - NGLA) * NWAVES) na_item(p, rpbL, it, lane);
}

__device__ void ph_gate(const P& p, int l, int bid, int nblk) {
    const int tid = mk_tid();
    const int tq = tid & 127, rsub = tid >> 7;
    for (int r = bid * 4 + rsub; r < ROWS; r += nblk * 4) {
        const bf16* pr = p.rest + (size_t)r * NREST;
        float o[8], z[8], res[8]; int oc;
        if (tq < 64) {
            const int cb = tq * 8;
            float a[8], bb[8];
            unpack8(*(const uint4*)(p.oa + (size_t)r * 512 + cb), a);
            unpack8(*(const uint4*)(p.oa + ((size_t)ROWS + r) * 512 + cb), bb);
            float ss = 0.f;
#pragma unroll
            for (int e = 0; e < 8; ++e) { o[e] = a[e] + bb[e]; ss += o[e] * o[e]; }
#pragma unroll
            for (int m = 8; m > 0; m >>= 1) ss += __shfl_xor(ss, m);
            const float rs = 1.f / sqrtf(ss * (1.f / 128.f) + 1e-6f);
            unpack8(*(const uint4*)(pr + RC_AZ + cb), z);
#pragma unroll
            for (int e = 0; e < 8; ++e) res[e] = o[e] * rs * p.gdn_norm[l * 128 + ((cb + e) & 127)] * silu_f(z[e]);
            oc = cb;
        } else if (tq < 96) {
            const int cb = (tq - 64) * 8;
            unpack8(*(const uint4*)(pr + RC_BQ + cb), o);
            unpack8(*(const uint4*)(pr + RC_BZ + cb), z);
#pragma unroll
            for (int e = 0; e < 8; ++e) res[e] = o[e] * silu_f(z[e]);
            oc = 512 + cb;
        } else {
            const int cb = (tq - 96) * 8;
            float a[8], bb[8];
            unpack8(*(const uint4*)(p.oc + (size_t)r * 256 + cb), a);
            unpack8(*(const uint4*)(p.oc + ((size_t)ROWS + r) * 256 + cb), bb);
            float ss = 0.f;
#pragma unroll
            for (int e = 0; e < 8; ++e) { o[e] = a[e] + bb[e]; ss += o[e] * o[e]; }
#pragma unroll
            for (int m = 4; m > 0; m >>= 1) ss += __shfl_xor(ss, m);
            const float rs = 1.f / sqrtf(ss * (1.f / 64.f) + 1e-6f);
            unpack8(*(const uint4*)(pr + RC_CZ + cb), z);
#pragma unroll
            for (int e = 0; e < 8; ++e) res[e] = o[e] * rs * p.gla_norm[l * 64 + ((cb + e) & 63)] * silu_f(z[e]);
            oc = 768 + cb;
        }
        uint4 w; w.x = pk2(res[0], res[1]); w.y = pk2(res[2], res[3]); w.z = pk2(res[4], res[5]); w.w = pk2(res[6], res[7]);
        *(uint4*)(p.mix + (size_t)r * D + oc) = w;
    }
}


#if PROBE
__device__ void gdn_scan_naive(const P& p, LASP float* sm, int l, int b, int hp, bf16* nb) {
    const int tid = mk_tid();
    LASP float* skq = sm;
    LASP float* sv = sm + 4 * 16 * 256;
    LASP float* sg = sv + 4 * 16 * 128;
    LASP float* sb = sg + 64;
    const int sub = tid >> 7, col = tid & 127, dir = sub & 1, h = hp * 2 + (sub >> 1);
    float S[128];
#pragma unroll
    for (int i = 0; i < 128; ++i) S[i] = 0.f;
    for (int s0 = 0; s0 < TOK; s0 += 16) {
        __syncthreads();
        for (int i = tid; i < 4 * 16 * 48; i += NTHREADS) {
            const int su = i / (16 * 48), rem = i % (16 * 48), j = rem / 48, chunk = rem % 48;
            const int sd = su & 1, hh = hp * 2 + (su >> 1);
            const int t = tok_of(sd, s0 + j);
            const size_t row = (size_t)b * TOK + t;
            const int part = chunk >> 4, c8 = chunk & 15;
            const uint4 w = *(const uint4*)(p.qkvn + row * NRAW + part * 512 + hh * 128 + c8 * 8);
            float f[8]; unpack8(w, f);
            LASP float* dst = (part < 2) ? skq + (su * 16 + j) * 256 + part * 128 + c8 * 8 : sv + (su * 16 + j) * 128 + c8 * 8;
#pragma unroll
            for (int e = 0; e < 8; ++e) dst[e] = f[e];
        }
        if (tid < 64) {
            const int su = tid >> 4, j = tid & 15, sd = su & 1, hh = hp * 2 + (su >> 1);
            const int t = tok_of(sd, s0 + j);
            const bf16* ab = p.rest + ((size_t)b * TOK + t) * NREST + RC_AB;
            const float a = bf2f(ab[sd * 4 + hh]) + p.dt_bias[(l * 2 + sd) * 4 + hh];
            const float sp = fmaxf(a, 0.f) + log1pf(expf(-fabsf(a)));
            const float g = -expf(p.a_log[(l * 2 + sd) * 4 + hh]) * sp;
            sg[su * 16 + j] = expf(g);
            const float bx = bf2f(ab[(2 + sd) * 4 + hh]);
            sb[su * 16 + j] = 1.f / (1.f + expf(-bx));
        }
        __syncthreads();
#pragma unroll 1
        for (int j = 0; j < 16; ++j) {
            const LASP float* qp = skq + (sub * 16 + j) * 256;
            const LASP float* kp = qp + 128;
            const float dec = sg[sub * 16 + j], bt = sb[sub * 16 + j];
            const float v = sv[(sub * 16 + j) * 128 + col];
            float d0 = 0.f, d1 = 0.f, d2 = 0.f, d3 = 0.f;
#pragma unroll
            for (int k4 = 0; k4 < 32; ++k4) {
                const f32x4_t kv = *(const LASP f32x4_t*)(kp + k4 * 4);
                d0 += S[k4 * 4] * kv.x; d1 += S[k4 * 4 + 1] * kv.y; d2 += S[k4 * 4 + 2] * kv.z; d3 += S[k4 * 4 + 3] * kv.w;
                if ((k4 & 7) == 7) __builtin_amdgcn_sched_barrier(0);
            }
            const float dot = (d0 + d1) + (d2 + d3);
            const float vn = bt * (v - dec * dot);
            float o0 = 0.f, o1 = 0.f, o2 = 0.f, o3 = 0.f;
#pragma unroll
            for (int k4 = 0; k4 < 32; ++k4) {
                const f32x4_t kv = *(const LASP f32x4_t*)(kp + k4 * 4);
                const f32x4_t qv = *(const LASP f32x4_t*)(qp + k4 * 4);
                S[k4 * 4] = dec * S[k4 * 4] + kv.x * vn; o0 += S[k4 * 4] * qv.x;
                S[k4 * 4 + 1] = dec * S[k4 * 4 + 1] + kv.y * vn; o1 += S[k4 * 4 + 1] * qv.y;
                S[k4 * 4 + 2] = dec * S[k4 * 4 + 2] + kv.z * vn; o2 += S[k4 * 4 + 2] * qv.z;
                S[k4 * 4 + 3] = dec * S[k4 * 4 + 3] + kv.w * vn; o3 += S[k4 * 4 + 3] * qv.w;
                if ((k4 & 3) == 3) __builtin_amdgcn_sched_barrier(0);
            }
            const int t = tok_of(dir, s0 + j);
            nb[((size_t)dir * TOK + t) * 256 + (h & 1) * 128 + col] = f2bf((o0 + o1) + (o2 + o3));
        }
    }
    __syncthreads();
}

__device__ void gla_scan_naive(const P& p, LASP float* sm, int l, int b, bf16* nb) {
    const int tid = mk_tid();
    LASP float* sq = sm;
    LASP float* sv = sm + 8 * 16 * 96;
    const int grp = tid >> 6, lane = tid & 63, h = grp >> 1, dir = grp & 1;
    const int d = lane & 31, par = lane >> 5;
    float w2c[16];
#pragma unroll
    for (int j = 0; j < 16; ++j) w2c[j] = p.gla_w2[((size_t)(l * 2 + dir) * 16 + j) * 128 + h * 32 + d];
    const float b2v = p.gla_b2[(l * 2 + dir) * 128 + h * 32 + d];
    const int dd = d & 15, f = dd & 7;
    const float inv = powf(10000.f, -(float)f / 8.f);
    const int pd = dd < 8 ? d + 8 : d - 8;
    float S[32];
#pragma unroll
    for (int i = 0; i < 32; ++i) S[i] = 0.f;
    for (int s0 = 0; s0 < TOK; s0 += 16) {
        __syncthreads();
#pragma unroll 1
        for (int jj = 0; jj < 8; ++jj) {
            const int j = par + 2 * jj;
            const int t = tok_of(dir, s0 + j);
            const bf16* base = p.rest + ((size_t)b * TOK + t) * NREST;
            float qv = bf2f(base[RC_CQ + h * 32 + d]), kv = bf2f(base[RC_CK + h * 32 + d]);
            if (t >= CTX) {
                const int pidx = t - CTX;
                const int pos = d < 16 ? (pidx >> 6) : (pidx & 63);
                const float ang = (float)pos * inv;
                const float cs = cosf(ang), sn = sinf(ang);
                const float qp = bf2f(base[RC_CQ + h * 32 + pd]), kp = bf2f(base[RC_CK + h * 32 + pd]);
                if (dd < 8) { qv = qv * cs - qp * sn; kv = kv * cs - kp * sn; }
                else { qv = qp * sn + qv * cs; kv = kp * sn + kv * cs; }
            }
            qv *= 0.17677669529663687f;
            float xg = b2v;
#pragma unroll
            for (int jr = 0; jr < 16; ++jr) xg += bf2f(base[RC_CR + dir * 16 + jr]) * w2c[jr];
            const float ls = fminf(xg, 0.f) - log1pf(expf(-fabsf(xg)));
            LASP float* dst = sq + (grp * 16 + j) * 96;
            dst[d] = qv; dst[32 + d] = kv; dst[64 + d] = expf(ls * (1.f / 16.f));
        }
        for (int i = lane; i < 16 * 64; i += 64) {
            const int j = i >> 6, c = i & 63;
            const int t = tok_of(dir, s0 + j);
            sv[(grp * 16 + j) * 64 + c] = bf2f(p.rest[((size_t)b * TOK + t) * NREST + RC_CV + h * 64 + c]);
        }
        __syncthreads();
#pragma unroll 1
        for (int j = 0; j < 16; ++j) {
            const LASP float* qp = sq + (grp * 16 + j) * 96;
            const LASP float* kp = qp + 32;
            const LASP float* dp = qp + 64;
            const float v = sv[(grp * 16 + j) * 64 + lane];
            float o0 = 0.f, o1 = 0.f;
#pragma unroll
            for (int e = 0; e < 32; e += 2) {
                S[e] = dp[e] * S[e] + kp[e] * v; o0 += S[e] * qp[e];
                S[e + 1] = dp[e + 1] * S[e + 1] + kp[e + 1] * v; o1 += S[e + 1] * qp[e + 1];
            }
            const int t = tok_of(dir, s0 + j);
            nb[((size_t)dir * TOK + t) * 256 + h * 64 + lane] = f2bf(o0 + o1);
        }
    }
    __syncthreads();
}

__device__ void na_query_naive(const P& p, LASP float* sm, int l, int b, int t0, bf16* nb) {
    const int tid = mk_tid();
    const int wave = tid >> 6, lane = tid & 63, h = wave & 3, t = t0 + (wave >> 2);
    LASP float* pw = sm + wave * 384;
    const size_t rowq = (size_t)b * TOK + t;
    float qv[64];
    {
        const bf16* qs = p.rest + rowq * NREST + RC_BQ + h * 64;
#pragma unroll
        for (int i = 0; i < 8; ++i) {
            float f[8]; unpack8(*(const uint4*)(qs + i * 8), f);
#pragma unroll
            for (int e = 0; e < 8; ++e) qv[i * 8 + e] = f[e] * 0.125f;
        }
    }
    const bool lat = t >= CTX;
    const int nk = lat ? 384 : 256;
    int r = 0, c = 0, r0 = 0, c0 = 0;
    if (lat) { int pi = t - CTX; r = pi >> 6; c = pi & 63; r0 = min(max(r - 4, 0), 56); c0 = min(max(c - 8, 0), 48); }
    float m = -1e30f;
    __syncthreads();
#pragma unroll 1
    for (int j = 0; j < 6; ++j) {
        const int idx = lane + 64 * j;
        float s = -1e30f;
        if (idx < nk) {
            int tk; float bias = 0.f;
            if (lat && idx < 128) {
                const int i = idx >> 4, kc = c0 + (idx & 15);
                tk = CTX + (r0 + i) * 64 + kc;
                bias = p.rpb[((size_t)(l * 4 + h) * 15 + (r0 + i - r + 7)) * 31 + (kc - c + 15)];
            } else tk = lat ? idx - 128 : idx;
            const bf16* ks = p.rest + ((size_t)b * TOK + tk) * NREST + RC_BK + h * 64;
            float d0 = 0.f, d1 = 0.f;
#pragma unroll
            for (int i = 0; i < 8; ++i) {
                float f[8]; unpack8(*(const uint4*)(ks + i * 8), f);
#pragma unroll
                for (int e = 0; e < 8; e += 2) { d0 += qv[i * 8 + e] * f[e]; d1 += qv[i * 8 + e + 1] * f[e + 1]; }
            }
            s = d0 + d1 + bias;
        }
        pw[idx] = s;
        m = fmaxf(m, s);
    }
    m = wave_max(m);
    float sum = 0.f;
#pragma unroll 1
    for (int j = 0; j < 6; ++j) { const float e = expf(pw[lane + 64 * j] - m); pw[lane + 64 * j] = e; sum += e; }
    sum = wave_sum(sum);
    const float inv = 1.f / sum;
    __syncthreads();
    float o0 = 0.f, o1 = 0.f;
    for (int idx = 0; idx < nk; idx += 2) {
        int tk0;
        if (lat && idx < 128) tk0 = CTX + (r0 + (idx >> 4)) * 64 + c0 + (idx & 15);
        else tk0 = lat ? idx - 128 : idx;
        o0 += pw[idx] * bf2f(p.rest[((size_t)b * TOK + tk0) * NREST + RC_BV + h * 64 + lane]);
        o1 += pw[idx + 1] * bf2f(p.rest[((size_t)b * TOK + tk0 + 1) * NREST + RC_BV + h * 64 + lane]);
    }
    nb[(size_t)t * 256 + h * 64 + lane] = f2bf((o0 + o1) * inv);
}


__device__ void ph_probe_naive(const P& p, LASP float* sm, int l, int bid, int nblk) {
    bf16* nb = (bf16*)p.xc1;
    if (PROBE == 1) { if (bid == 0) gdn_scan_naive(p, sm, l, 0, 0, nb); }
    else if (PROBE == 3) { if (bid == 0) gla_scan_naive(p, sm, l, 0, nb); }
    else { for (int it = bid; it < TOK / 2; it += nblk) na_query_naive(p, sm, l, 0, it * 2, nb); }
}
__device__ void ph_probe_cmp(const P& p, int bid, int nblk) {
    const int tid = mk_tid();
    const bf16* nb = (const bf16*)p.xc1;
    float md = 0.f, mr = 0.f;
    const int n = (PROBE == 2) ? TOK * 256 : 2 * TOK * 256;
    for (int i = bid * NTHREADS + tid; i < n; i += nblk * NTHREADS) {
        float a, r = bf2f(nb[i]);
        if (PROBE == 1) { const int dir = i / (TOK * 256), rem = i % (TOK * 256), t = rem >> 8, c = rem & 255; a = bf2f(p.oa[((size_t)dir * ROWS + t) * 512 + c]); }
        else if (PROBE == 3) { const int dir = i / (TOK * 256), rem = i % (TOK * 256); a = bf2f(p.oc[(size_t)dir * ROWS * 256 + rem]); }
        else { const int t = i >> 8, c = i & 255; a = bf2f(p.rest[(size_t)t * NREST + RC_BQ + c]); }
        md = fmaxf(md, fabsf(a - r)); mr = fmaxf(mr, fabsf(r));
    }
    md = wave_max(md); mr = wave_max(mr);
    if ((tid & 63) == 0) { atomicMax((unsigned*)p.stats, __float_as_uint(md)); atomicMax((unsigned*)p.stats + 1, __float_as_uint(mr)); }
}
#endif

#define XB_TMO      128
#define XB_XCNT(j)  (256  + 64 * (j))
#define XB_XSUB(j)  (1280 + 64 * (j))
#define XB_XGEN(j)  (2304 + 64 * (j))
#define XB_TOP      3328
#define XB_TOPGEN   3392
#define XCD_BAR_WORDS 3456
#define XB_SPIN_CAP (1u << 18)

__device__ __forceinline__ unsigned xb_ld(unsigned* p)              { return __hip_atomic_load(p, __ATOMIC_RELAXED, __HIP_MEMORY_SCOPE_AGENT); }
__device__ __forceinline__ unsigned xb_add(unsigned* p, unsigned v) { return __hip_atomic_fetch_add(p, v, __ATOMIC_RELAXED, __HIP_MEMORY_SCOPE_AGENT); }
__device__ __forceinline__ unsigned xb_xcc_id() { return (unsigned)__builtin_amdgcn_s_getreg((3 << 11) | 20) & 0xFu; }
#define XB_SPIN(cond, bar) do { unsigned _sp = 0; while (cond) { __builtin_amdgcn_s_sleep(1); \
    if ((++_sp & 255u) == 0u) { if (xb_ld(&(bar)[XB_TMO])) break; if (_sp > XB_SPIN_CAP) { atomicAdd(&(bar)[XB_TMO], 1u); break; } } } } while (0)

struct XcdBarrier {
    unsigned* bar; unsigned x;
    volatile LASP unsigned* st;
};

__device__ __forceinline__ XcdBarrier xcd_barrier_post(unsigned* bar, volatile LASP unsigned* st) {
    XcdBarrier b; b.bar = bar; b.x = xb_xcc_id(); b.st = st;
    if ((int)threadIdx.x == 0) (void)xb_add(&bar[XB_XCNT(b.x)], 1u);
    return b;
}
__device__ __forceinline__ void xcd_barrier_complete(unsigned* bar, unsigned x, unsigned& nloc, unsigned& nx) {
    const unsigned G = gridDim.x * gridDim.y * gridDim.z;
    unsigned sum, cnt, mine, sp = 0u;
    for (;;) {
        sum = 0u; cnt = 0u; mine = 0u;
#pragma unroll
        for (unsigned j = 0; j < 16; ++j) { const unsigned c = xb_ld(&bar[XB_XCNT(j)]); sum += c; cnt += (c > 0u) ? 1u : 0u; mine = (j == x) ? c : mine; }
        if (sum == G) break;
        __builtin_amdgcn_s_sleep(1);
        if ((++sp & 255u) == 0u) { if (xb_ld(&bar[XB_TMO])) break; if (sp > XB_SPIN_CAP) { atomicAdd(&bar[XB_TMO], 1u); break; } }
    }
    nloc = mine > 0u ? mine : 1u; nx = cnt > 0u ? cnt : 1u;
}

__device__ __forceinline__ void xcd_barrier(const XcdBarrier& b) {
    asm volatile("s_waitcnt vmcnt(0)" ::: "memory");
    __syncthreads();
    if ((int)threadIdx.x == 0) {
        unsigned* bar = b.bar;
        __builtin_amdgcn_s_waitcnt(0);
        unsigned nloc = b.st[0], nx = b.st[1];
        if (nloc == 0u) { xcd_barrier_complete(bar, b.x, nloc, nx); b.st[0] = nloc; b.st[1] = nx; }
        const unsigned old = xb_add(&bar[XB_XSUB(b.x)], 1u);
        const unsigned gen = old / nloc;
        if (old + 1u == (gen + 1u) * nloc) {
            __builtin_amdgcn_fence(__ATOMIC_RELEASE, "agent");
            asm volatile("s_waitcnt vmcnt(0)" ::: "memory");
            const unsigned og = xb_add(&bar[XB_TOP], 1u);
            const unsigned tg = og / nx;
            if (og + 1u == (tg + 1u) * nx) xb_add(&bar[XB_TOPGEN], 1u);
            else XB_SPIN(xb_ld(&bar[XB_TOPGEN]) == tg, bar);
            __builtin_amdgcn_fence(__ATOMIC_ACQUIRE, "agent");
            xb_add(&bar[XB_XGEN(b.x)], 1u);
            asm volatile("s_waitcnt vmcnt(0)" ::: "memory");
        } else {
            XB_SPIN(xb_ld(&bar[XB_XGEN(b.x)]) == gen, bar);
            __builtin_amdgcn_fence(__ATOMIC_ACQUIRE, "agent");
            asm volatile("s_waitcnt vmcnt(0)" ::: "memory");
        }
    }
    __syncthreads();
}


constexpr int NSTEP = 1 + 2 * 7 + 1;
__global__ void __launch_bounds__(NTHREADS, 2) k_mega(P p) {
    extern __shared__ __attribute__((aligned(16))) unsigned char lds_raw[];
    LASP unsigned char* lds = (LASP unsigned char*)lds_raw;
    cg::grid_group grid = cg::this_grid();
    const int bid = blockIdx.x, nblk = gridDim.x;
    volatile LASP unsigned* bst = (volatile LASP unsigned*)(lds + LDS_BYTES - 64);
    if (threadIdx.x < 16) bst[threadIdx.x] = 0u;
    __syncthreads();
    const XcdBarrier bar = xcd_barrier_post((unsigned*)p.ctl, bst);
#pragma unroll 1
    for (int step = 0; step < NSTEP; ++step) {
        int ph = 0, l = 0;
        if (step > 0) { const int s1 = step - 1; l = s1 / 7; ph = 1 + s1 % 7; }
#if TPROBE >= 0
        unsigned long long tp0 = 0;
        if (bid == 0 && threadIdx.x == 0) { if (step == 0) p.stats[2] = 0.f; tp0 = __builtin_amdgcn_s_memrealtime(); }
#endif
        if (ph == 0) ph_prologue(p, lds, bid, nblk);
        else if (ph == 1) ph_lnpass(p, l, bid, nblk);
        else if (l < 2) {
            if (ph == 2) {
                pg8::Gemm g{p.ml, p.wi_t + (size_t)l * NPAD * D, ROWS, NPAD, D}; pg8::StaticOrder S; S.init(ROWS, NPAD, nblk, bid);
                EpiProj E{p.raw, p.rest};
                pg8::gemm_phase<EpiProj, pg8::StaticOrder, true, true>(lds, g, S, E);
            } else if (ph == 3) ph_conv(p, l, bid, nblk);
            else if (ph == 4) ph_prep(p, lds, l, bid, nblk);
            else if (ph == 5) {
#if PROBE
                if (l == 0) { ph_probe_naive(p, (LASP float*)lds, l, bid, nblk); xcd_barrier(bar); }
#endif
#if TPROBE >= 50
                unsigned long long tr0 = 0;
                { const int rb = TPROBE == 50 ? 0 : (TPROBE == 51 ? 64 : (TPROBE == 52 ? 96 : 255)); if (bid == rb && threadIdx.x == 0) tr0 = __builtin_amdgcn_s_memrealtime(); }
#endif
                ph_mix(p, lds, l, bid, nblk);
#if TPROBE >= 50
                { const int rb = TPROBE == 50 ? 0 : (TPROBE == 51 ? 64 : (TPROBE == 52 ? 96 : 255)); if (bid == rb && threadIdx.x == 0) { __threadfence(); atomicAdd(&p.stats[2], (float)(__builtin_amdgcn_s_memrealtime() - tr0) * 0.01f); } }
#endif
#if PROBE
                if (l == 0) { xcd_barrier(bar); ph_probe_cmp(p, bid, nblk); }
#endif
            }
            else if (ph == 6) ph_gate(p, l, bid, nblk);
            else if (ph == 7) {
                pg8::Gemm g{p.mix, p.wo_t + (size_t)l * D * D, ROWS, D, D}; pg8::StaticOrder S; S.init(ROWS, D, nblk, bid);
                EpiRes E{l == 0 ? p.x : p.out, p.ctx, p.out, p.xc1, p.mods, l};
                pg8::gemm_phase<EpiRes, pg8::StaticOrder, true, true>(lds, g, S, E);
            }
        }
        if (step == 0) grid.sync(); else xcd_barrier(bar);
#if TPROBE >= 0
        if (bid == 0 && threadIdx.x == 0 && ph == TPROBE) p.stats[2] += (float)(__builtin_amdgcn_s_memrealtime() - tp0) * 0.01f;
#endif
    }
}

extern "C" void kernel_launch(void* const* d_in, const int* in_sizes, int n_in, void* d_out, int out_size, void* d_ws, size_t ws_size,
                              hipStream_t stream) {
    P p{};
    p.x = (const float*)d_in[0]; p.c = (const float*)d_in[1]; p.ctx = (const float*)d_in[2]; p.c_ctx = (const float*)d_in[3];
    p.w_mod = (const float*)d_in[4]; p.b_mod = (const float*)d_in[5]; p.w_in = (const float*)d_in[6]; p.conv_w = (const float*)d_in[7];
    p.a_log = (const float*)d_in[8]; p.dt_bias = (const float*)d_in[9]; p.gdn_norm = (const float*)d_in[10]; p.rpb = (const float*)d_in[11];
    p.gla_w2 = (const float*)d_in[12]; p.gla_b2 = (const float*)d_in[13]; p.gla_norm = (const float*)d_in[14]; p.w_out = (const float*)d_in[15];
    p.ln_g = (const float*)d_in[16]; p.ln_b = (const float*)d_in[17];
    p.out = (float*)d_out;
    unsigned char* w = (unsigned char*)d_ws;
    size_t off = 0;
    auto take = [&](size_t bytes) { unsigned char* r = w + off; off += (bytes + 255) & ~(size_t)255; return r; };
    p.ctl = (unsigned*)take(16384);
    p.mods = (float*)take((size_t)2 * 9 * 3072 * 4);
    p.xc1 = (float*)take((size_t)BATCH * CTX * D * 4);
    p.wi_t = (bf16*)take((size_t)2 * NPAD * D * 2);
    p.wo_t = (bf16*)take((size_t)2 * D * D * 2);
    p.rest = (bf16*)take((size_t)ROWS * NREST * 2);
    p.raw = (bf16*)take((size_t)ROWS * NRAW * 2);
    p.qkvn = (bf16*)take((size_t)ROWS * NRAW * 2);
    p.mix = p.qkvn;
    p.oa = (bf16*)take((size_t)2 * ROWS * 512 * 2);
    p.oc = (bf16*)take((size_t)2 * ROWS * 256 * 2);
    p.ml = p.oa;
    p.vtb = (bf16*)take((size_t)ROWS * 256 * 2);
    p.stats = (float*)take(256);
    static int grid_blocks = 0;
    if (!grid_blocks) {
        if (off > ws_size) { fprintf(stderr, "workspace too small: need %zu have %zu\n", off, ws_size); grid_blocks = -1; return; }
        int dev = 0, cus = 0, per_cu = 0;
        hipGetDevice(&dev);
        hipDeviceGetAttribute(&cus, hipDeviceAttributeMultiprocessorCount, dev);
        if (hipFuncSetAttribute((const void*)k_mega, hipFuncAttributeMaxDynamicSharedMemorySize, LDS_BYTES) != hipSuccess) { fprintf(stderr, "hipFuncSetAttribute failed\n"); grid_blocks = -1; return; }
        hipOccupancyMaxActiveBlocksPerMultiprocessor(&per_cu, (const void*)k_mega, NTHREADS, LDS_BYTES);
        if (per_cu < 1) { fprintf(stderr, "occupancy query says %d blocks per CU\n", per_cu); grid_blocks = -1; return; }
        grid_blocks = cus;
    }
    if (grid_blocks < 0) return;
    if (hipMemsetAsync(p.ctl, 0, 16384, stream) != hipSuccess) { fprintf(stderr, "memset of the barrier words failed\n"); return; }
    void* args[] = {&p};
    hipError_t e = hipLaunchCooperativeKernel((void*)k_mega, dim3(grid_blocks), dim3(NTHREADS), args, LDS_BYTES, stream);
    if (e != hipSuccess) fprintf(stderr, "cooperative launch failed: %s (grid %d)\n", hipGetErrorString(e), grid_blocks);
}
```

```cpp
#include <hip/hip_runtime.h>
#include <hip/hip_cooperative_groups.h>
#include <cstdio>
#include <cstdint>
namespace cg = cooperative_groups;
#ifndef PROBE
#define PROBE 0
#endif
#ifndef TPROBE
#define TPROBE -1
#endif
#ifndef TSHIFT
#define TSHIFT 0
#endif

constexpr int D = 1024, BATCH = 8, SEQ = 4096, CTX = 256, TOK = 4352, NPROJ = 3888;
constexpr int ROWS = BATCH * TOK;
constexpr int NRAW = 1536, NREST = 2352, NPAD = 4096;
constexpr int NTHREADS = 512, NWAVES = 8;
constexpr int LDS_BYTES = 147456;
constexpr float ALPHA = 1.4142135623730951f;
constexpr int RC_AB = 0, RC_AZ = 16, RC_BQ = 528, RC_BK = 784, RC_BV = 1040, RC_BZ = 1296, RC_CQ = 1552, RC_CK = 1680, RC_CV = 1808, RC_CR = 2064, RC_CZ = 2096;

typedef unsigned short bf16;
typedef float f32x4_t __attribute__((ext_vector_type(4)));

struct P {
    const float *x, *c, *ctx, *c_ctx, *w_mod, *b_mod, *w_in, *conv_w, *a_log, *dt_bias, *gdn_norm, *rpb,
        *gla_w2, *gla_b2, *gla_norm, *w_out, *ln_g, *ln_b;
    float* out;
    float *mods, *xc1, *stats; unsigned* ctl;
    bf16 *wi_t, *wo_t, *rest, *raw, *qkvn, *mix, *ml, *oa, *oc, *vtb;
};

__device__ __forceinline__ float bf2f(unsigned short u) { return __uint_as_float((unsigned)u << 16); }
__device__ __forceinline__ unsigned short f2bf(float f) { unsigned u = __float_as_uint(f); return (unsigned short)((u + 0x7fffu + ((u >> 16) & 1u)) >> 16); }
__device__ __forceinline__ unsigned pk2(float lo, float hi) { return (unsigned)f2bf(lo) | ((unsigned)f2bf(hi) << 16); }
__device__ __forceinline__ float bflo(unsigned w) { return __uint_as_float(w << 16); }
__device__ __forceinline__ float bfhi(unsigned w) { return __uint_as_float(w & 0xffff0000u); }
__device__ __forceinline__ void unpack8(uint4 w, float* f) {
    f[0] = bflo(w.x); f[1] = bfhi(w.x); f[2] = bflo(w.y); f[3] = bfhi(w.y); f[4] = bflo(w.z); f[5] = bfhi(w.z); f[6] = bflo(w.w); f[7] = bfhi(w.w);
}
__device__ __forceinline__ float silu_f(float x) { return x * __builtin_amdgcn_rcpf(1.f + __builtin_amdgcn_exp2f(-1.4426950408889634f * x)); }
__device__ __forceinline__ float wave_sum(float v) {
#pragma unroll
    for (int o = 32; o > 0; o >>= 1) v += __shfl_xor(v, o);
    return v;
}
__device__ __forceinline__ float wave_max(float v) {
#pragma unroll
    for (int o = 32; o > 0; o >>= 1) v = fmaxf(v, __shfl_xor(v, o));
    return v;
}
__device__ __forceinline__ int mk_tid() { int t = threadIdx.x; asm volatile("" : "+v"(t)); return t; }
__device__ __forceinline__ int tok_of(int dir, int s) { return dir == 0 ? s : (s < CTX ? CTX - 1 - s : TOK + CTX - 1 - s); }

namespace pg8 {
#define PG8_LAS __attribute__((address_space(3)))
typedef unsigned short bf16_t;
typedef short bf16x8 __attribute__((ext_vector_type(8)));
typedef float f32x4 __attribute__((ext_vector_type(4)));
typedef unsigned u32x4 __attribute__((ext_vector_type(4)));
constexpr int BM = 256, BK = 64, HALF = 128, HTB = HALF * BK * 2  , STAGE_BYTES = 8 * HTB, NXCD = 8, WGM = 8;

__host__ __device__ __forceinline__ int lds_byte(int r, int c) { const int st = (r >> 4) * 2 + (c >> 5), rr = r & 15, cc = c & 31, ob = rr * 64 + cc * 2; return st * 1024 + (ob ^ (((ob >> 9) & 1) << 5)); }
__host__ __device__ __forceinline__ void stage_rc(int b, int& R, int& C) { const int st = b / 1024, sb = b % 1024, swz = sb ^ (((sb >> 9) & 1) << 5); R = (st >> 1) * 16 + swz / 64; C = (st & 1) * 32 + (swz % 64) / 2; }
__host__ __device__ __forceinline__ int perm32(int rho) { const int n = rho >> 4, i = rho & 15; return 8 * (i >> 2) + 4 * n + (i & 3); }

struct Unit { int pm, pn; };
struct Gemm { const bf16_t* A; const bf16_t* Bt; int M, N, K; };

struct StaticOrder {
    int nM, nN, nwg, G, c;
    __host__ __device__ void init(int M, int N, int G_, int c_) { nM = M / BM; nN = N / BM; nwg = nM * nN; G = G_; c = c_; }
    __host__ __device__ bool next(int i, Unit& u) const {
        const long L = (long)i * G + c; if (L >= nwg) return false;
        int wgid = (int)L; { const int q = nwg / NXCD, r = nwg % NXCD, xcd = wgid % NXCD, off = wgid / NXCD; wgid = (xcd < r ? xcd * (q + 1) : r * (q + 1) + (xcd - r) * q) + off; }
        const int nig = WGM * nN, gid = wgid / nig, fm = gid * WGM, gsz = (nM - fm) < WGM ? (nM - fm) : WGM;
        u.pm = fm + ((wgid % nig) % gsz); u.pn = (wgid % nig) / gsz; return true;
    }
    __device__ __forceinline__ void a_ready(const Unit&) const {}
    __device__ __forceinline__ void done(const Unit&) const {}
};

__device__ __forceinline__ unsigned cvt_pk_bf16(float lo, float hi) { unsigned r; asm volatile("v_cvt_pk_bf16_f32 %0, %1, %2" : "=v"(r) : "v"(lo), "v"(hi)); return r; }
template <class Epi, class Sched, bool ALIGN_EPI = false, bool SP2 = false>
__device__ __forceinline__ void gemm_phase(PG8_LAS unsigned char* lds, const Gemm g, const Sched& S, const Epi& E) {
    const int tid = mk_tid(), wid = __builtin_amdgcn_readfirstlane(tid >> 6), lane = tid & 63, wr = wid >> 2, wc = wid & 3, fr = lane & 15, fq = lane >> 4;
    const int K = g.K, nt = K / BK;
    unsigned voffA[2], voffB[2];
#pragma unroll
    for (int i = 0; i < 2; ++i) { int R, C; stage_rc(tid * 16 + i * 8192, R, C); const int Rb = Epi::PERM ? ((R & ~31) + perm32(R & 31)) : R;
        voffA[i] = (unsigned)(R * K + C) * 2u; voffB[i] = (unsigned)(Rb * K + C) * 2u; }
    const size_t kstep = (size_t)(BK * 2);
    const size_t hstep = (size_t)HALF * K * 2;
    const size_t tstep = 2 * hstep;
    const unsigned ldsw = (unsigned)wid * 1024u;
    const int aoff = lds_byte(wr * 64 + fr, fq * 8), boff = lds_byte(wc * 32 + fr, fq * 8);
#define PG8_SA(b, h) (((b) * 2 + (h)) * HTB)
#define PG8_SB(b, h) ((4 + (b) * 2 + (h)) * HTB)
#define PG8_STAGE(bufoff, gbase, voff) do { _Pragma("unroll") for (int _i = 0; _i < 2; ++_i) \
        __builtin_amdgcn_global_load_lds((const unsigned*)((const char*)(gbase) + (voff)[_i]), (PG8_LAS unsigned*)(lds + (bufoff) + ldsw + _i * 8192), 16, 0, 0); } while (0)
#define PG8_LDA(dst, b, h) do { _Pragma("unroll") for (int m = 0; m < 4; ++m) _Pragma("unroll") for (int k = 0; k < 2; ++k) dst[m][k] = *(const PG8_LAS bf16x8*)(lds + PG8_SA(b, h) + aoff + m * 2048 + k * 1024); } while (0)
#define PG8_LDB(dst, b, h) do { _Pragma("unroll") for (int n = 0; n < 2; ++n) _Pragma("unroll") for (int k = 0; k < 2; ++k) dst[n][k] = *(const PG8_LAS bf16x8*)(lds + PG8_SB(b, h) + boff + n * 2048 + k * 1024); } while (0)
#define PG8_MMA(ai, bj, At, Bt) do { __builtin_amdgcn_s_setprio(1); _Pragma("unroll") for (int m = 0; m < 4; ++m) _Pragma("unroll") for (int n = 0; n < 2; ++n) _Pragma("unroll") for (int k = 0; k < 2; ++k) \
        acc[ai][bj][m][n] = __builtin_amdgcn_mfma_f32_16x16x32_bf16(Bt[n][k], At[m][k], acc[ai][bj][m][n], 0, 0, 0); __builtin_amdgcn_s_setprio(0); } while (0)
#define PG8_WAIT_V(n) asm volatile("s_waitcnt vmcnt(" #n ")" ::: "memory")
#define PG8_WAIT_L(n) asm volatile("s_waitcnt lgkmcnt(" #n ")" ::: "memory")
#define PG8_BAR __builtin_amdgcn_s_barrier()
#define PG8_SCHED __builtin_amdgcn_sched_barrier(0)
    Unit cur, nxt; int ui = 0;
    if (!S.next(0, cur)) return;
    f32x4 acc[2][2][4][2];
#pragma unroll
    for (int a = 0; a < 2; ++a)
#pragma unroll
        for (int b = 0; b < 2; ++b)
#pragma unroll
            for (int m = 0; m < 4; ++m)
#pragma unroll
                for (int n = 0; n < 2; ++n) acc[a][b][m][n] = (f32x4){0.f, 0.f, 0.f, 0.f};
    bf16x8 At[4][2], B0[2][2], B1[2][2];
    const char* cA = (const char*)g.A + (size_t)cur.pm * tstep; const char* cB = (const char*)g.Bt + (size_t)cur.pn * tstep;
    S.a_ready(cur);
    if constexpr (SP2) {
        PG8_STAGE(PG8_SB(0, 0), cB, voffB); PG8_STAGE(PG8_SB(0, 1), cB + hstep, voffB); PG8_STAGE(PG8_SA(0, 0), cA, voffA); PG8_STAGE(PG8_SA(0, 1), cA + hstep, voffA);
        if (wr == 1) PG8_BAR;
        PG8_WAIT_V(2); PG8_BAR;
        PG8_STAGE(PG8_SB(1, 0), cB + kstep, voffB); PG8_STAGE(PG8_SA(1, 0), cA + kstep, voffA); PG8_STAGE(PG8_SB(1, 1), cB + hstep + kstep, voffB);
        PG8_WAIT_V(6); PG8_BAR;
    } else {
        PG8_STAGE(PG8_SB(0, 0), cB, voffB); PG8_STAGE(PG8_SA(0, 0), cA, voffA); PG8_STAGE(PG8_SB(0, 1), cB + hstep, voffB); PG8_STAGE(PG8_SA(0, 1), cA + hstep, voffA);
        if (wr == 1) PG8_BAR;
        PG8_WAIT_V(4); PG8_BAR;
        PG8_STAGE(PG8_SB(1, 0), cB + kstep, voffB); PG8_STAGE(PG8_SA(1, 0), cA + kstep, voffA); PG8_STAGE(PG8_SB(1, 1), cB + hstep + kstep, voffB);
        PG8_WAIT_V(6); PG8_BAR;
    }
    for (;;) {
        const bool has_next = S.next(ui + 1, nxt);
        const char* nA = has_next ? (const char*)g.A + (size_t)nxt.pm * tstep : cA; const char* nB = has_next ? (const char*)g.Bt + (size_t)nxt.pn * tstep : cB;
        for (int t = 0; t < nt; t += 2) {
            const bool last = (t == nt - 2);
            const char* a1 = cA + (size_t)(t + 1) * kstep;
            const char* a2 = last ? nA : cA + (size_t)(t + 2) * kstep; const char* b2 = last ? nB : cB + (size_t)(t + 2) * kstep;
            const char* a3 = a2 + kstep; const char* b3 = b2 + kstep;
            if (last && has_next) S.a_ready(nxt);
            if constexpr (SP2) {
            PG8_LDB(B0, 0, 0); PG8_LDB(B1, 0, 1); PG8_SCHED; PG8_LDA(At, 0, 0); PG8_STAGE(PG8_SA(1, 1), a1 + hstep, voffA);
            PG8_WAIT_V(8); PG8_WAIT_L(0); PG8_BAR; PG8_MMA(0, 0, At, B0); PG8_MMA(0, 1, At, B1); PG8_BAR; PG8_SCHED;
            PG8_LDA(At, 0, 1); PG8_STAGE(PG8_SB(0, 0), b2, voffB); PG8_STAGE(PG8_SB(0, 1), b2 + hstep, voffB); PG8_STAGE(PG8_SA(0, 0), a2, voffA);
            PG8_WAIT_V(8); PG8_WAIT_L(0); PG8_BAR; PG8_MMA(1, 0, At, B0); PG8_MMA(1, 1, At, B1); PG8_BAR; PG8_SCHED;
            PG8_LDB(B0, 1, 0); PG8_LDB(B1, 1, 1); PG8_SCHED; PG8_LDA(At, 1, 0); PG8_STAGE(PG8_SA(0, 1), a2 + hstep, voffA);
            PG8_WAIT_V(8); PG8_WAIT_L(0); PG8_BAR; PG8_MMA(0, 0, At, B0); PG8_MMA(0, 1, At, B1); PG8_BAR; PG8_SCHED;
            PG8_LDA(At, 1, 1); PG8_STAGE(PG8_SB(1, 0), b3, voffB); PG8_STAGE(PG8_SB(1, 1), b3 + hstep, voffB); PG8_STAGE(PG8_SA(1, 0), a3, voffA);
            PG8_WAIT_V(8); PG8_WAIT_L(0); PG8_BAR; PG8_MMA(1, 0, At, B0); PG8_MMA(1, 1, At, B1); PG8_BAR; PG8_SCHED;
            } else {
            PG8_LDB(B0, 0, 0); PG8_SCHED; PG8_LDA(At, 0, 0); PG8_STAGE(PG8_SA(1, 1), a1 + hstep, voffA);
            PG8_WAIT_L(8); PG8_BAR; PG8_WAIT_L(0); PG8_MMA(0, 0, At, B0); PG8_BAR; PG8_SCHED;
            PG8_LDB(B1, 0, 1); PG8_STAGE(PG8_SB(0, 0), b2, voffB);
            PG8_BAR; PG8_WAIT_L(0); PG8_MMA(0, 1, At, B1); PG8_BAR;
            PG8_LDA(At, 0, 1); PG8_STAGE(PG8_SA(0, 0), a2, voffA);
            PG8_BAR; PG8_WAIT_L(0); PG8_MMA(1, 0, At, B0); PG8_BAR; PG8_SCHED;
            PG8_STAGE(PG8_SB(0, 1), b2 + hstep, voffB);
            PG8_WAIT_V(6); PG8_BAR; PG8_MMA(1, 1, At, B1); PG8_BAR;
            PG8_LDB(B0, 1, 0); PG8_SCHED; PG8_LDA(At, 1, 0); PG8_STAGE(PG8_SA(0, 1), a2 + hstep, voffA);
            PG8_WAIT_L(8); PG8_BAR; PG8_WAIT_L(0); PG8_MMA(0, 0, At, B0); PG8_BAR; PG8_SCHED;
            PG8_LDB(B1, 1, 1); PG8_STAGE(PG8_SB(1, 0), b3, voffB);
            PG8_BAR; PG8_WAIT_L(0); PG8_MMA(0, 1, At, B1); PG8_BAR;
            PG8_LDA(At, 1, 1); PG8_STAGE(PG8_SA(1, 0), a3, voffA);
            PG8_BAR; PG8_WAIT_L(0); PG8_MMA(1, 0, At, B0); PG8_BAR; PG8_SCHED;
            PG8_STAGE(PG8_SB(1, 1), b3 + hstep, voffB);
            PG8_WAIT_V(6); PG8_BAR; PG8_MMA(1, 1, At, B1); PG8_BAR;
            }
        }
        if constexpr (ALIGN_EPI) { if (wr == 0) PG8_BAR; }
        if constexpr (!Epi::AFTER_DRAIN) { E(acc, cur, wr, wc, fr, fq); S.done(cur); }
        if (!has_next) break;
#pragma unroll
        for (int a = 0; a < 2; ++a)
#pragma unroll
            for (int b = 0; b < 2; ++b)
#pragma unroll
                for (int m = 0; m < 4; ++m)
#pragma unroll
                    for (int n = 0; n < 2; ++n) acc[a][b][m][n] = (f32x4){0.f, 0.f, 0.f, 0.f};
        cur = nxt; cA = nA; cB = nB; ++ui;
        if constexpr (ALIGN_EPI) { if (wr == 1) PG8_BAR; }
    }
    PG8_WAIT_V(0);
    if constexpr (!ALIGN_EPI) { if (wr == 0) PG8_BAR; }
    PG8_BAR;
    if constexpr (Epi::AFTER_DRAIN) { E.fused(acc, cur, wr, wc, fr, fq, lds, wid, lane); S.done(cur); }
#undef PG8_SA
#undef PG8_SB
#undef PG8_STAGE
#undef PG8_LDA
#undef PG8_LDB
#undef PG8_MMA
#undef PG8_WAIT_V
#undef PG8_WAIT_L
#undef PG8_BAR
#undef PG8_SCHED
}
}

#define LASP __attribute__((address_space(3)))

struct EpiProj {
    static constexpr bool PERM = true, AFTER_DRAIN = false;
    bf16* raw; bf16* rest;
    __device__ __forceinline__ void operator()(const pg8::f32x4 (&acc)[2][2][4][2], const pg8::Unit& u, int wr, int wc, int fr, int fq) const {
        const int row0 = u.pm * 256 + wr * 64 + fr;
        const int colb = u.pn * 256 + wc * 32 + 8 * fq;
#pragma unroll
        for (int bj = 0; bj < 2; ++bj) {
            const int col = colb + bj * 128;
            if (col >= NPROJ) continue;
            bf16* base; int ld;
            if (col < NRAW) { base = raw + col; ld = NRAW; } else { base = rest + (col - NRAW); ld = NREST; }
#pragma unroll
            for (int ai = 0; ai < 2; ++ai)
#pragma unroll
                for (int m = 0; m < 4; ++m) {
                    const pg8::f32x4 v0 = acc[ai][bj][m][0], v1 = acc[ai][bj][m][1];
                    pg8::u32x4 w; w.x = pg8::cvt_pk_bf16(v0[0], v0[1]); w.y = pg8::cvt_pk_bf16(v0[2], v0[3]); w.z = pg8::cvt_pk_bf16(v1[0], v1[1]); w.w = pg8::cvt_pk_bf16(v1[2], v1[3]);
                    *(pg8::u32x4*)(base + (size_t)(row0 + ai * 128 + m * 16) * ld) = w;
                }
        }
    }
};
struct EpiRes {
    static constexpr bool PERM = false, AFTER_DRAIN = false;
    const float* xl_src; const float* xc_src; float* out; float* xc1; const float* mods; int l;
    __device__ __forceinline__ void operator()(const pg8::f32x4 (&acc)[2][2][4][2], const pg8::Unit& u, int wr, int wc, int fr, int fq) const {
        const int row0 = u.pm * 256 + wr * 64 + fr, col0 = u.pn * 256 + wc * 32 + 4 * fq;
#pragma unroll
        for (int ai = 0; ai < 2; ++ai)
#pragma unroll
            for (int m = 0; m < 4; ++m) {
                const int r = row0 + ai * 128 + m * 16;
                const int b = r / TOK, t = r - b * TOK;
                const float* src; float* dst; int s;
                if (t < CTX) { if (l != 0) continue; src = xc_src + ((size_t)b * CTX + t) * D; dst = xc1 + ((size_t)b * CTX + t) * D; s = 8; }
                else { src = xl_src + ((size_t)b * SEQ + (t - CTX)) * D; dst = out + ((size_t)b * SEQ + (t - CTX)) * D; s = b; }
                const float* gt = mods + (size_t)(l * 9 + s) * 3072 + 2048;
#pragma unroll
                for (int bj = 0; bj < 2; ++bj)
#pragma unroll
                    for (int n = 0; n < 2; ++n) {
                        const int c = col0 + bj * 128 + n * 16;
                        const pg8::f32x4 xv = *(const pg8::f32x4*)(src + c), g = *(const pg8::f32x4*)(gt + c);
                        *(pg8::f32x4*)(dst + c) = xv * ALPHA + g * acc[ai][bj][m][n];
                    }
            }
    }
};

__device__ __forceinline__ void transpose_item(const float* W, int K, int N, bf16* WT, LASP float* scr, int item, int lane) {
    const int nblk = (N + 31) / 32, kb = item / nblk, nb = item % nblk, k0 = 64 * kb, n0 = 32 * nb;
    const bool nok = (n0 + (lane & 31)) < N;
#pragma unroll 8
    for (int i = 0; i < 32; ++i) { const int kk = 2 * i + (lane >> 5); scr[kk * 33 + (lane & 31)] = nok ? W[(size_t)(k0 + kk) * N + n0 + (lane & 31)] : 0.f; }
    asm volatile("s_waitcnt lgkmcnt(0)" ::: "memory");
    const int c = lane & 7;
#pragma unroll
    for (int j = 0; j < 4; ++j) {
        const int n = (lane >> 3) + 8 * j; const LASP float* s = scr + (8 * c) * 33 + n;
        uint4 o; o.x = pk2(s[0 * 33], s[1 * 33]); o.y = pk2(s[2 * 33], s[3 * 33]); o.z = pk2(s[4 * 33], s[5 * 33]); o.w = pk2(s[6 * 33], s[7 * 33]);
        *(uint4*)(WT + (size_t)(n0 + n) * K + k0 + 8 * c) = o;
    }
    asm volatile("s_waitcnt lgkmcnt(0)" ::: "memory");
}

__device__ void ph_prologue(const P& p, LASP unsigned char* lds, int bid, int nblk) {
    const int tid = mk_tid(), lane = tid & 63, wave = tid >> 6;
    LASP float* sm = (LASP float*)lds;
    if (bid < 96) {
        for (int i = tid; i < 9 * 1024; i += NTHREADS) {
            int s = i >> 10, d = i & 1023;
            float cv = s < 8 ? p.c[s * 1024 + d] : p.c_ctx[d];
            sm[i] = silu_f(cv);
        }
        __syncthreads();
        const int l = bid / 48, j = (bid % 48) * 64 + lane;
        const float* w = p.w_mod + (size_t)l * 1024 * 3072 + j;
        float acc[9];
#pragma unroll
        for (int s = 0; s < 9; ++s) acc[s] = 0.f;
#pragma unroll 1
        for (int i0 = wave * 128; i0 < wave * 128 + 128; i0 += 16) {
            float wv[16];
#pragma unroll
            for (int u = 0; u < 16; ++u) wv[u] = w[(size_t)(i0 + u) * 3072];
#pragma unroll
            for (int u = 0; u < 16; ++u)
#pragma unroll
                for (int s = 0; s < 9; ++s) acc[s] += sm[s * 1024 + i0 + u] * wv[u];
        }
        LASP float* red = sm + 9 * 1024;
#pragma unroll
        for (int s = 0; s < 9; ++s) red[(wave * 9 + s) * 64 + lane] = acc[s];
        __syncthreads();
        for (int o = tid; o < 9 * 64; o += NTHREADS) {
            const int s = o >> 6, c = o & 63;
            float t = 0.f;
#pragma unroll
            for (int ww = 0; ww < 8; ++ww) t += red[(ww * 9 + s) * 64 + c];
            const int jj = (bid % 48) * 64 + c;
            p.mods[(size_t)(l * 9 + s) * 3072 + jj] = t + p.b_mod[l * 3072 + jj];
        }
        __syncthreads();
    }
#if PROBE
    if (bid == 0 && tid < 4) p.stats[tid] = 0.f;
#endif
    LASP float* scr = (LASP float*)(lds + 57344 + wave * 8704);
    const int gw = (nblk - 1 - bid) * NWAVES + wave, NGW = nblk * NWAVES;
    constexpr int I_IN = 16 * 122, I_OUT = 16 * 32;
    for (int it = gw; it < 2 * (I_IN + I_OUT); it += NGW) {
        int l = it / (I_IN + I_OUT), r = it % (I_IN + I_OUT);
        if (r < I_IN) transpose_item(p.w_in + (size_t)l * D * NPROJ, D, NPROJ, p.wi_t + (size_t)l * NPAD * D, scr, r, lane);
        else transpose_item(p.w_out + (size_t)l * D * D, D, D, p.wo_t + (size_t)l * D * D, scr, r - I_IN, lane);
    }
    for (int i = bid * NTHREADS + tid; i < 2 * 192 * 128; i += nblk * NTHREADS) {
        int l = i / (192 * 128), r = i % (192 * 128);
        *(uint4*)(p.wi_t + (size_t)l * NPAD * D + (size_t)3904 * D + (size_t)r * 8) = make_uint4(0, 0, 0, 0);
    }
}

__device__ void ph_lnpass(const P& p, int mode, int bid, int nblk) {
    const int tid = mk_tid();
    const int lane = tid & 63, wave = tid >> 6;
    for (int r = bid * NWAVES + wave; r < ROWS; r += nblk * NWAVES) {
        const int b = r / TOK, t = r - b * TOK;
        const bool isc = t < CTX;
        if (mode == 2 && isc) continue;
        float* buf; const float* src; int s;
        if (isc) { buf = p.xc1 + ((size_t)b * CTX + t) * D; src = (mode == 0) ? p.ctx + ((size_t)b * CTX + t) * D : buf; s = 8; }
        else { buf = p.out + ((size_t)b * SEQ + (t - CTX)) * D; src = (mode == 0) ? p.x + ((size_t)b * SEQ + (t - CTX)) * D : buf; s = b; }
        f32x4_t v[4];
#pragma unroll
        for (int j = 0; j < 4; ++j) v[j] = *(const f32x4_t*)(src + 256 * j + 4 * lane);
        if (mode >= 1) {
            const int lp = mode - 1;
            float sum = 0.f;
#pragma unroll
            for (int j = 0; j < 4; ++j) sum += (v[j].x + v[j].y) + (v[j].z + v[j].w);
            const float mu = wave_sum(sum) * (1.f / 1024.f);
            float sq = 0.f;
#pragma unroll
            for (int j = 0; j < 4; ++j) { v[j] = v[j] - mu; sq += (v[j].x * v[j].x + v[j].y * v[j].y) + (v[j].z * v[j].z + v[j].w * v[j].w); }
            const float rs = 1.f / sqrtf(wave_sum(sq) * (1.f / 1024.f) + 1e-6f);
#pragma unroll
            for (int j = 0; j < 4; ++j) {
                const f32x4_t g = *(const f32x4_t*)(p.ln_g + lp * 1024 + 256 * j + 4 * lane), bb = *(const f32x4_t*)(p.ln_b + lp * 1024 + 256 * j + 4 * lane);
                v[j] = v[j] * rs * g + bb;
#if PROBE
                if (mode == 2) v[j] = v[j] + (p.stats[0] / fmaxf(p.stats[1], 1e-20f));
#endif
#if TPROBE >= 0
                if (mode == 2) v[j] = v[j] + exp2f((rintf(log2f(fmaxf(p.stats[2], 1.f)) * 6.f + TSHIFT * 0.5f) - TSHIFT * 0.5f) * (1.f / 6.f)) * 1e-4f;
#endif
                *(f32x4_t*)(buf + 256 * j + 4 * lane) = v[j];
            }
            if (mode == 2) continue;
        }
        const int l = mode;
        float sum = 0.f;
#pragma unroll
        for (int j = 0; j < 4; ++j) sum += (v[j].x + v[j].y) + (v[j].z + v[j].w);
        const float mu = wave_sum(sum) * (1.f / 1024.f);
        float sq = 0.f;
#pragma unroll
        for (int j = 0; j < 4; ++j) { v[j] = v[j] - mu; sq += (v[j].x * v[j].x + v[j].y * v[j].y) + (v[j].z * v[j].z + v[j].w * v[j].w); }
        const float rs = 1.f / sqrtf(wave_sum(sq) * (1.f / 1024.f) + 1e-6f);
        const float* md = p.mods + (size_t)(l * 9 + s) * 3072;
#pragma unroll
        for (int j = 0; j < 4; ++j) {
            const f32x4_t sh = *(const f32x4_t*)(md + 256 * j + 4 * lane), sc = *(const f32x4_t*)(md + 1024 + 256 * j + 4 * lane);
            const f32x4_t o = v[j] * rs * (sc + 1.f) + sh;
            uint2 w; w.x = pk2(o.x, o.y); w.y = pk2(o.z, o.w);
            *(uint2*)(p.ml + (size_t)r * D + 256 * j + 4 * lane) = w;
        }
    }
}

__device__ void ph_conv(const P& p, int l, int bid, int nblk) {
    const int tid = mk_tid();
    const int lane = tid & 63, wave = tid >> 6;
    const float* cw = p.conv_w + (size_t)l * 5 * 1536;
    constexpr int NSTRIP = TOK / 16;
    for (int it = bid * NWAVES + wave; it < BATCH * NSTRIP * 3; it += nblk * NWAVES) {
        const int third = it % 3, rest_i = it / 3, strip = rest_i % NSTRIP, b = rest_i / NSTRIP;
        const int t0 = strip * 16;
        const int lo = t0 < CTX ? 0 : CTX, hi = t0 < CTX ? CTX : TOK;
        const int ch = third * 512 + lane * 8;
        float w[5][8];
#pragma unroll
        for (int j = 0; j < 5; ++j) {
            const f32x4_t a = *(const f32x4_t*)(cw + j * 1536 + ch), c = *(const f32x4_t*)(cw + j * 1536 + ch + 4);
            w[j][0] = a.x; w[j][1] = a.y; w[j][2] = a.z; w[j][3] = a.w; w[j][4] = c.x; w[j][5] = c.y; w[j][6] = c.z; w[j][7] = c.w;
        }
        const bf16* src = p.raw + ((size_t)b * TOK + t0) * NRAW + ch;
        bf16* dst = p.qkvn + ((size_t)b * TOK + t0) * NRAW + ch;
        uint4 rw[20];
#pragma unroll
        for (int i = 0; i < 20; ++i) {
            const int tt = t0 + i - 2;
            rw[i] = (tt >= lo && tt < hi) ? *(const uint4*)(src + (ptrdiff_t)(i - 2) * NRAW) : make_uint4(0, 0, 0, 0);
        }
        const int g = (ch >> 7);
        const float qs = g < 4 ? 0.08838834764831845f : 1.f;
#pragma unroll
        for (int n = 0; n < 16; ++n) {
            float acc[8];
#pragma unroll
            for (int e = 0; e < 8; ++e) acc[e] = 0.f;
#pragma unroll
            for (int j = 0; j < 5; ++j) {
                float f[8]; unpack8(rw[n + j], f);
#pragma unroll
                for (int e = 0; e < 8; ++e) acc[e] += w[j][e] * f[e];
            }
            float ss = 0.f;
#pragma unroll
            for (int e = 0; e < 8; ++e) { acc[e] = silu_f(acc[e]); ss += acc[e] * acc[e]; }
            if (g < 8) {
#pragma unroll
                for (int m = 8; m > 0; m >>= 1) ss += __shfl_xor(ss, m);
                const float sc = qs * __builtin_amdgcn_rsqf(ss + 1e-6f);
#pragma unroll
                for (int e = 0; e < 8; ++e) acc[e] *= sc;
            }
            uint4 o; o.x = pk2(acc[0], acc[1]); o.y = pk2(acc[2], acc[3]); o.z = pk2(acc[4], acc[5]); o.w = pk2(acc[6], acc[7]);
            *(uint4*)(dst + (size_t)n * NRAW) = o;
        }
    }
}

typedef short bf16x8_t __attribute__((ext_vector_type(8)));
typedef float f32x16_t __attribute__((ext_vector_type(16)));
typedef float f32x2_t __attribute__((ext_vector_type(2)));
typedef __bf16 bf16x2_t __attribute__((ext_vector_type(2)));
typedef unsigned u32x4_t __attribute__((ext_vector_type(4)));
#define MFMA32(a, b, c) __builtin_amdgcn_mfma_f32_32x32x16_bf16((a), (b), (c), 0, 0, 0)
__device__ __forceinline__ unsigned cvtpk(float lo, float hi) { f32x2_t v = {lo, hi}; bf16x2_t q = __builtin_convertvector(v, bf16x2_t); return __builtin_bit_cast(unsigned, q); }
__device__ __forceinline__ int crow(int reg, int h) { return (reg & 3) + 8 * (reg >> 2) + 4 * h; }
__device__ __forceinline__ int perm16(int a) { const int x = a & 15; return (a & ~15) + (x < 4 ? x : x < 8 ? x + 4 : x < 12 ? x - 4 : x); }
#define PACK8(x, s) __builtin_bit_cast(bf16x8_t, (u32x4_t){cvtpk((x)[8 * (s)], (x)[8 * (s) + 1]), cvtpk((x)[8 * (s) + 2], (x)[8 * (s) + 3]), cvtpk((x)[8 * (s) + 4], (x)[8 * (s) + 5]), cvtpk((x)[8 * (s) + 6], (x)[8 * (s) + 7])})
constexpr int GCH = 32, NCH = TOK / GCH;
constexpr int GP_ITEM = 4416;

__device__ void ph_gdnprep(const P& p, LASP unsigned char* lds, int l, int bid, int nblk, int tid) {
    const int lane = tid & 63, wave = tid >> 6, r = lane & 31, hh = lane >> 5;
    LASP float* Lm = (LASP float*)(lds + wave * 16384);
    LASP float* Xs = Lm + 2048;
    for (int it = bid * NWAVES + wave; it < BATCH * 4 * NCH; it += nblk * NWAVES) {
        const int c = it % NCH, bh = it / NCH, h = bh & 3, b = bh >> 2;
        const size_t row0 = (size_t)b * TOK + (size_t)c * GCH;
        f32x16_t KK, QK;
#pragma unroll
        for (int i = 0; i < 16; ++i) { KK[i] = 0.f; QK[i] = 0.f; }
        const bf16* kbase = p.qkvn + (row0 + r) * NRAW + 512 + h * 128 + 8 * hh;
        const bf16* qbase = p.qkvn + (row0 + r) * NRAW + h * 128 + 8 * hh;
#pragma unroll
        for (int s = 0; s < 8; ++s) {
            const bf16x8_t kf = *(const bf16x8_t*)(kbase + 16 * s), qf = *(const bf16x8_t*)(qbase + 16 * s);
            KK = MFMA32(kf, kf, KK);
            QK = MFMA32(qf, kf, QK);
        }
        float Gd, bd;
        {
            const bf16* ab = p.rest + (row0 + r) * NREST + RC_AB;
            const float a = bf2f(ab[hh * 4 + h]) + p.dt_bias[(l * 2 + hh) * 4 + h];
            const float sp = fmaxf(a, 0.f) + log1pf(expf(-fabsf(a)));
            Gd = -expf(p.a_log[(l * 2 + hh) * 4 + h]) * sp;
            bd = 1.f / (1.f + expf(-bf2f(ab[(2 + hh) * 4 + h])));
        }
#pragma unroll
        for (int off = 1; off < 32; off <<= 1) {
            const float up = __shfl_up(Gd, off, 32), dn = __shfl_down(Gd, off, 32);
            if (hh == 0) { if (r >= off) Gd += up; } else { if (r + off < 32) Gd += dn; }
        }
        unsigned char* gout = (unsigned char*)p.raw + ((size_t)(bh * 2) * NCH + c) * GP_ITEM;
        {
            const float Glast = __shfl(Gd, hh == 0 ? 31 : 32);
            float* sc = (float*)(gout + (size_t)hh * NCH * GP_ITEM + 4096);
            sc[r] = expf(Gd); sc[32 + r] = expf(Glast - Gd);
            if (r == 0) sc[64] = expf(Glast);
        }
        asm volatile("s_waitcnt lgkmcnt(0)" ::: "memory");
#pragma unroll
        for (int d = 0; d < 2; ++d) {
            const float Gcol = __shfl(Gd, d * 32 + r);
            bf16* qko = (bf16*)(gout + (size_t)d * NCH * GP_ITEM + 2048);
#pragma unroll
            for (int i = 0; i < 16; ++i) {
                const int n = crow(i, hh);
                const float Grow = __shfl(Gd, d * 32 + n), brow = __shfl(bd, d * 32 + n);
                const bool incl = d == 0 ? (r <= n) : (r >= n), strict = d == 0 ? (r < n) : (r > n);
                const float dec = expf(incl ? Grow - Gcol : 0.f);
                const float lv = strict ? brow * KK[i] * dec : 0.f;
                const float qv = incl ? QK[i] * dec : 0.f;
                const int n2 = d == 0 ? n : 31 - n, m2 = d == 0 ? r : 31 - r;
                Lm[(d * 32 + n2) * 32 + m2] = lv;
                qko[n * 32 + perm16(r)] = f2bf(qv);
                if ((i & 3) == 3) __builtin_amdgcn_sched_barrier(0);
            }
        }
        asm volatile("s_waitcnt lgkmcnt(0)" ::: "memory");
        {
            const LASP float* Lr = Lm + hh * 1024;
            LASP float* xc = Xs + lane;
#pragma unroll 4
            for (int j = 0; j < 32; ++j) xc[j * 64] = (j == r) ? 1.f : 0.f;
#pragma unroll 1
            for (int n = 1; n < 32; ++n) {
                float a0 = 0.f, a1 = 0.f;
#pragma unroll 1
                for (int j4 = 0; j4 < n; j4 += 4) {
                    const f32x4_t lv = *(const LASP f32x4_t*)(Lr + n * 32 + j4);
                    a0 += lv.x * xc[(j4 + 0) * 64]; a1 += lv.y * xc[(j4 + 1) * 64];
                    a0 += lv.z * xc[(j4 + 2) * 64]; a1 += lv.w * xc[(j4 + 3) * 64];
                }
                xc[n * 64] -= (a0 + a1);
            }
            const int mtok = hh == 0 ? r : 31 - r;
            const float bcol = __shfl(bd, hh * 32 + mtok);
            bf16* tq = (bf16*)(gout + (size_t)hh * NCH * GP_ITEM) + perm16(mtok) + (hh == 0 ? 0 : 31 * 32);
            const int tstep = hh == 0 ? 32 : -32;
#pragma unroll 4
            for (int n = 0; n < 32; ++n) { *tq = f2bf(xc[n * 64] * bcol); tq += tstep; }
        }
        asm volatile("s_waitcnt lgkmcnt(0)" ::: "memory");
    }
}


constexpr int ST_KA = 0, ST_QA = 8704, ST_KN = 17408, ST_V = 27648, ST_TP = 37888, ST_QK = 40448, ST_GL = 43008, ST_BYTES = 43072;
typedef unsigned u32x2_t __attribute__((ext_vector_type(2)));
typedef short s16x4_t __attribute__((ext_vector_type(4)));
struct GSlot { u32x4_t k0, k1, q0, q1, v0, v1, t; float e0, e1, f0, f1, gl; };

__device__ __forceinline__ int gdn_chunk(int dir, int s) { return dir == 0 ? s : (s < 8 ? 7 - s : 143 - s); }
__device__ __forceinline__ void gdn_issue(const P& p, GSlot& g, int b, int h, int dir, int step, int tl) {
    const int c = gdn_chunk(dir, step);
    const size_t row0 = (size_t)b * TOK + (size_t)c * GCH;
    const int r0 = tl >> 4, c16 = tl & 15;
    const bf16* a0 = p.qkvn + (row0 + r0) * NRAW + h * 128 + 8 * c16;
    const bf16* a1 = a0 + (size_t)16 * NRAW;
    g.q0 = *(const u32x4_t*)a0; g.q1 = *(const u32x4_t*)a1;
    g.k0 = *(const u32x4_t*)(a0 + 512); g.k1 = *(const u32x4_t*)(a1 + 512);
    g.v0 = *(const u32x4_t*)(a0 + 1024); g.v1 = *(const u32x4_t*)(a1 + 1024);
    const unsigned char* gp = (const unsigned char*)p.raw + ((size_t)((b * 4 + h) * 2 + dir) * NCH + c) * GP_ITEM;
    g.t = *(const u32x4_t*)(gp + tl * 16);
    const float* sc = (const float*)(gp + 4096);
    g.e0 = sc[r0]; g.e1 = sc[r0 + 16]; g.f0 = sc[32 + r0]; g.f1 = sc[48 + r0]; g.gl = sc[64];
}
__device__ __forceinline__ u32x4_t scale8(u32x4_t x, float s) {
    return (u32x4_t){cvtpk(bflo(x.x) * s, bfhi(x.x) * s), cvtpk(bflo(x.y) * s, bfhi(x.y) * s), cvtpk(bflo(x.z) * s, bfhi(x.z) * s), cvtpk(bflo(x.w) * s, bfhi(x.w) * s)};
}
__device__ __forceinline__ void gdn_put_rows(LASP unsigned char* st, int row, int c16, u32x4_t kq, int off) {
    const int g = c16 >> 1, odd = c16 & 1;
    *(LASP u32x2_t*)(st + off + row * 272 + (16 * g + (odd ? 4 : 0)) * 2) = (u32x2_t){kq.x, kq.y};
    *(LASP u32x2_t*)(st + off + row * 272 + (16 * g + (odd ? 12 : 8)) * 2) = (u32x2_t){kq.z, kq.w};
}
__device__ __forceinline__ void gdn_write(LASP unsigned char* st, const GSlot& g, int tl) {
    const int r0 = tl >> 4, c16 = tl & 15;
    gdn_put_rows(st, r0, c16, scale8(g.k0, -g.e0), ST_KA); gdn_put_rows(st, r0 + 16, c16, scale8(g.k1, -g.e1), ST_KA);
    gdn_put_rows(st, r0, c16, scale8(g.q0, g.e0), ST_QA); gdn_put_rows(st, r0 + 16, c16, scale8(g.q1, g.e1), ST_QA);
    *(LASP u32x4_t*)(st + ST_KN + r0 * 320 + c16 * 16) = scale8(g.k0, g.f0);
    *(LASP u32x4_t*)(st + ST_KN + (r0 + 16) * 320 + c16 * 16) = scale8(g.k1, g.f1);
    *(LASP u32x4_t*)(st + ST_V + r0 * 320 + c16 * 16) = g.v0;
    *(LASP u32x4_t*)(st + ST_V + (r0 + 16) * 320 + c16 * 16) = g.v1;
    { const int t2 = tl & 127; *(LASP u32x4_t*)(st + (tl < 128 ? ST_TP : ST_QK) + (t2 >> 2) * 80 + (t2 & 3) * 16) = g.t; }
    if (tl == 0) *(LASP float*)(st + ST_GL) = g.gl;
}
__device__ __forceinline__ s16x4_t trd(const LASP unsigned char* q) {
    typedef short v4i16_t __attribute__((ext_vector_type(4)));
    return __builtin_bit_cast(s16x4_t, __builtin_amdgcn_ds_read_tr16_b64_v4i16((LASP v4i16_t*)q));
}
#define TRFRAG(base) __builtin_shufflevector(trd(base), trd((base) + 8 * 320), 0, 1, 2, 3, 4, 5, 6, 7)

#if TPROBE == 60
#define GDN_SYNC_C() do { unsigned long long t_ = __builtin_amdgcn_s_memrealtime(); __syncthreads(); if (chain == 0 && tid == 0) p.stats[2] += (float)(__builtin_amdgcn_s_memrealtime() - t_) * 0.01f; } while (0)
#define GDN_SYNC_L() __syncthreads()
#elif TPROBE == 61
#define GDN_SYNC_L() do { unsigned long long t_ = __builtin_amdgcn_s_memrealtime(); __syncthreads(); if (chain == 0 && tid == 256) p.stats[2] += (float)(__builtin_amdgcn_s_memrealtime() - t_) * 0.01f; } while (0)
#define GDN_SYNC_C() __syncthreads()
#else
#define GDN_SYNC_C() __syncthreads()
#define GDN_SYNC_L() __syncthreads()
#endif
__device__ void gdn_scan_fast(const P& p, LASP unsigned char* lds, int chain) {
    const int tid = mk_tid();
    const int lane = tid & 63, wave = __builtin_amdgcn_readfirstlane(tid >> 6);
    const int dir = chain & 1, h = (chain >> 1) & 3, b = chain >> 3;
    constexpr int NS = NCH;
    if (wave >= 4) {
        const int tl = tid - 256;
        GSlot g0, g1, g2, g3;
        gdn_issue(p, g0, b, h, dir, 0, tl); gdn_issue(p, g1, b, h, dir, 1, tl); gdn_issue(p, g2, b, h, dir, 2, tl); gdn_issue(p, g3, b, h, dir, 3, tl);
        gdn_write(lds, g0, tl); gdn_issue(p, g0, b, h, dir, 4, tl);
        __syncthreads();
#pragma unroll 1
        for (int s = 0; s < NS; s += 4) {
            gdn_write(lds + ((s + 1) & 1) * ST_BYTES, g1, tl); gdn_issue(p, g1, b, h, dir, min(s + 5, NS - 1), tl);
            GDN_SYNC_L();
            gdn_write(lds + ((s + 2) & 1) * ST_BYTES, g2, tl); gdn_issue(p, g2, b, h, dir, min(s + 6, NS - 1), tl);
            GDN_SYNC_L();
            gdn_write(lds + ((s + 3) & 1) * ST_BYTES, g3, tl); gdn_issue(p, g3, b, h, dir, min(s + 7, NS - 1), tl);
            GDN_SYNC_L();
            gdn_write(lds + ((s + 4) & 1) * ST_BYTES, g0, tl); gdn_issue(p, g0, b, h, dir, min(s + 8, NS - 1), tl);
            GDN_SYNC_L();
        }
    } else {
        const int r = lane & 31, hh = lane >> 5, w = wave;
        f32x16_t S0, S1, S2, S3;
#pragma unroll
        for (int i = 0; i < 16; ++i) { S0[i] = 0.f; S1[i] = 0.f; S2[i] = 0.f; S3[i] = 0.f; }
        const int troff = (4 * hh + ((lane & 15) >> 2)) * 320 + (16 * ((lane >> 4) & 1) + 4 * (lane & 3)) * 2;
        LASP unsigned short* ost = (LASP unsigned short*)(lds + 2 * ST_BYTES + 256 + w * 2560);
        __syncthreads();
#pragma unroll 1
        for (int s = 0; s < NS; ++s) {
            LASP unsigned char* st = lds + (s & 1) * ST_BYTES;
            const LASP unsigned char* ka = st + ST_KA + r * 272 + hh * 16;
            const LASP unsigned char* qa = st + ST_QA + r * 272 + hh * 16;
            const bf16x8_t kA0 = *(const LASP bf16x8_t*)(ka), kA1 = *(const LASP bf16x8_t*)(ka + 32), kA2 = *(const LASP bf16x8_t*)(ka + 64), kA3 = *(const LASP bf16x8_t*)(ka + 96);
            const bf16x8_t kA4 = *(const LASP bf16x8_t*)(ka + 128), kA5 = *(const LASP bf16x8_t*)(ka + 160), kA6 = *(const LASP bf16x8_t*)(ka + 192), kA7 = *(const LASP bf16x8_t*)(ka + 224);
            const bf16x8_t qA0 = *(const LASP bf16x8_t*)(qa), qA1 = *(const LASP bf16x8_t*)(qa + 32), qA2 = *(const LASP bf16x8_t*)(qa + 64), qA3 = *(const LASP bf16x8_t*)(qa + 96);
            const bf16x8_t qA4 = *(const LASP bf16x8_t*)(qa + 128), qA5 = *(const LASP bf16x8_t*)(qa + 160), qA6 = *(const LASP bf16x8_t*)(qa + 192), qA7 = *(const LASP bf16x8_t*)(qa + 224);
            const LASP unsigned char* vbase = st + ST_V + troff + 64 * w;
            const bf16x8_t vB0 = TRFRAG(vbase), vB1 = TRFRAG(vbase + 16 * 320);
            const LASP unsigned char* tp = st + ST_TP + r * 80 + hh * 16;
            const bf16x8_t T0 = *(const LASP bf16x8_t*)(tp), T1 = *(const LASP bf16x8_t*)(tp + 32);
            const LASP unsigned char* qk = st + ST_QK + r * 80 + hh * 16;
            const bf16x8_t Q0 = *(const LASP bf16x8_t*)(qk), Q1 = *(const LASP bf16x8_t*)(qk + 32);
            const float gl = *(const LASP float*)(st + ST_GL);
            __builtin_amdgcn_sched_barrier(0);
            f32x16_t ak, aq, vn;
#pragma unroll
            for (int i = 0; i < 16; ++i) { ak[i] = 0.f; aq[i] = 0.f; vn[i] = 0.f; }
            vn = MFMA32(T0, vB0, vn); vn = MFMA32(T1, vB1, vn);
#define GDN_KQ(KA, QA, SX, u) { const bf16x8_t SB = PACK8(SX, u); ak = MFMA32(KA, SB, ak); aq = MFMA32(QA, SB, aq); }
            GDN_KQ(kA0, qA0, S0, 0) GDN_KQ(kA1, qA1, S0, 1) GDN_KQ(kA2, qA2, S1, 0) GDN_KQ(kA3, qA3, S1, 1)
            GDN_KQ(kA4, qA4, S2, 0) GDN_KQ(kA5, qA5, S2, 1) GDN_KQ(kA6, qA6, S3, 0) GDN_KQ(kA7, qA7, S3, 1)
#undef GDN_KQ
            __builtin_amdgcn_sched_barrier(0);
            const LASP unsigned char* kn = st + ST_KN + troff;
            const bf16x8_t N00 = TRFRAG(kn), N01 = TRFRAG(kn + 16 * 320), N10 = TRFRAG(kn + 64), N11 = TRFRAG(kn + 64 + 16 * 320);
            const bf16x8_t N20 = TRFRAG(kn + 128), N21 = TRFRAG(kn + 128 + 16 * 320), N30 = TRFRAG(kn + 192), N31 = TRFRAG(kn + 192 + 16 * 320);
            __builtin_amdgcn_sched_barrier(0);
            const bf16x8_t ab0 = PACK8(ak, 0), ab1 = PACK8(ak, 1);
            vn = MFMA32(T0, ab0, vn); vn = MFMA32(T1, ab1, vn);
            S0 = S0 * gl; S1 = S1 * gl; S2 = S2 * gl; S3 = S3 * gl;
            const bf16x8_t vb0 = PACK8(vn, 0), vb1 = PACK8(vn, 1);
            S0 = MFMA32(N00, vb0, S0); S1 = MFMA32(N10, vb0, S1); S2 = MFMA32(N20, vb0, S2); S3 = MFMA32(N30, vb0, S3);
            S0 = MFMA32(N01, vb1, S0); S1 = MFMA32(N11, vb1, S1); S2 = MFMA32(N21, vb1, S2); S3 = MFMA32(N31, vb1, S3);
            aq = MFMA32(Q0, vb0, aq); aq = MFMA32(Q1, vb1, aq);
            {
#pragma unroll
                for (int i = 0; i < 16; i += 2) { const unsigned pk = cvtpk(aq[i], aq[i + 1]); ost[crow(i, hh) * 40 + r] = (unsigned short)pk; ost[(crow(i, hh) + 1) * 40 + r] = (unsigned short)(pk >> 16); }
                asm volatile("s_waitcnt lgkmcnt(0)" ::: "memory");
                const int c = gdn_chunk(dir, s);
                const int orow = lane >> 1, oh = lane & 1;
                const u32x4_t o0 = *(const LASP u32x4_t*)((const LASP unsigned char*)ost + orow * 80 + oh * 32);
                const u32x4_t o1 = *(const LASP u32x4_t*)((const LASP unsigned char*)ost + orow * 80 + oh * 32 + 16);
                bf16* op = p.oa + ((size_t)dir * ROWS + (size_t)b * TOK + (size_t)c * GCH + orow) * 512 + h * 128 + 32 * w + oh * 16;
                *(u32x4_t*)op = o0; *(u32x4_t*)(op + 8) = o1;
            }
            GDN_SYNC_C();
        }
    }
}

constexpr int GL_ITEM = 6272;
constexpr size_t GLA_PREP_OFF = (size_t)BATCH * 4 * 2 * NCH * GP_ITEM;

__device__ __forceinline__ void gla_prep_item(const P& p, LASP unsigned char* wl, const LASP float* cstab, int l, int it, int lane) {
    const int r = lane & 31, hh = lane >> 5;
    const int c = it % NCH, bh = it / NCH, h = bh & 3, b = bh >> 2;
    const size_t row0 = (size_t)b * TOK + (size_t)c * GCH;
    float qv[16], kv[16];
    {
        const bf16* qb = p.rest + (row0 + 4 * hh) * NREST + RC_CQ + h * 32 + r;
#pragma unroll
        for (int i = 0; i < 16; ++i) { const int no = (i & 3) + 8 * (i >> 2); qv[i] = bf2f(qb[(size_t)no * NREST]); kv[i] = bf2f(qb[(size_t)no * NREST + 128]); }
    }
    if (c >= 8) {
        const int dd = r & 15, f = dd & 7;
        const int prow = (c - 8) >> 1, pcol0 = 32 * ((c - 8) & 1);
#pragma unroll
        for (int i = 0; i < 16; ++i) {
            const int n = crow(i, hh);
            const int pos = r < 16 ? prow : pcol0 + n;
            const float cs = cstab[(pos * 8 + f) * 2], sn = cstab[(pos * 8 + f) * 2 + 1];
            const float qp = __shfl_xor(qv[i], 8), kp = __shfl_xor(kv[i], 8);
            if (dd < 8) { qv[i] = qv[i] * cs - qp * sn; kv[i] = kv[i] * cs - kp * sn; }
            else { qv[i] = qp * sn + qv[i] * cs; kv[i] = kp * sn + kv[i] * cs; }
        }
    }
#pragma unroll
    for (int i = 0; i < 16; ++i) qv[i] *= 0.17677669529663687f;
#pragma unroll 1
    for (int dir = 0; dir < 2; ++dir) {
        f32x16_t X;
#pragma unroll
        for (int i = 0; i < 16; ++i) X[i] = 0.f;
        {
            const bf16x8_t A = *(const bf16x8_t*)(p.rest + (row0 + r) * NREST + RC_CR + dir * 16 + 8 * hh);
            const float* w2p = p.gla_w2 + ((size_t)(l * 2 + dir) * 16 + 8 * hh) * 128 + h * 32 + r;
            const bf16x8_t Bf = __builtin_bit_cast(bf16x8_t, (u32x4_t){cvtpk(w2p[0], w2p[128]), cvtpk(w2p[256], w2p[384]), cvtpk(w2p[512], w2p[640]), cvtpk(w2p[768], w2p[896])});
            X = MFMA32(A, Bf, X);
        }
        const float b2v = p.gla_b2[(l * 2 + dir) * 128 + h * 32 + r];
        float Bc[16];
#pragma unroll
        for (int i = 0; i < 16; ++i) { const float xg = X[i] + b2v; Bc[i] = (fminf(xg, 0.f) - log1pf(expf(-fabsf(xg)))) * (1.f / 16.f); }
        float tot;
        {
            float sg[4], ps[4];
#pragma unroll
            for (int g = 0; g < 4; ++g) { sg[g] = (Bc[4 * g] + Bc[4 * g + 1]) + (Bc[4 * g + 2] + Bc[4 * g + 3]); ps[g] = __shfl_xor(sg[g], 32); }
            tot = ((sg[0] + ps[0]) + (sg[1] + ps[1])) + ((sg[2] + ps[2]) + (sg[3] + ps[3]));
            if (dir == 0) {
                float base = 0.f;
#pragma unroll
                for (int g = 0; g < 4; ++g) {
                    float o = base + (hh ? ps[g] : 0.f);
#pragma unroll
                    for (int k = 0; k < 4; ++k) { o += Bc[4 * g + k]; Bc[4 * g + k] = o; }
                    base += sg[g] + ps[g];
                }
            } else {
                float base = 0.f;
#pragma unroll
                for (int g = 3; g >= 0; --g) {
                    float o = base + (hh ? 0.f : ps[g]);
#pragma unroll
                    for (int k = 3; k >= 0; --k) { o += Bc[4 * g + k]; Bc[4 * g + k] = o; }
                    base += sg[g] + ps[g];
                }
            }
        }
        unsigned char* gout = (unsigned char*)p.raw + GLA_PREP_OFF + ((size_t)(bh * 2 + dir) * NCH + c) * GL_ITEM;
        LASP bf16* ql = (LASP bf16*)wl;
        LASP bf16* kl = ql + 32 * 40;
        {
            bf16* qpo = (bf16*)gout + perm16(r);
            bf16* kdo = (bf16*)(gout + 4096) + r * 32;
#pragma unroll
            for (int g = 0; g < 4; ++g) {
                float kd[4];
#pragma unroll
                for (int k = 0; k < 4; ++k) {
                    const int i = 4 * g + k, n = crow(i, hh);
                    const float eb = expf(Bc[i]);
                    const float qs = qv[i] * eb, ks = kv[i] / eb;
                    kd[k] = kv[i] * expf(tot - Bc[i]);
                    const bf16 qsb = f2bf(qs);
                    qpo[n * 32] = qsb;
                    ql[n * 40 + r] = qsb; kl[n * 40 + r] = f2bf(ks);
                }
                *(u32x2_t*)(kdo + perm16(8 * g + 4 * hh)) = (u32x2_t){cvtpk(kd[0], kd[1]), cvtpk(kd[2], kd[3])};
            }
            if (hh == 0) ((float*)(gout + 6144))[r] = expf(tot);
        }
        asm volatile("s_waitcnt lgkmcnt(0)" ::: "memory");
        f32x16_t AT;
#pragma unroll
        for (int i = 0; i < 16; ++i) AT[i] = 0.f;
        AT = MFMA32(*(const LASP bf16x8_t*)((const LASP unsigned char*)kl + r * 80 + hh * 16), *(const LASP bf16x8_t*)((const LASP unsigned char*)ql + r * 80 + hh * 16), AT);
        AT = MFMA32(*(const LASP bf16x8_t*)((const LASP unsigned char*)kl + r * 80 + hh * 16 + 32), *(const LASP bf16x8_t*)((const LASP unsigned char*)ql + r * 80 + hh * 16 + 32), AT);
        {
            bf16* amo = (bf16*)(gout + 2048) + r * 32;
#pragma unroll
            for (int g = 0; g < 4; ++g) {
                float a[4];
#pragma unroll
                for (int k = 0; k < 4; ++k) { const int m = crow(4 * g + k, hh); const bool keep = dir == 0 ? (m <= r) : (m >= r); a[k] = keep ? AT[4 * g + k] : 0.f; }
                *(u32x2_t*)(amo + perm16(8 * g + 4 * hh)) = (u32x2_t){cvtpk(a[0], a[1]), cvtpk(a[2], a[3])};
            }
        }
        asm volatile("s_waitcnt lgkmcnt(0)" ::: "memory");
    }
}

constexpr int LS_QP = 0, LS_AM = 2560, LS_KD = 5120, LS_V = 7680, LS_GL = 13824, LS_BYTES = 13952;
struct LSlot { u32x4_t a0, a1, a2, v0, v1; f32x4_t gl; };
__device__ __forceinline__ void gla_issue(const P& p, LSlot& g, int b, int h, int dir, int step, int t2) {
    const int c = gdn_chunk(dir, step);
    const unsigned char* gp = (const unsigned char*)p.raw + GLA_PREP_OFF + ((size_t)((b * 4 + h) * 2 + dir) * NCH + c) * GL_ITEM;
    g.a0 = *(const u32x4_t*)(gp + t2 * 16); g.a1 = *(const u32x4_t*)(gp + 2048 + t2 * 16); g.a2 = *(const u32x4_t*)(gp + 4096 + t2 * 16);
    g.gl = *(const f32x4_t*)(gp + 6144 + (t2 < 8 ? t2 : 0) * 16);
    const size_t row0 = (size_t)b * TOK + (size_t)c * GCH;
    const bf16* vp = p.rest + (row0 + (t2 >> 3)) * NREST + RC_CV + h * 64 + 8 * (t2 & 7);
    g.v0 = *(const u32x4_t*)vp; g.v1 = *(const u32x4_t*)(vp + (size_t)16 * NREST);
}
__device__ __forceinline__ void gla_write(LASP unsigned char* st, const LSlot& g, int t2) {
    const int row = t2 >> 2, ch = t2 & 3;
    *(LASP u32x4_t*)(st + LS_QP + row * 80 + ch * 16) = g.a0;
    *(LASP u32x4_t*)(st + LS_AM + row * 80 + ch * 16) = g.a1;
    *(LASP u32x4_t*)(st + LS_KD + row * 80 + ch * 16) = g.a2;
    if (t2 < 8) *(LASP f32x4_t*)(st + LS_GL + t2 * 16) = g.gl;
    *(LASP u32x4_t*)(st + LS_V + (t2 >> 3) * 192 + (t2 & 7) * 16) = g.v0; *(LASP u32x4_t*)(st + LS_V + (16 + (t2 >> 3)) * 192 + (t2 & 7) * 16) = g.v1;
}
#if TPROBE == 62
#define GLA_SYNC_C() do { unsigned long long t_ = __builtin_amdgcn_s_memrealtime(); __syncthreads(); if (bh == 0 && tid == 0) p.stats[2] += (float)(__builtin_amdgcn_s_memrealtime() - t_) * 0.01f; } while (0)
#define GLA_SYNC_L() __syncthreads()
#elif TPROBE == 63
#define GLA_SYNC_L() do { unsigned long long t_ = __builtin_amdgcn_s_memrealtime(); __syncthreads(); if (bh == 0 && tid == 256) p.stats[2] += (float)(__builtin_amdgcn_s_memrealtime() - t_) * 0.01f; } while (0)
#define GLA_SYNC_C() __syncthreads()
#else
#define GLA_SYNC_C() __syncthreads()
#define GLA_SYNC_L() __syncthreads()
#endif
__device__ void gla_scan_fast(const P& p, LASP unsigned char* lds, int bh) {
    const int tid = mk_tid();
    const int lane = tid & 63, wave = __builtin_amdgcn_readfirstlane(tid >> 6);
    const int h = bh & 3, b = bh >> 2;
    constexpr int NS = NCH;
    if (wave >= 4) {
        const int dir = (wave - 4) >> 1, t2 = tid & 127;
        LASP unsigned char* base = lds + dir * 2 * LS_BYTES;
        LSlot g0, g1, g2, g3;
        gla_issue(p, g0, b, h, dir, 0, t2); gla_issue(p, g1, b, h, dir, 1, t2); gla_issue(p, g2, b, h, dir, 2, t2); gla_issue(p, g3, b, h, dir, 3, t2);
        gla_write(base, g0, t2); gla_issue(p, g0, b, h, dir, 4, t2);
        __syncthreads();
#pragma unroll 1
        for (int s = 0; s < NS; s += 4) {
            gla_write(base + ((s + 1) & 1) * LS_BYTES, g1, t2); gla_issue(p, g1, b, h, dir, min(s + 5, NS - 1), t2);
            GLA_SYNC_L();
            gla_write(base + ((s + 2) & 1) * LS_BYTES, g2, t2); gla_issue(p, g2, b, h, dir, min(s + 6, NS - 1), t2);
            GLA_SYNC_L();
            gla_write(base + ((s + 3) & 1) * LS_BYTES, g3, t2); gla_issue(p, g3, b, h, dir, min(s + 7, NS - 1), t2);
            GLA_SYNC_L();
            gla_write(base + ((s + 4) & 1) * LS_BYTES, g0, t2); gla_issue(p, g0, b, h, dir, min(s + 8, NS - 1), t2);
            GLA_SYNC_L();
        }
    } else {
        const int r = lane & 31, hh = lane >> 5, dir = wave >> 1, blk = wave & 1;
        LASP unsigned char* base = lds + dir * 2 * LS_BYTES;
        f32x16_t S;
#pragma unroll
        for (int i = 0; i < 16; ++i) S[i] = 0.f;
        __syncthreads();
        const int troff = (4 * hh + ((lane & 15) >> 2)) * 192 + (16 * ((lane >> 4) & 1) + 4 * (lane & 3)) * 2 + 64 * blk;
#define TRFRAG192(bs) __builtin_shufflevector(trd(bs), trd((bs) + 8 * 192), 0, 1, 2, 3, 4, 5, 6, 7)
#pragma unroll 1
        for (int s = 0; s < NS; ++s) {
            const LASP unsigned char* st = base + (s & 1) * LS_BYTES;
            const LASP unsigned char* qp = st + LS_QP + r * 80 + hh * 16;
            const LASP unsigned char* am = st + LS_AM + r * 80 + hh * 16;
            const LASP unsigned char* kd = st + LS_KD + r * 80 + hh * 16;
            const bf16x8_t QP0 = *(const LASP bf16x8_t*)(qp), QP1 = *(const LASP bf16x8_t*)(qp + 32);
            const bf16x8_t AM0 = *(const LASP bf16x8_t*)(am), AM1 = *(const LASP bf16x8_t*)(am + 32);
            const bf16x8_t KD0 = *(const LASP bf16x8_t*)(kd), KD1 = *(const LASP bf16x8_t*)(kd + 32);
            const LASP unsigned char* vb = st + LS_V + troff;
            const bf16x8_t V0 = TRFRAG192(vb), V1 = TRFRAG192(vb + 16 * 192);
            const LASP float* glp = (const LASP float*)(st + LS_GL);
            const f32x4_t g0 = *(const LASP f32x4_t*)(glp + 4 * hh), g1 = *(const LASP f32x4_t*)(glp + 8 + 4 * hh), g2 = *(const LASP f32x4_t*)(glp + 16 + 4 * hh), g3 = *(const LASP f32x4_t*)(glp + 24 + 4 * hh);
            __builtin_amdgcn_sched_barrier(0);
            const bf16x8_t Sb0 = PACK8(S, 0), Sb1 = PACK8(S, 1);
            f32x16_t oT;
#pragma unroll
            for (int i = 0; i < 16; ++i) oT[i] = 0.f;
            oT = MFMA32(V0, AM0, oT); oT = MFMA32(V1, AM1, oT);
            oT = MFMA32(Sb0, QP0, oT); oT = MFMA32(Sb1, QP1, oT);
            S[0] *= g0.x; S[1] *= g0.y; S[2] *= g0.z; S[3] *= g0.w; S[4] *= g1.x; S[5] *= g1.y; S[6] *= g1.z; S[7] *= g1.w;
            S[8] *= g2.x; S[9] *= g2.y; S[10] *= g2.z; S[11] *= g2.w; S[12] *= g3.x; S[13] *= g3.y; S[14] *= g3.z; S[15] *= g3.w;
            S = MFMA32(KD0, V0, S);
            S = MFMA32(KD1, V1, S);
            {
                const int c = gdn_chunk(dir, s);
                bf16* op = p.oc + ((size_t)dir * ROWS + (size_t)b * TOK + (size_t)c * GCH + r) * 256 + h * 64 + 32 * blk + 4 * hh;
#pragma unroll
                for (int g = 0; g < 4; ++g) *(u32x2_t*)(op + 8 * g) = (u32x2_t){cvtpk(oT[4 * g], oT[4 * g + 1]), cvtpk(oT[4 * g + 2], oT[4 * g + 3])};
            }
            GLA_SYNC_C();
        }
    }
}


__device__ __forceinline__ void vt_item(const P& p, int it, int lane) {
    const int r = lane & 31, hh = lane >> 5;
    const int tb = it % NCH, bh = it / NCH, h = bh & 3, b = bh >> 2;
    const bf16* vp = p.rest + ((size_t)b * TOK + 32 * tb + r) * NREST + RC_BV + h * 64 + 32 * hh;
    bf16* op = p.vtb + ((size_t)bh * 64 + 32 * hh) * TOK + 32 * tb + perm16(r);
#pragma unroll
    for (int q = 0; q < 4; ++q) {
        const u32x4_t w = *(const u32x4_t*)(vp + 8 * q);
        op[(size_t)(8 * q + 0) * TOK] = (bf16)(w.x & 0xffffu); op[(size_t)(8 * q + 1) * TOK] = (bf16)(w.x >> 16);
        op[(size_t)(8 * q + 2) * TOK] = (bf16)(w.y & 0xffffu); op[(size_t)(8 * q + 3) * TOK] = (bf16)(w.y >> 16);
        op[(size_t)(8 * q + 4) * TOK] = (bf16)(w.z & 0xffffu); op[(size_t)(8 * q + 5) * TOK] = (bf16)(w.z >> 16);
        op[(size_t)(8 * q + 6) * TOK] = (bf16)(w.w & 0xffffu); op[(size_t)(8 * q + 7) * TOK] = (bf16)(w.w >> 16);
    }
}

__device__ __forceinline__ void na_item(const P& p, const LASP float* rpbL, int it, int lane) {
    const int r = lane & 31, hh = lane >> 5;
    int b, h, ry, qb; bool lat;
    if (it < 4096) { lat = true; qb = it & 1; ry = (it >> 1) & 63; h = (it >> 7) & 3; b = it >> 9; }
    else { const int j = it - 4096; lat = false; qb = j & 7; h = (j >> 3) & 3; b = j >> 5; ry = 0; }
    const size_t brow = (size_t)b * TOK;
    const int q0 = lat ? CTX + ry * 64 + qb * 32 : qb * 32;
    bf16* qp = p.rest + (brow + q0 + r) * NREST + RC_BQ + h * 64;
    bf16x8_t Qf0 = *(const bf16x8_t*)(qp + 8 * hh), Qf1 = *(const bf16x8_t*)(qp + 16 + 8 * hh), Qf2 = *(const bf16x8_t*)(qp + 32 + 8 * hh), Qf3 = *(const bf16x8_t*)(qp + 48 + 8 * hh);
    f32x16_t O0, O1;
#pragma unroll
    for (int i = 0; i < 16; ++i) { O0[i] = 0.f; O1[i] = 0.f; }
    float m = -1e30f, lsum = 0.f;
    const bf16* vtb = p.vtb + ((size_t)(b * 4 + h) * 64 + r) * TOK + 8 * hh;
    const int nkb = lat ? 24 : 8;
    const int c = qb * 32 + r, c0 = min(max(c - 8, 0), 48), r0 = min(max(ry - 4, 0), 56);
    constexpr float SC = 0.125f * 1.4426950408889634f;
    const bf16* kbase = p.rest + (brow + r) * NREST + RC_BK + h * 64 + 8 * hh;
    bf16x8_t nK0, nK1, nK2, nK3, nV00, nV01, nV10, nV11;
    {
        const bf16* kp = kbase;
        nK0 = *(const bf16x8_t*)(kp); nK1 = *(const bf16x8_t*)(kp + 16); nK2 = *(const bf16x8_t*)(kp + 32); nK3 = *(const bf16x8_t*)(kp + 48);
        nV00 = *(const bf16x8_t*)(vtb); nV01 = *(const bf16x8_t*)(vtb + 16); nV10 = *(const bf16x8_t*)(vtb + (size_t)32 * TOK); nV11 = *(const bf16x8_t*)(vtb + (size_t)32 * TOK + 16);
    }
#pragma unroll 1
    for (int kb = 0; kb < nkb; ++kb) {
        int ky = 0, cb = 0; const bool win = kb >= 8;
        if (win) { const int w = kb - 8; ky = r0 + (w >> 1); cb = w & 1; }
        const bf16x8_t K0 = nK0, K1 = nK1, K2 = nK2, K3 = nK3, V00 = nV00, V01 = nV01, V10 = nV10, V11 = nV11;
        {
            const int kn = min(kb + 1, nkb - 1);
            const int wn = kn - 8;
            const int t0n = kn < 8 ? kn * 32 : CTX + (r0 + (wn >> 1)) * 64 + (wn & 1) * 32;
            const bf16* kp = kbase + (size_t)t0n * NREST;
            nK0 = *(const bf16x8_t*)(kp); nK1 = *(const bf16x8_t*)(kp + 16); nK2 = *(const bf16x8_t*)(kp + 32); nK3 = *(const bf16x8_t*)(kp + 48);
            const bf16* vp = vtb + t0n;
            nV00 = *(const bf16x8_t*)(vp); nV01 = *(const bf16x8_t*)(vp + 16); nV10 = *(const bf16x8_t*)(vp + (size_t)32 * TOK); nV11 = *(const bf16x8_t*)(vp + (size_t)32 * TOK + 16);
        }
        f32x16_t S;
#pragma unroll
        for (int i = 0; i < 16; ++i) S[i] = 0.f;
        S = MFMA32(K0, Qf0, S); S = MFMA32(K1, Qf1, S); S = MFMA32(K2, Qf2, S); S = MFMA32(K3, Qf3, S);
        float bm = -1e30f;
        if (win) {
            const LASP float* rb = rpbL + (h * 15 + (ky - ry + 7)) * 31 + 15 - c;
#pragma unroll
            for (int i = 0; i < 16; ++i) {
                const int kc = cb * 32 + crow(i, hh);
                const bool valid = (kc >= c0) && (kc < c0 + 16);
                const float bias = rb[valid ? kc : c];
                S[i] = valid ? S[i] * SC + bias : -1e30f;
                bm = fmaxf(bm, S[i]);
            }
        } else {
#pragma unroll
            for (int i = 0; i < 16; ++i) { S[i] *= SC; bm = fmaxf(bm, S[i]); }
        }
        bm = fmaxf(bm, __shfl_xor(bm, 32));
        const float mn = fmaxf(m, bm);
        const float alpha = __builtin_amdgcn_exp2f(m - mn);
        m = mn;
        float ps = 0.f;
#pragma unroll
        for (int i = 0; i < 16; ++i) { S[i] = __builtin_amdgcn_exp2f(S[i] - mn); ps += S[i]; }
        lsum = lsum * alpha + ps;
#pragma unroll
        for (int i = 0; i < 16; ++i) { O0[i] *= alpha; O1[i] *= alpha; }
        const bf16x8_t Pb0 = PACK8(S, 0), Pb1 = PACK8(S, 1);
        O0 = MFMA32(V00, Pb0, O0); O0 = MFMA32(V01, Pb1, O0);
        O1 = MFMA32(V10, Pb0, O1); O1 = MFMA32(V11, Pb1, O1);
    }
    const float inv = 1.f / (lsum + __shfl_xor(lsum, 32));
    bf16* op = qp + 4 * hh;
#pragma unroll
    for (int g = 0; g < 4; ++g) {
        *(u32x2_t*)(op + 8 * g) = (u32x2_t){cvtpk(O0[4 * g] * inv, O0[4 * g + 1] * inv), cvtpk(O0[4 * g + 2] * inv, O0[4 * g + 3] * inv)};
        *(u32x2_t*)(op + 32 + 8 * g) = (u32x2_t){cvtpk(O1[4 * g] * inv, O1[4 * g + 1] * inv), cvtpk(O1[4 * g + 2] * inv, O1[4 * g + 3] * inv)};
    }
}

__device__ void ph_prep(const P& p, LASP unsigned char* lds, int l, int bid, int nblk) {
    const int tid = mk_tid();
    LASP float* cstab = (LASP float*)(lds + 131072);
    {
        const int pos = tid >> 3, f = tid & 7;
        const float ang = (float)pos * powf(10000.f, -(float)f / 8.f);
        cstab[tid * 2] = cosf(ang); cstab[tid * 2 + 1] = sinf(ang);
    }
    __syncthreads();
    ph_gdnprep(p, lds, l, bid, nblk, tid);
    const int lane = tid & 63, wave = tid >> 6;
    for (int it = (nblk - 1 - bid) * NWAVES + wave; it < BATCH * 4 * NCH; it += nblk * NWAVES) gla_prep_item(p, lds + wave * 16384, cstab, l, it, lane);
    for (int it = bid * NWAVES + wave; it < BATCH * 4 * NCH; it += nblk * NWAVES) vt_item(p, it, lane);
}


__device__ void ph_mix(const P& p, LASP unsigned char* lds, int l, int bid, int nblk) {
    constexpr int NGDN = BATCH * 4 * 2;
    constexpr int NGLA = BATCH * 4;
    if (bid < NGDN) { gdn_scan_fast(p, lds, bid); return; }
    if (bid < NGDN + NGLA) { gla_scan_fast(p, lds, bid - NGDN); return; }
    const int tid = mk_tid();
    const int lane = tid & 63, wave = tid >> 6;
    LASP float* rpbL = (LASP float*)lds;
    for (int i = tid; i < 4 * 15 * 31; i += NTHREADS) rpbL[i] = p.rpb[(size_t)l * 4 * 15 * 31 + i] * 1.4426950408889634f;
    __syncthreads();
    const int total = 4096 + (l == 0 ? 256 : 0);
    for (int it = (bid - NGDN - NGLA) * NWAVES + wave; it < total; it += (nblk - NGDN - NGLA) * NWAVES) na_item(p, rpbL, it, lane);
}

__device__ void ph_gate(const P& p, int l, int bid, int nblk) {
    const int tid = mk_tid();
    const int tq = tid & 127, rsub = tid >> 7;
    for (int r = bid * 4 + rsub; r < ROWS; r += nblk * 4) {
        const bf16* pr = p.rest + (size_t)r * NREST;
        float o[8], z[8], res[8]; int oc;
        if (tq < 64) {
            const int cb = tq * 8;
            float a[8], bb[8];
            unpack8(*(const uint4*)(p.oa + (size_t)r * 512 + cb), a);
            unpack8(*(const uint4*)(p.oa + ((size_t)ROWS + r) * 512 + cb), bb);
            float ss = 0.f;
#pragma unroll
            for (int e = 0; e < 8; ++e) { o[e] = a[e] + bb[e]; ss += o[e] * o[e]; }
#pragma unroll
            for (int m = 8; m > 0; m >>= 1) ss += __shfl_xor(ss, m);
            const float rs = __builtin_amdgcn_rsqf(ss * (1.f / 128.f) + 1e-6f);
            unpack8(*(const uint4*)(pr + RC_AZ + cb), z);
#pragma unroll
            for (int e = 0; e < 8; ++e) res[e] = o[e] * rs * p.gdn_norm[l * 128 + ((cb + e) & 127)] * silu_f(z[e]);
            oc = cb;
        } else if (tq < 96) {
            const int cb = (tq - 64) * 8;
            unpack8(*(const uint4*)(pr + RC_BQ + cb), o);
            unpack8(*(const uint4*)(pr + RC_BZ + cb), z);
#pragma unroll
            for (int e = 0; e < 8; ++e) res[e] = o[e] * silu_f(z[e]);
            oc = 512 + cb;
        } else {
            const int cb = (tq - 96) * 8;
            float a[8], bb[8];
            unpack8(*(const uint4*)(p.oc + (size_t)r * 256 + cb), a);
            unpack8(*(const uint4*)(p.oc + ((size_t)ROWS + r) * 256 + cb), bb);
            float ss = 0.f;
#pragma unroll
            for (int e = 0; e < 8; ++e) { o[e] = a[e] + bb[e]; ss += o[e] * o[e]; }
#pragma unroll
            for (int m = 4; m > 0; m >>= 1) ss += __shfl_xor(ss, m);
            const float rs = __builtin_amdgcn_rsqf(ss * (1.f / 64.f) + 1e-6f);
            unpack8(*(const uint4*)(pr + RC_CZ + cb), z);
#pragma unroll
            for (int e = 0; e < 8; ++e) res[e] = o[e] * rs * p.gla_norm[l * 64 + ((cb + e) & 63)] * silu_f(z[e]);
            oc = 768 + cb;
        }
        uint4 w; w.x = pk2(res[0], res[1]); w.y = pk2(res[2], res[3]); w.z = pk2(res[4], res[5]); w.w = pk2(res[6], res[7]);
        *(uint4*)(p.mix + (size_t)r * D + oc) = w;
    }
}


#if PROBE
__device__ void gdn_scan_naive(const P& p, LASP float* sm, int l, int b, int hp, bf16* nb) {
    const int tid = mk_tid();
    LASP float* skq = sm;
    LASP float* sv = sm + 4 * 16 * 256;
    LASP float* sg = sv + 4 * 16 * 128;
    LASP float* sb = sg + 64;
    const int sub = tid >> 7, col = tid & 127, dir = sub & 1, h = hp * 2 + (sub >> 1);
    float S[128];
#pragma unroll
    for (int i = 0; i < 128; ++i) S[i] = 0.f;
    for (int s0 = 0; s0 < TOK; s0 += 16) {
        __syncthreads();
        for (int i = tid; i < 4 * 16 * 48; i += NTHREADS) {
            const int su = i / (16 * 48), rem = i % (16 * 48), j = rem / 48, chunk = rem % 48;
            const int sd = su & 1, hh = hp * 2 + (su >> 1);
            const int t = tok_of(sd, s0 + j);
            const size_t row = (size_t)b * TOK + t;
            const int part = chunk >> 4, c8 = chunk & 15;
            const uint4 w = *(const uint4*)(p.qkvn + row * NRAW + part * 512 + hh * 128 + c8 * 8);
            float f[8]; unpack8(w, f);
            LASP float* dst = (part < 2) ? skq + (su * 16 + j) * 256 + part * 128 + c8 * 8 : sv + (su * 16 + j) * 128 + c8 * 8;
#pragma unroll
            for (int e = 0; e < 8; ++e) dst[e] = f[e];
        }
        if (tid < 64) {
            const int su = tid >> 4, j = tid & 15, sd = su & 1, hh = hp * 2 + (su >> 1);
            const int t = tok_of(sd, s0 + j);
            const bf16* ab = p.rest + ((size_t)b * TOK + t) * NREST + RC_AB;
            const float a = bf2f(ab[sd * 4 + hh]) + p.dt_bias[(l * 2 + sd) * 4 + hh];
            const float sp = fmaxf(a, 0.f) + log1pf(expf(-fabsf(a)));
            const float g = -expf(p.a_log[(l * 2 + sd) * 4 + hh]) * sp;
            sg[su * 16 + j] = expf(g);
            const float bx = bf2f(ab[(2 + sd) * 4 + hh]);
            sb[su * 16 + j] = 1.f / (1.f + expf(-bx));
        }
        __syncthreads();
#pragma unroll 1
        for (int j = 0; j < 16; ++j) {
            const LASP float* qp = skq + (sub * 16 + j) * 256;
            const LASP float* kp = qp + 128;
            const float dec = sg[sub * 16 + j], bt = sb[sub * 16 + j];
            const float v = sv[(sub * 16 + j) * 128 + col];
            float d0 = 0.f, d1 = 0.f, d2 = 0.f, d3 = 0.f;
#pragma unroll
            for (int k4 = 0; k4 < 32; ++k4) {
                const f32x4_t kv = *(const LASP f32x4_t*)(kp + k4 * 4);
                d0 += S[k4 * 4] * kv.x; d1 += S[k4 * 4 + 1] * kv.y; d2 += S[k4 * 4 + 2] * kv.z; d3 += S[k4 * 4 + 3] * kv.w;
                if ((k4 & 7) == 7) __builtin_amdgcn_sched_barrier(0);
            }
            const float dot = (d0 + d1) + (d2 + d3);
            const float vn = bt * (v - dec * dot);
            float o0 = 0.f, o1 = 0.f, o2 = 0.f, o3 = 0.f;
#pragma unroll
            for (int k4 = 0; k4 < 32; ++k4) {
                const f32x4_t kv = *(const LASP f32x4_t*)(kp + k4 * 4);
                const f32x4_t qv = *(const LASP f32x4_t*)(qp + k4 * 4);
                S[k4 * 4] = dec * S[k4 * 4] + kv.x * vn; o0 += S[k4 * 4] * qv.x;
                S[k4 * 4 + 1] = dec * S[k4 * 4 + 1] + kv.y * vn; o1 += S[k4 * 4 + 1] * qv.y;
                S[k4 * 4 + 2] = dec * S[k4 * 4 + 2] + kv.z * vn; o2 += S[k4 * 4 + 2] * qv.z;
                S[k4 * 4 + 3] = dec * S[k4 * 4 + 3] + kv.w * vn; o3 += S[k4 * 4 + 3] * qv.w;
                if ((k4 & 3) == 3) __builtin_amdgcn_sched_barrier(0);
            }
            const int t = tok_of(dir, s0 + j);
            nb[((size_t)dir * TOK + t) * 256 + (h & 1) * 128 + col] = f2bf((o0 + o1) + (o2 + o3));
        }
    }
    __syncthreads();
}

__device__ void gla_scan_naive(const P& p, LASP float* sm, int l, int b, bf16* nb) {
    const int tid = mk_tid();
    LASP float* sq = sm;
    LASP float* sv = sm + 8 * 16 * 96;
    const int grp = tid >> 6, lane = tid & 63, h = grp >> 1, dir = grp & 1;
    const int d = lane & 31, par = lane >> 5;
    float w2c[16];
#pragma unroll
    for (int j = 0; j < 16; ++j) w2c[j] = p.gla_w2[((size_t)(l * 2 + dir) * 16 + j) * 128 + h * 32 + d];
    const float b2v = p.gla_b2[(l * 2 + dir) * 128 + h * 32 + d];
    const int dd = d & 15, f = dd & 7;
    const float inv = powf(10000.f, -(float)f / 8.f);
    const int pd = dd < 8 ? d + 8 : d - 8;
    float S[32];
#pragma unroll
    for (int i = 0; i < 32; ++i) S[i] = 0.f;
    for (int s0 = 0; s0 < TOK; s0 += 16) {
        __syncthreads();
#pragma unroll 1
        for (int jj = 0; jj < 8; ++jj) {
            const int j = par + 2 * jj;
            const int t = tok_of(dir, s0 + j);
            const bf16* base = p.rest + ((size_t)b * TOK + t) * NREST;
            float qv = bf2f(base[RC_CQ + h * 32 + d]), kv = bf2f(base[RC_CK + h * 32 + d]);
            if (t >= CTX) {
                const int pidx = t - CTX;
                const int pos = d < 16 ? (pidx >> 6) : (pidx & 63);
                const float ang = (float)pos * inv;
                const float cs = cosf(ang), sn = sinf(ang);
                const float qp = bf2f(base[RC_CQ + h * 32 + pd]), kp = bf2f(base[RC_CK + h * 32 + pd]);
                if (dd < 8) { qv = qv * cs - qp * sn; kv = kv * cs - kp * sn; }
                else { qv = qp * sn + qv * cs; kv = kp * sn + kv * cs; }
            }
            qv *= 0.17677669529663687f;
            float xg = b2v;
#pragma unroll
            for (int jr = 0; jr < 16; ++jr) xg += bf2f(base[RC_CR + dir * 16 + jr]) * w2c[jr];
            const float ls = fminf(xg, 0.f) - log1pf(expf(-fabsf(xg)));
            LASP float* dst = sq + (grp * 16 + j) * 96;
            dst[d] = qv; dst[32 + d] = kv; dst[64 + d] = expf(ls * (1.f / 16.f));
        }
        for (int i = lane; i < 16 * 64; i += 64) {
            const int j = i >> 6, c = i & 63;
            const int t = tok_of(dir, s0 + j);
            sv[(grp * 16 + j) * 64 + c] = bf2f(p.rest[((size_t)b * TOK + t) * NREST + RC_CV + h * 64 + c]);
        }
        __syncthreads();
#pragma unroll 1
        for (int j = 0; j < 16; ++j) {
            const LASP float* qp = sq + (grp * 16 + j) * 96;
            const LASP float* kp = qp + 32;
            const LASP float* dp = qp + 64;
            const float v = sv[(grp * 16 + j) * 64 + lane];
            float o0 = 0.f, o1 = 0.f;
#pragma unroll
            for (int e = 0; e < 32; e += 2) {
                S[e] = dp[e] * S[e] + kp[e] * v; o0 += S[e] * qp[e];
                S[e + 1] = dp[e + 1] * S[e + 1] + kp[e + 1] * v; o1 += S[e + 1] * qp[e + 1];
            }
            const int t = tok_of(dir, s0 + j);
            nb[((size_t)dir * TOK + t) * 256 + h * 64 + lane] = f2bf(o0 + o1);
        }
    }
    __syncthreads();
}

__device__ void na_query_naive(const P& p, LASP float* sm, int l, int b, int t0, bf16* nb) {
    const int tid = mk_tid();
    const int wave = tid >> 6, lane = tid & 63, h = wave & 3, t = t0 + (wave >> 2);
    LASP float* pw = sm + wave * 384;
    const size_t rowq = (size_t)b * TOK + t;
    float qv[64];
    {
        const bf16* qs = p.rest + rowq * NREST + RC_BQ + h * 64;
#pragma unroll
        for (int i = 0; i < 8; ++i) {
            float f[8]; unpack8(*(const uint4*)(qs + i * 8), f);
#pragma unroll
            for (int e = 0; e < 8; ++e) qv[i * 8 + e] = f[e] * 0.125f;
        }
    }
    const bool lat = t >= CTX;
    const int nk = lat ? 384 : 256;
    int r = 0, c = 0, r0 = 0, c0 = 0;
    if (lat) { int pi = t - CTX; r = pi >> 6; c = pi & 63; r0 = min(max(r - 4, 0), 56); c0 = min(max(c - 8, 0), 48); }
    float m = -1e30f;
    __syncthreads();
#pragma unroll 1
    for (int j = 0; j < 6; ++j) {
        const int idx = lane + 64 * j;
        float s = -1e30f;
        if (idx < nk) {
            int tk; float bias = 0.f;
            if (lat && idx < 128) {
                const int i = idx >> 4, kc = c0 + (idx & 15);
                tk = CTX + (r0 + i) * 64 + kc;
                bias = p.rpb[((size_t)(l * 4 + h) * 15 + (r0 + i - r + 7)) * 31 + (kc - c + 15)];
            } else tk = lat ? idx - 128 : idx;
            const bf16* ks = p.rest + ((size_t)b * TOK + tk) * NREST + RC_BK + h * 64;
            float d0 = 0.f, d1 = 0.f;
#pragma unroll
            for (int i = 0; i < 8; ++i) {
                float f[8]; unpack8(*(const uint4*)(ks + i * 8), f);
#pragma unroll
                for (int e = 0; e < 8; e += 2) { d0 += qv[i * 8 + e] * f[e]; d1 += qv[i * 8 + e + 1] * f[e + 1]; }
            }
            s = d0 + d1 + bias;
        }
        pw[idx] = s;
        m = fmaxf(m, s);
    }
    m = wave_max(m);
    float sum = 0.f;
#pragma unroll 1
    for (int j = 0; j < 6; ++j) { const float e = expf(pw[lane + 64 * j] - m); pw[lane + 64 * j] = e; sum += e; }
    sum = wave_sum(sum);
    const float inv = 1.f / sum;
    __syncthreads();
    float o0 = 0.f, o1 = 0.f;
    for (int idx = 0; idx < nk; idx += 2) {
        int tk0;
        if (lat && idx < 128) tk0 = CTX + (r0 + (idx >> 4)) * 64 + c0 + (idx & 15);
        else tk0 = lat ? idx - 128 : idx;
        o0 += pw[idx] * bf2f(p.rest[((size_t)b * TOK + tk0) * NREST + RC_BV + h * 64 + lane]);
        o1 += pw[idx + 1] * bf2f(p.rest[((size_t)b * TOK + tk0 + 1) * NREST + RC_BV + h * 64 + lane]);
    }
    nb[(size_t)t * 256 + h * 64 + lane] = f2bf((o0 + o1) * inv);
}


__device__ void ph_probe_naive(const P& p, LASP float* sm, int l, int bid, int nblk) {
    bf16* nb = (bf16*)p.xc1;
    if (PROBE == 1) { if (bid == 0) gdn_scan_naive(p, sm, l, 0, 0, nb); }
    else if (PROBE == 3) { if (bid == 0) gla_scan_naive(p, sm, l, 0, nb); }
    else { for (int it = bid; it < TOK / 2; it += nblk) na_query_naive(p, sm, l, 0, it * 2, nb); }
}
__device__ void ph_probe_cmp(const P& p, int bid, int nblk) {
    const int tid = mk_tid();
    const bf16* nb = (const bf16*)p.xc1;
    float md = 0.f, mr = 0.f;
    const int n = (PROBE == 2) ? TOK * 256 : 2 * TOK * 256;
    for (int i = bid * NTHREADS + tid; i < n; i += nblk * NTHREADS) {
        float a, r = bf2f(nb[i]);
        if (PROBE == 1) { const int dir = i / (TOK * 256), rem = i % (TOK * 256), t = rem >> 8, c = rem & 255; a = bf2f(p.oa[((size_t)dir * ROWS + t) * 512 + c]); }
        else if (PROBE == 3) { const int dir = i / (TOK * 256), rem = i % (TOK * 256); a = bf2f(p.oc[(size_t)dir * ROWS * 256 + rem]); }
        else { const int t = i >> 8, c = i & 255; a = bf2f(p.rest[(size_t)t * NREST + RC_BQ + c]); }
        md = fmaxf(md, fabsf(a - r)); mr = fmaxf(mr, fabsf(r));
    }
    md = wave_max(md); mr = wave_max(mr);
    if ((tid & 63) == 0) { atomicMax((unsigned*)p.stats, __float_as_uint(md)); atomicMax((unsigned*)p.stats + 1, __float_as_uint(mr)); }
}
#endif

#define XB_TMO      128
#define XB_XCNT(j)  (256  + 64 * (j))
#define XB_XSUB(j)  (1280 + 64 * (j))
#define XB_XGEN(j)  (2304 + 64 * (j))
#define XB_TOP      3328
#define XB_TOPGEN   3392
#define XCD_BAR_WORDS 3456
#define XB_SPIN_CAP (1u << 18)

__device__ __forceinline__ unsigned xb_ld(unsigned* p)              { return __hip_atomic_load(p, __ATOMIC_RELAXED, __HIP_MEMORY_SCOPE_AGENT); }
__device__ __forceinline__ unsigned xb_add(unsigned* p, unsigned v) { return __hip_atomic_fetch_add(p, v, __ATOMIC_RELAXED, __HIP_MEMORY_SCOPE_AGENT); }
__device__ __forceinline__ unsigned xb_xcc_id() { return (unsigned)__builtin_amdgcn_s_getreg((3 << 11) | 20) & 0xFu; }
#define XB_SPIN(cond, bar) do { unsigned _sp = 0; while (cond) { __builtin_amdgcn_s_sleep(1); \
    if ((++_sp & 255u) == 0u) { if (xb_ld(&(bar)[XB_TMO])) break; if (_sp > XB_SPIN_CAP) { atomicAdd(&(bar)[XB_TMO], 1u); break; } } } } while (0)

struct XcdBarrier {
    unsigned* bar; unsigned x;
    volatile LASP unsigned* st;
};

__device__ __forceinline__ XcdBarrier xcd_barrier_post(unsigned* bar, volatile LASP unsigned* st) {
    XcdBarrier b; b.bar = bar; b.x = xb_xcc_id(); b.st = st;
    if ((int)threadIdx.x == 0) (void)xb_add(&bar[XB_XCNT(b.x)], 1u);
    return b;
}
__device__ __forceinline__ void xcd_barrier_complete(unsigned* bar, unsigned x, unsigned& nloc, unsigned& nx) {
    const unsigned G = gridDim.x * gridDim.y * gridDim.z;
    unsigned sum, cnt, mine, sp = 0u;
    for (;;) {
        sum = 0u; cnt = 0u; mine = 0u;
#pragma unroll
        for (unsigned j = 0; j < 16; ++j) { const unsigned c = xb_ld(&bar[XB_XCNT(j)]); sum += c; cnt += (c > 0u) ? 1u : 0u; mine = (j == x) ? c : mine; }
        if (sum == G) break;
        __builtin_amdgcn_s_sleep(1);
        if ((++sp & 255u) == 0u) { if (xb_ld(&bar[XB_TMO])) break; if (sp > XB_SPIN_CAP) { atomicAdd(&bar[XB_TMO], 1u); break; } }
    }
    nloc = mine > 0u ? mine : 1u; nx = cnt > 0u ? cnt : 1u;
}

__device__ __forceinline__ void xcd_barrier(const XcdBarrier& b) {
    asm volatile("s_waitcnt vmcnt(0)" ::: "memory");
    __syncthreads();
    if ((int)threadIdx.x == 0) {
        unsigned* bar = b.bar;
        __builtin_amdgcn_s_waitcnt(0);
        unsigned nloc = b.st[0], nx = b.st[1];
        if (nloc == 0u) { xcd_barrier_complete(bar, b.x, nloc, nx); b.st[0] = nloc; b.st[1] = nx; }
        const unsigned old = xb_add(&bar[XB_XSUB(b.x)], 1u);
        const unsigned gen = old / nloc;
        if (old + 1u == (gen + 1u) * nloc) {
            __builtin_amdgcn_fence(__ATOMIC_RELEASE, "agent");
            asm volatile("s_waitcnt vmcnt(0)" ::: "memory");
            const unsigned og = xb_add(&bar[XB_TOP], 1u);
            const unsigned tg = og / nx;
            if (og + 1u == (tg + 1u) * nx) xb_add(&bar[XB_TOPGEN], 1u);
            else XB_SPIN(xb_ld(&bar[XB_TOPGEN]) == tg, bar);
            __builtin_amdgcn_fence(__ATOMIC_ACQUIRE, "agent");
            xb_add(&bar[XB_XGEN(b.x)], 1u);
            asm volatile("s_waitcnt vmcnt(0)" ::: "memory");
        } else {
            XB_SPIN(xb_ld(&bar[XB_XGEN(b.x)]) == gen, bar);
            __builtin_amdgcn_fence(__ATOMIC_ACQUIRE, "agent");
            asm volatile("s_waitcnt vmcnt(0)" ::: "memory");
        }
    }
    __syncthreads();
}


constexpr int NSTEP = 1 + 2 * 7 + 1;
__global__ void __launch_bounds__(NTHREADS, 2) k_mega(P p) {
    extern __shared__ __attribute__((aligned(16))) unsigned char lds_raw[];
    LASP unsigned char* lds = (LASP unsigned char*)lds_raw;
    cg::grid_group grid = cg::this_grid();
    const int bid = blockIdx.x, nblk = gridDim.x;
    volatile LASP unsigned* bst = (volatile LASP unsigned*)(lds + LDS_BYTES - 64);
    if (threadIdx.x < 16) bst[threadIdx.x] = 0u;
    __syncthreads();
    const XcdBarrier bar = xcd_barrier_post((unsigned*)p.ctl, bst);
#pragma unroll 1
    for (int step = 0; step < NSTEP; ++step) {
        int ph = 0, l = 0;
        if (step > 0) { const int s1 = step - 1; l = s1 / 7; ph = 1 + s1 % 7; }
#if TPROBE >= 0
        unsigned long long tp0 = 0;
        if (bid == 0 && threadIdx.x == 0) { if (step == 0) p.stats[2] = 0.f; tp0 = __builtin_amdgcn_s_memrealtime(); }
#endif
        if (ph == 0) ph_prologue(p, lds, bid, nblk);
        else if (ph == 1) ph_lnpass(p, l, bid, nblk);
        else if (l < 2) {
            if (ph == 2) {
                pg8::Gemm g{p.ml, p.wi_t + (size_t)l * NPAD * D, ROWS, NPAD, D}; pg8::StaticOrder S; S.init(ROWS, NPAD, nblk, bid);
                EpiProj E{p.raw, p.rest};
                pg8::gemm_phase<EpiProj, pg8::StaticOrder, true, true>(lds, g, S, E);
            } else if (ph == 3) ph_conv(p, l, bid, nblk);
            else if (ph == 4) ph_prep(p, lds, l, bid, nblk);
            else if (ph == 5) {
#if PROBE
                if (l == 0) { ph_probe_naive(p, (LASP float*)lds, l, bid, nblk); xcd_barrier(bar); }
#endif
#if TPROBE >= 50
                unsigned long long tr0 = 0;
                { const int rb = TPROBE == 50 ? 0 : (TPROBE == 51 ? 64 : (TPROBE == 52 ? 96 : 255)); if (bid == rb && threadIdx.x == 0) tr0 = __builtin_amdgcn_s_memrealtime(); }
#endif
                ph_mix(p, lds, l, bid, nblk);
#if TPROBE >= 50
                { const int rb = TPROBE == 50 ? 0 : (TPROBE == 51 ? 64 : (TPROBE == 52 ? 96 : 255)); if (bid == rb && threadIdx.x == 0) { __threadfence(); atomicAdd(&p.stats[2], (float)(__builtin_amdgcn_s_memrealtime() - tr0) * 0.01f); } }
#endif
#if PROBE
                if (l == 0) { xcd_barrier(bar); ph_probe_cmp(p, bid, nblk); }
#endif
            }
            else if (ph == 6) ph_gate(p, l, bid, nblk);
            else if (ph == 7) {
                pg8::Gemm g{p.mix, p.wo_t + (size_t)l * D * D, ROWS, D, D}; pg8::StaticOrder S; S.init(ROWS, D, nblk, bid);
                EpiRes E{l == 0 ? p.x : p.out, p.ctx, p.out, p.xc1, p.mods, l};
                pg8::gemm_phase<EpiRes, pg8::StaticOrder, true, true>(lds, g, S, E);
            }
        }
        if (step == 0) grid.sync(); else xcd_barrier(bar);
#if TPROBE >= 0
        if (bid == 0 && threadIdx.x == 0 && ph == TPROBE) p.stats[2] += (float)(__builtin_amdgcn_s_memrealtime() - tp0) * 0.01f;
#endif
    }
}

extern "C" void kernel_launch(void* const* d_in, const int* in_sizes, int n_in, void* d_out, int out_size, void* d_ws, size_t ws_size,
                              hipStream_t stream) {
    P p{};
    p.x = (const float*)d_in[0]; p.c = (const float*)d_in[1]; p.ctx = (const float*)d_in[2]; p.c_ctx = (const float*)d_in[3];
    p.w_mod = (const float*)d_in[4]; p.b_mod = (const float*)d_in[5]; p.w_in = (const float*)d_in[6]; p.conv_w = (const float*)d_in[7];
    p.a_log = (const float*)d_in[8]; p.dt_bias = (const float*)d_in[9]; p.gdn_norm = (const float*)d_in[10]; p.rpb = (const float*)d_in[11];
    p.gla_w2 = (const float*)d_in[12]; p.gla_b2 = (const float*)d_in[13]; p.gla_norm = (const float*)d_in[14]; p.w_out = (const float*)d_in[15];
    p.ln_g = (const float*)d_in[16]; p.ln_b = (const float*)d_in[17];
    p.out = (float*)d_out;
    unsigned char* w = (unsigned char*)d_ws;
    size_t off = 0;
    auto take = [&](size_t bytes) { unsigned char* r = w + off; off += (bytes + 255) & ~(size_t)255; return r; };
    p.ctl = (unsigned*)take(16384);
    p.mods = (float*)take((size_t)2 * 9 * 3072 * 4);
    p.xc1 = (float*)take((size_t)BATCH * CTX * D * 4);
    p.wi_t = (bf16*)take((size_t)2 * NPAD * D * 2);
    p.wo_t = (bf16*)take((size_t)2 * D * D * 2);
    p.rest = (bf16*)take((size_t)ROWS * NREST * 2);
    p.raw = (bf16*)take((size_t)ROWS * NRAW * 2);
    p.qkvn = (bf16*)take((size_t)ROWS * NRAW * 2);
    p.mix = p.qkvn;
    p.oa = (bf16*)take((size_t)2 * ROWS * 512 * 2);
    p.oc = (bf16*)take((size_t)2 * ROWS * 256 * 2);
    p.ml = p.oa;
    p.vtb = (bf16*)take((size_t)ROWS * 256 * 2);
    p.stats = (float*)take(256);
    static int grid_blocks = 0;
    if (!grid_blocks) {
        if (off > ws_size) { fprintf(stderr, "workspace too small: need %zu have %zu\n", off, ws_size); grid_blocks = -1; return; }
        int dev = 0, cus = 0, per_cu = 0;
        hipGetDevice(&dev);
        hipDeviceGetAttribute(&cus, hipDeviceAttributeMultiprocessorCount, dev);
        if (hipFuncSetAttribute((const void*)k_mega, hipFuncAttributeMaxDynamicSharedMemorySize, LDS_BYTES) != hipSuccess) { fprintf(stderr, "hipFuncSetAttribute failed\n"); grid_blocks = -1; return; }
        hipOccupancyMaxActiveBlocksPerMultiprocessor(&per_cu, (const void*)k_mega, NTHREADS, LDS_BYTES);
        if (per_cu < 1) { fprintf(stderr, "occupancy query says %d blocks per CU\n", per_cu); grid_blocks = -1; return; }
        grid_blocks = cus;
    }
    if (grid_blocks < 0) return;
    if (hipMemsetAsync(p.ctl, 0, 16384, stream) != hipSuccess) { fprintf(stderr, "memset of the barrier words failed\n"); return; }
    void* args[] = {&p};
    hipError_t e = hipLaunchCooperativeKernel((void*)k_mega, dim3(grid_blocks), dim3(NTHREADS), args, LDS_BYTES, stream);
    if (e != hipSuccess) fprintf(stderr, "cooperative launch failed: %s (grid %d)\n", hipGetErrorString(e), grid_blocks);
}
```

```cpp
#include <hip/hip_runtime.h>
#include <hip/hip_cooperative_groups.h>
#include <cstdio>
#include <cstdint>
namespace cg = cooperative_groups;
#ifndef PROBE
#define PROBE 0
#endif
#ifndef TPROBE
#define TPROBE -1
#endif
#ifndef TSHIFT
#define TSHIFT 0
#endif

constexpr int D = 1024, BATCH = 8, SEQ = 4096, CTX = 256, TOK = 4352, NPROJ = 3888;
constexpr int ROWS = BATCH * TOK;
constexpr int NRAW = 1536, NREST = 2352, NPAD = 4096;
constexpr int NTHREADS = 512, NWAVES = 8;
constexpr int LDS_BYTES = 147456;
constexpr float ALPHA = 1.4142135623730951f;
constexpr int RC_AB = 0, RC_AZ = 16, RC_BQ = 528, RC_BK = 784, RC_BV = 1040, RC_BZ = 1296, RC_CQ = 1552, RC_CK = 1680, RC_CV = 1808, RC_CR = 2064, RC_CZ = 2096;

typedef unsigned short bf16;
typedef float f32x4_t __attribute__((ext_vector_type(4)));

struct P {
    const float *x, *c, *ctx, *c_ctx, *w_mod, *b_mod, *w_in, *conv_w, *a_log, *dt_bias, *gdn_norm, *rpb,
        *gla_w2, *gla_b2, *gla_norm, *w_out, *ln_g, *ln_b;
    float* out;
    float *mods, *xc1, *stats; unsigned* ctl;
    bf16 *wi_t, *wo_t, *rest, *raw, *qkvn, *mix, *ml, *oa, *oc, *vtb;
};

__device__ __forceinline__ float bf2f(unsigned short u) { return __uint_as_float((unsigned)u << 16); }
__device__ __forceinline__ unsigned short f2bf(float f) { unsigned u = __float_as_uint(f); return (unsigned short)((u + 0x7fffu + ((u >> 16) & 1u)) >> 16); }
__device__ __forceinline__ unsigned pk2(float lo, float hi) { return (unsigned)f2bf(lo) | ((unsigned)f2bf(hi) << 16); }
__device__ __forceinline__ float bflo(unsigned w) { return __uint_as_float(w << 16); }
__device__ __forceinline__ float bfhi(unsigned w) { return __uint_as_float(w & 0xffff0000u); }
__device__ __forceinline__ void unpack8(uint4 w, float* f) {
    f[0] = bflo(w.x); f[1] = bfhi(w.x); f[2] = bflo(w.y); f[3] = bfhi(w.y); f[4] = bflo(w.z); f[5] = bfhi(w.z); f[6] = bflo(w.w); f[7] = bfhi(w.w);
}
__device__ __forceinline__ float silu_f(float x) { return x * __builtin_amdgcn_rcpf(1.f + __builtin_amdgcn_exp2f(-1.4426950408889634f * x)); }
__device__ __forceinline__ float wave_sum(float v) {
#pragma unroll
    for (int o = 32; o > 0; o >>= 1) v += __shfl_xor(v, o);
    return v;
}
__device__ __forceinline__ float wave_max(float v) {
#pragma unroll
    for (int o = 32; o > 0; o >>= 1) v = fmaxf(v, __shfl_xor(v, o));
    return v;
}
__device__ __forceinline__ int mk_tid() { int t = threadIdx.x; asm volatile("" : "+v"(t)); return t; }
__device__ __forceinline__ int tok_of(int dir, int s) { return dir == 0 ? s : (s < CTX ? CTX - 1 - s : TOK + CTX - 1 - s); }

namespace pg8 {
#define PG8_LAS __attribute__((address_space(3)))
typedef unsigned short bf16_t;
typedef short bf16x8 __attribute__((ext_vector_type(8)));
typedef float f32x4 __attribute__((ext_vector_type(4)));
typedef unsigned u32x4 __attribute__((ext_vector_type(4)));
constexpr int BM = 256, BK = 64, HALF = 128, HTB = HALF * BK * 2  , STAGE_BYTES = 8 * HTB, NXCD = 8, WGM = 8;

__host__ __device__ __forceinline__ int lds_byte(int r, int c) { const int st = (r >> 4) * 2 + (c >> 5), rr = r & 15, cc = c & 31, ob = rr * 64 + cc * 2; return st * 1024 + (ob ^ (((ob >> 9) & 1) << 5)); }
__host__ __device__ __forceinline__ void stage_rc(int b, int& R, int& C) { const int st = b / 1024, sb = b % 1024, swz = sb ^ (((sb >> 9) & 1) << 5); R = (st >> 1) * 16 + swz / 64; C = (st & 1) * 32 + (swz % 64) / 2; }
__host__ __device__ __forceinline__ int perm32(int rho) { const int n = rho >> 4, i = rho & 15; return 8 * (i >> 2) + 4 * n + (i & 3); }

struct Unit { int pm, pn; };
struct Gemm { const bf16_t* A; const bf16_t* Bt; int M, N, K; };

struct StaticOrder {
    int nM, nN, nwg, G, c;
    __host__ __device__ void init(int M, int N, int G_, int c_) { nM = M / BM; nN = N / BM; nwg = nM * nN; G = G_; c = c_; }
    __host__ __device__ bool next(int i, Unit& u) const {
        const long L = (long)i * G + c; if (L >= nwg) return false;
        int wgid = (int)L; { const int q = nwg / NXCD, r = nwg % NXCD, xcd = wgid % NXCD, off = wgid / NXCD; wgid = (xcd < r ? xcd * (q + 1) : r * (q + 1) + (xcd - r) * q) + off; }
        const int nig = WGM * nN, gid = wgid / nig, fm = gid * WGM, gsz = (nM - fm) < WGM ? (nM - fm) : WGM;
        u.pm = fm + ((wgid % nig) % gsz); u.pn = (wgid % nig) / gsz; return true;
    }
    __device__ __forceinline__ void a_ready(const Unit&) const {}
    __device__ __forceinline__ void done(const Unit&) const {}
};

__device__ __forceinline__ unsigned cvt_pk_bf16(float lo, float hi) { unsigned r; asm volatile("v_cvt_pk_bf16_f32 %0, %1, %2" : "=v"(r) : "v"(lo), "v"(hi)); return r; }
template <class Epi, class Sched, bool ALIGN_EPI = false, bool SP2 = false>
__device__ __forceinline__ void gemm_phase(PG8_LAS unsigned char* lds, const Gemm g, const Sched& S, const Epi& E) {
    const int tid = mk_tid(), wid = __builtin_amdgcn_readfirstlane(tid >> 6), lane = tid & 63, wr = wid >> 2, wc = wid & 3, fr = lane & 15, fq = lane >> 4;
    const int K = g.K, nt = K / BK;
    unsigned voffA[2], voffB[2];
#pragma unroll
    for (int i = 0; i < 2; ++i) { int R, C; stage_rc(tid * 16 + i * 8192, R, C); const int Rb = Epi::PERM ? ((R & ~31) + perm32(R & 31)) : R;
        voffA[i] = (unsigned)(R * K + C) * 2u; voffB[i] = (unsigned)(Rb * K + C) * 2u; }
    const size_t kstep = (size_t)(BK * 2);
    const size_t hstep = (size_t)HALF * K * 2;
    const size_t tstep = 2 * hstep;
    const unsigned ldsw = (unsigned)wid * 1024u;
    const int aoff = lds_byte(wr * 64 + fr, fq * 8), boff = lds_byte(wc * 32 + fr, fq * 8);
#define PG8_SA(b, h) (((b) * 2 + (h)) * HTB)
#define PG8_SB(b, h) ((4 + (b) * 2 + (h)) * HTB)
#define PG8_STAGE(bufoff, gbase, voff) do { _Pragma("unroll") for (int _i = 0; _i < 2; ++_i) \
        __builtin_amdgcn_global_load_lds((const unsigned*)((const char*)(gbase) + (voff)[_i]), (PG8_LAS unsigned*)(lds + (bufoff) + ldsw + _i * 8192), 16, 0, 0); } while (0)
#define PG8_LDA(dst, b, h) do { _Pragma("unroll") for (int m = 0; m < 4; ++m) _Pragma("unroll") for (int k = 0; k < 2; ++k) dst[m][k] = *(const PG8_LAS bf16x8*)(lds + PG8_SA(b, h) + aoff + m * 2048 + k * 1024); } while (0)
#define PG8_LDB(dst, b, h) do { _Pragma("unroll") for (int n = 0; n < 2; ++n) _Pragma("unroll") for (int k = 0; k < 2; ++k) dst[n][k] = *(const PG8_LAS bf16x8*)(lds + PG8_SB(b, h) + boff + n * 2048 + k * 1024); } while (0)
#define PG8_MMA(ai, bj, At, Bt) do { __builtin_amdgcn_s_setprio(1); _Pragma("unroll") for (int m = 0; m < 4; ++m) _Pragma("unroll") for (int n = 0; n < 2; ++n) _Pragma("unroll") for (int k = 0; k < 2; ++k) \
        acc[ai][bj][m][n] = __builtin_amdgcn_mfma_f32_16x16x32_bf16(Bt[n][k], At[m][k], acc[ai][bj][m][n], 0, 0, 0); __builtin_amdgcn_s_setprio(0); } while (0)
#define PG8_WAIT_V(n) asm volatile("s_waitcnt vmcnt(" #n ")" ::: "memory")
#define PG8_WAIT_L(n) asm volatile("s_waitcnt lgkmcnt(" #n ")" ::: "memory")
#define PG8_BAR __builtin_amdgcn_s_barrier()
#define PG8_SCHED __builtin_amdgcn_sched_barrier(0)
    Unit cur, nxt; int ui = 0;
    if (!S.next(0, cur)) return;
    f32x4 acc[2][2][4][2];
#pragma unroll
    for (int a = 0; a < 2; ++a)
#pragma unroll
        for (int b = 0; b < 2; ++b)
#pragma unroll
            for (int m = 0; m < 4; ++m)
#pragma unroll
                for (int n = 0; n < 2; ++n) acc[a][b][m][n] = (f32x4){0.f, 0.f, 0.f, 0.f};
    bf16x8 At[4][2], B0[2][2], B1[2][2];
    const char* cA = (const char*)g.A + (size_t)cur.pm * tstep; const char* cB = (const char*)g.Bt + (size_t)cur.pn * tstep;
    S.a_ready(cur);
    if constexpr (SP2) {
        PG8_STAGE(PG8_SB(0, 0), cB, voffB); PG8_STAGE(PG8_SB(0, 1), cB + hstep, voffB); PG8_STAGE(PG8_SA(0, 0), cA, voffA); PG8_STAGE(PG8_SA(0, 1), cA + hstep, voffA);
        if (wr == 1) PG8_BAR;
        PG8_WAIT_V(2); PG8_BAR;
        PG8_STAGE(PG8_SB(1, 0), cB + kstep, voffB); PG8_STAGE(PG8_SA(1, 0), cA + kstep, voffA); PG8_STAGE(PG8_SB(1, 1), cB + hstep + kstep, voffB);
        PG8_WAIT_V(6); PG8_BAR;
    } else {
        PG8_STAGE(PG8_SB(0, 0), cB, voffB); PG8_STAGE(PG8_SA(0, 0), cA, voffA); PG8_STAGE(PG8_SB(0, 1), cB + hstep, voffB); PG8_STAGE(PG8_SA(0, 1), cA + hstep, voffA);
        if (wr == 1) PG8_BAR;
        PG8_WAIT_V(4); PG8_BAR;
        PG8_STAGE(PG8_SB(1, 0), cB + kstep, voffB); PG8_STAGE(PG8_SA(1, 0), cA + kstep, voffA); PG8_STAGE(PG8_SB(1, 1), cB + hstep + kstep, voffB);
        PG8_WAIT_V(6); PG8_BAR;
    }
    for (;;) {
        const bool has_next = S.next(ui + 1, nxt);
        const char* nA = has_next ? (const char*)g.A + (size_t)nxt.pm * tstep : cA; const char* nB = has_next ? (const char*)g.Bt + (size_t)nxt.pn * tstep : cB;
        for (int t = 0; t < nt; t += 2) {
            const bool last = (t == nt - 2);
            const char* a1 = cA + (size_t)(t + 1) * kstep;
            const char* a2 = last ? nA : cA + (size_t)(t + 2) * kstep; const char* b2 = last ? nB : cB + (size_t)(t + 2) * kstep;
            const char* a3 = a2 + kstep; const char* b3 = b2 + kstep;
            if (last && has_next) S.a_ready(nxt);
            if constexpr (SP2) {
            PG8_LDB(B0, 0, 0); PG8_LDB(B1, 0, 1); PG8_SCHED; PG8_LDA(At, 0, 0); PG8_STAGE(PG8_SA(1, 1), a1 + hstep, voffA);
            PG8_WAIT_V(8); PG8_WAIT_L(0); PG8_BAR; PG8_MMA(0, 0, At, B0); PG8_MMA(0, 1, At, B1); PG8_BAR; PG8_SCHED;
            PG8_LDA(At, 0, 1); PG8_STAGE(PG8_SB(0, 0), b2, voffB); PG8_STAGE(PG8_SB(0, 1), b2 + hstep, voffB); PG8_STAGE(PG8_SA(0, 0), a2, voffA);
            PG8_WAIT_V(8); PG8_WAIT_L(0); PG8_BAR; PG8_MMA(1, 0, At, B0); PG8_MMA(1, 1, At, B1); PG8_BAR; PG8_SCHED;
            PG8_LDB(B0, 1, 0); PG8_LDB(B1, 1, 1); PG8_SCHED; PG8_LDA(At, 1, 0); PG8_STAGE(PG8_SA(0, 1), a2 + hstep, voffA);
            PG8_WAIT_V(8); PG8_WAIT_L(0); PG8_BAR; PG8_MMA(0, 0, At, B0); PG8_MMA(0, 1, At, B1); PG8_BAR; PG8_SCHED;
            PG8_LDA(At, 1, 1); PG8_STAGE(PG8_SB(1, 0), b3, voffB); PG8_STAGE(PG8_SB(1, 1), b3 + hstep, voffB); PG8_STAGE(PG8_SA(1, 0), a3, voffA);
            PG8_WAIT_V(8); PG8_WAIT_L(0); PG8_BAR; PG8_MMA(1, 0, At, B0); PG8_MMA(1, 1, At, B1); PG8_BAR; PG8_SCHED;
            } else {
            PG8_LDB(B0, 0, 0); PG8_SCHED; PG8_LDA(At, 0, 0); PG8_STAGE(PG8_SA(1, 1), a1 + hstep, voffA);
            PG8_WAIT_L(8); PG8_BAR; PG8_WAIT_L(0); PG8_MMA(0, 0, At, B0); PG8_BAR; PG8_SCHED;
            PG8_LDB(B1, 0, 1); PG8_STAGE(PG8_SB(0, 0), b2, voffB);
            PG8_BAR; PG8_WAIT_L(0); PG8_MMA(0, 1, At, B1); PG8_BAR;
            PG8_LDA(At, 0, 1); PG8_STAGE(PG8_SA(0, 0), a2, voffA);
            PG8_BAR; PG8_WAIT_L(0); PG8_MMA(1, 0, At, B0); PG8_BAR; PG8_SCHED;
            PG8_STAGE(PG8_SB(0, 1), b2 + hstep, voffB);
            PG8_WAIT_V(6); PG8_BAR; PG8_MMA(1, 1, At, B1); PG8_BAR;
            PG8_LDB(B0, 1, 0); PG8_SCHED; PG8_LDA(At, 1, 0); PG8_STAGE(PG8_SA(0, 1), a2 + hstep, voffA);
            PG8_WAIT_L(8); PG8_BAR; PG8_WAIT_L(0); PG8_MMA(0, 0, At, B0); PG8_BAR; PG8_SCHED;
            PG8_LDB(B1, 1, 1); PG8_STAGE(PG8_SB(1, 0), b3, voffB);
            PG8_BAR; PG8_WAIT_L(0); PG8_MMA(0, 1, At, B1); PG8_BAR;
            PG8_LDA(At, 1, 1); PG8_STAGE(PG8_SA(1, 0), a3, voffA);
            PG8_BAR; PG8_WAIT_L(0); PG8_MMA(1, 0, At, B0); PG8_BAR; PG8_SCHED;
            PG8_STAGE(PG8_SB(1, 1), b3 + hstep, voffB);
            PG8_WAIT_V(6); PG8_BAR; PG8_MMA(1, 1, At, B1); PG8_BAR;
            }
        }
        if constexpr (ALIGN_EPI) { if (wr == 0) PG8_BAR; }
        if constexpr (!Epi::AFTER_DRAIN) { E(acc, cur, wr, wc, fr, fq); S.done(cur); }
        if (!has_next) break;
#pragma unroll
        for (int a = 0; a < 2; ++a)
#pragma unroll
            for (int b = 0; b < 2; ++b)
#pragma unroll
                for (int m = 0; m < 4; ++m)
#pragma unroll
                    for (int n = 0; n < 2; ++n) acc[a][b][m][n] = (f32x4){0.f, 0.f, 0.f, 0.f};
        cur = nxt; cA = nA; cB = nB; ++ui;
        if constexpr (ALIGN_EPI) { if (wr == 1) PG8_BAR; }
    }
    PG8_WAIT_V(0);
    if constexpr (!ALIGN_EPI) { if (wr == 0) PG8_BAR; }
    PG8_BAR;
    if constexpr (Epi::AFTER_DRAIN) { E.fused(acc, cur, wr, wc, fr, fq, lds, wid, lane); S.done(cur); }
#undef PG8_SA
#undef PG8_SB
#undef PG8_STAGE
#undef PG8_LDA
#undef PG8_LDB
#undef PG8_MMA
#undef PG8_WAIT_V
#undef PG8_WAIT_L
#undef PG8_BAR
#undef PG8_SCHED
}
}

#define LASP __attribute__((address_space(3)))

struct EpiProj {
    static constexpr bool PERM = true, AFTER_DRAIN = false;
    bf16* raw; bf16* rest;
    __device__ __forceinline__ void operator()(const pg8::f32x4 (&acc)[2][2][4][2], const pg8::Unit& u, int wr, int wc, int fr, int fq) const {
        const int row0 = u.pm * 256 + wr * 64 + fr;
        const int colb = u.pn * 256 + wc * 32 + 8 * fq;
#pragma unroll
        for (int bj = 0; bj < 2; ++bj) {
            const int col = colb + bj * 128;
            if (col >= NPROJ) continue;
            bf16* base; int ld;
            if (col < NRAW) { base = raw + col; ld = NRAW; } else { base = rest + (col - NRAW); ld = NREST; }
#pragma unroll
            for (int ai = 0; ai < 2; ++ai)
#pragma unroll
                for (int m = 0; m < 4; ++m) {
                    const pg8::f32x4 v0 = acc[ai][bj][m][0], v1 = acc[ai][bj][m][1];
                    pg8::u32x4 w; w.x = pg8::cvt_pk_bf16(v0[0], v0[1]); w.y = pg8::cvt_pk_bf16(v0[2], v0[3]); w.z = pg8::cvt_pk_bf16(v1[0], v1[1]); w.w = pg8::cvt_pk_bf16(v1[2], v1[3]);
                    *(pg8::u32x4*)(base + (size_t)(row0 + ai * 128 + m * 16) * ld) = w;
                }
        }
    }
};
struct EpiRes {
    static constexpr bool PERM = false, AFTER_DRAIN = false;
    const float* xl_src; const float* xc_src; float* out; float* xc1; const float* mods; int l;
    __device__ __forceinline__ void operator()(const pg8::f32x4 (&acc)[2][2][4][2], const pg8::Unit& u, int wr, int wc, int fr, int fq) const {
        const int row0 = u.pm * 256 + wr * 64 + fr, col0 = u.pn * 256 + wc * 32 + 4 * fq;
#pragma unroll
        for (int ai = 0; ai < 2; ++ai)
#pragma unroll
            for (int m = 0; m < 4; ++m) {
                const int r = row0 + ai * 128 + m * 16;
                const int b = r / TOK, t = r - b * TOK;
                const float* src; float* dst; int s;
                if (t < CTX) { if (l != 0) continue; src = xc_src + ((size_t)b * CTX + t) * D; dst = xc1 + ((size_t)b * CTX + t) * D; s = 8; }
                else { src = xl_src + ((size_t)b * SEQ + (t - CTX)) * D; dst = out + ((size_t)b * SEQ + (t - CTX)) * D; s = b; }
                const float* gt = mods + (size_t)(l * 9 + s) * 3072 + 2048;
#pragma unroll
                for (int bj = 0; bj < 2; ++bj)
#pragma unroll
                    for (int n = 0; n < 2; ++n) {
                        const int c = col0 + bj * 128 + n * 16;
                        const pg8::f32x4 xv = *(const pg8::f32x4*)(src + c), g = *(const pg8::f32x4*)(gt + c);
                        *(pg8::f32x4*)(dst + c) = xv * ALPHA + g * acc[ai][bj][m][n];
                    }
            }
    }
};

__device__ __forceinline__ void transpose_item(const float* W, int K, int N, bf16* WT, LASP float* scr, int item, int lane) {
    const int nblk = (N + 31) / 32, kb = item / nblk, nb = item % nblk, k0 = 64 * kb, n0 = 32 * nb;
    const bool nok = (n0 + (lane & 31)) < N;
#pragma unroll 8
    for (int i = 0; i < 32; ++i) { const int kk = 2 * i + (lane >> 5); scr[kk * 33 + (lane & 31)] = nok ? W[(size_t)(k0 + kk) * N + n0 + (lane & 31)] : 0.f; }
    asm volatile("s_waitcnt lgkmcnt(0)" ::: "memory");
    const int c = lane & 7;
#pragma unroll
    for (int j = 0; j < 4; ++j) {
        const int n = (lane >> 3) + 8 * j; const LASP float* s = scr + (8 * c) * 33 + n;
        uint4 o; o.x = pk2(s[0 * 33], s[1 * 33]); o.y = pk2(s[2 * 33], s[3 * 33]); o.z = pk2(s[4 * 33], s[5 * 33]); o.w = pk2(s[6 * 33], s[7 * 33]);
        *(uint4*)(WT + (size_t)(n0 + n) * K + k0 + 8 * c) = o;
    }
    asm volatile("s_waitcnt lgkmcnt(0)" ::: "memory");
}

__device__ void ph_prologue(const P& p, LASP unsigned char* lds, int bid, int nblk) {
    const int tid = mk_tid(), lane = tid & 63, wave = tid >> 6;
    LASP float* sm = (LASP float*)lds;
    if (bid < 96) {
        for (int i = tid; i < 9 * 1024; i += NTHREADS) {
            int s = i >> 10, d = i & 1023;
            float cv = s < 8 ? p.c[s * 1024 + d] : p.c_ctx[d];
            sm[i] = silu_f(cv);
        }
        __syncthreads();
        const int l = bid / 48, j = (bid % 48) * 64 + lane;
        const float* w = p.w_mod + (size_t)l * 1024 * 3072 + j;
        float acc[9];
#pragma unroll
        for (int s = 0; s < 9; ++s) acc[s] = 0.f;
#pragma unroll 1
        for (int i0 = wave * 128; i0 < wave * 128 + 128; i0 += 16) {
            float wv[16];
#pragma unroll
            for (int u = 0; u < 16; ++u) wv[u] = w[(size_t)(i0 + u) * 3072];
#pragma unroll
            for (int u = 0; u < 16; ++u)
#pragma unroll
                for (int s = 0; s < 9; ++s) acc[s] += sm[s * 1024 + i0 + u] * wv[u];
        }
        LASP float* red = sm + 9 * 1024;
#pragma unroll
        for (int s = 0; s < 9; ++s) red[(wave * 9 + s) * 64 + lane] = acc[s];
        __syncthreads();
        for (int o = tid; o < 9 * 64; o += NTHREADS) {
            const int s = o >> 6, c = o & 63;
            float t = 0.f;
#pragma unroll
            for (int ww = 0; ww < 8; ++ww) t += red[(ww * 9 + s) * 64 + c];
            const int jj = (bid % 48) * 64 + c;
            p.mods[(size_t)(l * 9 + s) * 3072 + jj] = t + p.b_mod[l * 3072 + jj];
        }
        __syncthreads();
    }
#if PROBE
    if (bid == 0 && tid < 4) p.stats[tid] = 0.f;
#endif
    LASP float* scr = (LASP float*)(lds + 57344 + wave * 8704);
    const int gw = (nblk - 1 - bid) * NWAVES + wave, NGW = nblk * NWAVES;
    constexpr int I_IN = 16 * 122, I_OUT = 16 * 32;
    for (int it = gw; it < 2 * (I_IN + I_OUT); it += NGW) {
        int l = it / (I_IN + I_OUT), r = it % (I_IN + I_OUT);
        if (r < I_IN) transpose_item(p.w_in + (size_t)l * D * NPROJ, D, NPROJ, p.wi_t + (size_t)l * NPAD * D, scr, r, lane);
        else transpose_item(p.w_out + (size_t)l * D * D, D, D, p.wo_t + (size_t)l * D * D, scr, r - I_IN, lane);
    }
    for (int i = bid * NTHREADS + tid; i < 2 * 192 * 128; i += nblk * NTHREADS) {
        int l = i / (192 * 128), r = i % (192 * 128);
        *(uint4*)(p.wi_t + (size_t)l * NPAD * D + (size_t)3904 * D + (size_t)r * 8) = make_uint4(0, 0, 0, 0);
    }
}

__device__ void ph_lnpass(const P& p, int mode, int bid, int nblk) {
    const int tid = mk_tid();
    const int lane = tid & 63, wave = tid >> 6;
    for (int r = bid * NWAVES + wave; r < ROWS; r += nblk * NWAVES) {
        const int b = r / TOK, t = r - b * TOK;
        const bool isc = t < CTX;
        if (mode == 2 && isc) continue;
        float* buf; const float* src; int s;
        if (isc) { buf = p.xc1 + ((size_t)b * CTX + t) * D; src = (mode == 0) ? p.ctx + ((size_t)b * CTX + t) * D : buf; s = 8; }
        else { buf = p.out + ((size_t)b * SEQ + (t - CTX)) * D; src = (mode == 0) ? p.x + ((size_t)b * SEQ + (t - CTX)) * D : buf; s = b; }
        f32x4_t v[4];
#pragma unroll
        for (int j = 0; j < 4; ++j) v[j] = *(const f32x4_t*)(src + 256 * j + 4 * lane);
        if (mode >= 1) {
            const int lp = mode - 1;
            float sum = 0.f;
#pragma unroll
            for (int j = 0; j < 4; ++j) sum += (v[j].x + v[j].y) + (v[j].z + v[j].w);
            const float mu = wave_sum(sum) * (1.f / 1024.f);
            float sq = 0.f;
#pragma unroll
            for (int j = 0; j < 4; ++j) { v[j] = v[j] - mu; sq += (v[j].x * v[j].x + v[j].y * v[j].y) + (v[j].z * v[j].z + v[j].w * v[j].w); }
            const float rs = 1.f / sqrtf(wave_sum(sq) * (1.f / 1024.f) + 1e-6f);
#pragma unroll
            for (int j = 0; j < 4; ++j) {
                const f32x4_t g = *(const f32x4_t*)(p.ln_g + lp * 1024 + 256 * j + 4 * lane), bb = *(const f32x4_t*)(p.ln_b + lp * 1024 + 256 * j + 4 * lane);
                v[j] = v[j] * rs * g + bb;
#if PROBE
                if (mode == 2) v[j] = v[j] + (p.stats[0] / fmaxf(p.stats[1], 1e-20f));
#endif
#if TPROBE >= 0
                if (mode == 2) v[j] = v[j] + exp2f((rintf(log2f(fmaxf(p.stats[2], 1.f)) * 6.f + TSHIFT * 0.5f) - TSHIFT * 0.5f) * (1.f / 6.f)) * 1e-4f;
#endif
                *(f32x4_t*)(buf + 256 * j + 4 * lane) = v[j];
            }
            if (mode == 2) continue;
        }
        const int l = mode;
        float sum = 0.f;
#pragma unroll
        for (int j = 0; j < 4; ++j) sum += (v[j].x + v[j].y) + (v[j].z + v[j].w);
        const float mu = wave_sum(sum) * (1.f / 1024.f);
        float sq = 0.f;
#pragma unroll
        for (int j = 0; j < 4; ++j) { v[j] = v[j] - mu; sq += (v[j].x * v[j].x + v[j].y * v[j].y) + (v[j].z * v[j].z + v[j].w * v[j].w); }
        const float rs = 1.f / sqrtf(wave_sum(sq) * (1.f / 1024.f) + 1e-6f);
        const float* md = p.mods + (size_t)(l * 9 + s) * 3072;
#pragma unroll
        for (int j = 0; j < 4; ++j) {
            const f32x4_t sh = *(const f32x4_t*)(md + 256 * j + 4 * lane), sc = *(const f32x4_t*)(md + 1024 + 256 * j + 4 * lane);
            const f32x4_t o = v[j] * rs * (sc + 1.f) + sh;
            uint2 w; w.x = pk2(o.x, o.y); w.y = pk2(o.z, o.w);
            *(uint2*)(p.ml + (size_t)r * D + 256 * j + 4 * lane) = w;
        }
    }
}

__device__ void ph_conv(const P& p, int l, int bid, int nblk) {
    const int tid = mk_tid();
    const int lane = tid & 63, wave = tid >> 6;
    const float* cw = p.conv_w + (size_t)l * 5 * 1536;
    constexpr int NSTRIP = TOK / 16;
    for (int it = bid * NWAVES + wave; it < BATCH * NSTRIP * 3; it += nblk * NWAVES) {
        const int third = it % 3, rest_i = it / 3, strip = rest_i % NSTRIP, b = rest_i / NSTRIP;
        const int t0 = strip * 16;
        const int lo = t0 < CTX ? 0 : CTX, hi = t0 < CTX ? CTX : TOK;
        const int ch = third * 512 + lane * 8;
        float w[5][8];
#pragma unroll
        for (int j = 0; j < 5; ++j) {
            const f32x4_t a = *(const f32x4_t*)(cw + j * 1536 + ch), c = *(const f32x4_t*)(cw + j * 1536 + ch + 4);
            w[j][0] = a.x; w[j][1] = a.y; w[j][2] = a.z; w[j][3] = a.w; w[j][4] = c.x; w[j][5] = c.y; w[j][6] = c.z; w[j][7] = c.w;
        }
        const bf16* src = p.raw + ((size_t)b * TOK + t0) * NRAW + ch;
        bf16* dst = p.qkvn + ((size_t)b * TOK + t0) * NRAW + ch;
        uint4 rw[20];
#pragma unroll
        for (int i = 0; i < 20; ++i) {
            const int tt = t0 + i - 2;
            rw[i] = (tt >= lo && tt < hi) ? *(const uint4*)(src + (ptrdiff_t)(i - 2) * NRAW) : make_uint4(0, 0, 0, 0);
        }
        const int g = (ch >> 7);
        const float qs = g < 4 ? 0.08838834764831845f : 1.f;
#pragma unroll
        for (int n = 0; n < 16; ++n) {
            float acc[8];
#pragma unroll
            for (int e = 0; e < 8; ++e) acc[e] = 0.f;
#pragma unroll
            for (int j = 0; j < 5; ++j) {
                float f[8]; unpack8(rw[n + j], f);
#pragma unroll
                for (int e = 0; e < 8; ++e) acc[e] += w[j][e] * f[e];
            }
            float ss = 0.f;
#pragma unroll
            for (int e = 0; e < 8; ++e) { acc[e] = silu_f(acc[e]); ss += acc[e] * acc[e]; }
            if (g < 8) {
#pragma unroll
                for (int m = 8; m > 0; m >>= 1) ss += __shfl_xor(ss, m);
                const float sc = qs * __builtin_amdgcn_rsqf(ss + 1e-6f);
#pragma unroll
                for (int e = 0; e < 8; ++e) acc[e] *= sc;
            }
            uint4 o; o.x = pk2(acc[0], acc[1]); o.y = pk2(acc[2], acc[3]); o.z = pk2(acc[4], acc[5]); o.w = pk2(acc[6], acc[7]);
            *(uint4*)(dst + (size_t)n * NRAW) = o;
        }
    }
}

typedef short bf16x8_t __attribute__((ext_vector_type(8)));
typedef float f32x16_t __attribute__((ext_vector_type(16)));
typedef float f32x2_t __attribute__((ext_vector_type(2)));
typedef __bf16 bf16x2_t __attribute__((ext_vector_type(2)));
typedef unsigned u32x4_t __attribute__((ext_vector_type(4)));
#define MFMA32(a, b, c) __builtin_amdgcn_mfma_f32_32x32x16_bf16((a), (b), (c), 0, 0, 0)
__device__ __forceinline__ unsigned cvtpk(float lo, float hi) { f32x2_t v = {lo, hi}; bf16x2_t q = __builtin_convertvector(v, bf16x2_t); return __builtin_bit_cast(unsigned, q); }
__device__ __forceinline__ int crow(int reg, int h) { return (reg & 3) + 8 * (reg >> 2) + 4 * h; }
__device__ __forceinline__ int perm16(int a) { const int x = a & 15; return (a & ~15) + (x < 4 ? x : x < 8 ? x + 4 : x < 12 ? x - 4 : x); }
#define PACK8(x, s) __builtin_bit_cast(bf16x8_t, (u32x4_t){cvtpk((x)[8 * (s)], (x)[8 * (s) + 1]), cvtpk((x)[8 * (s) + 2], (x)[8 * (s) + 3]), cvtpk((x)[8 * (s) + 4], (x)[8 * (s) + 5]), cvtpk((x)[8 * (s) + 6], (x)[8 * (s) + 7])})
constexpr int GCH = 32, NCH = TOK / GCH;
constexpr int GP_ITEM = 4416;

__device__ void ph_gdnprep(const P& p, LASP unsigned char* lds, int l, int bid, int nblk, int tid) {
    const int lane = tid & 63, wave = tid >> 6, r = lane & 31, hh = lane >> 5;
    LASP float* Lm = (LASP float*)(lds + wave * 16384);
    LASP float* Xs = Lm + 2048;
    for (int it = bid * NWAVES + wave; it < BATCH * 4 * NCH; it += nblk * NWAVES) {
        const int c = it % NCH, bh = it / NCH, h = bh & 3, b = bh >> 2;
        const size_t row0 = (size_t)b * TOK + (size_t)c * GCH;
        f32x16_t KK, QK;
#pragma unroll
        for (int i = 0; i < 16; ++i) { KK[i] = 0.f; QK[i] = 0.f; }
        const bf16* kbase = p.qkvn + (row0 + r) * NRAW + 512 + h * 128 + 8 * hh;
        const bf16* qbase = p.qkvn + (row0 + r) * NRAW + h * 128 + 8 * hh;
#pragma unroll
        for (int s = 0; s < 8; ++s) {
            const bf16x8_t kf = *(const bf16x8_t*)(kbase + 16 * s), qf = *(const bf16x8_t*)(qbase + 16 * s);
            KK = MFMA32(kf, kf, KK);
            QK = MFMA32(qf, kf, QK);
        }
        float Gd, bd;
        {
            const bf16* ab = p.rest + (row0 + r) * NREST + RC_AB;
            const float a = bf2f(ab[hh * 4 + h]) + p.dt_bias[(l * 2 + hh) * 4 + h];
            const float sp = fmaxf(a, 0.f) + log1pf(expf(-fabsf(a)));
            Gd = -expf(p.a_log[(l * 2 + hh) * 4 + h]) * sp;
            bd = 1.f / (1.f + expf(-bf2f(ab[(2 + hh) * 4 + h])));
        }
#pragma unroll
        for (int off = 1; off < 32; off <<= 1) {
            const float up = __shfl_up(Gd, off, 32), dn = __shfl_down(Gd, off, 32);
            if (hh == 0) { if (r >= off) Gd += up; } else { if (r + off < 32) Gd += dn; }
        }
        unsigned char* gout = (unsigned char*)p.raw + ((size_t)(bh * 2) * NCH + c) * GP_ITEM;
        {
            const float Glast = __shfl(Gd, hh == 0 ? 31 : 32);
            float* sc = (float*)(gout + (size_t)hh * NCH * GP_ITEM + 4096);
            sc[r] = expf(Gd); sc[32 + r] = expf(Glast - Gd);
            if (r == 0) sc[64] = expf(Glast);
        }
        asm volatile("s_waitcnt lgkmcnt(0)" ::: "memory");
#pragma unroll
        for (int d = 0; d < 2; ++d) {
            const float Gcol = __shfl(Gd, d * 32 + r);
            bf16* qko = (bf16*)(gout + (size_t)d * NCH * GP_ITEM + 2048);
#pragma unroll
            for (int i = 0; i < 16; ++i) {
                const int n = crow(i, hh);
                const float Grow = __shfl(Gd, d * 32 + n), brow = __shfl(bd, d * 32 + n);
                const bool incl = d == 0 ? (r <= n) : (r >= n), strict = d == 0 ? (r < n) : (r > n);
                const float dec = expf(incl ? Grow - Gcol : 0.f);
                const float lv = strict ? brow * KK[i] * dec : 0.f;
                const float qv = incl ? QK[i] * dec : 0.f;
                const int n2 = d == 0 ? n : 31 - n, m2 = d == 0 ? r : 31 - r;
                Lm[(d * 32 + n2) * 32 + m2] = lv;
                qko[n * 32 + perm16(r)] = f2bf(qv);
                if ((i & 3) == 3) __builtin_amdgcn_sched_barrier(0);
            }
        }
        asm volatile("s_waitcnt lgkmcnt(0)" ::: "memory");
        {
            const LASP float* Lr = Lm + hh * 1024;
            LASP float* xc = Xs + lane;
#pragma unroll 4
            for (int j = 0; j < 32; ++j) xc[j * 64] = (j == r) ? 1.f : 0.f;
#pragma unroll 1
            for (int n = 1; n < 32; ++n) {
                float a0 = 0.f, a1 = 0.f;
#pragma unroll 1
                for (int j4 = 0; j4 < n; j4 += 4) {
                    const f32x4_t lv = *(const LASP f32x4_t*)(Lr + n * 32 + j4);
                    a0 += lv.x * xc[(j4 + 0) * 64]; a1 += lv.y * xc[(j4 + 1) * 64];
                    a0 += lv.z * xc[(j4 + 2) * 64]; a1 += lv.w * xc[(j4 + 3) * 64];
                }
                xc[n * 64] -= (a0 + a1);
            }
            const int mtok = hh == 0 ? r : 31 - r;
            const float bcol = __shfl(bd, hh * 32 + mtok);
            bf16* tq = (bf16*)(gout + (size_t)hh * NCH * GP_ITEM) + perm16(mtok) + (hh == 0 ? 0 : 31 * 32);
            const int tstep = hh == 0 ? 32 : -32;
#pragma unroll 4
            for (int n = 0; n < 32; ++n) { *tq = f2bf(xc[n * 64] * bcol); tq += tstep; }
        }
        asm volatile("s_waitcnt lgkmcnt(0)" ::: "memory");
    }
}


constexpr int ST_KA = 0, ST_QA = 8704, ST_KN = 17408, ST_V = 27648, ST_TP = 37888, ST_QK = 40448, ST_GL = 43008, ST_BYTES = 43328;
constexpr int GDN_OST = 2 * ST_BYTES, GDN_OST_BYTES = 32 * 272;
typedef unsigned u32x2_t __attribute__((ext_vector_type(2)));
typedef short s16x4_t __attribute__((ext_vector_type(4)));
struct GSlot { u32x4_t k0, k1, q0, q1, v0, v1, t; f32x4_t sc; };

__device__ __forceinline__ int gdn_chunk(int dir, int s) { return dir == 0 ? s : (s < 8 ? 7 - s : 143 - s); }
__device__ __forceinline__ void gdn_issue(const P& p, GSlot& g, int b, int h, int dir, int step, int tl) {
    const int c = gdn_chunk(dir, step);
    const size_t row0 = (size_t)b * TOK + (size_t)c * GCH;
    const int r0 = tl >> 4, c16 = tl & 15;
    const bf16* a0 = p.qkvn + (row0 + r0) * NRAW + h * 128 + 8 * c16;
    const bf16* a1 = a0 + (size_t)16 * NRAW;
    g.q0 = *(const u32x4_t*)a0; g.q1 = *(const u32x4_t*)a1;
    g.k0 = *(const u32x4_t*)(a0 + 512); g.k1 = *(const u32x4_t*)(a1 + 512);
    g.v0 = *(const u32x4_t*)(a0 + 1024); g.v1 = *(const u32x4_t*)(a1 + 1024);
    const unsigned char* gp = (const unsigned char*)p.raw + ((size_t)((b * 4 + h) * 2 + dir) * NCH + c) * GP_ITEM;
    g.t = *(const u32x4_t*)(gp + tl * 16);
    g.sc = *(const f32x4_t*)(gp + 4096 + (tl < 20 ? tl : 0) * 16);
}
__device__ __forceinline__ u32x4_t scale8(u32x4_t x, float s) {
    return (u32x4_t){cvtpk(bflo(x.x) * s, bfhi(x.x) * s), cvtpk(bflo(x.y) * s, bfhi(x.y) * s), cvtpk(bflo(x.z) * s, bfhi(x.z) * s), cvtpk(bflo(x.w) * s, bfhi(x.w) * s)};
}
__device__ __forceinline__ void gdn_put_rows(LASP unsigned char* st, int row, int c16, u32x4_t kq, int off) {
    const int g = c16 >> 1, odd = c16 & 1;
    *(LASP u32x2_t*)(st + off + row * 272 + (16 * g + (odd ? 4 : 0)) * 2) = (u32x2_t){kq.x, kq.y};
    *(LASP u32x2_t*)(st + off + row * 272 + (16 * g + (odd ? 12 : 8)) * 2) = (u32x2_t){kq.z, kq.w};
}
__device__ __forceinline__ void gdn_write(LASP unsigned char* st, const GSlot& g, int tl) {
    const int r0 = tl >> 4, c16 = tl & 15;
    gdn_put_rows(st, r0, c16, g.k0, ST_KA); gdn_put_rows(st, r0 + 16, c16, g.k1, ST_KA);
    gdn_put_rows(st, r0, c16, g.q0, ST_QA); gdn_put_rows(st, r0 + 16, c16, g.q1, ST_QA);
    *(LASP u32x4_t*)(st + ST_KN + r0 * 320 + c16 * 16) = g.k0;
    *(LASP u32x4_t*)(st + ST_KN + (r0 + 16) * 320 + c16 * 16) = g.k1;
    *(LASP u32x4_t*)(st + ST_V + r0 * 320 + c16 * 16) = g.v0;
    *(LASP u32x4_t*)(st + ST_V + (r0 + 16) * 320 + c16 * 16) = g.v1;
    { const int t2 = tl & 127; *(LASP u32x4_t*)(st + (tl < 128 ? ST_TP : ST_QK) + (t2 >> 2) * 80 + (t2 & 3) * 16) = g.t; }
    if (tl < 20) *(LASP f32x4_t*)(st + ST_GL + tl * 16) = g.sc;
}
__device__ __forceinline__ void gdn_flush(const P& p, LASP unsigned char* lds, int b, int h, int dir, int step, int tl) {
    const int c = gdn_chunk(dir, step);
    const LASP unsigned char* ost = lds + GDN_OST + (step & 1) * GDN_OST_BYTES;
    bf16* op = p.oa + ((size_t)dir * ROWS + (size_t)b * TOK + (size_t)c * GCH) * 512 + h * 128;
#pragma unroll
    for (int k = 0; k < 2; ++k) { const int idx = tl + 256 * k, row = idx >> 4, ch = idx & 15; *(u32x4_t*)(op + (size_t)row * 512 + ch * 8) = *(const LASP u32x4_t*)(ost + row * 272 + ch * 16); }
}
__device__ __forceinline__ s16x4_t trd(const LASP unsigned char* q) {
    typedef short v4i16_t __attribute__((ext_vector_type(4)));
    return __builtin_bit_cast(s16x4_t, __builtin_amdgcn_ds_read_tr16_b64_v4i16((LASP v4i16_t*)q));
}
#define TRFRAG(base) __builtin_shufflevector(trd(base), trd((base) + 8 * 320), 0, 1, 2, 3, 4, 5, 6, 7)

#if TPROBE == 60
#define GDN_SYNC_C() do { unsigned long long t_ = __builtin_amdgcn_s_memrealtime(); __syncthreads(); if (chain == 0 && tid == 0) p.stats[2] += (float)(__builtin_amdgcn_s_memrealtime() - t_) * 0.01f; } while (0)
#define GDN_SYNC_L() __syncthreads()
#elif TPROBE == 61
#define GDN_SYNC_L() do { unsigned long long t_ = __builtin_amdgcn_s_memrealtime(); __syncthreads(); if (chain == 0 && tid == 256) p.stats[2] += (float)(__builtin_amdgcn_s_memrealtime() - t_) * 0.01f; } while (0)
#define GDN_SYNC_C() __syncthreads()
#else
#define GDN_SYNC_C() __syncthreads()
#define GDN_SYNC_L() __syncthreads()
#endif
__device__ void gdn_scan_fast(const P& p, LASP unsigned char* lds, int chain) {
    const int tid = mk_tid();
    const int lane = tid & 63, wave = __builtin_amdgcn_readfirstlane(tid >> 6);
    const int dir = chain & 1, h = (chain >> 1) & 3, b = chain >> 3;
    constexpr int NS = NCH;
    if (wave >= 4) {
        const int tl = tid - 256;
        GSlot g0, g1, g2, g3;
        gdn_issue(p, g0, b, h, dir, 0, tl); gdn_issue(p, g1, b, h, dir, 1, tl); gdn_issue(p, g2, b, h, dir, 2, tl); gdn_issue(p, g3, b, h, dir, 3, tl);
        gdn_write(lds, g0, tl); gdn_issue(p, g0, b, h, dir, 4, tl);
        __syncthreads();
#pragma unroll 1
        for (int s = 0; s < NS; s += 4) {
            if (s > 0) gdn_flush(p, lds, b, h, dir, s - 1, tl);
            gdn_write(lds + ((s + 1) & 1) * ST_BYTES, g1, tl); gdn_issue(p, g1, b, h, dir, min(s + 5, NS - 1), tl);
            GDN_SYNC_L();
            gdn_flush(p, lds, b, h, dir, s, tl);
            gdn_write(lds + ((s + 2) & 1) * ST_BYTES, g2, tl); gdn_issue(p, g2, b, h, dir, min(s + 6, NS - 1), tl);
            GDN_SYNC_L();
            gdn_flush(p, lds, b, h, dir, s + 1, tl);
            gdn_write(lds + ((s + 3) & 1) * ST_BYTES, g3, tl); gdn_issue(p, g3, b, h, dir, min(s + 7, NS - 1), tl);
            GDN_SYNC_L();
            gdn_flush(p, lds, b, h, dir, s + 2, tl);
            gdn_write(lds + ((s + 4) & 1) * ST_BYTES, g0, tl); gdn_issue(p, g0, b, h, dir, min(s + 8, NS - 1), tl);
            GDN_SYNC_L();
        }
        gdn_flush(p, lds, b, h, dir, NS - 1, tl);
    } else {
        const int r = lane & 31, hh = lane >> 5, w = wave;
        f32x16_t S0, S1, S2, S3;
#pragma unroll
        for (int i = 0; i < 16; ++i) { S0[i] = 0.f; S1[i] = 0.f; S2[i] = 0.f; S3[i] = 0.f; }
        const int troff = (4 * hh + ((lane & 15) >> 2)) * 320 + (16 * ((lane >> 4) & 1) + 4 * (lane & 3)) * 2;
        __syncthreads();
#pragma unroll 1
        for (int s = 0; s < NS; ++s) {
            LASP unsigned char* st = lds + (s & 1) * ST_BYTES;
            const LASP unsigned char* ka = st + ST_KA + r * 272 + hh * 16;
            const LASP unsigned char* qa = st + ST_QA + r * 272 + hh * 16;
            const bf16x8_t kA0 = *(const LASP bf16x8_t*)(ka), kA1 = *(const LASP bf16x8_t*)(ka + 32), kA2 = *(const LASP bf16x8_t*)(ka + 64), kA3 = *(const LASP bf16x8_t*)(ka + 96);
            const bf16x8_t kA4 = *(const LASP bf16x8_t*)(ka + 128), kA5 = *(const LASP bf16x8_t*)(ka + 160), kA6 = *(const LASP bf16x8_t*)(ka + 192), kA7 = *(const LASP bf16x8_t*)(ka + 224);
            const bf16x8_t qA0 = *(const LASP bf16x8_t*)(qa), qA1 = *(const LASP bf16x8_t*)(qa + 32), qA2 = *(const LASP bf16x8_t*)(qa + 64), qA3 = *(const LASP bf16x8_t*)(qa + 96);
            const bf16x8_t qA4 = *(const LASP bf16x8_t*)(qa + 128), qA5 = *(const LASP bf16x8_t*)(qa + 160), qA6 = *(const LASP bf16x8_t*)(qa + 192), qA7 = *(const LASP bf16x8_t*)(qa + 224);
            const LASP unsigned char* vbase = st + ST_V + troff + 64 * w;
            const bf16x8_t vB0 = TRFRAG(vbase), vB1 = TRFRAG(vbase + 16 * 320);
            const LASP unsigned char* tp = st + ST_TP + r * 80 + hh * 16;
            const bf16x8_t T0 = *(const LASP bf16x8_t*)(tp), T1 = *(const LASP bf16x8_t*)(tp + 32);
            const LASP unsigned char* qk = st + ST_QK + r * 80 + hh * 16;
            const bf16x8_t Q0 = *(const LASP bf16x8_t*)(qk), Q1 = *(const LASP bf16x8_t*)(qk + 32);
            const LASP float* sc = (const LASP float*)(st + ST_GL);
            const f32x4_t e0 = *(const LASP f32x4_t*)(sc + 4 * hh), e1 = *(const LASP f32x4_t*)(sc + 8 + 4 * hh), e2 = *(const LASP f32x4_t*)(sc + 16 + 4 * hh), e3 = *(const LASP f32x4_t*)(sc + 24 + 4 * hh);
            const f32x4_t f0 = *(const LASP f32x4_t*)(sc + 32 + 4 * hh), f1 = *(const LASP f32x4_t*)(sc + 40 + 4 * hh), f2 = *(const LASP f32x4_t*)(sc + 48 + 4 * hh), f3 = *(const LASP f32x4_t*)(sc + 56 + 4 * hh);
            const float gl = sc[64];
            __builtin_amdgcn_sched_barrier(0);
            f32x16_t ak, aq, vn;
#pragma unroll
            for (int i = 0; i < 16; ++i) { ak[i] = 0.f; aq[i] = 0.f; vn[i] = 0.f; }
            vn = MFMA32(T0, vB0, vn); vn = MFMA32(T1, vB1, vn);
#define GDN_KQ(KA, QA, SX, u) { const bf16x8_t SB = PACK8(SX, u); ak = MFMA32(KA, SB, ak); aq = MFMA32(QA, SB, aq); }
            GDN_KQ(kA0, qA0, S0, 0) GDN_KQ(kA1, qA1, S0, 1) GDN_KQ(kA2, qA2, S1, 0) GDN_KQ(kA3, qA3, S1, 1)
            GDN_KQ(kA4, qA4, S2, 0) GDN_KQ(kA5, qA5, S2, 1) GDN_KQ(kA6, qA6, S3, 0) GDN_KQ(kA7, qA7, S3, 1)
#undef GDN_KQ
            __builtin_amdgcn_sched_barrier(0);
            const LASP unsigned char* kn = st + ST_KN + troff;
            const bf16x8_t N00 = TRFRAG(kn), N01 = TRFRAG(kn + 16 * 320), N10 = TRFRAG(kn + 64), N11 = TRFRAG(kn + 64 + 16 * 320);
            const bf16x8_t N20 = TRFRAG(kn + 128), N21 = TRFRAG(kn + 128 + 16 * 320), N30 = TRFRAG(kn + 192), N31 = TRFRAG(kn + 192 + 16 * 320);
            __builtin_amdgcn_sched_barrier(0);
#define ROWSCALE(X, sgn) { X[0] *= sgn e0.x; X[1] *= sgn e0.y; X[2] *= sgn e0.z; X[3] *= sgn e0.w; X[4] *= sgn e1.x; X[5] *= sgn e1.y; X[6] *= sgn e1.z; X[7] *= sgn e1.w; \
                           X[8] *= sgn e2.x; X[9] *= sgn e2.y; X[10] *= sgn e2.z; X[11] *= sgn e2.w; X[12] *= sgn e3.x; X[13] *= sgn e3.y; X[14] *= sgn e3.z; X[15] *= sgn e3.w; }
            ROWSCALE(ak, -) ROWSCALE(aq, +)
#undef ROWSCALE
            const bf16x8_t ab0 = PACK8(ak, 0), ab1 = PACK8(ak, 1);
            vn = MFMA32(T0, ab0, vn); vn = MFMA32(T1, ab1, vn);
            S0 = S0 * gl; S1 = S1 * gl; S2 = S2 * gl; S3 = S3 * gl;
            const bf16x8_t vb0 = PACK8(vn, 0), vb1 = PACK8(vn, 1);
            f32x16_t vf;
            vf[0] = vn[0] * f0.x; vf[1] = vn[1] * f0.y; vf[2] = vn[2] * f0.z; vf[3] = vn[3] * f0.w; vf[4] = vn[4] * f1.x; vf[5] = vn[5] * f1.y; vf[6] = vn[6] * f1.z; vf[7] = vn[7] * f1.w;
            vf[8] = vn[8] * f2.x; vf[9] = vn[9] * f2.y; vf[10] = vn[10] * f2.z; vf[11] = vn[11] * f2.w; vf[12] = vn[12] * f3.x; vf[13] = vn[13] * f3.y; vf[14] = vn[14] * f3.z; vf[15] = vn[15] * f3.w;
            const bf16x8_t fb0 = PACK8(vf, 0), fb1 = PACK8(vf, 1);
            S0 = MFMA32(N00, fb0, S0); S1 = MFMA32(N10, fb0, S1); S2 = MFMA32(N20, fb0, S2); S3 = MFMA32(N30, fb0, S3);
            S0 = MFMA32(N01, fb1, S0); S1 = MFMA32(N11, fb1, S1); S2 = MFMA32(N21, fb1, S2); S3 = MFMA32(N31, fb1, S3);
            aq = MFMA32(Q0, vb0, aq); aq = MFMA32(Q1, vb1, aq);
            {
                LASP unsigned short* ost = (LASP unsigned short*)(lds + GDN_OST + (s & 1) * GDN_OST_BYTES) + 32 * w + r;
#pragma unroll
                for (int i = 0; i < 16; i += 2) { const unsigned pk = cvtpk(aq[i], aq[i + 1]); ost[crow(i, hh) * 136] = (unsigned short)pk; ost[(crow(i, hh) + 1) * 136] = (unsigned short)(pk >> 16); }
            }
            GDN_SYNC_C();
        }
    }
}

constexpr int GL_ITEM = 6272;
constexpr size_t GLA_PREP_OFF = (size_t)BATCH * 4 * 2 * NCH * GP_ITEM;

__device__ __forceinline__ void gla_prep_item(const P& p, LASP unsigned char* wl, const LASP float* cstab, int l, int it, int lane) {
    const int r = lane & 31, hh = lane >> 5;
    const int c = it % NCH, bh = it / NCH, h = bh & 3, b = bh >> 2;
    const size_t row0 = (size_t)b * TOK + (size_t)c * GCH;
    float qv[16], kv[16];
    {
        const bf16* qb = p.rest + (row0 + 4 * hh) * NREST + RC_CQ + h * 32 + r;
#pragma unroll
        for (int i = 0; i < 16; ++i) { const int no = (i & 3) + 8 * (i >> 2); qv[i] = bf2f(qb[(size_t)no * NREST]); kv[i] = bf2f(qb[(size_t)no * NREST + 128]); }
    }
    if (c >= 8) {
        const int dd = r & 15, f = dd & 7;
        const int prow = (c - 8) >> 1, pcol0 = 32 * ((c - 8) & 1);
#pragma unroll
        for (int i = 0; i < 16; ++i) {
            const int n = crow(i, hh);
            const int pos = r < 16 ? prow : pcol0 + n;
            const float cs = cstab[(pos * 8 + f) * 2], sn = cstab[(pos * 8 + f) * 2 + 1];
            const float qp = __shfl_xor(qv[i], 8), kp = __shfl_xor(kv[i], 8);
            if (dd < 8) { qv[i] = qv[i] * cs - qp * sn; kv[i] = kv[i] * cs - kp * sn; }
            else { qv[i] = qp * sn + qv[i] * cs; kv[i] = kp * sn + kv[i] * cs; }
        }
    }
#pragma unroll
    for (int i = 0; i < 16; ++i) qv[i] *= 0.17677669529663687f;
#pragma unroll 1
    for (int dir = 0; dir < 2; ++dir) {
        f32x16_t X;
#pragma unroll
        for (int i = 0; i < 16; ++i) X[i] = 0.f;
        {
            const bf16x8_t A = *(const bf16x8_t*)(p.rest + (row0 + r) * NREST + RC_CR + dir * 16 + 8 * hh);
            const float* w2p = p.gla_w2 + ((size_t)(l * 2 + dir) * 16 + 8 * hh) * 128 + h * 32 + r;
            const bf16x8_t Bf = __builtin_bit_cast(bf16x8_t, (u32x4_t){cvtpk(w2p[0], w2p[128]), cvtpk(w2p[256], w2p[384]), cvtpk(w2p[512], w2p[640]), cvtpk(w2p[768], w2p[896])});
            X = MFMA32(A, Bf, X);
        }
        const float b2v = p.gla_b2[(l * 2 + dir) * 128 + h * 32 + r];
        float Bc[16];
#pragma unroll
        for (int i = 0; i < 16; ++i) { const float xg = X[i] + b2v; Bc[i] = (fminf(xg, 0.f) - log1pf(expf(-fabsf(xg)))) * (1.f / 16.f); }
        float tot;
        {
            float sg[4], ps[4];
#pragma unroll
            for (int g = 0; g < 4; ++g) { sg[g] = (Bc[4 * g] + Bc[4 * g + 1]) + (Bc[4 * g + 2] + Bc[4 * g + 3]); ps[g] = __shfl_xor(sg[g], 32); }
            tot = ((sg[0] + ps[0]) + (sg[1] + ps[1])) + ((sg[2] + ps[2]) + (sg[3] + ps[3]));
            if (dir == 0) {
                float base = 0.f;
#pragma unroll
                for (int g = 0; g < 4; ++g) {
                    float o = base + (hh ? ps[g] : 0.f);
#pragma unroll
                    for (int k = 0; k < 4; ++k) { o += Bc[4 * g + k]; Bc[4 * g + k] = o; }
                    base += sg[g] + ps[g];
                }
            } else {
                float base = 0.f;
#pragma unroll
                for (int g = 3; g >= 0; --g) {
                    float o = base + (hh ? 0.f : ps[g]);
#pragma unroll
                    for (int k = 3; k >= 0; --k) { o += Bc[4 * g + k]; Bc[4 * g + k] = o; }
                    base += sg[g] + ps[g];
                }
            }
        }
        unsigned char* gout = (unsigned char*)p.raw + GLA_PREP_OFF + ((size_t)(bh * 2 + dir) * NCH + c) * GL_ITEM;
        LASP bf16* ql = (LASP bf16*)wl;
        LASP bf16* kl = ql + 32 * 40;
        {
            bf16* qpo = (bf16*)gout + perm16(r);
            bf16* kdo = (bf16*)(gout + 4096) + r * 32;
#pragma unroll
            for (int g = 0; g < 4; ++g) {
                float kd[4];
#pragma unroll
                for (int k = 0; k < 4; ++k) {
                    const int i = 4 * g + k, n = crow(i, hh);
                    const float eb = expf(Bc[i]);
                    const float qs = qv[i] * eb, ks = kv[i] / eb;
                    kd[k] = kv[i] * expf(tot - Bc[i]);
                    const bf16 qsb = f2bf(qs);
                    qpo[n * 32] = qsb;
                    ql[n * 40 + r] = qsb; kl[n * 40 + r] = f2bf(ks);
                }
                *(u32x2_t*)(kdo + perm16(8 * g + 4 * hh)) = (u32x2_t){cvtpk(kd[0], kd[1]), cvtpk(kd[2], kd[3])};
            }
            if (hh == 0) ((float*)(gout + 6144))[r] = expf(tot);
        }
        asm volatile("s_waitcnt lgkmcnt(0)" ::: "memory");
        f32x16_t AT;
#pragma unroll
        for (int i = 0; i < 16; ++i) AT[i] = 0.f;
        AT = MFMA32(*(const LASP bf16x8_t*)((const LASP unsigned char*)kl + r * 80 + hh * 16), *(const LASP bf16x8_t*)((const LASP unsigned char*)ql + r * 80 + hh * 16), AT);
        AT = MFMA32(*(const LASP bf16x8_t*)((const LASP unsigned char*)kl + r * 80 + hh * 16 + 32), *(const LASP bf16x8_t*)((const LASP unsigned char*)ql + r * 80 + hh * 16 + 32), AT);
        {
            bf16* amo = (bf16*)(gout + 2048) + r * 32;
#pragma unroll
            for (int g = 0; g < 4; ++g) {
                float a[4];
#pragma unroll
                for (int k = 0; k < 4; ++k) { const int m = crow(4 * g + k, hh); const bool keep = dir == 0 ? (m <= r) : (m >= r); a[k] = keep ? AT[4 * g + k] : 0.f; }
                *(u32x2_t*)(amo + perm16(8 * g + 4 * hh)) = (u32x2_t){cvtpk(a[0], a[1]), cvtpk(a[2], a[3])};
            }
        }
        asm volatile("s_waitcnt lgkmcnt(0)" ::: "memory");
    }
}

constexpr int LS_QP = 0, LS_AM = 2560, LS_KD = 5120, LS_V = 7680, LS_GL = 13824, LS_BYTES = 13952;
constexpr int GLA_OST = 4 * LS_BYTES, GLA_OST_BYTES = 32 * 144;
struct LSlot { u32x4_t a0, a1, a2, v0, v1; f32x4_t gl; };
__device__ __forceinline__ void gla_issue(const P& p, LSlot& g, int b, int h, int dir, int step, int t2) {
    const int c = gdn_chunk(dir, step);
    const unsigned char* gp = (const unsigned char*)p.raw + GLA_PREP_OFF + ((size_t)((b * 4 + h) * 2 + dir) * NCH + c) * GL_ITEM;
    g.a0 = *(const u32x4_t*)(gp + t2 * 16); g.a1 = *(const u32x4_t*)(gp + 2048 + t2 * 16); g.a2 = *(const u32x4_t*)(gp + 4096 + t2 * 16);
    g.gl = *(const f32x4_t*)(gp + 6144 + (t2 < 8 ? t2 : 0) * 16);
    const size_t row0 = (size_t)b * TOK + (size_t)c * GCH;
    const bf16* vp = p.rest + (row0 + (t2 >> 3)) * NREST + RC_CV + h * 64 + 8 * (t2 & 7);
    g.v0 = *(const u32x4_t*)vp; g.v1 = *(const u32x4_t*)(vp + (size_t)16 * NREST);
}
__device__ __forceinline__ void gla_write(LASP unsigned char* st, const LSlot& g, int t2) {
    const int row = t2 >> 2, ch = t2 & 3;
    *(LASP u32x4_t*)(st + LS_QP + row * 80 + ch * 16) = g.a0;
    *(LASP u32x4_t*)(st + LS_AM + row * 80 + ch * 16) = g.a1;
    *(LASP u32x4_t*)(st + LS_KD + row * 80 + ch * 16) = g.a2;
    if (t2 < 8) *(LASP f32x4_t*)(st + LS_GL + t2 * 16) = g.gl;
    *(LASP u32x4_t*)(st + LS_V + (t2 >> 3) * 192 + (t2 & 7) * 16) = g.v0; *(LASP u32x4_t*)(st + LS_V + (16 + (t2 >> 3)) * 192 + (t2 & 7) * 16) = g.v1;
}
__device__ __forceinline__ void gla_flush(const P& p, LASP unsigned char* lds, int b, int h, int dir, int step, int t2) {
    const int c = gdn_chunk(dir, step);
    const LASP unsigned char* ost = lds + GLA_OST + (dir * 2 + (step & 1)) * GLA_OST_BYTES;
    bf16* op = p.oc + ((size_t)dir * ROWS + (size_t)b * TOK + (size_t)c * GCH) * 256 + h * 64;
#pragma unroll
    for (int k = 0; k < 2; ++k) { const int idx = t2 + 128 * k, row = idx >> 3, ch = idx & 7; *(u32x4_t*)(op + (size_t)row * 256 + ch * 8) = *(const LASP u32x4_t*)(ost + row * 144 + ch * 16); }
}
#if TPROBE == 62
#define GLA_SYNC_C() do { unsigned long long t_ = __builtin_amdgcn_s_memrealtime(); __syncthreads(); if (bh == 0 && tid == 0) p.stats[2] += (float)(__builtin_amdgcn_s_memrealtime() - t_) * 0.01f; } while (0)
#define GLA_SYNC_L() __syncthreads()
#elif TPROBE == 63
#define GLA_SYNC_L() do { unsigned long long t_ = __builtin_amdgcn_s_memrealtime(); __syncthreads(); if (bh == 0 && tid == 256) p.stats[2] += (float)(__builtin_amdgcn_s_memrealtime() - t_) * 0.01f; } while (0)
#define GLA_SYNC_C() __syncthreads()
#else
#define GLA_SYNC_C() __syncthreads()
#define GLA_SYNC_L() __syncthreads()
#endif
__device__ void gla_scan_fast(const P& p, LASP unsigned char* lds, int bh) {
    const int tid = mk_tid();
    const int lane = tid & 63, wave = __builtin_amdgcn_readfirstlane(tid >> 6);
    const int h = bh & 3, b = bh >> 2;
    constexpr int NS = NCH;
    if (wave >= 4) {
        const int dir = (wave - 4) >> 1, t2 = tid & 127;
        LASP unsigned char* base = lds + dir * 2 * LS_BYTES;
        LSlot g0, g1, g2, g3;
        gla_issue(p, g0, b, h, dir, 0, t2); gla_issue(p, g1, b, h, dir, 1, t2); gla_issue(p, g2, b, h, dir, 2, t2); gla_issue(p, g3, b, h, dir, 3, t2);
        gla_write(base, g0, t2); gla_issue(p, g0, b, h, dir, 4, t2);
        __syncthreads();
#pragma unroll 1
        for (int s = 0; s < NS; s += 4) {
            if (s > 0) gla_flush(p, lds, b, h, dir, s - 1, t2);
            gla_write(base + ((s + 1) & 1) * LS_BYTES, g1, t2); gla_issue(p, g1, b, h, dir, min(s + 5, NS - 1), t2);
            GLA_SYNC_L();
            gla_flush(p, lds, b, h, dir, s, t2);
            gla_write(base + ((s + 2) & 1) * LS_BYTES, g2, t2); gla_issue(p, g2, b, h, dir, min(s + 6, NS - 1), t2);
            GLA_SYNC_L();
            gla_flush(p, lds, b, h, dir, s + 1, t2);
            gla_write(base + ((s + 3) & 1) * LS_BYTES, g3, t2); gla_issue(p, g3, b, h, dir, min(s + 7, NS - 1), t2);
            GLA_SYNC_L();
            gla_flush(p, lds, b, h, dir, s + 2, t2);
            gla_write(base + ((s + 4) & 1) * LS_BYTES, g0, t2); gla_issue(p, g0, b, h, dir, min(s + 8, NS - 1), t2);
            GLA_SYNC_L();
        }
        gla_flush(p, lds, b, h, dir, NS - 1, t2);
    } else {
        const int r = lane & 31, hh = lane >> 5, dir = wave >> 1, blk = wave & 1;
        LASP unsigned char* base = lds + dir * 2 * LS_BYTES;
        f32x16_t S;
#pragma unroll
        for (int i = 0; i < 16; ++i) S[i] = 0.f;
        __syncthreads();
        const int troff = (4 * hh + ((lane & 15) >> 2)) * 192 + (16 * ((lane >> 4) & 1) + 4 * (lane & 3)) * 2 + 64 * blk;
#define TRFRAG192(bs) __builtin_shufflevector(trd(bs), trd((bs) + 8 * 192), 0, 1, 2, 3, 4, 5, 6, 7)
#pragma unroll 1
        for (int s = 0; s < NS; ++s) {
            const LASP unsigned char* st = base + (s & 1) * LS_BYTES;
#if TPROBE == 64 || TPROBE == 65
            const unsigned long long ttop_ = __builtin_amdgcn_s_memrealtime();
            __builtin_amdgcn_sched_barrier(0);
#endif
            const LASP unsigned char* qp = st + LS_QP + r * 80 + hh * 16;
            const LASP unsigned char* am = st + LS_AM + r * 80 + hh * 16;
            const LASP unsigned char* kd = st + LS_KD + r * 80 + hh * 16;
            const bf16x8_t QP0 = *(const LASP bf16x8_t*)(qp), QP1 = *(const LASP bf16x8_t*)(qp + 32);
            const bf16x8_t AM0 = *(const LASP bf16x8_t*)(am), AM1 = *(const LASP bf16x8_t*)(am + 32);
            const bf16x8_t KD0 = *(const LASP bf16x8_t*)(kd), KD1 = *(const LASP bf16x8_t*)(kd + 32);
            const LASP unsigned char* vb = st + LS_V + troff;
            const bf16x8_t V0 = TRFRAG192(vb), V1 = TRFRAG192(vb + 16 * 192);
            const LASP float* glp = (const LASP float*)(st + LS_GL);
            const f32x4_t g0 = *(const LASP f32x4_t*)(glp + 4 * hh), g1 = *(const LASP f32x4_t*)(glp + 8 + 4 * hh), g2 = *(const LASP f32x4_t*)(glp + 16 + 4 * hh), g3 = *(const LASP f32x4_t*)(glp + 24 + 4 * hh);
            __builtin_amdgcn_sched_barrier(0);
#if TPROBE == 64 || TPROBE == 65
            asm volatile("s_waitcnt lgkmcnt(0)" ::: "memory");
            const unsigned long long tmid_ = __builtin_amdgcn_s_memrealtime();
            if (TPROBE == 64 && bh == 0 && tid == 0) p.stats[2] += (float)(tmid_ - ttop_) * 0.01f;
            __builtin_amdgcn_sched_barrier(0);
#endif
            const bf16x8_t Sb0 = PACK8(S, 0), Sb1 = PACK8(S, 1);
            f32x16_t oT;
#pragma unroll
            for (int i = 0; i < 16; ++i) oT[i] = 0.f;
            oT = MFMA32(V0, AM0, oT); oT = MFMA32(V1, AM1, oT);
            oT = MFMA32(Sb0, QP0, oT); oT = MFMA32(Sb1, QP1, oT);
            S[0] *= g0.x; S[1] *= g0.y; S[2] *= g0.z; S[3] *= g0.w; S[4] *= g1.x; S[5] *= g1.y; S[6] *= g1.z; S[7] *= g1.w;
            S[8] *= g2.x; S[9] *= g2.y; S[10] *= g2.z; S[11] *= g2.w; S[12] *= g3.x; S[13] *= g3.y; S[14] *= g3.z; S[15] *= g3.w;
            S = MFMA32(KD0, V0, S);
            S = MFMA32(KD1, V1, S);
            {
                LASP unsigned char* ost = lds + GLA_OST + (dir * 2 + (s & 1)) * GLA_OST_BYTES + r * 144 + (32 * blk + 4 * hh) * 2;
#pragma unroll
                for (int g = 0; g < 4; ++g) *(LASP u32x2_t*)(ost + 16 * g) = (u32x2_t){cvtpk(oT[4 * g], oT[4 * g + 1]), cvtpk(oT[4 * g + 2], oT[4 * g + 3])};
            }
#if TPROBE == 65
            __builtin_amdgcn_sched_barrier(0);
            asm volatile("s_nop 15\n\ts_nop 15" ::: "memory");
            if (bh == 0 && tid == 0) p.stats[2] += (float)(__builtin_amdgcn_s_memrealtime() - tmid_) * 0.01f;
#endif
            GLA_SYNC_C();
        }
    }
}


__device__ __forceinline__ void vt_item(const P& p, int it, int lane) {
    const int r = lane & 31, hh = lane >> 5;
    const int tb = it % NCH, bh = it / NCH, h = bh & 3, b = bh >> 2;
    const bf16* vp = p.rest + ((size_t)b * TOK + 32 * tb + r) * NREST + RC_BV + h * 64 + 32 * hh;
    bf16* op = p.vtb + ((size_t)bh * 64 + 32 * hh) * TOK + 32 * tb + perm16(r);
#pragma unroll
    for (int q = 0; q < 4; ++q) {
        const u32x4_t w = *(const u32x4_t*)(vp + 8 * q);
        op[(size_t)(8 * q + 0) * TOK] = (bf16)(w.x & 0xffffu); op[(size_t)(8 * q + 1) * TOK] = (bf16)(w.x >> 16);
        op[(size_t)(8 * q + 2) * TOK] = (bf16)(w.y & 0xffffu); op[(size_t)(8 * q + 3) * TOK] = (bf16)(w.y >> 16);
        op[(size_t)(8 * q + 4) * TOK] = (bf16)(w.z & 0xffffu); op[(size_t)(8 * q + 5) * TOK] = (bf16)(w.z >> 16);
        op[(size_t)(8 * q + 6) * TOK] = (bf16)(w.w & 0xffffu); op[(size_t)(8 * q + 7) * TOK] = (bf16)(w.w >> 16);
    }
}

__device__ __forceinline__ void na_item(const P& p, const LASP float* rpbL, int it, int lane) {
    const int r = lane & 31, hh = lane >> 5;
    int b, h, ry, qb; bool lat;
    if (it < 4096) { lat = true; qb = it & 1; ry = (it >> 1) & 63; h = (it >> 7) & 3; b = it >> 9; }
    else { const int j = it - 4096; lat = false; qb = j & 7; h = (j >> 3) & 3; b = j >> 5; ry = 0; }
    const size_t brow = (size_t)b * TOK;
    const int q0 = lat ? CTX + ry * 64 + qb * 32 : qb * 32;
    bf16* qp = p.rest + (brow + q0 + r) * NREST + RC_BQ + h * 64;
    bf16x8_t Qf0 = *(const bf16x8_t*)(qp + 8 * hh), Qf1 = *(const bf16x8_t*)(qp + 16 + 8 * hh), Qf2 = *(const bf16x8_t*)(qp + 32 + 8 * hh), Qf3 = *(const bf16x8_t*)(qp + 48 + 8 * hh);
    f32x16_t O0, O1;
#pragma unroll
    for (int i = 0; i < 16; ++i) { O0[i] = 0.f; O1[i] = 0.f; }
    float m = -1e30f, lsum = 0.f;
    const bf16* vtb = p.vtb + ((size_t)(b * 4 + h) * 64 + r) * TOK + 8 * hh;
    const int nkb = lat ? 24 : 8;
    const int c = qb * 32 + r, c0 = min(max(c - 8, 0), 48), r0 = min(max(ry - 4, 0), 56);
    constexpr float SC = 0.125f * 1.4426950408889634f;
    const bf16* kbase = p.rest + (brow + r) * NREST + RC_BK + h * 64 + 8 * hh;
    bf16x8_t nK0, nK1, nK2, nK3, nV00, nV01, nV10, nV11;
    {
        const bf16* kp = kbase;
        nK0 = *(const bf16x8_t*)(kp); nK1 = *(const bf16x8_t*)(kp + 16); nK2 = *(const bf16x8_t*)(kp + 32); nK3 = *(const bf16x8_t*)(kp + 48);
        nV00 = *(const bf16x8_t*)(vtb); nV01 = *(const bf16x8_t*)(vtb + 16); nV10 = *(const bf16x8_t*)(vtb + (size_t)32 * TOK); nV11 = *(const bf16x8_t*)(vtb + (size_t)32 * TOK + 16);
    }
#pragma unroll 1
    for (int kb = 0; kb < nkb; ++kb) {
        int ky = 0, cb = 0; const bool win = kb >= 8;
        if (win) { const int w = kb - 8; ky = r0 + (w >> 1); cb = w & 1; }
        const bf16x8_t K0 = nK0, K1 = nK1, K2 = nK2, K3 = nK3, V00 = nV00, V01 = nV01, V10 = nV10, V11 = nV11;
        {
            const int kn = min(kb + 1, nkb - 1);
            const int wn = kn - 8;
            const int t0n = kn < 8 ? kn * 32 : CTX + (r0 + (wn >> 1)) * 64 + (wn & 1) * 32;
            const bf16* kp = kbase + (size_t)t0n * NREST;
            nK0 = *(const bf16x8_t*)(kp); nK1 = *(const bf16x8_t*)(kp + 16); nK2 = *(const bf16x8_t*)(kp + 32); nK3 = *(const bf16x8_t*)(kp + 48);
            const bf16* vp = vtb + t0n;
            nV00 = *(const bf16x8_t*)(vp); nV01 = *(const bf16x8_t*)(vp + 16); nV10 = *(const bf16x8_t*)(vp + (size_t)32 * TOK); nV11 = *(const bf16x8_t*)(vp + (size_t)32 * TOK + 16);
        }
        f32x16_t S;
#pragma unroll
        for (int i = 0; i < 16; ++i) S[i] = 0.f;
        S = MFMA32(K0, Qf0, S); S = MFMA32(K1, Qf1, S); S = MFMA32(K2, Qf2, S); S = MFMA32(K3, Qf3, S);
        float bm = -1e30f;
        if (win) {
            const LASP float* rb = rpbL + (h * 15 + (ky - ry + 7)) * 31 + 15 - c;
#pragma unroll
            for (int i = 0; i < 16; ++i) {
                const int kc = cb * 32 + crow(i, hh);
                const bool valid = (kc >= c0) && (kc < c0 + 16);
                const float bias = rb[valid ? kc : c];
                S[i] = valid ? S[i] * SC + bias : -1e30f;
                bm = fmaxf(bm, S[i]);
            }
        } else {
#pragma unroll
            for (int i = 0; i < 16; ++i) { S[i] *= SC; bm = fmaxf(bm, S[i]); }
        }
        bm = fmaxf(bm, __shfl_xor(bm, 32));
        const float mn = fmaxf(m, bm);
        const float alpha = __builtin_amdgcn_exp2f(m - mn);
        m = mn;
        float ps = 0.f;
#pragma unroll
        for (int i = 0; i < 16; ++i) { S[i] = __builtin_amdgcn_exp2f(S[i] - mn); ps += S[i]; }
        lsum = lsum * alpha + ps;
#pragma unroll
        for (int i = 0; i < 16; ++i) { O0[i] *= alpha; O1[i] *= alpha; }
        const bf16x8_t Pb0 = PACK8(S, 0), Pb1 = PACK8(S, 1);
        O0 = MFMA32(V00, Pb0, O0); O0 = MFMA32(V01, Pb1, O0);
        O1 = MFMA32(V10, Pb0, O1); O1 = MFMA32(V11, Pb1, O1);
    }
    const float inv = 1.f / (lsum + __shfl_xor(lsum, 32));
    bf16* op = qp + 4 * hh;
#pragma unroll
    for (int g = 0; g < 4; ++g) {
        *(u32x2_t*)(op + 8 * g) = (u32x2_t){cvtpk(O0[4 * g] * inv, O0[4 * g + 1] * inv), cvtpk(O0[4 * g + 2] * inv, O0[4 * g + 3] * inv)};
        *(u32x2_t*)(op + 32 + 8 * g) = (u32x2_t){cvtpk(O1[4 * g] * inv, O1[4 * g + 1] * inv), cvtpk(O1[4 * g + 2] * inv, O1[4 * g + 3] * inv)};
    }
}

__device__ void ph_prep(const P& p, LASP unsigned char* lds, int l, int bid, int nblk) {
    const int tid = mk_tid();
    LASP float* cstab = (LASP float*)(lds + 131072);
    {
        const int pos = tid >> 3, f = tid & 7;
        const float ang = (float)pos * powf(10000.f, -(float)f / 8.f);
        cstab[tid * 2] = cosf(ang); cstab[tid * 2 + 1] = sinf(ang);
    }
    __syncthreads();
    ph_gdnprep(p, lds, l, bid, nblk, tid);
    const int lane = tid & 63, wave = tid >> 6;
    for (int it = (nblk - 1 - bid) * NWAVES + wave; it < BATCH * 4 * NCH; it += nblk * NWAVES) gla_prep_item(p, lds + wave * 16384, cstab, l, it, lane);
    for (int it = bid * NWAVES + wave; it < BATCH * 4 * NCH; it += nblk * NWAVES) vt_item(p, it, lane);
}


__device__ void ph_mix(const P& p, LASP unsigned char* lds, int l, int bid, int nblk) {
    constexpr int NGDN = BATCH * 4 * 2;
    constexpr int NGLA = BATCH * 4;
    if (bid < NGDN) { gdn_scan_fast(p, lds, bid); return; }
    if (bid < NGDN + NGLA) { gla_scan_fast(p, lds, bid - NGDN); return; }
    const int tid = mk_tid();
    const int lane = tid & 63, wave = tid >> 6;
    LASP float* rpbL = (LASP float*)lds;
    for (int i = tid; i < 4 * 15 * 31; i += NTHREADS) rpbL[i] = p.rpb[(size_t)l * 4 * 15 * 31 + i] * 1.4426950408889634f;
    __syncthreads();
    const int total = 4096 + (l == 0 ? 256 : 0);
    for (int it = (bid - NGDN - NGLA) * NWAVES + wave; it < total; it += (nblk - NGDN - NGLA) * NWAVES) na_item(p, rpbL, it, lane);
}

__device__ void ph_gate(const P& p, int l, int bid, int nblk) {
    const int tid = mk_tid();
    const int tq = tid & 127, rsub = tid >> 7;
    const int kind = tq < 64 ? 0 : (tq < 96 ? 1 : 2);
    const int cb = kind == 0 ? tq * 8 : (kind == 1 ? (tq - 64) * 8 : (tq - 96) * 8);
    const int zoff = kind == 0 ? RC_AZ + cb : (kind == 1 ? RC_BZ + cb : RC_CZ + cb);
    const int oc = kind == 0 ? cb : (kind == 1 ? 512 + cb : 768 + cb);
    float nw[8];
#pragma unroll
    for (int e = 0; e < 8; ++e) nw[e] = kind == 0 ? p.gdn_norm[l * 128 + ((cb + e) & 127)] : (kind == 2 ? p.gla_norm[l * 64 + ((cb + e) & 63)] : 1.f);
    for (int r0 = bid * 16; r0 < ROWS; r0 += nblk * 16) {
        uint4 a[4], bb[4], zz[4];
#pragma unroll
        for (int j = 0; j < 4; ++j) {
            const size_t r = (size_t)(r0 + rsub + 4 * j);
            const bf16* pr = p.rest + r * NREST;
            zz[j] = *(const uint4*)(pr + zoff);
            if (kind == 0) { a[j] = *(const uint4*)(p.oa + r * 512 + cb); bb[j] = *(const uint4*)(p.oa + ((size_t)ROWS + r) * 512 + cb); }
            else if (kind == 1) { a[j] = *(const uint4*)(pr + RC_BQ + cb); bb[j] = make_uint4(0, 0, 0, 0); }
            else { a[j] = *(const uint4*)(p.oc + r * 256 + cb); bb[j] = *(const uint4*)(p.oc + ((size_t)ROWS + r) * 256 + cb); }
        }
#pragma unroll
        for (int j = 0; j < 4; ++j) {
            float fa[8], fb[8], z[8], o[8];
            unpack8(a[j], fa); unpack8(bb[j], fb); unpack8(zz[j], z);
            float ss = 0.f;
#pragma unroll
            for (int e = 0; e < 8; ++e) { o[e] = fa[e] + fb[e]; ss += o[e] * o[e]; }
            float rs = 1.f;
            if (kind == 0) {
#pragma unroll
                for (int m = 8; m > 0; m >>= 1) ss += __shfl_xor(ss, m);
                rs = __builtin_amdgcn_rsqf(ss * (1.f / 128.f) + 1e-6f);
            } else if (kind == 2) {
#pragma unroll
                for (int m = 4; m > 0; m >>= 1) ss += __shfl_xor(ss, m);
                rs = __builtin_amdgcn_rsqf(ss * (1.f / 64.f) + 1e-6f);
            }
            float res[8];
#pragma unroll
            for (int e = 0; e < 8; ++e) res[e] = o[e] * rs * nw[e] * silu_f(z[e]);
            uint4 w; w.x = pk2(res[0], res[1]); w.y = pk2(res[2], res[3]); w.z = pk2(res[4], res[5]); w.w = pk2(res[6], res[7]);
            *(uint4*)(p.mix + (size_t)(r0 + rsub + 4 * j) * D + oc) = w;
        }
    }
}

#if PROBE
__device__ void gdn_scan_naive(const P& p, LASP float* sm, int l, int b, int hp, bf16* nb) {
    const int tid = mk_tid();
    LASP float* skq = sm;
    LASP float* sv = sm + 4 * 16 * 256;
    LASP float* sg = sv + 4 * 16 * 128;
    LASP float* sb = sg + 64;
    const int sub = tid >> 7, col = tid & 127, dir = sub & 1, h = hp * 2 + (sub >> 1);
    float S[128];
#pragma unroll
    for (int i = 0; i < 128; ++i) S[i] = 0.f;
    for (int s0 = 0; s0 < TOK; s0 += 16) {
        __syncthreads();
        for (int i = tid; i < 4 * 16 * 48; i += NTHREADS) {
            const int su = i / (16 * 48), rem = i % (16 * 48), j = rem / 48, chunk = rem % 48;
            const int sd = su & 1, hh = hp * 2 + (su >> 1);
            const int t = tok_of(sd, s0 + j);
            const size_t row = (size_t)b * TOK + t;
            const int part = chunk >> 4, c8 = chunk & 15;
            const uint4 w = *(const uint4*)(p.qkvn + row * NRAW + part * 512 + hh * 128 + c8 * 8);
            float f[8]; unpack8(w, f);
            LASP float* dst = (part < 2) ? skq + (su * 16 + j) * 256 + part * 128 + c8 * 8 : sv + (su * 16 + j) * 128 + c8 * 8;
#pragma unroll
            for (int e = 0; e < 8; ++e) dst[e] = f[e];
        }
        if (tid < 64) {
            const int su = tid >> 4, j = tid & 15, sd = su & 1, hh = hp * 2 + (su >> 1);
            const int t = tok_of(sd, s0 + j);
            const bf16* ab = p.rest + ((size_t)b * TOK + t) * NREST + RC_AB;
            const float a = bf2f(ab[sd * 4 + hh]) + p.dt_bias[(l * 2 + sd) * 4 + hh];
            const float sp = fmaxf(a, 0.f) + log1pf(expf(-fabsf(a)));
            const float g = -expf(p.a_log[(l * 2 + sd) * 4 + hh]) * sp;
            sg[su * 16 + j] = expf(g);
            const float bx = bf2f(ab[(2 + sd) * 4 + hh]);
            sb[su * 16 + j] = 1.f / (1.f + expf(-bx));
        }
        __syncthreads();
#pragma unroll 1
        for (int j = 0; j < 16; ++j) {
            const LASP float* qp = skq + (sub * 16 + j) * 256;
            const LASP float* kp = qp + 128;
            const float dec = sg[sub * 16 + j], bt = sb[sub * 16 + j];
            const float v = sv[(sub * 16 + j) * 128 + col];
            float d0 = 0.f, d1 = 0.f, d2 = 0.f, d3 = 0.f;
#pragma unroll
            for (int k4 = 0; k4 < 32; ++k4) {
                const f32x4_t kv = *(const LASP f32x4_t*)(kp + k4 * 4);
                d0 += S[k4 * 4] * kv.x; d1 += S[k4 * 4 + 1] * kv.y; d2 += S[k4 * 4 + 2] * kv.z; d3 += S[k4 * 4 + 3] * kv.w;
                if ((k4 & 7) == 7) __builtin_amdgcn_sched_barrier(0);
            }
            const float dot = (d0 + d1) + (d2 + d3);
            const float vn = bt * (v - dec * dot);
            float o0 = 0.f, o1 = 0.f, o2 = 0.f, o3 = 0.f;
#pragma unroll
            for (int k4 = 0; k4 < 32; ++k4) {
                const f32x4_t kv = *(const LASP f32x4_t*)(kp + k4 * 4);
                const f32x4_t qv = *(const LASP f32x4_t*)(qp + k4 * 4);
                S[k4 * 4] = dec * S[k4 * 4] + kv.x * vn; o0 += S[k4 * 4] * qv.x;
                S[k4 * 4 + 1] = dec * S[k4 * 4 + 1] + kv.y * vn; o1 += S[k4 * 4 + 1] * qv.y;
                S[k4 * 4 + 2] = dec * S[k4 * 4 + 2] + kv.z * vn; o2 += S[k4 * 4 + 2] * qv.z;
                S[k4 * 4 + 3] = dec * S[k4 * 4 + 3] + kv.w * vn; o3 += S[k4 * 4 + 3] * qv.w;
                if ((k4 & 3) == 3) __builtin_amdgcn_sched_barrier(0);
            }
            const int t = tok_of(dir, s0 + j);
            nb[((size_t)dir * TOK + t) * 256 + (h & 1) * 128 + col] = f2bf((o0 + o1) + (o2 + o3));
        }
    }
    __syncthreads();
}

__device__ void gla_scan_naive(const P& p, LASP float* sm, int l, int b, bf16* nb) {
    const int tid = mk_tid();
    LASP float* sq = sm;
    LASP float* sv = sm + 8 * 16 * 96;
    const int grp = tid >> 6, lane = tid & 63, h = grp >> 1, dir = grp & 1;
    const int d = lane & 31, par = lane >> 5;
    float w2c[16];
#pragma unroll
    for (int j = 0; j < 16; ++j) w2c[j] = p.gla_w2[((size_t)(l * 2 + dir) * 16 + j) * 128 + h * 32 + d];
    const float b2v = p.gla_b2[(l * 2 + dir) * 128 + h * 32 + d];
    const int dd = d & 15, f = dd & 7;
    const float inv = powf(10000.f, -(float)f / 8.f);
    const int pd = dd < 8 ? d + 8 : d - 8;
    float S[32];
#pragma unroll
    for (int i = 0; i < 32; ++i) S[i] = 0.f;
    for (int s0 = 0; s0 < TOK; s0 += 16) {
        __syncthreads();
#pragma unroll 1
        for (int jj = 0; jj < 8; ++jj) {
            const int j = par + 2 * jj;
            const int t = tok_of(dir, s0 + j);
            const bf16* base = p.rest + ((size_t)b * TOK + t) * NREST;
            float qv = bf2f(base[RC_CQ + h * 32 + d]), kv = bf2f(base[RC_CK + h * 32 + d]);
            if (t >= CTX) {
                const int pidx = t - CTX;
                const int pos = d < 16 ? (pidx >> 6) : (pidx & 63);
                const float ang = (float)pos * inv;
                const float cs = cosf(ang), sn = sinf(ang);
                const float qp = bf2f(base[RC_CQ + h * 32 + pd]), kp = bf2f(base[RC_CK + h * 32 + pd]);
                if (dd < 8) { qv = qv * cs - qp * sn; kv = kv * cs - kp * sn; }
                else { qv = qp * sn + qv * cs; kv = kp * sn + kv * cs; }
            }
            qv *= 0.17677669529663687f;
            float xg = b2v;
#pragma unroll
            for (int jr = 0; jr < 16; ++jr) xg += bf2f(base[RC_CR + dir * 16 + jr]) * w2c[jr];
            const float ls = fminf(xg, 0.f) - log1pf(expf(-fabsf(xg)));
            LASP float* dst = sq + (grp * 16 + j) * 96;
            dst[d] = qv; dst[32 + d] = kv; dst[64 + d] = expf(ls * (1.f / 16.f));
        }
        for (int i = lane; i < 16 * 64; i += 64) {
            const int j = i >> 6, c = i & 63;
            const int t = tok_of(dir, s0 + j);
            sv[(grp * 16 + j) * 64 + c] = bf2f(p.rest[((size_t)b * TOK + t) * NREST + RC_CV + h * 64 + c]);
        }
        __syncthreads();
#pragma unroll 1
        for (int j = 0; j < 16; ++j) {
            const LASP float* qp = sq + (grp * 16 + j) * 96;
            const LASP float* kp = qp + 32;
            const LASP float* dp = qp + 64;
            const float v = sv[(grp * 16 + j) * 64 + lane];
            float o0 = 0.f, o1 = 0.f;
#pragma unroll
            for (int e = 0; e < 32; e += 2) {
                S[e] = dp[e] * S[e] + kp[e] * v; o0 += S[e] * qp[e];
                S[e + 1] = dp[e + 1] * S[e + 1] + kp[e + 1] * v; o1 += S[e + 1] * qp[e + 1];
            }
            const int t = tok_of(dir, s0 + j);
            nb[((size_t)dir * TOK + t) * 256 + h * 64 + lane] = f2bf(o0 + o1);
        }
    }
    __syncthreads();
}

__device__ void na_query_naive(const P& p, LASP float* sm, int l, int b, int t0, bf16* nb) {
    const int tid = mk_tid();
    const int wave = tid >> 6, lane = tid & 63, h = wave & 3, t = t0 + (wave >> 2);
    LASP float* pw = sm + wave * 384;
    const size_t rowq = (size_t)b * TOK + t;
    float qv[64];
    {
        const bf16* qs = p.rest + rowq * NREST + RC_BQ + h * 64;
#pragma unroll
        for (int i = 0; i < 8; ++i) {
            float f[8]; unpack8(*(const uint4*)(qs + i * 8), f);
#pragma unroll
            for (int e = 0; e < 8; ++e) qv[i * 8 + e] = f[e] * 0.125f;
        }
    }
    const bool lat = t >= CTX;
    const int nk = lat ? 384 : 256;
    int r = 0, c = 0, r0 = 0, c0 = 0;
    if (lat) { int pi = t - CTX; r = pi >> 6; c = pi & 63; r0 = min(max(r - 4, 0), 56); c0 = min(max(c - 8, 0), 48); }
    float m = -1e30f;
    __syncthreads();
#pragma unroll 1
    for (int j = 0; j < 6; ++j) {
        const int idx = lane + 64 * j;
        float s = -1e30f;
        if (idx < nk) {
            int tk; float bias = 0.f;
            if (lat && idx < 128) {
                const int i = idx >> 4, kc = c0 + (idx & 15);
                tk = CTX + (r0 + i) * 64 + kc;
                bias = p.rpb[((size_t)(l * 4 + h) * 15 + (r0 + i - r + 7)) * 31 + (kc - c + 15)];
            } else tk = lat ? idx - 128 : idx;
            const bf16* ks = p.rest + ((size_t)b * TOK + tk) * NREST + RC_BK + h * 64;
            float d0 = 0.f, d1 = 0.f;
#pragma unroll
            for (int i = 0; i < 8; ++i) {
                float f[8]; unpack8(*(const uint4*)(ks + i * 8), f);
#pragma unroll
                for (int e = 0; e < 8; e += 2) { d0 += qv[i * 8 + e] * f[e]; d1 += qv[i * 8 + e + 1] * f[e + 1]; }
            }
            s = d0 + d1 + bias;
        }
        pw[idx] = s;
        m = fmaxf(m, s);
    }
    m = wave_max(m);
    float sum = 0.f;
#pragma unroll 1
    for (int j = 0; j < 6; ++j) { const float e = expf(pw[lane + 64 * j] - m); pw[lane + 64 * j] = e; sum += e; }
    sum = wave_sum(sum);
    const float inv = 1.f / sum;
    __syncthreads();
    float o0 = 0.f, o1 = 0.f;
    for (int idx = 0; idx < nk; idx += 2) {
        int tk0;
        if (lat && idx < 128) tk0 = CTX + (r0 + (idx >> 4)) * 64 + c0 + (idx & 15);
        else tk0 = lat ? idx - 128 : idx;
        o0 += pw[idx] * bf2f(p.rest[((size_t)b * TOK + tk0) * NREST + RC_BV + h * 64 + lane]);
        o1 += pw[idx + 1] * bf2f(p.rest[((size_t)b * TOK + tk0 + 1) * NREST + RC_BV + h * 64 + lane]);
    }
    nb[(size_t)t * 256 + h * 64 + lane] = f2bf((o0 + o1) * inv);
}


__device__ void ph_probe_naive(const P& p, LASP float* sm, int l, int bid, int nblk) {
    bf16* nb = (bf16*)p.xc1;
    if (PROBE == 1) { if (bid == 0) gdn_scan_naive(p, sm, l, 0, 0, nb); }
    else if (PROBE == 3) { if (bid == 0) gla_scan_naive(p, sm, l, 0, nb); }
    else { for (int it = bid; it < TOK / 2; it += nblk) na_query_naive(p, sm, l, 0, it * 2, nb); }
}
__device__ void ph_probe_cmp(const P& p, int bid, int nblk) {
    const int tid = mk_tid();
    const bf16* nb = (const bf16*)p.xc1;
    float md = 0.f, mr = 0.f;
    const int n = (PROBE == 2) ? TOK * 256 : 2 * TOK * 256;
    for (int i = bid * NTHREADS + tid; i < n; i += nblk * NTHREADS) {
        float a, r = bf2f(nb[i]);
        if (PROBE == 1) { const int dir = i / (TOK * 256), rem = i % (TOK * 256), t = rem >> 8, c = rem & 255; a = bf2f(p.oa[((size_t)dir * ROWS + t) * 512 + c]); }
        else if (PROBE == 3) { const int dir = i / (TOK * 256), rem = i % (TOK * 256); a = bf2f(p.oc[(size_t)dir * ROWS * 256 + rem]); }
        else { const int t = i >> 8, c = i & 255; a = bf2f(p.rest[(size_t)t * NREST + RC_BQ + c]); }
        md = fmaxf(md, fabsf(a - r)); mr = fmaxf(mr, fabsf(r));
    }
    md = wave_max(md); mr = wave_max(mr);
    if ((tid & 63) == 0) { atomicMax((unsigned*)p.stats, __float_as_uint(md)); atomicMax((unsigned*)p.stats + 1, __float_as_uint(mr)); }
}
#endif

#define XB_TMO      128
#define XB_XCNT(j)  (256  + 64 * (j))
#define XB_XSUB(j)  (1280 + 64 * (j))
#define XB_XGEN(j)  (2304 + 64 * (j))
#define XB_TOP      3328
#define XB_TOPGEN   3392
#define XCD_BAR_WORDS 3456
#define XB_SPIN_CAP (1u << 18)

__device__ __forceinline__ unsigned xb_ld(unsigned* p)              { return __hip_atomic_load(p, __ATOMIC_RELAXED, __HIP_MEMORY_SCOPE_AGENT); }
__device__ __forceinline__ unsigned xb_add(unsigned* p, unsigned v) { return __hip_atomic_fetch_add(p, v, __ATOMIC_RELAXED, __HIP_MEMORY_SCOPE_AGENT); }
__device__ __forceinline__ unsigned xb_xcc_id() { return (unsigned)__builtin_amdgcn_s_getreg((3 << 11) | 20) & 0xFu; }
#define XB_SPIN(cond, bar) do { unsigned _sp = 0; while (cond) { __builtin_amdgcn_s_sleep(1); \
    if ((++_sp & 255u) == 0u) { if (xb_ld(&(bar)[XB_TMO])) break; if (_sp > XB_SPIN_CAP) { atomicAdd(&(bar)[XB_TMO], 1u); break; } } } } while (0)

struct XcdBarrier {
    unsigned* bar; unsigned x;
    volatile LASP unsigned* st;
};

__device__ __forceinline__ XcdBarrier xcd_barrier_post(unsigned* bar, volatile LASP unsigned* st) {
    XcdBarrier b; b.bar = bar; b.x = xb_xcc_id(); b.st = st;
    if ((int)threadIdx.x == 0) (void)xb_add(&bar[XB_XCNT(b.x)], 1u);
    return b;
}
__device__ __forceinline__ void xcd_barrier_complete(unsigned* bar, unsigned x, unsigned& nloc, unsigned& nx) {
    const unsigned G = gridDim.x * gridDim.y * gridDim.z;
    unsigned sum, cnt, mine, sp = 0u;
    for (;;) {
        sum = 0u; cnt = 0u; mine = 0u;
#pragma unroll
        for (unsigned j = 0; j < 16; ++j) { const unsigned c = xb_ld(&bar[XB_XCNT(j)]); sum += c; cnt += (c > 0u) ? 1u : 0u; mine = (j == x) ? c : mine; }
        if (sum == G) break;
        __builtin_amdgcn_s_sleep(1);
        if ((++sp & 255u) == 0u) { if (xb_ld(&bar[XB_TMO])) break; if (sp > XB_SPIN_CAP) { atomicAdd(&bar[XB_TMO], 1u); break; } }
    }
    nloc = mine > 0u ? mine : 1u; nx = cnt > 0u ? cnt : 1u;
}

__device__ __forceinline__ void xcd_barrier(const XcdBarrier& b) {
    asm volatile("s_waitcnt vmcnt(0)" ::: "memory");
    __syncthreads();
    if ((int)threadIdx.x == 0) {
        unsigned* bar = b.bar;
        __builtin_amdgcn_s_waitcnt(0);
        unsigned nloc = b.st[0], nx = b.st[1];
        if (nloc == 0u) { xcd_barrier_complete(bar, b.x, nloc, nx); b.st[0] = nloc; b.st[1] = nx; }
        const unsigned old = xb_add(&bar[XB_XSUB(b.x)], 1u);
        const unsigned gen = old / nloc;
        if (old + 1u == (gen + 1u) * nloc) {
            __builtin_amdgcn_fence(__ATOMIC_RELEASE, "agent");
            asm volatile("s_waitcnt vmcnt(0)" ::: "memory");
            const unsigned og = xb_add(&bar[XB_TOP], 1u);
            const unsigned tg = og / nx;
            if (og + 1u == (tg + 1u) * nx) xb_add(&bar[XB_TOPGEN], 1u);
            else XB_SPIN(xb_ld(&bar[XB_TOPGEN]) == tg, bar);
            __builtin_amdgcn_fence(__ATOMIC_ACQUIRE, "agent");
            xb_add(&bar[XB_XGEN(b.x)], 1u);
            asm volatile("s_waitcnt vmcnt(0)" ::: "memory");
        } else {
            XB_SPIN(xb_ld(&bar[XB_XGEN(b.x)]) == gen, bar);
            __builtin_amdgcn_fence(__ATOMIC_ACQUIRE, "agent");
            asm volatile("s_waitcnt vmcnt(0)" ::: "memory");
        }
    }
    __syncthreads();
}


constexpr int NSTEP = 1 + 2 * 7 + 1;
__global__ void __launch_bounds__(NTHREADS, 2) k_mega(P p) {
    extern __shared__ __attribute__((aligned(16))) unsigned char lds_raw[];
    LASP unsigned char* lds = (LASP unsigned char*)lds_raw;
    cg::grid_group grid = cg::this_grid();
    const int bid = blockIdx.x, nblk = gridDim.x;
    volatile LASP unsigned* bst = (volatile LASP unsigned*)(lds + LDS_BYTES - 64);
    if (threadIdx.x < 16) bst[threadIdx.x] = 0u;
    __syncthreads();
    const XcdBarrier bar = xcd_barrier_post((unsigned*)p.ctl, bst);
#pragma unroll 1
    for (int step = 0; step < NSTEP; ++step) {
        int ph = 0, l = 0;
        if (step > 0) { const int s1 = step - 1; l = s1 / 7; ph = 1 + s1 % 7; }
#if TPROBE >= 0
        unsigned long long tp0 = 0;
        if (bid == 0 && threadIdx.x == 0) { if (step == 0) p.stats[2] = 0.f; tp0 = __builtin_amdgcn_s_memrealtime(); }
#endif
        if (ph == 0) ph_prologue(p, lds, bid, nblk);
        else if (ph == 1) ph_lnpass(p, l, bid, nblk);
        else if (l < 2) {
            if (ph == 2) {
                pg8::Gemm g{p.ml, p.wi_t + (size_t)l * NPAD * D, ROWS, NPAD, D}; pg8::StaticOrder S; S.init(ROWS, NPAD, nblk, bid);
                EpiProj E{p.raw, p.rest};
                pg8::gemm_phase<EpiProj, pg8::StaticOrder, true, true>(lds, g, S, E);
            } else if (ph == 3) ph_conv(p, l, bid, nblk);
            else if (ph == 4) ph_prep(p, lds, l, bid, nblk);
            else if (ph == 5) {
#if PROBE
                if (l == 0) { ph_probe_naive(p, (LASP float*)lds, l, bid, nblk); xcd_barrier(bar); }
#endif
#if TPROBE >= 50
                unsigned long long tr0 = 0;
                const bool inrole = TPROBE == 50 ? (bid < 64) : (TPROBE == 51 ? (bid >= 64 && bid < 96) : (bid >= 96));
                const float rscale = TPROBE == 50 ? (1.f / 64.f) : (TPROBE == 51 ? (1.f / 32.f) : (1.f / 160.f));
                if (inrole && threadIdx.x == 0) tr0 = __builtin_amdgcn_s_memrealtime();
#endif
                ph_mix(p, lds, l, bid, nblk);
#if TPROBE >= 50
                if (inrole && threadIdx.x == 0) atomicAdd(&p.stats[2], (float)(__builtin_amdgcn_s_memrealtime() - tr0) * 0.01f * rscale);
#endif
#if PROBE
                if (l == 0) { xcd_barrier(bar); ph_probe_cmp(p, bid, nblk); }
#endif
            }
            else if (ph == 6) ph_gate(p, l, bid, nblk);
            else if (ph == 7) {
                pg8::Gemm g{p.mix, p.wo_t + (size_t)l * D * D, ROWS, D, D}; pg8::StaticOrder S; S.init(ROWS, D, nblk, bid);
                EpiRes E{l == 0 ? p.x : p.out, p.ctx, p.out, p.xc1, p.mods, l};
                pg8::gemm_phase<EpiRes, pg8::StaticOrder, true, true>(lds, g, S, E);
            }
        }
        if (step == 0) grid.sync(); else xcd_barrier(bar);
#if TPROBE >= 0
        if (bid == 0 && threadIdx.x == 0 && ph == TPROBE) p.stats[2] += (float)(__builtin_amdgcn_s_memrealtime() - tp0) * 0.01f;
#endif
    }
}

extern "C" void kernel_launch(void* const* d_in, const int* in_sizes, int n_in, void* d_out, int out_size, void* d_ws, size_t ws_size,
                              hipStream_t stream) {
    P p{};
    p.x = (const float*)d_in[0]; p.c = (const float*)d_in[1]; p.ctx = (const float*)d_in[2]; p.c_ctx = (const float*)d_in[3];
    p.w_mod = (const float*)d_in[4]; p.b_mod = (const float*)d_in[5]; p.w_in = (const float*)d_in[6]; p.conv_w = (const float*)d_in[7];
    p.a_log = (const float*)d_in[8]; p.dt_bias = (const float*)d_in[9]; p.gdn_norm = (const float*)d_in[10]; p.rpb = (const float*)d_in[11];
    p.gla_w2 = (const float*)d_in[12]; p.gla_b2 = (const float*)d_in[13]; p.gla_norm = (const float*)d_in[14]; p.w_out = (const float*)d_in[15];
    p.ln_g = (const float*)d_in[16]; p.ln_b = (const float*)d_in[17];
    p.out = (float*)d_out;
    unsigned char* w = (unsigned char*)d_ws;
    size_t off = 0;
    auto take = [&](size_t bytes) { unsigned char* r = w + off; off += (bytes + 255) & ~(size_t)255; return r; };
    p.ctl = (unsigned*)take(16384);
    p.mods = (float*)take((size_t)2 * 9 * 3072 * 4);
    p.xc1 = (float*)take((size_t)BATCH * CTX * D * 4);
    p.wi_t = (bf16*)take((size_t)2 * NPAD * D * 2);
    p.wo_t = (bf16*)take((size_t)2 * D * D * 2);
    p.rest = (bf16*)take((size_t)ROWS * NREST * 2);
    p.raw = (bf16*)take((size_t)ROWS * NRAW * 2);
    p.qkvn = (bf16*)take((size_t)ROWS * NRAW * 2);
    p.mix = p.qkvn;
    p.oa = (bf16*)take((size_t)2 * ROWS * 512 * 2);
    p.oc = (bf16*)take((size_t)2 * ROWS * 256 * 2);
    p.ml = p.oa;
    p.vtb = (bf16*)take((size_t)ROWS * 256 * 2);
    p.stats = (float*)take(256);
    static int grid_blocks = 0;
    if (!grid_blocks) {
        if (off > ws_size) { fprintf(stderr, "workspace too small: need %zu have %zu\n", off, ws_size); grid_blocks = -1; return; }
        int dev = 0, cus = 0, per_cu = 0;
        hipGetDevice(&dev);
        hipDeviceGetAttribute(&cus, hipDeviceAttributeMultiprocessorCount, dev);
        if (hipFuncSetAttribute((const void*)k_mega, hipFuncAttributeMaxDynamicSharedMemorySize, LDS_BYTES) != hipSuccess) { fprintf(stderr, "hipFuncSetAttribute failed\n"); grid_blocks = -1; return; }
        hipOccupancyMaxActiveBlocksPerMultiprocessor(&per_cu, (const void*)k_mega, NTHREADS, LDS_BYTES);
        if (per_cu < 1) { fprintf(stderr, "occupancy query says %d blocks per CU\n", per_cu); grid_blocks = -1; return; }
        grid_blocks = cus;
    }
    if (grid_blocks < 0) return;
    if (hipMemsetAsync(p.ctl, 0, 16384, stream) != hipSuccess) { fprintf(stderr, "memset of the barrier words failed\n"); return; }
    void* args[] = {&p};
    hipError_t e = hipLaunchCooperativeKernel((void*)k_mega, dim3(grid_blocks), dim3(NTHREADS), args, LDS_BYTES, stream);
    if (e != hipSuccess) fprintf(stderr, "cooperative launch failed: %s (grid %d)\n", hipGetErrorString(e), grid_blocks);
}
```

```cpp
#include <hip/hip_runtime.h>
#include <hip/hip_cooperative_groups.h>
#include <cstdio>
#include <cstdint>
namespace cg = cooperative_groups;
#ifndef PROBE
#define PROBE 0
#endif
#ifndef TPROBE
#define TPROBE -1
#endif
#ifndef TSHIFT
#define TSHIFT 0
#endif

constexpr int D = 1024, BATCH = 8, SEQ = 4096, CTX = 256, TOK = 4352, NPROJ = 3888;
constexpr int ROWS = BATCH * TOK;
constexpr int NRAW = 1536, NREST = 2096, NPAD = 4096;
constexpr int NTHREADS = 512, NWAVES = 8;
constexpr int LDS_BYTES = 147456;
constexpr float ALPHA = 1.4142135623730951f;
constexpr int RC_AB = 0, RC_AZ = 16, RC_BQ = 528, RC_BV = 784, RC_BZ = 1040, RC_CQ = 1296, RC_CK = 1424, RC_CV = 1552, RC_CR = 1808, RC_CZ = 1840;
constexpr int PC_BK = 2320, PC_BV = 2576;

typedef unsigned short bf16;
typedef float f32x4_t __attribute__((ext_vector_type(4)));

struct P {
    const float *x, *c, *ctx, *c_ctx, *w_mod, *b_mod, *w_in, *conv_w, *a_log, *dt_bias, *gdn_norm, *rpb,
        *gla_w2, *gla_b2, *gla_norm, *w_out, *ln_g, *ln_b;
    float* out;
    float *mods, *xc1, *stats; unsigned* ctl;
    bf16 *wi_t, *wo_t, *rest, *raw, *qkvn, *mix, *ml, *oa, *oc, *vf, *kf;
};

__device__ __forceinline__ float bf2f(unsigned short u) { return __uint_as_float((unsigned)u << 16); }
__device__ __forceinline__ unsigned short f2bf(float f) { unsigned u = __float_as_uint(f); return (unsigned short)((u + 0x7fffu + ((u >> 16) & 1u)) >> 16); }
__device__ __forceinline__ unsigned pk2(float lo, float hi) { return (unsigned)f2bf(lo) | ((unsigned)f2bf(hi) << 16); }
__device__ __forceinline__ float bflo(unsigned w) { return __uint_as_float(w << 16); }
__device__ __forceinline__ float bfhi(unsigned w) { return __uint_as_float(w & 0xffff0000u); }
__device__ __forceinline__ void unpack8(uint4 w, float* f) {
    f[0] = bflo(w.x); f[1] = bfhi(w.x); f[2] = bflo(w.y); f[3] = bfhi(w.y); f[4] = bflo(w.z); f[5] = bfhi(w.z); f[6] = bflo(w.w); f[7] = bfhi(w.w);
}
__device__ __forceinline__ float silu_f(float x) { return x * __builtin_amdgcn_rcpf(1.f + __builtin_amdgcn_exp2f(-1.4426950408889634f * x)); }
__device__ __forceinline__ float wave_sum(float v) {
#pragma unroll
    for (int o = 32; o > 0; o >>= 1) v += __shfl_xor(v, o);
    return v;
}
__device__ __forceinline__ float wave_max(float v) {
#pragma unroll
    for (int o = 32; o > 0; o >>= 1) v = fmaxf(v, __shfl_xor(v, o));
    return v;
}
__device__ __forceinline__ int mk_tid() { int t = threadIdx.x; asm volatile("" : "+v"(t)); return t; }
__device__ __forceinline__ int tok_of(int dir, int s) { return dir == 0 ? s : (s < CTX ? CTX - 1 - s : TOK + CTX - 1 - s); }

namespace pg8 {
#define PG8_LAS __attribute__((address_space(3)))
typedef unsigned short bf16_t;
typedef short bf16x8 __attribute__((ext_vector_type(8)));
typedef float f32x4 __attribute__((ext_vector_type(4)));
typedef unsigned u32x4 __attribute__((ext_vector_type(4)));
constexpr int BM = 256, BK = 64, HALF = 128, HTB = HALF * BK * 2  , STAGE_BYTES = 8 * HTB, NXCD = 8, WGM = 8;

__host__ __device__ __forceinline__ int lds_byte(int r, int c) { const int st = (r >> 4) * 2 + (c >> 5), rr = r & 15, cc = c & 31, ob = rr * 64 + cc * 2; return st * 1024 + (ob ^ (((ob >> 9) & 1) << 5)); }
__host__ __device__ __forceinline__ void stage_rc(int b, int& R, int& C) { const int st = b / 1024, sb = b % 1024, swz = sb ^ (((sb >> 9) & 1) << 5); R = (st >> 1) * 16 + swz / 64; C = (st & 1) * 32 + (swz % 64) / 2; }
__host__ __device__ __forceinline__ int perm32(int rho) { const int n = rho >> 4, i = rho & 15; return 8 * (i >> 2) + 4 * n + (i & 3); }

struct Unit { int pm, pn; };
struct Gemm { const bf16_t* A; const bf16_t* Bt; int M, N, K; };

struct StaticOrder {
    int nM, nN, nwg, G, c;
    __host__ __device__ void init(int M, int N, int G_, int c_) { nM = M / BM; nN = N / BM; nwg = nM * nN; G = G_; c = c_; }
    __host__ __device__ bool next(int i, Unit& u) const {
        const long L = (long)i * G + c; if (L >= nwg) return false;
        int wgid = (int)L; { const int q = nwg / NXCD, r = nwg % NXCD, xcd = wgid % NXCD, off = wgid / NXCD; wgid = (xcd < r ? xcd * (q + 1) : r * (q + 1) + (xcd - r) * q) + off; }
        const int nig = WGM * nN, gid = wgid / nig, fm = gid * WGM, gsz = (nM - fm) < WGM ? (nM - fm) : WGM;
        u.pm = fm + ((wgid % nig) % gsz); u.pn = (wgid % nig) / gsz; return true;
    }
    __device__ __forceinline__ void a_ready(const Unit&) const {}
    __device__ __forceinline__ void done(const Unit&) const {}
};

__device__ __forceinline__ unsigned cvt_pk_bf16(float lo, float hi) { unsigned r; asm volatile("v_cvt_pk_bf16_f32 %0, %1, %2" : "=v"(r) : "v"(lo), "v"(hi)); return r; }
template <class Epi, class Sched, bool ALIGN_EPI = false, bool SP2 = false>
__device__ __forceinline__ void gemm_phase(PG8_LAS unsigned char* lds, const Gemm g, const Sched& S, const Epi& E) {
    const int tid = mk_tid(), wid = __builtin_amdgcn_readfirstlane(tid >> 6), lane = tid & 63, wr = wid >> 2, wc = wid & 3, fr = lane & 15, fq = lane >> 4;
    const int K = g.K, nt = K / BK;
    unsigned voffA[2], voffB[2];
#pragma unroll
    for (int i = 0; i < 2; ++i) { int R, C; stage_rc(tid * 16 + i * 8192, R, C); const int Rb = Epi::PERM ? ((R & ~31) + perm32(R & 31)) : R;
        voffA[i] = (unsigned)(R * K + C) * 2u; voffB[i] = (unsigned)(Rb * K + C) * 2u; }
    const size_t kstep = (size_t)(BK * 2);
    const size_t hstep = (size_t)HALF * K * 2;
    const size_t tstep = 2 * hstep;
    const unsigned ldsw = (unsigned)wid * 1024u;
    const int aoff = lds_byte(wr * 64 + fr, fq * 8), boff = lds_byte(wc * 32 + fr, fq * 8);
#define PG8_SA(b, h) (((b) * 2 + (h)) * HTB)
#define PG8_SB(b, h) ((4 + (b) * 2 + (h)) * HTB)
#define PG8_STAGE(bufoff, gbase, voff) do { _Pragma("unroll") for (int _i = 0; _i < 2; ++_i) \
        __builtin_amdgcn_global_load_lds((const unsigned*)((const char*)(gbase) + (voff)[_i]), (PG8_LAS unsigned*)(lds + (bufoff) + ldsw + _i * 8192), 16, 0, 0); } while (0)
#define PG8_LDA(dst, b, h) do { _Pragma("unroll") for (int m = 0; m < 4; ++m) _Pragma("unroll") for (int k = 0; k < 2; ++k) dst[m][k] = *(const PG8_LAS bf16x8*)(lds + PG8_SA(b, h) + aoff + m * 2048 + k * 1024); } while (0)
#define PG8_LDB(dst, b, h) do { _Pragma("unroll") for (int n = 0; n < 2; ++n) _Pragma("unroll") for (int k = 0; k < 2; ++k) dst[n][k] = *(const PG8_LAS bf16x8*)(lds + PG8_SB(b, h) + boff + n * 2048 + k * 1024); } while (0)
#define PG8_MMA(ai, bj, At, Bt) do { __builtin_amdgcn_s_setprio(1); _Pragma("unroll") for (int m = 0; m < 4; ++m) _Pragma("unroll") for (int n = 0; n < 2; ++n) _Pragma("unroll") for (int k = 0; k < 2; ++k) \
        acc[ai][bj][m][n] = __builtin_amdgcn_mfma_f32_16x16x32_bf16(Bt[n][k], At[m][k], acc[ai][bj][m][n], 0, 0, 0); __builtin_amdgcn_s_setprio(0); } while (0)
#define PG8_WAIT_V(n) asm volatile("s_waitcnt vmcnt(" #n ")" ::: "memory")
#define PG8_WAIT_L(n) asm volatile("s_waitcnt lgkmcnt(" #n ")" ::: "memory")
#define PG8_BAR __builtin_amdgcn_s_barrier()
#define PG8_SCHED __builtin_amdgcn_sched_barrier(0)
    Unit cur, nxt; int ui = 0;
    if (!S.next(0, cur)) return;
    f32x4 acc[2][2][4][2];
#pragma unroll
    for (int a = 0; a < 2; ++a)
#pragma unroll
        for (int b = 0; b < 2; ++b)
#pragma unroll
            for (int m = 0; m < 4; ++m)
#pragma unroll
                for (int n = 0; n < 2; ++n) acc[a][b][m][n] = (f32x4){0.f, 0.f, 0.f, 0.f};
    bf16x8 At[4][2], B0[2][2], B1[2][2];
    const char* cA = (const char*)g.A + (size_t)cur.pm * tstep; const char* cB = (const char*)g.Bt + (size_t)cur.pn * tstep;
    S.a_ready(cur);
    if constexpr (SP2) {
        PG8_STAGE(PG8_SB(0, 0), cB, voffB); PG8_STAGE(PG8_SB(0, 1), cB + hstep, voffB); PG8_STAGE(PG8_SA(0, 0), cA, voffA); PG8_STAGE(PG8_SA(0, 1), cA + hstep, voffA);
        if (wr == 1) PG8_BAR;
        PG8_WAIT_V(2); PG8_BAR;
        PG8_STAGE(PG8_SB(1, 0), cB + kstep, voffB); PG8_STAGE(PG8_SA(1, 0), cA + kstep, voffA); PG8_STAGE(PG8_SB(1, 1), cB + hstep + kstep, voffB);
        PG8_WAIT_V(6); PG8_BAR;
    } else {
        PG8_STAGE(PG8_SB(0, 0), cB, voffB); PG8_STAGE(PG8_SA(0, 0), cA, voffA); PG8_STAGE(PG8_SB(0, 1), cB + hstep, voffB); PG8_STAGE(PG8_SA(0, 1), cA + hstep, voffA);
        if (wr == 1) PG8_BAR;
        PG8_WAIT_V(4); PG8_BAR;
        PG8_STAGE(PG8_SB(1, 0), cB + kstep, voffB); PG8_STAGE(PG8_SA(1, 0), cA + kstep, voffA); PG8_STAGE(PG8_SB(1, 1), cB + hstep + kstep, voffB);
        PG8_WAIT_V(6); PG8_BAR;
    }
    for (;;) {
        const bool has_next = S.next(ui + 1, nxt);
        const char* nA = has_next ? (const char*)g.A + (size_t)nxt.pm * tstep : cA; const char* nB = has_next ? (const char*)g.Bt + (size_t)nxt.pn * tstep : cB;
        for (int t = 0; t < nt; t += 2) {
            const bool last = (t == nt - 2);
            const char* a1 = cA + (size_t)(t + 1) * kstep;
            const char* a2 = last ? nA : cA + (size_t)(t + 2) * kstep; const char* b2 = last ? nB : cB + (size_t)(t + 2) * kstep;
            const char* a3 = a2 + kstep; const char* b3 = b2 + kstep;
            if (last && has_next) S.a_ready(nxt);
            if constexpr (SP2) {
            PG8_LDB(B0, 0, 0); PG8_LDB(B1, 0, 1); PG8_SCHED; PG8_LDA(At, 0, 0); PG8_STAGE(PG8_SA(1, 1), a1 + hstep, voffA);
            PG8_WAIT_V(8); PG8_WAIT_L(0); PG8_BAR; PG8_MMA(0, 0, At, B0); PG8_MMA(0, 1, At, B1); PG8_BAR; PG8_SCHED;
            PG8_LDA(At, 0, 1); PG8_STAGE(PG8_SB(0, 0), b2, voffB); PG8_STAGE(PG8_SB(0, 1), b2 + hstep, voffB); PG8_STAGE(PG8_SA(0, 0), a2, voffA);
            PG8_WAIT_V(8); PG8_WAIT_L(0); PG8_BAR; PG8_MMA(1, 0, At, B0); PG8_MMA(1, 1, At, B1); PG8_BAR; PG8_SCHED;
            PG8_LDB(B0, 1, 0); PG8_LDB(B1, 1, 1); PG8_SCHED; PG8_LDA(At, 1, 0); PG8_STAGE(PG8_SA(0, 1), a2 + hstep, voffA);
            PG8_WAIT_V(8); PG8_WAIT_L(0); PG8_BAR; PG8_MMA(0, 0, At, B0); PG8_MMA(0, 1, At, B1); PG8_BAR; PG8_SCHED;
            PG8_LDA(At, 1, 1); PG8_STAGE(PG8_SB(1, 0), b3, voffB); PG8_STAGE(PG8_SB(1, 1), b3 + hstep, voffB); PG8_STAGE(PG8_SA(1, 0), a3, voffA);
            PG8_WAIT_V(8); PG8_WAIT_L(0); PG8_BAR; PG8_MMA(1, 0, At, B0); PG8_MMA(1, 1, At, B1); PG8_BAR; PG8_SCHED;
            } else {
            PG8_LDB(B0, 0, 0); PG8_SCHED; PG8_LDA(At, 0, 0); PG8_STAGE(PG8_SA(1, 1), a1 + hstep, voffA);
            PG8_WAIT_L(8); PG8_BAR; PG8_WAIT_L(0); PG8_MMA(0, 0, At, B0); PG8_BAR; PG8_SCHED;
            PG8_LDB(B1, 0, 1); PG8_STAGE(PG8_SB(0, 0), b2, voffB);
            PG8_BAR; PG8_WAIT_L(0); PG8_MMA(0, 1, At, B1); PG8_BAR;
            PG8_LDA(At, 0, 1); PG8_STAGE(PG8_SA(0, 0), a2, voffA);
            PG8_BAR; PG8_WAIT_L(0); PG8_MMA(1, 0, At, B0); PG8_BAR; PG8_SCHED;
            PG8_STAGE(PG8_SB(0, 1), b2 + hstep, voffB);
            PG8_WAIT_V(6); PG8_BAR; PG8_MMA(1, 1, At, B1); PG8_BAR;
            PG8_LDB(B0, 1, 0); PG8_SCHED; PG8_LDA(At, 1, 0); PG8_STAGE(PG8_SA(0, 1), a2 + hstep, voffA);
            PG8_WAIT_L(8); PG8_BAR; PG8_WAIT_L(0); PG8_MMA(0, 0, At, B0); PG8_BAR; PG8_SCHED;
            PG8_LDB(B1, 1, 1); PG8_STAGE(PG8_SB(1, 0), b3, voffB);
            PG8_BAR; PG8_WAIT_L(0); PG8_MMA(0, 1, At, B1); PG8_BAR;
            PG8_LDA(At, 1, 1); PG8_STAGE(PG8_SA(1, 0), a3, voffA);
            PG8_BAR; PG8_WAIT_L(0); PG8_MMA(1, 0, At, B0); PG8_BAR; PG8_SCHED;
            PG8_STAGE(PG8_SB(1, 1), b3 + hstep, voffB);
            PG8_WAIT_V(6); PG8_BAR; PG8_MMA(1, 1, At, B1); PG8_BAR;
            }
        }
        if constexpr (ALIGN_EPI) { if (wr == 0) PG8_BAR; }
        if constexpr (!Epi::AFTER_DRAIN) { E(acc, cur, wr, wc, fr, fq); S.done(cur); }
        if (!has_next) break;
#pragma unroll
        for (int a = 0; a < 2; ++a)
#pragma unroll
            for (int b = 0; b < 2; ++b)
#pragma unroll
                for (int m = 0; m < 4; ++m)
#pragma unroll
                    for (int n = 0; n < 2; ++n) acc[a][b][m][n] = (f32x4){0.f, 0.f, 0.f, 0.f};
        cur = nxt; cA = nA; cB = nB; ++ui;
        if constexpr (ALIGN_EPI) { if (wr == 1) PG8_BAR; }
    }
    PG8_WAIT_V(0);
    if constexpr (!ALIGN_EPI) { if (wr == 0) PG8_BAR; }
    PG8_BAR;
    if constexpr (Epi::AFTER_DRAIN) { E.fused(acc, cur, wr, wc, fr, fq, lds, wid, lane); S.done(cur); }
#undef PG8_SA
#undef PG8_SB
#undef PG8_STAGE
#undef PG8_LDA
#undef PG8_LDB
#undef PG8_MMA
#undef PG8_WAIT_V
#undef PG8_WAIT_L
#undef PG8_BAR
#undef PG8_SCHED
}
}

#define LASP __attribute__((address_space(3)))
constexpr int NCHK = TOK / 32;

struct LatentOrder {
    pg8::StaticOrder S;
    __device__ __forceinline__ bool next(int i, pg8::Unit& u) const { if (!S.next(i, u)) return false; u.pm = 17 * (u.pm >> 4) + 1 + (u.pm & 15); return true; }
    __device__ __forceinline__ void a_ready(const pg8::Unit&) const {}
    __device__ __forceinline__ void done(const pg8::Unit&) const {}
};
struct EpiProj {
    static constexpr bool PERM = true, AFTER_DRAIN = false;
    bf16* raw; bf16* rest; bf16* kf;
    __device__ __forceinline__ void operator()(const pg8::f32x4 (&acc)[2][2][4][2], const pg8::Unit& u, int wr, int wc, int fr, int fq) const {
        const int row0 = u.pm * 256 + wr * 64 + fr;
        const int colb = u.pn * 256 + wc * 32 + 8 * fq;
#pragma unroll
        for (int bj = 0; bj < 2; ++bj) {
            const int col = colb + bj * 128;
            if (col >= NPROJ) continue;
            const bool iskf = col >= PC_BK && col < PC_BV;
            bf16* base; int ld;
            if (col < NRAW) { base = raw + col; ld = NRAW; }
            else if (col < PC_BK) { base = rest + (col - NRAW); ld = NREST; }
            else { base = rest + (col - NRAW - 256); ld = NREST; }
            const int hd = col - PC_BK, hk = hd >> 6, dk = hd & 63;
#pragma unroll
            for (int ai = 0; ai < 2; ++ai)
#pragma unroll
                for (int m = 0; m < 4; ++m) {
                    const pg8::f32x4 v0 = acc[ai][bj][m][0], v1 = acc[ai][bj][m][1];
                    pg8::u32x4 w; w.x = pg8::cvt_pk_bf16(v0[0], v0[1]); w.y = pg8::cvt_pk_bf16(v0[2], v0[3]); w.z = pg8::cvt_pk_bf16(v1[0], v1[1]); w.w = pg8::cvt_pk_bf16(v1[2], v1[3]);
                    const int row = row0 + ai * 128 + m * 16;
                    if (iskf) {
                        const int bb = row / TOK, t = row - bb * TOK;
                        *(pg8::u32x4*)(kf + ((((size_t)(bb * 4 + hk) * NCHK + (t >> 5)) * 4 + (dk >> 4)) * 64 + ((dk >> 3) & 1) * 32 + (t & 31)) * 8) = w;
                    } else *(pg8::u32x4*)(base + (size_t)row * ld) = w;
                }
        }
    }
};
struct EpiY {
    static constexpr bool PERM = true, AFTER_DRAIN = false;
    bf16* y;
    __device__ __forceinline__ void operator()(const pg8::f32x4 (&acc)[2][2][4][2], const pg8::Unit& u, int wr, int wc, int fr, int fq) const {
        const int row0 = u.pm * 256 + wr * 64 + fr;
        const int colb = u.pn * 256 + wc * 32 + 8 * fq;
#pragma unroll
        for (int bj = 0; bj < 2; ++bj)
#pragma unroll
            for (int ai = 0; ai < 2; ++ai)
#pragma unroll
                for (int m = 0; m < 4; ++m) {
                    const pg8::f32x4 v0 = acc[ai][bj][m][0], v1 = acc[ai][bj][m][1];
                    pg8::u32x4 w; w.x = pg8::cvt_pk_bf16(v0[0], v0[1]); w.y = pg8::cvt_pk_bf16(v0[2], v0[3]); w.z = pg8::cvt_pk_bf16(v1[0], v1[1]); w.w = pg8::cvt_pk_bf16(v1[2], v1[3]);
                    *(pg8::u32x4*)(y + (size_t)(row0 + ai * 128 + m * 16) * D + colb + bj * 128) = w;
                }
    }
};

__device__ __forceinline__ void transpose_item(const float* W, int K, int N, bf16* WT, LASP float* scr, int item, int lane) {
    const int nblk = (N + 31) / 32, kb = item / nblk, nb = item % nblk, k0 = 64 * kb, n0 = 32 * nb;
    const bool nok = (n0 + (lane & 31)) < N;
#pragma unroll 8
    for (int i = 0; i < 32; ++i) { const int kk = 2 * i + (lane >> 5); scr[kk * 33 + (lane & 31)] = nok ? W[(size_t)(k0 + kk) * N + n0 + (lane & 31)] : 0.f; }
    asm volatile("s_waitcnt lgkmcnt(0)" ::: "memory");
    const int c = lane & 7;
#pragma unroll
    for (int j = 0; j < 4; ++j) {
        const int n = (lane >> 3) + 8 * j; const LASP float* s = scr + (8 * c) * 33 + n;
        uint4 o; o.x = pk2(s[0 * 33], s[1 * 33]); o.y = pk2(s[2 * 33], s[3 * 33]); o.z = pk2(s[4 * 33], s[5 * 33]); o.w = pk2(s[6 * 33], s[7 * 33]);
        *(uint4*)(WT + (size_t)(n0 + n) * K + k0 + 8 * c) = o;
    }
    asm volatile("s_waitcnt lgkmcnt(0)" ::: "memory");
}

__device__ void ph_prologue(const P& p, LASP unsigned char* lds, int bid, int nblk) {
    const int tid = mk_tid(), lane = tid & 63, wave = tid >> 6;
    LASP float* sm = (LASP float*)lds;
    if (bid < 96) {
        for (int i = tid; i < 9 * 1024; i += NTHREADS) {
            int s = i >> 10, d = i & 1023;
            float cv = s < 8 ? p.c[s * 1024 + d] : p.c_ctx[d];
            sm[i] = silu_f(cv);
        }
        __syncthreads();
        const int l = bid / 48, j = (bid % 48) * 64 + lane;
        const float* w = p.w_mod + (size_t)l * 1024 * 3072 + j;
        float acc[9];
#pragma unroll
        for (int s = 0; s < 9; ++s) acc[s] = 0.f;
#pragma unroll 1
        for (int i0 = wave * 128; i0 < wave * 128 + 128; i0 += 16) {
            float wv[16];
#pragma unroll
            for (int u = 0; u < 16; ++u) wv[u] = w[(size_t)(i0 + u) * 3072];
#pragma unroll
            for (int u = 0; u < 16; ++u)
#pragma unroll
                for (int s = 0; s < 9; ++s) acc[s] += sm[s * 1024 + i0 + u] * wv[u];
        }
        LASP float* red = sm + 9 * 1024;
#pragma unroll
        for (int s = 0; s < 9; ++s) red[(wave * 9 + s) * 64 + lane] = acc[s];
        __syncthreads();
        for (int o = tid; o < 9 * 64; o += NTHREADS) {
            const int s = o >> 6, c = o & 63;
            float t = 0.f;
#pragma unroll
            for (int ww = 0; ww < 8; ++ww) t += red[(ww * 9 + s) * 64 + c];
            const int jj = (bid % 48) * 64 + c;
            p.mods[(size_t)(l * 9 + s) * 3072 + jj] = t + p.b_mod[l * 3072 + jj];
        }
        __syncthreads();
    }
#if PROBE
    if (bid == 0 && tid < 4) p.stats[tid] = 0.f;
#endif
    LASP float* scr = (LASP float*)(lds + 57344 + wave * 8704);
    const int gw = (nblk - 1 - bid) * NWAVES + wave, NGW = nblk * NWAVES;
    constexpr int I_IN = 16 * 122, I_OUT = 16 * 32;
    for (int it = gw; it < 2 * (I_IN + I_OUT); it += NGW) {
        int l = it / (I_IN + I_OUT), r = it % (I_IN + I_OUT);
        if (r < I_IN) transpose_item(p.w_in + (size_t)l * D * NPROJ, D, NPROJ, p.wi_t + (size_t)l * NPAD * D, scr, r, lane);
        else transpose_item(p.w_out + (size_t)l * D * D, D, D, p.wo_t + (size_t)l * D * D, scr, r - I_IN, lane);
    }
    for (int i = bid * NTHREADS + tid; i < 2 * 192 * 128; i += nblk * NTHREADS) {
        int l = i / (192 * 128), r = i % (192 * 128);
        *(uint4*)(p.wi_t + (size_t)l * NPAD * D + (size_t)3904 * D + (size_t)r * 8) = make_uint4(0, 0, 0, 0);
    }
}

__device__ void ph_lnpass(const P& p, int mode, int bid, int nblk) {
    const int tid = mk_tid();
    const int lane = tid & 63, wave = tid >> 6;
    for (int r = bid * NWAVES + wave; r < ROWS; r += nblk * NWAVES) {
        const int b = r / TOK, t = r - b * TOK;
        const bool isc = t < CTX;
        if (mode == 2 && isc) continue;
        float* buf; const float* src; int s;
        if (isc) { buf = p.xc1 + ((size_t)b * CTX + t) * D; src = p.ctx + ((size_t)b * CTX + t) * D; s = 8; }
        else { buf = p.out + ((size_t)b * SEQ + (t - CTX)) * D; src = (mode == 2) ? buf : p.x + ((size_t)b * SEQ + (t - CTX)) * D; s = b; }
        f32x4_t v[4];
#pragma unroll
        for (int j = 0; j < 4; ++j) v[j] = *(const f32x4_t*)(src + 256 * j + 4 * lane);
        if (mode >= 1) {
            const int lp = mode - 1;
            const float* gt = p.mods + (size_t)(lp * 9 + s) * 3072 + 2048;
#pragma unroll
            for (int j = 0; j < 4; ++j) {
                const uint2 yw = *(const uint2*)(p.ml + (size_t)r * D + 256 * j + 4 * lane);
                const f32x4_t g = *(const f32x4_t*)(gt + 256 * j + 4 * lane);
                const f32x4_t yv = {bflo(yw.x), bfhi(yw.x), bflo(yw.y), bfhi(yw.y)};
                v[j] = v[j] * ALPHA + g * yv;
            }
            float sum = 0.f;
#pragma unroll
            for (int j = 0; j < 4; ++j) sum += (v[j].x + v[j].y) + (v[j].z + v[j].w);
            const float mu = wave_sum(sum) * (1.f / 1024.f);
            float sq = 0.f;
#pragma unroll
            for (int j = 0; j < 4; ++j) { v[j] = v[j] - mu; sq += (v[j].x * v[j].x + v[j].y * v[j].y) + (v[j].z * v[j].z + v[j].w * v[j].w); }
            const float rs = 1.f / sqrtf(wave_sum(sq) * (1.f / 1024.f) + 1e-6f);
#pragma unroll
            for (int j = 0; j < 4; ++j) {
                const f32x4_t g = *(const f32x4_t*)(p.ln_g + lp * 1024 + 256 * j + 4 * lane), bb = *(const f32x4_t*)(p.ln_b + lp * 1024 + 256 * j + 4 * lane);
                v[j] = v[j] * rs * g + bb;
#if PROBE
                if (mode == 2) v[j] = v[j] + (p.stats[0] / fmaxf(p.stats[1], 1e-20f));
#endif
#if TPROBE >= 0
                if (mode == 2) v[j] = v[j] + exp2f((rintf(log2f(fmaxf(p.stats[2], 1.f)) * 6.f + TSHIFT * 0.5f) - TSHIFT * 0.5f) * (1.f / 6.f)) * 1e-4f;
#endif
                *(f32x4_t*)(buf + 256 * j + 4 * lane) = v[j];
            }
            if (mode == 2) continue;
        }
        const int l = mode;
        float sum = 0.f;
#pragma unroll
        for (int j = 0; j < 4; ++j) sum += (v[j].x + v[j].y) + (v[j].z + v[j].w);
        const float mu = wave_sum(sum) * (1.f / 1024.f);
        float sq = 0.f;
#pragma unroll
        for (int j = 0; j < 4; ++j) { v[j] = v[j] - mu; sq += (v[j].x * v[j].x + v[j].y * v[j].y) + (v[j].z * v[j].z + v[j].w * v[j].w); }
        const float rs = 1.f / sqrtf(wave_sum(sq) * (1.f / 1024.f) + 1e-6f);
        const float* md = p.mods + (size_t)(l * 9 + s) * 3072;
#pragma unroll
        for (int j = 0; j < 4; ++j) {
            const f32x4_t sh = *(const f32x4_t*)(md + 256 * j + 4 * lane), sc = *(const f32x4_t*)(md + 1024 + 256 * j + 4 * lane);
            const f32x4_t o = v[j] * rs * (sc + 1.f) + sh;
            uint2 w; w.x = pk2(o.x, o.y); w.y = pk2(o.z, o.w);
            *(uint2*)(p.ml + (size_t)r * D + 256 * j + 4 * lane) = w;
        }
    }
}

__device__ void ph_conv(const P& p, int l, int bid, int nblk) {
    const int tid = mk_tid();
    const int lane = tid & 63, wave = tid >> 6;
    const float* cw = p.conv_w + (size_t)l * 5 * 1536;
    constexpr int NSTRIP = TOK / 16;
    for (int it = bid * NWAVES + wave; it < BATCH * NSTRIP * 3; it += nblk * NWAVES) {
        const int third = it % 3, rest_i = it / 3, strip = rest_i % NSTRIP, b = rest_i / NSTRIP;
        const int t0 = strip * 16;
        const int lo = t0 < CTX ? 0 : CTX, hi = t0 < CTX ? CTX : TOK;
        const int ch = third * 512 + lane * 8;
        float w[5][8];
#pragma unroll
        for (int j = 0; j < 5; ++j) {
            const f32x4_t a = *(const f32x4_t*)(cw + j * 1536 + ch), c = *(const f32x4_t*)(cw + j * 1536 + ch + 4);
            w[j][0] = a.x; w[j][1] = a.y; w[j][2] = a.z; w[j][3] = a.w; w[j][4] = c.x; w[j][5] = c.y; w[j][6] = c.z; w[j][7] = c.w;
        }
        const bf16* src = p.raw + ((size_t)b * TOK + t0) * NRAW + ch;
        bf16* dst = p.qkvn + ((size_t)b * TOK + t0) * NRAW + ch;
        uint4 rw[20];
#pragma unroll
        for (int i = 0; i < 20; ++i) {
            const int tt = t0 + i - 2;
            rw[i] = (tt >= lo && tt < hi) ? *(const uint4*)(src + (ptrdiff_t)(i - 2) * NRAW) : make_uint4(0, 0, 0, 0);
        }
        const int g = (ch >> 7);
        const float qs = g < 4 ? 0.08838834764831845f : 1.f;
#pragma unroll
        for (int n = 0; n < 16; ++n) {
            float acc[8];
#pragma unroll
            for (int e = 0; e < 8; ++e) acc[e] = 0.f;
#pragma unroll
            for (int j = 0; j < 5; ++j) {
                float f[8]; unpack8(rw[n + j], f);
#pragma unroll
                for (int e = 0; e < 8; ++e) acc[e] += w[j][e] * f[e];
            }
            float ss = 0.f;
#pragma unroll
            for (int e = 0; e < 8; ++e) { acc[e] = silu_f(acc[e]); ss += acc[e] * acc[e]; }
            if (g < 8) {
#pragma unroll
                for (int m = 8; m > 0; m >>= 1) ss += __shfl_xor(ss, m);
                const float sc = qs * __builtin_amdgcn_rsqf(ss + 1e-6f);
#pragma unroll
                for (int e = 0; e < 8; ++e) acc[e] *= sc;
            }
            uint4 o; o.x = pk2(acc[0], acc[1]); o.y = pk2(acc[2], acc[3]); o.z = pk2(acc[4], acc[5]); o.w = pk2(acc[6], acc[7]);
            *(uint4*)(dst + (size_t)n * NRAW) = o;
        }
    }
}

typedef short bf16x8_t __attribute__((ext_vector_type(8)));
typedef float f32x16_t __attribute__((ext_vector_type(16)));
typedef float f32x2_t __attribute__((ext_vector_type(2)));
typedef __bf16 bf16x2_t __attribute__((ext_vector_type(2)));
typedef unsigned u32x4_t __attribute__((ext_vector_type(4)));
#define MFMA32(a, b, c) __builtin_amdgcn_mfma_f32_32x32x16_bf16((a), (b), (c), 0, 0, 0)
__device__ __forceinline__ unsigned cvtpk(float lo, float hi) { f32x2_t v = {lo, hi}; bf16x2_t q = __builtin_convertvector(v, bf16x2_t); return __builtin_bit_cast(unsigned, q); }
__device__ __forceinline__ int crow(int reg, int h) { return (reg & 3) + 8 * (reg >> 2) + 4 * h; }
__device__ __forceinline__ int perm16(int a) { const int x = a & 15; return (a & ~15) + (x < 4 ? x : x < 8 ? x + 4 : x < 12 ? x - 4 : x); }
#define PACK8(x, s) __builtin_bit_cast(bf16x8_t, (u32x4_t){cvtpk((x)[8 * (s)], (x)[8 * (s) + 1]), cvtpk((x)[8 * (s) + 2], (x)[8 * (s) + 3]), cvtpk((x)[8 * (s) + 4], (x)[8 * (s) + 5]), cvtpk((x)[8 * (s) + 6], (x)[8 * (s) + 7])})
constexpr int GCH = 32, NCH = TOK / GCH;
constexpr int GP_ITEM = 4416;

__device__ void ph_gdnprep(const P& p, LASP unsigned char* lds, int l, int bid, int nblk, int tid) {
    const int lane = tid & 63, wave = tid >> 6, r = lane & 31, hh = lane >> 5;
    LASP float* Lm = (LASP float*)(lds + wave * 16384);
    LASP float* Xs = Lm + 2048;
    for (int it = bid * NWAVES + wave; it < BATCH * 4 * NCH; it += nblk * NWAVES) {
        const int c = it % NCH, bh = it / NCH, h = bh & 3, b = bh >> 2;
        const size_t row0 = (size_t)b * TOK + (size_t)c * GCH;
        f32x16_t KK, QK;
#pragma unroll
        for (int i = 0; i < 16; ++i) { KK[i] = 0.f; QK[i] = 0.f; }
        const bf16* kbase = p.qkvn + (row0 + r) * NRAW + 512 + h * 128 + 8 * hh;
        const bf16* qbase = p.qkvn + (row0 + r) * NRAW + h * 128 + 8 * hh;
#pragma unroll
        for (int s = 0; s < 8; ++s) {
            const bf16x8_t kf = *(const bf16x8_t*)(kbase + 16 * s), qf = *(const bf16x8_t*)(qbase + 16 * s);
            KK = MFMA32(kf, kf, KK);
            QK = MFMA32(qf, kf, QK);
        }
        float Gd, bd;
        {
            const bf16* ab = p.rest + (row0 + r) * NREST + RC_AB;
            const float a = bf2f(ab[hh * 4 + h]) + p.dt_bias[(l * 2 + hh) * 4 + h];
            const float sp = fmaxf(a, 0.f) + log1pf(expf(-fabsf(a)));
            Gd = -expf(p.a_log[(l * 2 + hh) * 4 + h]) * sp;
            bd = 1.f / (1.f + expf(-bf2f(ab[(2 + hh) * 4 + h])));
        }
#pragma unroll
        for (int off = 1; off < 32; off <<= 1) {
            const float up = __shfl_up(Gd, off, 32), dn = __shfl_down(Gd, off, 32);
            if (hh == 0) { if (r >= off) Gd += up; } else { if (r + off < 32) Gd += dn; }
        }
        unsigned char* gout = (unsigned char*)p.raw + ((size_t)(bh * 2) * NCH + c) * GP_ITEM;
        {
            const float Glast = __shfl(Gd, hh == 0 ? 31 : 32);
            float* sc = (float*)(gout + (size_t)hh * NCH * GP_ITEM + 4096);
            sc[r] = expf(Gd); sc[32 + r] = expf(Glast - Gd);
            if (r == 0) sc[64] = expf(Glast);
        }
        asm volatile("s_waitcnt lgkmcnt(0)" ::: "memory");
#pragma unroll
        for (int d = 0; d < 2; ++d) {
            const float Gcol = __shfl(Gd, d * 32 + r);
            bf16* qko = (bf16*)(gout + (size_t)d * NCH * GP_ITEM + 2048);
#pragma unroll
            for (int i = 0; i < 16; ++i) {
                const int n = crow(i, hh);
                const float Grow = __shfl(Gd, d * 32 + n), brow = __shfl(bd, d * 32 + n);
                const bool incl = d == 0 ? (r <= n) : (r >= n), strict = d == 0 ? (r < n) : (r > n);
                const float dec = expf(incl ? Grow - Gcol : 0.f);
                const float lv = strict ? brow * KK[i] * dec : 0.f;
                const float qv = incl ? QK[i] * dec : 0.f;
                const int n2 = d == 0 ? n : 31 - n, m2 = d == 0 ? r : 31 - r;
                Lm[(d * 32 + n2) * 32 + m2] = lv;
                qko[n * 32 + perm16(r)] = f2bf(qv);
                if ((i & 3) == 3) __builtin_amdgcn_sched_barrier(0);
            }
        }
        asm volatile("s_waitcnt lgkmcnt(0)" ::: "memory");
        {
            const LASP float* Lr = Lm + hh * 1024;
            LASP float* xc = Xs + lane;
#pragma unroll 4
            for (int j = 0; j < 32; ++j) xc[j * 64] = (j == r) ? 1.f : 0.f;
#pragma unroll 1
            for (int n = 1; n < 32; ++n) {
                float a0 = 0.f, a1 = 0.f;
#pragma unroll 1
                for (int j4 = 0; j4 < n; j4 += 4) {
                    const f32x4_t lv = *(const LASP f32x4_t*)(Lr + n * 32 + j4);
                    a0 += lv.x * xc[(j4 + 0) * 64]; a1 += lv.y * xc[(j4 + 1) * 64];
                    a0 += lv.z * xc[(j4 + 2) * 64]; a1 += lv.w * xc[(j4 + 3) * 64];
                }
                xc[n * 64] -= (a0 + a1);
            }
            const int mtok = hh == 0 ? r : 31 - r;
            const float bcol = __shfl(bd, hh * 32 + mtok);
            bf16* tq = (bf16*)(gout + (size_t)hh * NCH * GP_ITEM) + perm16(mtok) + (hh == 0 ? 0 : 31 * 32);
            const int tstep = hh == 0 ? 32 : -32;
#pragma unroll 4
            for (int n = 0; n < 32; ++n) { *tq = f2bf(xc[n * 64] * bcol); tq += tstep; }
        }
        asm volatile("s_waitcnt lgkmcnt(0)" ::: "memory");
    }
}


constexpr int ST_KA = 0, ST_QA = 8704, ST_KN = 17408, ST_V = 27648, ST_TP = 37888, ST_QK = 40448, ST_GL = 43008, ST_BYTES = 43328;
constexpr int GDN_OST = 2 * ST_BYTES, GDN_OST_BYTES = 32 * 272;
typedef unsigned u32x2_t __attribute__((ext_vector_type(2)));
typedef short s16x4_t __attribute__((ext_vector_type(4)));
struct GSlot { u32x4_t k0, k1, q0, q1, v0, v1, t; f32x4_t sc; };

__device__ __forceinline__ int gdn_chunk(int dir, int s) { return dir == 0 ? s : (s < 8 ? 7 - s : 143 - s); }
__device__ __forceinline__ void gdn_issue(const P& p, GSlot& g, int b, int h, int dir, int step, int tl) {
    const int c = gdn_chunk(dir, step);
    const size_t row0 = (size_t)b * TOK + (size_t)c * GCH;
    const int r0 = tl >> 4, c16 = tl & 15;
    const bf16* a0 = p.qkvn + (row0 + r0) * NRAW + h * 128 + 8 * c16;
    const bf16* a1 = a0 + (size_t)16 * NRAW;
    g.q0 = *(const u32x4_t*)a0; g.q1 = *(const u32x4_t*)a1;
    g.k0 = *(const u32x4_t*)(a0 + 512); g.k1 = *(const u32x4_t*)(a1 + 512);
    g.v0 = *(const u32x4_t*)(a0 + 1024); g.v1 = *(const u32x4_t*)(a1 + 1024);
    const unsigned char* gp = (const unsigned char*)p.raw + ((size_t)((b * 4 + h) * 2 + dir) * NCH + c) * GP_ITEM;
    g.t = *(const u32x4_t*)(gp + tl * 16);
    g.sc = *(const f32x4_t*)(gp + 4096 + (tl < 20 ? tl : 0) * 16);
}
__device__ __forceinline__ u32x4_t scale8(u32x4_t x, float s) {
    return (u32x4_t){cvtpk(bflo(x.x) * s, bfhi(x.x) * s), cvtpk(bflo(x.y) * s, bfhi(x.y) * s), cvtpk(bflo(x.z) * s, bfhi(x.z) * s), cvtpk(bflo(x.w) * s, bfhi(x.w) * s)};
}
__device__ __forceinline__ void gdn_put_rows(LASP unsigned char* st, int row, int c16, u32x4_t kq, int off) {
    const int g = c16 >> 1, odd = c16 & 1;
    *(LASP u32x2_t*)(st + off + row * 272 + (16 * g + (odd ? 4 : 0)) * 2) = (u32x2_t){kq.x, kq.y};
    *(LASP u32x2_t*)(st + off + row * 272 + (16 * g + (odd ? 12 : 8)) * 2) = (u32x2_t){kq.z, kq.w};
}
__device__ __forceinline__ void gdn_write(LASP unsigned char* st, const GSlot& g, int tl) {
    const int r0 = tl >> 4, c16 = tl & 15;
    gdn_put_rows(st, r0, c16, g.k0, ST_KA); gdn_put_rows(st, r0 + 16, c16, g.k1, ST_KA);
    gdn_put_rows(st, r0, c16, g.q0, ST_QA); gdn_put_rows(st, r0 + 16, c16, g.q1, ST_QA);
    *(LASP u32x4_t*)(st + ST_KN + r0 * 320 + c16 * 16) = g.k0;
    *(LASP u32x4_t*)(st + ST_KN + (r0 + 16) * 320 + c16 * 16) = g.k1;
    *(LASP u32x4_t*)(st + ST_V + r0 * 320 + c16 * 16) = g.v0;
    *(LASP u32x4_t*)(st + ST_V + (r0 + 16) * 320 + c16 * 16) = g.v1;
    { const int t2 = tl & 127; *(LASP u32x4_t*)(st + (tl < 128 ? ST_TP : ST_QK) + (t2 >> 2) * 80 + (t2 & 3) * 16) = g.t; }
    if (tl < 20) *(LASP f32x4_t*)(st + ST_GL + tl * 16) = g.sc;
}
__device__ __forceinline__ void gdn_flush(const P& p, LASP unsigned char* lds, int b, int h, int dir, int step, int tl) {
    const int c = gdn_chunk(dir, step);
    const LASP unsigned char* ost = lds + GDN_OST + (step & 1) * GDN_OST_BYTES;
    bf16* op = p.oa + ((size_t)dir * ROWS + (size_t)b * TOK + (size_t)c * GCH) * 512 + h * 128;
#pragma unroll
    for (int k = 0; k < 2; ++k) { const int idx = tl + 256 * k, row = idx >> 4, ch = idx & 15; *(u32x4_t*)(op + (size_t)row * 512 + ch * 8) = *(const LASP u32x4_t*)(ost + row * 272 + ch * 16); }
}
__device__ __forceinline__ s16x4_t trd(const LASP unsigned char* q) {
    typedef short v4i16_t __attribute__((ext_vector_type(4)));
    return __builtin_bit_cast(s16x4_t, __builtin_amdgcn_ds_read_tr16_b64_v4i16((LASP v4i16_t*)q));
}
#define TRFRAG(base) __builtin_shufflevector(trd(base), trd((base) + 8 * 320), 0, 1, 2, 3, 4, 5, 6, 7)

#if TPROBE == 60
#define GDN_SYNC_C() do { unsigned long long t_ = __builtin_amdgcn_s_memrealtime(); __syncthreads(); if (chain == 0 && tid == 0) p.stats[2] += (float)(__builtin_amdgcn_s_memrealtime() - t_) * 0.01f; } while (0)
#define GDN_SYNC_L() __syncthreads()
#elif TPROBE == 61
#define GDN_SYNC_L() do { unsigned long long t_ = __builtin_amdgcn_s_memrealtime(); __syncthreads(); if (chain == 0 && tid == 256) p.stats[2] += (float)(__builtin_amdgcn_s_memrealtime() - t_) * 0.01f; } while (0)
#define GDN_SYNC_C() __syncthreads()
#else
#define GDN_SYNC_C() __syncthreads()
#define GDN_SYNC_L() __syncthreads()
#endif
__device__ void gdn_scan_fast(const P& p, LASP unsigned char* lds, int chain) {
    const int tid = mk_tid();
    const int lane = tid & 63, wave = __builtin_amdgcn_readfirstlane(tid >> 6);
    const int dir = chain & 1, h = (chain >> 1) & 3, b = chain >> 3;
    constexpr int NS = NCH;
    if (wave >= 4) {
        const int tl = tid - 256;
        GSlot g0, g1, g2, g3;
        gdn_issue(p, g0, b, h, dir, 0, tl); gdn_issue(p, g1, b, h, dir, 1, tl); gdn_issue(p, g2, b, h, dir, 2, tl); gdn_issue(p, g3, b, h, dir, 3, tl);
        gdn_write(lds, g0, tl); gdn_issue(p, g0, b, h, dir, 4, tl);
        __syncthreads();
#pragma unroll 1
        for (int s = 0; s < NS; s += 4) {
            if (s > 0) gdn_flush(p, lds, b, h, dir, s - 1, tl);
            gdn_write(lds + ((s + 1) & 1) * ST_BYTES, g1, tl); gdn_issue(p, g1, b, h, dir, min(s + 5, NS - 1), tl);
            GDN_SYNC_L();
            gdn_flush(p, lds, b, h, dir, s, tl);
            gdn_write(lds + ((s + 2) & 1) * ST_BYTES, g2, tl); gdn_issue(p, g2, b, h, dir, min(s + 6, NS - 1), tl);
            GDN_SYNC_L();
            gdn_flush(p, lds, b, h, dir, s + 1, tl);
            gdn_write(lds + ((s + 3) & 1) * ST_BYTES, g3, tl); gdn_issue(p, g3, b, h, dir, min(s + 7, NS - 1), tl);
            GDN_SYNC_L();
            gdn_flush(p, lds, b, h, dir, s + 2, tl);
            gdn_write(lds + ((s + 4) & 1) * ST_BYTES, g0, tl); gdn_issue(p, g0, b, h, dir, min(s + 8, NS - 1), tl);
            GDN_SYNC_L();
        }
        gdn_flush(p, lds, b, h, dir, NS - 1, tl);
    } else {
        const int r = lane & 31, hh = lane >> 5, w = wave;
        f32x16_t S0, S1, S2, S3;
#pragma unroll
        for (int i = 0; i < 16; ++i) { S0[i] = 0.f; S1[i] = 0.f; S2[i] = 0.f; S3[i] = 0.f; }
        const int troff = (4 * hh + ((lane & 15) >> 2)) * 320 + (16 * ((lane >> 4) & 1) + 4 * (lane & 3)) * 2;
        __syncthreads();
#pragma unroll 1
        for (int s = 0; s < NS; ++s) {
            LASP unsigned char* st = lds + (s & 1) * ST_BYTES;
            const LASP unsigned char* ka = st + ST_KA + r * 272 + hh * 16;
            const LASP unsigned char* qa = st + ST_QA + r * 272 + hh * 16;
            const bf16x8_t kA0 = *(const LASP bf16x8_t*)(ka), kA1 = *(const LASP bf16x8_t*)(ka + 32), kA2 = *(const LASP bf16x8_t*)(ka + 64), kA3 = *(const LASP bf16x8_t*)(ka + 96);
            const bf16x8_t kA4 = *(const LASP bf16x8_t*)(ka + 128), kA5 = *(const LASP bf16x8_t*)(ka + 160), kA6 = *(const LASP bf16x8_t*)(ka + 192), kA7 = *(const LASP bf16x8_t*)(ka + 224);
            const bf16x8_t qA0 = *(const LASP bf16x8_t*)(qa), qA1 = *(const LASP bf16x8_t*)(qa + 32), qA2 = *(const LASP bf16x8_t*)(qa + 64), qA3 = *(const LASP bf16x8_t*)(qa + 96);
            const bf16x8_t qA4 = *(const LASP bf16x8_t*)(qa + 128), qA5 = *(const LASP bf16x8_t*)(qa + 160), qA6 = *(const LASP bf16x8_t*)(qa + 192), qA7 = *(const LASP bf16x8_t*)(qa + 224);
            const LASP unsigned char* vbase = st + ST_V + troff + 64 * w;
            const bf16x8_t vB0 = TRFRAG(vbase), vB1 = TRFRAG(vbase + 16 * 320);
            const LASP unsigned char* tp = st + ST_TP + r * 80 + hh * 16;
            const bf16x8_t T0 = *(const LASP bf16x8_t*)(tp), T1 = *(const LASP bf16x8_t*)(tp + 32);
            const LASP unsigned char* qk = st + ST_QK + r * 80 + hh * 16;
            const bf16x8_t Q0 = *(const LASP bf16x8_t*)(qk), Q1 = *(const LASP bf16x8_t*)(qk + 32);
            const LASP float* sc = (const LASP float*)(st + ST_GL);
            const f32x4_t e0 = *(const LASP f32x4_t*)(sc + 4 * hh), e1 = *(const LASP f32x4_t*)(sc + 8 + 4 * hh), e2 = *(const LASP f32x4_t*)(sc + 16 + 4 * hh), e3 = *(const LASP f32x4_t*)(sc + 24 + 4 * hh);
            const f32x4_t f0 = *(const LASP f32x4_t*)(sc + 32 + 4 * hh), f1 = *(const LASP f32x4_t*)(sc + 40 + 4 * hh), f2 = *(const LASP f32x4_t*)(sc + 48 + 4 * hh), f3 = *(const LASP f32x4_t*)(sc + 56 + 4 * hh);
            const float gl = sc[64];
            __builtin_amdgcn_sched_barrier(0);
            f32x16_t ak, aq, vn;
#pragma unroll
            for (int i = 0; i < 16; ++i) { ak[i] = 0.f; aq[i] = 0.f; vn[i] = 0.f; }
            vn = MFMA32(T0, vB0, vn); vn = MFMA32(T1, vB1, vn);
#define GDN_KQ(KA, QA, SX, u) { const bf16x8_t SB = PACK8(SX, u); ak = MFMA32(KA, SB, ak); aq = MFMA32(QA, SB, aq); }
            GDN_KQ(kA0, qA0, S0, 0) GDN_KQ(kA1, qA1, S0, 1) GDN_KQ(kA2, qA2, S1, 0) GDN_KQ(kA3, qA3, S1, 1)
            GDN_KQ(kA4, qA4, S2, 0) GDN_KQ(kA5, qA5, S2, 1) GDN_KQ(kA6, qA6, S3, 0) GDN_KQ(kA7, qA7, S3, 1)
#undef GDN_KQ
            __builtin_amdgcn_sched_barrier(0);
            const LASP unsigned char* kn = st + ST_KN + troff;
            const bf16x8_t N00 = TRFRAG(kn), N01 = TRFRAG(kn + 16 * 320), N10 = TRFRAG(kn + 64), N11 = TRFRAG(kn + 64 + 16 * 320);
            const bf16x8_t N20 = TRFRAG(kn + 128), N21 = TRFRAG(kn + 128 + 16 * 320), N30 = TRFRAG(kn + 192), N31 = TRFRAG(kn + 192 + 16 * 320);
            __builtin_amdgcn_sched_barrier(0);
#define ROWSCALE(X, sgn) { X[0] *= sgn e0.x; X[1] *= sgn e0.y; X[2] *= sgn e0.z; X[3] *= sgn e0.w; X[4] *= sgn e1.x; X[5] *= sgn e1.y; X[6] *= sgn e1.z; X[7] *= sgn e1.w; \
                           X[8] *= sgn e2.x; X[9] *= sgn e2.y; X[10] *= sgn e2.z; X[11] *= sgn e2.w; X[12] *= sgn e3.x; X[13] *= sgn e3.y; X[14] *= sgn e3.z; X[15] *= sgn e3.w; }
            ROWSCALE(ak, -) ROWSCALE(aq, +)
#undef ROWSCALE
            const bf16x8_t ab0 = PACK8(ak, 0), ab1 = PACK8(ak, 1);
            vn = MFMA32(T0, ab0, vn); vn = MFMA32(T1, ab1, vn);
            S0 = S0 * gl; S1 = S1 * gl; S2 = S2 * gl; S3 = S3 * gl;
            const bf16x8_t vb0 = PACK8(vn, 0), vb1 = PACK8(vn, 1);
            f32x16_t vf;
            vf[0] = vn[0] * f0.x; vf[1] = vn[1] * f0.y; vf[2] = vn[2] * f0.z; vf[3] = vn[3] * f0.w; vf[4] = vn[4] * f1.x; vf[5] = vn[5] * f1.y; vf[6] = vn[6] * f1.z; vf[7] = vn[7] * f1.w;
            vf[8] = vn[8] * f2.x; vf[9] = vn[9] * f2.y; vf[10] = vn[10] * f2.z; vf[11] = vn[11] * f2.w; vf[12] = vn[12] * f3.x; vf[13] = vn[13] * f3.y; vf[14] = vn[14] * f3.z; vf[15] = vn[15] * f3.w;
            const bf16x8_t fb0 = PACK8(vf, 0), fb1 = PACK8(vf, 1);
            S0 = MFMA32(N00, fb0, S0); S1 = MFMA32(N10, fb0, S1); S2 = MFMA32(N20, fb0, S2); S3 = MFMA32(N30, fb0, S3);
            S0 = MFMA32(N01, fb1, S0); S1 = MFMA32(N11, fb1, S1); S2 = MFMA32(N21, fb1, S2); S3 = MFMA32(N31, fb1, S3);
            aq = MFMA32(Q0, vb0, aq); aq = MFMA32(Q1, vb1, aq);
            {
                LASP unsigned short* ost = (LASP unsigned short*)(lds + GDN_OST + (s & 1) * GDN_OST_BYTES) + 32 * w + r;
#pragma unroll
                for (int i = 0; i < 16; i += 2) { const unsigned pk = cvtpk(aq[i], aq[i + 1]); ost[crow(i, hh) * 136] = (unsigned short)pk; ost[(crow(i, hh) + 1) * 136] = (unsigned short)(pk >> 16); }
            }
            GDN_SYNC_C();
        }
    }
}

constexpr int GL_ITEM = 6272;
constexpr size_t GLA_PREP_OFF = (size_t)BATCH * 4 * 2 * NCH * GP_ITEM;

__device__ __forceinline__ void gla_prep_item(const P& p, LASP unsigned char* wl, const LASP float* cstab, int l, int it, int lane) {
    const int r = lane & 31, hh = lane >> 5;
    const int c = it % NCH, bh = it / NCH, h = bh & 3, b = bh >> 2;
    const size_t row0 = (size_t)b * TOK + (size_t)c * GCH;
    float qv[16], kv[16];
    {
        const bf16* qb = p.rest + (row0 + 4 * hh) * NREST + RC_CQ + h * 32 + r;
#pragma unroll
        for (int i = 0; i < 16; ++i) { const int no = (i & 3) + 8 * (i >> 2); qv[i] = bf2f(qb[(size_t)no * NREST]); kv[i] = bf2f(qb[(size_t)no * NREST + 128]); }
    }
    if (c >= 8) {
        const int dd = r & 15, f = dd & 7;
        const int prow = (c - 8) >> 1, pcol0 = 32 * ((c - 8) & 1);
#pragma unroll
        for (int i = 0; i < 16; ++i) {
            const int n = crow(i, hh);
            const int pos = r < 16 ? prow : pcol0 + n;
            const float cs = cstab[(pos * 8 + f) * 2], sn = cstab[(pos * 8 + f) * 2 + 1];
            const float qp = __shfl_xor(qv[i], 8), kp = __shfl_xor(kv[i], 8);
            if (dd < 8) { qv[i] = qv[i] * cs - qp * sn; kv[i] = kv[i] * cs - kp * sn; }
            else { qv[i] = qp * sn + qv[i] * cs; kv[i] = kp * sn + kv[i] * cs; }
        }
    }
#pragma unroll
    for (int i = 0; i < 16; ++i) qv[i] *= 0.17677669529663687f;
#pragma unroll 1
    for (int dir = 0; dir < 2; ++dir) {
        f32x16_t X;
#pragma unroll
        for (int i = 0; i < 16; ++i) X[i] = 0.f;
        {
            const bf16x8_t A = *(const bf16x8_t*)(p.rest + (row0 + r) * NREST + RC_CR + dir * 16 + 8 * hh);
            const float* w2p = p.gla_w2 + ((size_t)(l * 2 + dir) * 16 + 8 * hh) * 128 + h * 32 + r;
            const bf16x8_t Bf = __builtin_bit_cast(bf16x8_t, (u32x4_t){cvtpk(w2p[0], w2p[128]), cvtpk(w2p[256], w2p[384]), cvtpk(w2p[512], w2p[640]), cvtpk(w2p[768], w2p[896])});
            X = MFMA32(A, Bf, X);
        }
        const float b2v = p.gla_b2[(l * 2 + dir) * 128 + h * 32 + r];
        float Bc[16];
#pragma unroll
        for (int i = 0; i < 16; ++i) { const float xg = X[i] + b2v; Bc[i] = (fminf(xg, 0.f) - log1pf(expf(-fabsf(xg)))) * (1.f / 16.f); }
        float tot;
        {
            float sg[4], ps[4];
#pragma unroll
            for (int g = 0; g < 4; ++g) { sg[g] = (Bc[4 * g] + Bc[4 * g + 1]) + (Bc[4 * g + 2] + Bc[4 * g + 3]); ps[g] = __shfl_xor(sg[g], 32); }
            tot = ((sg[0] + ps[0]) + (sg[1] + ps[1])) + ((sg[2] + ps[2]) + (sg[3] + ps[3]));
            if (dir == 0) {
                float base = 0.f;
#pragma unroll
                for (int g = 0; g < 4; ++g) {
                    float o = base + (hh ? ps[g] : 0.f);
#pragma unroll
                    for (int k = 0; k < 4; ++k) { o += Bc[4 * g + k]; Bc[4 * g + k] = o; }
                    base += sg[g] + ps[g];
                }
            } else {
                float base = 0.f;
#pragma unroll
                for (int g = 3; g >= 0; --g) {
                    float o = base + (hh ? 0.f : ps[g]);
#pragma unroll
                    for (int k = 3; k >= 0; --k) { o += Bc[4 * g + k]; Bc[4 * g + k] = o; }
                    base += sg[g] + ps[g];
                }
            }
        }
        unsigned char* gout = (unsigned char*)p.raw + GLA_PREP_OFF + ((size_t)(bh * 2 + dir) * NCH + c) * GL_ITEM;
        LASP bf16* ql = (LASP bf16*)wl;
        LASP bf16* kl = ql + 32 * 40;
        {
            bf16* qpo = (bf16*)gout + perm16(r);
            bf16* kdo = (bf16*)(gout + 4096) + r * 32;
#pragma unroll
            for (int g = 0; g < 4; ++g) {
                float kd[4];
#pragma unroll
                for (int k = 0; k < 4; ++k) {
                    const int i = 4 * g + k, n = crow(i, hh);
                    const float eb = expf(Bc[i]);
                    const float qs = qv[i] * eb, ks = kv[i] / eb;
                    kd[k] = kv[i] * expf(tot - Bc[i]);
                    const bf16 qsb = f2bf(qs);
                    qpo[n * 32] = qsb;
                    ql[n * 40 + r] = qsb; kl[n * 40 + r] = f2bf(ks);
                }
                *(u32x2_t*)(kdo + perm16(8 * g + 4 * hh)) = (u32x2_t){cvtpk(kd[0], kd[1]), cvtpk(kd[2], kd[3])};
            }
            if (hh == 0) ((float*)(gout + 6144))[r] = expf(tot);
        }
        asm volatile("s_waitcnt lgkmcnt(0)" ::: "memory");
        f32x16_t AT;
#pragma unroll
        for (int i = 0; i < 16; ++i) AT[i] = 0.f;
        AT = MFMA32(*(const LASP bf16x8_t*)((const LASP unsigned char*)kl + r * 80 + hh * 16), *(const LASP bf16x8_t*)((const LASP unsigned char*)ql + r * 80 + hh * 16), AT);
        AT = MFMA32(*(const LASP bf16x8_t*)((const LASP unsigned char*)kl + r * 80 + hh * 16 + 32), *(const LASP bf16x8_t*)((const LASP unsigned char*)ql + r * 80 + hh * 16 + 32), AT);
        {
            bf16* amo = (bf16*)(gout + 2048) + r * 32;
#pragma unroll
            for (int g = 0; g < 4; ++g) {
                float a[4];
#pragma unroll
                for (int k = 0; k < 4; ++k) { const int m = crow(4 * g + k, hh); const bool keep = dir == 0 ? (m <= r) : (m >= r); a[k] = keep ? AT[4 * g + k] : 0.f; }
                *(u32x2_t*)(amo + perm16(8 * g + 4 * hh)) = (u32x2_t){cvtpk(a[0], a[1]), cvtpk(a[2], a[3])};
            }
        }
        asm volatile("s_waitcnt lgkmcnt(0)" ::: "memory");
    }
}

constexpr int LS_QP = 0, LS_AM = 2560, LS_KD = 5120, LS_V = 7680, LS_GL = 13824, LS_BYTES = 13952;
constexpr int GLA_OST = 4 * LS_BYTES, GLA_OST_BYTES = 32 * 144;
struct LSlot { u32x4_t a0, a1, a2, v0, v1; f32x4_t gl; };
__device__ __forceinline__ void gla_issue(const P& p, LSlot& g, int b, int h, int dir, int step, int t2) {
    const int c = gdn_chunk(dir, step);
    const unsigned char* gp = (const unsigned char*)p.raw + GLA_PREP_OFF + ((size_t)((b * 4 + h) * 2 + dir) * NCH + c) * GL_ITEM;
    g.a0 = *(const u32x4_t*)(gp + t2 * 16); g.a1 = *(const u32x4_t*)(gp + 2048 + t2 * 16); g.a2 = *(const u32x4_t*)(gp + 4096 + t2 * 16);
    g.gl = *(const f32x4_t*)(gp + 6144 + (t2 < 8 ? t2 : 0) * 16);
    const size_t row0 = (size_t)b * TOK + (size_t)c * GCH;
    const bf16* vp = p.rest + (row0 + (t2 >> 3)) * NREST + RC_CV + h * 64 + 8 * (t2 & 7);
    g.v0 = *(const u32x4_t*)vp; g.v1 = *(const u32x4_t*)(vp + (size_t)16 * NREST);
}
__device__ __forceinline__ void gla_write(LASP unsigned char* st, const LSlot& g, int t2) {
    const int row = t2 >> 2, ch = t2 & 3;
    *(LASP u32x4_t*)(st + LS_QP + row * 80 + ch * 16) = g.a0;
    *(LASP u32x4_t*)(st + LS_AM + row * 80 + ch * 16) = g.a1;
    *(LASP u32x4_t*)(st + LS_KD + row * 80 + ch * 16) = g.a2;
    if (t2 < 8) *(LASP f32x4_t*)(st + LS_GL + t2 * 16) = g.gl;
    *(LASP u32x4_t*)(st + LS_V + (t2 >> 3) * 192 + (t2 & 7) * 16) = g.v0; *(LASP u32x4_t*)(st + LS_V + (16 + (t2 >> 3)) * 192 + (t2 & 7) * 16) = g.v1;
}
__device__ __forceinline__ void gla_flush(const P& p, LASP unsigned char* lds, int b, int h, int dir, int step, int t2) {
    const int c = gdn_chunk(dir, step);
    const LASP unsigned char* ost = lds + GLA_OST + (dir * 2 + (step & 1)) * GLA_OST_BYTES;
    bf16* op = p.oc + ((size_t)dir * ROWS + (size_t)b * TOK + (size_t)c * GCH) * 256 + h * 64;
#pragma unroll
    for (int k = 0; k < 2; ++k) { const int idx = t2 + 128 * k, row = idx >> 3, ch = idx & 7; *(u32x4_t*)(op + (size_t)row * 256 + ch * 8) = *(const LASP u32x4_t*)(ost + row * 144 + ch * 16); }
}
#if TPROBE == 62
#define GLA_SYNC_C() do { unsigned long long t_ = __builtin_amdgcn_s_memrealtime(); __syncthreads(); if (bh == 0 && tid == 0) p.stats[2] += (float)(__builtin_amdgcn_s_memrealtime() - t_) * 0.01f; } while (0)
#define GLA_SYNC_L() __syncthreads()
#elif TPROBE == 63
#define GLA_SYNC_L() do { unsigned long long t_ = __builtin_amdgcn_s_memrealtime(); __syncthreads(); if (bh == 0 && tid == 256) p.stats[2] += (float)(__builtin_amdgcn_s_memrealtime() - t_) * 0.01f; } while (0)
#define GLA_SYNC_C() __syncthreads()
#else
#define GLA_SYNC_C() __syncthreads()
#define GLA_SYNC_L() __syncthreads()
#endif
__device__ void gla_scan_fast(const P& p, LASP unsigned char* lds, int bh) {
    const int tid = mk_tid();
    const int lane = tid & 63, wave = __builtin_amdgcn_readfirstlane(tid >> 6);
    const int h = bh & 3, b = bh >> 2;
    constexpr int NS = NCH;
    if (wave >= 4) {
        const int dir = (wave - 4) >> 1, t2 = tid & 127;
        LASP unsigned char* base = lds + dir * 2 * LS_BYTES;
        LSlot g0, g1, g2, g3;
        gla_issue(p, g0, b, h, dir, 0, t2); gla_issue(p, g1, b, h, dir, 1, t2); gla_issue(p, g2, b, h, dir, 2, t2); gla_issue(p, g3, b, h, dir, 3, t2);
        gla_write(base, g0, t2); gla_issue(p, g0, b, h, dir, 4, t2);
        __syncthreads();
#pragma unroll 1
        for (int s = 0; s < NS; s += 4) {
            if (s > 0) gla_flush(p, lds, b, h, dir, s - 1, t2);
            gla_write(base + ((s + 1) & 1) * LS_BYTES, g1, t2); gla_issue(p, g1, b, h, dir, min(s + 5, NS - 1), t2);
            GLA_SYNC_L();
            gla_flush(p, lds, b, h, dir, s, t2);
            gla_write(base + ((s + 2) & 1) * LS_BYTES, g2, t2); gla_issue(p, g2, b, h, dir, min(s + 6, NS - 1), t2);
            GLA_SYNC_L();
            gla_flush(p, lds, b, h, dir, s + 1, t2);
            gla_write(base + ((s + 3) & 1) * LS_BYTES, g3, t2); gla_issue(p, g3, b, h, dir, min(s + 7, NS - 1), t2);
            GLA_SYNC_L();
            gla_flush(p, lds, b, h, dir, s + 2, t2);
            gla_write(base + ((s + 4) & 1) * LS_BYTES, g0, t2); gla_issue(p, g0, b, h, dir, min(s + 8, NS - 1), t2);
            GLA_SYNC_L();
        }
        gla_flush(p, lds, b, h, dir, NS - 1, t2);
    } else {
        const int r = lane & 31, hh = lane >> 5, dir = wave >> 1, blk = wave & 1;
        LASP unsigned char* base = lds + dir * 2 * LS_BYTES;
        f32x16_t S;
#pragma unroll
        for (int i = 0; i < 16; ++i) S[i] = 0.f;
        __syncthreads();
        const int troff = (4 * hh + ((lane & 15) >> 2)) * 192 + (16 * ((lane >> 4) & 1) + 4 * (lane & 3)) * 2 + 64 * blk;
#define TRFRAG192(bs) __builtin_shufflevector(trd(bs), trd((bs) + 8 * 192), 0, 1, 2, 3, 4, 5, 6, 7)
#pragma unroll 1
        for (int s = 0; s < NS; ++s) {
            const LASP unsigned char* st = base + (s & 1) * LS_BYTES;
#if TPROBE == 64 || TPROBE == 65
            const unsigned long long ttop_ = __builtin_amdgcn_s_memrealtime();
            __builtin_amdgcn_sched_barrier(0);
#endif
            const LASP unsigned char* qp = st + LS_QP + r * 80 + hh * 16;
            const LASP unsigned char* am = st + LS_AM + r * 80 + hh * 16;
            const LASP unsigned char* kd = st + LS_KD + r * 80 + hh * 16;
            const bf16x8_t QP0 = *(const LASP bf16x8_t*)(qp), QP1 = *(const LASP bf16x8_t*)(qp + 32);
            const bf16x8_t AM0 = *(const LASP bf16x8_t*)(am), AM1 = *(const LASP bf16x8_t*)(am + 32);
            const bf16x8_t KD0 = *(const LASP bf16x8_t*)(kd), KD1 = *(const LASP bf16x8_t*)(kd + 32);
            const LASP unsigned char* vb = st + LS_V + troff;
            const bf16x8_t V0 = TRFRAG192(vb), V1 = TRFRAG192(vb + 16 * 192);
            const LASP float* glp = (const LASP float*)(st + LS_GL);
            const f32x4_t g0 = *(const LASP f32x4_t*)(glp + 4 * hh), g1 = *(const LASP f32x4_t*)(glp + 8 + 4 * hh), g2 = *(const LASP f32x4_t*)(glp + 16 + 4 * hh), g3 = *(const LASP f32x4_t*)(glp + 24 + 4 * hh);
            __builtin_amdgcn_sched_barrier(0);
#if TPROBE == 64 || TPROBE == 65
            asm volatile("s_waitcnt lgkmcnt(0)" ::: "memory");
            const unsigned long long tmid_ = __builtin_amdgcn_s_memrealtime();
            if (TPROBE == 64 && bh == 0 && tid == 0) p.stats[2] += (float)(tmid_ - ttop_) * 0.01f;
            __builtin_amdgcn_sched_barrier(0);
#endif
            const bf16x8_t Sb0 = PACK8(S, 0), Sb1 = PACK8(S, 1);
            f32x16_t oT;
#pragma unroll
            for (int i = 0; i < 16; ++i) oT[i] = 0.f;
            oT = MFMA32(V0, AM0, oT); oT = MFMA32(V1, AM1, oT);
            oT = MFMA32(Sb0, QP0, oT); oT = MFMA32(Sb1, QP1, oT);
            S[0] *= g0.x; S[1] *= g0.y; S[2] *= g0.z; S[3] *= g0.w; S[4] *= g1.x; S[5] *= g1.y; S[6] *= g1.z; S[7] *= g1.w;
            S[8] *= g2.x; S[9] *= g2.y; S[10] *= g2.z; S[11] *= g2.w; S[12] *= g3.x; S[13] *= g3.y; S[14] *= g3.z; S[15] *= g3.w;
            S = MFMA32(KD0, V0, S);
            S = MFMA32(KD1, V1, S);
            {
                LASP unsigned char* ost = lds + GLA_OST + (dir * 2 + (s & 1)) * GLA_OST_BYTES + r * 144 + (32 * blk + 4 * hh) * 2;
#pragma unroll
                for (int g = 0; g < 4; ++g) *(LASP u32x2_t*)(ost + 16 * g) = (u32x2_t){cvtpk(oT[4 * g], oT[4 * g + 1]), cvtpk(oT[4 * g + 2], oT[4 * g + 3])};
            }
#if TPROBE == 65
            __builtin_amdgcn_sched_barrier(0);
            asm volatile("s_nop 15\n\ts_nop 15" ::: "memory");
            if (bh == 0 && tid == 0) p.stats[2] += (float)(__builtin_amdgcn_s_memrealtime() - tmid_) * 0.01f;
#endif
            GLA_SYNC_C();
        }
    }
}


__device__ __forceinline__ void vf_item(const P& p, LASP unsigned char* wl, int it, int lane) {
    const int r = lane & 31, hh = lane >> 5;
    const int kb = it % NCH, bh = it / NCH, h = bh & 3, b = bh >> 2;
    const bf16* vp = p.rest + ((size_t)b * TOK + 32 * kb + r) * NREST + RC_BV + h * 64 + 32 * hh;
#pragma unroll
    for (int q = 0; q < 4; ++q) *(LASP u32x4_t*)(wl + r * 192 + (32 * hh + 8 * q) * 2) = *(const u32x4_t*)(vp + 8 * q);
    asm volatile("s_waitcnt lgkmcnt(0)" ::: "memory");
    const int troff = (4 * hh + ((lane & 15) >> 2)) * 192 + (16 * ((lane >> 4) & 1) + 4 * (lane & 3)) * 2;
    bf16* op = p.vf + ((size_t)(bh * NCH + kb) * 4) * 512 + lane * 8;
#pragma unroll
    for (int dvb = 0; dvb < 2; ++dvb)
#pragma unroll
        for (int u = 0; u < 2; ++u) {
            const LASP unsigned char* bs = wl + troff + 64 * dvb + (16 * u) * 192;
            const bf16x8_t f = __builtin_shufflevector(trd(bs), trd(bs + 8 * 192), 0, 1, 2, 3, 4, 5, 6, 7);
            *(bf16x8_t*)(op + (dvb * 2 + u) * 512) = f;
        }
    asm volatile("s_waitcnt lgkmcnt(0)" ::: "memory");
}

__device__ __forceinline__ void na_item(const P& p, const LASP float* rpbL, int it, int lane) {
    const int r = lane & 31, hh = lane >> 5;
    int b, h, ry, qb; bool lat;
    if (it < 4096) { lat = true; qb = it & 1; ry = (it >> 1) & 63; h = (it >> 7) & 3; b = it >> 9; }
    else { const int j = it - 4096; lat = false; qb = j & 7; h = (j >> 3) & 3; b = j >> 5; ry = 0; }
    const size_t brow = (size_t)b * TOK;
    const int q0 = lat ? CTX + ry * 64 + qb * 32 : qb * 32;
    bf16* qp = p.rest + (brow + q0 + r) * NREST + RC_BQ + h * 64;
    bf16x8_t Qf0 = *(const bf16x8_t*)(qp + 8 * hh), Qf1 = *(const bf16x8_t*)(qp + 16 + 8 * hh), Qf2 = *(const bf16x8_t*)(qp + 32 + 8 * hh), Qf3 = *(const bf16x8_t*)(qp + 48 + 8 * hh);
    f32x16_t O0, O1;
#pragma unroll
    for (int i = 0; i < 16; ++i) { O0[i] = 0.f; O1[i] = 0.f; }
    float m = -1e30f, lsum = 0.f;
    const bf16* kfb = p.kf + ((size_t)(b * 4 + h) * NCH) * 2048 + lane * 8;
    const bf16* vfb = p.vf + ((size_t)(b * 4 + h) * NCH) * 2048 + lane * 8;
    const int nkb = lat ? 24 : 8;
    const int c = qb * 32 + r, c0 = min(max(c - 8, 0), 48), r0 = min(max(ry - 4, 0), 56);
    constexpr float SC = 0.125f * 1.4426950408889634f;
    bf16x8_t nK0, nK1, nK2, nK3, nV00, nV01, nV10, nV11;
    {
        nK0 = *(const bf16x8_t*)(kfb); nK1 = *(const bf16x8_t*)(kfb + 512); nK2 = *(const bf16x8_t*)(kfb + 1024); nK3 = *(const bf16x8_t*)(kfb + 1536);
        nV00 = *(const bf16x8_t*)(vfb); nV01 = *(const bf16x8_t*)(vfb + 512); nV10 = *(const bf16x8_t*)(vfb + 1024); nV11 = *(const bf16x8_t*)(vfb + 1536);
    }
#pragma unroll 1
    for (int kb = 0; kb < nkb; ++kb) {
        int ky = 0, cb = 0; const bool win = kb >= 8;
        if (win) { const int w = kb - 8; ky = r0 + (w >> 1); cb = w & 1; }
        const bf16x8_t K0 = nK0, K1 = nK1, K2 = nK2, K3 = nK3, V00 = nV00, V01 = nV01, V10 = nV10, V11 = nV11;
        {
            const int kn = min(kb + 1, nkb - 1);
            const int wn = kn - 8;
            const int kbn = kn < 8 ? kn : 8 + (r0 + (wn >> 1)) * 2 + (wn & 1);
            const bf16* kp = kfb + (size_t)kbn * 2048;
            nK0 = *(const bf16x8_t*)(kp); nK1 = *(const bf16x8_t*)(kp + 512); nK2 = *(const bf16x8_t*)(kp + 1024); nK3 = *(const bf16x8_t*)(kp + 1536);
            const bf16* vp = vfb + (size_t)kbn * 2048;
            nV00 = *(const bf16x8_t*)(vp); nV01 = *(const bf16x8_t*)(vp + 512); nV10 = *(const bf16x8_t*)(vp + 1024); nV11 = *(const bf16x8_t*)(vp + 1536);
        }
        f32x16_t S;
#pragma unroll
        for (int i = 0; i < 16; ++i) S[i] = 0.f;
        S = MFMA32(K0, Qf0, S); S = MFMA32(K1, Qf1, S); S = MFMA32(K2, Qf2, S); S = MFMA32(K3, Qf3, S);
        float bm = -1e30f;
        if (win) {
            const LASP float* rb = rpbL + (h * 15 + (ky - ry + 7)) * 31 + 15 - c;
#pragma unroll
            for (int i = 0; i < 16; ++i) {
                const int kc = cb * 32 + crow(i, hh);
                const bool valid = (kc >= c0) && (kc < c0 + 16);
                const float bias = rb[valid ? kc : c];
                S[i] = valid ? S[i] * SC + bias : -1e30f;
                bm = fmaxf(bm, S[i]);
            }
        } else {
#pragma unroll
            for (int i = 0; i < 16; ++i) { S[i] *= SC; bm = fmaxf(bm, S[i]); }
        }
        bm = fmaxf(bm, __shfl_xor(bm, 32));
        const float mn = fmaxf(m, bm);
        const float alpha = __builtin_amdgcn_exp2f(m - mn);
        m = mn;
        float ps = 0.f;
#pragma unroll
        for (int i = 0; i < 16; ++i) { S[i] = __builtin_amdgcn_exp2f(S[i] - mn); ps += S[i]; }
        lsum = lsum * alpha + ps;
#pragma unroll
        for (int i = 0; i < 16; ++i) { O0[i] *= alpha; O1[i] *= alpha; }
        const bf16x8_t Pb0 = PACK8(S, 0), Pb1 = PACK8(S, 1);
        O0 = MFMA32(V00, Pb0, O0); O0 = MFMA32(V01, Pb1, O0);
        O1 = MFMA32(V10, Pb0, O1); O1 = MFMA32(V11, Pb1, O1);
    }
    const float inv = 1.f / (lsum + __shfl_xor(lsum, 32));
    bf16* op = qp + 4 * hh;
#pragma unroll
    for (int g = 0; g < 4; ++g) {
        *(u32x2_t*)(op + 8 * g) = (u32x2_t){cvtpk(O0[4 * g] * inv, O0[4 * g + 1] * inv), cvtpk(O0[4 * g + 2] * inv, O0[4 * g + 3] * inv)};
        *(u32x2_t*)(op + 32 + 8 * g) = (u32x2_t){cvtpk(O1[4 * g] * inv, O1[4 * g + 1] * inv), cvtpk(O1[4 * g + 2] * inv, O1[4 * g + 3] * inv)};
    }
}

__device__ void ph_prep(const P& p, LASP unsigned char* lds, int l, int bid, int nblk) {
    const int tid = mk_tid();
    LASP float* cstab = (LASP float*)(lds + 131072);
    {
        const int pos = tid >> 3, f = tid & 7;
        const float ang = (float)pos * powf(10000.f, -(float)f / 8.f);
        cstab[tid * 2] = cosf(ang); cstab[tid * 2 + 1] = sinf(ang);
    }
    __syncthreads();
    ph_gdnprep(p, lds, l, bid, nblk, tid);
    const int lane = tid & 63, wave = tid >> 6;
    for (int it = (nblk - 1 - bid) * NWAVES + wave; it < BATCH * 4 * NCH; it += nblk * NWAVES) gla_prep_item(p, lds + wave * 16384, cstab, l, it, lane);
    for (int it = bid * NWAVES + wave; it < BATCH * 4 * NCH; it += nblk * NWAVES) vf_item(p, lds + wave * 16384, it, lane);
}


__device__ void ph_mix(const P& p, LASP unsigned char* lds, int l, int bid, int nblk) {
    constexpr int NGDN = BATCH * 4 * 2;
    constexpr int NGLA = BATCH * 4;
    if (bid < NGDN) { gdn_scan_fast(p, lds, bid); return; }
    if (bid < NGDN + NGLA) { gla_scan_fast(p, lds, bid - NGDN); return; }
    const int tid = mk_tid();
    const int lane = tid & 63, wave = tid >> 6;
    LASP float* rpbL = (LASP float*)lds;
    for (int i = tid; i < 4 * 15 * 31; i += NTHREADS) rpbL[i] = p.rpb[(size_t)l * 4 * 15 * 31 + i] * 1.4426950408889634f;
    __syncthreads();
    const int total = 4096 + (l == 0 ? 256 : 0);
    for (int it = (bid - NGDN - NGLA) * NWAVES + wave; it < total; it += (nblk - NGDN - NGLA) * NWAVES) na_item(p, rpbL, it, lane);
}

__device__ void ph_gate(const P& p, int l, int bid, int nblk) {
    const int tid = mk_tid();
    const int tq = tid & 127, rsub = tid >> 7;
    const int kind = tq < 64 ? 0 : (tq < 96 ? 1 : 2);
    const int cb = kind == 0 ? tq * 8 : (kind == 1 ? (tq - 64) * 8 : (tq - 96) * 8);
    const int zoff = kind == 0 ? RC_AZ + cb : (kind == 1 ? RC_BZ + cb : RC_CZ + cb);
    const int oc = kind == 0 ? cb : (kind == 1 ? 512 + cb : 768 + cb);
    float nw[8];
#pragma unroll
    for (int e = 0; e < 8; ++e) nw[e] = kind == 0 ? p.gdn_norm[l * 128 + ((cb + e) & 127)] : (kind == 2 ? p.gla_norm[l * 64 + ((cb + e) & 63)] : 1.f);
    for (int r0 = bid * 16; r0 < ROWS; r0 += nblk * 16) {
        uint4 a[4], bb[4], zz[4];
#pragma unroll
        for (int j = 0; j < 4; ++j) {
            const size_t r = (size_t)(r0 + rsub + 4 * j);
            const bf16* pr = p.rest + r * NREST;
            zz[j] = *(const uint4*)(pr + zoff);
            if (kind == 0) { a[j] = *(const uint4*)(p.oa + r * 512 + cb); bb[j] = *(const uint4*)(p.oa + ((size_t)ROWS + r) * 512 + cb); }
            else if (kind == 1) { a[j] = *(const uint4*)(pr + RC_BQ + cb); bb[j] = make_uint4(0, 0, 0, 0); }
            else { a[j] = *(const uint4*)(p.oc + r * 256 + cb); bb[j] = *(const uint4*)(p.oc + ((size_t)ROWS + r) * 256 + cb); }
        }
#pragma unroll
        for (int j = 0; j < 4; ++j) {
            float fa[8], fb[8], z[8], o[8];
            unpack8(a[j], fa); unpack8(bb[j], fb); unpack8(zz[j], z);
            float ss = 0.f;
#pragma unroll
            for (int e = 0; e < 8; ++e) { o[e] = fa[e] + fb[e]; ss += o[e] * o[e]; }
            float rs = 1.f;
            if (kind == 0) {
#pragma unroll
                for (int m = 8; m > 0; m >>= 1) ss += __shfl_xor(ss, m);
                rs = __builtin_amdgcn_rsqf(ss * (1.f / 128.f) + 1e-6f);
            } else if (kind == 2) {
#pragma unroll
                for (int m = 4; m > 0; m >>= 1) ss += __shfl_xor(ss, m);
                rs = __builtin_amdgcn_rsqf(ss * (1.f / 64.f) + 1e-6f);
            }
            float res[8];
#pragma unroll
            for (int e = 0; e < 8; ++e) res[e] = o[e] * rs * nw[e] * silu_f(z[e]);
            uint4 w; w.x = pk2(res[0], res[1]); w.y = pk2(res[2], res[3]); w.z = pk2(res[4], res[5]); w.w = pk2(res[6], res[7]);
            *(uint4*)(p.mix + (size_t)(r0 + rsub + 4 * j) * D + oc) = w;
        }
    }
}

#if PROBE
__device__ void gdn_scan_naive(const P& p, LASP float* sm, int l, int b, int hp, bf16* nb) {
    const int tid = mk_tid();
    LASP float* skq = sm;
    LASP float* sv = sm + 4 * 16 * 256;
    LASP float* sg = sv + 4 * 16 * 128;
    LASP float* sb = sg + 64;
    const int sub = tid >> 7, col = tid & 127, dir = sub & 1, h = hp * 2 + (sub >> 1);
    float S[128];
#pragma unroll
    for (int i = 0; i < 128; ++i) S[i] = 0.f;
    for (int s0 = 0; s0 < TOK; s0 += 16) {
        __syncthreads();
        for (int i = tid; i < 4 * 16 * 48; i += NTHREADS) {
            const int su = i / (16 * 48), rem = i % (16 * 48), j = rem / 48, chunk = rem % 48;
            const int sd = su & 1, hh = hp * 2 + (su >> 1);
            const int t = tok_of(sd, s0 + j);
            const size_t row = (size_t)b * TOK + t;
            const int part = chunk >> 4, c8 = chunk & 15;
            const uint4 w = *(const uint4*)(p.qkvn + row * NRAW + part * 512 + hh * 128 + c8 * 8);
            float f[8]; unpack8(w, f);
            LASP float* dst = (part < 2) ? skq + (su * 16 + j) * 256 + part * 128 + c8 * 8 : sv + (su * 16 + j) * 128 + c8 * 8;
#pragma unroll
            for (int e = 0; e < 8; ++e) dst[e] = f[e];
        }
        if (tid < 64) {
            const int su = tid >> 4, j = tid & 15, sd = su & 1, hh = hp * 2 + (su >> 1);
            const int t = tok_of(sd, s0 + j);
            const bf16* ab = p.rest + ((size_t)b * TOK + t) * NREST + RC_AB;
            const float a = bf2f(ab[sd * 4 + hh]) + p.dt_bias[(l * 2 + sd) * 4 + hh];
            const float sp = fmaxf(a, 0.f) + log1pf(expf(-fabsf(a)));
            const float g = -expf(p.a_log[(l * 2 + sd) * 4 + hh]) * sp;
            sg[su * 16 + j] = expf(g);
            const float bx = bf2f(ab[(2 + sd) * 4 + hh]);
            sb[su * 16 + j] = 1.f / (1.f + expf(-bx));
        }
        __syncthreads();
#pragma unroll 1
        for (int j = 0; j < 16; ++j) {
            const LASP float* qp = skq + (sub * 16 + j) * 256;
            const LASP float* kp = qp + 128;
            const float dec = sg[sub * 16 + j], bt = sb[sub * 16 + j];
            const float v = sv[(sub * 16 + j) * 128 + col];
            float d0 = 0.f, d1 = 0.f, d2 = 0.f, d3 = 0.f;
#pragma unroll
            for (int k4 = 0; k4 < 32; ++k4) {
                const f32x4_t kv = *(const LASP f32x4_t*)(kp + k4 * 4);
                d0 += S[k4 * 4] * kv.x; d1 += S[k4 * 4 + 1] * kv.y; d2 += S[k4 * 4 + 2] * kv.z; d3 += S[k4 * 4 + 3] * kv.w;
                if ((k4 & 7) == 7) __builtin_amdgcn_sched_barrier(0);
            }
            const float dot = (d0 + d1) + (d2 + d3);
            const float vn = bt * (v - dec * dot);
            float o0 = 0.f, o1 = 0.f, o2 = 0.f, o3 = 0.f;
#pragma unroll
            for (int k4 = 0; k4 < 32; ++k4) {
                const f32x4_t kv = *(const LASP f32x4_t*)(kp + k4 * 4);
                const f32x4_t qv = *(const LASP f32x4_t*)(qp + k4 * 4);
                S[k4 * 4] = dec * S[k4 * 4] + kv.x * vn; o0 += S[k4 * 4] * qv.x;
                S[k4 * 4 + 1] = dec * S[k4 * 4 + 1] + kv.y * vn; o1 += S[k4 * 4 + 1] * qv.y;
                S[k4 * 4 + 2] = dec * S[k4 * 4 + 2] + kv.z * vn; o2 += S[k4 * 4 + 2] * qv.z;
                S[k4 * 4 + 3] = dec * S[k4 * 4 + 3] + kv.w * vn; o3 += S[k4 * 4 + 3] * qv.w;
                if ((k4 & 3) == 3) __builtin_amdgcn_sched_barrier(0);
            }
            const int t = tok_of(dir, s0 + j);
            nb[((size_t)dir * TOK + t) * 256 + (h & 1) * 128 + col] = f2bf((o0 + o1) + (o2 + o3));
        }
    }
    __syncthreads();
}

__device__ void gla_scan_naive(const P& p, LASP float* sm, int l, int b, bf16* nb) {
    const int tid = mk_tid();
    LASP float* sq = sm;
    LASP float* sv = sm + 8 * 16 * 96;
    const int grp = tid >> 6, lane = tid & 63, h = grp >> 1, dir = grp & 1;
    const int d = lane & 31, par = lane >> 5;
    float w2c[16];
#pragma unroll
    for (int j = 0; j < 16; ++j) w2c[j] = p.gla_w2[((size_t)(l * 2 + dir) * 16 + j) * 128 + h * 32 + d];
    const float b2v = p.gla_b2[(l * 2 + dir) * 128 + h * 32 + d];
    const int dd = d & 15, f = dd & 7;
    const float inv = powf(10000.f, -(float)f / 8.f);
    const int pd = dd < 8 ? d + 8 : d - 8;
    float S[32];
#pragma unroll
    for (int i = 0; i < 32; ++i) S[i] = 0.f;
    for (int s0 = 0; s0 < TOK; s0 += 16) {
        __syncthreads();
#pragma unroll 1
        for (int jj = 0; jj < 8; ++jj) {
            const int j = par + 2 * jj;
            const int t = tok_of(dir, s0 + j);
            const bf16* base = p.rest + ((size_t)b * TOK + t) * NREST;
            float qv = bf2f(base[RC_CQ + h * 32 + d]), kv = bf2f(base[RC_CK + h * 32 + d]);
            if (t >= CTX) {
                const int pidx = t - CTX;
                const int pos = d < 16 ? (pidx >> 6) : (pidx & 63);
                const float ang = (float)pos * inv;
                const float cs = cosf(ang), sn = sinf(ang);
                const float qp = bf2f(base[RC_CQ + h * 32 + pd]), kp = bf2f(base[RC_CK + h * 32 + pd]);
                if (dd < 8) { qv = qv * cs - qp * sn; kv = kv * cs - kp * sn; }
                else { qv = qp * sn + qv * cs; kv = kp * sn + kv * cs; }
            }
            qv *= 0.17677669529663687f;
            float xg = b2v;
#pragma unroll
            for (int jr = 0; jr < 16; ++jr) xg += bf2f(base[RC_CR + dir * 16 + jr]) * w2c[jr];
            const float ls = fminf(xg, 0.f) - log1pf(expf(-fabsf(xg)));
            LASP float* dst = sq + (grp * 16 + j) * 96;
            dst[d] = qv; dst[32 + d] = kv; dst[64 + d] = expf(ls * (1.f / 16.f));
        }
        for (int i = lane; i < 16 * 64; i += 64) {
            const int j = i >> 6, c = i & 63;
            const int t = tok_of(dir, s0 + j);
            sv[(grp * 16 + j) * 64 + c] = bf2f(p.rest[((size_t)b * TOK + t) * NREST + RC_CV + h * 64 + c]);
        }
        __syncthreads();
#pragma unroll 1
        for (int j = 0; j < 16; ++j) {
            const LASP float* qp = sq + (grp * 16 + j) * 96;
            const LASP float* kp = qp + 32;
            const LASP float* dp = qp + 64;
            const float v = sv[(grp * 16 + j) * 64 + lane];
            float o0 = 0.f, o1 = 0.f;
#pragma unroll
            for (int e = 0; e < 32; e += 2) {
                S[e] = dp[e] * S[e] + kp[e] * v; o0 += S[e] * qp[e];
                S[e + 1] = dp[e + 1] * S[e + 1] + kp[e + 1] * v; o1 += S[e + 1] * qp[e + 1];
            }
            const int t = tok_of(dir, s0 + j);
            nb[((size_t)dir * TOK + t) * 256 + h * 64 + lane] = f2bf(o0 + o1);
        }
    }
    __syncthreads();
}

__device__ void na_query_naive(const P& p, LASP float* sm, int l, int b, int t0, bf16* nb) {
    const int tid = mk_tid();
    const int wave = tid >> 6, lane = tid & 63, h = wave & 3, t = t0 + (wave >> 2);
    LASP float* pw = sm + wave * 384;
    const size_t rowq = (size_t)b * TOK + t;
    float qv[64];
    {
        const bf16* qs = p.rest + rowq * NREST + RC_BQ + h * 64;
#pragma unroll
        for (int i = 0; i < 8; ++i) {
            float f[8]; unpack8(*(const uint4*)(qs + i * 8), f);
#pragma unroll
            for (int e = 0; e < 8; ++e) qv[i * 8 + e] = f[e] * 0.125f;
        }
    }
    const bool lat = t >= CTX;
    const int nk = lat ? 384 : 256;
    int r = 0, c = 0, r0 = 0, c0 = 0;
    if (lat) { int pi = t - CTX; r = pi >> 6; c = pi & 63; r0 = min(max(r - 4, 0), 56); c0 = min(max(c - 8, 0), 48); }
    float m = -1e30f;
    __syncthreads();
#pragma unroll 1
    for (int j = 0; j < 6; ++j) {
        const int idx = lane + 64 * j;
        float s = -1e30f;
        if (idx < nk) {
            int tk; float bias = 0.f;
            if (lat && idx < 128) {
                const int i = idx >> 4, kc = c0 + (idx & 15);
                tk = CTX + (r0 + i) * 64 + kc;
                bias = p.rpb[((size_t)(l * 4 + h) * 15 + (r0 + i - r + 7)) * 31 + (kc - c + 15)];
            } else tk = lat ? idx - 128 : idx;
            const bf16* ks = p.kf + (((size_t)(b * 4 + h) * NCH + (tk >> 5)) * 4 * 64 + (tk & 31)) * 8;
            float d0 = 0.f, d1 = 0.f;
#pragma unroll
            for (int i = 0; i < 8; ++i) {
                float f[8]; unpack8(*(const uint4*)(ks + ((i >> 1) * 64 + (i & 1) * 32) * 8), f);
#pragma unroll
                for (int e = 0; e < 8; e += 2) { d0 += qv[i * 8 + e] * f[e]; d1 += qv[i * 8 + e + 1] * f[e + 1]; }
            }
            s = d0 + d1 + bias;
        }
        pw[idx] = s;
        m = fmaxf(m, s);
    }
    m = wave_max(m);
    float sum = 0.f;
#pragma unroll 1
    for (int j = 0; j < 6; ++j) { const float e = expf(pw[lane + 64 * j] - m); pw[lane + 64 * j] = e; sum += e; }
    sum = wave_sum(sum);
    const float inv = 1.f / sum;
    __syncthreads();
    float o0 = 0.f, o1 = 0.f;
    for (int idx = 0; idx < nk; idx += 2) {
        int tk0;
        if (lat && idx < 128) tk0 = CTX + (r0 + (idx >> 4)) * 64 + c0 + (idx & 15);
        else tk0 = lat ? idx - 128 : idx;
        o0 += pw[idx] * bf2f(p.rest[((size_t)b * TOK + tk0) * NREST + RC_BV + h * 64 + lane]);
        o1 += pw[idx + 1] * bf2f(p.rest[((size_t)b * TOK + tk0 + 1) * NREST + RC_BV + h * 64 + lane]);
    }
    nb[(size_t)t * 256 + h * 64 + lane] = f2bf((o0 + o1) * inv);
}


__device__ void ph_probe_naive(const P& p, LASP float* sm, int l, int bid, int nblk) {
    bf16* nb = (bf16*)p.xc1;
    if (PROBE == 1) { if (bid == 0) gdn_scan_naive(p, sm, l, 0, 0, nb); }
    else if (PROBE == 3) { if (bid == 0) gla_scan_naive(p, sm, l, 0, nb); }
    else { for (int it = bid; it < TOK / 2; it += nblk) na_query_naive(p, sm, l, 0, it * 2, nb); }
}
__device__ void ph_probe_cmp(const P& p, int bid, int nblk) {
    const int tid = mk_tid();
    const bf16* nb = (const bf16*)p.xc1;
    float md = 0.f, mr = 0.f;
    const int n = (PROBE == 2) ? TOK * 256 : 2 * TOK * 256;
    for (int i = bid * NTHREADS + tid; i < n; i += nblk * NTHREADS) {
        float a, r = bf2f(nb[i]);
        if (PROBE == 1) { const int dir = i / (TOK * 256), rem = i % (TOK * 256), t = rem >> 8, c = rem & 255; a = bf2f(p.oa[((size_t)dir * ROWS + t) * 512 + c]); }
        else if (PROBE == 3) { const int dir = i / (TOK * 256), rem = i % (TOK * 256); a = bf2f(p.oc[(size_t)dir * ROWS * 256 + rem]); }
        else { const int t = i >> 8, c = i & 255; a = bf2f(p.rest[(size_t)t * NREST + RC_BQ + c]); }
        md = fmaxf(md, fabsf(a - r)); mr = fmaxf(mr, fabsf(r));
    }
    md = wave_max(md); mr = wave_max(mr);
    if ((tid & 63) == 0) { atomicMax((unsigned*)p.stats, __float_as_uint(md)); atomicMax((unsigned*)p.stats + 1, __float_as_uint(mr)); }
}
#endif

#define XB_TMO      128
#define XB_XCNT(j)  (256  + 64 * (j))
#define XB_XSUB(j)  (1280 + 64 * (j))
#define XB_XGEN(j)  (2304 + 64 * (j))
#define XB_TOP      3328
#define XB_TOPGEN   3392
#define XCD_BAR_WORDS 3456
#define XB_SPIN_CAP (1u << 18)

__device__ __forceinline__ unsigned xb_ld(unsigned* p)              { return __hip_atomic_load(p, __ATOMIC_RELAXED, __HIP_MEMORY_SCOPE_AGENT); }
__device__ __forceinline__ unsigned xb_add(unsigned* p, unsigned v) { return __hip_atomic_fetch_add(p, v, __ATOMIC_RELAXED, __HIP_MEMORY_SCOPE_AGENT); }
__device__ __forceinline__ unsigned xb_xcc_id() { return (unsigned)__builtin_amdgcn_s_getreg((3 << 11) | 20) & 0xFu; }
#define XB_SPIN(cond, bar) do { unsigned _sp = 0; while (cond) { __builtin_amdgcn_s_sleep(1); \
    if ((++_sp & 255u) == 0u) { if (xb_ld(&(bar)[XB_TMO])) break; if (_sp > XB_SPIN_CAP) { atomicAdd(&(bar)[XB_TMO], 1u); break; } } } } while (0)

struct XcdBarrier {
    unsigned* bar; unsigned x;
    volatile LASP unsigned* st;
};

__device__ __forceinline__ XcdBarrier xcd_barrier_post(unsigned* bar, volatile LASP unsigned* st) {
    XcdBarrier b; b.bar = bar; b.x = xb_xcc_id(); b.st = st;
    if ((int)threadIdx.x == 0) (void)xb_add(&bar[XB_XCNT(b.x)], 1u);
    return b;
}
__device__ __forceinline__ void xcd_barrier_complete(unsigned* bar, unsigned x, unsigned& nloc, unsigned& nx) {
    const unsigned G = gridDim.x * gridDim.y * gridDim.z;
    unsigned sum, cnt, mine, sp = 0u;
    for (;;) {
        sum = 0u; cnt = 0u; mine = 0u;
#pragma unroll
        for (unsigned j = 0; j < 16; ++j) { const unsigned c = xb_ld(&bar[XB_XCNT(j)]); sum += c; cnt += (c > 0u) ? 1u : 0u; mine = (j == x) ? c : mine; }
        if (sum == G) break;
        __builtin_amdgcn_s_sleep(1);
        if ((++sp & 255u) == 0u) { if (xb_ld(&bar[XB_TMO])) break; if (sp > XB_SPIN_CAP) { atomicAdd(&bar[XB_TMO], 1u); break; } }
    }
    nloc = mine > 0u ? mine : 1u; nx = cnt > 0u ? cnt : 1u;
}

__device__ __forceinline__ void xcd_barrier(const XcdBarrier& b) {
    asm volatile("s_waitcnt vmcnt(0)" ::: "memory");
    __syncthreads();
    if ((int)threadIdx.x == 0) {
        unsigned* bar = b.bar;
        __builtin_amdgcn_s_waitcnt(0);
        unsigned nloc = b.st[0], nx = b.st[1];
        if (nloc == 0u) { xcd_barrier_complete(bar, b.x, nloc, nx); b.st[0] = nloc; b.st[1] = nx; }
        const unsigned old = xb_add(&bar[XB_XSUB(b.x)], 1u);
        const unsigned gen = old / nloc;
        if (old + 1u == (gen + 1u) * nloc) {
            __builtin_amdgcn_fence(__ATOMIC_RELEASE, "agent");
            asm volatile("s_waitcnt vmcnt(0)" ::: "memory");
            const unsigned og = xb_add(&bar[XB_TOP], 1u);
            const unsigned tg = og / nx;
            if (og + 1u == (tg + 1u) * nx) xb_add(&bar[XB_TOPGEN], 1u);
            else XB_SPIN(xb_ld(&bar[XB_TOPGEN]) == tg, bar);
            __builtin_amdgcn_fence(__ATOMIC_ACQUIRE, "agent");
            xb_add(&bar[XB_XGEN(b.x)], 1u);
            asm volatile("s_waitcnt vmcnt(0)" ::: "memory");
        } else {
            XB_SPIN(xb_ld(&bar[XB_XGEN(b.x)]) == gen, bar);
            __builtin_amdgcn_fence(__ATOMIC_ACQUIRE, "agent");
            asm volatile("s_waitcnt vmcnt(0)" ::: "memory");
        }
    }
    __syncthreads();
}


constexpr int NSTEP = 1 + 2 * 7 + 1;
__global__ void __launch_bounds__(NTHREADS, 2) k_mega(P p) {
    extern __shared__ __attribute__((aligned(16))) unsigned char lds_raw[];
    LASP unsigned char* lds = (LASP unsigned char*)lds_raw;
    cg::grid_group grid = cg::this_grid();
    const int bid = blockIdx.x, nblk = gridDim.x;
    volatile LASP unsigned* bst = (volatile LASP unsigned*)(lds + LDS_BYTES - 64);
    if (threadIdx.x < 16) bst[threadIdx.x] = 0u;
    __syncthreads();
    const XcdBarrier bar = xcd_barrier_post((unsigned*)p.ctl, bst);
#pragma unroll 1
    for (int step = 0; step < NSTEP; ++step) {
        int ph = 0, l = 0;
        if (step > 0) { const int s1 = step - 1; l = s1 / 7; ph = 1 + s1 % 7; }
#if TPROBE >= 0
        unsigned long long tp0 = 0;
        if (bid == 0 && threadIdx.x == 0) { if (step == 0) p.stats[2] = 0.f; tp0 = __builtin_amdgcn_s_memrealtime(); }
#endif
        if (ph == 0) ph_prologue(p, lds, bid, nblk);
        else if (ph == 1) ph_lnpass(p, l, bid, nblk);
        else if (l < 2) {
            if (ph == 2) {
                pg8::Gemm g{p.ml, p.wi_t + (size_t)l * NPAD * D, ROWS, NPAD, D}; pg8::StaticOrder S; S.init(ROWS, NPAD, nblk, bid);
                EpiProj E{p.raw, p.rest, p.kf};
                pg8::gemm_phase<EpiProj, pg8::StaticOrder, true, true>(lds, g, S, E);
            } else if (ph == 3) ph_conv(p, l, bid, nblk);
            else if (ph == 4) ph_prep(p, lds, l, bid, nblk);
            else if (ph == 5) {
#if PROBE
                if (l == 0) { ph_probe_naive(p, (LASP float*)lds, l, bid, nblk); xcd_barrier(bar); }
#endif
#if TPROBE >= 50
                unsigned long long tr0 = 0;
                const bool inrole = TPROBE == 50 ? (bid < 64) : (TPROBE == 51 ? (bid >= 64 && bid < 96) : (bid >= 96));
                const float rscale = TPROBE == 50 ? (1.f / 64.f) : (TPROBE == 51 ? (1.f / 32.f) : (1.f / 160.f));
                if (inrole && threadIdx.x == 0) tr0 = __builtin_amdgcn_s_memrealtime();
#endif
                ph_mix(p, lds, l, bid, nblk);
#if TPROBE >= 50
                if (inrole && threadIdx.x == 0) atomicAdd(&p.stats[2], (float)(__builtin_amdgcn_s_memrealtime() - tr0) * 0.01f * rscale);
#endif
#if PROBE
                if (l == 0) { xcd_barrier(bar); ph_probe_cmp(p, bid, nblk); }
#endif
            }
            else if (ph == 6) ph_gate(p, l, bid, nblk);
            else if (ph == 7) {
                pg8::Gemm g{p.mix, p.wo_t + (size_t)l * D * D, ROWS, D, D};
                EpiY E{p.ml};
                if (l == 0) { pg8::StaticOrder S; S.init(ROWS, D, nblk, bid); pg8::gemm_phase<EpiY, pg8::StaticOrder, true, true>(lds, g, S, E); }
                else { LatentOrder S; S.S.init(BATCH * SEQ, D, nblk, bid); pg8::gemm_phase<EpiY, LatentOrder, true, true>(lds, g, S, E); }
            }
        }
        if (step == 0) grid.sync(); else xcd_barrier(bar);
#if TPROBE >= 0
        if (bid == 0 && threadIdx.x == 0 && ph == TPROBE) p.stats[2] += (float)(__builtin_amdgcn_s_memrealtime() - tp0) * 0.01f;
#endif
    }
}

extern "C" void kernel_launch(void* const* d_in, const int* in_sizes, int n_in, void* d_out, int out_size, void* d_ws, size_t ws_size,
                              hipStream_t stream) {
    P p{};
    p.x = (const float*)d_in[0]; p.c = (const float*)d_in[1]; p.ctx = (const float*)d_in[2]; p.c_ctx = (const float*)d_in[3];
    p.w_mod = (const float*)d_in[4]; p.b_mod = (const float*)d_in[5]; p.w_in = (const float*)d_in[6]; p.conv_w = (const float*)d_in[7];
    p.a_log = (const float*)d_in[8]; p.dt_bias = (const float*)d_in[9]; p.gdn_norm = (const float*)d_in[10]; p.rpb = (const float*)d_in[11];
    p.gla_w2 = (const float*)d_in[12]; p.gla_b2 = (const float*)d_in[13]; p.gla_norm = (const float*)d_in[14]; p.w_out = (const float*)d_in[15];
    p.ln_g = (const float*)d_in[16]; p.ln_b = (const float*)d_in[17];
    p.out = (float*)d_out;
    unsigned char* w = (unsigned char*)d_ws;
    size_t off = 0;
    auto take = [&](size_t bytes) { unsigned char* r = w + off; off += (bytes + 255) & ~(size_t)255; return r; };
    p.ctl = (unsigned*)take(16384);
    p.mods = (float*)take((size_t)2 * 9 * 3072 * 4);
    p.xc1 = (float*)take((size_t)BATCH * CTX * D * 4);
    p.wi_t = (bf16*)take((size_t)2 * NPAD * D * 2);
    p.wo_t = (bf16*)take((size_t)2 * D * D * 2);
    p.rest = (bf16*)take((size_t)ROWS * NREST * 2);
    p.raw = (bf16*)take((size_t)ROWS * NRAW * 2);
    p.qkvn = (bf16*)take((size_t)ROWS * NRAW * 2);
    p.mix = p.qkvn;
    p.oa = (bf16*)take((size_t)2 * ROWS * 512 * 2);
    p.oc = (bf16*)take((size_t)2 * ROWS * 256 * 2);
    p.ml = p.oa;
    p.vf = (bf16*)take((size_t)ROWS * 256 * 2);
    p.kf = (bf16*)take((size_t)ROWS * 256 * 2);
    p.stats = (float*)take(256);
    static int grid_blocks = 0;
    if (!grid_blocks) {
        if (off > ws_size) { fprintf(stderr, "workspace too small: need %zu have %zu\n", off, ws_size); grid_blocks = -1; return; }
        int dev = 0, cus = 0, per_cu = 0;
        hipGetDevice(&dev);
        hipDeviceGetAttribute(&cus, hipDeviceAttributeMultiprocessorCount, dev);
        if (hipFuncSetAttribute((const void*)k_mega, hipFuncAttributeMaxDynamicSharedMemorySize, LDS_BYTES) != hipSuccess) { fprintf(stderr, "hipFuncSetAttribute failed\n"); grid_blocks = -1; return; }
        hipOccupancyMaxActiveBlocksPerMultiprocessor(&per_cu, (const void*)k_mega, NTHREADS, LDS_BYTES);
        if (per_cu < 1) { fprintf(stderr, "occupancy query says %d blocks per CU\n", per_cu); grid_blocks = -1; return; }
        grid_blocks = cus;
    }
    if (grid_blocks < 0) return;
    if (hipMemsetAsync(p.ctl, 0, 16384, stream) != hipSuccess) { fprintf(stderr, "memset of the barrier words failed\n"); return; }
    void* args[] = {&p};
    hipError_t e = hipLaunchCooperativeKernel((void*)k_mega, dim3(grid_blocks), dim3(NTHREADS), args, LDS_BYTES, stream);
    if (e != hipSuccess) fprintf(stderr, "cooperative launch failed: %s (grid %d)\n", hipGetErrorString(e), grid_blocks);
}
```

```cpp
#include <hip/hip_runtime.h>
#include <hip/hip_cooperative_groups.h>
#include <cstdio>
#include <cstdint>
namespace cg = cooperative_groups;
#ifndef PROBE
#define PROBE 0
#endif
#ifndef TPROBE
#define TPROBE -1
#endif
#ifndef TSHIFT
#define TSHIFT 0
#endif

constexpr int D = 1024, BATCH = 8, SEQ = 4096, CTX = 256, TOK = 4352, NPROJ = 3888;
constexpr int ROWS = BATCH * TOK;
constexpr int NRAW = 1536, NREST = 2096, NPAD = 4096;
constexpr int NTHREADS = 512, NWAVES = 8;
constexpr int LDS_BYTES = 147456;
constexpr float ALPHA = 1.4142135623730951f;
constexpr int RC_AB = 0, RC_AZ = 16, RC_BQ = 528, RC_BV = 784, RC_BZ = 1040, RC_CQ = 1296, RC_CK = 1424, RC_CV = 1552, RC_CR = 1808, RC_CZ = 1840;
constexpr int PC_BK = 2320, PC_BV = 2576;

typedef unsigned short bf16;
typedef float f32x4_t __attribute__((ext_vector_type(4)));

struct P {
    const float *x, *c, *ctx, *c_ctx, *w_mod, *b_mod, *w_in, *conv_w, *a_log, *dt_bias, *gdn_norm, *rpb,
        *gla_w2, *gla_b2, *gla_norm, *w_out, *ln_g, *ln_b;
    float* out;
    float *mods, *xc1, *stats; unsigned* ctl;
    bf16 *wi_t, *wo_t, *rest, *raw, *qkvn, *mix, *ml, *oa, *oc, *vf, *kf;
};

__device__ __forceinline__ float bf2f(unsigned short u) { return __uint_as_float((unsigned)u << 16); }
__device__ __forceinline__ unsigned short f2bf(float f) { unsigned u = __float_as_uint(f); return (unsigned short)((u + 0x7fffu + ((u >> 16) & 1u)) >> 16); }
__device__ __forceinline__ unsigned pk2(float lo, float hi) { return (unsigned)f2bf(lo) | ((unsigned)f2bf(hi) << 16); }
__device__ __forceinline__ float bflo(unsigned w) { return __uint_as_float(w << 16); }
__device__ __forceinline__ float bfhi(unsigned w) { return __uint_as_float(w & 0xffff0000u); }
__device__ __forceinline__ void unpack8(uint4 w, float* f) {
    f[0] = bflo(w.x); f[1] = bfhi(w.x); f[2] = bflo(w.y); f[3] = bfhi(w.y); f[4] = bflo(w.z); f[5] = bfhi(w.z); f[6] = bflo(w.w); f[7] = bfhi(w.w);
}
__device__ __forceinline__ float silu_f(float x) { return x * __builtin_amdgcn_rcpf(1.f + __builtin_amdgcn_exp2f(-1.4426950408889634f * x)); }
__device__ __forceinline__ float wave_sum(float v) {
#pragma unroll
    for (int o = 32; o > 0; o >>= 1) v += __shfl_xor(v, o);
    return v;
}
__device__ __forceinline__ float wave_max(float v) {
#pragma unroll
    for (int o = 32; o > 0; o >>= 1) v = fmaxf(v, __shfl_xor(v, o));
    return v;
}
__device__ __forceinline__ int mk_tid() { int t = threadIdx.x; asm volatile("" : "+v"(t)); return t; }
__device__ __forceinline__ int tok_of(int dir, int s) { return dir == 0 ? s : (s < CTX ? CTX - 1 - s : TOK + CTX - 1 - s); }

namespace pg8 {
#define PG8_LAS __attribute__((address_space(3)))
typedef unsigned short bf16_t;
typedef short bf16x8 __attribute__((ext_vector_type(8)));
typedef float f32x4 __attribute__((ext_vector_type(4)));
typedef unsigned u32x4 __attribute__((ext_vector_type(4)));
constexpr int BM = 256, BK = 64, HALF = 128, HTB = HALF * BK * 2  , STAGE_BYTES = 8 * HTB, NXCD = 8, WGM = 8;

__host__ __device__ __forceinline__ int lds_byte(int r, int c) { const int st = (r >> 4) * 2 + (c >> 5), rr = r & 15, cc = c & 31, ob = rr * 64 + cc * 2; return st * 1024 + (ob ^ (((ob >> 9) & 1) << 5)); }
__host__ __device__ __forceinline__ void stage_rc(int b, int& R, int& C) { const int st = b / 1024, sb = b % 1024, swz = sb ^ (((sb >> 9) & 1) << 5); R = (st >> 1) * 16 + swz / 64; C = (st & 1) * 32 + (swz % 64) / 2; }
__host__ __device__ __forceinline__ int perm32(int rho) { const int n = rho >> 4, i = rho & 15; return 8 * (i >> 2) + 4 * n + (i & 3); }

struct Unit { int pm, pn; };
struct Gemm { const bf16_t* A; const bf16_t* Bt; int M, N, K; };

struct StaticOrder {
    int nM, nN, nwg, G, c;
    __host__ __device__ void init(int M, int N, int G_, int c_) { nM = M / BM; nN = N / BM; nwg = nM * nN; G = G_; c = c_; }
    __host__ __device__ bool next(int i, Unit& u) const {
        const long L = (long)i * G + c; if (L >= nwg) return false;
        int wgid = (int)L; { const int q = nwg / NXCD, r = nwg % NXCD, xcd = wgid % NXCD, off = wgid / NXCD; wgid = (xcd < r ? xcd * (q + 1) : r * (q + 1) + (xcd - r) * q) + off; }
        const int nig = WGM * nN, gid = wgid / nig, fm = gid * WGM, gsz = (nM - fm) < WGM ? (nM - fm) : WGM;
        u.pm = fm + ((wgid % nig) % gsz); u.pn = (wgid % nig) / gsz; return true;
    }
    __device__ __forceinline__ void a_ready(const Unit&) const {}
    __device__ __forceinline__ void done(const Unit&) const {}
};

__device__ __forceinline__ unsigned cvt_pk_bf16(float lo, float hi) { unsigned r; asm volatile("v_cvt_pk_bf16_f32 %0, %1, %2" : "=v"(r) : "v"(lo), "v"(hi)); return r; }
template <class Epi, class Sched, bool ALIGN_EPI = false, bool SP2 = false>
__device__ __forceinline__ void gemm_phase(PG8_LAS unsigned char* lds, const Gemm g, const Sched& S, const Epi& E) {
    const int tid = mk_tid(), wid = __builtin_amdgcn_readfirstlane(tid >> 6), lane = tid & 63, wr = wid >> 2, wc = wid & 3, fr = lane & 15, fq = lane >> 4;
    const int K = g.K, nt = K / BK;
    unsigned voffA[2], voffB[2];
#pragma unroll
    for (int i = 0; i < 2; ++i) { int R, C; stage_rc(tid * 16 + i * 8192, R, C); const int Rb = Epi::PERM ? ((R & ~31) + perm32(R & 31)) : R;
        voffA[i] = (unsigned)(R * K + C) * 2u; voffB[i] = (unsigned)(Rb * K + C) * 2u; }
    const size_t kstep = (size_t)(BK * 2);
    const size_t hstep = (size_t)HALF * K * 2;
    const size_t tstep = 2 * hstep;
    const unsigned ldsw = (unsigned)wid * 1024u;
    const int aoff = lds_byte(wr * 64 + fr, fq * 8), boff = lds_byte(wc * 32 + fr, fq * 8);
#define PG8_SA(b, h) (((b) * 2 + (h)) * HTB)
#define PG8_SB(b, h) ((4 + (b) * 2 + (h)) * HTB)
#define PG8_STAGE(bufoff, gbase, voff) do { _Pragma("unroll") for (int _i = 0; _i < 2; ++_i) \
        __builtin_amdgcn_global_load_lds((const unsigned*)((const char*)(gbase) + (voff)[_i]), (PG8_LAS unsigned*)(lds + (bufoff) + ldsw + _i * 8192), 16, 0, 0); } while (0)
#define PG8_LDA(dst, b, h) do { _Pragma("unroll") for (int m = 0; m < 4; ++m) _Pragma("unroll") for (int k = 0; k < 2; ++k) dst[m][k] = *(const PG8_LAS bf16x8*)(lds + PG8_SA(b, h) + aoff + m * 2048 + k * 1024); } while (0)
#define PG8_LDB(dst, b, h) do { _Pragma("unroll") for (int n = 0; n < 2; ++n) _Pragma("unroll") for (int k = 0; k < 2; ++k) dst[n][k] = *(const PG8_LAS bf16x8*)(lds + PG8_SB(b, h) + boff + n * 2048 + k * 1024); } while (0)
#define PG8_MMA(ai, bj, At, Bt) do { __builtin_amdgcn_s_setprio(1); _Pragma("unroll") for (int m = 0; m < 4; ++m) _Pragma("unroll") for (int n = 0; n < 2; ++n) _Pragma("unroll") for (int k = 0; k < 2; ++k) \
        acc[ai][bj][m][n] = __builtin_amdgcn_mfma_f32_16x16x32_bf16(Bt[n][k], At[m][k], acc[ai][bj][m][n], 0, 0, 0); __builtin_amdgcn_s_setprio(0); } while (0)
#define PG8_WAIT_V(n) asm volatile("s_waitcnt vmcnt(" #n ")" ::: "memory")
#define PG8_WAIT_L(n) asm volatile("s_waitcnt lgkmcnt(" #n ")" ::: "memory")
#define PG8_BAR __builtin_amdgcn_s_barrier()
#define PG8_SCHED __builtin_amdgcn_sched_barrier(0)
    Unit cur, nxt; int ui = 0;
    if (!S.next(0, cur)) return;
    f32x4 acc[2][2][4][2];
#pragma unroll
    for (int a = 0; a < 2; ++a)
#pragma unroll
        for (int b = 0; b < 2; ++b)
#pragma unroll
            for (int m = 0; m < 4; ++m)
#pragma unroll
                for (int n = 0; n < 2; ++n) acc[a][b][m][n] = (f32x4){0.f, 0.f, 0.f, 0.f};
    bf16x8 At[4][2], B0[2][2], B1[2][2];
    const char* cA = (const char*)g.A + (size_t)cur.pm * tstep; const char* cB = (const char*)g.Bt + (size_t)cur.pn * tstep;
    S.a_ready(cur);
    if constexpr (SP2) {
        PG8_STAGE(PG8_SB(0, 0), cB, voffB); PG8_STAGE(PG8_SB(0, 1), cB + hstep, voffB); PG8_STAGE(PG8_SA(0, 0), cA, voffA); PG8_STAGE(PG8_SA(0, 1), cA + hstep, voffA);
        if (wr == 1) PG8_BAR;
        PG8_WAIT_V(2); PG8_BAR;
        PG8_STAGE(PG8_SB(1, 0), cB + kstep, voffB); PG8_STAGE(PG8_SA(1, 0), cA + kstep, voffA); PG8_STAGE(PG8_SB(1, 1), cB + hstep + kstep, voffB);
        PG8_WAIT_V(6); PG8_BAR;
    } else {
        PG8_STAGE(PG8_SB(0, 0), cB, voffB); PG8_STAGE(PG8_SA(0, 0), cA, voffA); PG8_STAGE(PG8_SB(0, 1), cB + hstep, voffB); PG8_STAGE(PG8_SA(0, 1), cA + hstep, voffA);
        if (wr == 1) PG8_BAR;
        PG8_WAIT_V(4); PG8_BAR;
        PG8_STAGE(PG8_SB(1, 0), cB + kstep, voffB); PG8_STAGE(PG8_SA(1, 0), cA + kstep, voffA); PG8_STAGE(PG8_SB(1, 1), cB + hstep + kstep, voffB);
        PG8_WAIT_V(6); PG8_BAR;
    }
    for (;;) {
        const bool has_next = S.next(ui + 1, nxt);
        const char* nA = has_next ? (const char*)g.A + (size_t)nxt.pm * tstep : cA; const char* nB = has_next ? (const char*)g.Bt + (size_t)nxt.pn * tstep : cB;
        for (int t = 0; t < nt; t += 2) {
            const bool last = (t == nt - 2);
            const char* a1 = cA + (size_t)(t + 1) * kstep;
            const char* a2 = last ? nA : cA + (size_t)(t + 2) * kstep; const char* b2 = last ? nB : cB + (size_t)(t + 2) * kstep;
            const char* a3 = a2 + kstep; const char* b3 = b2 + kstep;
            if (last && has_next) S.a_ready(nxt);
            if constexpr (SP2) {
            PG8_LDB(B0, 0, 0); PG8_LDB(B1, 0, 1); PG8_SCHED; PG8_LDA(At, 0, 0); PG8_STAGE(PG8_SA(1, 1), a1 + hstep, voffA);
            PG8_WAIT_V(8); PG8_WAIT_L(0); PG8_BAR; PG8_MMA(0, 0, At, B0); PG8_MMA(0, 1, At, B1); PG8_BAR; PG8_SCHED;
            PG8_LDA(At, 0, 1); PG8_STAGE(PG8_SB(0, 0), b2, voffB); PG8_STAGE(PG8_SB(0, 1), b2 + hstep, voffB); PG8_STAGE(PG8_SA(0, 0), a2, voffA);
            PG8_WAIT_V(8); PG8_WAIT_L(0); PG8_BAR; PG8_MMA(1, 0, At, B0); PG8_MMA(1, 1, At, B1); PG8_BAR; PG8_SCHED;
            PG8_LDB(B0, 1, 0); PG8_LDB(B1, 1, 1); PG8_SCHED; PG8_LDA(At, 1, 0); PG8_STAGE(PG8_SA(0, 1), a2 + hstep, voffA);
            PG8_WAIT_V(8); PG8_WAIT_L(0); PG8_BAR; PG8_MMA(0, 0, At, B0); PG8_MMA(0, 1, At, B1); PG8_BAR; PG8_SCHED;
            PG8_LDA(At, 1, 1); PG8_STAGE(PG8_SB(1, 0), b3, voffB); PG8_STAGE(PG8_SB(1, 1), b3 + hstep, voffB); PG8_STAGE(PG8_SA(1, 0), a3, voffA);
            PG8_WAIT_V(8); PG8_WAIT_L(0); PG8_BAR; PG8_MMA(1, 0, At, B0); PG8_MMA(1, 1, At, B1); PG8_BAR; PG8_SCHED;
            } else {
            PG8_LDB(B0, 0, 0); PG8_SCHED; PG8_LDA(At, 0, 0); PG8_STAGE(PG8_SA(1, 1), a1 + hstep, voffA);
            PG8_WAIT_L(8); PG8_BAR; PG8_WAIT_L(0); PG8_MMA(0, 0, At, B0); PG8_BAR; PG8_SCHED;
            PG8_LDB(B1, 0, 1); PG8_STAGE(PG8_SB(0, 0), b2, voffB);
            PG8_BAR; PG8_WAIT_L(0); PG8_MMA(0, 1, At, B1); PG8_BAR;
            PG8_LDA(At, 0, 1); PG8_STAGE(PG8_SA(0, 0), a2, voffA);
            PG8_BAR; PG8_WAIT_L(0); PG8_MMA(1, 0, At, B0); PG8_BAR; PG8_SCHED;
            PG8_STAGE(PG8_SB(0, 1), b2 + hstep, voffB);
            PG8_WAIT_V(6); PG8_BAR; PG8_MMA(1, 1, At, B1); PG8_BAR;
            PG8_LDB(B0, 1, 0); PG8_SCHED; PG8_LDA(At, 1, 0); PG8_STAGE(PG8_SA(0, 1), a2 + hstep, voffA);
            PG8_WAIT_L(8); PG8_BAR; PG8_WAIT_L(0); PG8_MMA(0, 0, At, B0); PG8_BAR; PG8_SCHED;
            PG8_LDB(B1, 1, 1); PG8_STAGE(PG8_SB(1, 0), b3, voffB);
            PG8_BAR; PG8_WAIT_L(0); PG8_MMA(0, 1, At, B1); PG8_BAR;
            PG8_LDA(At, 1, 1); PG8_STAGE(PG8_SA(1, 0), a3, voffA);
            PG8_BAR; PG8_WAIT_L(0); PG8_MMA(1, 0, At, B0); PG8_BAR; PG8_SCHED;
            PG8_STAGE(PG8_SB(1, 1), b3 + hstep, voffB);
            PG8_WAIT_V(6); PG8_BAR; PG8_MMA(1, 1, At, B1); PG8_BAR;
            }
        }
        if constexpr (ALIGN_EPI) { if (wr == 0) PG8_BAR; }
        if constexpr (!Epi::AFTER_DRAIN) { E(acc, cur, wr, wc, fr, fq); S.done(cur); }
        if (!has_next) break;
#pragma unroll
        for (int a = 0; a < 2; ++a)
#pragma unroll
            for (int b = 0; b < 2; ++b)
#pragma unroll
                for (int m = 0; m < 4; ++m)
#pragma unroll
                    for (int n = 0; n < 2; ++n) acc[a][b][m][n] = (f32x4){0.f, 0.f, 0.f, 0.f};
        cur = nxt; cA = nA; cB = nB; ++ui;
        if constexpr (ALIGN_EPI) { if (wr == 1) PG8_BAR; }
    }
    PG8_WAIT_V(0);
    if constexpr (!ALIGN_EPI) { if (wr == 0) PG8_BAR; }
    PG8_BAR;
    if constexpr (Epi::AFTER_DRAIN) { E.fused(acc, cur, wr, wc, fr, fq, lds, wid, lane); S.done(cur); }
#undef PG8_SA
#undef PG8_SB
#undef PG8_STAGE
#undef PG8_LDA
#undef PG8_LDB
#undef PG8_MMA
#undef PG8_WAIT_V
#undef PG8_WAIT_L
#undef PG8_BAR
#undef PG8_SCHED
}
}

#define LASP __attribute__((address_space(3)))
constexpr int NCHK = TOK / 32;

struct LatentOrder {
    pg8::StaticOrder S;
    __device__ __forceinline__ bool next(int i, pg8::Unit& u) const { if (!S.next(i, u)) return false; u.pm = 17 * (u.pm >> 4) + 1 + (u.pm & 15); return true; }
    __device__ __forceinline__ void a_ready(const pg8::Unit&) const {}
    __device__ __forceinline__ void done(const pg8::Unit&) const {}
};
struct EpiProj {
    static constexpr bool PERM = true, AFTER_DRAIN = false;
    bf16* raw; bf16* rest; bf16* kf;
    __device__ __forceinline__ void operator()(const pg8::f32x4 (&acc)[2][2][4][2], const pg8::Unit& u, int wr, int wc, int fr, int fq) const {
        const int row0 = u.pm * 256 + wr * 64 + fr;
        const int colb = u.pn * 256 + wc * 32 + 8 * fq;
#pragma unroll
        for (int bj = 0; bj < 2; ++bj) {
            const int col = colb + bj * 128;
            if (col >= NPROJ) continue;
            const bool iskf = col >= PC_BK && col < PC_BV;
            bf16* base; int ld;
            if (col < NRAW) { base = raw + col; ld = NRAW; }
            else if (col < PC_BK) { base = rest + (col - NRAW); ld = NREST; }
            else { base = rest + (col - NRAW - 256); ld = NREST; }
            const int hd = col - PC_BK, hk = hd >> 6, dk = hd & 63;
#pragma unroll
            for (int ai = 0; ai < 2; ++ai)
#pragma unroll
                for (int m = 0; m < 4; ++m) {
                    const pg8::f32x4 v0 = acc[ai][bj][m][0], v1 = acc[ai][bj][m][1];
                    pg8::u32x4 w; w.x = pg8::cvt_pk_bf16(v0[0], v0[1]); w.y = pg8::cvt_pk_bf16(v0[2], v0[3]); w.z = pg8::cvt_pk_bf16(v1[0], v1[1]); w.w = pg8::cvt_pk_bf16(v1[2], v1[3]);
                    const int row = row0 + ai * 128 + m * 16;
                    if (iskf) {
                        const int bb = row / TOK, t = row - bb * TOK;
                        *(pg8::u32x4*)(kf + ((((size_t)(bb * 4 + hk) * NCHK + (t >> 5)) * 4 + (dk >> 4)) * 64 + ((dk >> 3) & 1) * 32 + (t & 31)) * 8) = w;
                    } else *(pg8::u32x4*)(base + (size_t)row * ld) = w;
                }
        }
    }
};
struct EpiY {
    static constexpr bool PERM = true, AFTER_DRAIN = false;
    bf16* y;
    __device__ __forceinline__ void operator()(const pg8::f32x4 (&acc)[2][2][4][2], const pg8::Unit& u, int wr, int wc, int fr, int fq) const {
        const int row0 = u.pm * 256 + wr * 64 + fr;
        const int colb = u.pn * 256 + wc * 32 + 8 * fq;
#pragma unroll
        for (int bj = 0; bj < 2; ++bj)
#pragma unroll
            for (int ai = 0; ai < 2; ++ai)
#pragma unroll
                for (int m = 0; m < 4; ++m) {
                    const pg8::f32x4 v0 = acc[ai][bj][m][0], v1 = acc[ai][bj][m][1];
                    pg8::u32x4 w; w.x = pg8::cvt_pk_bf16(v0[0], v0[1]); w.y = pg8::cvt_pk_bf16(v0[2], v0[3]); w.z = pg8::cvt_pk_bf16(v1[0], v1[1]); w.w = pg8::cvt_pk_bf16(v1[2], v1[3]);
                    *(pg8::u32x4*)(y + (size_t)(row0 + ai * 128 + m * 16) * D + colb + bj * 128) = w;
                }
    }
};

__device__ __forceinline__ void transpose_item(const float* W, int K, int N, bf16* WT, LASP float* scr, int item, int lane) {
    const int nblk = (N + 31) / 32, kb = item / nblk, nb = item % nblk, k0 = 64 * kb, n0 = 32 * nb;
    const bool nok = (n0 + (lane & 31)) < N;
#pragma unroll 8
    for (int i = 0; i < 32; ++i) { const int kk = 2 * i + (lane >> 5); scr[kk * 33 + (lane & 31)] = nok ? W[(size_t)(k0 + kk) * N + n0 + (lane & 31)] : 0.f; }
    asm volatile("s_waitcnt lgkmcnt(0)" ::: "memory");
    const int c = lane & 7;
#pragma unroll
    for (int j = 0; j < 4; ++j) {
        const int n = (lane >> 3) + 8 * j; const LASP float* s = scr + (8 * c) * 33 + n;
        uint4 o; o.x = pk2(s[0 * 33], s[1 * 33]); o.y = pk2(s[2 * 33], s[3 * 33]); o.z = pk2(s[4 * 33], s[5 * 33]); o.w = pk2(s[6 * 33], s[7 * 33]);
        *(uint4*)(WT + (size_t)(n0 + n) * K + k0 + 8 * c) = o;
    }
    asm volatile("s_waitcnt lgkmcnt(0)" ::: "memory");
}

__device__ void ph_prologue(const P& p, LASP unsigned char* lds, int bid, int nblk) {
    const int tid = mk_tid(), lane = tid & 63, wave = tid >> 6;
    LASP float* sm = (LASP float*)lds;
    if (bid < 96) {
        for (int i = tid; i < 9 * 1024; i += NTHREADS) {
            int s = i >> 10, d = i & 1023;
            float cv = s < 8 ? p.c[s * 1024 + d] : p.c_ctx[d];
            sm[i] = silu_f(cv);
        }
        __syncthreads();
        const int l = bid / 48, j = (bid % 48) * 64 + lane;
        const float* w = p.w_mod + (size_t)l * 1024 * 3072 + j;
        float acc[9];
#pragma unroll
        for (int s = 0; s < 9; ++s) acc[s] = 0.f;
#pragma unroll 1
        for (int i0 = wave * 128; i0 < wave * 128 + 128; i0 += 16) {
            float wv[16];
#pragma unroll
            for (int u = 0; u < 16; ++u) wv[u] = w[(size_t)(i0 + u) * 3072];
#pragma unroll
            for (int u = 0; u < 16; ++u)
#pragma unroll
                for (int s = 0; s < 9; ++s) acc[s] += sm[s * 1024 + i0 + u] * wv[u];
        }
        LASP float* red = sm + 9 * 1024;
#pragma unroll
        for (int s = 0; s < 9; ++s) red[(wave * 9 + s) * 64 + lane] = acc[s];
        __syncthreads();
        for (int o = tid; o < 9 * 64; o += NTHREADS) {
            const int s = o >> 6, c = o & 63;
            float t = 0.f;
#pragma unroll
            for (int ww = 0; ww < 8; ++ww) t += red[(ww * 9 + s) * 64 + c];
            const int jj = (bid % 48) * 64 + c;
            p.mods[(size_t)(l * 9 + s) * 3072 + jj] = t + p.b_mod[l * 3072 + jj];
        }
        __syncthreads();
    }
#if PROBE
    if (bid == 0 && tid < 4) p.stats[tid] = 0.f;
#endif
}
__device__ void ph_transposes(const P& p, LASP unsigned char* lds, int bid, int nblk) {
    const int tid = mk_tid(), lane = tid & 63, wave = tid >> 6;
    LASP float* scr = (LASP float*)(lds + 57344 + wave * 8704);
    const int gw = (nblk - 1 - bid) * NWAVES + wave, NGW = nblk * NWAVES;
    constexpr int I_IN = 16 * 122, I_OUT = 16 * 32;
    for (int it = gw; it < 2 * (I_IN + I_OUT); it += NGW) {
        int l = it / (I_IN + I_OUT), r = it % (I_IN + I_OUT);
        if (r < I_IN) transpose_item(p.w_in + (size_t)l * D * NPROJ, D, NPROJ, p.wi_t + (size_t)l * NPAD * D, scr, r, lane);
        else transpose_item(p.w_out + (size_t)l * D * D, D, D, p.wo_t + (size_t)l * D * D, scr, r - I_IN, lane);
    }
    for (int i = bid * NTHREADS + tid; i < 2 * 192 * 128; i += nblk * NTHREADS) {
        int l = i / (192 * 128), r = i % (192 * 128);
        *(uint4*)(p.wi_t + (size_t)l * NPAD * D + (size_t)3904 * D + (size_t)r * 8) = make_uint4(0, 0, 0, 0);
    }
}

__device__ void ph_lnpass(const P& p, int mode, int bid, int nblk) {
    const int tid = mk_tid();
    const int lane = tid & 63, wave = tid >> 6;
    for (int r = bid * NWAVES + wave; r < ROWS; r += nblk * NWAVES) {
        const int b = r / TOK, t = r - b * TOK;
        const bool isc = t < CTX;
        if (mode == 2 && isc) continue;
        float* buf; const float* src; int s;
        if (isc) { buf = p.xc1 + ((size_t)b * CTX + t) * D; src = p.ctx + ((size_t)b * CTX + t) * D; s = 8; }
        else { buf = p.out + ((size_t)b * SEQ + (t - CTX)) * D; src = (mode == 2) ? buf : p.x + ((size_t)b * SEQ + (t - CTX)) * D; s = b; }
        f32x4_t v[4];
#pragma unroll
        for (int j = 0; j < 4; ++j) v[j] = *(const f32x4_t*)(src + 256 * j + 4 * lane);
        if (mode >= 1) {
            const int lp = mode - 1;
            const float* gt = p.mods + (size_t)(lp * 9 + s) * 3072 + 2048;
#pragma unroll
            for (int j = 0; j < 4; ++j) {
                const uint2 yw = *(const uint2*)(p.ml + (size_t)r * D + 256 * j + 4 * lane);
                const f32x4_t g = *(const f32x4_t*)(gt + 256 * j + 4 * lane);
                const f32x4_t yv = {bflo(yw.x), bfhi(yw.x), bflo(yw.y), bfhi(yw.y)};
                v[j] = v[j] * ALPHA + g * yv;
            }
            float sum = 0.f;
#pragma unroll
            for (int j = 0; j < 4; ++j) sum += (v[j].x + v[j].y) + (v[j].z + v[j].w);
            const float mu = wave_sum(sum) * (1.f / 1024.f);
            float sq = 0.f;
#pragma unroll
            for (int j = 0; j < 4; ++j) { v[j] = v[j] - mu; sq += (v[j].x * v[j].x + v[j].y * v[j].y) + (v[j].z * v[j].z + v[j].w * v[j].w); }
            const float rs = 1.f / sqrtf(wave_sum(sq) * (1.f / 1024.f) + 1e-6f);
#pragma unroll
            for (int j = 0; j < 4; ++j) {
                const f32x4_t g = *(const f32x4_t*)(p.ln_g + lp * 1024 + 256 * j + 4 * lane), bb = *(const f32x4_t*)(p.ln_b + lp * 1024 + 256 * j + 4 * lane);
                v[j] = v[j] * rs * g + bb;
#if PROBE
                if (mode == 2) v[j] = v[j] + (p.stats[0] / fmaxf(p.stats[1], 1e-20f));
#endif
#if TPROBE >= 0
                if (mode == 2) v[j] = v[j] + exp2f((rintf(log2f(fmaxf(p.stats[2], 1.f)) * 6.f + TSHIFT * 0.5f) - TSHIFT * 0.5f) * (1.f / 6.f)) * 1e-4f;
#endif
                *(f32x4_t*)(buf + 256 * j + 4 * lane) = v[j];
            }
            if (mode == 2) continue;
        }
        const int l = mode;
        float sum = 0.f;
#pragma unroll
        for (int j = 0; j < 4; ++j) sum += (v[j].x + v[j].y) + (v[j].z + v[j].w);
        const float mu = wave_sum(sum) * (1.f / 1024.f);
        float sq = 0.f;
#pragma unroll
        for (int j = 0; j < 4; ++j) { v[j] = v[j] - mu; sq += (v[j].x * v[j].x + v[j].y * v[j].y) + (v[j].z * v[j].z + v[j].w * v[j].w); }
        const float rs = 1.f / sqrtf(wave_sum(sq) * (1.f / 1024.f) + 1e-6f);
        const float* md = p.mods + (size_t)(l * 9 + s) * 3072;
#pragma unroll
        for (int j = 0; j < 4; ++j) {
            const f32x4_t sh = *(const f32x4_t*)(md + 256 * j + 4 * lane), sc = *(const f32x4_t*)(md + 1024 + 256 * j + 4 * lane);
            const f32x4_t o = v[j] * rs * (sc + 1.f) + sh;
            uint2 w; w.x = pk2(o.x, o.y); w.y = pk2(o.z, o.w);
            *(uint2*)(p.ml + (size_t)r * D + 256 * j + 4 * lane) = w;
        }
    }
}

__device__ void ph_conv(const P& p, int l, int bid, int nblk) {
    const int tid = mk_tid();
    const int lane = tid & 63, wave = tid >> 6;
    const float* cw = p.conv_w + (size_t)l * 5 * 1536;
    constexpr int NSTRIP = TOK / 16;
    for (int it = bid * NWAVES + wave; it < BATCH * NSTRIP * 3; it += nblk * NWAVES) {
        const int third = it % 3, rest_i = it / 3, strip = rest_i % NSTRIP, b = rest_i / NSTRIP;
        const int t0 = strip * 16;
        const int lo = t0 < CTX ? 0 : CTX, hi = t0 < CTX ? CTX : TOK;
        const int ch = third * 512 + lane * 8;
        float w[5][8];
#pragma unroll
        for (int j = 0; j < 5; ++j) {
            const f32x4_t a = *(const f32x4_t*)(cw + j * 1536 + ch), c = *(const f32x4_t*)(cw + j * 1536 + ch + 4);
            w[j][0] = a.x; w[j][1] = a.y; w[j][2] = a.z; w[j][3] = a.w; w[j][4] = c.x; w[j][5] = c.y; w[j][6] = c.z; w[j][7] = c.w;
        }
        const bf16* src = p.raw + ((size_t)b * TOK + t0) * NRAW + ch;
        bf16* dst = p.qkvn + ((size_t)b * TOK + t0) * NRAW + ch;
        uint4 rw[20];
#pragma unroll
        for (int i = 0; i < 20; ++i) {
            const int tt = t0 + i - 2;
            rw[i] = (tt >= lo && tt < hi) ? *(const uint4*)(src + (ptrdiff_t)(i - 2) * NRAW) : make_uint4(0, 0, 0, 0);
        }
        const int g = (ch >> 7);
        const float qs = g < 4 ? 0.08838834764831845f : 1.f;
#pragma unroll
        for (int n = 0; n < 16; ++n) {
            float acc[8];
#pragma unroll
            for (int e = 0; e < 8; ++e) acc[e] = 0.f;
#pragma unroll
            for (int j = 0; j < 5; ++j) {
                float f[8]; unpack8(rw[n + j], f);
#pragma unroll
                for (int e = 0; e < 8; ++e) acc[e] += w[j][e] * f[e];
            }
            float ss = 0.f;
#pragma unroll
            for (int e = 0; e < 8; ++e) { acc[e] = silu_f(acc[e]); ss += acc[e] * acc[e]; }
            if (g < 8) {
#pragma unroll
                for (int m = 8; m > 0; m >>= 1) ss += __shfl_xor(ss, m);
                const float sc = qs * __builtin_amdgcn_rsqf(ss + 1e-6f);
#pragma unroll
                for (int e = 0; e < 8; ++e) acc[e] *= sc;
            }
            uint4 o; o.x = pk2(acc[0], acc[1]); o.y = pk2(acc[2], acc[3]); o.z = pk2(acc[4], acc[5]); o.w = pk2(acc[6], acc[7]);
            *(uint4*)(dst + (size_t)n * NRAW) = o;
        }
    }
}

typedef short bf16x8_t __attribute__((ext_vector_type(8)));
typedef float f32x16_t __attribute__((ext_vector_type(16)));
typedef float f32x2_t __attribute__((ext_vector_type(2)));
typedef __bf16 bf16x2_t __attribute__((ext_vector_type(2)));
typedef unsigned u32x4_t __attribute__((ext_vector_type(4)));
#define MFMA32(a, b, c) __builtin_amdgcn_mfma_f32_32x32x16_bf16((a), (b), (c), 0, 0, 0)
__device__ __forceinline__ unsigned cvtpk(float lo, float hi) { f32x2_t v = {lo, hi}; bf16x2_t q = __builtin_convertvector(v, bf16x2_t); return __builtin_bit_cast(unsigned, q); }
__device__ __forceinline__ int crow(int reg, int h) { return (reg & 3) + 8 * (reg >> 2) + 4 * h; }
__device__ __forceinline__ int perm16(int a) { const int x = a & 15; return (a & ~15) + (x < 4 ? x : x < 8 ? x + 4 : x < 12 ? x - 4 : x); }
#define PACK8(x, s) __builtin_bit_cast(bf16x8_t, (u32x4_t){cvtpk((x)[8 * (s)], (x)[8 * (s) + 1]), cvtpk((x)[8 * (s) + 2], (x)[8 * (s) + 3]), cvtpk((x)[8 * (s) + 4], (x)[8 * (s) + 5]), cvtpk((x)[8 * (s) + 6], (x)[8 * (s) + 7])})
constexpr int GCH = 32, NCH = TOK / GCH;
constexpr int GP_ITEM = 4416;

__device__ void ph_gdnprep(const P& p, LASP unsigned char* lds, int l, int bid, int nblk, int tid) {
    const int lane = tid & 63, wave = tid >> 6, r = lane & 31, hh = lane >> 5;
    LASP float* Lm = (LASP float*)(lds + wave * 16384);
    LASP float* Xs = Lm + 2048;
    for (int it = bid * NWAVES + wave; it < BATCH * 4 * NCH; it += nblk * NWAVES) {
        const int c = it % NCH, bh = it / NCH, h = bh & 3, b = bh >> 2;
        const size_t row0 = (size_t)b * TOK + (size_t)c * GCH;
        f32x16_t KK, QK;
#pragma unroll
        for (int i = 0; i < 16; ++i) { KK[i] = 0.f; QK[i] = 0.f; }
        const bf16* kbase = p.qkvn + (row0 + r) * NRAW + 512 + h * 128 + 8 * hh;
        const bf16* qbase = p.qkvn + (row0 + r) * NRAW + h * 128 + 8 * hh;
#pragma unroll
        for (int s = 0; s < 8; ++s) {
            const bf16x8_t kf = *(const bf16x8_t*)(kbase + 16 * s), qf = *(const bf16x8_t*)(qbase + 16 * s);
            KK = MFMA32(kf, kf, KK);
            QK = MFMA32(qf, kf, QK);
        }
        float Gd, bd;
        {
            const bf16* ab = p.rest + (row0 + r) * NREST + RC_AB;
            const float a = bf2f(ab[hh * 4 + h]) + p.dt_bias[(l * 2 + hh) * 4 + h];
            const float sp = fmaxf(a, 0.f) + log1pf(expf(-fabsf(a)));
            Gd = -expf(p.a_log[(l * 2 + hh) * 4 + h]) * sp;
            bd = 1.f / (1.f + expf(-bf2f(ab[(2 + hh) * 4 + h])));
        }
#pragma unroll
        for (int off = 1; off < 32; off <<= 1) {
            const float up = __shfl_up(Gd, off, 32), dn = __shfl_down(Gd, off, 32);
            if (hh == 0) { if (r >= off) Gd += up; } else { if (r + off < 32) Gd += dn; }
        }
        unsigned char* gout = (unsigned char*)p.raw + ((size_t)(bh * 2) * NCH + c) * GP_ITEM;
        {
            const float Glast = __shfl(Gd, hh == 0 ? 31 : 32);
            float* sc = (float*)(gout + (size_t)hh * NCH * GP_ITEM + 4096);
            sc[r] = expf(Gd); sc[32 + r] = expf(Glast - Gd);
            if (r == 0) sc[64] = expf(Glast);
        }
        asm volatile("s_waitcnt lgkmcnt(0)" ::: "memory");
        LASP unsigned short* qkt = (LASP unsigned short*)Xs;
        LASP float* bs = (LASP float*)(lds + 135168 + wave * 256);
        bs[lane] = bd;
#pragma unroll
        for (int d = 0; d < 2; ++d) {
            const float Gcol = __shfl(Gd, d * 32 + r);
#pragma unroll
            for (int i = 0; i < 16; ++i) {
                const int n = crow(i, hh);
                const float Grow = __shfl(Gd, d * 32 + n), brow = __shfl(bd, d * 32 + n);
                const bool incl = d == 0 ? (r <= n) : (r >= n), strict = d == 0 ? (r < n) : (r > n);
                const float dec = __builtin_amdgcn_exp2f((incl ? Grow - Gcol : 0.f) * 1.4426950408889634f);
                const float lv = strict ? brow * KK[i] * dec : 0.f;
                const float qv = incl ? QK[i] * dec : 0.f;
                const int n2 = d == 0 ? n : 31 - n, m2 = d == 0 ? r : 31 - r;
                Lm[(d * 32 + n2) * 32 + m2] = lv;
                qkt[(d * 32 + n) * 40 + perm16(r)] = f2bf(qv);
                if ((i & 3) == 3) __builtin_amdgcn_sched_barrier(0);
            }
        }
        asm volatile("s_waitcnt lgkmcnt(0)" ::: "memory");
#pragma unroll
        for (int d = 0; d < 2; ++d)
#pragma unroll
            for (int k = 0; k < 2; ++k) {
                const int q = lane + 64 * k, row = q >> 2, ch = q & 3;
                *(u32x4_t*)(gout + (size_t)d * NCH * GP_ITEM + 2048 + row * 64 + ch * 16) = *(const LASP u32x4_t*)((const LASP unsigned char*)qkt + (d * 32 + row) * 80 + ch * 16);
            }
        asm volatile("s_waitcnt lgkmcnt(0)" ::: "memory");
        {
            const LASP float* Lr = Lm + hh * 1024;
            LASP float* xc = Xs + lane;
#pragma unroll 1
            for (int nb = 0; nb < 8; ++nb) {
                float a[4];
#pragma unroll
                for (int k = 0; k < 4; ++k) a[k] = (4 * nb + k == r) ? 1.f : 0.f;
#pragma unroll 2
                for (int jb = 0; jb < nb; ++jb) {
                    const float x0 = xc[(4 * jb) * 64], x1 = xc[(4 * jb + 1) * 64], x2 = xc[(4 * jb + 2) * 64], x3 = xc[(4 * jb + 3) * 64];
#pragma unroll
                    for (int k = 0; k < 4; ++k) {
                        const f32x4_t lv = *(const LASP f32x4_t*)(Lr + (4 * nb + k) * 32 + 4 * jb);
                        a[k] -= (lv.x * x0 + lv.y * x1) + (lv.z * x2 + lv.w * x3);
                    }
                }
                const f32x4_t l1 = *(const LASP f32x4_t*)(Lr + (4 * nb + 1) * 32 + 4 * nb), l2 = *(const LASP f32x4_t*)(Lr + (4 * nb + 2) * 32 + 4 * nb), l3 = *(const LASP f32x4_t*)(Lr + (4 * nb + 3) * 32 + 4 * nb);
                a[1] -= l1.x * a[0];
                a[2] -= l2.x * a[0] + l2.y * a[1];
                a[3] -= (l3.x * a[0] + l3.y * a[1]) + l3.z * a[2];
#pragma unroll
                for (int k = 0; k < 4; ++k) xc[(4 * nb + k) * 64] = a[k];
                asm volatile("s_waitcnt lgkmcnt(0)" ::: "memory");
            }
        }
        asm volatile("s_waitcnt lgkmcnt(0)" ::: "memory");
#pragma unroll
        for (int d = 0; d < 2; ++d)
#pragma unroll
            for (int k = 0; k < 2; ++k) {
                const int q = lane + 64 * k, row = q >> 2, ch = q & 3;
                const int nn = d == 0 ? row : 31 - row;
                float v[8];
#pragma unroll
                for (int e = 0; e < 8; ++e) {
                    const int m = perm16(ch * 8 + e);
                    const int lidx = d == 0 ? m : 32 + 31 - m;
                    v[e] = Xs[nn * 64 + lidx] * bs[d * 32 + m];
                }
                *(u32x4_t*)(gout + (size_t)d * NCH * GP_ITEM + row * 64 + ch * 16) = (u32x4_t){cvtpk(v[0], v[1]), cvtpk(v[2], v[3]), cvtpk(v[4], v[5]), cvtpk(v[6], v[7])};
            }
        asm volatile("s_waitcnt lgkmcnt(0)" ::: "memory");
    }
}

constexpr int ST_KA = 0, ST_QA = 8704, ST_KN = 17408, ST_V = 27648, ST_TP = 37888, ST_QK = 40448, ST_GL = 43008, ST_BYTES = 43328;
constexpr int GDN_OST = 2 * ST_BYTES, GDN_OST_BYTES = 32 * 272;
typedef unsigned u32x2_t __attribute__((ext_vector_type(2)));
typedef short s16x4_t __attribute__((ext_vector_type(4)));
struct GSlot { u32x4_t k0, k1, q0, q1, v0, v1, t; f32x4_t sc; };

__device__ __forceinline__ int gdn_chunk(int dir, int s) { return dir == 0 ? s : (s < 8 ? 7 - s : 143 - s); }
__device__ __forceinline__ void gdn_issue(const P& p, GSlot& g, int b, int h, int dir, int step, int tl) {
    const int c = gdn_chunk(dir, step);
    const size_t row0 = (size_t)b * TOK + (size_t)c * GCH;
    const int r0 = tl >> 4, c16 = tl & 15;
    const bf16* a0 = p.qkvn + (row0 + r0) * NRAW + h * 128 + 8 * c16;
    const bf16* a1 = a0 + (size_t)16 * NRAW;
    g.q0 = *(const u32x4_t*)a0; g.q1 = *(const u32x4_t*)a1;
    g.k0 = *(const u32x4_t*)(a0 + 512); g.k1 = *(const u32x4_t*)(a1 + 512);
    g.v0 = *(const u32x4_t*)(a0 + 1024); g.v1 = *(const u32x4_t*)(a1 + 1024);
    const unsigned char* gp = (const unsigned char*)p.raw + ((size_t)((b * 4 + h) * 2 + dir) * NCH + c) * GP_ITEM;
    g.t = *(const u32x4_t*)(gp + tl * 16);
    g.sc = *(const f32x4_t*)(gp + 4096 + (tl < 20 ? tl : 0) * 16);
}
__device__ __forceinline__ u32x4_t scale8(u32x4_t x, float s) {
    return (u32x4_t){cvtpk(bflo(x.x) * s, bfhi(x.x) * s), cvtpk(bflo(x.y) * s, bfhi(x.y) * s), cvtpk(bflo(x.z) * s, bfhi(x.z) * s), cvtpk(bflo(x.w) * s, bfhi(x.w) * s)};
}
__device__ __forceinline__ void gdn_put_rows(LASP unsigned char* st, int row, int c16, u32x4_t kq, int off) {
    const int g = c16 >> 1, odd = c16 & 1;
    *(LASP u32x2_t*)(st + off + row * 272 + (16 * g + (odd ? 4 : 0)) * 2) = (u32x2_t){kq.x, kq.y};
    *(LASP u32x2_t*)(st + off + row * 272 + (16 * g + (odd ? 12 : 8)) * 2) = (u32x2_t){kq.z, kq.w};
}
__device__ __forceinline__ void gdn_write(LASP unsigned char* st, const GSlot& g, int tl) {
    const int r0 = tl >> 4, c16 = tl & 15;
    gdn_put_rows(st, r0, c16, g.k0, ST_KA); gdn_put_rows(st, r0 + 16, c16, g.k1, ST_KA);
    gdn_put_rows(st, r0, c16, g.q0, ST_QA); gdn_put_rows(st, r0 + 16, c16, g.q1, ST_QA);
    *(LASP u32x4_t*)(st + ST_KN + r0 * 320 + c16 * 16) = g.k0;
    *(LASP u32x4_t*)(st + ST_KN + (r0 + 16) * 320 + c16 * 16) = g.k1;
    *(LASP u32x4_t*)(st + ST_V + r0 * 320 + c16 * 16) = g.v0;
    *(LASP u32x4_t*)(st + ST_V + (r0 + 16) * 320 + c16 * 16) = g.v1;
    { const int t2 = tl & 127; *(LASP u32x4_t*)(st + (tl < 128 ? ST_TP : ST_QK) + (t2 >> 2) * 80 + (t2 & 3) * 16) = g.t; }
    if (tl < 20) *(LASP f32x4_t*)(st + ST_GL + tl * 16) = g.sc;
}
__device__ __forceinline__ void gdn_flush(const P& p, LASP unsigned char* lds, int b, int h, int dir, int step, int tl) {
    const int c = gdn_chunk(dir, step);
    const LASP unsigned char* ost = lds + GDN_OST + (step & 1) * GDN_OST_BYTES;
    bf16* op = p.oa + ((size_t)dir * ROWS + (size_t)b * TOK + (size_t)c * GCH) * 512 + h * 128;
#pragma unroll
    for (int k = 0; k < 2; ++k) { const int idx = tl + 256 * k, row = idx >> 4, ch = idx & 15; *(u32x4_t*)(op + (size_t)row * 512 + ch * 8) = *(const LASP u32x4_t*)(ost + row * 272 + ch * 16); }
}
__device__ __forceinline__ s16x4_t trd(const LASP unsigned char* q) {
    typedef short v4i16_t __attribute__((ext_vector_type(4)));
    return __builtin_bit_cast(s16x4_t, __builtin_amdgcn_ds_read_tr16_b64_v4i16((LASP v4i16_t*)q));
}
#define TRFRAG(base) __builtin_shufflevector(trd(base), trd((base) + 8 * 320), 0, 1, 2, 3, 4, 5, 6, 7)

#if TPROBE == 60
#define GDN_SYNC_C() do { unsigned long long t_ = __builtin_amdgcn_s_memrealtime(); __syncthreads(); if (chain == 0 && tid == 0) p.stats[2] += (float)(__builtin_amdgcn_s_memrealtime() - t_) * 0.01f; } while (0)
#define GDN_SYNC_L() __syncthreads()
#elif TPROBE == 61
#define GDN_SYNC_L() do { unsigned long long t_ = __builtin_amdgcn_s_memrealtime(); __syncthreads(); if (chain == 0 && tid == 256) p.stats[2] += (float)(__builtin_amdgcn_s_memrealtime() - t_) * 0.01f; } while (0)
#define GDN_SYNC_C() __syncthreads()
#else
#define GDN_SYNC_C() __syncthreads()
#define GDN_SYNC_L() __syncthreads()
#endif
__device__ void gdn_scan_fast(const P& p, LASP unsigned char* lds, int chain) {
    const int tid = mk_tid();
    const int lane = tid & 63, wave = __builtin_amdgcn_readfirstlane(tid >> 6);
    const int dir = chain & 1, h = (chain >> 1) & 3, b = chain >> 3;
    constexpr int NS = NCH;
    if (wave >= 4) {
        const int tl = tid - 256;
        GSlot g0, g1, g2, g3;
        gdn_issue(p, g0, b, h, dir, 0, tl); gdn_issue(p, g1, b, h, dir, 1, tl); gdn_issue(p, g2, b, h, dir, 2, tl); gdn_issue(p, g3, b, h, dir, 3, tl);
        gdn_write(lds, g0, tl); gdn_issue(p, g0, b, h, dir, 4, tl);
        __syncthreads();
#pragma unroll 1
        for (int s = 0; s < NS; s += 4) {
            if (s > 0) gdn_flush(p, lds, b, h, dir, s - 1, tl);
            gdn_write(lds + ((s + 1) & 1) * ST_BYTES, g1, tl); gdn_issue(p, g1, b, h, dir, min(s + 5, NS - 1), tl);
            GDN_SYNC_L();
            gdn_flush(p, lds, b, h, dir, s, tl);
            gdn_write(lds + ((s + 2) & 1) * ST_BYTES, g2, tl); gdn_issue(p, g2, b, h, dir, min(s + 6, NS - 1), tl);
            GDN_SYNC_L();
            gdn_flush(p, lds, b, h, dir, s + 1, tl);
            gdn_write(lds + ((s + 3) & 1) * ST_BYTES, g3, tl); gdn_issue(p, g3, b, h, dir, min(s + 7, NS - 1), tl);
            GDN_SYNC_L();
            gdn_flush(p, lds, b, h, dir, s + 2, tl);
            gdn_write(lds + ((s + 4) & 1) * ST_BYTES, g0, tl); gdn_issue(p, g0, b, h, dir, min(s + 8, NS - 1), tl);
            GDN_SYNC_L();
        }
        gdn_flush(p, lds, b, h, dir, NS - 1, tl);
    } else {
        const int r = lane & 31, hh = lane >> 5, w = wave;
        f32x16_t S0, S1, S2, S3;
#pragma unroll
        for (int i = 0; i < 16; ++i) { S0[i] = 0.f; S1[i] = 0.f; S2[i] = 0.f; S3[i] = 0.f; }
        const int troff = (4 * hh + ((lane & 15) >> 2)) * 320 + (16 * ((lane >> 4) & 1) + 4 * (lane & 3)) * 2;
        __syncthreads();
#pragma unroll 1
        for (int s = 0; s < NS; ++s) {
            LASP unsigned char* st = lds + (s & 1) * ST_BYTES;
            const LASP unsigned char* ka = st + ST_KA + r * 272 + hh * 16;
            const LASP unsigned char* qa = st + ST_QA + r * 272 + hh * 16;
            const bf16x8_t kA0 = *(const LASP bf16x8_t*)(ka), kA1 = *(const LASP bf16x8_t*)(ka + 32), kA2 = *(const LASP bf16x8_t*)(ka + 64), kA3 = *(const LASP bf16x8_t*)(ka + 96);
            const bf16x8_t kA4 = *(const LASP bf16x8_t*)(ka + 128), kA5 = *(const LASP bf16x8_t*)(ka + 160), kA6 = *(const LASP bf16x8_t*)(ka + 192), kA7 = *(const LASP bf16x8_t*)(ka + 224);
            const bf16x8_t qA0 = *(const LASP bf16x8_t*)(qa), qA1 = *(const LASP bf16x8_t*)(qa + 32), qA2 = *(const LASP bf16x8_t*)(qa + 64), qA3 = *(const LASP bf16x8_t*)(qa + 96);
            const bf16x8_t qA4 = *(const LASP bf16x8_t*)(qa + 128), qA5 = *(const LASP bf16x8_t*)(qa + 160), qA6 = *(const LASP bf16x8_t*)(qa + 192), qA7 = *(const LASP bf16x8_t*)(qa + 224);
            const LASP unsigned char* vbase = st + ST_V + troff + 64 * w;
            const bf16x8_t vB0 = TRFRAG(vbase), vB1 = TRFRAG(vbase + 16 * 320);
            const LASP unsigned char* tp = st + ST_TP + r * 80 + hh * 16;
            const bf16x8_t T0 = *(const LASP bf16x8_t*)(tp), T1 = *(const LASP bf16x8_t*)(tp + 32);
            const LASP unsigned char* qk = st + ST_QK + r * 80 + hh * 16;
            const bf16x8_t Q0 = *(const LASP bf16x8_t*)(qk), Q1 = *(const LASP bf16x8_t*)(qk + 32);
            const LASP float* sc = (const LASP float*)(st + ST_GL);
            const f32x4_t e0 = *(const LASP f32x4_t*)(sc + 4 * hh), e1 = *(const LASP f32x4_t*)(sc + 8 + 4 * hh), e2 = *(const LASP f32x4_t*)(sc + 16 + 4 * hh), e3 = *(const LASP f32x4_t*)(sc + 24 + 4 * hh);
            const f32x4_t f0 = *(const LASP f32x4_t*)(sc + 32 + 4 * hh), f1 = *(const LASP f32x4_t*)(sc + 40 + 4 * hh), f2 = *(const LASP f32x4_t*)(sc + 48 + 4 * hh), f3 = *(const LASP f32x4_t*)(sc + 56 + 4 * hh);
            const float gl = sc[64];
            __builtin_amdgcn_sched_barrier(0);
            f32x16_t ak, aq, vn;
#pragma unroll
            for (int i = 0; i < 16; ++i) { ak[i] = 0.f; aq[i] = 0.f; vn[i] = 0.f; }
            vn = MFMA32(T0, vB0, vn); vn = MFMA32(T1, vB1, vn);
#define GDN_KQ(KA, QA, SX, u) { const bf16x8_t SB = PACK8(SX, u); ak = MFMA32(KA, SB, ak); aq = MFMA32(QA, SB, aq); }
            GDN_KQ(kA0, qA0, S0, 0) GDN_KQ(kA1, qA1, S0, 1) GDN_KQ(kA2, qA2, S1, 0) GDN_KQ(kA3, qA3, S1, 1)
            GDN_KQ(kA4, qA4, S2, 0) GDN_KQ(kA5, qA5, S2, 1) GDN_KQ(kA6, qA6, S3, 0) GDN_KQ(kA7, qA7, S3, 1)
#undef GDN_KQ
            __builtin_amdgcn_sched_barrier(0);
            const LASP unsigned char* kn = st + ST_KN + troff;
            const bf16x8_t N00 = TRFRAG(kn), N01 = TRFRAG(kn + 16 * 320), N10 = TRFRAG(kn + 64), N11 = TRFRAG(kn + 64 + 16 * 320);
            const bf16x8_t N20 = TRFRAG(kn + 128), N21 = TRFRAG(kn + 128 + 16 * 320), N30 = TRFRAG(kn + 192), N31 = TRFRAG(kn + 192 + 16 * 320);
            __builtin_amdgcn_sched_barrier(0);
#define ROWSCALE(X, sgn) { X[0] *= sgn e0.x; X[1] *= sgn e0.y; X[2] *= sgn e0.z; X[3] *= sgn e0.w; X[4] *= sgn e1.x; X[5] *= sgn e1.y; X[6] *= sgn e1.z; X[7] *= sgn e1.w; \
                           X[8] *= sgn e2.x; X[9] *= sgn e2.y; X[10] *= sgn e2.z; X[11] *= sgn e2.w; X[12] *= sgn e3.x; X[13] *= sgn e3.y; X[14] *= sgn e3.z; X[15] *= sgn e3.w; }
            ROWSCALE(ak, -) ROWSCALE(aq, +)
#undef ROWSCALE
            const bf16x8_t ab0 = PACK8(ak, 0), ab1 = PACK8(ak, 1);
            vn = MFMA32(T0, ab0, vn); vn = MFMA32(T1, ab1, vn);
            S0 = S0 * gl; S1 = S1 * gl; S2 = S2 * gl; S3 = S3 * gl;
            const bf16x8_t vb0 = PACK8(vn, 0), vb1 = PACK8(vn, 1);
            f32x16_t vf;
            vf[0] = vn[0] * f0.x; vf[1] = vn[1] * f0.y; vf[2] = vn[2] * f0.z; vf[3] = vn[3] * f0.w; vf[4] = vn[4] * f1.x; vf[5] = vn[5] * f1.y; vf[6] = vn[6] * f1.z; vf[7] = vn[7] * f1.w;
            vf[8] = vn[8] * f2.x; vf[9] = vn[9] * f2.y; vf[10] = vn[10] * f2.z; vf[11] = vn[11] * f2.w; vf[12] = vn[12] * f3.x; vf[13] = vn[13] * f3.y; vf[14] = vn[14] * f3.z; vf[15] = vn[15] * f3.w;
            const bf16x8_t fb0 = PACK8(vf, 0), fb1 = PACK8(vf, 1);
            S0 = MFMA32(N00, fb0, S0); S1 = MFMA32(N10, fb0, S1); S2 = MFMA32(N20, fb0, S2); S3 = MFMA32(N30, fb0, S3);
            S0 = MFMA32(N01, fb1, S0); S1 = MFMA32(N11, fb1, S1); S2 = MFMA32(N21, fb1, S2); S3 = MFMA32(N31, fb1, S3);
            aq = MFMA32(Q0, vb0, aq); aq = MFMA32(Q1, vb1, aq);
            {
                LASP unsigned short* ost = (LASP unsigned short*)(lds + GDN_OST + (s & 1) * GDN_OST_BYTES) + 32 * w + r;
#pragma unroll
                for (int i = 0; i < 16; i += 2) { const unsigned pk = cvtpk(aq[i], aq[i + 1]); ost[crow(i, hh) * 136] = (unsigned short)pk; ost[(crow(i, hh) + 1) * 136] = (unsigned short)(pk >> 16); }
            }
            GDN_SYNC_C();
        }
    }
}

constexpr int GL_ITEM = 6272;
constexpr size_t GLA_PREP_OFF = (size_t)BATCH * 4 * 2 * NCH * GP_ITEM;

__device__ __forceinline__ void gla_prep_item(const P& p, LASP unsigned char* wl, const LASP float* cstab, int l, int it, int lane) {
    const int r = lane & 31, hh = lane >> 5;
    const int c = it % NCH, bh = it / NCH, h = bh & 3, b = bh >> 2;
    const size_t row0 = (size_t)b * TOK + (size_t)c * GCH;
    float qv[16], kv[16];
    {
        const bf16* qb = p.rest + (row0 + 4 * hh) * NREST + RC_CQ + h * 32 + r;
#pragma unroll
        for (int i = 0; i < 16; ++i) { const int no = (i & 3) + 8 * (i >> 2); qv[i] = bf2f(qb[(size_t)no * NREST]); kv[i] = bf2f(qb[(size_t)no * NREST + 128]); }
    }
    if (c >= 8) {
        const int dd = r & 15, f = dd & 7;
        const int prow = (c - 8) >> 1, pcol0 = 32 * ((c - 8) & 1);
#pragma unroll
        for (int i = 0; i < 16; ++i) {
            const int n = crow(i, hh);
            const int pos = r < 16 ? prow : pcol0 + n;
            const float cs = cstab[(pos * 8 + f) * 2], sn = cstab[(pos * 8 + f) * 2 + 1];
            const float qp = __shfl_xor(qv[i], 8), kp = __shfl_xor(kv[i], 8);
            if (dd < 8) { qv[i] = qv[i] * cs - qp * sn; kv[i] = kv[i] * cs - kp * sn; }
            else { qv[i] = qp * sn + qv[i] * cs; kv[i] = kp * sn + kv[i] * cs; }
        }
    }
#pragma unroll
    for (int i = 0; i < 16; ++i) qv[i] *= 0.17677669529663687f;
#pragma unroll 1
    for (int dir = 0; dir < 2; ++dir) {
        f32x16_t X;
#pragma unroll
        for (int i = 0; i < 16; ++i) X[i] = 0.f;
        {
            const bf16x8_t A = *(const bf16x8_t*)(p.rest + (row0 + r) * NREST + RC_CR + dir * 16 + 8 * hh);
            const float* w2p = p.gla_w2 + ((size_t)(l * 2 + dir) * 16 + 8 * hh) * 128 + h * 32 + r;
            const bf16x8_t Bf = __builtin_bit_cast(bf16x8_t, (u32x4_t){cvtpk(w2p[0], w2p[128]), cvtpk(w2p[256], w2p[384]), cvtpk(w2p[512], w2p[640]), cvtpk(w2p[768], w2p[896])});
            X = MFMA32(A, Bf, X);
        }
        const float b2v = p.gla_b2[(l * 2 + dir) * 128 + h * 32 + r];
        float Bc[16];
#pragma unroll
        for (int i = 0; i < 16; ++i) { const float xg = X[i] + b2v; Bc[i] = (fminf(xg, 0.f) - log1pf(expf(-fabsf(xg)))) * (1.f / 16.f); }
        float tot;
        {
            float sg[4], ps[4];
#pragma unroll
            for (int g = 0; g < 4; ++g) { sg[g] = (Bc[4 * g] + Bc[4 * g + 1]) + (Bc[4 * g + 2] + Bc[4 * g + 3]); ps[g] = __shfl_xor(sg[g], 32); }
            tot = ((sg[0] + ps[0]) + (sg[1] + ps[1])) + ((sg[2] + ps[2]) + (sg[3] + ps[3]));
            if (dir == 0) {
                float base = 0.f;
#pragma unroll
                for (int g = 0; g < 4; ++g) {
                    float o = base + (hh ? ps[g] : 0.f);
#pragma unroll
                    for (int k = 0; k < 4; ++k) { o += Bc[4 * g + k]; Bc[4 * g + k] = o; }
                    base += sg[g] + ps[g];
                }
            } else {
                float base = 0.f;
#pragma unroll
                for (int g = 3; g >= 0; --g) {
                    float o = base + (hh ? 0.f : ps[g]);
#pragma unroll
                    for (int k = 3; k >= 0; --k) { o += Bc[4 * g + k]; Bc[4 * g + k] = o; }
                    base += sg[g] + ps[g];
                }
            }
        }
        unsigned char* gout = (unsigned char*)p.raw + GLA_PREP_OFF + ((size_t)(bh * 2 + dir) * NCH + c) * GL_ITEM;
        LASP bf16* ql = (LASP bf16*)wl;
        LASP bf16* kl = ql + 32 * 40;
        {
            bf16* qpo = (bf16*)gout + perm16(r);
            bf16* kdo = (bf16*)(gout + 4096) + r * 32;
#pragma unroll
            for (int g = 0; g < 4; ++g) {
                float kd[4];
#pragma unroll
                for (int k = 0; k < 4; ++k) {
                    const int i = 4 * g + k, n = crow(i, hh);
                    const float eb = expf(Bc[i]);
                    const float qs = qv[i] * eb, ks = kv[i] / eb;
                    kd[k] = kv[i] * expf(tot - Bc[i]);
                    const bf16 qsb = f2bf(qs);
                    qpo[n * 32] = qsb;
                    ql[n * 40 + r] = qsb; kl[n * 40 + r] = f2bf(ks);
                }
                *(u32x2_t*)(kdo + perm16(8 * g + 4 * hh)) = (u32x2_t){cvtpk(kd[0], kd[1]), cvtpk(kd[2], kd[3])};
            }
            if (hh == 0) ((float*)(gout + 6144))[r] = expf(tot);
        }
        asm volatile("s_waitcnt lgkmcnt(0)" ::: "memory");
        f32x16_t AT;
#pragma unroll
        for (int i = 0; i < 16; ++i) AT[i] = 0.f;
        AT = MFMA32(*(const LASP bf16x8_t*)((const LASP unsigned char*)kl + r * 80 + hh * 16), *(const LASP bf16x8_t*)((const LASP unsigned char*)ql + r * 80 + hh * 16), AT);
        AT = MFMA32(*(const LASP bf16x8_t*)((const LASP unsigned char*)kl + r * 80 + hh * 16 + 32), *(const LASP bf16x8_t*)((const LASP unsigned char*)ql + r * 80 + hh * 16 + 32), AT);
        {
            bf16* amo = (bf16*)(gout + 2048) + r * 32;
#pragma unroll
            for (int g = 0; g < 4; ++g) {
                float a[4];
#pragma unroll
                for (int k = 0; k < 4; ++k) { const int m = crow(4 * g + k, hh); const bool keep = dir == 0 ? (m <= r) : (m >= r); a[k] = keep ? AT[4 * g + k] : 0.f; }
                *(u32x2_t*)(amo + perm16(8 * g + 4 * hh)) = (u32x2_t){cvtpk(a[0], a[1]), cvtpk(a[2], a[3])};
            }
        }
        asm volatile("s_waitcnt lgkmcnt(0)" ::: "memory");
    }
}

constexpr int LS_QP = 0, LS_AM = 2560, LS_KD = 5120, LS_V = 7680, LS_GL = 13824, LS_BYTES = 13952;
constexpr int GLA_OST = 4 * LS_BYTES, GLA_OST_BYTES = 32 * 144;
struct LSlot { u32x4_t a0, a1, a2, v0, v1; f32x4_t gl; };
__device__ __forceinline__ void gla_issue(const P& p, LSlot& g, int b, int h, int dir, int step, int t2) {
    const int c = gdn_chunk(dir, step);
    const unsigned char* gp = (const unsigned char*)p.raw + GLA_PREP_OFF + ((size_t)((b * 4 + h) * 2 + dir) * NCH + c) * GL_ITEM;
    g.a0 = *(const u32x4_t*)(gp + t2 * 16); g.a1 = *(const u32x4_t*)(gp + 2048 + t2 * 16); g.a2 = *(const u32x4_t*)(gp + 4096 + t2 * 16);
    g.gl = *(const f32x4_t*)(gp + 6144 + (t2 < 8 ? t2 : 0) * 16);
    const size_t row0 = (size_t)b * TOK + (size_t)c * GCH;
    const bf16* vp = p.rest + (row0 + (t2 >> 3)) * NREST + RC_CV + h * 64 + 8 * (t2 & 7);
    g.v0 = *(const u32x4_t*)vp; g.v1 = *(const u32x4_t*)(vp + (size_t)16 * NREST);
}
__device__ __forceinline__ void gla_write(LASP unsigned char* st, const LSlot& g, int t2) {
    const int row = t2 >> 2, ch = t2 & 3;
    *(LASP u32x4_t*)(st + LS_QP + row * 80 + ch * 16) = g.a0;
    *(LASP u32x4_t*)(st + LS_AM + row * 80 + ch * 16) = g.a1;
    *(LASP u32x4_t*)(st + LS_KD + row * 80 + ch * 16) = g.a2;
    if (t2 < 8) *(LASP f32x4_t*)(st + LS_GL + t2 * 16) = g.gl;
    *(LASP u32x4_t*)(st + LS_V + (t2 >> 3) * 192 + (t2 & 7) * 16) = g.v0; *(LASP u32x4_t*)(st + LS_V + (16 + (t2 >> 3)) * 192 + (t2 & 7) * 16) = g.v1;
}
__device__ __forceinline__ void gla_flush(const P& p, LASP unsigned char* lds, int b, int h, int dir, int step, int t2) {
    const int c = gdn_chunk(dir, step);
    const LASP unsigned char* ost = lds + GLA_OST + (dir * 2 + (step & 1)) * GLA_OST_BYTES;
    bf16* op = p.oc + ((size_t)dir * ROWS + (size_t)b * TOK + (size_t)c * GCH) * 256 + h * 64;
#pragma unroll
    for (int k = 0; k < 2; ++k) { const int idx = t2 + 128 * k, row = idx >> 3, ch = idx & 7; *(u32x4_t*)(op + (size_t)row * 256 + ch * 8) = *(const LASP u32x4_t*)(ost + row * 144 + ch * 16); }
}
#if TPROBE == 62
#define GLA_SYNC_C() do { unsigned long long t_ = __builtin_amdgcn_s_memrealtime(); __syncthreads(); if (bh == 0 && tid == 0) p.stats[2] += (float)(__builtin_amdgcn_s_memrealtime() - t_) * 0.01f; } while (0)
#define GLA_SYNC_L() __syncthreads()
#elif TPROBE == 63
#define GLA_SYNC_L() do { unsigned long long t_ = __builtin_amdgcn_s_memrealtime(); __syncthreads(); if (bh == 0 && tid == 256) p.stats[2] += (float)(__builtin_amdgcn_s_memrealtime() - t_) * 0.01f; } while (0)
#define GLA_SYNC_C() __syncthreads()
#else
#define GLA_SYNC_C() __syncthreads()
#define GLA_SYNC_L() __syncthreads()
#endif
__device__ void gla_scan_fast(const P& p, LASP unsigned char* lds, int bh) {
    const int tid = mk_tid();
    const int lane = tid & 63, wave = __builtin_amdgcn_readfirstlane(tid >> 6);
    const int h = bh & 3, b = bh >> 2;
    constexpr int NS = NCH;
    if (wave >= 4) {
        const int dir = (wave - 4) >> 1, t2 = tid & 127;
        LASP unsigned char* base = lds + dir * 2 * LS_BYTES;
        LSlot g0, g1, g2, g3;
        gla_issue(p, g0, b, h, dir, 0, t2); gla_issue(p, g1, b, h, dir, 1, t2); gla_issue(p, g2, b, h, dir, 2, t2); gla_issue(p, g3, b, h, dir, 3, t2);
        gla_write(base, g0, t2); gla_issue(p, g0, b, h, dir, 4, t2);
        __syncthreads();
#pragma unroll 1
        for (int s = 0; s < NS; s += 4) {
            if (s > 0) gla_flush(p, lds, b, h, dir, s - 1, t2);
            gla_write(base + ((s + 1) & 1) * LS_BYTES, g1, t2); gla_issue(p, g1, b, h, dir, min(s + 5, NS - 1), t2);
            GLA_SYNC_L();
            gla_flush(p, lds, b, h, dir, s, t2);
            gla_write(base + ((s + 2) & 1) * LS_BYTES, g2, t2); gla_issue(p, g2, b, h, dir, min(s + 6, NS - 1), t2);
            GLA_SYNC_L();
            gla_flush(p, lds, b, h, dir, s + 1, t2);
            gla_write(base + ((s + 3) & 1) * LS_BYTES, g3, t2); gla_issue(p, g3, b, h, dir, min(s + 7, NS - 1), t2);
            GLA_SYNC_L();
            gla_flush(p, lds, b, h, dir, s + 2, t2);
            gla_write(base + ((s + 4) & 1) * LS_BYTES, g0, t2); gla_issue(p, g0, b, h, dir, min(s + 8, NS - 1), t2);
            GLA_SYNC_L();
        }
        gla_flush(p, lds, b, h, dir, NS - 1, t2);
    } else {
        const int r = lane & 31, hh = lane >> 5, dir = wave >> 1, blk = wave & 1;
        LASP unsigned char* base = lds + dir * 2 * LS_BYTES;
        f32x16_t S;
#pragma unroll
        for (int i = 0; i < 16; ++i) S[i] = 0.f;
        __syncthreads();
        const int troff = (4 * hh + ((lane & 15) >> 2)) * 192 + (16 * ((lane >> 4) & 1) + 4 * (lane & 3)) * 2 + 64 * blk;
#define TRFRAG192(bs) __builtin_shufflevector(trd(bs), trd((bs) + 8 * 192), 0, 1, 2, 3, 4, 5, 6, 7)
#pragma unroll 1
        for (int s = 0; s < NS; ++s) {
            const LASP unsigned char* st = base + (s & 1) * LS_BYTES;
#if TPROBE == 64 || TPROBE == 65
            const unsigned long long ttop_ = __builtin_amdgcn_s_memrealtime();
            __builtin_amdgcn_sched_barrier(0);
#endif
            const LASP unsigned char* qp = st + LS_QP + r * 80 + hh * 16;
            const LASP unsigned char* am = st + LS_AM + r * 80 + hh * 16;
            const LASP unsigned char* kd = st + LS_KD + r * 80 + hh * 16;
            const bf16x8_t QP0 = *(const LASP bf16x8_t*)(qp), QP1 = *(const LASP bf16x8_t*)(qp + 32);
            const bf16x8_t AM0 = *(const LASP bf16x8_t*)(am), AM1 = *(const LASP bf16x8_t*)(am + 32);
            const bf16x8_t KD0 = *(const LASP bf16x8_t*)(kd), KD1 = *(const LASP bf16x8_t*)(kd + 32);
            const LASP unsigned char* vb = st + LS_V + troff;
            const bf16x8_t V0 = TRFRAG192(vb), V1 = TRFRAG192(vb + 16 * 192);
            const LASP float* glp = (const LASP float*)(st + LS_GL);
            const f32x4_t g0 = *(const LASP f32x4_t*)(glp + 4 * hh), g1 = *(const LASP f32x4_t*)(glp + 8 + 4 * hh), g2 = *(const LASP f32x4_t*)(glp + 16 + 4 * hh), g3 = *(const LASP f32x4_t*)(glp + 24 + 4 * hh);
            __builtin_amdgcn_sched_barrier(0);
#if TPROBE == 64 || TPROBE == 65
            asm volatile("s_waitcnt lgkmcnt(0)" ::: "memory");
            const unsigned long long tmid_ = __builtin_amdgcn_s_memrealtime();
            if (TPROBE == 64 && bh == 0 && tid == 0) p.stats[2] += (float)(tmid_ - ttop_) * 0.01f;
            __builtin_amdgcn_sched_barrier(0);
#endif
            const bf16x8_t Sb0 = PACK8(S, 0), Sb1 = PACK8(S, 1);
            f32x16_t oT;
#pragma unroll
            for (int i = 0; i < 16; ++i) oT[i] = 0.f;
            oT = MFMA32(V0, AM0, oT); oT = MFMA32(V1, AM1, oT);
            oT = MFMA32(Sb0, QP0, oT); oT = MFMA32(Sb1, QP1, oT);
            S[0] *= g0.x; S[1] *= g0.y; S[2] *= g0.z; S[3] *= g0.w; S[4] *= g1.x; S[5] *= g1.y; S[6] *= g1.z; S[7] *= g1.w;
            S[8] *= g2.x; S[9] *= g2.y; S[10] *= g2.z; S[11] *= g2.w; S[12] *= g3.x; S[13] *= g3.y; S[14] *= g3.z; S[15] *= g3.w;
            S = MFMA32(KD0, V0, S);
            S = MFMA32(KD1, V1, S);
            {
                LASP unsigned char* ost = lds + GLA_OST + (dir * 2 + (s & 1)) * GLA_OST_BYTES + r * 144 + (32 * blk + 4 * hh) * 2;
#pragma unroll
                for (int g = 0; g < 4; ++g) *(LASP u32x2_t*)(ost + 16 * g) = (u32x2_t){cvtpk(oT[4 * g], oT[4 * g + 1]), cvtpk(oT[4 * g + 2], oT[4 * g + 3])};
            }
#if TPROBE == 65
            __builtin_amdgcn_sched_barrier(0);
            asm volatile("s_nop 15\n\ts_nop 15" ::: "memory");
            if (bh == 0 && tid == 0) p.stats[2] += (float)(__builtin_amdgcn_s_memrealtime() - tmid_) * 0.01f;
#endif
            GLA_SYNC_C();
        }
    }
}


__device__ __forceinline__ void vf_item(const P& p, LASP unsigned char* wl, int it, int lane) {
    const int r = lane & 31, hh = lane >> 5;
    const int kb = it % NCH, bh = it / NCH, h = bh & 3, b = bh >> 2;
    const bf16* vp = p.rest + ((size_t)b * TOK + 32 * kb + r) * NREST + RC_BV + h * 64 + 32 * hh;
#pragma unroll
    for (int q = 0; q < 4; ++q) *(LASP u32x4_t*)(wl + r * 192 + (32 * hh + 8 * q) * 2) = *(const u32x4_t*)(vp + 8 * q);
    asm volatile("s_waitcnt lgkmcnt(0)" ::: "memory");
    const int troff = (4 * hh + ((lane & 15) >> 2)) * 192 + (16 * ((lane >> 4) & 1) + 4 * (lane & 3)) * 2;
    bf16* op = p.vf + ((size_t)(bh * NCH + kb) * 4) * 512 + lane * 8;
#pragma unroll
    for (int dvb = 0; dvb < 2; ++dvb)
#pragma unroll
        for (int u = 0; u < 2; ++u) {
            const LASP unsigned char* bs = wl + troff + 64 * dvb + (16 * u) * 192;
            const bf16x8_t f = __builtin_shufflevector(trd(bs), trd(bs + 8 * 192), 0, 1, 2, 3, 4, 5, 6, 7);
            *(bf16x8_t*)(op + (dvb * 2 + u) * 512) = f;
        }
    asm volatile("s_waitcnt lgkmcnt(0)" ::: "memory");
}

__device__ __forceinline__ void na_item(const P& p, const LASP float* rpbL, int it, int lane) {
    const int r = lane & 31, hh = lane >> 5;
    int b, h, ry, qb; bool lat;
    if (it < 4096) { lat = true; qb = it & 1; ry = (it >> 1) & 63; h = (it >> 7) & 3; b = it >> 9; }
    else { const int j = it - 4096; lat = false; qb = j & 7; h = (j >> 3) & 3; b = j >> 5; ry = 0; }
    const size_t brow = (size_t)b * TOK;
    const int q0 = lat ? CTX + ry * 64 + qb * 32 : qb * 32;
    bf16* qp = p.rest + (brow + q0 + r) * NREST + RC_BQ + h * 64;
    bf16x8_t Qf0 = *(const bf16x8_t*)(qp + 8 * hh), Qf1 = *(const bf16x8_t*)(qp + 16 + 8 * hh), Qf2 = *(const bf16x8_t*)(qp + 32 + 8 * hh), Qf3 = *(const bf16x8_t*)(qp + 48 + 8 * hh);
    f32x16_t O0, O1;
#pragma unroll
    for (int i = 0; i < 16; ++i) { O0[i] = 0.f; O1[i] = 0.f; }
    float m = -1e30f, lsum = 0.f;
    const bf16* kfb = p.kf + ((size_t)(b * 4 + h) * NCH) * 2048 + lane * 8;
    const bf16* vfb = p.vf + ((size_t)(b * 4 + h) * NCH) * 2048 + lane * 8;
    const int nkb = lat ? 24 : 8;
    const int c = qb * 32 + r, c0 = min(max(c - 8, 0), 48), r0 = min(max(ry - 4, 0), 56);
    constexpr float SC = 0.125f * 1.4426950408889634f;
    struct KV { bf16x8_t k0, k1, k2, k3, v00, v01, v10, v11; };
    KV fA, fB;
#define NA_KBIDX(kq) ((kq) < 8 ? (kq) : 8 + (r0 + (((kq) - 8) >> 1)) * 2 + (((kq) - 8) & 1))
#define NA_LOAD(F, kq) { const size_t o_ = (size_t)NA_KBIDX(min((kq), nkb - 1)) * 2048; const bf16* kp = kfb + o_; const bf16* vp = vfb + o_; \
        F.k0 = *(const bf16x8_t*)(kp); F.k1 = *(const bf16x8_t*)(kp + 512); F.k2 = *(const bf16x8_t*)(kp + 1024); F.k3 = *(const bf16x8_t*)(kp + 1536); \
        F.v00 = *(const bf16x8_t*)(vp); F.v01 = *(const bf16x8_t*)(vp + 512); F.v10 = *(const bf16x8_t*)(vp + 1024); F.v11 = *(const bf16x8_t*)(vp + 1536); }
    NA_LOAD(fA, 0) NA_LOAD(fB, 1)
#define NA_BLOCK(F, kq) { \
        const int kb_ = (kq); int ky = 0, cb = 0; const bool win = kb_ >= 8; \
        if (win) { const int w_ = kb_ - 8; ky = r0 + (w_ >> 1); cb = w_ & 1; } \
        f32x16_t S; _Pragma("unroll") for (int i = 0; i < 16; ++i) S[i] = 0.f; \
        S = MFMA32(F.k0, Qf0, S); S = MFMA32(F.k1, Qf1, S); S = MFMA32(F.k2, Qf2, S); S = MFMA32(F.k3, Qf3, S); \
        const bf16x8_t V00 = F.v00, V01 = F.v01, V10 = F.v10, V11 = F.v11; \
        NA_LOAD(F, kb_ + 2) \
        float bm = -1e30f; \
        if (win) { \
            const LASP float* rb = rpbL + (h * 15 + (ky - ry + 7)) * 31 + 15 - c; \
            _Pragma("unroll") for (int i = 0; i < 16; ++i) { \
                const int kc = cb * 32 + crow(i, hh); \
                const bool valid = (kc >= c0) && (kc < c0 + 16); \
                const float bias = rb[valid ? kc : c]; \
                S[i] = valid ? S[i] * SC + bias : -1e30f; \
                bm = fmaxf(bm, S[i]); } \
        } else { _Pragma("unroll") for (int i = 0; i < 16; ++i) { S[i] *= SC; bm = fmaxf(bm, S[i]); } } \
        bm = fmaxf(bm, __shfl_xor(bm, 32)); \
        const float mn = fmaxf(m, bm); \
        const float alpha = __builtin_amdgcn_exp2f(m - mn); \
        m = mn; \
        float ps = 0.f; \
        _Pragma("unroll") for (int i = 0; i < 16; ++i) { S[i] = __builtin_amdgcn_exp2f(S[i] - mn); ps += S[i]; } \
        lsum = lsum * alpha + ps; \
        _Pragma("unroll") for (int i = 0; i < 16; ++i) { O0[i] *= alpha; O1[i] *= alpha; } \
        const bf16x8_t Pb0 = PACK8(S, 0), Pb1 = PACK8(S, 1); \
        O0 = MFMA32(V00, Pb0, O0); O0 = MFMA32(V01, Pb1, O0); \
        O1 = MFMA32(V10, Pb0, O1); O1 = MFMA32(V11, Pb1, O1); }
#pragma unroll 1
    for (int kb = 0; kb < nkb; kb += 2) { NA_BLOCK(fA, kb) NA_BLOCK(fB, kb + 1) }
#undef NA_BLOCK
#undef NA_LOAD
#undef NA_KBIDX
    const float inv = 1.f / (lsum + __shfl_xor(lsum, 32));
    bf16* op = qp + 4 * hh;
#pragma unroll
    for (int g = 0; g < 4; ++g) {
        *(u32x2_t*)(op + 8 * g) = (u32x2_t){cvtpk(O0[4 * g] * inv, O0[4 * g + 1] * inv), cvtpk(O0[4 * g + 2] * inv, O0[4 * g + 3] * inv)};
        *(u32x2_t*)(op + 32 + 8 * g) = (u32x2_t){cvtpk(O1[4 * g] * inv, O1[4 * g + 1] * inv), cvtpk(O1[4 * g + 2] * inv, O1[4 * g + 3] * inv)};
    }
}

__device__ void ph_prep_early(const P& p, LASP unsigned char* lds, int l, int bid, int nblk) {
    const int tid = mk_tid();
    const int lane = tid & 63, wave = tid >> 6;
    for (int it = bid * NWAVES + wave; it < BATCH * 4 * NCH; it += nblk * NWAVES) vf_item(p, lds + wave * 16384, it, lane);
}
__device__ void ph_prep(const P& p, LASP unsigned char* lds, int l, int bid, int nblk) {
    const int tid = mk_tid();
    LASP float* cstab = (LASP float*)(lds + 131072);
    {
        const int pos = tid >> 3, f = tid & 7;
        const float ang = (float)pos * powf(10000.f, -(float)f / 8.f);
        cstab[tid * 2] = cosf(ang); cstab[tid * 2 + 1] = sinf(ang);
    }
    __syncthreads();
    ph_gdnprep(p, lds, l, bid, nblk, tid);
    const int lane = tid & 63, wave = tid >> 6;
    for (int it = (nblk - 1 - bid) * NWAVES + wave; it < BATCH * 4 * NCH; it += nblk * NWAVES) gla_prep_item(p, lds + wave * 16384, cstab, l, it, lane);
}

__device__ void ph_mix(const P& p, LASP unsigned char* lds, int l, int bid, int nblk) {
    constexpr int NGDN = BATCH * 4 * 2;
    constexpr int NGLA = BATCH * 4;
    if (bid < NGDN) { gdn_scan_fast(p, lds, bid); return; }
    if (bid < NGDN + NGLA) { gla_scan_fast(p, lds, bid - NGDN); return; }
    const int tid = mk_tid();
    const int lane = tid & 63, wave = tid >> 6;
    LASP float* rpbL = (LASP float*)lds;
    for (int i = tid; i < 4 * 15 * 31; i += NTHREADS) rpbL[i] = p.rpb[(size_t)l * 4 * 15 * 31 + i] * 1.4426950408889634f;
    __syncthreads();
    const int total = 4096 + (l == 0 ? 256 : 0);
    for (int it = (bid - NGDN - NGLA) * NWAVES + wave; it < total; it += (nblk - NGDN - NGLA) * NWAVES) na_item(p, rpbL, it, lane);
}

__device__ void ph_gate(const P& p, int l, int bid, int nblk) {
    const int tid = mk_tid();
    const int tq = tid & 127, rsub = tid >> 7;
    const int kind = tq < 64 ? 0 : (tq < 96 ? 1 : 2);
    const int cb = kind == 0 ? tq * 8 : (kind == 1 ? (tq - 64) * 8 : (tq - 96) * 8);
    const int zoff = kind == 0 ? RC_AZ + cb : (kind == 1 ? RC_BZ + cb : RC_CZ + cb);
    const int oc = kind == 0 ? cb : (kind == 1 ? 512 + cb : 768 + cb);
    float nw[8];
#pragma unroll
    for (int e = 0; e < 8; ++e) nw[e] = kind == 0 ? p.gdn_norm[l * 128 + ((cb + e) & 127)] : (kind == 2 ? p.gla_norm[l * 64 + ((cb + e) & 63)] : 1.f);
    for (int r0 = bid * 16; r0 < ROWS; r0 += nblk * 16) {
        uint4 a[4], bb[4], zz[4];
#pragma unroll
        for (int j = 0; j < 4; ++j) {
            const size_t r = (size_t)(r0 + rsub + 4 * j);
            const bf16* pr = p.rest + r * NREST;
            zz[j] = *(const uint4*)(pr + zoff);
            if (kind == 0) { a[j] = *(const uint4*)(p.oa + r * 512 + cb); bb[j] = *(const uint4*)(p.oa + ((size_t)ROWS + r) * 512 + cb); }
            else if (kind == 1) { a[j] = *(const uint4*)(pr + RC_BQ + cb); bb[j] = make_uint4(0, 0, 0, 0); }
            else { a[j] = *(const uint4*)(p.oc + r * 256 + cb); bb[j] = *(const uint4*)(p.oc + ((size_t)ROWS + r) * 256 + cb); }
        }
#pragma unroll
        for (int j = 0; j < 4; ++j) {
            float fa[8], fb[8], z[8], o[8];
            unpack8(a[j], fa); unpack8(bb[j], fb); unpack8(zz[j], z);
            float ss = 0.f;
#pragma unroll
            for (int e = 0; e < 8; ++e) { o[e] = fa[e] + fb[e]; ss += o[e] * o[e]; }
            float rs = 1.f;
            if (kind == 0) {
#pragma unroll
                for (int m = 8; m > 0; m >>= 1) ss += __shfl_xor(ss, m);
                rs = __builtin_amdgcn_rsqf(ss * (1.f / 128.f) + 1e-6f);
            } else if (kind == 2) {
#pragma unroll
                for (int m = 4; m > 0; m >>= 1) ss += __shfl_xor(ss, m);
                rs = __builtin_amdgcn_rsqf(ss * (1.f / 64.f) + 1e-6f);
            }
            float res[8];
#pragma unroll
            for (int e = 0; e < 8; ++e) res[e] = o[e] * rs * nw[e] * silu_f(z[e]);
            uint4 w; w.x = pk2(res[0], res[1]); w.y = pk2(res[2], res[3]); w.z = pk2(res[4], res[5]); w.w = pk2(res[6], res[7]);
            *(uint4*)(p.mix + (size_t)(r0 + rsub + 4 * j) * D + oc) = w;
        }
    }
}

#if PROBE
__device__ void gdn_scan_naive(const P& p, LASP float* sm, int l, int b, int hp, bf16* nb) {
    const int tid = mk_tid();
    LASP float* skq = sm;
    LASP float* sv = sm + 4 * 16 * 256;
    LASP float* sg = sv + 4 * 16 * 128;
    LASP float* sb = sg + 64;
    const int sub = tid >> 7, col = tid & 127, dir = sub & 1, h = hp * 2 + (sub >> 1);
    float S[128];
#pragma unroll
    for (int i = 0; i < 128; ++i) S[i] = 0.f;
    for (int s0 = 0; s0 < TOK; s0 += 16) {
        __syncthreads();
        for (int i = tid; i < 4 * 16 * 48; i += NTHREADS) {
            const int su = i / (16 * 48), rem = i % (16 * 48), j = rem / 48, chunk = rem % 48;
            const int sd = su & 1, hh = hp * 2 + (su >> 1);
            const int t = tok_of(sd, s0 + j);
            const size_t row = (size_t)b * TOK + t;
            const int part = chunk >> 4, c8 = chunk & 15;
            const uint4 w = *(const uint4*)(p.qkvn + row * NRAW + part * 512 + hh * 128 + c8 * 8);
            float f[8]; unpack8(w, f);
            LASP float* dst = (part < 2) ? skq + (su * 16 + j) * 256 + part * 128 + c8 * 8 : sv + (su * 16 + j) * 128 + c8 * 8;
#pragma unroll
            for (int e = 0; e < 8; ++e) dst[e] = f[e];
        }
        if (tid < 64) {
            const int su = tid >> 4, j = tid & 15, sd = su & 1, hh = hp * 2 + (su >> 1);
            const int t = tok_of(sd, s0 + j);
            const bf16* ab = p.rest + ((size_t)b * TOK + t) * NREST + RC_AB;
            const float a = bf2f(ab[sd * 4 + hh]) + p.dt_bias[(l * 2 + sd) * 4 + hh];
            const float sp = fmaxf(a, 0.f) + log1pf(expf(-fabsf(a)));
            const float g = -expf(p.a_log[(l * 2 + sd) * 4 + hh]) * sp;
            sg[su * 16 + j] = expf(g);
            const float bx = bf2f(ab[(2 + sd) * 4 + hh]);
            sb[su * 16 + j] = 1.f / (1.f + expf(-bx));
        }
        __syncthreads();
#pragma unroll 1
        for (int j = 0; j < 16; ++j) {
            const LASP float* qp = skq + (sub * 16 + j) * 256;
            const LASP float* kp = qp + 128;
            const float dec = sg[sub * 16 + j], bt = sb[sub * 16 + j];
            const float v = sv[(sub * 16 + j) * 128 + col];
            float d0 = 0.f, d1 = 0.f, d2 = 0.f, d3 = 0.f;
#pragma unroll
            for (int k4 = 0; k4 < 32; ++k4) {
                const f32x4_t kv = *(const LASP f32x4_t*)(kp + k4 * 4);
                d0 += S[k4 * 4] * kv.x; d1 += S[k4 * 4 + 1] * kv.y; d2 += S[k4 * 4 + 2] * kv.z; d3 += S[k4 * 4 + 3] * kv.w;
                if ((k4 & 7) == 7) __builtin_amdgcn_sched_barrier(0);
            }
            const float dot = (d0 + d1) + (d2 + d3);
            const float vn = bt * (v - dec * dot);
            float o0 = 0.f, o1 = 0.f, o2 = 0.f, o3 = 0.f;
#pragma unroll
            for (int k4 = 0; k4 < 32; ++k4) {
                const f32x4_t kv = *(const LASP f32x4_t*)(kp + k4 * 4);
                const f32x4_t qv = *(const LASP f32x4_t*)(qp + k4 * 4);
                S[k4 * 4] = dec * S[k4 * 4] + kv.x * vn; o0 += S[k4 * 4] * qv.x;
                S[k4 * 4 + 1] = dec * S[k4 * 4 + 1] + kv.y * vn; o1 += S[k4 * 4 + 1] * qv.y;
                S[k4 * 4 + 2] = dec * S[k4 * 4 + 2] + kv.z * vn; o2 += S[k4 * 4 + 2] * qv.z;
                S[k4 * 4 + 3] = dec * S[k4 * 4 + 3] + kv.w * vn; o3 += S[k4 * 4 + 3] * qv.w;
                if ((k4 & 3) == 3) __builtin_amdgcn_sched_barrier(0);
            }
            const int t = tok_of(dir, s0 + j);
            nb[((size_t)dir * TOK + t) * 256 + (h & 1) * 128 + col] = f2bf((o0 + o1) + (o2 + o3));
        }
    }
    __syncthreads();
}

__device__ void gla_scan_naive(const P& p, LASP float* sm, int l, int b, bf16* nb) {
    const int tid = mk_tid();
    LASP float* sq = sm;
    LASP float* sv = sm + 8 * 16 * 96;
    const int grp = tid >> 6, lane = tid & 63, h = grp >> 1, dir = grp & 1;
    const int d = lane & 31, par = lane >> 5;
    float w2c[16];
#pragma unroll
    for (int j = 0; j < 16; ++j) w2c[j] = p.gla_w2[((size_t)(l * 2 + dir) * 16 + j) * 128 + h * 32 + d];
    const float b2v = p.gla_b2[(l * 2 + dir) * 128 + h * 32 + d];
    const int dd = d & 15, f = dd & 7;
    const float inv = powf(10000.f, -(float)f / 8.f);
    const int pd = dd < 8 ? d + 8 : d - 8;
    float S[32];
#pragma unroll
    for (int i = 0; i < 32; ++i) S[i] = 0.f;
    for (int s0 = 0; s0 < TOK; s0 += 16) {
        __syncthreads();
#pragma unroll 1
        for (int jj = 0; jj < 8; ++jj) {
            const int j = par + 2 * jj;
            const int t = tok_of(dir, s0 + j);
            const bf16* base = p.rest + ((size_t)b * TOK + t) * NREST;
            float qv = bf2f(base[RC_CQ + h * 32 + d]), kv = bf2f(base[RC_CK + h * 32 + d]);
            if (t >= CTX) {
                const int pidx = t - CTX;
                const int pos = d < 16 ? (pidx >> 6) : (pidx & 63);
                const float ang = (float)pos * inv;
                const float cs = cosf(ang), sn = sinf(ang);
                const float qp = bf2f(base[RC_CQ + h * 32 + pd]), kp = bf2f(base[RC_CK + h * 32 + pd]);
                if (dd < 8) { qv = qv * cs - qp * sn; kv = kv * cs - kp * sn; }
                else { qv = qp * sn + qv * cs; kv = kp * sn + kv * cs; }
            }
            qv *= 0.17677669529663687f;
            float xg = b2v;
#pragma unroll
            for (int jr = 0; jr < 16; ++jr) xg += bf2f(base[RC_CR + dir * 16 + jr]) * w2c[jr];
            const float ls = fminf(xg, 0.f) - log1pf(expf(-fabsf(xg)));
            LASP float* dst = sq + (grp * 16 + j) * 96;
            dst[d] = qv; dst[32 + d] = kv; dst[64 + d] = expf(ls * (1.f / 16.f));
        }
        for (int i = lane; i < 16 * 64; i += 64) {
            const int j = i >> 6, c = i & 63;
            const int t = tok_of(dir, s0 + j);
            sv[(grp * 16 + j) * 64 + c] = bf2f(p.rest[((size_t)b * TOK + t) * NREST + RC_CV + h * 64 + c]);
        }
        __syncthreads();
#pragma unroll 1
        for (int j = 0; j < 16; ++j) {
            const LASP float* qp = sq + (grp * 16 + j) * 96;
            const LASP float* kp = qp + 32;
            const LASP float* dp = qp + 64;
            const float v = sv[(grp * 16 + j) * 64 + lane];
            float o0 = 0.f, o1 = 0.f;
#pragma unroll
            for (int e = 0; e < 32; e += 2) {
                S[e] = dp[e] * S[e] + kp[e] * v; o0 += S[e] * qp[e];
                S[e + 1] = dp[e + 1] * S[e + 1] + kp[e + 1] * v; o1 += S[e + 1] * qp[e + 1];
            }
            const int t = tok_of(dir, s0 + j);
            nb[((size_t)dir * TOK + t) * 256 + h * 64 + lane] = f2bf(o0 + o1);
        }
    }
    __syncthreads();
}

__device__ void na_query_naive(const P& p, LASP float* sm, int l, int b, int t0, bf16* nb) {
    const int tid = mk_tid();
    const int wave = tid >> 6, lane = tid & 63, h = wave & 3, t = t0 + (wave >> 2);
    LASP float* pw = sm + wave * 384;
    const size_t rowq = (size_t)b * TOK + t;
    float qv[64];
    {
        const bf16* qs = p.rest + rowq * NREST + RC_BQ + h * 64;
#pragma unroll
        for (int i = 0; i < 8; ++i) {
            float f[8]; unpack8(*(const uint4*)(qs + i * 8), f);
#pragma unroll
            for (int e = 0; e < 8; ++e) qv[i * 8 + e] = f[e] * 0.125f;
        }
    }
    const bool lat = t >= CTX;
    const int nk = lat ? 384 : 256;
    int r = 0, c = 0, r0 = 0, c0 = 0;
    if (lat) { int pi = t - CTX; r = pi >> 6; c = pi & 63; r0 = min(max(r - 4, 0), 56); c0 = min(max(c - 8, 0), 48); }
    float m = -1e30f;
    __syncthreads();
#pragma unroll 1
    for (int j = 0; j < 6; ++j) {
        const int idx = lane + 64 * j;
        float s = -1e30f;
        if (idx < nk) {
            int tk; float bias = 0.f;
            if (lat && idx < 128) {
                const int i = idx >> 4, kc = c0 + (idx & 15);
                tk = CTX + (r0 + i) * 64 + kc;
                bias = p.rpb[((size_t)(l * 4 + h) * 15 + (r0 + i - r + 7)) * 31 + (kc - c + 15)];
            } else tk = lat ? idx - 128 : idx;
            const bf16* ks = p.kf + (((size_t)(b * 4 + h) * NCH + (tk >> 5)) * 4 * 64 + (tk & 31)) * 8;
            float d0 = 0.f, d1 = 0.f;
#pragma unroll
            for (int i = 0; i < 8; ++i) {
                float f[8]; unpack8(*(const uint4*)(ks + ((i >> 1) * 64 + (i & 1) * 32) * 8), f);
#pragma unroll
                for (int e = 0; e < 8; e += 2) { d0 += qv[i * 8 + e] * f[e]; d1 += qv[i * 8 + e + 1] * f[e + 1]; }
            }
            s = d0 + d1 + bias;
        }
        pw[idx] = s;
        m = fmaxf(m, s);
    }
    m = wave_max(m);
    float sum = 0.f;
#pragma unroll 1
    for (int j = 0; j < 6; ++j) { const float e = expf(pw[lane + 64 * j] - m); pw[lane + 64 * j] = e; sum += e; }
    sum = wave_sum(sum);
    const float inv = 1.f / sum;
    __syncthreads();
    float o0 = 0.f, o1 = 0.f;
    for (int idx = 0; idx < nk; idx += 2) {
        int tk0;
        if (lat && idx < 128) tk0 = CTX + (r0 + (idx >> 4)) * 64 + c0 + (idx & 15);
        else tk0 = lat ? idx - 128 : idx;
        o0 += pw[idx] * bf2f(p.rest[((size_t)b * TOK + tk0) * NREST + RC_BV + h * 64 + lane]);
        o1 += pw[idx + 1] * bf2f(p.rest[((size_t)b * TOK + tk0 + 1) * NREST + RC_BV + h * 64 + lane]);
    }
    nb[(size_t)t * 256 + h * 64 + lane] = f2bf((o0 + o1) * inv);
}


__device__ void ph_probe_naive(const P& p, LASP float* sm, int l, int bid, int nblk) {
    bf16* nb = (bf16*)p.xc1;
    if (PROBE == 1) { if (bid == 0) gdn_scan_naive(p, sm, l, 0, 0, nb); }
    else if (PROBE == 3) { if (bid == 0) gla_scan_naive(p, sm, l, 0, nb); }
    else { for (int it = bid; it < TOK / 2; it += nblk) na_query_naive(p, sm, l, 0, it * 2, nb); }
}
__device__ void ph_probe_cmp(const P& p, int bid, int nblk) {
    const int tid = mk_tid();
    const bf16* nb = (const bf16*)p.xc1;
    float md = 0.f, mr = 0.f;
    const int n = (PROBE == 2) ? TOK * 256 : 2 * TOK * 256;
    for (int i = bid * NTHREADS + tid; i < n; i += nblk * NTHREADS) {
        float a, r = bf2f(nb[i]);
        if (PROBE == 1) { const int dir = i / (TOK * 256), rem = i % (TOK * 256), t = rem >> 8, c = rem & 255; a = bf2f(p.oa[((size_t)dir * ROWS + t) * 512 + c]); }
        else if (PROBE == 3) { const int dir = i / (TOK * 256), rem = i % (TOK * 256); a = bf2f(p.oc[(size_t)dir * ROWS * 256 + rem]); }
        else { const int t = i >> 8, c = i & 255; a = bf2f(p.rest[(size_t)t * NREST + RC_BQ + c]); }
        md = fmaxf(md, fabsf(a - r)); mr = fmaxf(mr, fabsf(r));
    }
    md = wave_max(md); mr = wave_max(mr);
    if ((tid & 63) == 0) { atomicMax((unsigned*)p.stats, __float_as_uint(md)); atomicMax((unsigned*)p.stats + 1, __float_as_uint(mr)); }
}
#endif

#define XB_TMO      128
#define XB_XCNT(j)  (256  + 64 * (j))
#define XB_XSUB(j)  (1280 + 64 * (j))
#define XB_XGEN(j)  (2304 + 64 * (j))
#define XB_TOP      3328
#define XB_TOPGEN   3392
#define XCD_BAR_WORDS 3456
#define XB_SPIN_CAP (1u << 18)

__device__ __forceinline__ unsigned xb_ld(unsigned* p)              { return __hip_atomic_load(p, __ATOMIC_RELAXED, __HIP_MEMORY_SCOPE_AGENT); }
__device__ __forceinline__ unsigned xb_add(unsigned* p, unsigned v) { return __hip_atomic_fetch_add(p, v, __ATOMIC_RELAXED, __HIP_MEMORY_SCOPE_AGENT); }
__device__ __forceinline__ unsigned xb_xcc_id() { return (unsigned)__builtin_amdgcn_s_getreg((3 << 11) | 20) & 0xFu; }
#define XB_SPIN(cond, bar) do { unsigned _sp = 0; while (cond) { __builtin_amdgcn_s_sleep(1); \
    if ((++_sp & 255u) == 0u) { if (xb_ld(&(bar)[XB_TMO])) break; if (_sp > XB_SPIN_CAP) { atomicAdd(&(bar)[XB_TMO], 1u); break; } } } } while (0)

struct XcdBarrier {
    unsigned* bar; unsigned x;
    volatile LASP unsigned* st;
};

__device__ __forceinline__ XcdBarrier xcd_barrier_post(unsigned* bar, volatile LASP unsigned* st) {
    XcdBarrier b; b.bar = bar; b.x = xb_xcc_id(); b.st = st;
    if ((int)threadIdx.x == 0) (void)xb_add(&bar[XB_XCNT(b.x)], 1u);
    return b;
}
__device__ __forceinline__ void xcd_barrier_complete(unsigned* bar, unsigned x, unsigned& nloc, unsigned& nx) {
    const unsigned G = gridDim.x * gridDim.y * gridDim.z;
    unsigned sum, cnt, mine, sp = 0u;
    for (;;) {
        sum = 0u; cnt = 0u; mine = 0u;
#pragma unroll
        for (unsigned j = 0; j < 16; ++j) { const unsigned c = xb_ld(&bar[XB_XCNT(j)]); sum += c; cnt += (c > 0u) ? 1u : 0u; mine = (j == x) ? c : mine; }
        if (sum == G) break;
        __builtin_amdgcn_s_sleep(1);
        if ((++sp & 255u) == 0u) { if (xb_ld(&bar[XB_TMO])) break; if (sp > XB_SPIN_CAP) { atomicAdd(&bar[XB_TMO], 1u); break; } }
    }
    nloc = mine > 0u ? mine : 1u; nx = cnt > 0u ? cnt : 1u;
}

__device__ __forceinline__ void xcd_barrier(const XcdBarrier& b) {
    asm volatile("s_waitcnt vmcnt(0)" ::: "memory");
    __syncthreads();
    if ((int)threadIdx.x == 0) {
        unsigned* bar = b.bar;
        __builtin_amdgcn_s_waitcnt(0);
        unsigned nloc = b.st[0], nx = b.st[1];
        if (nloc == 0u) { xcd_barrier_complete(bar, b.x, nloc, nx); b.st[0] = nloc; b.st[1] = nx; }
        const unsigned old = xb_add(&bar[XB_XSUB(b.x)], 1u);
        const unsigned gen = old / nloc;
        if (old + 1u == (gen + 1u) * nloc) {
            __builtin_amdgcn_fence(__ATOMIC_RELEASE, "agent");
            asm volatile("s_waitcnt vmcnt(0)" ::: "memory");
            const unsigned og = xb_add(&bar[XB_TOP], 1u);
            const unsigned tg = og / nx;
            if (og + 1u == (tg + 1u) * nx) xb_add(&bar[XB_TOPGEN], 1u);
            else XB_SPIN(xb_ld(&bar[XB_TOPGEN]) == tg, bar);
            __builtin_amdgcn_fence(__ATOMIC_ACQUIRE, "agent");
            xb_add(&bar[XB_XGEN(b.x)], 1u);
            asm volatile("s_waitcnt vmcnt(0)" ::: "memory");
        } else {
            XB_SPIN(xb_ld(&bar[XB_XGEN(b.x)]) == gen, bar);
            __builtin_amdgcn_fence(__ATOMIC_ACQUIRE, "agent");
            asm volatile("s_waitcnt vmcnt(0)" ::: "memory");
        }
    }
    __syncthreads();
}


constexpr int NSTEP = 1 + 2 * 7 + 1;
__global__ void __launch_bounds__(NTHREADS, 2) k_mega(P p) {
    extern __shared__ __attribute__((aligned(16))) unsigned char lds_raw[];
    LASP unsigned char* lds = (LASP unsigned char*)lds_raw;
    const int bid = blockIdx.x, nblk = gridDim.x;
    volatile LASP unsigned* bst = (volatile LASP unsigned*)(lds + LDS_BYTES - 64);
    if (threadIdx.x < 16) bst[threadIdx.x] = 0u;
    __syncthreads();
    { const XcdBarrier b0 = xcd_barrier_post((unsigned*)p.ctl, bst); if (threadIdx.x == 0) bst[2] = b0.x; }
    __syncthreads();
    ph_prologue(p, lds, bid, nblk);
    { cg::grid_group grid = cg::this_grid(); grid.sync(); }
#pragma unroll 1
    for (int step = 1; step < NSTEP; ++step) {
        int ph = 0, l = 0;
        { const int s1 = step - 1; l = s1 / 7; ph = 1 + s1 % 7; }
#if TPROBE >= 0
        if (bid == 0 && threadIdx.x == 0) { if (step == 1) p.stats[2] = 0.f; const unsigned long long t_ = __builtin_amdgcn_s_memrealtime(); bst[4] = (unsigned)t_; bst[5] = (unsigned)(t_ >> 32); }
#endif
        if (ph == 1) { if (l == 0) ph_transposes(p, lds, bid, nblk); ph_lnpass(p, l, bid, nblk); }
        else if (l < 2) {
            if (ph == 2) {
                pg8::Gemm g{p.ml, p.wi_t + (size_t)l * NPAD * D, ROWS, NPAD, D}; pg8::StaticOrder S; S.init(ROWS, NPAD, nblk, bid);
                EpiProj E{p.raw, p.rest, p.kf};
                pg8::gemm_phase<EpiProj, pg8::StaticOrder, true, true>(lds, g, S, E);
            } else if (ph == 3) { ph_prep_early(p, lds, l, bid, nblk); ph_conv(p, l, bid, nblk); }
            else if (ph == 4) ph_prep(p, lds, l, bid, nblk);
            else if (ph == 5) {
#if PROBE
                if (l == 0) { ph_probe_naive(p, (LASP float*)lds, l, bid, nblk); XcdBarrier bar; bar.bar = (unsigned*)p.ctl; bar.x = (unsigned)__builtin_amdgcn_readfirstlane((int)bst[2]); bar.st = bst; xcd_barrier(bar); }
#endif
#if TPROBE >= 50
                const bool inrole = TPROBE == 50 ? (bid < 64) : (TPROBE == 51 ? (bid >= 64 && bid < 96) : (bid >= 96));
                const float rscale = TPROBE == 50 ? (1.f / 64.f) : (TPROBE == 51 ? (1.f / 32.f) : (1.f / 160.f));
                if (inrole && threadIdx.x == 0) { const unsigned long long t_ = __builtin_amdgcn_s_memrealtime(); bst[6] = (unsigned)t_; bst[7] = (unsigned)(t_ >> 32); }
#endif
                ph_mix(p, lds, l, bid, nblk);
#if TPROBE >= 50
                if (inrole && threadIdx.x == 0) { const unsigned long long tr0 = (unsigned long long)bst[6] | ((unsigned long long)bst[7] << 32); atomicAdd(&p.stats[2], (float)(__builtin_amdgcn_s_memrealtime() - tr0) * 0.01f * rscale); }
#endif
#if PROBE
                if (l == 0) { XcdBarrier bar; bar.bar = (unsigned*)p.ctl; bar.x = (unsigned)__builtin_amdgcn_readfirstlane((int)bst[2]); bar.st = bst; xcd_barrier(bar); ph_probe_cmp(p, bid, nblk); }
#endif
            }
            else if (ph == 6) ph_gate(p, l, bid, nblk);
            else if (ph == 7) {
                pg8::Gemm g{p.mix, p.wo_t + (size_t)l * D * D, ROWS, D, D};
                EpiY E{p.ml};
                if (l == 0) { pg8::StaticOrder S; S.init(ROWS, D, nblk, bid); pg8::gemm_phase<EpiY, pg8::StaticOrder, true, true>(lds, g, S, E); }
                else { LatentOrder S; S.S.init(BATCH * SEQ, D, nblk, bid); pg8::gemm_phase<EpiY, LatentOrder, true, true>(lds, g, S, E); }
            }
        }
        { XcdBarrier bar; bar.bar = (unsigned*)p.ctl; bar.x = (unsigned)__builtin_amdgcn_readfirstlane((int)bst[2]); bar.st = bst; xcd_barrier(bar); }
#if TPROBE >= 0
        if (bid == 0 && threadIdx.x == 0 && ph == TPROBE) { const unsigned long long tp0 = (unsigned long long)bst[4] | ((unsigned long long)bst[5] << 32); p.stats[2] += (float)(__builtin_amdgcn_s_memrealtime() - tp0) * 0.01f; }
#endif
    }
}

extern "C" void kernel_launch(void* const* d_in, const int* in_sizes, int n_in, void* d_out, int out_size, void* d_ws, size_t ws_size,
                              hipStream_t stream) {
    P p{};
    p.x = (const float*)d_in[0]; p.c = (const float*)d_in[1]; p.ctx = (const float*)d_in[2]; p.c_ctx = (const float*)d_in[3];
    p.w_mod = (const float*)d_in[4]; p.b_mod = (const float*)d_in[5]; p.w_in = (const float*)d_in[6]; p.conv_w = (const float*)d_in[7];
    p.a_log = (const float*)d_in[8]; p.dt_bias = (const float*)d_in[9]; p.gdn_norm = (const float*)d_in[10]; p.rpb = (const float*)d_in[11];
    p.gla_w2 = (const float*)d_in[12]; p.gla_b2 = (const float*)d_in[13]; p.gla_norm = (const float*)d_in[14]; p.w_out = (const float*)d_in[15];
    p.ln_g = (const float*)d_in[16]; p.ln_b = (const float*)d_in[17];
    p.out = (float*)d_out;
    unsigned char* w = (unsigned char*)d_ws;
    size_t off = 0;
    auto take = [&](size_t bytes) { unsigned char* r = w + off; off += (bytes + 255) & ~(size_t)255; return r; };
    p.ctl = (unsigned*)take(16384);
    p.mods = (float*)take((size_t)2 * 9 * 3072 * 4);
    p.xc1 = (float*)take((size_t)BATCH * CTX * D * 4);
    p.wi_t = (bf16*)take((size_t)2 * NPAD * D * 2);
    p.wo_t = (bf16*)take((size_t)2 * D * D * 2);
    p.rest = (bf16*)take((size_t)ROWS * NREST * 2);
    p.raw = (bf16*)take((size_t)ROWS * NRAW * 2);
    p.qkvn = (bf16*)take((size_t)ROWS * NRAW * 2);
    p.mix = p.qkvn;
    p.oa = (bf16*)take((size_t)2 * ROWS * 512 * 2);
    p.oc = (bf16*)take((size_t)2 * ROWS * 256 * 2);
    p.ml = p.oa;
    p.vf = (bf16*)take((size_t)ROWS * 256 * 2);
    p.kf = (bf16*)take((size_t)ROWS * 256 * 2);
    p.stats = (float*)take(256);
    static int grid_blocks = 0;
    if (!grid_blocks) {
        if (off > ws_size) { fprintf(stderr, "workspace too small: need %zu have %zu\n", off, ws_size); grid_blocks = -1; return; }
        int dev = 0, cus = 0, per_cu = 0;
        hipGetDevice(&dev);
        hipDeviceGetAttribute(&cus, hipDeviceAttributeMultiprocessorCount, dev);
        if (hipFuncSetAttribute((const void*)k_mega, hipFuncAttributeMaxDynamicSharedMemorySize, LDS_BYTES) != hipSuccess) { fprintf(stderr, "hipFuncSetAttribute failed\n"); grid_blocks = -1; return; }
        hipOccupancyMaxActiveBlocksPerMultiprocessor(&per_cu, (const void*)k_mega, NTHREADS, LDS_BYTES);
        if (per_cu < 1) { fprintf(stderr, "occupancy query says %d blocks per CU\n", per_cu); grid_blocks = -1; return; }
        grid_blocks = cus;
    }
    if (grid_blocks < 0) return;
    if (hipMemsetAsync(p.ctl, 0, 16384, stream) != hipSuccess) { fprintf(stderr, "memset of the barrier words failed\n"); return; }
    void* args[] = {&p};
    hipError_t e = hipLaunchCooperativeKernel((void*)k_mega, dim3(grid_blocks), dim3(NTHREADS), args, LDS_BYTES, stream);
    if (e != hipSuccess) fprintf(stderr, "cooperative launch failed: %s (grid %d)\n", hipGetErrorString(e), grid_blocks);
}
```

```cpp
#include <hip/hip_runtime.h>
#include <hip/hip_cooperative_groups.h>
#include <cstdio>
#include <cstdint>
namespace cg = cooperative_groups;
#ifndef PROBE
#define PROBE 0
#endif
#ifndef TPROBE
#define TPROBE -1
#endif
#ifndef TSHIFT
#define TSHIFT 0
#endif

constexpr int D = 1024, BATCH = 8, SEQ = 4096, CTX = 256, TOK = 4352, NPROJ = 3888;
constexpr int ROWS = BATCH * TOK;
constexpr int NRAW = 1536, NREST = 2096, NPAD = 4096;
constexpr int NTHREADS = 512, NWAVES = 8;
constexpr int LDS_BYTES = 147456;
constexpr float ALPHA = 1.4142135623730951f;
constexpr int RC_AB = 0, RC_AZ = 16, RC_BQ = 528, RC_BV = 784, RC_BZ = 1040, RC_CQ = 1296, RC_CK = 1424, RC_CV = 1552, RC_CR = 1808, RC_CZ = 1840;
constexpr int PC_BK = 2320, PC_BV = 2576;

typedef unsigned short bf16;
typedef float f32x4_t __attribute__((ext_vector_type(4)));

struct P {
    const float *x, *c, *ctx, *c_ctx, *w_mod, *b_mod, *w_in, *conv_w, *a_log, *dt_bias, *gdn_norm, *rpb,
        *gla_w2, *gla_b2, *gla_norm, *w_out, *ln_g, *ln_b;
    float* out;
    float *mods, *xc1, *stats; unsigned* ctl;
    bf16 *wi_t, *wo_t, *rest, *raw, *qkvn, *mix, *ml, *oa, *oc, *vf, *kf;
};

__device__ __forceinline__ float bf2f(unsigned short u) { return __uint_as_float((unsigned)u << 16); }
typedef float f32x2_t __attribute__((ext_vector_type(2)));
typedef __bf16 bf16x2_t __attribute__((ext_vector_type(2)));
__device__ __forceinline__ unsigned cvtpk(float lo, float hi) { f32x2_t v = {lo, hi}; bf16x2_t q = __builtin_convertvector(v, bf16x2_t); return __builtin_bit_cast(unsigned, q); }
__device__ __forceinline__ unsigned short f2bf(float f) { return (unsigned short)cvtpk(f, f); }
__device__ __forceinline__ unsigned pk2(float lo, float hi) { return cvtpk(lo, hi); }
__device__ __forceinline__ float bflo(unsigned w) { return __uint_as_float(w << 16); }
__device__ __forceinline__ float bfhi(unsigned w) { return __uint_as_float(w & 0xffff0000u); }
__device__ __forceinline__ void unpack8(uint4 w, float* f) {
    f[0] = bflo(w.x); f[1] = bfhi(w.x); f[2] = bflo(w.y); f[3] = bfhi(w.y); f[4] = bflo(w.z); f[5] = bfhi(w.z); f[6] = bflo(w.w); f[7] = bfhi(w.w);
}
__device__ __forceinline__ float silu_f(float x) { return x * __builtin_amdgcn_rcpf(1.f + __builtin_amdgcn_exp2f(-1.4426950408889634f * x)); }
__device__ __forceinline__ float wave_sum(float v) {
#pragma unroll
    for (int o = 32; o > 0; o >>= 1) v += __shfl_xor(v, o);
    return v;
}
__device__ __forceinline__ float wave_max(float v) {
#pragma unroll
    for (int o = 32; o > 0; o >>= 1) v = fmaxf(v, __shfl_xor(v, o));
    return v;
}
__device__ __forceinline__ int mk_tid() { int t = threadIdx.x; asm volatile("" : "+v"(t)); return t; }
__device__ __forceinline__ int tok_of(int dir, int s) { return dir == 0 ? s : (s < CTX ? CTX - 1 - s : TOK + CTX - 1 - s); }

namespace pg8 {
#define PG8_LAS __attribute__((address_space(3)))
typedef unsigned short bf16_t;
typedef short bf16x8 __attribute__((ext_vector_type(8)));
typedef float f32x4 __attribute__((ext_vector_type(4)));
typedef unsigned u32x4 __attribute__((ext_vector_type(4)));
constexpr int BM = 256, BK = 64, HALF = 128, HTB = HALF * BK * 2  , STAGE_BYTES = 8 * HTB, NXCD = 8, WGM = 8;

__host__ __device__ __forceinline__ int lds_byte(int r, int c) { const int st = (r >> 4) * 2 + (c >> 5), rr = r & 15, cc = c & 31, ob = rr * 64 + cc * 2; return st * 1024 + (ob ^ (((ob >> 9) & 1) << 5)); }
__host__ __device__ __forceinline__ void stage_rc(int b, int& R, int& C) { const int st = b / 1024, sb = b % 1024, swz = sb ^ (((sb >> 9) & 1) << 5); R = (st >> 1) * 16 + swz / 64; C = (st & 1) * 32 + (swz % 64) / 2; }
__host__ __device__ __forceinline__ int perm32(int rho) { const int n = rho >> 4, i = rho & 15; return 8 * (i >> 2) + 4 * n + (i & 3); }

struct Unit { int pm, pn; };
struct Gemm { const bf16_t* A; const bf16_t* Bt; int M, N, K; };

struct StaticOrder {
    int nM, nN, nwg, G, c;
    __host__ __device__ void init(int M, int N, int G_, int c_) { nM = M / BM; nN = N / BM; nwg = nM * nN; G = G_; c = c_; }
    __host__ __device__ bool next(int i, Unit& u) const {
        const long L = (long)i * G + c; if (L >= nwg) return false;
        int wgid = (int)L; { const int q = nwg / NXCD, r = nwg % NXCD, xcd = wgid % NXCD, off = wgid / NXCD; wgid = (xcd < r ? xcd * (q + 1) : r * (q + 1) + (xcd - r) * q) + off; }
        const int nig = WGM * nN, gid = wgid / nig, fm = gid * WGM, gsz = (nM - fm) < WGM ? (nM - fm) : WGM;
        u.pm = fm + ((wgid % nig) % gsz); u.pn = (wgid % nig) / gsz; return true;
    }
    __device__ __forceinline__ void a_ready(const Unit&) const {}
    __device__ __forceinline__ void done(const Unit&) const {}
};

__device__ __forceinline__ unsigned cvt_pk_bf16(float lo, float hi) { unsigned r; asm volatile("v_cvt_pk_bf16_f32 %0, %1, %2" : "=v"(r) : "v"(lo), "v"(hi)); return r; }
template <class Epi, class Sched, bool ALIGN_EPI = false, bool SP2 = false>
__device__ __forceinline__ void gemm_phase(PG8_LAS unsigned char* lds, const Gemm g, const Sched& S, const Epi& E) {
    const int tid = mk_tid(), wid = __builtin_amdgcn_readfirstlane(tid >> 6), lane = tid & 63, wr = wid >> 2, wc = wid & 3, fr = lane & 15, fq = lane >> 4;
    const int K = g.K, nt = K / BK;
    unsigned voffA[2], voffB[2];
#pragma unroll
    for (int i = 0; i < 2; ++i) { int R, C; stage_rc(tid * 16 + i * 8192, R, C); const int Rb = Epi::PERM ? ((R & ~31) + perm32(R & 31)) : R;
        voffA[i] = (unsigned)(R * K + C) * 2u; voffB[i] = (unsigned)(Rb * K + C) * 2u; }
    const size_t kstep = (size_t)(BK * 2);
    const size_t hstep = (size_t)HALF * K * 2;
    const size_t tstep = 2 * hstep;
    const unsigned ldsw = (unsigned)wid * 1024u;
    const int aoff = lds_byte(wr * 64 + fr, fq * 8), boff = lds_byte(wc * 32 + fr, fq * 8);
#define PG8_SA(b, h) (((b) * 2 + (h)) * HTB)
#define PG8_SB(b, h) ((4 + (b) * 2 + (h)) * HTB)
#define PG8_STAGE(bufoff, gbase, voff) do { _Pragma("unroll") for (int _i = 0; _i < 2; ++_i) \
        __builtin_amdgcn_global_load_lds((const unsigned*)((const char*)(gbase) + (voff)[_i]), (PG8_LAS unsigned*)(lds + (bufoff) + ldsw + _i * 8192), 16, 0, 0); } while (0)
#define PG8_LDA(dst, b, h) do { _Pragma("unroll") for (int m = 0; m < 4; ++m) _Pragma("unroll") for (int k = 0; k < 2; ++k) dst[m][k] = *(const PG8_LAS bf16x8*)(lds + PG8_SA(b, h) + aoff + m * 2048 + k * 1024); } while (0)
#define PG8_LDB(dst, b, h) do { _Pragma("unroll") for (int n = 0; n < 2; ++n) _Pragma("unroll") for (int k = 0; k < 2; ++k) dst[n][k] = *(const PG8_LAS bf16x8*)(lds + PG8_SB(b, h) + boff + n * 2048 + k * 1024); } while (0)
#define PG8_MMA(ai, bj, At, Bt) do { __builtin_amdgcn_s_setprio(1); _Pragma("unroll") for (int m = 0; m < 4; ++m) _Pragma("unroll") for (int n = 0; n < 2; ++n) _Pragma("unroll") for (int k = 0; k < 2; ++k) \
        acc[ai][bj][m][n] = __builtin_amdgcn_mfma_f32_16x16x32_bf16(Bt[n][k], At[m][k], acc[ai][bj][m][n], 0, 0, 0); __builtin_amdgcn_s_setprio(0); } while (0)
#define PG8_WAIT_V(n) asm volatile("s_waitcnt vmcnt(" #n ")" ::: "memory")
#define PG8_WAIT_L(n) asm volatile("s_waitcnt lgkmcnt(" #n ")" ::: "memory")
#define PG8_BAR __builtin_amdgcn_s_barrier()
#define PG8_SCHED __builtin_amdgcn_sched_barrier(0)
    Unit cur, nxt; int ui = 0;
    if (!S.next(0, cur)) return;
    f32x4 acc[2][2][4][2];
#pragma unroll
    for (int a = 0; a < 2; ++a)
#pragma unroll
        for (int b = 0; b < 2; ++b)
#pragma unroll
            for (int m = 0; m < 4; ++m)
#pragma unroll
                for (int n = 0; n < 2; ++n) acc[a][b][m][n] = (f32x4){0.f, 0.f, 0.f, 0.f};
    bf16x8 At[4][2], B0[2][2], B1[2][2];
    const char* cA = (const char*)g.A + (size_t)cur.pm * tstep; const char* cB = (const char*)g.Bt + (size_t)cur.pn * tstep;
    S.a_ready(cur);
    if constexpr (SP2) {
        PG8_STAGE(PG8_SB(0, 0), cB, voffB); PG8_STAGE(PG8_SB(0, 1), cB + hstep, voffB); PG8_STAGE(PG8_SA(0, 0), cA, voffA); PG8_STAGE(PG8_SA(0, 1), cA + hstep, voffA);
        if (wr == 1) PG8_BAR;
        PG8_WAIT_V(2); PG8_BAR;
        PG8_STAGE(PG8_SB(1, 0), cB + kstep, voffB); PG8_STAGE(PG8_SA(1, 0), cA + kstep, voffA); PG8_STAGE(PG8_SB(1, 1), cB + hstep + kstep, voffB);
        PG8_WAIT_V(6); PG8_BAR;
    } else {
        PG8_STAGE(PG8_SB(0, 0), cB, voffB); PG8_STAGE(PG8_SA(0, 0), cA, voffA); PG8_STAGE(PG8_SB(0, 1), cB + hstep, voffB); PG8_STAGE(PG8_SA(0, 1), cA + hstep, voffA);
        if (wr == 1) PG8_BAR;
        PG8_WAIT_V(4); PG8_BAR;
        PG8_STAGE(PG8_SB(1, 0), cB + kstep, voffB); PG8_STAGE(PG8_SA(1, 0), cA + kstep, voffA); PG8_STAGE(PG8_SB(1, 1), cB + hstep + kstep, voffB);
        PG8_WAIT_V(6); PG8_BAR;
    }
    for (;;) {
        const bool has_next = S.next(ui + 1, nxt);
        const char* nA = has_next ? (const char*)g.A + (size_t)nxt.pm * tstep : cA; const char* nB = has_next ? (const char*)g.Bt + (size_t)nxt.pn * tstep : cB;
        for (int t = 0; t < nt; t += 2) {
            const bool last = (t == nt - 2);
            const char* a1 = cA + (size_t)(t + 1) * kstep;
            const char* a2 = last ? nA : cA + (size_t)(t + 2) * kstep; const char* b2 = last ? nB : cB + (size_t)(t + 2) * kstep;
            const char* a3 = a2 + kstep; const char* b3 = b2 + kstep;
            if (last && has_next) S.a_ready(nxt);
            if constexpr (SP2) {
            PG8_LDB(B0, 0, 0); PG8_LDB(B1, 0, 1); PG8_SCHED; PG8_LDA(At, 0, 0); PG8_STAGE(PG8_SA(1, 1), a1 + hstep, voffA);
            PG8_WAIT_V(8); PG8_WAIT_L(0); PG8_BAR; PG8_MMA(0, 0, At, B0); PG8_MMA(0, 1, At, B1); PG8_BAR; PG8_SCHED;
            PG8_LDA(At, 0, 1); PG8_STAGE(PG8_SB(0, 0), b2, voffB); PG8_STAGE(PG8_SB(0, 1), b2 + hstep, voffB); PG8_STAGE(PG8_SA(0, 0), a2, voffA);
            PG8_WAIT_V(8); PG8_WAIT_L(0); PG8_BAR; PG8_MMA(1, 0, At, B0); PG8_MMA(1, 1, At, B1); PG8_BAR; PG8_SCHED;
            PG8_LDB(B0, 1, 0); PG8_LDB(B1, 1, 1); PG8_SCHED; PG8_LDA(At, 1, 0); PG8_STAGE(PG8_SA(0, 1), a2 + hstep, voffA);
            PG8_WAIT_V(8); PG8_WAIT_L(0); PG8_BAR; PG8_MMA(0, 0, At, B0); PG8_MMA(0, 1, At, B1); PG8_BAR; PG8_SCHED;
            PG8_LDA(At, 1, 1); PG8_STAGE(PG8_SB(1, 0), b3, voffB); PG8_STAGE(PG8_SB(1, 1), b3 + hstep, voffB); PG8_STAGE(PG8_SA(1, 0), a3, voffA);
            PG8_WAIT_V(8); PG8_WAIT_L(0); PG8_BAR; PG8_MMA(1, 0, At, B0); PG8_MMA(1, 1, At, B1); PG8_BAR; PG8_SCHED;
            } else {
            PG8_LDB(B0, 0, 0); PG8_SCHED; PG8_LDA(At, 0, 0); PG8_STAGE(PG8_SA(1, 1), a1 + hstep, voffA);
            PG8_WAIT_L(8); PG8_BAR; PG8_WAIT_L(0); PG8_MMA(0, 0, At, B0); PG8_BAR; PG8_SCHED;
            PG8_LDB(B1, 0, 1); PG8_STAGE(PG8_SB(0, 0), b2, voffB);
            PG8_BAR; PG8_WAIT_L(0); PG8_MMA(0, 1, At, B1); PG8_BAR;
            PG8_LDA(At, 0, 1); PG8_STAGE(PG8_SA(0, 0), a2, voffA);
            PG8_BAR; PG8_WAIT_L(0); PG8_MMA(1, 0, At, B0); PG8_BAR; PG8_SCHED;
            PG8_STAGE(PG8_SB(0, 1), b2 + hstep, voffB);
            PG8_WAIT_V(6); PG8_BAR; PG8_MMA(1, 1, At, B1); PG8_BAR;
            PG8_LDB(B0, 1, 0); PG8_SCHED; PG8_LDA(At, 1, 0); PG8_STAGE(PG8_SA(0, 1), a2 + hstep, voffA);
            PG8_WAIT_L(8); PG8_BAR; PG8_WAIT_L(0); PG8_MMA(0, 0, At, B0); PG8_BAR; PG8_SCHED;
            PG8_LDB(B1, 1, 1); PG8_STAGE(PG8_SB(1, 0), b3, voffB);
            PG8_BAR; PG8_WAIT_L(0); PG8_MMA(0, 1, At, B1); PG8_BAR;
            PG8_LDA(At, 1, 1); PG8_STAGE(PG8_SA(1, 0), a3, voffA);
            PG8_BAR; PG8_WAIT_L(0); PG8_MMA(1, 0, At, B0); PG8_BAR; PG8_SCHED;
            PG8_STAGE(PG8_SB(1, 1), b3 + hstep, voffB);
            PG8_WAIT_V(6); PG8_BAR; PG8_MMA(1, 1, At, B1); PG8_BAR;
            }
        }
        if constexpr (ALIGN_EPI) { if (wr == 0) PG8_BAR; }
        if constexpr (!Epi::AFTER_DRAIN) { E(acc, cur, wr, wc, fr, fq); S.done(cur); }
        if (!has_next) break;
#pragma unroll
        for (int a = 0; a < 2; ++a)
#pragma unroll
            for (int b = 0; b < 2; ++b)
#pragma unroll
                for (int m = 0; m < 4; ++m)
#pragma unroll
                    for (int n = 0; n < 2; ++n) acc[a][b][m][n] = (f32x4){0.f, 0.f, 0.f, 0.f};
        cur = nxt; cA = nA; cB = nB; ++ui;
        if constexpr (ALIGN_EPI) { if (wr == 1) PG8_BAR; }
    }
    PG8_WAIT_V(0);
    if constexpr (!ALIGN_EPI) { if (wr == 0) PG8_BAR; }
    PG8_BAR;
    if constexpr (Epi::AFTER_DRAIN) { E.fused(acc, cur, wr, wc, fr, fq, lds, wid, lane); S.done(cur); }
#undef PG8_SA
#undef PG8_SB
#undef PG8_STAGE
#undef PG8_LDA
#undef PG8_LDB
#undef PG8_MMA
#undef PG8_WAIT_V
#undef PG8_WAIT_L
#undef PG8_BAR
#undef PG8_SCHED
}
}

#define LASP __attribute__((address_space(3)))
constexpr int NCHK = TOK / 32;

struct LatentOrder {
    pg8::StaticOrder S;
    __device__ __forceinline__ bool next(int i, pg8::Unit& u) const { if (!S.next(i, u)) return false; u.pm = 17 * (u.pm >> 4) + 1 + (u.pm & 15); return true; }
    __device__ __forceinline__ void a_ready(const pg8::Unit&) const {}
    __device__ __forceinline__ void done(const pg8::Unit&) const {}
};
struct EpiProj {
    static constexpr bool PERM = true, AFTER_DRAIN = false;
    bf16* raw; bf16* rest; bf16* kf;
    __device__ __forceinline__ void operator()(const pg8::f32x4 (&acc)[2][2][4][2], const pg8::Unit& u, int wr, int wc, int fr, int fq) const {
        const int row0 = u.pm * 256 + wr * 64 + fr;
        const int colb = u.pn * 256 + wc * 32 + 8 * fq;
#pragma unroll
        for (int bj = 0; bj < 2; ++bj) {
            const int col = colb + bj * 128;
            if (col >= NPROJ) continue;
            const bool iskf = col >= PC_BK && col < PC_BV;
            bf16* base; int ld;
            if (col < NRAW) { base = raw + col; ld = NRAW; }
            else if (col < PC_BK) { base = rest + (col - NRAW); ld = NREST; }
            else { base = rest + (col - NRAW - 256); ld = NREST; }
            const int hd = col - PC_BK, hk = hd >> 6, dk = hd & 63;
#pragma unroll
            for (int ai = 0; ai < 2; ++ai)
#pragma unroll
                for (int m = 0; m < 4; ++m) {
                    const pg8::f32x4 v0 = acc[ai][bj][m][0], v1 = acc[ai][bj][m][1];
                    pg8::u32x4 w; w.x = pg8::cvt_pk_bf16(v0[0], v0[1]); w.y = pg8::cvt_pk_bf16(v0[2], v0[3]); w.z = pg8::cvt_pk_bf16(v1[0], v1[1]); w.w = pg8::cvt_pk_bf16(v1[2], v1[3]);
                    const int row = row0 + ai * 128 + m * 16;
                    if (iskf) {
                        const int bb = row / TOK, t = row - bb * TOK;
                        *(pg8::u32x4*)(kf + ((((size_t)(bb * 4 + hk) * NCHK + (t >> 5)) * 4 + (dk >> 4)) * 64 + ((dk >> 3) & 1) * 32 + (t & 31)) * 8) = w;
                    } else *(pg8::u32x4*)(base + (size_t)row * ld) = w;
                }
        }
    }
};
struct EpiY {
    static constexpr bool PERM = true, AFTER_DRAIN = false;
    bf16* y;
    __device__ __forceinline__ void operator()(const pg8::f32x4 (&acc)[2][2][4][2], const pg8::Unit& u, int wr, int wc, int fr, int fq) const {
        const int row0 = u.pm * 256 + wr * 64 + fr;
        const int colb = u.pn * 256 + wc * 32 + 8 * fq;
#pragma unroll
        for (int bj = 0; bj < 2; ++bj)
#pragma unroll
            for (int ai = 0; ai < 2; ++ai)
#pragma unroll
                for (int m = 0; m < 4; ++m) {
                    const pg8::f32x4 v0 = acc[ai][bj][m][0], v1 = acc[ai][bj][m][1];
                    pg8::u32x4 w; w.x = pg8::cvt_pk_bf16(v0[0], v0[1]); w.y = pg8::cvt_pk_bf16(v0[2], v0[3]); w.z = pg8::cvt_pk_bf16(v1[0], v1[1]); w.w = pg8::cvt_pk_bf16(v1[2], v1[3]);
                    *(pg8::u32x4*)(y + (size_t)(row0 + ai * 128 + m * 16) * D + colb + bj * 128) = w;
                }
    }
};

__device__ __forceinline__ void transpose_item(const float* W, int K, int N, bf16* WT, LASP float* scr, int item, int lane) {
    const int nblk = (N + 31) / 32, kb = item / nblk, nb = item % nblk, k0 = 64 * kb, n0 = 32 * nb;
    const bool nok = (n0 + (lane & 31)) < N;
#pragma unroll 8
    for (int i = 0; i < 32; ++i) { const int kk = 2 * i + (lane >> 5); scr[kk * 33 + (lane & 31)] = nok ? W[(size_t)(k0 + kk) * N + n0 + (lane & 31)] : 0.f; }
    asm volatile("s_waitcnt lgkmcnt(0)" ::: "memory");
    const int c = lane & 7;
#pragma unroll
    for (int j = 0; j < 4; ++j) {
        const int n = (lane >> 3) + 8 * j; const LASP float* s = scr + (8 * c) * 33 + n;
        uint4 o; o.x = pk2(s[0 * 33], s[1 * 33]); o.y = pk2(s[2 * 33], s[3 * 33]); o.z = pk2(s[4 * 33], s[5 * 33]); o.w = pk2(s[6 * 33], s[7 * 33]);
        *(uint4*)(WT + (size_t)(n0 + n) * K + k0 + 8 * c) = o;
    }
    asm volatile("s_waitcnt lgkmcnt(0)" ::: "memory");
}

__device__ void ph_prologue(const P& p, LASP unsigned char* lds, int bid, int nblk) {
    const int tid = mk_tid(), lane = tid & 63, wave = tid >> 6;
    LASP float* sm = (LASP float*)lds;
    if (bid < 96) {
        for (int i = tid; i < 9 * 1024; i += NTHREADS) {
            int s = i >> 10, d = i & 1023;
            float cv = s < 8 ? p.c[s * 1024 + d] : p.c_ctx[d];
            sm[i] = silu_f(cv);
        }
        __syncthreads();
        const int l = bid / 48, j = (bid % 48) * 64 + lane;
        const float* w = p.w_mod + (size_t)l * 1024 * 3072 + j;
        float acc[9];
#pragma unroll
        for (int s = 0; s < 9; ++s) acc[s] = 0.f;
#pragma unroll 1
        for (int i0 = wave * 128; i0 < wave * 128 + 128; i0 += 16) {
            float wv[16];
#pragma unroll
            for (int u = 0; u < 16; ++u) wv[u] = w[(size_t)(i0 + u) * 3072];
#pragma unroll
            for (int u = 0; u < 16; ++u)
#pragma unroll
                for (int s = 0; s < 9; ++s) acc[s] += sm[s * 1024 + i0 + u] * wv[u];
        }
        LASP float* red = sm + 9 * 1024;
#pragma unroll
        for (int s = 0; s < 9; ++s) red[(wave * 9 + s) * 64 + lane] = acc[s];
        __syncthreads();
        for (int o = tid; o < 9 * 64; o += NTHREADS) {
            const int s = o >> 6, c = o & 63;
            float t = 0.f;
#pragma unroll
            for (int ww = 0; ww < 8; ++ww) t += red[(ww * 9 + s) * 64 + c];
            const int jj = (bid % 48) * 64 + c;
            p.mods[(size_t)(l * 9 + s) * 3072 + jj] = t + p.b_mod[l * 3072 + jj];
        }
        __syncthreads();
    }
#if PROBE
    if (bid == 0 && tid < 4) p.stats[tid] = 0.f;
#endif
}
__device__ void ph_transposes(const P& p, LASP unsigned char* lds, int bid, int nblk) {
    const int tid = mk_tid(), lane = tid & 63, wave = tid >> 6;
    LASP float* scr = (LASP float*)(lds + 57344 + wave * 8704);
    const int gw = (nblk - 1 - bid) * NWAVES + wave, NGW = nblk * NWAVES;
    constexpr int I_IN = 16 * 122, I_OUT = 16 * 32;
    for (int it = gw; it < 2 * (I_IN + I_OUT); it += NGW) {
        int l = it / (I_IN + I_OUT), r = it % (I_IN + I_OUT);
        if (r < I_IN) transpose_item(p.w_in + (size_t)l * D * NPROJ, D, NPROJ, p.wi_t + (size_t)l * NPAD * D, scr, r, lane);
        else transpose_item(p.w_out + (size_t)l * D * D, D, D, p.wo_t + (size_t)l * D * D, scr, r - I_IN, lane);
    }
    for (int i = bid * NTHREADS + tid; i < 2 * 192 * 128; i += nblk * NTHREADS) {
        int l = i / (192 * 128), r = i % (192 * 128);
        unsigned z; asm volatile("v_mov_b32 %0, 0" : "=v"(z));
        *(uint4*)(p.wi_t + (size_t)l * NPAD * D + (size_t)3904 * D + (size_t)r * 8) = make_uint4(z, z, z, z);
    }
}

__device__ void ph_lnpass(const P& p, int mode, int bid, int nblk) {
    const int tid = mk_tid();
    const int lane = tid & 63, wave = tid >> 6;
    for (int r = bid * NWAVES + wave; r < ROWS; r += nblk * NWAVES) {
        const int b = r / TOK, t = r - b * TOK;
        const bool isc = t < CTX;
        if (mode == 2 && isc) continue;
        float* buf; const float* src; int s;
        if (isc) { buf = p.xc1 + ((size_t)b * CTX + t) * D; src = p.ctx + ((size_t)b * CTX + t) * D; s = 8; }
        else { buf = p.out + ((size_t)b * SEQ + (t - CTX)) * D; src = (mode == 2) ? buf : p.x + ((size_t)b * SEQ + (t - CTX)) * D; s = b; }
        f32x4_t v[4];
#pragma unroll
        for (int j = 0; j < 4; ++j) v[j] = *(const f32x4_t*)(src + 256 * j + 4 * lane);
        if (mode >= 1) {
            const int lp = mode - 1;
            const float* gt = p.mods + (size_t)(lp * 9 + s) * 3072 + 2048;
#pragma unroll
            for (int j = 0; j < 4; ++j) {
                const uint2 yw = *(const uint2*)(p.ml + (size_t)r * D + 256 * j + 4 * lane);
                const f32x4_t g = *(const f32x4_t*)(gt + 256 * j + 4 * lane);
                const f32x4_t yv = {bflo(yw.x), bfhi(yw.x), bflo(yw.y), bfhi(yw.y)};
                v[j] = v[j] * ALPHA + g * yv;
            }
            float sum = 0.f;
#pragma unroll
            for (int j = 0; j < 4; ++j) sum += (v[j].x + v[j].y) + (v[j].z + v[j].w);
            const float mu = wave_sum(sum) * (1.f / 1024.f);
            float sq = 0.f;
#pragma unroll
            for (int j = 0; j < 4; ++j) { v[j] = v[j] - mu; sq += (v[j].x * v[j].x + v[j].y * v[j].y) + (v[j].z * v[j].z + v[j].w * v[j].w); }
            const float rs = __builtin_amdgcn_rsqf(wave_sum(sq) * (1.f / 1024.f) + 1e-6f);
#pragma unroll
            for (int j = 0; j < 4; ++j) {
                const f32x4_t g = *(const f32x4_t*)(p.ln_g + lp * 1024 + 256 * j + 4 * lane), bb = *(const f32x4_t*)(p.ln_b + lp * 1024 + 256 * j + 4 * lane);
                v[j] = v[j] * rs * g + bb;
#if PROBE
                if (mode == 2) v[j] = v[j] + (p.stats[0] / fmaxf(p.stats[1], 1e-20f));
#endif
#if TPROBE >= 0
                if (mode == 2) v[j] = v[j] + exp2f((rintf(log2f(fmaxf(p.stats[2], 1.f)) * 6.f + TSHIFT * 0.5f) - TSHIFT * 0.5f) * (1.f / 6.f)) * 1e-4f;
#endif
                *(f32x4_t*)(buf + 256 * j + 4 * lane) = v[j];
            }
            if (mode == 2) continue;
        }
        const int l = mode;
        float sum = 0.f;
#pragma unroll
        for (int j = 0; j < 4; ++j) sum += (v[j].x + v[j].y) + (v[j].z + v[j].w);
        const float mu = wave_sum(sum) * (1.f / 1024.f);
        float sq = 0.f;
#pragma unroll
        for (int j = 0; j < 4; ++j) { v[j] = v[j] - mu; sq += (v[j].x * v[j].x + v[j].y * v[j].y) + (v[j].z * v[j].z + v[j].w * v[j].w); }
        const float rs = __builtin_amdgcn_rsqf(wave_sum(sq) * (1.f / 1024.f) + 1e-6f);
        const float* md = p.mods + (size_t)(l * 9 + s) * 3072;
#pragma unroll
        for (int j = 0; j < 4; ++j) {
            const f32x4_t sh = *(const f32x4_t*)(md + 256 * j + 4 * lane), sc = *(const f32x4_t*)(md + 1024 + 256 * j + 4 * lane);
            const f32x4_t o = v[j] * rs * (sc + 1.f) + sh;
            uint2 w; w.x = pk2(o.x, o.y); w.y = pk2(o.z, o.w);
            *(uint2*)(p.ml + (size_t)r * D + 256 * j + 4 * lane) = w;
        }
    }
}

__device__ void ph_conv(const P& p, int l, int bid, int nblk) {
    const int tid = mk_tid();
    const int lane = tid & 63, wave = tid >> 6;
    const float* cw = p.conv_w + (size_t)l * 5 * 1536;
    constexpr int NSTRIP = TOK / 16;
    for (int it = bid * NWAVES + wave; it < BATCH * NSTRIP * 3; it += nblk * NWAVES) {
        const int third = it % 3, rest_i = it / 3, strip = rest_i % NSTRIP, b = rest_i / NSTRIP;
        const int t0 = strip * 16;
        const int lo = t0 < CTX ? 0 : CTX, hi = t0 < CTX ? CTX : TOK;
        const int ch = third * 512 + lane * 8;
        float w[5][8];
#pragma unroll
        for (int j = 0; j < 5; ++j) {
            const f32x4_t a = *(const f32x4_t*)(cw + j * 1536 + ch), c = *(const f32x4_t*)(cw + j * 1536 + ch + 4);
            w[j][0] = a.x; w[j][1] = a.y; w[j][2] = a.z; w[j][3] = a.w; w[j][4] = c.x; w[j][5] = c.y; w[j][6] = c.z; w[j][7] = c.w;
        }
        const bf16* src = p.raw + ((size_t)b * TOK + t0) * NRAW + ch;
        bf16* dst = p.qkvn + ((size_t)b * TOK + t0) * NRAW + ch;
        uint4 rw[20];
#pragma unroll
        for (int i = 0; i < 20; ++i) {
            const int tt = t0 + i - 2;
            rw[i] = (tt >= lo && tt < hi) ? *(const uint4*)(src + (ptrdiff_t)(i - 2) * NRAW) : make_uint4(0, 0, 0, 0);
        }
        const int g = (ch >> 7);
        const float qs = g < 4 ? 0.08838834764831845f : 1.f;
#pragma unroll
        for (int n = 0; n < 16; ++n) {
            float acc[8];
#pragma unroll
            for (int e = 0; e < 8; ++e) acc[e] = 0.f;
#pragma unroll
            for (int j = 0; j < 5; ++j) {
                float f[8]; unpack8(rw[n + j], f);
#pragma unroll
                for (int e = 0; e < 8; ++e) acc[e] += w[j][e] * f[e];
            }
            float ss = 0.f;
#pragma unroll
            for (int e = 0; e < 8; ++e) { acc[e] = silu_f(acc[e]); ss += acc[e] * acc[e]; }
            if (g < 8) {
#pragma unroll
                for (int m = 8; m > 0; m >>= 1) ss += __shfl_xor(ss, m);
                const float sc = qs * __builtin_amdgcn_rsqf(ss + 1e-6f);
#pragma unroll
                for (int e = 0; e < 8; ++e) acc[e] *= sc;
            }
            uint4 o; o.x = pk2(acc[0], acc[1]); o.y = pk2(acc[2], acc[3]); o.z = pk2(acc[4], acc[5]); o.w = pk2(acc[6], acc[7]);
            *(uint4*)(dst + (size_t)n * NRAW) = o;
        }
    }
}

typedef short bf16x8_t __attribute__((ext_vector_type(8)));
typedef float f32x16_t __attribute__((ext_vector_type(16)));
typedef unsigned u32x4_t __attribute__((ext_vector_type(4)));
#define MFMA32(a, b, c) __builtin_amdgcn_mfma_f32_32x32x16_bf16((a), (b), (c), 0, 0, 0)
__device__ __forceinline__ int crow(int reg, int h) { return (reg & 3) + 8 * (reg >> 2) + 4 * h; }
__device__ __forceinline__ int perm16(int a) { const int x = a & 15; return (a & ~15) + (x < 4 ? x : x < 8 ? x + 4 : x < 12 ? x - 4 : x); }
#define PACK8(x, s) __builtin_bit_cast(bf16x8_t, (u32x4_t){cvtpk((x)[8 * (s)], (x)[8 * (s) + 1]), cvtpk((x)[8 * (s) + 2], (x)[8 * (s) + 3]), cvtpk((x)[8 * (s) + 4], (x)[8 * (s) + 5]), cvtpk((x)[8 * (s) + 6], (x)[8 * (s) + 7])})
constexpr int GCH = 32, NCH = TOK / GCH;
constexpr int GP_ITEM = 4416;

__device__ void ph_gdnprep(const P& p, LASP unsigned char* lds, int l, int bid, int nblk, int tid) {
    const int lane = tid & 63, wave = tid >> 6, r = lane & 31, hh = lane >> 5;
    LASP float* Lm = (LASP float*)(lds + wave * 16384);
    LASP float* Xs = Lm + 2048;
    for (int it = bid * NWAVES + wave; it < BATCH * 4 * NCH; it += nblk * NWAVES) {
        const int c = it % NCH, bh = it / NCH, h = bh & 3, b = bh >> 2;
        const size_t row0 = (size_t)b * TOK + (size_t)c * GCH;
        f32x16_t KK, QK;
#pragma unroll
        for (int i = 0; i < 16; ++i) { KK[i] = 0.f; QK[i] = 0.f; }
        const bf16* kbase = p.qkvn + (row0 + r) * NRAW + 512 + h * 128 + 8 * hh;
        const bf16* qbase = p.qkvn + (row0 + r) * NRAW + h * 128 + 8 * hh;
#pragma unroll
        for (int s = 0; s < 8; ++s) {
            const bf16x8_t kf = *(const bf16x8_t*)(kbase + 16 * s), qf = *(const bf16x8_t*)(qbase + 16 * s);
            KK = MFMA32(kf, kf, KK);
            QK = MFMA32(qf, kf, QK);
        }
        float Gd, bd;
        {
            const bf16* ab = p.rest + (row0 + r) * NREST + RC_AB;
            const float a = bf2f(ab[hh * 4 + h]) + p.dt_bias[(l * 2 + hh) * 4 + h];
            const float sp = fmaxf(a, 0.f) + 0.6931471805599453f * __builtin_amdgcn_logf(1.f + __builtin_amdgcn_exp2f(-1.4426950408889634f * fabsf(a)));
            Gd = -__builtin_amdgcn_exp2f(1.4426950408889634f * p.a_log[(l * 2 + hh) * 4 + h]) * sp;
            bd = __builtin_amdgcn_rcpf(1.f + __builtin_amdgcn_exp2f(-1.4426950408889634f * bf2f(ab[(2 + hh) * 4 + h])));
        }
#pragma unroll
        for (int off = 1; off < 32; off <<= 1) {
            const float up = __shfl_up(Gd, off, 32), dn = __shfl_down(Gd, off, 32);
            if (hh == 0) { if (r >= off) Gd += up; } else { if (r + off < 32) Gd += dn; }
        }
        unsigned char* gout = (unsigned char*)p.raw + ((size_t)(bh * 2) * NCH + c) * GP_ITEM;
        {
            const float Glast = __shfl(Gd, hh == 0 ? 31 : 32);
            float* sc = (float*)(gout + (size_t)hh * NCH * GP_ITEM + 4096);
            sc[r] = __builtin_amdgcn_exp2f(1.4426950408889634f * Gd); sc[32 + r] = __builtin_amdgcn_exp2f(1.4426950408889634f * (Glast - Gd));
            if (r == 0) sc[64] = __builtin_amdgcn_exp2f(1.4426950408889634f * Glast);
        }
        asm volatile("s_waitcnt lgkmcnt(0)" ::: "memory");
        LASP unsigned short* qkt = (LASP unsigned short*)Xs;
        LASP float* bs = (LASP float*)(lds + 135168 + wave * 256);
        bs[lane] = bd;
#pragma unroll
        for (int d = 0; d < 2; ++d) {
            const float Gcol = __shfl(Gd, d * 32 + r);
#pragma unroll
            for (int i = 0; i < 16; ++i) {
                const int n = crow(i, hh);
                const float Grow = __shfl(Gd, d * 32 + n), brow = __shfl(bd, d * 32 + n);
                const bool incl = d == 0 ? (r <= n) : (r >= n), strict = d == 0 ? (r < n) : (r > n);
                const float dec = __builtin_amdgcn_exp2f((incl ? Grow - Gcol : 0.f) * 1.4426950408889634f);
                const float lv = strict ? brow * KK[i] * dec : 0.f;
                const float qv = incl ? QK[i] * dec : 0.f;
                const int n2 = d == 0 ? n : 31 - n, m2 = d == 0 ? r : 31 - r;
                Lm[(d * 32 + n2) * 32 + m2] = lv;
                qkt[(d * 32 + n) * 40 + perm16(r)] = f2bf(qv);
                if ((i & 3) == 3) __builtin_amdgcn_sched_barrier(0);
            }
        }
        asm volatile("s_waitcnt lgkmcnt(0)" ::: "memory");
#pragma unroll
        for (int d = 0; d < 2; ++d)
#pragma unroll
            for (int k = 0; k < 2; ++k) {
                const int q = lane + 64 * k, row = q >> 2, ch = q & 3;
                *(u32x4_t*)(gout + (size_t)d * NCH * GP_ITEM + 2048 + row * 64 + ch * 16) = *(const LASP u32x4_t*)((const LASP unsigned char*)qkt + (d * 32 + row) * 80 + ch * 16);
            }
        asm volatile("s_waitcnt lgkmcnt(0)" ::: "memory");
        {
            const LASP float* Lr = Lm + hh * 1024;
            LASP float* xc = Xs + lane;
#pragma unroll 1
            for (int nb = 0; nb < 8; ++nb) {
                float a[4];
#pragma unroll
                for (int k = 0; k < 4; ++k) a[k] = (4 * nb + k == r) ? 1.f : 0.f;
#pragma unroll 2
                for (int jb = 0; jb < nb; ++jb) {
                    const float x0 = xc[(4 * jb) * 64], x1 = xc[(4 * jb + 1) * 64], x2 = xc[(4 * jb + 2) * 64], x3 = xc[(4 * jb + 3) * 64];
#pragma unroll
                    for (int k = 0; k < 4; ++k) {
                        const f32x4_t lv = *(const LASP f32x4_t*)(Lr + (4 * nb + k) * 32 + 4 * jb);
                        a[k] -= (lv.x * x0 + lv.y * x1) + (lv.z * x2 + lv.w * x3);
                    }
                }
                const f32x4_t l1 = *(const LASP f32x4_t*)(Lr + (4 * nb + 1) * 32 + 4 * nb), l2 = *(const LASP f32x4_t*)(Lr + (4 * nb + 2) * 32 + 4 * nb), l3 = *(const LASP f32x4_t*)(Lr + (4 * nb + 3) * 32 + 4 * nb);
                a[1] -= l1.x * a[0];
                a[2] -= l2.x * a[0] + l2.y * a[1];
                a[3] -= (l3.x * a[0] + l3.y * a[1]) + l3.z * a[2];
#pragma unroll
                for (int k = 0; k < 4; ++k) xc[(4 * nb + k) * 64] = a[k];
                asm volatile("s_waitcnt lgkmcnt(0)" ::: "memory");
            }
        }
        asm volatile("s_waitcnt lgkmcnt(0)" ::: "memory");
#pragma unroll
        for (int d = 0; d < 2; ++d)
#pragma unroll
            for (int k = 0; k < 2; ++k) {
                const int q = lane + 64 * k, row = q >> 2, ch = q & 3;
                const int nn = d == 0 ? row : 31 - row;
                float v[8];
#pragma unroll
                for (int e = 0; e < 8; ++e) {
                    const int m = perm16(ch * 8 + e);
                    const int lidx = d == 0 ? m : 32 + 31 - m;
                    v[e] = Xs[nn * 64 + lidx] * bs[d * 32 + m];
                }
                *(u32x4_t*)(gout + (size_t)d * NCH * GP_ITEM + row * 64 + ch * 16) = (u32x4_t){cvtpk(v[0], v[1]), cvtpk(v[2], v[3]), cvtpk(v[4], v[5]), cvtpk(v[6], v[7])};
            }
        asm volatile("s_waitcnt lgkmcnt(0)" ::: "memory");
    }
}

constexpr int ST_KA = 0, ST_QA = 8704, ST_KN = 17408, ST_V = 27648, ST_TP = 37888, ST_QK = 40448, ST_GL = 43008, ST_BYTES = 43328;
constexpr int GDN_OST = 2 * ST_BYTES, GDN_OST_BYTES = 32 * 272;
typedef unsigned u32x2_t __attribute__((ext_vector_type(2)));
typedef short s16x4_t __attribute__((ext_vector_type(4)));
struct GSlot { u32x4_t k0, k1, q0, q1, v0, v1, t; f32x4_t sc; };

__device__ __forceinline__ int gdn_chunk(int dir, int s) { return dir == 0 ? s : (s < 8 ? 7 - s : 143 - s); }
__device__ __forceinline__ void gdn_issue(const P& p, GSlot& g, int b, int h, int dir, int step, int tl) {
    const int c = gdn_chunk(dir, step);
    const size_t row0 = (size_t)b * TOK + (size_t)c * GCH;
    const int r0 = tl >> 4, c16 = tl & 15;
    const bf16* a0 = p.qkvn + (row0 + r0) * NRAW + h * 128 + 8 * c16;
    const bf16* a1 = a0 + (size_t)16 * NRAW;
    g.q0 = *(const u32x4_t*)a0; g.q1 = *(const u32x4_t*)a1;
    g.k0 = *(const u32x4_t*)(a0 + 512); g.k1 = *(const u32x4_t*)(a1 + 512);
    g.v0 = *(const u32x4_t*)(a0 + 1024); g.v1 = *(const u32x4_t*)(a1 + 1024);
    const unsigned char* gp = (const unsigned char*)p.raw + ((size_t)((b * 4 + h) * 2 + dir) * NCH + c) * GP_ITEM;
    g.t = *(const u32x4_t*)(gp + tl * 16);
    g.sc = *(const f32x4_t*)(gp + 4096 + (tl < 20 ? tl : 0) * 16);
}
__device__ __forceinline__ u32x4_t scale8(u32x4_t x, float s) {
    return (u32x4_t){cvtpk(bflo(x.x) * s, bfhi(x.x) * s), cvtpk(bflo(x.y) * s, bfhi(x.y) * s), cvtpk(bflo(x.z) * s, bfhi(x.z) * s), cvtpk(bflo(x.w) * s, bfhi(x.w) * s)};
}
__device__ __forceinline__ void gdn_put_rows(LASP unsigned char* st, int row, int c16, u32x4_t kq, int off) {
    const int g = c16 >> 1, odd = c16 & 1;
    *(LASP u32x2_t*)(st + off + row * 272 + (16 * g + (odd ? 4 : 0)) * 2) = (u32x2_t){kq.x, kq.y};
    *(LASP u32x2_t*)(st + off + row * 272 + (16 * g + (odd ? 12 : 8)) * 2) = (u32x2_t){kq.z, kq.w};
}
__device__ __forceinline__ void gdn_write(LASP unsigned char* st, const GSlot& g, int tl) {
    const int r0 = tl >> 4, c16 = tl & 15;
    gdn_put_rows(st, r0, c16, g.k0, ST_KA); gdn_put_rows(st, r0 + 16, c16, g.k1, ST_KA);
    gdn_put_rows(st, r0, c16, g.q0, ST_QA); gdn_put_rows(st, r0 + 16, c16, g.q1, ST_QA);
    *(LASP u32x4_t*)(st + ST_KN + r0 * 320 + c16 * 16) = g.k0;
    *(LASP u32x4_t*)(st + ST_KN + (r0 + 16) * 320 + c16 * 16) = g.k1;
    *(LASP u32x4_t*)(st + ST_V + r0 * 320 + c16 * 16) = g.v0;
    *(LASP u32x4_t*)(st + ST_V + (r0 + 16) * 320 + c16 * 16) = g.v1;
    { const int t2 = tl & 127; *(LASP u32x4_t*)(st + (tl < 128 ? ST_TP : ST_QK) + (t2 >> 2) * 80 + (t2 & 3) * 16) = g.t; }
    if (tl < 20) *(LASP f32x4_t*)(st + ST_GL + tl * 16) = g.sc;
}
__device__ __forceinline__ void gdn_flush(const P& p, LASP unsigned char* lds, int b, int h, int dir, int step, int tl) {
    const int c = gdn_chunk(dir, step);
    const LASP unsigned char* ost = lds + GDN_OST + (step & 1) * GDN_OST_BYTES;
    bf16* op = p.oa + ((size_t)dir * ROWS + (size_t)b * TOK + (size_t)c * GCH) * 512 + h * 128;
#pragma unroll
    for (int k = 0; k < 2; ++k) { const int idx = tl + 256 * k, row = idx >> 4, ch = idx & 15; *(u32x4_t*)(op + (size_t)row * 512 + ch * 8) = *(const LASP u32x4_t*)(ost + row * 272 + ch * 16); }
}
__device__ __forceinline__ s16x4_t trd(const LASP unsigned char* q) {
    typedef short v4i16_t __attribute__((ext_vector_type(4)));
    return __builtin_bit_cast(s16x4_t, __builtin_amdgcn_ds_read_tr16_b64_v4i16((LASP v4i16_t*)q));
}
#define TRFRAG(base) __builtin_shufflevector(trd(base), trd((base) + 8 * 320), 0, 1, 2, 3, 4, 5, 6, 7)

#if TPROBE == 60
#define GDN_SYNC_C() do { unsigned long long t_ = __builtin_amdgcn_s_memrealtime(); __syncthreads(); if (chain == 0 && tid == 0) p.stats[2] += (float)(__builtin_amdgcn_s_memrealtime() - t_) * 0.01f; } while (0)
#define GDN_SYNC_L() __syncthreads()
#elif TPROBE == 61
#define GDN_SYNC_L() do { unsigned long long t_ = __builtin_amdgcn_s_memrealtime(); __syncthreads(); if (chain == 0 && tid == 256) p.stats[2] += (float)(__builtin_amdgcn_s_memrealtime() - t_) * 0.01f; } while (0)
#define GDN_SYNC_C() __syncthreads()
#else
#define GDN_SYNC_C() __syncthreads()
#define GDN_SYNC_L() __syncthreads()
#endif
__device__ void gdn_scan_fast(const P& p, LASP unsigned char* lds, int chain) {
    const int tid = mk_tid();
    const int lane = tid & 63, wave = __builtin_amdgcn_readfirstlane(tid >> 6);
    const int dir = chain & 1, h = (chain >> 1) & 3, b = chain >> 3;
    constexpr int NS = NCH;
    if (wave >= 4) {
        const int tl = tid - 256;
        GSlot g0, g1, g2, g3;
        gdn_issue(p, g0, b, h, dir, 0, tl); gdn_issue(p, g1, b, h, dir, 1, tl); gdn_issue(p, g2, b, h, dir, 2, tl); gdn_issue(p, g3, b, h, dir, 3, tl);
        gdn_write(lds, g0, tl); gdn_issue(p, g0, b, h, dir, 4, tl);
        __syncthreads();
#pragma unroll 1
        for (int s = 0; s < NS; s += 4) {
            if (s > 0) gdn_flush(p, lds, b, h, dir, s - 1, tl);
            gdn_write(lds + ((s + 1) & 1) * ST_BYTES, g1, tl); gdn_issue(p, g1, b, h, dir, min(s + 5, NS - 1), tl);
            GDN_SYNC_L();
            gdn_flush(p, lds, b, h, dir, s, tl);
            gdn_write(lds + ((s + 2) & 1) * ST_BYTES, g2, tl); gdn_issue(p, g2, b, h, dir, min(s + 6, NS - 1), tl);
            GDN_SYNC_L();
            gdn_flush(p, lds, b, h, dir, s + 1, tl);
            gdn_write(lds + ((s + 3) & 1) * ST_BYTES, g3, tl); gdn_issue(p, g3, b, h, dir, min(s + 7, NS - 1), tl);
            GDN_SYNC_L();
            gdn_flush(p, lds, b, h, dir, s + 2, tl);
            gdn_write(lds + ((s + 4) & 1) * ST_BYTES, g0, tl); gdn_issue(p, g0, b, h, dir, min(s + 8, NS - 1), tl);
            GDN_SYNC_L();
        }
        gdn_flush(p, lds, b, h, dir, NS - 1, tl);
    } else {
        const int r = lane & 31, hh = lane >> 5, w = wave;
        f32x16_t S0, S1, S2, S3;
#pragma unroll
        for (int i = 0; i < 16; ++i) { S0[i] = 0.f; S1[i] = 0.f; S2[i] = 0.f; S3[i] = 0.f; }
        const int troff = (4 * hh + ((lane & 15) >> 2)) * 320 + (16 * ((lane >> 4) & 1) + 4 * (lane & 3)) * 2;
        __syncthreads();
#pragma unroll 1
        for (int s = 0; s < NS; ++s) {
            LASP unsigned char* st = lds + (s & 1) * ST_BYTES;
            const LASP unsigned char* ka = st + ST_KA + r * 272 + hh * 16;
            const LASP unsigned char* qa = st + ST_QA + r * 272 + hh * 16;
            const bf16x8_t kA0 = *(const LASP bf16x8_t*)(ka), kA1 = *(const LASP bf16x8_t*)(ka + 32), kA2 = *(const LASP bf16x8_t*)(ka + 64), kA3 = *(const LASP bf16x8_t*)(ka + 96);
            const bf16x8_t kA4 = *(const LASP bf16x8_t*)(ka + 128), kA5 = *(const LASP bf16x8_t*)(ka + 160), kA6 = *(const LASP bf16x8_t*)(ka + 192), kA7 = *(const LASP bf16x8_t*)(ka + 224);
            const bf16x8_t qA0 = *(const LASP bf16x8_t*)(qa), qA1 = *(const LASP bf16x8_t*)(qa + 32), qA2 = *(const LASP bf16x8_t*)(qa + 64), qA3 = *(const LASP bf16x8_t*)(qa + 96);
            const bf16x8_t qA4 = *(const LASP bf16x8_t*)(qa + 128), qA5 = *(const LASP bf16x8_t*)(qa + 160), qA6 = *(const LASP bf16x8_t*)(qa + 192), qA7 = *(const LASP bf16x8_t*)(qa + 224);
            const LASP unsigned char* vbase = st + ST_V + troff + 64 * w;
            const bf16x8_t vB0 = TRFRAG(vbase), vB1 = TRFRAG(vbase + 16 * 320);
            const LASP unsigned char* tp = st + ST_TP + r * 80 + hh * 16;
            const bf16x8_t T0 = *(const LASP bf16x8_t*)(tp), T1 = *(const LASP bf16x8_t*)(tp + 32);
            const LASP unsigned char* qk = st + ST_QK + r * 80 + hh * 16;
            const bf16x8_t Q0 = *(const LASP bf16x8_t*)(qk), Q1 = *(const LASP bf16x8_t*)(qk + 32);
            const LASP float* sc = (const LASP float*)(st + ST_GL);
            const f32x4_t e0 = *(const LASP f32x4_t*)(sc + 4 * hh), e1 = *(const LASP f32x4_t*)(sc + 8 + 4 * hh), e2 = *(const LASP f32x4_t*)(sc + 16 + 4 * hh), e3 = *(const LASP f32x4_t*)(sc + 24 + 4 * hh);
            const f32x4_t f0 = *(const LASP f32x4_t*)(sc + 32 + 4 * hh), f1 = *(const LASP f32x4_t*)(sc + 40 + 4 * hh), f2 = *(const LASP f32x4_t*)(sc + 48 + 4 * hh), f3 = *(const LASP f32x4_t*)(sc + 56 + 4 * hh);
            const float gl = sc[64];
            __builtin_amdgcn_sched_barrier(0);
            f32x16_t ak, aq, vn;
#pragma unroll
            for (int i = 0; i < 16; ++i) { ak[i] = 0.f; aq[i] = 0.f; vn[i] = 0.f; }
            vn = MFMA32(T0, vB0, vn); vn = MFMA32(T1, vB1, vn);
#define GDN_KQ(KA, QA, SX, u) { const bf16x8_t SB = PACK8(SX, u); ak = MFMA32(KA, SB, ak); aq = MFMA32(QA, SB, aq); }
            GDN_KQ(kA0, qA0, S0, 0) GDN_KQ(kA1, qA1, S0, 1) GDN_KQ(kA2, qA2, S1, 0) GDN_KQ(kA3, qA3, S1, 1)
            GDN_KQ(kA4, qA4, S2, 0) GDN_KQ(kA5, qA5, S2, 1) GDN_KQ(kA6, qA6, S3, 0) GDN_KQ(kA7, qA7, S3, 1)
#undef GDN_KQ
            __builtin_amdgcn_sched_barrier(0);
            const LASP unsigned char* kn = st + ST_KN + troff;
            const bf16x8_t N00 = TRFRAG(kn), N01 = TRFRAG(kn + 16 * 320), N10 = TRFRAG(kn + 64), N11 = TRFRAG(kn + 64 + 16 * 320);
            const bf16x8_t N20 = TRFRAG(kn + 128), N21 = TRFRAG(kn + 128 + 16 * 320), N30 = TRFRAG(kn + 192), N31 = TRFRAG(kn + 192 + 16 * 320);
            __builtin_amdgcn_sched_barrier(0);
#define ROWSCALE(X, sgn) { X[0] *= sgn e0.x; X[1] *= sgn e0.y; X[2] *= sgn e0.z; X[3] *= sgn e0.w; X[4] *= sgn e1.x; X[5] *= sgn e1.y; X[6] *= sgn e1.z; X[7] *= sgn e1.w; \
                           X[8] *= sgn e2.x; X[9] *= sgn e2.y; X[10] *= sgn e2.z; X[11] *= sgn e2.w; X[12] *= sgn e3.x; X[13] *= sgn e3.y; X[14] *= sgn e3.z; X[15] *= sgn e3.w; }
            ROWSCALE(ak, -) ROWSCALE(aq, +)
#undef ROWSCALE
            const bf16x8_t ab0 = PACK8(ak, 0), ab1 = PACK8(ak, 1);
            vn = MFMA32(T0, ab0, vn); vn = MFMA32(T1, ab1, vn);
            S0 = S0 * gl; S1 = S1 * gl; S2 = S2 * gl; S3 = S3 * gl;
            const bf16x8_t vb0 = PACK8(vn, 0), vb1 = PACK8(vn, 1);
            f32x16_t vf;
            vf[0] = vn[0] * f0.x; vf[1] = vn[1] * f0.y; vf[2] = vn[2] * f0.z; vf[3] = vn[3] * f0.w; vf[4] = vn[4] * f1.x; vf[5] = vn[5] * f1.y; vf[6] = vn[6] * f1.z; vf[7] = vn[7] * f1.w;
            vf[8] = vn[8] * f2.x; vf[9] = vn[9] * f2.y; vf[10] = vn[10] * f2.z; vf[11] = vn[11] * f2.w; vf[12] = vn[12] * f3.x; vf[13] = vn[13] * f3.y; vf[14] = vn[14] * f3.z; vf[15] = vn[15] * f3.w;
            const bf16x8_t fb0 = PACK8(vf, 0), fb1 = PACK8(vf, 1);
            S0 = MFMA32(N00, fb0, S0); S1 = MFMA32(N10, fb0, S1); S2 = MFMA32(N20, fb0, S2); S3 = MFMA32(N30, fb0, S3);
            S0 = MFMA32(N01, fb1, S0); S1 = MFMA32(N11, fb1, S1); S2 = MFMA32(N21, fb1, S2); S3 = MFMA32(N31, fb1, S3);
            aq = MFMA32(Q0, vb0, aq); aq = MFMA32(Q1, vb1, aq);
            {
                LASP unsigned short* ost = (LASP unsigned short*)(lds + GDN_OST + (s & 1) * GDN_OST_BYTES) + 32 * w + r;
#pragma unroll
                for (int i = 0; i < 16; i += 2) { const unsigned pk = cvtpk(aq[i], aq[i + 1]); ost[crow(i, hh) * 136] = (unsigned short)pk; ost[(crow(i, hh) + 1) * 136] = (unsigned short)(pk >> 16); }
            }
            GDN_SYNC_C();
        }
    }
}

constexpr int GL_ITEM = 6272;
constexpr size_t GLA_PREP_OFF = (size_t)BATCH * 4 * 2 * NCH * GP_ITEM;

__device__ __forceinline__ void gla_prep_item(const P& p, LASP unsigned char* wl, const LASP float* cstab, int l, int it, int lane) {
    const int r = lane & 31, hh = lane >> 5;
    const int c = it % NCH, bh = it / NCH, h = bh & 3, b = bh >> 2;
    const size_t row0 = (size_t)b * TOK + (size_t)c * GCH;
    float qv[16], kv[16];
    {
        const bf16* qb = p.rest + (row0 + 4 * hh) * NREST + RC_CQ + h * 32 + r;
#pragma unroll
        for (int i = 0; i < 16; ++i) { const int no = (i & 3) + 8 * (i >> 2); qv[i] = bf2f(qb[(size_t)no * NREST]); kv[i] = bf2f(qb[(size_t)no * NREST + 128]); }
    }
    if (c >= 8) {
        const int dd = r & 15, f = dd & 7;
        const int prow = (c - 8) >> 1, pcol0 = 32 * ((c - 8) & 1);
#pragma unroll
        for (int i = 0; i < 16; ++i) {
            const int n = crow(i, hh);
            const int pos = r < 16 ? prow : pcol0 + n;
            const float cs = cstab[(pos * 8 + f) * 2], sn = cstab[(pos * 8 + f) * 2 + 1];
            const float qp = __shfl_xor(qv[i], 8), kp = __shfl_xor(kv[i], 8);
            if (dd < 8) { qv[i] = qv[i] * cs - qp * sn; kv[i] = kv[i] * cs - kp * sn; }
            else { qv[i] = qp * sn + qv[i] * cs; kv[i] = kp * sn + kv[i] * cs; }
        }
    }
#pragma unroll
    for (int i = 0; i < 16; ++i) qv[i] *= 0.17677669529663687f;
#pragma unroll 1
    for (int dir = 0; dir < 2; ++dir) {
        f32x16_t X;
#pragma unroll
        for (int i = 0; i < 16; ++i) X[i] = 0.f;
        {
            const bf16x8_t A = *(const bf16x8_t*)(p.rest + (row0 + r) * NREST + RC_CR + dir * 16 + 8 * hh);
            const float* w2p = p.gla_w2 + ((size_t)(l * 2 + dir) * 16 + 8 * hh) * 128 + h * 32 + r;
            const bf16x8_t Bf = __builtin_bit_cast(bf16x8_t, (u32x4_t){cvtpk(w2p[0], w2p[128]), cvtpk(w2p[256], w2p[384]), cvtpk(w2p[512], w2p[640]), cvtpk(w2p[768], w2p[896])});
            X = MFMA32(A, Bf, X);
        }
        const float b2v = p.gla_b2[(l * 2 + dir) * 128 + h * 32 + r];
        float Bc[16];
#pragma unroll
        for (int i = 0; i < 16; ++i) { const float xg = X[i] + b2v; Bc[i] = (fminf(xg, 0.f) - 0.6931471805599453f * __builtin_amdgcn_logf(1.f + __builtin_amdgcn_exp2f(-1.4426950408889634f * fabsf(xg)))) * (1.f / 16.f); }
        float tot;
        {
            float sg[4], ps[4];
#pragma unroll
            for (int g = 0; g < 4; ++g) { sg[g] = (Bc[4 * g] + Bc[4 * g + 1]) + (Bc[4 * g + 2] + Bc[4 * g + 3]); ps[g] = __shfl_xor(sg[g], 32); }
            tot = ((sg[0] + ps[0]) + (sg[1] + ps[1])) + ((sg[2] + ps[2]) + (sg[3] + ps[3]));
            if (dir == 0) {
                float base = 0.f;
#pragma unroll
                for (int g = 0; g < 4; ++g) {
                    float o = base + (hh ? ps[g] : 0.f);
#pragma unroll
                    for (int k = 0; k < 4; ++k) { o += Bc[4 * g + k]; Bc[4 * g + k] = o; }
                    base += sg[g] + ps[g];
                }
            } else {
                float base = 0.f;
#pragma unroll
                for (int g = 3; g >= 0; --g) {
                    float o = base + (hh ? 0.f : ps[g]);
#pragma unroll
                    for (int k = 3; k >= 0; --k) { o += Bc[4 * g + k]; Bc[4 * g + k] = o; }
                    base += sg[g] + ps[g];
                }
            }
        }
        unsigned char* gout = (unsigned char*)p.raw + GLA_PREP_OFF + ((size_t)(bh * 2 + dir) * NCH + c) * GL_ITEM;
        LASP bf16* ql = (LASP bf16*)wl;
        LASP bf16* kl = ql + 32 * 40;
        {
            bf16* qpo = (bf16*)gout + perm16(r);
            bf16* kdo = (bf16*)(gout + 4096) + r * 32;
#pragma unroll
            for (int g = 0; g < 4; ++g) {
                float kd[4];
#pragma unroll
                for (int k = 0; k < 4; ++k) {
                    const int i = 4 * g + k, n = crow(i, hh);
                    const float eb = __builtin_amdgcn_exp2f(1.4426950408889634f * Bc[i]);
                    const float qs = qv[i] * eb, ks = kv[i] * __builtin_amdgcn_rcpf(eb);
                    kd[k] = kv[i] * __builtin_amdgcn_exp2f(1.4426950408889634f * (tot - Bc[i]));
                    const bf16 qsb = f2bf(qs);
                    qpo[n * 32] = qsb;
                    ql[n * 40 + r] = qsb; kl[n * 40 + r] = f2bf(ks);
                }
                *(u32x2_t*)(kdo + perm16(8 * g + 4 * hh)) = (u32x2_t){cvtpk(kd[0], kd[1]), cvtpk(kd[2], kd[3])};
            }
            if (hh == 0) ((float*)(gout + 6144))[r] = __builtin_amdgcn_exp2f(1.4426950408889634f * tot);
        }
        asm volatile("s_waitcnt lgkmcnt(0)" ::: "memory");
        f32x16_t AT;
#pragma unroll
        for (int i = 0; i < 16; ++i) AT[i] = 0.f;
        AT = MFMA32(*(const LASP bf16x8_t*)((const LASP unsigned char*)kl + r * 80 + hh * 16), *(const LASP bf16x8_t*)((const LASP unsigned char*)ql + r * 80 + hh * 16), AT);
        AT = MFMA32(*(const LASP bf16x8_t*)((const LASP unsigned char*)kl + r * 80 + hh * 16 + 32), *(const LASP bf16x8_t*)((const LASP unsigned char*)ql + r * 80 + hh * 16 + 32), AT);
        {
            bf16* amo = (bf16*)(gout + 2048) + r * 32;
#pragma unroll
            for (int g = 0; g < 4; ++g) {
                float a[4];
#pragma unroll
                for (int k = 0; k < 4; ++k) { const int m = crow(4 * g + k, hh); const bool keep = dir == 0 ? (m <= r) : (m >= r); a[k] = keep ? AT[4 * g + k] : 0.f; }
                *(u32x2_t*)(amo + perm16(8 * g + 4 * hh)) = (u32x2_t){cvtpk(a[0], a[1]), cvtpk(a[2], a[3])};
            }
        }
        asm volatile("s_waitcnt lgkmcnt(0)" ::: "memory");
    }
}

constexpr int LS_QP = 0, LS_AM = 2560, LS_KD = 5120, LS_V = 7680, LS_GL = 13824, LS_BYTES = 13952;
constexpr int GLA_OST = 4 * LS_BYTES, GLA_OST_BYTES = 32 * 144;
struct LSlot { u32x4_t a0, a1, a2, v0, v1; f32x4_t gl; };
__device__ __forceinline__ void gla_issue(const P& p, LSlot& g, int b, int h, int dir, int step, int t2) {
    const int c = gdn_chunk(dir, step);
    const unsigned char* gp = (const unsigned char*)p.raw + GLA_PREP_OFF + ((size_t)((b * 4 + h) * 2 + dir) * NCH + c) * GL_ITEM;
    g.a0 = *(const u32x4_t*)(gp + t2 * 16); g.a1 = *(const u32x4_t*)(gp + 2048 + t2 * 16); g.a2 = *(const u32x4_t*)(gp + 4096 + t2 * 16);
    g.gl = *(const f32x4_t*)(gp + 6144 + (t2 < 8 ? t2 : 0) * 16);
    const size_t row0 = (size_t)b * TOK + (size_t)c * GCH;
    const bf16* vp = p.rest + (row0 + (t2 >> 3)) * NREST + RC_CV + h * 64 + 8 * (t2 & 7);
    g.v0 = *(const u32x4_t*)vp; g.v1 = *(const u32x4_t*)(vp + (size_t)16 * NREST);
}
__device__ __forceinline__ void gla_write(LASP unsigned char* st, const LSlot& g, int t2) {
    const int row = t2 >> 2, ch = t2 & 3;
    *(LASP u32x4_t*)(st + LS_QP + row * 80 + ch * 16) = g.a0;
    *(LASP u32x4_t*)(st + LS_AM + row * 80 + ch * 16) = g.a1;
    *(LASP u32x4_t*)(st + LS_KD + row * 80 + ch * 16) = g.a2;
    if (t2 < 8) *(LASP f32x4_t*)(st + LS_GL + t2 * 16) = g.gl;
    *(LASP u32x4_t*)(st + LS_V + (t2 >> 3) * 192 + (t2 & 7) * 16) = g.v0; *(LASP u32x4_t*)(st + LS_V + (16 + (t2 >> 3)) * 192 + (t2 & 7) * 16) = g.v1;
}
__device__ __forceinline__ void gla_flush(const P& p, LASP unsigned char* lds, int b, int h, int dir, int step, int t2) {
    const int c = gdn_chunk(dir, step);
    const LASP unsigned char* ost = lds + GLA_OST + (dir * 2 + (step & 1)) * GLA_OST_BYTES;
    bf16* op = p.oc + ((size_t)dir * ROWS + (size_t)b * TOK + (size_t)c * GCH) * 256 + h * 64;
#pragma unroll
    for (int k = 0; k < 2; ++k) { const int idx = t2 + 128 * k, row = idx >> 3, ch = idx & 7; *(u32x4_t*)(op + (size_t)row * 256 + ch * 8) = *(const LASP u32x4_t*)(ost + row * 144 + ch * 16); }
}
#if TPROBE == 62
#define GLA_SYNC_C() do { unsigned long long t_ = __builtin_amdgcn_s_memrealtime(); __syncthreads(); if (bh == 0 && tid == 0) p.stats[2] += (float)(__builtin_amdgcn_s_memrealtime() - t_) * 0.01f; } while (0)
#define GLA_SYNC_L() __syncthreads()
#elif TPROBE == 63
#define GLA_SYNC_L() do { unsigned long long t_ = __builtin_amdgcn_s_memrealtime(); __syncthreads(); if (bh == 0 && tid == 256) p.stats[2] += (float)(__builtin_amdgcn_s_memrealtime() - t_) * 0.01f; } while (0)
#define GLA_SYNC_C() __syncthreads()
#else
#define GLA_SYNC_C() __syncthreads()
#define GLA_SYNC_L() __syncthreads()
#endif
__device__ void gla_scan_fast(const P& p, LASP unsigned char* lds, int bh) {
    const int tid = mk_tid();
    const int lane = tid & 63, wave = __builtin_amdgcn_readfirstlane(tid >> 6);
    const int h = bh & 3, b = bh >> 2;
    constexpr int NS = NCH;
    if (wave >= 4) {
        const int dir = (wave - 4) >> 1, t2 = tid & 127;
        LASP unsigned char* base = lds + dir * 2 * LS_BYTES;
        LSlot g0, g1, g2, g3;
        gla_issue(p, g0, b, h, dir, 0, t2); gla_issue(p, g1, b, h, dir, 1, t2); gla_issue(p, g2, b, h, dir, 2, t2); gla_issue(p, g3, b, h, dir, 3, t2);
        gla_write(base, g0, t2); gla_issue(p, g0, b, h, dir, 4, t2);
        __syncthreads();
#pragma unroll 1
        for (int s = 0; s < NS; s += 4) {
            if (s > 0) gla_flush(p, lds, b, h, dir, s - 1, t2);
            gla_write(base + ((s + 1) & 1) * LS_BYTES, g1, t2); gla_issue(p, g1, b, h, dir, min(s + 5, NS - 1), t2);
            GLA_SYNC_L();
            gla_flush(p, lds, b, h, dir, s, t2);
            gla_write(base + ((s + 2) & 1) * LS_BYTES, g2, t2); gla_issue(p, g2, b, h, dir, min(s + 6, NS - 1), t2);
            GLA_SYNC_L();
            gla_flush(p, lds, b, h, dir, s + 1, t2);
            gla_write(base + ((s + 3) & 1) * LS_BYTES, g3, t2); gla_issue(p, g3, b, h, dir, min(s + 7, NS - 1), t2);
            GLA_SYNC_L();
            gla_flush(p, lds, b, h, dir, s + 2, t2);
            gla_write(base + ((s + 4) & 1) * LS_BYTES, g0, t2); gla_issue(p, g0, b, h, dir, min(s + 8, NS - 1), t2);
            GLA_SYNC_L();
        }
        gla_flush(p, lds, b, h, dir, NS - 1, t2);
    } else {
        const int r = lane & 31, hh = lane >> 5, dir = wave >> 1, blk = wave & 1;
        LASP unsigned char* base = lds + dir * 2 * LS_BYTES;
        f32x16_t S;
#pragma unroll
        for (int i = 0; i < 16; ++i) S[i] = 0.f;
        __syncthreads();
        const int troff = (4 * hh + ((lane & 15) >> 2)) * 192 + (16 * ((lane >> 4) & 1) + 4 * (lane & 3)) * 2 + 64 * blk;
#define TRFRAG192(bs) __builtin_shufflevector(trd(bs), trd((bs) + 8 * 192), 0, 1, 2, 3, 4, 5, 6, 7)
#pragma unroll 1
        for (int s = 0; s < NS; ++s) {
            const LASP unsigned char* st = base + (s & 1) * LS_BYTES;
#if TPROBE == 64 || TPROBE == 65
            const unsigned long long ttop_ = __builtin_amdgcn_s_memrealtime();
            __builtin_amdgcn_sched_barrier(0);
#endif
            const LASP unsigned char* qp = st + LS_QP + r * 80 + hh * 16;
            const LASP unsigned char* am = st + LS_AM + r * 80 + hh * 16;
            const LASP unsigned char* kd = st + LS_KD + r * 80 + hh * 16;
            const bf16x8_t QP0 = *(const LASP bf16x8_t*)(qp), QP1 = *(const LASP bf16x8_t*)(qp + 32);
            const bf16x8_t AM0 = *(const LASP bf16x8_t*)(am), AM1 = *(const LASP bf16x8_t*)(am + 32);
            const bf16x8_t KD0 = *(const LASP bf16x8_t*)(kd), KD1 = *(const LASP bf16x8_t*)(kd + 32);
            const LASP unsigned char* vb = st + LS_V + troff;
            const bf16x8_t V0 = TRFRAG192(vb), V1 = TRFRAG192(vb + 16 * 192);
            const LASP float* glp = (const LASP float*)(st + LS_GL);
            const f32x4_t g0 = *(const LASP f32x4_t*)(glp + 4 * hh), g1 = *(const LASP f32x4_t*)(glp + 8 + 4 * hh), g2 = *(const LASP f32x4_t*)(glp + 16 + 4 * hh), g3 = *(const LASP f32x4_t*)(glp + 24 + 4 * hh);
            __builtin_amdgcn_sched_barrier(0);
#if TPROBE == 64 || TPROBE == 65
            asm volatile("s_waitcnt lgkmcnt(0)" ::: "memory");
            const unsigned long long tmid_ = __builtin_amdgcn_s_memrealtime();
            if (TPROBE == 64 && bh == 0 && tid == 0) p.stats[2] += (float)(tmid_ - ttop_) * 0.01f;
            __builtin_amdgcn_sched_barrier(0);
#endif
            const bf16x8_t Sb0 = PACK8(S, 0), Sb1 = PACK8(S, 1);
            f32x16_t oT;
#pragma unroll
            for (int i = 0; i < 16; ++i) oT[i] = 0.f;
            oT = MFMA32(V0, AM0, oT); oT = MFMA32(V1, AM1, oT);
            oT = MFMA32(Sb0, QP0, oT); oT = MFMA32(Sb1, QP1, oT);
            S[0] *= g0.x; S[1] *= g0.y; S[2] *= g0.z; S[3] *= g0.w; S[4] *= g1.x; S[5] *= g1.y; S[6] *= g1.z; S[7] *= g1.w;
            S[8] *= g2.x; S[9] *= g2.y; S[10] *= g2.z; S[11] *= g2.w; S[12] *= g3.x; S[13] *= g3.y; S[14] *= g3.z; S[15] *= g3.w;
            S = MFMA32(KD0, V0, S);
            S = MFMA32(KD1, V1, S);
            {
                LASP unsigned char* ost = lds + GLA_OST + (dir * 2 + (s & 1)) * GLA_OST_BYTES + r * 144 + (32 * blk + 4 * hh) * 2;
#pragma unroll
                for (int g = 0; g < 4; ++g) *(LASP u32x2_t*)(ost + 16 * g) = (u32x2_t){cvtpk(oT[4 * g], oT[4 * g + 1]), cvtpk(oT[4 * g + 2], oT[4 * g + 3])};
            }
#if TPROBE == 65
            __builtin_amdgcn_sched_barrier(0);
            asm volatile("s_nop 15\n\ts_nop 15" ::: "memory");
            if (bh == 0 && tid == 0) p.stats[2] += (float)(__builtin_amdgcn_s_memrealtime() - tmid_) * 0.01f;
#endif
            GLA_SYNC_C();
        }
    }
}


__device__ __forceinline__ void vf_item(const P& p, LASP unsigned char* wl, int it, int lane) {
    const int r = lane & 31, hh = lane >> 5;
    const int kb = it % NCH, bh = it / NCH, h = bh & 3, b = bh >> 2;
    const bf16* vp = p.rest + ((size_t)b * TOK + 32 * kb + r) * NREST + RC_BV + h * 64 + 32 * hh;
#pragma unroll
    for (int q = 0; q < 4; ++q) *(LASP u32x4_t*)(wl + r * 192 + (32 * hh + 8 * q) * 2) = *(const u32x4_t*)(vp + 8 * q);
    asm volatile("s_waitcnt lgkmcnt(0)" ::: "memory");
    const int troff = (4 * hh + ((lane & 15) >> 2)) * 192 + (16 * ((lane >> 4) & 1) + 4 * (lane & 3)) * 2;
    bf16* op = p.vf + ((size_t)(bh * NCH + kb) * 4) * 512 + lane * 8;
#pragma unroll
    for (int dvb = 0; dvb < 2; ++dvb)
#pragma unroll
        for (int u = 0; u < 2; ++u) {
            const LASP unsigned char* bs = wl + troff + 64 * dvb + (16 * u) * 192;
            const bf16x8_t f = __builtin_shufflevector(trd(bs), trd(bs + 8 * 192), 0, 1, 2, 3, 4, 5, 6, 7);
            *(bf16x8_t*)(op + (dvb * 2 + u) * 512) = f;
        }
    asm volatile("s_waitcnt lgkmcnt(0)" ::: "memory");
}

__device__ __forceinline__ void na_item(const P& p, const LASP float* rpbL, int it, int lane) {
    const int r = lane & 31, hh = lane >> 5;
    int b, h, ry, qb; bool lat;
    if (it < 4096) { lat = true; qb = it & 1; ry = (it >> 1) & 63; h = (it >> 7) & 3; b = it >> 9; }
    else { const int j = it - 4096; lat = false; qb = j & 7; h = (j >> 3) & 3; b = j >> 5; ry = 0; }
    const size_t brow = (size_t)b * TOK;
    const int q0 = lat ? CTX + ry * 64 + qb * 32 : qb * 32;
    bf16* qp = p.rest + (brow + q0 + r) * NREST + RC_BQ + h * 64;
    bf16x8_t Qf0 = *(const bf16x8_t*)(qp + 8 * hh), Qf1 = *(const bf16x8_t*)(qp + 16 + 8 * hh), Qf2 = *(const bf16x8_t*)(qp + 32 + 8 * hh), Qf3 = *(const bf16x8_t*)(qp + 48 + 8 * hh);
    f32x16_t O0, O1;
#pragma unroll
    for (int i = 0; i < 16; ++i) { O0[i] = 0.f; O1[i] = 0.f; }
    float m = -1e30f, lsum = 0.f;
    const bf16* kfb = p.kf + ((size_t)(b * 4 + h) * NCH) * 2048 + lane * 8;
    const bf16* vfb = p.vf + ((size_t)(b * 4 + h) * NCH) * 2048 + lane * 8;
    const int nkb = lat ? 24 : 8;
    const int c = qb * 32 + r, c0 = min(max(c - 8, 0), 48), r0 = min(max(ry - 4, 0), 56);
    constexpr float SC = 0.125f * 1.4426950408889634f;
    struct KV { bf16x8_t k0, k1, k2, k3, v00, v01, v10, v11; };
    KV fA, fB;
#define NA_KBIDX(kq) ((kq) < 8 ? (kq) : 8 + (r0 + (((kq) - 8) >> 1)) * 2 + (((kq) - 8) & 1))
#define NA_LOAD(F, kq) { const size_t o_ = (size_t)NA_KBIDX(min((kq), nkb - 1)) * 2048; const bf16* kp = kfb + o_; const bf16* vp = vfb + o_; \
        F.k0 = *(const bf16x8_t*)(kp); F.k1 = *(const bf16x8_t*)(kp + 512); F.k2 = *(const bf16x8_t*)(kp + 1024); F.k3 = *(const bf16x8_t*)(kp + 1536); \
        F.v00 = *(const bf16x8_t*)(vp); F.v01 = *(const bf16x8_t*)(vp + 512); F.v10 = *(const bf16x8_t*)(vp + 1024); F.v11 = *(const bf16x8_t*)(vp + 1536); }
    NA_LOAD(fA, 0) NA_LOAD(fB, 1)
#define NA_BLOCK(F, kq) { \
        const int kb_ = (kq); int ky = 0, cb = 0; const bool win = kb_ >= 8; \
        if (win) { const int w_ = kb_ - 8; ky = r0 + (w_ >> 1); cb = w_ & 1; } \
        f32x16_t S; _Pragma("unroll") for (int i = 0; i < 16; ++i) S[i] = 0.f; \
        S = MFMA32(F.k0, Qf0, S); S = MFMA32(F.k1, Qf1, S); S = MFMA32(F.k2, Qf2, S); S = MFMA32(F.k3, Qf3, S); \
        const bf16x8_t V00 = F.v00, V01 = F.v01, V10 = F.v10, V11 = F.v11; \
        NA_LOAD(F, kb_ + 2) \
        float bm = -1e30f; \
        if (win) { \
            const LASP float* rb = rpbL + (h * 15 + (ky - ry + 7)) * 31 + 15 - c; \
            _Pragma("unroll") for (int i = 0; i < 16; ++i) { \
                const int kc = cb * 32 + crow(i, hh); \
                const bool valid = (kc >= c0) && (kc < c0 + 16); \
                const float bias = rb[valid ? kc : c]; \
                S[i] = valid ? S[i] * SC + bias : -1e30f; \
                bm = fmaxf(bm, S[i]); } \
        } else { _Pragma("unroll") for (int i = 0; i < 16; ++i) { S[i] *= SC; bm = fmaxf(bm, S[i]); } } \
        bm = fmaxf(bm, __shfl_xor(bm, 32)); \
        const float mn = fmaxf(m, bm); \
        const float alpha = __builtin_amdgcn_exp2f(m - mn); \
        m = mn; \
        float ps = 0.f; \
        _Pragma("unroll") for (int i = 0; i < 16; ++i) { S[i] = __builtin_amdgcn_exp2f(S[i] - mn); ps += S[i]; } \
        lsum = lsum * alpha + ps; \
        _Pragma("unroll") for (int i = 0; i < 16; ++i) { O0[i] *= alpha; O1[i] *= alpha; } \
        const bf16x8_t Pb0 = PACK8(S, 0), Pb1 = PACK8(S, 1); \
        O0 = MFMA32(V00, Pb0, O0); O0 = MFMA32(V01, Pb1, O0); \
        O1 = MFMA32(V10, Pb0, O1); O1 = MFMA32(V11, Pb1, O1); }
#pragma unroll 1
    for (int kb = 0; kb < nkb; kb += 2) { NA_BLOCK(fA, kb) NA_BLOCK(fB, kb + 1) }
#undef NA_BLOCK
#undef NA_LOAD
#undef NA_KBIDX
    const float inv = 1.f / (lsum + __shfl_xor(lsum, 32));
    bf16* op = qp + 4 * hh;
#pragma unroll
    for (int g = 0; g < 4; ++g) {
        *(u32x2_t*)(op + 8 * g) = (u32x2_t){cvtpk(O0[4 * g] * inv, O0[4 * g + 1] * inv), cvtpk(O0[4 * g + 2] * inv, O0[4 * g + 3] * inv)};
        *(u32x2_t*)(op + 32 + 8 * g) = (u32x2_t){cvtpk(O1[4 * g] * inv, O1[4 * g + 1] * inv), cvtpk(O1[4 * g + 2] * inv, O1[4 * g + 3] * inv)};
    }
}

__device__ void ph_prep_early(const P& p, LASP unsigned char* lds, int l, int bid, int nblk) {
    const int tid = mk_tid();
    const int lane = tid & 63, wave = tid >> 6;
    for (int it = bid * NWAVES + wave; it < BATCH * 4 * NCH; it += nblk * NWAVES) vf_item(p, lds + wave * 16384, it, lane);
}
__device__ void ph_prep(const P& p, LASP unsigned char* lds, int l, int bid, int nblk) {
    const int tid = mk_tid();
    LASP float* cstab = (LASP float*)(lds + 131072);
    {
        const int pos = tid >> 3, f = tid & 7;
        const float ang = (float)pos * powf(10000.f, -(float)f / 8.f);
        cstab[tid * 2] = cosf(ang); cstab[tid * 2 + 1] = sinf(ang);
    }
    __syncthreads();
    ph_gdnprep(p, lds, l, bid, nblk, tid);
    const int lane = tid & 63, wave = tid >> 6;
    for (int it = (nblk - 1 - bid) * NWAVES + wave; it < BATCH * 4 * NCH; it += nblk * NWAVES) gla_prep_item(p, lds + wave * 16384, cstab, l, it, lane);
}

__device__ void ph_mix(const P& p, LASP unsigned char* lds, int l, int bid, int nblk) {
    constexpr int NGDN = BATCH * 4 * 2;
    constexpr int NGLA = BATCH * 4;
    if (bid < NGDN) { gdn_scan_fast(p, lds, bid); return; }
    if (bid < NGDN + NGLA) { gla_scan_fast(p, lds, bid - NGDN); return; }
    const int tid = mk_tid();
    const int lane = tid & 63, wave = tid >> 6;
    LASP float* rpbL = (LASP float*)lds;
    for (int i = tid; i < 4 * 15 * 31; i += NTHREADS) rpbL[i] = p.rpb[(size_t)l * 4 * 15 * 31 + i] * 1.4426950408889634f;
    __syncthreads();
    const int total = 4096 + (l == 0 ? 256 : 0);
    for (int it = (bid - NGDN - NGLA) * NWAVES + wave; it < total; it += (nblk - NGDN - NGLA) * NWAVES) na_item(p, rpbL, it, lane);
}

__device__ void ph_gate(const P& p, int l, int bid, int nblk) {
    const int tid = mk_tid();
    const int tq = tid & 127, rsub = tid >> 7;
    const int kind = tq < 64 ? 0 : (tq < 96 ? 1 : 2);
    const int cb = kind == 0 ? tq * 8 : (kind == 1 ? (tq - 64) * 8 : (tq - 96) * 8);
    const int zoff = kind == 0 ? RC_AZ + cb : (kind == 1 ? RC_BZ + cb : RC_CZ + cb);
    const int oc = kind == 0 ? cb : (kind == 1 ? 512 + cb : 768 + cb);
    float nw[8];
#pragma unroll
    for (int e = 0; e < 8; ++e) nw[e] = kind == 0 ? p.gdn_norm[l * 128 + ((cb + e) & 127)] : (kind == 2 ? p.gla_norm[l * 64 + ((cb + e) & 63)] : 1.f);
    for (int r0 = bid * 16; r0 < ROWS; r0 += nblk * 16) {
        uint4 a[4], bb[4], zz[4];
#pragma unroll
        for (int j = 0; j < 4; ++j) {
            const size_t r = (size_t)(r0 + rsub + 4 * j);
            const bf16* pr = p.rest + r * NREST;
            zz[j] = *(const uint4*)(pr + zoff);
            if (kind == 0) { a[j] = *(const uint4*)(p.oa + r * 512 + cb); bb[j] = *(const uint4*)(p.oa + ((size_t)ROWS + r) * 512 + cb); }
            else if (kind == 1) { a[j] = *(const uint4*)(pr + RC_BQ + cb); bb[j] = make_uint4(0, 0, 0, 0); }
            else { a[j] = *(const uint4*)(p.oc + r * 256 + cb); bb[j] = *(const uint4*)(p.oc + ((size_t)ROWS + r) * 256 + cb); }
        }
#pragma unroll
        for (int j = 0; j < 4; ++j) {
            float fa[8], fb[8], z[8], o[8];
            unpack8(a[j], fa); unpack8(bb[j], fb); unpack8(zz[j], z);
            float ss = 0.f;
#pragma unroll
            for (int e = 0; e < 8; ++e) { o[e] = fa[e] + fb[e]; ss += o[e] * o[e]; }
            float rs = 1.f;
            if (kind == 0) {
#pragma unroll
                for (int m = 8; m > 0; m >>= 1) ss += __shfl_xor(ss, m);
                rs = __builtin_amdgcn_rsqf(ss * (1.f / 128.f) + 1e-6f);
            } else if (kind == 2) {
#pragma unroll
                for (int m = 4; m > 0; m >>= 1) ss += __shfl_xor(ss, m);
                rs = __builtin_amdgcn_rsqf(ss * (1.f / 64.f) + 1e-6f);
            }
            float res[8];
#pragma unroll
            for (int e = 0; e < 8; ++e) res[e] = o[e] * rs * nw[e] * silu_f(z[e]);
            uint4 w; w.x = pk2(res[0], res[1]); w.y = pk2(res[2], res[3]); w.z = pk2(res[4], res[5]); w.w = pk2(res[6], res[7]);
            *(uint4*)(p.mix + (size_t)(r0 + rsub + 4 * j) * D + oc) = w;
        }
    }
}

#if PROBE
__device__ void gdn_scan_naive(const P& p, LASP float* sm, int l, int b, int hp, bf16* nb) {
    const int tid = mk_tid();
    LASP float* skq = sm;
    LASP float* sv = sm + 4 * 16 * 256;
    LASP float* sg = sv + 4 * 16 * 128;
    LASP float* sb = sg + 64;
    const int sub = tid >> 7, col = tid & 127, dir = sub & 1, h = hp * 2 + (sub >> 1);
    float S[128];
#pragma unroll
    for (int i = 0; i < 128; ++i) S[i] = 0.f;
    for (int s0 = 0; s0 < TOK; s0 += 16) {
        __syncthreads();
        for (int i = tid; i < 4 * 16 * 48; i += NTHREADS) {
            const int su = i / (16 * 48), rem = i % (16 * 48), j = rem / 48, chunk = rem % 48;
            const int sd = su & 1, hh = hp * 2 + (su >> 1);
            const int t = tok_of(sd, s0 + j);
            const size_t row = (size_t)b * TOK + t;
            const int part = chunk >> 4, c8 = chunk & 15;
            const uint4 w = *(const uint4*)(p.qkvn + row * NRAW + part * 512 + hh * 128 + c8 * 8);
            float f[8]; unpack8(w, f);
            LASP float* dst = (part < 2) ? skq + (su * 16 + j) * 256 + part * 128 + c8 * 8 : sv + (su * 16 + j) * 128 + c8 * 8;
#pragma unroll
            for (int e = 0; e < 8; ++e) dst[e] = f[e];
        }
        if (tid < 64) {
            const int su = tid >> 4, j = tid & 15, sd = su & 1, hh = hp * 2 + (su >> 1);
            const int t = tok_of(sd, s0 + j);
            const bf16* ab = p.rest + ((size_t)b * TOK + t) * NREST + RC_AB;
            const float a = bf2f(ab[sd * 4 + hh]) + p.dt_bias[(l * 2 + sd) * 4 + hh];
            const float sp = fmaxf(a, 0.f) + log1pf(expf(-fabsf(a)));
            const float g = -expf(p.a_log[(l * 2 + sd) * 4 + hh]) * sp;
            sg[su * 16 + j] = expf(g);
            const float bx = bf2f(ab[(2 + sd) * 4 + hh]);
            sb[su * 16 + j] = 1.f / (1.f + expf(-bx));
        }
        __syncthreads();
#pragma unroll 1
        for (int j = 0; j < 16; ++j) {
            const LASP float* qp = skq + (sub * 16 + j) * 256;
            const LASP float* kp = qp + 128;
            const float dec = sg[sub * 16 + j], bt = sb[sub * 16 + j];
            const float v = sv[(sub * 16 + j) * 128 + col];
            float d0 = 0.f, d1 = 0.f, d2 = 0.f, d3 = 0.f;
#pragma unroll
            for (int k4 = 0; k4 < 32; ++k4) {
                const f32x4_t kv = *(const LASP f32x4_t*)(kp + k4 * 4);
                d0 += S[k4 * 4] * kv.x; d1 += S[k4 * 4 + 1] * kv.y; d2 += S[k4 * 4 + 2] * kv.z; d3 += S[k4 * 4 + 3] * kv.w;
                if ((k4 & 7) == 7) __builtin_amdgcn_sched_barrier(0);
            }
            const float dot = (d0 + d1) + (d2 + d3);
            const float vn = bt * (v - dec * dot);
            float o0 = 0.f, o1 = 0.f, o2 = 0.f, o3 = 0.f;
#pragma unroll
            for (int k4 = 0; k4 < 32; ++k4) {
                const f32x4_t kv = *(const LASP f32x4_t*)(kp + k4 * 4);
                const f32x4_t qv = *(const LASP f32x4_t*)(qp + k4 * 4);
                S[k4 * 4] = dec * S[k4 * 4] + kv.x * vn; o0 += S[k4 * 4] * qv.x;
                S[k4 * 4 + 1] = dec * S[k4 * 4 + 1] + kv.y * vn; o1 += S[k4 * 4 + 1] * qv.y;
                S[k4 * 4 + 2] = dec * S[k4 * 4 + 2] + kv.z * vn; o2 += S[k4 * 4 + 2] * qv.z;
                S[k4 * 4 + 3] = dec * S[k4 * 4 + 3] + kv.w * vn; o3 += S[k4 * 4 + 3] * qv.w;
                if ((k4 & 3) == 3) __builtin_amdgcn_sched_barrier(0);
            }
            const int t = tok_of(dir, s0 + j);
            nb[((size_t)dir * TOK + t) * 256 + (h & 1) * 128 + col] = f2bf((o0 + o1) + (o2 + o3));
        }
    }
    __syncthreads();
}

__device__ void gla_scan_naive(const P& p, LASP float* sm, int l, int b, bf16* nb) {
    const int tid = mk_tid();
    LASP float* sq = sm;
    LASP float* sv = sm + 8 * 16 * 96;
    const int grp = tid >> 6, lane = tid & 63, h = grp >> 1, dir = grp & 1;
    const int d = lane & 31, par = lane >> 5;
    float w2c[16];
#pragma unroll
    for (int j = 0; j < 16; ++j) w2c[j] = p.gla_w2[((size_t)(l * 2 + dir) * 16 + j) * 128 + h * 32 + d];
    const float b2v = p.gla_b2[(l * 2 + dir) * 128 + h * 32 + d];
    const int dd = d & 15, f = dd & 7;
    const float inv = powf(10000.f, -(float)f / 8.f);
    const int pd = dd < 8 ? d + 8 : d - 8;
    float S[32];
#pragma unroll
    for (int i = 0; i < 32; ++i) S[i] = 0.f;
    for (int s0 = 0; s0 < TOK; s0 += 16) {
        __syncthreads();
#pragma unroll 1
        for (int jj = 0; jj < 8; ++jj) {
            const int j = par + 2 * jj;
            const int t = tok_of(dir, s0 + j);
            const bf16* base = p.rest + ((size_t)b * TOK + t) * NREST;
            float qv = bf2f(base[RC_CQ + h * 32 + d]), kv = bf2f(base[RC_CK + h * 32 + d]);
            if (t >= CTX) {
                const int pidx = t - CTX;
                const int pos = d < 16 ? (pidx >> 6) : (pidx & 63);
                const float ang = (float)pos * inv;
                const float cs = cosf(ang), sn = sinf(ang);
                const float qp = bf2f(base[RC_CQ + h * 32 + pd]), kp = bf2f(base[RC_CK + h * 32 + pd]);
                if (dd < 8) { qv = qv * cs - qp * sn; kv = kv * cs - kp * sn; }
                else { qv = qp * sn + qv * cs; kv = kp * sn + kv * cs; }
            }
            qv *= 0.17677669529663687f;
            float xg = b2v;
#pragma unroll
            for (int jr = 0; jr < 16; ++jr) xg += bf2f(base[RC_CR + dir * 16 + jr]) * w2c[jr];
            const float ls = fminf(xg, 0.f) - log1pf(expf(-fabsf(xg)));
            LASP float* dst = sq + (grp * 16 + j) * 96;
            dst[d] = qv; dst[32 + d] = kv; dst[64 + d] = expf(ls * (1.f / 16.f));
        }
        for (int i = lane; i < 16 * 64; i += 64) {
            const int j = i >> 6, c = i & 63;
            const int t = tok_of(dir, s0 + j);
            sv[(grp * 16 + j) * 64 + c] = bf2f(p.rest[((size_t)b * TOK + t) * NREST + RC_CV + h * 64 + c]);
        }
        __syncthreads();
#pragma unroll 1
        for (int j = 0; j < 16; ++j) {
            const LASP float* qp = sq + (grp * 16 + j) * 96;
            const LASP float* kp = qp + 32;
            const LASP float* dp = qp + 64;
            const float v = sv[(grp * 16 + j) * 64 + lane];
            float o0 = 0.f, o1 = 0.f;
#pragma unroll
            for (int e = 0; e < 32; e += 2) {
                S[e] = dp[e] * S[e] + kp[e] * v; o0 += S[e] * qp[e];
                S[e + 1] = dp[e + 1] * S[e + 1] + kp[e + 1] * v; o1 += S[e + 1] * qp[e + 1];
            }
            const int t = tok_of(dir, s0 + j);
            nb[((size_t)dir * TOK + t) * 256 + h * 64 + lane] = f2bf(o0 + o1);
        }
    }
    __syncthreads();
}

__device__ void na_query_naive(const P& p, LASP float* sm, int l, int b, int t0, bf16* nb) {
    const int tid = mk_tid();
    const int wave = tid >> 6, lane = tid & 63, h = wave & 3, t = t0 + (wave >> 2);
    LASP float* pw = sm + wave * 384;
    const size_t rowq = (size_t)b * TOK + t;
    float qv[64];
    {
        const bf16* qs = p.rest + rowq * NREST + RC_BQ + h * 64;
#pragma unroll
        for (int i = 0; i < 8; ++i) {
            float f[8]; unpack8(*(const uint4*)(qs + i * 8), f);
#pragma unroll
            for (int e = 0; e < 8; ++e) qv[i * 8 + e] = f[e] * 0.125f;
        }
    }
    const bool lat = t >= CTX;
    const int nk = lat ? 384 : 256;
    int r = 0, c = 0, r0 = 0, c0 = 0;
    if (lat) { int pi = t - CTX; r = pi >> 6; c = pi & 63; r0 = min(max(r - 4, 0), 56); c0 = min(max(c - 8, 0), 48); }
    float m = -1e30f;
    __syncthreads();
#pragma unroll 1
    for (int j = 0; j < 6; ++j) {
        const int idx = lane + 64 * j;
        float s = -1e30f;
        if (idx < nk) {
            int tk; float bias = 0.f;
            if (lat && idx < 128) {
                const int i = idx >> 4, kc = c0 + (idx & 15);
                tk = CTX + (r0 + i) * 64 + kc;
                bias = p.rpb[((size_t)(l * 4 + h) * 15 + (r0 + i - r + 7)) * 31 + (kc - c + 15)];
            } else tk = lat ? idx - 128 : idx;
            const bf16* ks = p.kf + (((size_t)(b * 4 + h) * NCH + (tk >> 5)) * 4 * 64 + (tk & 31)) * 8;
            float d0 = 0.f, d1 = 0.f;
#pragma unroll
            for (int i = 0; i < 8; ++i) {
                float f[8]; unpack8(*(const uint4*)(ks + ((i >> 1) * 64 + (i & 1) * 32) * 8), f);
#pragma unroll
                for (int e = 0; e < 8; e += 2) { d0 += qv[i * 8 + e] * f[e]; d1 += qv[i * 8 + e + 1] * f[e + 1]; }
            }
            s = d0 + d1 + bias;
        }
        pw[idx] = s;
        m = fmaxf(m, s);
    }
    m = wave_max(m);
    float sum = 0.f;
#pragma unroll 1
    for (int j = 0; j < 6; ++j) { const float e = expf(pw[lane + 64 * j] - m); pw[lane + 64 * j] = e; sum += e; }
    sum = wave_sum(sum);
    const float inv = 1.f / sum;
    __syncthreads();
    float o0 = 0.f, o1 = 0.f;
    for (int idx = 0; idx < nk; idx += 2) {
        int tk0;
        if (lat && idx < 128) tk0 = CTX + (r0 + (idx >> 4)) * 64 + c0 + (idx & 15);
        else tk0 = lat ? idx - 128 : idx;
        o0 += pw[idx] * bf2f(p.rest[((size_t)b * TOK + tk0) * NREST + RC_BV + h * 64 + lane]);
        o1 += pw[idx + 1] * bf2f(p.rest[((size_t)b * TOK + tk0 + 1) * NREST + RC_BV + h * 64 + lane]);
    }
    nb[(size_t)t * 256 + h * 64 + lane] = f2bf((o0 + o1) * inv);
}


__device__ void ph_probe_naive(const P& p, LASP float* sm, int l, int bid, int nblk) {
    bf16* nb = (bf16*)p.xc1;
    if (PROBE == 1) { if (bid == 0) gdn_scan_naive(p, sm, l, 0, 0, nb); }
    else if (PROBE == 3) { if (bid == 0) gla_scan_naive(p, sm, l, 0, nb); }
    else { for (int it = bid; it < TOK / 2; it += nblk) na_query_naive(p, sm, l, 0, it * 2, nb); }
}
__device__ void ph_probe_cmp(const P& p, int bid, int nblk) {
    const int tid = mk_tid();
    const bf16* nb = (const bf16*)p.xc1;
    float md = 0.f, mr = 0.f;
    const int n = (PROBE == 2) ? TOK * 256 : 2 * TOK * 256;
    for (int i = bid * NTHREADS + tid; i < n; i += nblk * NTHREADS) {
        float a, r = bf2f(nb[i]);
        if (PROBE == 1) { const int dir = i / (TOK * 256), rem = i % (TOK * 256), t = rem >> 8, c = rem & 255; a = bf2f(p.oa[((size_t)dir * ROWS + t) * 512 + c]); }
        else if (PROBE == 3) { const int dir = i / (TOK * 256), rem = i % (TOK * 256); a = bf2f(p.oc[(size_t)dir * ROWS * 256 + rem]); }
        else { const int t = i >> 8, c = i & 255; a = bf2f(p.rest[(size_t)t * NREST + RC_BQ + c]); }
        md = fmaxf(md, fabsf(a - r)); mr = fmaxf(mr, fabsf(r));
    }
    md = wave_max(md); mr = wave_max(mr);
    if ((tid & 63) == 0) { atomicMax((unsigned*)p.stats, __float_as_uint(md)); atomicMax((unsigned*)p.stats + 1, __float_as_uint(mr)); }
}
#endif

#define XB_TMO      128
#define XB_XCNT(j)  (256  + 64 * (j))
#define XB_XSUB(j)  (1280 + 64 * (j))
#define XB_XGEN(j)  (2304 + 64 * (j))
#define XB_TOP      3328
#define XB_TOPGEN   3392
#define XCD_BAR_WORDS 3456
#define XB_SPIN_CAP (1u << 18)

__device__ __forceinline__ unsigned xb_ld(unsigned* p)              { return __hip_atomic_load(p, __ATOMIC_RELAXED, __HIP_MEMORY_SCOPE_AGENT); }
__device__ __forceinline__ unsigned xb_add(unsigned* p, unsigned v) { return __hip_atomic_fetch_add(p, v, __ATOMIC_RELAXED, __HIP_MEMORY_SCOPE_AGENT); }
__device__ __forceinline__ unsigned xb_xcc_id() { return (unsigned)__builtin_amdgcn_s_getreg((3 << 11) | 20) & 0xFu; }
#define XB_SPIN(cond, bar) do { unsigned _sp = 0; while (cond) { __builtin_amdgcn_s_sleep(1); \
    if ((++_sp & 255u) == 0u) { if (xb_ld(&(bar)[XB_TMO])) break; if (_sp > XB_SPIN_CAP) { atomicAdd(&(bar)[XB_TMO], 1u); break; } } } } while (0)

struct XcdBarrier {
    unsigned* bar; unsigned x;
    volatile LASP unsigned* st;
};

__device__ __forceinline__ XcdBarrier xcd_barrier_post(unsigned* bar, volatile LASP unsigned* st) {
    XcdBarrier b; b.bar = bar; b.x = xb_xcc_id(); b.st = st;
    if ((int)threadIdx.x == 0) (void)xb_add(&bar[XB_XCNT(b.x)], 1u);
    return b;
}
__device__ __forceinline__ void xcd_barrier_complete(unsigned* bar, unsigned x, unsigned& nloc, unsigned& nx) {
    const unsigned G = gridDim.x * gridDim.y * gridDim.z;
    unsigned sum, cnt, mine, sp = 0u;
    for (;;) {
        sum = 0u; cnt = 0u; mine = 0u;
#pragma unroll
        for (unsigned j = 0; j < 16; ++j) { const unsigned c = xb_ld(&bar[XB_XCNT(j)]); sum += c; cnt += (c > 0u) ? 1u : 0u; mine = (j == x) ? c : mine; }
        if (sum == G) break;
        __builtin_amdgcn_s_sleep(1);
        if ((++sp & 255u) == 0u) { if (xb_ld(&bar[XB_TMO])) break; if (sp > XB_SPIN_CAP) { atomicAdd(&bar[XB_TMO], 1u); break; } }
    }
    nloc = mine > 0u ? mine : 1u; nx = cnt > 0u ? cnt : 1u;
}

__device__ __forceinline__ void xcd_barrier(const XcdBarrier& b) {
    asm volatile("s_waitcnt vmcnt(0)" ::: "memory");
    __syncthreads();
    if ((int)threadIdx.x == 0) {
        unsigned* bar = b.bar;
        __builtin_amdgcn_s_waitcnt(0);
        unsigned nloc = b.st[0], nx = b.st[1];
        if (nloc == 0u) { xcd_barrier_complete(bar, b.x, nloc, nx); b.st[0] = nloc; b.st[1] = nx; }
        const unsigned old = xb_add(&bar[XB_XSUB(b.x)], 1u);
        const unsigned gen = old / nloc;
        if (old + 1u == (gen + 1u) * nloc) {
            __builtin_amdgcn_fence(__ATOMIC_RELEASE, "agent");
            asm volatile("s_waitcnt vmcnt(0)" ::: "memory");
            const unsigned og = xb_add(&bar[XB_TOP], 1u);
            const unsigned tg = og / nx;
            if (og + 1u == (tg + 1u) * nx) xb_add(&bar[XB_TOPGEN], 1u);
            else XB_SPIN(xb_ld(&bar[XB_TOPGEN]) == tg, bar);
            __builtin_amdgcn_fence(__ATOMIC_ACQUIRE, "agent");
            xb_add(&bar[XB_XGEN(b.x)], 1u);
            asm volatile("s_waitcnt vmcnt(0)" ::: "memory");
        } else {
            XB_SPIN(xb_ld(&bar[XB_XGEN(b.x)]) == gen, bar);
            __builtin_amdgcn_fence(__ATOMIC_ACQUIRE, "agent");
            asm volatile("s_waitcnt vmcnt(0)" ::: "memory");
        }
    }
    __syncthreads();
}


constexpr int NSTEP = 1 + 2 * 7 + 1;
__global__ void __launch_bounds__(NTHREADS, 2) k_mega(P p) {
    extern __shared__ __attribute__((aligned(16))) unsigned char lds_raw[];
    LASP unsigned char* lds = (LASP unsigned char*)lds_raw;
    const int bid = blockIdx.x, nblk = gridDim.x;
    volatile LASP unsigned* bst = (volatile LASP unsigned*)(lds + LDS_BYTES - 64);
    if (threadIdx.x < 16) bst[threadIdx.x] = 0u;
    __syncthreads();
    { const XcdBarrier b0 = xcd_barrier_post((unsigned*)p.ctl, bst); if (threadIdx.x == 0) bst[2] = b0.x; }
    __syncthreads();
    ph_prologue(p, lds, bid, nblk);
    { cg::grid_group grid = cg::this_grid(); grid.sync(); }
#pragma unroll 1
    for (int step = 1; step < NSTEP; ++step) {
        int ph = 0, l = 0;
        { const int s1 = step - 1; l = s1 / 7; ph = 1 + s1 % 7; }
#if TPROBE >= 0
        if (bid == 0 && threadIdx.x == 0) { if (step == 1) p.stats[2] = 0.f; const unsigned long long t_ = __builtin_amdgcn_s_memrealtime(); bst[4] = (unsigned)t_; bst[5] = (unsigned)(t_ >> 32); }
#endif
        if (ph == 1) { if (l == 0) ph_transposes(p, lds, bid, nblk); ph_lnpass(p, l, bid, nblk); }
        else if (l < 2) {
            if (ph == 2) {
                pg8::Gemm g{p.ml, p.wi_t + (size_t)l * NPAD * D, ROWS, NPAD, D}; pg8::StaticOrder S; S.init(ROWS, NPAD, nblk, bid);
                EpiProj E{p.raw, p.rest, p.kf};
                pg8::gemm_phase<EpiProj, pg8::StaticOrder, true, true>(lds, g, S, E);
            } else if (ph == 3) { ph_prep_early(p, lds, l, bid, nblk); ph_conv(p, l, bid, nblk); }
            else if (ph == 4) ph_prep(p, lds, l, bid, nblk);
            else if (ph == 5) {
#if PROBE
                if (l == 0) { ph_probe_naive(p, (LASP float*)lds, l, bid, nblk); XcdBarrier bar; bar.bar = (unsigned*)p.ctl; bar.x = (unsigned)__builtin_amdgcn_readfirstlane((int)bst[2]); bar.st = bst; xcd_barrier(bar); }
#endif
#if TPROBE >= 50
                const bool inrole = TPROBE == 50 ? (bid < 64) : (TPROBE == 51 ? (bid >= 64 && bid < 96) : (bid >= 96));
                const float rscale = TPROBE == 50 ? (1.f / 64.f) : (TPROBE == 51 ? (1.f / 32.f) : (1.f / 160.f));
                if (inrole && threadIdx.x == 0) { const unsigned long long t_ = __builtin_amdgcn_s_memrealtime(); bst[6] = (unsigned)t_; bst[7] = (unsigned)(t_ >> 32); }
#endif
                ph_mix(p, lds, l, bid, nblk);
#if TPROBE >= 50
                if (inrole && threadIdx.x == 0) { const unsigned long long tr0 = (unsigned long long)bst[6] | ((unsigned long long)bst[7] << 32); atomicAdd(&p.stats[2], (float)(__builtin_amdgcn_s_memrealtime() - tr0) * 0.01f * rscale); }
#endif
#if PROBE
                if (l == 0) { XcdBarrier bar; bar.bar = (unsigned*)p.ctl; bar.x = (unsigned)__builtin_amdgcn_readfirstlane((int)bst[2]); bar.st = bst; xcd_barrier(bar); ph_probe_cmp(p, bid, nblk); }
#endif
            }
            else if (ph == 6) ph_gate(p, l, bid, nblk);
            else if (ph == 7) {
                pg8::Gemm g{p.mix, p.wo_t + (size_t)l * D * D, ROWS, D, D};
                EpiY E{p.ml};
                if (l == 0) { pg8::StaticOrder S; S.init(ROWS, D, nblk, bid); pg8::gemm_phase<EpiY, pg8::StaticOrder, true, true>(lds, g, S, E); }
                else { LatentOrder S; S.S.init(BATCH * SEQ, D, nblk, bid); pg8::gemm_phase<EpiY, LatentOrder, true, true>(lds, g, S, E); }
            }
        }
        { XcdBarrier bar; bar.bar = (unsigned*)p.ctl; bar.x = (unsigned)__builtin_amdgcn_readfirstlane((int)bst[2]); bar.st = bst; xcd_barrier(bar); }
#if TPROBE >= 0
        if (bid == 0 && threadIdx.x == 0 && ph == TPROBE) { const unsigned long long tp0 = (unsigned long long)bst[4] | ((unsigned long long)bst[5] << 32); p.stats[2] += (float)(__builtin_amdgcn_s_memrealtime() - tp0) * 0.01f; }
#endif
    }
}

extern "C" void kernel_launch(void* const* d_in, const int* in_sizes, int n_in, void* d_out, int out_size, void* d_ws, size_t ws_size,
                              hipStream_t stream) {
    P p{};
    p.x = (const float*)d_in[0]; p.c = (const float*)d_in[1]; p.ctx = (const float*)d_in[2]; p.c_ctx = (const float*)d_in[3];
    p.w_mod = (const float*)d_in[4]; p.b_mod = (const float*)d_in[5]; p.w_in = (const float*)d_in[6]; p.conv_w = (const float*)d_in[7];
    p.a_log = (const float*)d_in[8]; p.dt_bias = (const float*)d_in[9]; p.gdn_norm = (const float*)d_in[10]; p.rpb = (const float*)d_in[11];
    p.gla_w2 = (const float*)d_in[12]; p.gla_b2 = (const float*)d_in[13]; p.gla_norm = (const float*)d_in[14]; p.w_out = (const float*)d_in[15];
    p.ln_g = (const float*)d_in[16]; p.ln_b = (const float*)d_in[17];
    p.out = (float*)d_out;
    unsigned char* w = (unsigned char*)d_ws;
    size_t off = 0;
    auto take = [&](size_t bytes) { unsigned char* r = w + off; off += (bytes + 255) & ~(size_t)255; return r; };
    p.ctl = (unsigned*)take(16384);
    p.mods = (float*)take((size_t)2 * 9 * 3072 * 4);
    p.xc1 = (float*)take((size_t)BATCH * CTX * D * 4);
    p.wi_t = (bf16*)take((size_t)2 * NPAD * D * 2);
    p.wo_t = (bf16*)take((size_t)2 * D * D * 2);
    p.rest = (bf16*)take((size_t)ROWS * NREST * 2);
    p.raw = (bf16*)take((size_t)ROWS * NRAW * 2);
    p.qkvn = (bf16*)take((size_t)ROWS * NRAW * 2);
    p.mix = p.qkvn;
    p.oa = (bf16*)take((size_t)2 * ROWS * 512 * 2);
    p.oc = (bf16*)take((size_t)2 * ROWS * 256 * 2);
    p.ml = p.oa;
    p.vf = (bf16*)take((size_t)ROWS * 256 * 2);
    p.kf = (bf16*)take((size_t)ROWS * 256 * 2);
    p.stats = (float*)take(256);
    static int grid_blocks = 0;
    if (!grid_blocks) {
        if (off > ws_size) { fprintf(stderr, "workspace too small: need %zu have %zu\n", off, ws_size); grid_blocks = -1; return; }
        int dev = 0, cus = 0, per_cu = 0;
        hipGetDevice(&dev);
        hipDeviceGetAttribute(&cus, hipDeviceAttributeMultiprocessorCount, dev);
        if (hipFuncSetAttribute((const void*)k_mega, hipFuncAttributeMaxDynamicSharedMemorySize, LDS_BYTES) != hipSuccess) { fprintf(stderr, "hipFuncSetAttribute failed\n"); grid_blocks = -1; return; }
        hipOccupancyMaxActiveBlocksPerMultiprocessor(&per_cu, (const void*)k_mega, NTHREADS, LDS_BYTES);
        if (per_cu < 1) { fprintf(stderr, "occupancy query says %d blocks per CU\n", per_cu); grid_blocks = -1; return; }
        grid_blocks = cus;
    }
    if (grid_blocks < 0) return;
    if (hipMemsetAsync(p.ctl, 0, 16384, stream) != hipSuccess) { fprintf(stderr, "memset of the barrier words failed\n"); return; }
    void* args[] = {&p};
    hipError_t e = hipLaunchCooperativeKernel((void*)k_mega, dim3(grid_blocks), dim3(NTHREADS), args, LDS_BYTES, stream);
    if (e != hipSuccess) fprintf(stderr, "cooperative launch failed: %s (grid %d)\n", hipGetErrorString(e), grid_blocks);
}
```

```cpp
#include <hip/hip_runtime.h>
#include <hip/hip_cooperative_groups.h>
#include <cstdio>
#include <cstdint>
namespace cg = cooperative_groups;
#ifndef PROBE
#define PROBE 0
#endif
#ifndef TPROBE
#define TPROBE -1
#endif
#ifndef TSHIFT
#define TSHIFT 0
#endif

constexpr int D = 1024, BATCH = 8, SEQ = 4096, CTX = 256, TOK = 4352, NPROJ = 3888;
constexpr int ROWS = BATCH * TOK;
constexpr int NRAW = 1536, NREST = 2096, NPAD = 4096;
constexpr int NTHREADS = 512, NWAVES = 8;
constexpr int LDS_BYTES = 147456;
constexpr float ALPHA = 1.4142135623730951f;
constexpr int RC_AB = 0, RC_AZ = 16, RC_BQ = 528, RC_BV = 784, RC_BZ = 1040, RC_CQ = 1296, RC_CK = 1424, RC_CV = 1552, RC_CR = 1808, RC_CZ = 1840;
constexpr int PC_BK = 2320, PC_BV = 2576;

typedef unsigned short bf16;
typedef float f32x4_t __attribute__((ext_vector_type(4)));

struct P {
    const float *x, *c, *ctx, *c_ctx, *w_mod, *b_mod, *w_in, *conv_w, *a_log, *dt_bias, *gdn_norm, *rpb,
        *gla_w2, *gla_b2, *gla_norm, *w_out, *ln_g, *ln_b;
    float* out;
    float *mods, *xc1, *stats; unsigned* ctl;
    bf16 *wi_t, *wo_t, *rest, *raw, *qkvn, *mix, *ml, *oa, *oc, *vf, *kf;
};

__device__ __forceinline__ float bf2f(unsigned short u) { return __uint_as_float((unsigned)u << 16); }
typedef float f32x2_t __attribute__((ext_vector_type(2)));
typedef __bf16 bf16x2_t __attribute__((ext_vector_type(2)));
__device__ __forceinline__ unsigned cvtpk(float lo, float hi) { f32x2_t v = {lo, hi}; bf16x2_t q = __builtin_convertvector(v, bf16x2_t); return __builtin_bit_cast(unsigned, q); }
__device__ __forceinline__ unsigned short f2bf(float f) { return (unsigned short)cvtpk(f, f); }
__device__ __forceinline__ unsigned pk2(float lo, float hi) { return cvtpk(lo, hi); }
__device__ __forceinline__ float bflo(unsigned w) { return __uint_as_float(w << 16); }
__device__ __forceinline__ float bfhi(unsigned w) { return __uint_as_float(w & 0xffff0000u); }
__device__ __forceinline__ void unpack8(uint4 w, float* f) {
    f[0] = bflo(w.x); f[1] = bfhi(w.x); f[2] = bflo(w.y); f[3] = bfhi(w.y); f[4] = bflo(w.z); f[5] = bfhi(w.z); f[6] = bflo(w.w); f[7] = bfhi(w.w);
}
__device__ __forceinline__ float silu_f(float x) { return x * __builtin_amdgcn_rcpf(1.f + __builtin_amdgcn_exp2f(-1.4426950408889634f * x)); }
__device__ __forceinline__ float wave_sum(float v) {
#pragma unroll
    for (int o = 32; o > 0; o >>= 1) v += __shfl_xor(v, o);
    return v;
}
__device__ __forceinline__ float wave_max(float v) {
#pragma unroll
    for (int o = 32; o > 0; o >>= 1) v = fmaxf(v, __shfl_xor(v, o));
    return v;
}
__device__ __forceinline__ int mk_tid() { int t = threadIdx.x; asm volatile("" : "+v"(t)); return t; }
__device__ __forceinline__ int tok_of(int dir, int s) { return dir == 0 ? s : (s < CTX ? CTX - 1 - s : TOK + CTX - 1 - s); }

namespace pg8 {
#define PG8_LAS __attribute__((address_space(3)))
typedef unsigned short bf16_t;
typedef short bf16x8 __attribute__((ext_vector_type(8)));
typedef float f32x4 __attribute__((ext_vector_type(4)));
typedef unsigned u32x4 __attribute__((ext_vector_type(4)));
constexpr int BM = 256, BK = 64, HALF = 128, HTB = HALF * BK * 2  , STAGE_BYTES = 8 * HTB, NXCD = 8, WGM = 8;

__host__ __device__ __forceinline__ int lds_byte(int r, int c) { const int st = (r >> 4) * 2 + (c >> 5), rr = r & 15, cc = c & 31, ob = rr * 64 + cc * 2; return st * 1024 + (ob ^ (((ob >> 9) & 1) << 5)); }
__host__ __device__ __forceinline__ void stage_rc(int b, int& R, int& C) { const int st = b / 1024, sb = b % 1024, swz = sb ^ (((sb >> 9) & 1) << 5); R = (st >> 1) * 16 + swz / 64; C = (st & 1) * 32 + (swz % 64) / 2; }
__host__ __device__ __forceinline__ int perm32(int rho) { const int n = rho >> 4, i = rho & 15; return 8 * (i >> 2) + 4 * n + (i & 3); }

struct Unit { int pm, pn; };
struct Gemm { const bf16_t* A; const bf16_t* Bt; int M, N, K; };

struct StaticOrder {
    int nM, nN, nwg, G, c;
    __host__ __device__ void init(int M, int N, int G_, int c_) { nM = M / BM; nN = N / BM; nwg = nM * nN; G = G_; c = c_; }
    __host__ __device__ bool next(int i, Unit& u) const {
        const long L = (long)i * G + c; if (L >= nwg) return false;
        int wgid = (int)L; { const int q = nwg / NXCD, r = nwg % NXCD, xcd = wgid % NXCD, off = wgid / NXCD; wgid = (xcd < r ? xcd * (q + 1) : r * (q + 1) + (xcd - r) * q) + off; }
        const int nig = WGM * nN, gid = wgid / nig, fm = gid * WGM, gsz = (nM - fm) < WGM ? (nM - fm) : WGM;
        u.pm = fm + ((wgid % nig) % gsz); u.pn = (wgid % nig) / gsz; return true;
    }
    __device__ __forceinline__ void a_ready(const Unit&) const {}
    __device__ __forceinline__ void done(const Unit&) const {}
};

__device__ __forceinline__ unsigned cvt_pk_bf16(float lo, float hi) { unsigned r; asm volatile("v_cvt_pk_bf16_f32 %0, %1, %2" : "=v"(r) : "v"(lo), "v"(hi)); return r; }
template <class Epi, class Sched, bool ALIGN_EPI = false, bool SP2 = false>
__device__ __forceinline__ void gemm_phase(PG8_LAS unsigned char* lds, const Gemm g, const Sched& S, const Epi& E) {
    const int tid = mk_tid(), wid = __builtin_amdgcn_readfirstlane(tid >> 6), lane = tid & 63, wr = wid >> 2, wc = wid & 3, fr = lane & 15, fq = lane >> 4;
    const int K = g.K, nt = K / BK;
    unsigned voffA[2], voffB[2];
#pragma unroll
    for (int i = 0; i < 2; ++i) { int R, C; stage_rc(tid * 16 + i * 8192, R, C); const int Rb = Epi::PERM ? ((R & ~31) + perm32(R & 31)) : R;
        voffA[i] = (unsigned)(R * K + C) * 2u; voffB[i] = (unsigned)(Rb * K + C) * 2u; }
    const size_t kstep = (size_t)(BK * 2);
    const size_t hstep = (size_t)HALF * K * 2;
    const size_t tstep = 2 * hstep;
    const unsigned ldsw = (unsigned)wid * 1024u;
    const int aoff = lds_byte(wr * 64 + fr, fq * 8), boff = lds_byte(wc * 32 + fr, fq * 8);
#define PG8_SA(b, h) (((b) * 2 + (h)) * HTB)
#define PG8_SB(b, h) ((4 + (b) * 2 + (h)) * HTB)
#define PG8_STAGE(bufoff, gbase, voff) do { _Pragma("unroll") for (int _i = 0; _i < 2; ++_i) \
        __builtin_amdgcn_global_load_lds((const unsigned*)((const char*)(gbase) + (voff)[_i]), (PG8_LAS unsigned*)(lds + (bufoff) + ldsw + _i * 8192), 16, 0, 0); } while (0)
#define PG8_LDA(dst, b, h) do { _Pragma("unroll") for (int m = 0; m < 4; ++m) _Pragma("unroll") for (int k = 0; k < 2; ++k) dst[m][k] = *(const PG8_LAS bf16x8*)(lds + PG8_SA(b, h) + aoff + m * 2048 + k * 1024); } while (0)
#define PG8_LDB(dst, b, h) do { _Pragma("unroll") for (int n = 0; n < 2; ++n) _Pragma("unroll") for (int k = 0; k < 2; ++k) dst[n][k] = *(const PG8_LAS bf16x8*)(lds + PG8_SB(b, h) + boff + n * 2048 + k * 1024); } while (0)
#define PG8_MMA(ai, bj, At, Bt) do { __builtin_amdgcn_s_setprio(1); _Pragma("unroll") for (int m = 0; m < 4; ++m) _Pragma("unroll") for (int n = 0; n < 2; ++n) _Pragma("unroll") for (int k = 0; k < 2; ++k) \
        acc[ai][bj][m][n] = __builtin_amdgcn_mfma_f32_16x16x32_bf16(Bt[n][k], At[m][k], acc[ai][bj][m][n], 0, 0, 0); __builtin_amdgcn_s_setprio(0); } while (0)
#define PG8_WAIT_V(n) asm volatile("s_waitcnt vmcnt(" #n ")" ::: "memory")
#define PG8_WAIT_L(n) asm volatile("s_waitcnt lgkmcnt(" #n ")" ::: "memory")
#define PG8_BAR __builtin_amdgcn_s_barrier()
#define PG8_SCHED __builtin_amdgcn_sched_barrier(0)
    Unit cur, nxt; int ui = 0;
    if (!S.next(0, cur)) return;
    f32x4 acc[2][2][4][2];
#pragma unroll
    for (int a = 0; a < 2; ++a)
#pragma unroll
        for (int b = 0; b < 2; ++b)
#pragma unroll
            for (int m = 0; m < 4; ++m)
#pragma unroll
                for (int n = 0; n < 2; ++n) acc[a][b][m][n] = (f32x4){0.f, 0.f, 0.f, 0.f};
    bf16x8 At[4][2], B0[2][2], B1[2][2];
    const char* cA = (const char*)g.A + (size_t)cur.pm * tstep; const char* cB = (const char*)g.Bt + (size_t)cur.pn * tstep;
    S.a_ready(cur);
    if constexpr (SP2) {
        PG8_STAGE(PG8_SB(0, 0), cB, voffB); PG8_STAGE(PG8_SB(0, 1), cB + hstep, voffB); PG8_STAGE(PG8_SA(0, 0), cA, voffA); PG8_STAGE(PG8_SA(0, 1), cA + hstep, voffA);
        if (wr == 1) PG8_BAR;
        PG8_WAIT_V(2); PG8_BAR;
        PG8_STAGE(PG8_SB(1, 0), cB + kstep, voffB); PG8_STAGE(PG8_SA(1, 0), cA + kstep, voffA); PG8_STAGE(PG8_SB(1, 1), cB + hstep + kstep, voffB);
        PG8_WAIT_V(6); PG8_BAR;
    } else {
        PG8_STAGE(PG8_SB(0, 0), cB, voffB); PG8_STAGE(PG8_SA(0, 0), cA, voffA); PG8_STAGE(PG8_SB(0, 1), cB + hstep, voffB); PG8_STAGE(PG8_SA(0, 1), cA + hstep, voffA);
        if (wr == 1) PG8_BAR;
        PG8_WAIT_V(4); PG8_BAR;
        PG8_STAGE(PG8_SB(1, 0), cB + kstep, voffB); PG8_STAGE(PG8_SA(1, 0), cA + kstep, voffA); PG8_STAGE(PG8_SB(1, 1), cB + hstep + kstep, voffB);
        PG8_WAIT_V(6); PG8_BAR;
    }
    for (;;) {
        const bool has_next = S.next(ui + 1, nxt);
        const char* nA = has_next ? (const char*)g.A + (size_t)nxt.pm * tstep : cA; const char* nB = has_next ? (const char*)g.Bt + (size_t)nxt.pn * tstep : cB;
        for (int t = 0; t < nt; t += 2) {
            const bool last = (t == nt - 2);
            const char* a1 = cA + (size_t)(t + 1) * kstep;
            const char* a2 = last ? nA : cA + (size_t)(t + 2) * kstep; const char* b2 = last ? nB : cB + (size_t)(t + 2) * kstep;
            const char* a3 = a2 + kstep; const char* b3 = b2 + kstep;
            if (last && has_next) S.a_ready(nxt);
            if constexpr (SP2) {
            PG8_LDB(B0, 0, 0); PG8_LDB(B1, 0, 1); PG8_SCHED; PG8_LDA(At, 0, 0); PG8_STAGE(PG8_SA(1, 1), a1 + hstep, voffA);
            PG8_WAIT_V(8); PG8_WAIT_L(0); PG8_BAR; PG8_MMA(0, 0, At, B0); PG8_MMA(0, 1, At, B1); PG8_BAR; PG8_SCHED;
            PG8_LDA(At, 0, 1); PG8_STAGE(PG8_SB(0, 0), b2, voffB); PG8_STAGE(PG8_SB(0, 1), b2 + hstep, voffB); PG8_STAGE(PG8_SA(0, 0), a2, voffA);
            PG8_WAIT_V(8); PG8_WAIT_L(0); PG8_BAR; PG8_MMA(1, 0, At, B0); PG8_MMA(1, 1, At, B1); PG8_BAR; PG8_SCHED;
            PG8_LDB(B0, 1, 0); PG8_LDB(B1, 1, 1); PG8_SCHED; PG8_LDA(At, 1, 0); PG8_STAGE(PG8_SA(0, 1), a2 + hstep, voffA);
            PG8_WAIT_V(8); PG8_WAIT_L(0); PG8_BAR; PG8_MMA(0, 0, At, B0); PG8_MMA(0, 1, At, B1); PG8_BAR; PG8_SCHED;
            PG8_LDA(At, 1, 1); PG8_STAGE(PG8_SB(1, 0), b3, voffB); PG8_STAGE(PG8_SB(1, 1), b3 + hstep, voffB); PG8_STAGE(PG8_SA(1, 0), a3, voffA);
            PG8_WAIT_V(8); PG8_WAIT_L(0); PG8_BAR; PG8_MMA(1, 0, At, B0); PG8_MMA(1, 1, At, B1); PG8_BAR; PG8_SCHED;
            } else {
            PG8_LDB(B0, 0, 0); PG8_SCHED; PG8_LDA(At, 0, 0); PG8_STAGE(PG8_SA(1, 1), a1 + hstep, voffA);
            PG8_WAIT_L(8); PG8_BAR; PG8_WAIT_L(0); PG8_MMA(0, 0, At, B0); PG8_BAR; PG8_SCHED;
            PG8_LDB(B1, 0, 1); PG8_STAGE(PG8_SB(0, 0), b2, voffB);
            PG8_BAR; PG8_WAIT_L(0); PG8_MMA(0, 1, At, B1); PG8_BAR;
            PG8_LDA(At, 0, 1); PG8_STAGE(PG8_SA(0, 0), a2, voffA);
            PG8_BAR; PG8_WAIT_L(0); PG8_MMA(1, 0, At, B0); PG8_BAR; PG8_SCHED;
            PG8_STAGE(PG8_SB(0, 1), b2 + hstep, voffB);
            PG8_WAIT_V(6); PG8_BAR; PG8_MMA(1, 1, At, B1); PG8_BAR;
            PG8_LDB(B0, 1, 0); PG8_SCHED; PG8_LDA(At, 1, 0); PG8_STAGE(PG8_SA(0, 1), a2 + hstep, voffA);
            PG8_WAIT_L(8); PG8_BAR; PG8_WAIT_L(0); PG8_MMA(0, 0, At, B0); PG8_BAR; PG8_SCHED;
            PG8_LDB(B1, 1, 1); PG8_STAGE(PG8_SB(1, 0), b3, voffB);
            PG8_BAR; PG8_WAIT_L(0); PG8_MMA(0, 1, At, B1); PG8_BAR;
            PG8_LDA(At, 1, 1); PG8_STAGE(PG8_SA(1, 0), a3, voffA);
            PG8_BAR; PG8_WAIT_L(0); PG8_MMA(1, 0, At, B0); PG8_BAR; PG8_SCHED;
            PG8_STAGE(PG8_SB(1, 1), b3 + hstep, voffB);
            PG8_WAIT_V(6); PG8_BAR; PG8_MMA(1, 1, At, B1); PG8_BAR;
            }
        }
        if constexpr (ALIGN_EPI) { if (wr == 0) PG8_BAR; }
        if constexpr (!Epi::AFTER_DRAIN) { E(acc, cur, wr, wc, fr, fq); S.done(cur); }
        if (!has_next) break;
#pragma unroll
        for (int a = 0; a < 2; ++a)
#pragma unroll
            for (int b = 0; b < 2; ++b)
#pragma unroll
                for (int m = 0; m < 4; ++m)
#pragma unroll
                    for (int n = 0; n < 2; ++n) acc[a][b][m][n] = (f32x4){0.f, 0.f, 0.f, 0.f};
        cur = nxt; cA = nA; cB = nB; ++ui;
        if constexpr (ALIGN_EPI) { if (wr == 1) PG8_BAR; }
    }
    PG8_WAIT_V(0);
    if constexpr (!ALIGN_EPI) { if (wr == 0) PG8_BAR; }
    PG8_BAR;
    if constexpr (Epi::AFTER_DRAIN) { E.fused(acc, cur, wr, wc, fr, fq, lds, wid, lane); S.done(cur); }
#undef PG8_SA
#undef PG8_SB
#undef PG8_STAGE
#undef PG8_LDA
#undef PG8_LDB
#undef PG8_MMA
#undef PG8_WAIT_V
#undef PG8_WAIT_L
#undef PG8_BAR
#undef PG8_SCHED
}
}

#define LASP __attribute__((address_space(3)))
constexpr int NCHK = TOK / 32;

struct LatentOrder {
    pg8::StaticOrder S;
    __device__ __forceinline__ bool next(int i, pg8::Unit& u) const { if (!S.next(i, u)) return false; u.pm = 17 * (u.pm >> 4) + 1 + (u.pm & 15); return true; }
    __device__ __forceinline__ void a_ready(const pg8::Unit&) const {}
    __device__ __forceinline__ void done(const pg8::Unit&) const {}
};
struct EpiProj {
    static constexpr bool PERM = true, AFTER_DRAIN = false;
    bf16* raw; bf16* rest; bf16* kf;
    __device__ __forceinline__ void operator()(const pg8::f32x4 (&acc)[2][2][4][2], const pg8::Unit& u, int wr, int wc, int fr, int fq) const {
        const int row0 = u.pm * 256 + wr * 64 + fr;
        const int colb = u.pn * 256 + wc * 32 + 8 * fq;
#pragma unroll
        for (int bj = 0; bj < 2; ++bj) {
            const int col = colb + bj * 128;
            if (col >= NPROJ) continue;
            const bool iskf = col >= PC_BK && col < PC_BV;
            bf16* base; int ld;
            if (col < NRAW) { base = raw + col; ld = NRAW; }
            else if (col < PC_BK) { base = rest + (col - NRAW); ld = NREST; }
            else { base = rest + (col - NRAW - 256); ld = NREST; }
            const int hd = col - PC_BK, hk = hd >> 6, dk = hd & 63;
#pragma unroll
            for (int ai = 0; ai < 2; ++ai)
#pragma unroll
                for (int m = 0; m < 4; ++m) {
                    const pg8::f32x4 v0 = acc[ai][bj][m][0], v1 = acc[ai][bj][m][1];
                    pg8::u32x4 w; w.x = pg8::cvt_pk_bf16(v0[0], v0[1]); w.y = pg8::cvt_pk_bf16(v0[2], v0[3]); w.z = pg8::cvt_pk_bf16(v1[0], v1[1]); w.w = pg8::cvt_pk_bf16(v1[2], v1[3]);
                    const int row = row0 + ai * 128 + m * 16;
                    if (iskf) {
                        const int bb = row / TOK, t = row - bb * TOK;
                        *(pg8::u32x4*)(kf + ((((size_t)(bb * 4 + hk) * NCHK + (t >> 5)) * 4 + (dk >> 4)) * 64 + ((dk >> 3) & 1) * 32 + (t & 31)) * 8) = w;
                    } else *(pg8::u32x4*)(base + (size_t)row * ld) = w;
                }
        }
    }
};
struct EpiY {
    static constexpr bool PERM = true, AFTER_DRAIN = false;
    bf16* y;
    __device__ __forceinline__ void operator()(const pg8::f32x4 (&acc)[2][2][4][2], const pg8::Unit& u, int wr, int wc, int fr, int fq) const {
        const int row0 = u.pm * 256 + wr * 64 + fr;
        const int colb = u.pn * 256 + wc * 32 + 8 * fq;
#pragma unroll
        for (int bj = 0; bj < 2; ++bj)
#pragma unroll
            for (int ai = 0; ai < 2; ++ai)
#pragma unroll
                for (int m = 0; m < 4; ++m) {
                    const pg8::f32x4 v0 = acc[ai][bj][m][0], v1 = acc[ai][bj][m][1];
                    pg8::u32x4 w; w.x = pg8::cvt_pk_bf16(v0[0], v0[1]); w.y = pg8::cvt_pk_bf16(v0[2], v0[3]); w.z = pg8::cvt_pk_bf16(v1[0], v1[1]); w.w = pg8::cvt_pk_bf16(v1[2], v1[3]);
                    *(pg8::u32x4*)(y + (size_t)(row0 + ai * 128 + m * 16) * D + colb + bj * 128) = w;
                }
    }
};

__device__ __forceinline__ void transpose_item(const float* W, int K, int N, bf16* WT, LASP float* scr, int item, int lane) {
    const int nblk = (N + 31) / 32, kb = item / nblk, nb = item % nblk, k0 = 64 * kb, n0 = 32 * nb;
    const bool nok = (n0 + (lane & 31)) < N;
#pragma unroll 8
    for (int i = 0; i < 32; ++i) { const int kk = 2 * i + (lane >> 5); scr[kk * 33 + (lane & 31)] = nok ? W[(size_t)(k0 + kk) * N + n0 + (lane & 31)] : 0.f; }
    asm volatile("s_waitcnt lgkmcnt(0)" ::: "memory");
    const int c = lane & 7;
#pragma unroll
    for (int j = 0; j < 4; ++j) {
        const int n = (lane >> 3) + 8 * j; const LASP float* s = scr + (8 * c) * 33 + n;
        uint4 o; o.x = pk2(s[0 * 33], s[1 * 33]); o.y = pk2(s[2 * 33], s[3 * 33]); o.z = pk2(s[4 * 33], s[5 * 33]); o.w = pk2(s[6 * 33], s[7 * 33]);
        *(uint4*)(WT + (size_t)(n0 + n) * K + k0 + 8 * c) = o;
    }
    asm volatile("s_waitcnt lgkmcnt(0)" ::: "memory");
}

__device__ void ph_prologue(const P& p, LASP unsigned char* lds, int bid, int nblk) {
    const int tid = mk_tid(), lane = tid & 63, wave = tid >> 6;
    LASP float* sm = (LASP float*)lds;
    if (bid < 96) {
        for (int i = tid; i < 9 * 1024; i += NTHREADS) {
            int s = i >> 10, d = i & 1023;
            float cv = s < 8 ? p.c[s * 1024 + d] : p.c_ctx[d];
            sm[i] = silu_f(cv);
        }
        __syncthreads();
        const int l = bid / 48, j = (bid % 48) * 64 + lane;
        const float* w = p.w_mod + (size_t)l * 1024 * 3072 + j;
        float acc[9];
#pragma unroll
        for (int s = 0; s < 9; ++s) acc[s] = 0.f;
#pragma unroll 1
        for (int i0 = wave * 128; i0 < wave * 128 + 128; i0 += 16) {
            float wv[16];
#pragma unroll
            for (int u = 0; u < 16; ++u) wv[u] = w[(size_t)(i0 + u) * 3072];
#pragma unroll
            for (int u = 0; u < 16; ++u)
#pragma unroll
                for (int s = 0; s < 9; ++s) acc[s] += sm[s * 1024 + i0 + u] * wv[u];
        }
        LASP float* red = sm + 9 * 1024;
#pragma unroll
        for (int s = 0; s < 9; ++s) red[(wave * 9 + s) * 64 + lane] = acc[s];
        __syncthreads();
        for (int o = tid; o < 9 * 64; o += NTHREADS) {
            const int s = o >> 6, c = o & 63;
            float t = 0.f;
#pragma unroll
            for (int ww = 0; ww < 8; ++ww) t += red[(ww * 9 + s) * 64 + c];
            const int jj = (bid % 48) * 64 + c;
            p.mods[(size_t)(l * 9 + s) * 3072 + jj] = t + p.b_mod[l * 3072 + jj];
        }
        __syncthreads();
    }
#if PROBE
    if (bid == 0 && tid < 4) p.stats[tid] = 0.f;
#endif
}
__device__ void ph_transposes(const P& p, LASP unsigned char* lds, int bid, int nblk) {
    const int tid = mk_tid(), lane = tid & 63, wave = tid >> 6;
    LASP float* scr = (LASP float*)(lds + 57344 + wave * 8704);
    const int gw = (nblk - 1 - bid) * NWAVES + wave, NGW = nblk * NWAVES;
    constexpr int I_IN = 16 * 122, I_OUT = 16 * 32;
    for (int it = gw; it < 2 * (I_IN + I_OUT); it += NGW) {
        int l = it / (I_IN + I_OUT), r = it % (I_IN + I_OUT);
        if (r < I_IN) transpose_item(p.w_in + (size_t)l * D * NPROJ, D, NPROJ, p.wi_t + (size_t)l * NPAD * D, scr, r, lane);
        else transpose_item(p.w_out + (size_t)l * D * D, D, D, p.wo_t + (size_t)l * D * D, scr, r - I_IN, lane);
    }
    for (int i = bid * NTHREADS + tid; i < 2 * 192 * 128; i += nblk * NTHREADS) {
        int l = i / (192 * 128), r = i % (192 * 128);
        unsigned z; asm volatile("v_mov_b32 %0, 0" : "=v"(z));
        *(uint4*)(p.wi_t + (size_t)l * NPAD * D + (size_t)3904 * D + (size_t)r * 8) = make_uint4(z, z, z, z);
    }
}

__device__ void ph_lnpass(const P& p, int mode, int bid, int nblk) {
    const int tid = mk_tid();
    const int lane = tid & 63, wave = tid >> 6;
    for (int r = bid * NWAVES + wave; r < ROWS; r += nblk * NWAVES) {
        const int b = r / TOK, t = r - b * TOK;
        const bool isc = t < CTX;
        if (mode == 2 && isc) continue;
        float* buf; const float* src; int s;
        if (isc) { buf = p.xc1 + ((size_t)b * CTX + t) * D; src = p.ctx + ((size_t)b * CTX + t) * D; s = 8; }
        else { buf = p.out + ((size_t)b * SEQ + (t - CTX)) * D; src = (mode == 2) ? buf : p.x + ((size_t)b * SEQ + (t - CTX)) * D; s = b; }
        f32x4_t v[4];
#pragma unroll
        for (int j = 0; j < 4; ++j) v[j] = *(const f32x4_t*)(src + 256 * j + 4 * lane);
        if (mode >= 1) {
            const int lp = mode - 1;
            const float* gt = p.mods + (size_t)(lp * 9 + s) * 3072 + 2048;
#pragma unroll
            for (int j = 0; j < 4; ++j) {
                const uint2 yw = *(const uint2*)(p.ml + (size_t)r * D + 256 * j + 4 * lane);
                const f32x4_t g = *(const f32x4_t*)(gt + 256 * j + 4 * lane);
                const f32x4_t yv = {bflo(yw.x), bfhi(yw.x), bflo(yw.y), bfhi(yw.y)};
                v[j] = v[j] * ALPHA + g * yv;
            }
            float sum = 0.f;
#pragma unroll
            for (int j = 0; j < 4; ++j) sum += (v[j].x + v[j].y) + (v[j].z + v[j].w);
            const float mu = wave_sum(sum) * (1.f / 1024.f);
            float sq = 0.f;
#pragma unroll
            for (int j = 0; j < 4; ++j) { v[j] = v[j] - mu; sq += (v[j].x * v[j].x + v[j].y * v[j].y) + (v[j].z * v[j].z + v[j].w * v[j].w); }
            const float rs = __builtin_amdgcn_rsqf(wave_sum(sq) * (1.f / 1024.f) + 1e-6f);
#pragma unroll
            for (int j = 0; j < 4; ++j) {
                const f32x4_t g = *(const f32x4_t*)(p.ln_g + lp * 1024 + 256 * j + 4 * lane), bb = *(const f32x4_t*)(p.ln_b + lp * 1024 + 256 * j + 4 * lane);
                v[j] = v[j] * rs * g + bb;
#if PROBE
                if (mode == 2) v[j] = v[j] + (p.stats[0] / fmaxf(p.stats[1], 1e-20f));
#endif
#if TPROBE >= 0
                if (mode == 2) v[j] = v[j] + exp2f((rintf(log2f(fmaxf(p.stats[2], 1.f)) * 6.f + TSHIFT * 0.5f) - TSHIFT * 0.5f) * (1.f / 6.f)) * 1e-4f;
#endif
                *(f32x4_t*)(buf + 256 * j + 4 * lane) = v[j];
            }
            if (mode == 2) continue;
        }
        const int l = mode;
        float sum = 0.f;
#pragma unroll
        for (int j = 0; j < 4; ++j) sum += (v[j].x + v[j].y) + (v[j].z + v[j].w);
        const float mu = wave_sum(sum) * (1.f / 1024.f);
        float sq = 0.f;
#pragma unroll
        for (int j = 0; j < 4; ++j) { v[j] = v[j] - mu; sq += (v[j].x * v[j].x + v[j].y * v[j].y) + (v[j].z * v[j].z + v[j].w * v[j].w); }
        const float rs = __builtin_amdgcn_rsqf(wave_sum(sq) * (1.f / 1024.f) + 1e-6f);
        const float* md = p.mods + (size_t)(l * 9 + s) * 3072;
#pragma unroll
        for (int j = 0; j < 4; ++j) {
            const f32x4_t sh = *(const f32x4_t*)(md + 256 * j + 4 * lane), sc = *(const f32x4_t*)(md + 1024 + 256 * j + 4 * lane);
            const f32x4_t o = v[j] * rs * (sc + 1.f) + sh;
            uint2 w; w.x = pk2(o.x, o.y); w.y = pk2(o.z, o.w);
            *(uint2*)(p.ml + (size_t)r * D + 256 * j + 4 * lane) = w;
        }
    }
}

__device__ void ph_conv(const P& p, int l, int bid, int nblk) {
    const int tid = mk_tid();
    const int lane = tid & 63, wave = tid >> 6;
    const float* cw = p.conv_w + (size_t)l * 5 * 1536;
    constexpr int NSTRIP = TOK / 16;
    for (int it = bid * NWAVES + wave; it < BATCH * NSTRIP * 3; it += nblk * NWAVES) {
        const int third = it % 3, rest_i = it / 3, strip = rest_i % NSTRIP, b = rest_i / NSTRIP;
        const int t0 = strip * 16;
        const int lo = t0 < CTX ? 0 : CTX, hi = t0 < CTX ? CTX : TOK;
        const int ch = third * 512 + lane * 8;
        float w[5][8];
#pragma unroll
        for (int j = 0; j < 5; ++j) {
            const f32x4_t a = *(const f32x4_t*)(cw + j * 1536 + ch), c = *(const f32x4_t*)(cw + j * 1536 + ch + 4);
            w[j][0] = a.x; w[j][1] = a.y; w[j][2] = a.z; w[j][3] = a.w; w[j][4] = c.x; w[j][5] = c.y; w[j][6] = c.z; w[j][7] = c.w;
        }
        const bf16* src = p.raw + ((size_t)b * TOK + t0) * NRAW + ch;
        bf16* dst = p.qkvn + ((size_t)b * TOK + t0) * NRAW + ch;
        uint4 rw[20];
#pragma unroll
        for (int i = 0; i < 20; ++i) {
            const int tt = t0 + i - 2;
            rw[i] = (tt >= lo && tt < hi) ? *(const uint4*)(src + (ptrdiff_t)(i - 2) * NRAW) : make_uint4(0, 0, 0, 0);
        }
        const int g = (ch >> 7);
        const float qs = g < 4 ? 0.08838834764831845f : 1.f;
#pragma unroll
        for (int n = 0; n < 16; ++n) {
            float acc[8];
#pragma unroll
            for (int e = 0; e < 8; ++e) acc[e] = 0.f;
#pragma unroll
            for (int j = 0; j < 5; ++j) {
                float f[8]; unpack8(rw[n + j], f);
#pragma unroll
                for (int e = 0; e < 8; ++e) acc[e] += w[j][e] * f[e];
            }
            float ss = 0.f;
#pragma unroll
            for (int e = 0; e < 8; ++e) { acc[e] = silu_f(acc[e]); ss += acc[e] * acc[e]; }
            if (g < 8) {
#pragma unroll
                for (int m = 8; m > 0; m >>= 1) ss += __shfl_xor(ss, m);
                const float sc = qs * __builtin_amdgcn_rsqf(ss + 1e-6f);
#pragma unroll
                for (int e = 0; e < 8; ++e) acc[e] *= sc;
            }
            uint4 o; o.x = pk2(acc[0], acc[1]); o.y = pk2(acc[2], acc[3]); o.z = pk2(acc[4], acc[5]); o.w = pk2(acc[6], acc[7]);
            *(uint4*)(dst + (size_t)n * NRAW) = o;
        }
    }
}

typedef short bf16x8_t __attribute__((ext_vector_type(8)));
typedef float f32x16_t __attribute__((ext_vector_type(16)));
typedef unsigned u32x4_t __attribute__((ext_vector_type(4)));
#define MFMA32(a, b, c) __builtin_amdgcn_mfma_f32_32x32x16_bf16((a), (b), (c), 0, 0, 0)
__device__ __forceinline__ int crow(int reg, int h) { return (reg & 3) + 8 * (reg >> 2) + 4 * h; }
__device__ __forceinline__ int perm16(int a) { const int x = a & 15; return (a & ~15) + (x < 4 ? x : x < 8 ? x + 4 : x < 12 ? x - 4 : x); }
#define PACK8(x, s) __builtin_bit_cast(bf16x8_t, (u32x4_t){cvtpk((x)[8 * (s)], (x)[8 * (s) + 1]), cvtpk((x)[8 * (s) + 2], (x)[8 * (s) + 3]), cvtpk((x)[8 * (s) + 4], (x)[8 * (s) + 5]), cvtpk((x)[8 * (s) + 6], (x)[8 * (s) + 7])})
constexpr int GCH = 32, NCH = TOK / GCH;
constexpr int GP_ITEM = 4416;

__device__ void ph_gdnprep(const P& p, LASP unsigned char* lds, int l, int bid, int nblk, int tid) {
    const int lane = tid & 63, wave = tid >> 6, r = lane & 31, hh = lane >> 5;
    LASP float* Lm = (LASP float*)(lds + wave * 16384);
    LASP float* Xs = Lm + 2048;
    for (int it = bid * NWAVES + wave; it < BATCH * 4 * NCH; it += nblk * NWAVES) {
        const int c = it % NCH, bh = it / NCH, h = bh & 3, b = bh >> 2;
        const size_t row0 = (size_t)b * TOK + (size_t)c * GCH;
        f32x16_t KK, QK;
#pragma unroll
        for (int i = 0; i < 16; ++i) { KK[i] = 0.f; QK[i] = 0.f; }
        const bf16* kbase = p.qkvn + (row0 + r) * NRAW + 512 + h * 128 + 8 * hh;
        const bf16* qbase = p.qkvn + (row0 + r) * NRAW + h * 128 + 8 * hh;
#pragma unroll
        for (int s = 0; s < 8; ++s) {
            const bf16x8_t kf = *(const bf16x8_t*)(kbase + 16 * s), qf = *(const bf16x8_t*)(qbase + 16 * s);
            KK = MFMA32(kf, kf, KK);
            QK = MFMA32(qf, kf, QK);
        }
        float Gd, bd;
        {
            const bf16* ab = p.rest + (row0 + r) * NREST + RC_AB;
            const float a = bf2f(ab[hh * 4 + h]) + p.dt_bias[(l * 2 + hh) * 4 + h];
            const float sp = fmaxf(a, 0.f) + 0.6931471805599453f * __builtin_amdgcn_logf(1.f + __builtin_amdgcn_exp2f(-1.4426950408889634f * fabsf(a)));
            Gd = -__builtin_amdgcn_exp2f(1.4426950408889634f * p.a_log[(l * 2 + hh) * 4 + h]) * sp;
            bd = __builtin_amdgcn_rcpf(1.f + __builtin_amdgcn_exp2f(-1.4426950408889634f * bf2f(ab[(2 + hh) * 4 + h])));
        }
#pragma unroll
        for (int off = 1; off < 32; off <<= 1) {
            const float up = __shfl_up(Gd, off, 32), dn = __shfl_down(Gd, off, 32);
            if (hh == 0) { if (r >= off) Gd += up; } else { if (r + off < 32) Gd += dn; }
        }
        unsigned char* gout = (unsigned char*)p.raw + ((size_t)(bh * 2) * NCH + c) * GP_ITEM;
        {
            const float Glast = __shfl(Gd, hh == 0 ? 31 : 32);
            float* sc = (float*)(gout + (size_t)hh * NCH * GP_ITEM + 4096);
            sc[r] = __builtin_amdgcn_exp2f(1.4426950408889634f * Gd); sc[32 + r] = __builtin_amdgcn_exp2f(1.4426950408889634f * (Glast - Gd));
            if (r == 0) sc[64] = __builtin_amdgcn_exp2f(1.4426950408889634f * Glast);
        }
        asm volatile("s_waitcnt lgkmcnt(0)" ::: "memory");
        LASP unsigned short* qkt = (LASP unsigned short*)Xs;
        LASP float* bs = (LASP float*)(lds + 135168 + wave * 256);
        bs[lane] = bd;
#pragma unroll
        for (int d = 0; d < 2; ++d) {
            const float Gcol = __shfl(Gd, d * 32 + r);
#pragma unroll
            for (int i = 0; i < 16; ++i) {
                const int n = crow(i, hh);
                const float Grow = __shfl(Gd, d * 32 + n), brow = __shfl(bd, d * 32 + n);
                const bool incl = d == 0 ? (r <= n) : (r >= n), strict = d == 0 ? (r < n) : (r > n);
                const float dec = __builtin_amdgcn_exp2f((incl ? Grow - Gcol : 0.f) * 1.4426950408889634f);
                const float lv = strict ? brow * KK[i] * dec : 0.f;
                const float qv = incl ? QK[i] * dec : 0.f;
                const int n2 = d == 0 ? n : 31 - n, m2 = d == 0 ? r : 31 - r;
                Lm[(d * 32 + n2) * 32 + m2] = lv;
                qkt[(d * 32 + n) * 40 + perm16(r)] = f2bf(qv);
                if ((i & 3) == 3) __builtin_amdgcn_sched_barrier(0);
            }
        }
        asm volatile("s_waitcnt lgkmcnt(0)" ::: "memory");
#pragma unroll
        for (int d = 0; d < 2; ++d)
#pragma unroll
            for (int k = 0; k < 2; ++k) {
                const int q = lane + 64 * k, row = q >> 2, ch = q & 3;
                *(u32x4_t*)(gout + (size_t)d * NCH * GP_ITEM + 2048 + row * 64 + ch * 16) = *(const LASP u32x4_t*)((const LASP unsigned char*)qkt + (d * 32 + row) * 80 + ch * 16);
            }
        asm volatile("s_waitcnt lgkmcnt(0)" ::: "memory");
        {
            const LASP float* Lr = Lm + hh * 1024;
            LASP float* xc = Xs + lane;
#pragma unroll 1
            for (int nb = 0; nb < 8; ++nb) {
                float a[4];
#pragma unroll
                for (int k = 0; k < 4; ++k) a[k] = (4 * nb + k == r) ? 1.f : 0.f;
#pragma unroll 2
                for (int jb = 0; jb < nb; ++jb) {
                    const float x0 = xc[(4 * jb) * 64], x1 = xc[(4 * jb + 1) * 64], x2 = xc[(4 * jb + 2) * 64], x3 = xc[(4 * jb + 3) * 64];
#pragma unroll
                    for (int k = 0; k < 4; ++k) {
                        const f32x4_t lv = *(const LASP f32x4_t*)(Lr + (4 * nb + k) * 32 + 4 * jb);
                        a[k] -= (lv.x * x0 + lv.y * x1) + (lv.z * x2 + lv.w * x3);
                    }
                }
                const f32x4_t l1 = *(const LASP f32x4_t*)(Lr + (4 * nb + 1) * 32 + 4 * nb), l2 = *(const LASP f32x4_t*)(Lr + (4 * nb + 2) * 32 + 4 * nb), l3 = *(const LASP f32x4_t*)(Lr + (4 * nb + 3) * 32 + 4 * nb);
                a[1] -= l1.x * a[0];
                a[2] -= l2.x * a[0] + l2.y * a[1];
                a[3] -= (l3.x * a[0] + l3.y * a[1]) + l3.z * a[2];
#pragma unroll
                for (int k = 0; k < 4; ++k) xc[(4 * nb + k) * 64] = a[k];
                asm volatile("s_waitcnt lgkmcnt(0)" ::: "memory");
            }
        }
        asm volatile("s_waitcnt lgkmcnt(0)" ::: "memory");
#pragma unroll
        for (int d = 0; d < 2; ++d)
#pragma unroll
            for (int k = 0; k < 2; ++k) {
                const int q = lane + 64 * k, row = q >> 2, ch = q & 3;
                const int nn = d == 0 ? row : 31 - row;
                float v[8];
#pragma unroll
                for (int e = 0; e < 8; ++e) {
                    const int m = perm16(ch * 8 + e);
                    const int lidx = d == 0 ? m : 32 + 31 - m;
                    v[e] = Xs[nn * 64 + lidx] * bs[d * 32 + m];
                }
                *(u32x4_t*)(gout + (size_t)d * NCH * GP_ITEM + row * 64 + ch * 16) = (u32x4_t){cvtpk(v[0], v[1]), cvtpk(v[2], v[3]), cvtpk(v[4], v[5]), cvtpk(v[6], v[7])};
            }
        asm volatile("s_waitcnt lgkmcnt(0)" ::: "memory");
    }
}

constexpr int ST_KA = 0, ST_QA = 8704, ST_KN = 17408, ST_V = 27648, ST_TP = 37888, ST_QK = 40448, ST_GL = 43008, ST_BYTES = 43328;
constexpr int GDN_OST = 2 * ST_BYTES, GDN_OST_BYTES = 32 * 272;
typedef unsigned u32x2_t __attribute__((ext_vector_type(2)));
typedef short s16x4_t __attribute__((ext_vector_type(4)));
struct GSlot { u32x4_t k0, k1, q0, q1, v0, v1, t; f32x4_t sc; };

__device__ __forceinline__ int gdn_chunk(int dir, int s) { return dir == 0 ? s : (s < 8 ? 7 - s : 143 - s); }
__device__ __forceinline__ void gdn_issue(const P& p, GSlot& g, int b, int h, int dir, int step, int tl) {
    const int c = gdn_chunk(dir, step);
    const size_t row0 = (size_t)b * TOK + (size_t)c * GCH;
    const int r0 = tl >> 4, c16 = tl & 15;
    const bf16* a0 = p.qkvn + (row0 + r0) * NRAW + h * 128 + 8 * c16;
    const bf16* a1 = a0 + (size_t)16 * NRAW;
    g.q0 = *(const u32x4_t*)a0; g.q1 = *(const u32x4_t*)a1;
    g.k0 = *(const u32x4_t*)(a0 + 512); g.k1 = *(const u32x4_t*)(a1 + 512);
    g.v0 = *(const u32x4_t*)(a0 + 1024); g.v1 = *(const u32x4_t*)(a1 + 1024);
    const unsigned char* gp = (const unsigned char*)p.raw + ((size_t)((b * 4 + h) * 2 + dir) * NCH + c) * GP_ITEM;
    g.t = *(const u32x4_t*)(gp + tl * 16);
    g.sc = *(const f32x4_t*)(gp + 4096 + (tl < 20 ? tl : 0) * 16);
}
__device__ __forceinline__ u32x4_t scale8(u32x4_t x, float s) {
    return (u32x4_t){cvtpk(bflo(x.x) * s, bfhi(x.x) * s), cvtpk(bflo(x.y) * s, bfhi(x.y) * s), cvtpk(bflo(x.z) * s, bfhi(x.z) * s), cvtpk(bflo(x.w) * s, bfhi(x.w) * s)};
}
__device__ __forceinline__ void gdn_put_rows(LASP unsigned char* st, int row, int c16, u32x4_t kq, int off) {
    const int g = c16 >> 1, odd = c16 & 1;
    *(LASP u32x2_t*)(st + off + row * 272 + (16 * g + (odd ? 4 : 0)) * 2) = (u32x2_t){kq.x, kq.y};
    *(LASP u32x2_t*)(st + off + row * 272 + (16 * g + (odd ? 12 : 8)) * 2) = (u32x2_t){kq.z, kq.w};
}
__device__ __forceinline__ void gdn_write(LASP unsigned char* st, const GSlot& g, int tl) {
    const int r0 = tl >> 4, c16 = tl & 15;
    gdn_put_rows(st, r0, c16, g.k0, ST_KA); gdn_put_rows(st, r0 + 16, c16, g.k1, ST_KA);
    gdn_put_rows(st, r0, c16, g.q0, ST_QA); gdn_put_rows(st, r0 + 16, c16, g.q1, ST_QA);
    *(LASP u32x4_t*)(st + ST_KN + r0 * 320 + c16 * 16) = g.k0;
    *(LASP u32x4_t*)(st + ST_KN + (r0 + 16) * 320 + c16 * 16) = g.k1;
    *(LASP u32x4_t*)(st + ST_V + r0 * 320 + c16 * 16) = g.v0;
    *(LASP u32x4_t*)(st + ST_V + (r0 + 16) * 320 + c16 * 16) = g.v1;
    { const int t2 = tl & 127; *(LASP u32x4_t*)(st + (tl < 128 ? ST_TP : ST_QK) + (t2 >> 2) * 80 + (t2 & 3) * 16) = g.t; }
    if (tl < 20) *(LASP f32x4_t*)(st + ST_GL + tl * 16) = g.sc;
}
__device__ __forceinline__ void gdn_flush(const P& p, LASP unsigned char* lds, int b, int h, int dir, int step, int tl) {
    const int c = gdn_chunk(dir, step);
    const LASP unsigned char* ost = lds + GDN_OST + (step & 1) * GDN_OST_BYTES;
    bf16* op = p.oa + ((size_t)dir * ROWS + (size_t)b * TOK + (size_t)c * GCH) * 512 + h * 128;
#pragma unroll
    for (int k = 0; k < 2; ++k) { const int idx = tl + 256 * k, row = idx >> 4, ch = idx & 15; *(u32x4_t*)(op + (size_t)row * 512 + ch * 8) = *(const LASP u32x4_t*)(ost + row * 272 + ch * 16); }
}
__device__ __forceinline__ s16x4_t trd(const LASP unsigned char* q) {
    typedef short v4i16_t __attribute__((ext_vector_type(4)));
    return __builtin_bit_cast(s16x4_t, __builtin_amdgcn_ds_read_tr16_b64_v4i16((LASP v4i16_t*)q));
}
#define TRFRAG(base) __builtin_shufflevector(trd(base), trd((base) + 8 * 320), 0, 1, 2, 3, 4, 5, 6, 7)

#if TPROBE == 60
#define GDN_SYNC_C() do { unsigned long long t_ = __builtin_amdgcn_s_memrealtime(); __syncthreads(); if (chain == 0 && tid == 0) p.stats[2] += (float)(__builtin_amdgcn_s_memrealtime() - t_) * 0.01f; } while (0)
#define GDN_SYNC_L() __syncthreads()
#elif TPROBE == 61
#define GDN_SYNC_L() do { unsigned long long t_ = __builtin_amdgcn_s_memrealtime(); __syncthreads(); if (chain == 0 && tid == 256) p.stats[2] += (float)(__builtin_amdgcn_s_memrealtime() - t_) * 0.01f; } while (0)
#define GDN_SYNC_C() __syncthreads()
#else
#define GDN_SYNC_C() __syncthreads()
#define GDN_SYNC_L() __syncthreads()
#endif
__device__ void gdn_scan_fast(const P& p, LASP unsigned char* lds, int chain) {
    const int tid = mk_tid();
    const int lane = tid & 63, wave = __builtin_amdgcn_readfirstlane(tid >> 6);
    const int dir = chain & 1, h = (chain >> 1) & 3, b = chain >> 3;
    constexpr int NS = NCH;
    if (wave >= 4) {
        const int tl = tid - 256;
        GSlot g0, g1, g2, g3;
        gdn_issue(p, g0, b, h, dir, 0, tl); gdn_issue(p, g1, b, h, dir, 1, tl); gdn_issue(p, g2, b, h, dir, 2, tl); gdn_issue(p, g3, b, h, dir, 3, tl);
        gdn_write(lds, g0, tl); gdn_issue(p, g0, b, h, dir, 4, tl);
        __syncthreads();
#pragma unroll 1
        for (int s = 0; s < NS; s += 4) {
            if (s > 0) gdn_flush(p, lds, b, h, dir, s - 1, tl);
            gdn_write(lds + ((s + 1) & 1) * ST_BYTES, g1, tl); gdn_issue(p, g1, b, h, dir, min(s + 5, NS - 1), tl);
            GDN_SYNC_L();
            gdn_flush(p, lds, b, h, dir, s, tl);
            gdn_write(lds + ((s + 2) & 1) * ST_BYTES, g2, tl); gdn_issue(p, g2, b, h, dir, min(s + 6, NS - 1), tl);
            GDN_SYNC_L();
            gdn_flush(p, lds, b, h, dir, s + 1, tl);
            gdn_write(lds + ((s + 3) & 1) * ST_BYTES, g3, tl); gdn_issue(p, g3, b, h, dir, min(s + 7, NS - 1), tl);
            GDN_SYNC_L();
            gdn_flush(p, lds, b, h, dir, s + 2, tl);
            gdn_write(lds + ((s + 4) & 1) * ST_BYTES, g0, tl); gdn_issue(p, g0, b, h, dir, min(s + 8, NS - 1), tl);
            GDN_SYNC_L();
        }
        gdn_flush(p, lds, b, h, dir, NS - 1, tl);
    } else {
        const int r = lane & 31, hh = lane >> 5, w = wave;
        f32x16_t S0, S1, S2, S3;
#pragma unroll
        for (int i = 0; i < 16; ++i) { S0[i] = 0.f; S1[i] = 0.f; S2[i] = 0.f; S3[i] = 0.f; }
        const int troff = (4 * hh + ((lane & 15) >> 2)) * 320 + (16 * ((lane >> 4) & 1) + 4 * (lane & 3)) * 2;
        __syncthreads();
#pragma unroll 1
        for (int s = 0; s < NS; ++s) {
            LASP unsigned char* st = lds + (s & 1) * ST_BYTES;
            const LASP unsigned char* ka = st + ST_KA + r * 272 + hh * 16;
            const LASP unsigned char* qa = st + ST_QA + r * 272 + hh * 16;
            const bf16x8_t kA0 = *(const LASP bf16x8_t*)(ka), kA1 = *(const LASP bf16x8_t*)(ka + 32), kA2 = *(const LASP bf16x8_t*)(ka + 64), kA3 = *(const LASP bf16x8_t*)(ka + 96);
            const bf16x8_t kA4 = *(const LASP bf16x8_t*)(ka + 128), kA5 = *(const LASP bf16x8_t*)(ka + 160), kA6 = *(const LASP bf16x8_t*)(ka + 192), kA7 = *(const LASP bf16x8_t*)(ka + 224);
            const bf16x8_t qA0 = *(const LASP bf16x8_t*)(qa), qA1 = *(const LASP bf16x8_t*)(qa + 32), qA2 = *(const LASP bf16x8_t*)(qa + 64), qA3 = *(const LASP bf16x8_t*)(qa + 96);
            const bf16x8_t qA4 = *(const LASP bf16x8_t*)(qa + 128), qA5 = *(const LASP bf16x8_t*)(qa + 160), qA6 = *(const LASP bf16x8_t*)(qa + 192), qA7 = *(const LASP bf16x8_t*)(qa + 224);
            const LASP unsigned char* vbase = st + ST_V + troff + 64 * w;
            const bf16x8_t vB0 = TRFRAG(vbase), vB1 = TRFRAG(vbase + 16 * 320);
            const LASP unsigned char* tp = st + ST_TP + r * 80 + hh * 16;
            const bf16x8_t T0 = *(const LASP bf16x8_t*)(tp), T1 = *(const LASP bf16x8_t*)(tp + 32);
            const LASP unsigned char* qk = st + ST_QK + r * 80 + hh * 16;
            const bf16x8_t Q0 = *(const LASP bf16x8_t*)(qk), Q1 = *(const LASP bf16x8_t*)(qk + 32);
            const LASP float* sc = (const LASP float*)(st + ST_GL);
            const f32x4_t e0 = *(const LASP f32x4_t*)(sc + 4 * hh), e1 = *(const LASP f32x4_t*)(sc + 8 + 4 * hh), e2 = *(const LASP f32x4_t*)(sc + 16 + 4 * hh), e3 = *(const LASP f32x4_t*)(sc + 24 + 4 * hh);
            const f32x4_t f0 = *(const LASP f32x4_t*)(sc + 32 + 4 * hh), f1 = *(const LASP f32x4_t*)(sc + 40 + 4 * hh), f2 = *(const LASP f32x4_t*)(sc + 48 + 4 * hh), f3 = *(const LASP f32x4_t*)(sc + 56 + 4 * hh);
            const float gl = sc[64];
            __builtin_amdgcn_sched_barrier(0);
            f32x16_t ak, aq, vn;
#pragma unroll
            for (int i = 0; i < 16; ++i) { ak[i] = 0.f; aq[i] = 0.f; vn[i] = 0.f; }
            vn = MFMA32(T0, vB0, vn); vn = MFMA32(T1, vB1, vn);
#define GDN_KQ(KA, QA, SX, u) { const bf16x8_t SB = PACK8(SX, u); ak = MFMA32(KA, SB, ak); aq = MFMA32(QA, SB, aq); }
            GDN_KQ(kA0, qA0, S0, 0) GDN_KQ(kA1, qA1, S0, 1) GDN_KQ(kA2, qA2, S1, 0) GDN_KQ(kA3, qA3, S1, 1)
            GDN_KQ(kA4, qA4, S2, 0) GDN_KQ(kA5, qA5, S2, 1) GDN_KQ(kA6, qA6, S3, 0) GDN_KQ(kA7, qA7, S3, 1)
#undef GDN_KQ
            __builtin_amdgcn_sched_barrier(0);
            const LASP unsigned char* kn = st + ST_KN + troff;
            const bf16x8_t N00 = TRFRAG(kn), N01 = TRFRAG(kn + 16 * 320), N10 = TRFRAG(kn + 64), N11 = TRFRAG(kn + 64 + 16 * 320);
            const bf16x8_t N20 = TRFRAG(kn + 128), N21 = TRFRAG(kn + 128 + 16 * 320), N30 = TRFRAG(kn + 192), N31 = TRFRAG(kn + 192 + 16 * 320);
            __builtin_amdgcn_sched_barrier(0);
#define ROWSCALE(X, sgn) { X[0] *= sgn e0.x; X[1] *= sgn e0.y; X[2] *= sgn e0.z; X[3] *= sgn e0.w; X[4] *= sgn e1.x; X[5] *= sgn e1.y; X[6] *= sgn e1.z; X[7] *= sgn e1.w; \
                           X[8] *= sgn e2.x; X[9] *= sgn e2.y; X[10] *= sgn e2.z; X[11] *= sgn e2.w; X[12] *= sgn e3.x; X[13] *= sgn e3.y; X[14] *= sgn e3.z; X[15] *= sgn e3.w; }
            ROWSCALE(ak, -) ROWSCALE(aq, +)
#undef ROWSCALE
            const bf16x8_t ab0 = PACK8(ak, 0), ab1 = PACK8(ak, 1);
            vn = MFMA32(T0, ab0, vn); vn = MFMA32(T1, ab1, vn);
            S0 = S0 * gl; S1 = S1 * gl; S2 = S2 * gl; S3 = S3 * gl;
            const bf16x8_t vb0 = PACK8(vn, 0), vb1 = PACK8(vn, 1);
            f32x16_t vf;
            vf[0] = vn[0] * f0.x; vf[1] = vn[1] * f0.y; vf[2] = vn[2] * f0.z; vf[3] = vn[3] * f0.w; vf[4] = vn[4] * f1.x; vf[5] = vn[5] * f1.y; vf[6] = vn[6] * f1.z; vf[7] = vn[7] * f1.w;
            vf[8] = vn[8] * f2.x; vf[9] = vn[9] * f2.y; vf[10] = vn[10] * f2.z; vf[11] = vn[11] * f2.w; vf[12] = vn[12] * f3.x; vf[13] = vn[13] * f3.y; vf[14] = vn[14] * f3.z; vf[15] = vn[15] * f3.w;
            const bf16x8_t fb0 = PACK8(vf, 0), fb1 = PACK8(vf, 1);
            S0 = MFMA32(N00, fb0, S0); S1 = MFMA32(N10, fb0, S1); S2 = MFMA32(N20, fb0, S2); S3 = MFMA32(N30, fb0, S3);
            S0 = MFMA32(N01, fb1, S0); S1 = MFMA32(N11, fb1, S1); S2 = MFMA32(N21, fb1, S2); S3 = MFMA32(N31, fb1, S3);
            aq = MFMA32(Q0, vb0, aq); aq = MFMA32(Q1, vb1, aq);
            {
                LASP unsigned short* ost = (LASP unsigned short*)(lds + GDN_OST + (s & 1) * GDN_OST_BYTES) + 32 * w + r;
#pragma unroll
                for (int i = 0; i < 16; i += 2) { const unsigned pk = cvtpk(aq[i], aq[i + 1]); ost[crow(i, hh) * 136] = (unsigned short)pk; ost[(crow(i, hh) + 1) * 136] = (unsigned short)(pk >> 16); }
            }
            GDN_SYNC_C();
        }
    }
}

constexpr int GL_ITEM = 6272;
constexpr size_t GLA_PREP_OFF = (size_t)BATCH * 4 * 2 * NCH * GP_ITEM;

__device__ __forceinline__ void gla_prep_item(const P& p, LASP unsigned char* wl, const LASP float* cstab, int l, int it, int lane) {
    const int r = lane & 31, hh = lane >> 5;
    const int c = it % NCH, bh = it / NCH, h = bh & 3, b = bh >> 2;
    const size_t row0 = (size_t)b * TOK + (size_t)c * GCH;
    float qv[16], kv[16];
    {
        const bf16* qb = p.rest + (row0 + 4 * hh) * NREST + RC_CQ + h * 32 + r;
#pragma unroll
        for (int i = 0; i < 16; ++i) { const int no = (i & 3) + 8 * (i >> 2); qv[i] = bf2f(qb[(size_t)no * NREST]); kv[i] = bf2f(qb[(size_t)no * NREST + 128]); }
    }
    if (c >= 8) {
        const int dd = r & 15, f = dd & 7;
        const int prow = (c - 8) >> 1, pcol0 = 32 * ((c - 8) & 1);
#pragma unroll
        for (int i = 0; i < 16; ++i) {
            const int n = crow(i, hh);
            const int pos = r < 16 ? prow : pcol0 + n;
            const float cs = cstab[(pos * 8 + f) * 2], sn = cstab[(pos * 8 + f) * 2 + 1];
            const float qp = __shfl_xor(qv[i], 8), kp = __shfl_xor(kv[i], 8);
            if (dd < 8) { qv[i] = qv[i] * cs - qp * sn; kv[i] = kv[i] * cs - kp * sn; }
            else { qv[i] = qp * sn + qv[i] * cs; kv[i] = kp * sn + kv[i] * cs; }
        }
    }
#pragma unroll
    for (int i = 0; i < 16; ++i) qv[i] *= 0.17677669529663687f;
#pragma unroll 1
    for (int dir = 0; dir < 2; ++dir) {
        f32x16_t X;
#pragma unroll
        for (int i = 0; i < 16; ++i) X[i] = 0.f;
        {
            const bf16x8_t A = *(const bf16x8_t*)(p.rest + (row0 + r) * NREST + RC_CR + dir * 16 + 8 * hh);
            const float* w2p = p.gla_w2 + ((size_t)(l * 2 + dir) * 16 + 8 * hh) * 128 + h * 32 + r;
            const bf16x8_t Bf = __builtin_bit_cast(bf16x8_t, (u32x4_t){cvtpk(w2p[0], w2p[128]), cvtpk(w2p[256], w2p[384]), cvtpk(w2p[512], w2p[640]), cvtpk(w2p[768], w2p[896])});
            X = MFMA32(A, Bf, X);
        }
        const float b2v = p.gla_b2[(l * 2 + dir) * 128 + h * 32 + r];
        float Bc[16];
#pragma unroll
        for (int i = 0; i < 16; ++i) { const float xg = X[i] + b2v; Bc[i] = (fminf(xg, 0.f) - 0.6931471805599453f * __builtin_amdgcn_logf(1.f + __builtin_amdgcn_exp2f(-1.4426950408889634f * fabsf(xg)))) * (1.f / 16.f); }
        float tot;
        {
            float sg[4], ps[4];
#pragma unroll
            for (int g = 0; g < 4; ++g) { sg[g] = (Bc[4 * g] + Bc[4 * g + 1]) + (Bc[4 * g + 2] + Bc[4 * g + 3]); ps[g] = __shfl_xor(sg[g], 32); }
            tot = ((sg[0] + ps[0]) + (sg[1] + ps[1])) + ((sg[2] + ps[2]) + (sg[3] + ps[3]));
            if (dir == 0) {
                float base = 0.f;
#pragma unroll
                for (int g = 0; g < 4; ++g) {
                    float o = base + (hh ? ps[g] : 0.f);
#pragma unroll
                    for (int k = 0; k < 4; ++k) { o += Bc[4 * g + k]; Bc[4 * g + k] = o; }
                    base += sg[g] + ps[g];
                }
            } else {
                float base = 0.f;
#pragma unroll
                for (int g = 3; g >= 0; --g) {
                    float o = base + (hh ? 0.f : ps[g]);
#pragma unroll
                    for (int k = 3; k >= 0; --k) { o += Bc[4 * g + k]; Bc[4 * g + k] = o; }
                    base += sg[g] + ps[g];
                }
            }
        }
        unsigned char* gout = (unsigned char*)p.raw + GLA_PREP_OFF + ((size_t)(bh * 2 + dir) * NCH + c) * GL_ITEM;
        LASP bf16* ql = (LASP bf16*)wl;
        LASP bf16* kl = ql + 32 * 40;
        {
            bf16* qpo = (bf16*)gout + perm16(r);
            bf16* kdo = (bf16*)(gout + 4096) + r * 32;
#pragma unroll
            for (int g = 0; g < 4; ++g) {
                float kd[4];
#pragma unroll
                for (int k = 0; k < 4; ++k) {
                    const int i = 4 * g + k, n = crow(i, hh);
                    const float eb = __builtin_amdgcn_exp2f(1.4426950408889634f * Bc[i]);
                    const float qs = qv[i] * eb, ks = kv[i] * __builtin_amdgcn_rcpf(eb);
                    kd[k] = kv[i] * __builtin_amdgcn_exp2f(1.4426950408889634f * (tot - Bc[i]));
                    const bf16 qsb = f2bf(qs);
                    qpo[n * 32] = qsb;
                    ql[n * 40 + r] = qsb; kl[n * 40 + r] = f2bf(ks);
                }
                *(u32x2_t*)(kdo + perm16(8 * g + 4 * hh)) = (u32x2_t){cvtpk(kd[0], kd[1]), cvtpk(kd[2], kd[3])};
            }
            if (hh == 0) ((float*)(gout + 6144))[r] = __builtin_amdgcn_exp2f(1.4426950408889634f * tot);
        }
        asm volatile("s_waitcnt lgkmcnt(0)" ::: "memory");
        f32x16_t AT;
#pragma unroll
        for (int i = 0; i < 16; ++i) AT[i] = 0.f;
        AT = MFMA32(*(const LASP bf16x8_t*)((const LASP unsigned char*)kl + r * 80 + hh * 16), *(const LASP bf16x8_t*)((const LASP unsigned char*)ql + r * 80 + hh * 16), AT);
        AT = MFMA32(*(const LASP bf16x8_t*)((const LASP unsigned char*)kl + r * 80 + hh * 16 + 32), *(const LASP bf16x8_t*)((const LASP unsigned char*)ql + r * 80 + hh * 16 + 32), AT);
        {
            bf16* amo = (bf16*)(gout + 2048) + r * 32;
#pragma unroll
            for (int g = 0; g < 4; ++g) {
                float a[4];
#pragma unroll
                for (int k = 0; k < 4; ++k) { const int m = crow(4 * g + k, hh); const bool keep = dir == 0 ? (m <= r) : (m >= r); a[k] = keep ? AT[4 * g + k] : 0.f; }
                *(u32x2_t*)(amo + perm16(8 * g + 4 * hh)) = (u32x2_t){cvtpk(a[0], a[1]), cvtpk(a[2], a[3])};
            }
        }
        asm volatile("s_waitcnt lgkmcnt(0)" ::: "memory");
    }
}

constexpr int LS_QP = 0, LS_AM = 2560, LS_KD = 5120, LS_V = 7680, LS_GL = 13824, LS_BYTES = 13952;
constexpr int GLA_OST = 4 * LS_BYTES, GLA_OST_BYTES = 32 * 144;
struct LSlot { u32x4_t a0, a1, a2, v0, v1; f32x4_t gl; };
__device__ __forceinline__ void gla_issue(const P& p, LSlot& g, int b, int h, int dir, int step, int t2) {
    const int c = gdn_chunk(dir, step);
    const unsigned char* gp = (const unsigned char*)p.raw + GLA_PREP_OFF + ((size_t)((b * 4 + h) * 2 + dir) * NCH + c) * GL_ITEM;
    g.a0 = *(const u32x4_t*)(gp + t2 * 16); g.a1 = *(const u32x4_t*)(gp + 2048 + t2 * 16); g.a2 = *(const u32x4_t*)(gp + 4096 + t2 * 16);
    g.gl = *(const f32x4_t*)(gp + 6144 + (t2 < 8 ? t2 : 0) * 16);
    const size_t row0 = (size_t)b * TOK + (size_t)c * GCH;
    const bf16* vp = p.rest + (row0 + (t2 >> 3)) * NREST + RC_CV + h * 64 + 8 * (t2 & 7);
    g.v0 = *(const u32x4_t*)vp; g.v1 = *(const u32x4_t*)(vp + (size_t)16 * NREST);
}
__device__ __forceinline__ void gla_write(LASP unsigned char* st, const LSlot& g, int t2) {
    const int row = t2 >> 2, ch = t2 & 3;
    *(LASP u32x4_t*)(st + LS_QP + row * 80 + ch * 16) = g.a0;
    *(LASP u32x4_t*)(st + LS_AM + row * 80 + ch * 16) = g.a1;
    *(LASP u32x4_t*)(st + LS_KD + row * 80 + ch * 16) = g.a2;
    if (t2 < 8) *(LASP f32x4_t*)(st + LS_GL + t2 * 16) = g.gl;
    *(LASP u32x4_t*)(st + LS_V + (t2 >> 3) * 192 + (t2 & 7) * 16) = g.v0; *(LASP u32x4_t*)(st + LS_V + (16 + (t2 >> 3)) * 192 + (t2 & 7) * 16) = g.v1;
}
__device__ __forceinline__ void gla_flush(const P& p, LASP unsigned char* lds, int b, int h, int dir, int step, int t2) {
    const int c = gdn_chunk(dir, step);
    const LASP unsigned char* ost = lds + GLA_OST + (dir * 2 + (step & 1)) * GLA_OST_BYTES;
    bf16* op = p.oc + ((size_t)dir * ROWS + (size_t)b * TOK + (size_t)c * GCH) * 256 + h * 64;
#pragma unroll
    for (int k = 0; k < 2; ++k) { const int idx = t2 + 128 * k, row = idx >> 3, ch = idx & 7; *(u32x4_t*)(op + (size_t)row * 256 + ch * 8) = *(const LASP u32x4_t*)(ost + row * 144 + ch * 16); }
}
#if TPROBE == 62
#define GLA_SYNC_C() do { unsigned long long t_ = __builtin_amdgcn_s_memrealtime(); __syncthreads(); if (bh == 0 && tid == 0) p.stats[2] += (float)(__builtin_amdgcn_s_memrealtime() - t_) * 0.01f; } while (0)
#define GLA_SYNC_L() __syncthreads()
#elif TPROBE == 63
#define GLA_SYNC_L() do { unsigned long long t_ = __builtin_amdgcn_s_memrealtime(); __syncthreads(); if (bh == 0 && tid == 256) p.stats[2] += (float)(__builtin_amdgcn_s_memrealtime() - t_) * 0.01f; } while (0)
#define GLA_SYNC_C() __syncthreads()
#else
#define GLA_SYNC_C() __syncthreads()
#define GLA_SYNC_L() __syncthreads()
#endif
__device__ void gla_scan_fast(const P& p, LASP unsigned char* lds, int bh) {
    const int tid = mk_tid();
    const int lane = tid & 63, wave = __builtin_amdgcn_readfirstlane(tid >> 6);
    const int h = bh & 3, b = bh >> 2;
    constexpr int NS = NCH;
    if (wave >= 4) {
        const int dir = (wave - 4) >> 1, t2 = tid & 127;
        LASP unsigned char* base = lds + dir * 2 * LS_BYTES;
        LSlot g0, g1, g2, g3;
        gla_issue(p, g0, b, h, dir, 0, t2); gla_issue(p, g1, b, h, dir, 1, t2); gla_issue(p, g2, b, h, dir, 2, t2); gla_issue(p, g3, b, h, dir, 3, t2);
        gla_write(base, g0, t2); gla_issue(p, g0, b, h, dir, 4, t2);
        __syncthreads();
#pragma unroll 1
        for (int s = 0; s < NS; s += 4) {
            if (s > 0) gla_flush(p, lds, b, h, dir, s - 1, t2);
            gla_write(base + ((s + 1) & 1) * LS_BYTES, g1, t2); gla_issue(p, g1, b, h, dir, min(s + 5, NS - 1), t2);
            GLA_SYNC_L();
            gla_flush(p, lds, b, h, dir, s, t2);
            gla_write(base + ((s + 2) & 1) * LS_BYTES, g2, t2); gla_issue(p, g2, b, h, dir, min(s + 6, NS - 1), t2);
            GLA_SYNC_L();
            gla_flush(p, lds, b, h, dir, s + 1, t2);
            gla_write(base + ((s + 3) & 1) * LS_BYTES, g3, t2); gla_issue(p, g3, b, h, dir, min(s + 7, NS - 1), t2);
            GLA_SYNC_L();
            gla_flush(p, lds, b, h, dir, s + 2, t2);
            gla_write(base + ((s + 4) & 1) * LS_BYTES, g0, t2); gla_issue(p, g0, b, h, dir, min(s + 8, NS - 1), t2);
            GLA_SYNC_L();
        }
        gla_flush(p, lds, b, h, dir, NS - 1, t2);
    } else {
        const int r = lane & 31, hh = lane >> 5, dir = wave >> 1, blk = wave & 1;
        LASP unsigned char* base = lds + dir * 2 * LS_BYTES;
        f32x16_t S;
#pragma unroll
        for (int i = 0; i < 16; ++i) S[i] = 0.f;
        __syncthreads();
        const int troff = (4 * hh + ((lane & 15) >> 2)) * 192 + (16 * ((lane >> 4) & 1) + 4 * (lane & 3)) * 2 + 64 * blk;
#define TRFRAG192(bs) __builtin_shufflevector(trd(bs), trd((bs) + 8 * 192), 0, 1, 2, 3, 4, 5, 6, 7)
#pragma unroll 1
        for (int s = 0; s < NS; ++s) {
            const LASP unsigned char* st = base + (s & 1) * LS_BYTES;
#if TPROBE == 64 || TPROBE == 65
            const unsigned long long ttop_ = __builtin_amdgcn_s_memrealtime();
            __builtin_amdgcn_sched_barrier(0);
#endif
            const LASP unsigned char* qp = st + LS_QP + r * 80 + hh * 16;
            const LASP unsigned char* am = st + LS_AM + r * 80 + hh * 16;
            const LASP unsigned char* kd = st + LS_KD + r * 80 + hh * 16;
            const bf16x8_t QP0 = *(const LASP bf16x8_t*)(qp), QP1 = *(const LASP bf16x8_t*)(qp + 32);
            const bf16x8_t AM0 = *(const LASP bf16x8_t*)(am), AM1 = *(const LASP bf16x8_t*)(am + 32);
            const bf16x8_t KD0 = *(const LASP bf16x8_t*)(kd), KD1 = *(const LASP bf16x8_t*)(kd + 32);
            const LASP unsigned char* vb = st + LS_V + troff;
            const bf16x8_t V0 = TRFRAG192(vb), V1 = TRFRAG192(vb + 16 * 192);
            const LASP float* glp = (const LASP float*)(st + LS_GL);
            const f32x4_t g0 = *(const LASP f32x4_t*)(glp + 4 * hh), g1 = *(const LASP f32x4_t*)(glp + 8 + 4 * hh), g2 = *(const LASP f32x4_t*)(glp + 16 + 4 * hh), g3 = *(const LASP f32x4_t*)(glp + 24 + 4 * hh);
            __builtin_amdgcn_sched_barrier(0);
#if TPROBE == 64 || TPROBE == 65
            asm volatile("s_waitcnt lgkmcnt(0)" ::: "memory");
            const unsigned long long tmid_ = __builtin_amdgcn_s_memrealtime();
            if (TPROBE == 64 && bh == 0 && tid == 0) p.stats[2] += (float)(tmid_ - ttop_) * 0.01f;
            __builtin_amdgcn_sched_barrier(0);
#endif
            const bf16x8_t Sb0 = PACK8(S, 0), Sb1 = PACK8(S, 1);
            f32x16_t oT;
#pragma unroll
            for (int i = 0; i < 16; ++i) oT[i] = 0.f;
            oT = MFMA32(V0, AM0, oT); oT = MFMA32(V1, AM1, oT);
            oT = MFMA32(Sb0, QP0, oT); oT = MFMA32(Sb1, QP1, oT);
            S[0] *= g0.x; S[1] *= g0.y; S[2] *= g0.z; S[3] *= g0.w; S[4] *= g1.x; S[5] *= g1.y; S[6] *= g1.z; S[7] *= g1.w;
            S[8] *= g2.x; S[9] *= g2.y; S[10] *= g2.z; S[11] *= g2.w; S[12] *= g3.x; S[13] *= g3.y; S[14] *= g3.z; S[15] *= g3.w;
            S = MFMA32(KD0, V0, S);
            S = MFMA32(KD1, V1, S);
            {
                LASP unsigned char* ost = lds + GLA_OST + (dir * 2 + (s & 1)) * GLA_OST_BYTES + r * 144 + (32 * blk + 4 * hh) * 2;
#pragma unroll
                for (int g = 0; g < 4; ++g) *(LASP u32x2_t*)(ost + 16 * g) = (u32x2_t){cvtpk(oT[4 * g], oT[4 * g + 1]), cvtpk(oT[4 * g + 2], oT[4 * g + 3])};
            }
#if TPROBE == 65
            __builtin_amdgcn_sched_barrier(0);
            asm volatile("s_nop 15\n\ts_nop 15" ::: "memory");
            if (bh == 0 && tid == 0) p.stats[2] += (float)(__builtin_amdgcn_s_memrealtime() - tmid_) * 0.01f;
#endif
            GLA_SYNC_C();
        }
    }
}


__device__ __forceinline__ void vf_item(const P& p, LASP unsigned char* wl, int it, int lane) {
    const int r = lane & 31, hh = lane >> 5;
    const int kb = it % NCH, bh = it / NCH, h = bh & 3, b = bh >> 2;
    const bf16* vp = p.rest + ((size_t)b * TOK + 32 * kb + r) * NREST + RC_BV + h * 64 + 32 * hh;
#pragma unroll
    for (int q = 0; q < 4; ++q) *(LASP u32x4_t*)(wl + r * 192 + (32 * hh + 8 * q) * 2) = *(const u32x4_t*)(vp + 8 * q);
    asm volatile("s_waitcnt lgkmcnt(0)" ::: "memory");
    const int troff = (4 * hh + ((lane & 15) >> 2)) * 192 + (16 * ((lane >> 4) & 1) + 4 * (lane & 3)) * 2;
    bf16* op = p.vf + ((size_t)(bh * NCH + kb) * 4) * 512 + lane * 8;
#pragma unroll
    for (int dvb = 0; dvb < 2; ++dvb)
#pragma unroll
        for (int u = 0; u < 2; ++u) {
            const LASP unsigned char* bs = wl + troff + 64 * dvb + (16 * u) * 192;
            const bf16x8_t f = __builtin_shufflevector(trd(bs), trd(bs + 8 * 192), 0, 1, 2, 3, 4, 5, 6, 7);
            *(bf16x8_t*)(op + (dvb * 2 + u) * 512) = f;
        }
    asm volatile("s_waitcnt lgkmcnt(0)" ::: "memory");
}

__device__ __forceinline__ void na_item(const P& p, const LASP float* rpbL, int it, int lane) {
    const int r = lane & 31, hh = lane >> 5;
    int b, h, ry, qb; bool lat;
    if (it < 4096) { lat = true; qb = it & 1; ry = (it >> 1) & 63; h = (it >> 7) & 3; b = it >> 9; }
    else { const int j = it - 4096; lat = false; qb = j & 7; h = (j >> 3) & 3; b = j >> 5; ry = 0; }
    const size_t brow = (size_t)b * TOK;
    const int q0 = lat ? CTX + ry * 64 + qb * 32 : qb * 32;
    bf16* qp = p.rest + (brow + q0 + r) * NREST + RC_BQ + h * 64;
    bf16x8_t Qf0 = *(const bf16x8_t*)(qp + 8 * hh), Qf1 = *(const bf16x8_t*)(qp + 16 + 8 * hh), Qf2 = *(const bf16x8_t*)(qp + 32 + 8 * hh), Qf3 = *(const bf16x8_t*)(qp + 48 + 8 * hh);
    f32x16_t O0, O1;
#pragma unroll
    for (int i = 0; i < 16; ++i) { O0[i] = 0.f; O1[i] = 0.f; }
    float m = -1e30f, lsum = 0.f;
    const bf16* kfb = p.kf + ((size_t)(b * 4 + h) * NCH) * 2048 + lane * 8;
    const bf16* vfb = p.vf + ((size_t)(b * 4 + h) * NCH) * 2048 + lane * 8;
    const int nkb = lat ? 24 : 8;
    const int c = qb * 32 + r, c0 = min(max(c - 8, 0), 48), r0 = min(max(ry - 4, 0), 56);
    constexpr float SC = 0.125f * 1.4426950408889634f;
    struct KV { bf16x8_t k0, k1, k2, k3, v00, v01, v10, v11; };
    KV fA, fB;
#define NA_KBIDX(kq) ((kq) < 8 ? (kq) : 8 + (r0 + (((kq) - 8) >> 1)) * 2 + (((kq) - 8) & 1))
#define NA_LOAD(F, kq) { const size_t o_ = (size_t)NA_KBIDX(min((kq), nkb - 1)) * 2048; const bf16* kp = kfb + o_; const bf16* vp = vfb + o_; \
        F.k0 = *(const bf16x8_t*)(kp); F.k1 = *(const bf16x8_t*)(kp + 512); F.k2 = *(const bf16x8_t*)(kp + 1024); F.k3 = *(const bf16x8_t*)(kp + 1536); \
        F.v00 = *(const bf16x8_t*)(vp); F.v01 = *(const bf16x8_t*)(vp + 512); F.v10 = *(const bf16x8_t*)(vp + 1024); F.v11 = *(const bf16x8_t*)(vp + 1536); }
    NA_LOAD(fA, 0) NA_LOAD(fB, 1)
#define NA_BLOCK(F, kq) { \
        const int kb_ = (kq); int ky = 0, cb = 0; const bool win = kb_ >= 8; \
        if (win) { const int w_ = kb_ - 8; ky = r0 + (w_ >> 1); cb = w_ & 1; } \
        f32x16_t S; _Pragma("unroll") for (int i = 0; i < 16; ++i) S[i] = 0.f; \
        S = MFMA32(F.k0, Qf0, S); S = MFMA32(F.k1, Qf1, S); S = MFMA32(F.k2, Qf2, S); S = MFMA32(F.k3, Qf3, S); \
        const bf16x8_t V00 = F.v00, V01 = F.v01, V10 = F.v10, V11 = F.v11; \
        NA_LOAD(F, kb_ + 2) \
        float bm = -1e30f; \
        if (win) { \
            const LASP float* rb = rpbL + (h * 15 + (ky - ry + 7)) * 31 + 15 - c; \
            _Pragma("unroll") for (int i = 0; i < 16; ++i) { \
                const int kc = cb * 32 + crow(i, hh); \
                const bool valid = (kc >= c0) && (kc < c0 + 16); \
                const float bias = rb[valid ? kc : c]; \
                S[i] = valid ? S[i] * SC + bias : -1e30f; \
                bm = fmaxf(bm, S[i]); } \
        } else { _Pragma("unroll") for (int i = 0; i < 16; ++i) { S[i] *= SC; bm = fmaxf(bm, S[i]); } } \
        bm = fmaxf(bm, __shfl_xor(bm, 32)); \
        const float mn = fmaxf(m, bm); \
        const float alpha = __builtin_amdgcn_exp2f(m - mn); \
        m = mn; \
        float ps = 0.f; \
        _Pragma("unroll") for (int i = 0; i < 16; ++i) { S[i] = __builtin_amdgcn_exp2f(S[i] - mn); ps += S[i]; } \
        lsum = lsum * alpha + ps; \
        _Pragma("unroll") for (int i = 0; i < 16; ++i) { O0[i] *= alpha; O1[i] *= alpha; } \
        const bf16x8_t Pb0 = PACK8(S, 0), Pb1 = PACK8(S, 1); \
        O0 = MFMA32(V00, Pb0, O0); O0 = MFMA32(V01, Pb1, O0); \
        O1 = MFMA32(V10, Pb0, O1); O1 = MFMA32(V11, Pb1, O1); }
#pragma unroll 1
    for (int kb = 0; kb < nkb; kb += 2) { NA_BLOCK(fA, kb) NA_BLOCK(fB, kb + 1) }
#undef NA_BLOCK
#undef NA_LOAD
#undef NA_KBIDX
    const float inv = 1.f / (lsum + __shfl_xor(lsum, 32));
    bf16* op = qp + 4 * hh;
#pragma unroll
    for (int g = 0; g < 4; ++g) {
        *(u32x2_t*)(op + 8 * g) = (u32x2_t){cvtpk(O0[4 * g] * inv, O0[4 * g + 1] * inv), cvtpk(O0[4 * g + 2] * inv, O0[4 * g + 3] * inv)};
        *(u32x2_t*)(op + 32 + 8 * g) = (u32x2_t){cvtpk(O1[4 * g] * inv, O1[4 * g + 1] * inv), cvtpk(O1[4 * g + 2] * inv, O1[4 * g + 3] * inv)};
    }
}

__device__ void ph_prep_early(const P& p, LASP unsigned char* lds, int l, int bid, int nblk) {
    const int tid = mk_tid();
    const int lane = tid & 63, wave = tid >> 6;
    for (int it = bid * NWAVES + wave; it < BATCH * 4 * NCH; it += nblk * NWAVES) vf_item(p, lds + wave * 16384, it, lane);
}
__device__ void ph_prep(const P& p, LASP unsigned char* lds, int l, int bid, int nblk) {
    const int tid = mk_tid();
    LASP float* cstab = (LASP float*)(lds + 131072);
    {
        const int pos = tid >> 3, f = tid & 7;
        const float ang = (float)pos * powf(10000.f, -(float)f / 8.f);
        cstab[tid * 2] = cosf(ang); cstab[tid * 2 + 1] = sinf(ang);
    }
    __syncthreads();
    ph_gdnprep(p, lds, l, bid, nblk, tid);
    const int lane = tid & 63, wave = tid >> 6;
    for (int it = (nblk - 1 - bid) * NWAVES + wave; it < BATCH * 4 * NCH; it += nblk * NWAVES) gla_prep_item(p, lds + wave * 16384, cstab, l, it, lane);
}

__device__ void ph_mix(const P& p, LASP unsigned char* lds, int l, int bid, int nblk) {
    constexpr int NGDN = BATCH * 4 * 2;
    constexpr int NGLA = BATCH * 4;
    if (bid < NGDN) { gdn_scan_fast(p, lds, bid); return; }
    if (bid < NGDN + NGLA) { gla_scan_fast(p, lds, bid - NGDN); return; }
    const int tid = mk_tid();
    const int lane = tid & 63, wave = tid >> 6;
    LASP float* rpbL = (LASP float*)lds;
    for (int i = tid; i < 4 * 15 * 31; i += NTHREADS) rpbL[i] = p.rpb[(size_t)l * 4 * 15 * 31 + i] * 1.4426950408889634f;
    __syncthreads();
    const int total = 4096 + (l == 0 ? 256 : 0);
    for (int it = (bid - NGDN - NGLA) * NWAVES + wave; it < total; it += (nblk - NGDN - NGLA) * NWAVES) na_item(p, rpbL, it, lane);
}

__device__ void ph_gate(const P& p, int l, int bid, int nblk) {
    const int tid = mk_tid();
    const int tq = tid & 127, rsub = tid >> 7;
    const int kind = tq < 64 ? 0 : (tq < 96 ? 1 : 2);
    const int cb = kind == 0 ? tq * 8 : (kind == 1 ? (tq - 64) * 8 : (tq - 96) * 8);
    const int zoff = kind == 0 ? RC_AZ + cb : (kind == 1 ? RC_BZ + cb : RC_CZ + cb);
    const int oc = kind == 0 ? cb : (kind == 1 ? 512 + cb : 768 + cb);
    float nw[8];
#pragma unroll
    for (int e = 0; e < 8; ++e) nw[e] = kind == 0 ? p.gdn_norm[l * 128 + ((cb + e) & 127)] : (kind == 2 ? p.gla_norm[l * 64 + ((cb + e) & 63)] : 1.f);
    for (int r0 = bid * 16; r0 < ROWS; r0 += nblk * 16) {
        uint4 a[4], bb[4], zz[4];
#pragma unroll
        for (int j = 0; j < 4; ++j) {
            const size_t r = (size_t)(r0 + rsub + 4 * j);
            const bf16* pr = p.rest + r * NREST;
            zz[j] = *(const uint4*)(pr + zoff);
            if (kind == 0) { a[j] = *(const uint4*)(p.oa + r * 512 + cb); bb[j] = *(const uint4*)(p.oa + ((size_t)ROWS + r) * 512 + cb); }
            else if (kind == 1) { a[j] = *(const uint4*)(pr + RC_BQ + cb); bb[j] = make_uint4(0, 0, 0, 0); }
            else { a[j] = *(const uint4*)(p.oc + r * 256 + cb); bb[j] = *(const uint4*)(p.oc + ((size_t)ROWS + r) * 256 + cb); }
        }
#pragma unroll
        for (int j = 0; j < 4; ++j) {
            float fa[8], fb[8], z[8], o[8];
            unpack8(a[j], fa); unpack8(bb[j], fb); unpack8(zz[j], z);
            float ss = 0.f;
#pragma unroll
            for (int e = 0; e < 8; ++e) { o[e] = fa[e] + fb[e]; ss += o[e] * o[e]; }
            float rs = 1.f;
            if (kind == 0) {
#pragma unroll
                for (int m = 8; m > 0; m >>= 1) ss += __shfl_xor(ss, m);
                rs = __builtin_amdgcn_rsqf(ss * (1.f / 128.f) + 1e-6f);
            } else if (kind == 2) {
#pragma unroll
                for (int m = 4; m > 0; m >>= 1) ss += __shfl_xor(ss, m);
                rs = __builtin_amdgcn_rsqf(ss * (1.f / 64.f) + 1e-6f);
            }
            float res[8];
#pragma unroll
            for (int e = 0; e < 8; ++e) res[e] = o[e] * rs * nw[e] * silu_f(z[e]);
            uint4 w; w.x = pk2(res[0], res[1]); w.y = pk2(res[2], res[3]); w.z = pk2(res[4], res[5]); w.w = pk2(res[6], res[7]);
            *(uint4*)(p.mix + (size_t)(r0 + rsub + 4 * j) * D + oc) = w;
        }
    }
}

#if PROBE
__device__ void gdn_scan_naive(const P& p, LASP float* sm, int l, int b, int hp, bf16* nb) {
    const int tid = mk_tid();
    LASP float* skq = sm;
    LASP float* sv = sm + 4 * 16 * 256;
    LASP float* sg = sv + 4 * 16 * 128;
    LASP float* sb = sg + 64;
    const int sub = tid >> 7, col = tid & 127, dir = sub & 1, h = hp * 2 + (sub >> 1);
    float S[128];
#pragma unroll
    for (int i = 0; i < 128; ++i) S[i] = 0.f;
    for (int s0 = 0; s0 < TOK; s0 += 16) {
        __syncthreads();
        for (int i = tid; i < 4 * 16 * 48; i += NTHREADS) {
            const int su = i / (16 * 48), rem = i % (16 * 48), j = rem / 48, chunk = rem % 48;
            const int sd = su & 1, hh = hp * 2 + (su >> 1);
            const int t = tok_of(sd, s0 + j);
            const size_t row = (size_t)b * TOK + t;
            const int part = chunk >> 4, c8 = chunk & 15;
            const uint4 w = *(const uint4*)(p.qkvn + row * NRAW + part * 512 + hh * 128 + c8 * 8);
            float f[8]; unpack8(w, f);
            LASP float* dst = (part < 2) ? skq + (su * 16 + j) * 256 + part * 128 + c8 * 8 : sv + (su * 16 + j) * 128 + c8 * 8;
#pragma unroll
            for (int e = 0; e < 8; ++e) dst[e] = f[e];
        }
        if (tid < 64) {
            const int su = tid >> 4, j = tid & 15, sd = su & 1, hh = hp * 2 + (su >> 1);
            const int t = tok_of(sd, s0 + j);
            const bf16* ab = p.rest + ((size_t)b * TOK + t) * NREST + RC_AB;
            const float a = bf2f(ab[sd * 4 + hh]) + p.dt_bias[(l * 2 + sd) * 4 + hh];
            const float sp = fmaxf(a, 0.f) + log1pf(expf(-fabsf(a)));
            const float g = -expf(p.a_log[(l * 2 + sd) * 4 + hh]) * sp;
            sg[su * 16 + j] = expf(g);
            const float bx = bf2f(ab[(2 + sd) * 4 + hh]);
            sb[su * 16 + j] = 1.f / (1.f + expf(-bx));
        }
        __syncthreads();
#pragma unroll 1
        for (int j = 0; j < 16; ++j) {
            const LASP float* qp = skq + (sub * 16 + j) * 256;
            const LASP float* kp = qp + 128;
            const float dec = sg[sub * 16 + j], bt = sb[sub * 16 + j];
            const float v = sv[(sub * 16 + j) * 128 + col];
            float d0 = 0.f, d1 = 0.f, d2 = 0.f, d3 = 0.f;
#pragma unroll
            for (int k4 = 0; k4 < 32; ++k4) {
                const f32x4_t kv = *(const LASP f32x4_t*)(kp + k4 * 4);
                d0 += S[k4 * 4] * kv.x; d1 += S[k4 * 4 + 1] * kv.y; d2 += S[k4 * 4 + 2] * kv.z; d3 += S[k4 * 4 + 3] * kv.w;
                if ((k4 & 7) == 7) __builtin_amdgcn_sched_barrier(0);
            }
            const float dot = (d0 + d1) + (d2 + d3);
            const float vn = bt * (v - dec * dot);
            float o0 = 0.f, o1 = 0.f, o2 = 0.f, o3 = 0.f;
#pragma unroll
            for (int k4 = 0; k4 < 32; ++k4) {
                const f32x4_t kv = *(const LASP f32x4_t*)(kp + k4 * 4);
                const f32x4_t qv = *(const LASP f32x4_t*)(qp + k4 * 4);
                S[k4 * 4] = dec * S[k4 * 4] + kv.x * vn; o0 += S[k4 * 4] * qv.x;
                S[k4 * 4 + 1] = dec * S[k4 * 4 + 1] + kv.y * vn; o1 += S[k4 * 4 + 1] * qv.y;
                S[k4 * 4 + 2] = dec * S[k4 * 4 + 2] + kv.z * vn; o2 += S[k4 * 4 + 2] * qv.z;
                S[k4 * 4 + 3] = dec * S[k4 * 4 + 3] + kv.w * vn; o3 += S[k4 * 4 + 3] * qv.w;
                if ((k4 & 3) == 3) __builtin_amdgcn_sched_barrier(0);
            }
            const int t = tok_of(dir, s0 + j);
            nb[((size_t)dir * TOK + t) * 256 + (h & 1) * 128 + col] = f2bf((o0 + o1) + (o2 + o3));
        }
    }
    __syncthreads();
}

__device__ void gla_scan_naive(const P& p, LASP float* sm, int l, int b, bf16* nb) {
    const int tid = mk_tid();
    LASP float* sq = sm;
    LASP float* sv = sm + 8 * 16 * 96;
    const int grp = tid >> 6, lane = tid & 63, h = grp >> 1, dir = grp & 1;
    const int d = lane & 31, par = lane >> 5;
    float w2c[16];
#pragma unroll
    for (int j = 0; j < 16; ++j) w2c[j] = p.gla_w2[((size_t)(l * 2 + dir) * 16 + j) * 128 + h * 32 + d];
    const float b2v = p.gla_b2[(l * 2 + dir) * 128 + h * 32 + d];
    const int dd = d & 15, f = dd & 7;
    const float inv = powf(10000.f, -(float)f / 8.f);
    const int pd = dd < 8 ? d + 8 : d - 8;
    float S[32];
#pragma unroll
    for (int i = 0; i < 32; ++i) S[i] = 0.f;
    for (int s0 = 0; s0 < TOK; s0 += 16) {
        __syncthreads();
#pragma unroll 1
        for (int jj = 0; jj < 8; ++jj) {
            const int j = par + 2 * jj;
            const int t = tok_of(dir, s0 + j);
            const bf16* base = p.rest + ((size_t)b * TOK + t) * NREST;
            float qv = bf2f(base[RC_CQ + h * 32 + d]), kv = bf2f(base[RC_CK + h * 32 + d]);
            if (t >= CTX) {
                const int pidx = t - CTX;
                const int pos = d < 16 ? (pidx >> 6) : (pidx & 63);
                const float ang = (float)pos * inv;
                const float cs = cosf(ang), sn = sinf(ang);
                const float qp = bf2f(base[RC_CQ + h * 32 + pd]), kp = bf2f(base[RC_CK + h * 32 + pd]);
                if (dd < 8) { qv = qv * cs - qp * sn; kv = kv * cs - kp * sn; }
                else { qv = qp * sn + qv * cs; kv = kp * sn + kv * cs; }
            }
            qv *= 0.17677669529663687f;
            float xg = b2v;
#pragma unroll
            for (int jr = 0; jr < 16; ++jr) xg += bf2f(base[RC_CR + dir * 16 + jr]) * w2c[jr];
            const float ls = fminf(xg, 0.f) - log1pf(expf(-fabsf(xg)));
            LASP float* dst = sq + (grp * 16 + j) * 96;
            dst[d] = qv; dst[32 + d] = kv; dst[64 + d] = expf(ls * (1.f / 16.f));
        }
        for (int i = lane; i < 16 * 64; i += 64) {
            const int j = i >> 6, c = i & 63;
            const int t = tok_of(dir, s0 + j);
            sv[(grp * 16 + j) * 64 + c] = bf2f(p.rest[((size_t)b * TOK + t) * NREST + RC_CV + h * 64 + c]);
        }
        __syncthreads();
#pragma unroll 1
        for (int j = 0; j < 16; ++j) {
            const LASP float* qp = sq + (grp * 16 + j) * 96;
            const LASP float* kp = qp + 32;
            const LASP float* dp = qp + 64;
            const float v = sv[(grp * 16 + j) * 64 + lane];
            float o0 = 0.f, o1 = 0.f;
#pragma unroll
            for (int e = 0; e < 32; e += 2) {
                S[e] = dp[e] * S[e] + kp[e] * v; o0 += S[e] * qp[e];
                S[e + 1] = dp[e + 1] * S[e + 1] + kp[e + 1] * v; o1 += S[e + 1] * qp[e + 1];
            }
            const int t = tok_of(dir, s0 + j);
            nb[((size_t)dir * TOK + t) * 256 + h * 64 + lane] = f2bf(o0 + o1);
        }
    }
    __syncthreads();
}

__device__ void na_query_naive(const P& p, LASP float* sm, int l, int b, int t0, bf16* nb) {
    const int tid = mk_tid();
    const int wave = tid >> 6, lane = tid & 63, h = wave & 3, t = t0 + (wave >> 2);
    LASP float* pw = sm + wave * 384;
    const size_t rowq = (size_t)b * TOK + t;
    float qv[64];
    {
        const bf16* qs = p.rest + rowq * NREST + RC_BQ + h * 64;
#pragma unroll
        for (int i = 0; i < 8; ++i) {
            float f[8]; unpack8(*(const uint4*)(qs + i * 8), f);
#pragma unroll
            for (int e = 0; e < 8; ++e) qv[i * 8 + e] = f[e] * 0.125f;
        }
    }
    const bool lat = t >= CTX;
    const int nk = lat ? 384 : 256;
    int r = 0, c = 0, r0 = 0, c0 = 0;
    if (lat) { int pi = t - CTX; r = pi >> 6; c = pi & 63; r0 = min(max(r - 4, 0), 56); c0 = min(max(c - 8, 0), 48); }
    float m = -1e30f;
    __syncthreads();
#pragma unroll 1
    for (int j = 0; j < 6; ++j) {
        const int idx = lane + 64 * j;
        float s = -1e30f;
        if (idx < nk) {
            int tk; float bias = 0.f;
            if (lat && idx < 128) {
                const int i = idx >> 4, kc = c0 + (idx & 15);
                tk = CTX + (r0 + i) * 64 + kc;
                bias = p.rpb[((size_t)(l * 4 + h) * 15 + (r0 + i - r + 7)) * 31 + (kc - c + 15)];
            } else tk = lat ? idx - 128 : idx;
            const bf16* ks = p.kf + (((size_t)(b * 4 + h) * NCH + (tk >> 5)) * 4 * 64 + (tk & 31)) * 8;
            float d0 = 0.f, d1 = 0.f;
#pragma unroll
            for (int i = 0; i < 8; ++i) {
                float f[8]; unpack8(*(const uint4*)(ks + ((i >> 1) * 64 + (i & 1) * 32) * 8), f);
#pragma unroll
                for (int e = 0; e < 8; e += 2) { d0 += qv[i * 8 + e] * f[e]; d1 += qv[i * 8 + e + 1] * f[e + 1]; }
            }
            s = d0 + d1 + bias;
        }
        pw[idx] = s;
        m = fmaxf(m, s);
    }
    m = wave_max(m);
    float sum = 0.f;
#pragma unroll 1
    for (int j = 0; j < 6; ++j) { const float e = expf(pw[lane + 64 * j] - m); pw[lane + 64 * j] = e; sum += e; }
    sum = wave_sum(sum);
    const float inv = 1.f / sum;
    __syncthreads();
    float o0 = 0.f, o1 = 0.f;
    for (int idx = 0; idx < nk; idx += 2) {
        int tk0;
        if (lat && idx < 128) tk0 = CTX + (r0 + (idx >> 4)) * 64 + c0 + (idx & 15);
        else tk0 = lat ? idx - 128 : idx;
        o0 += pw[idx] * bf2f(p.rest[((size_t)b * TOK + tk0) * NREST + RC_BV + h * 64 + lane]);
        o1 += pw[idx + 1] * bf2f(p.rest[((size_t)b * TOK + tk0 + 1) * NREST + RC_BV + h * 64 + lane]);
    }
    nb[(size_t)t * 256 + h * 64 + lane] = f2bf((o0 + o1) * inv);
}


__device__ void ph_probe_naive(const P& p, LASP float* sm, int l, int bid, int nblk) {
    bf16* nb = (bf16*)p.xc1;
    if (PROBE == 1) { if (bid == 0) gdn_scan_naive(p, sm, l, 0, 0, nb); }
    else if (PROBE == 3) { if (bid == 0) gla_scan_naive(p, sm, l, 0, nb); }
    else { for (int it = bid; it < TOK / 2; it += nblk) na_query_naive(p, sm, l, 0, it * 2, nb); }
}
__device__ void ph_probe_cmp(const P& p, int bid, int nblk) {
    const int tid = mk_tid();
    const bf16* nb = (const bf16*)p.xc1;
    float md = 0.f, mr = 0.f;
    const int n = (PROBE == 2) ? TOK * 256 : 2 * TOK * 256;
    for (int i = bid * NTHREADS + tid; i < n; i += nblk * NTHREADS) {
        float a, r = bf2f(nb[i]);
        if (PROBE == 1) { const int dir = i / (TOK * 256), rem = i % (TOK * 256), t = rem >> 8, c = rem & 255; a = bf2f(p.oa[((size_t)dir * ROWS + t) * 512 + c]); }
        else if (PROBE == 3) { const int dir = i / (TOK * 256), rem = i % (TOK * 256); a = bf2f(p.oc[(size_t)dir * ROWS * 256 + rem]); }
        else { const int t = i >> 8, c = i & 255; a = bf2f(p.rest[(size_t)t * NREST + RC_BQ + c]); }
        md = fmaxf(md, fabsf(a - r)); mr = fmaxf(mr, fabsf(r));
    }
    md = wave_max(md); mr = wave_max(mr);
    if ((tid & 63) == 0) { atomicMax((unsigned*)p.stats, __float_as_uint(md)); atomicMax((unsigned*)p.stats + 1, __float_as_uint(mr)); }
}
#endif

#define XB_TMO      128
#define XB_XCNT(j)  (256  + 64 * (j))
#define XB_XSUB(j)  (1280 + 64 * (j))
#define XB_XGEN(j)  (2304 + 64 * (j))
#define XB_TOP      3328
#define XB_TOPGEN   3392
#define XCD_BAR_WORDS 3456
#define XB_SPIN_CAP (1u << 18)

__device__ __forceinline__ unsigned xb_ld(unsigned* p)              { return __hip_atomic_load(p, __ATOMIC_RELAXED, __HIP_MEMORY_SCOPE_AGENT); }
__device__ __forceinline__ unsigned xb_add(unsigned* p, unsigned v) { return __hip_atomic_fetch_add(p, v, __ATOMIC_RELAXED, __HIP_MEMORY_SCOPE_AGENT); }
__device__ __forceinline__ unsigned xb_xcc_id() { return (unsigned)__builtin_amdgcn_s_getreg((3 << 11) | 20) & 0xFu; }
#define XB_SPIN(cond, bar) do { unsigned _sp = 0; while (cond) { __builtin_amdgcn_s_sleep(1); \
    if ((++_sp & 255u) == 0u) { if (xb_ld(&(bar)[XB_TMO])) break; if (_sp > XB_SPIN_CAP) { atomicAdd(&(bar)[XB_TMO], 1u); break; } } } } while (0)

struct XcdBarrier {
    unsigned* bar; unsigned x;
    volatile LASP unsigned* st;
};

__device__ __forceinline__ XcdBarrier xcd_barrier_post(unsigned* bar, volatile LASP unsigned* st) {
    XcdBarrier b; b.bar = bar; b.x = xb_xcc_id(); b.st = st;
    if ((int)threadIdx.x == 0) (void)xb_add(&bar[XB_XCNT(b.x)], 1u);
    return b;
}
__device__ __forceinline__ void xcd_barrier_complete(unsigned* bar, unsigned x, unsigned& nloc, unsigned& nx) {
    const unsigned G = gridDim.x * gridDim.y * gridDim.z;
    unsigned sum, cnt, mine, sp = 0u;
    for (;;) {
        sum = 0u; cnt = 0u; mine = 0u;
#pragma unroll
        for (unsigned j = 0; j < 16; ++j) { const unsigned c = xb_ld(&bar[XB_XCNT(j)]); sum += c; cnt += (c > 0u) ? 1u : 0u; mine = (j == x) ? c : mine; }
        if (sum == G) break;
        __builtin_amdgcn_s_sleep(1);
        if ((++sp & 255u) == 0u) { if (xb_ld(&bar[XB_TMO])) break; if (sp > XB_SPIN_CAP) { atomicAdd(&bar[XB_TMO], 1u); break; } }
    }
    nloc = mine > 0u ? mine : 1u; nx = cnt > 0u ? cnt : 1u;
}

__device__ __forceinline__ void xcd_barrier(const XcdBarrier& b) {
    asm volatile("s_waitcnt vmcnt(0)" ::: "memory");
    __syncthreads();
    if ((int)threadIdx.x == 0) {
        unsigned* bar = b.bar;
        __builtin_amdgcn_s_waitcnt(0);
        unsigned nloc = b.st[0], nx = b.st[1];
        if (nloc == 0u) { xcd_barrier_complete(bar, b.x, nloc, nx); b.st[0] = nloc; b.st[1] = nx; }
        const unsigned old = xb_add(&bar[XB_XSUB(b.x)], 1u);
        const unsigned gen = old / nloc;
        if (old + 1u == (gen + 1u) * nloc) {
            __builtin_amdgcn_fence(__ATOMIC_RELEASE, "agent");
            asm volatile("s_waitcnt vmcnt(0)" ::: "memory");
            const unsigned og = xb_add(&bar[XB_TOP], 1u);
            const unsigned tg = og / nx;
            if (og + 1u == (tg + 1u) * nx) xb_add(&bar[XB_TOPGEN], 1u);
            else XB_SPIN(xb_ld(&bar[XB_TOPGEN]) == tg, bar);
            __builtin_amdgcn_fence(__ATOMIC_ACQUIRE, "agent");
            xb_add(&bar[XB_XGEN(b.x)], 1u);
            asm volatile("s_waitcnt vmcnt(0)" ::: "memory");
        } else {
            XB_SPIN(xb_ld(&bar[XB_XGEN(b.x)]) == gen, bar);
            __builtin_amdgcn_fence(__ATOMIC_ACQUIRE, "agent");
            asm volatile("s_waitcnt vmcnt(0)" ::: "memory");
        }
    }
    __syncthreads();
}


constexpr int NSTEP = 1 + 2 * 7 + 1;
__global__ void __launch_bounds__(NTHREADS, 2) k_mega(P p) {
    extern __shared__ __attribute__((aligned(16))) unsigned char lds_raw[];
    LASP unsigned char* lds = (LASP unsigned char*)lds_raw;
    const int bid = blockIdx.x, nblk = gridDim.x;
    volatile LASP unsigned* bst = (volatile LASP unsigned*)(lds + LDS_BYTES - 64);
    if (threadIdx.x < 16) bst[threadIdx.x] = 0u;
    __syncthreads();
    { const XcdBarrier b0 = xcd_barrier_post((unsigned*)p.ctl, bst); if (threadIdx.x == 0) bst[2] = b0.x; }
    __syncthreads();
    ph_prologue(p, lds, bid, nblk);
    { XcdBarrier bar; bar.bar = (unsigned*)p.ctl; bar.x = (unsigned)__builtin_amdgcn_readfirstlane((int)bst[2]); bar.st = bst; xcd_barrier(bar); }
#pragma unroll 1
    for (int step = 1; step < NSTEP; ++step) {
        int ph = 0, l = 0;
        { const int s1 = step - 1; l = s1 / 7; ph = 1 + s1 % 7; }
#if TPROBE >= 0
        if (bid == 0 && threadIdx.x == 0) { if (step == 1) p.stats[2] = 0.f; const unsigned long long t_ = __builtin_amdgcn_s_memrealtime(); bst[4] = (unsigned)t_; bst[5] = (unsigned)(t_ >> 32); }
#endif
        if (ph == 1) { if (l == 0) ph_transposes(p, lds, bid, nblk); ph_lnpass(p, l, bid, nblk); }
        else if (l < 2) {
            if (ph == 2) {
                pg8::Gemm g{p.ml, p.wi_t + (size_t)l * NPAD * D, ROWS, NPAD, D}; pg8::StaticOrder S; S.init(ROWS, NPAD, nblk, bid);
                EpiProj E{p.raw, p.rest, p.kf};
                pg8::gemm_phase<EpiProj, pg8::StaticOrder, true, true>(lds, g, S, E);
            } else if (ph == 3) { ph_prep_early(p, lds, l, bid, nblk); ph_conv(p, l, bid, nblk); }
            else if (ph == 4) ph_prep(p, lds, l, bid, nblk);
            else if (ph == 5) {
#if PROBE
                if (l == 0) { ph_probe_naive(p, (LASP float*)lds, l, bid, nblk); XcdBarrier bar; bar.bar = (unsigned*)p.ctl; bar.x = (unsigned)__builtin_amdgcn_readfirstlane((int)bst[2]); bar.st = bst; xcd_barrier(bar); }
#endif
#if TPROBE >= 50
                const bool inrole = TPROBE == 50 ? (bid < 64) : (TPROBE == 51 ? (bid >= 64 && bid < 96) : (bid >= 96));
                const float rscale = TPROBE == 50 ? (1.f / 64.f) : (TPROBE == 51 ? (1.f / 32.f) : (1.f / 160.f));
                if (inrole && threadIdx.x == 0) { const unsigned long long t_ = __builtin_amdgcn_s_memrealtime(); bst[6] = (unsigned)t_; bst[7] = (unsigned)(t_ >> 32); }
#endif
                ph_mix(p, lds, l, bid, nblk);
#if TPROBE >= 50
                if (inrole && threadIdx.x == 0) { const unsigned long long tr0 = (unsigned long long)bst[6] | ((unsigned long long)bst[7] << 32); atomicAdd(&p.stats[2], (float)(__builtin_amdgcn_s_memrealtime() - tr0) * 0.01f * rscale); }
#endif
#if PROBE
                if (l == 0) { XcdBarrier bar; bar.bar = (unsigned*)p.ctl; bar.x = (unsigned)__builtin_amdgcn_readfirstlane((int)bst[2]); bar.st = bst; xcd_barrier(bar); ph_probe_cmp(p, bid, nblk); }
#endif
            }
            else if (ph == 6) ph_gate(p, l, bid, nblk);
            else if (ph == 7) {
                pg8::Gemm g{p.mix, p.wo_t + (size_t)l * D * D, ROWS, D, D};
                EpiY E{p.ml};
                if (l == 0) { pg8::StaticOrder S; S.init(ROWS, D, nblk, bid); pg8::gemm_phase<EpiY, pg8::StaticOrder, true, true>(lds, g, S, E); }
                else { LatentOrder S; S.S.init(BATCH * SEQ, D, nblk, bid); pg8::gemm_phase<EpiY, LatentOrder, true, true>(lds, g, S, E); }
            }
        }
        { XcdBarrier bar; bar.bar = (unsigned*)p.ctl; bar.x = (unsigned)__builtin_amdgcn_readfirstlane((int)bst[2]); bar.st = bst; xcd_barrier(bar); }
#if TPROBE >= 0
        if (bid == 0 && threadIdx.x == 0 && ph == TPROBE) { const unsigned long long tp0 = (unsigned long long)bst[4] | ((unsigned long long)bst[5] << 32); p.stats[2] += (float)(__builtin_amdgcn_s_memrealtime() - tp0) * 0.01f; }
#endif
    }
}

extern "C" void kernel_launch(void* const* d_in, const int* in_sizes, int n_in, void* d_out, int out_size, void* d_ws, size_t ws_size,
                              hipStream_t stream) {
    P p{};
    p.x = (const float*)d_in[0]; p.c = (const float*)d_in[1]; p.ctx = (const float*)d_in[2]; p.c_ctx = (const float*)d_in[3];
    p.w_mod = (const float*)d_in[4]; p.b_mod = (const float*)d_in[5]; p.w_in = (const float*)d_in[6]; p.conv_w = (const float*)d_in[7];
    p.a_log = (const float*)d_in[8]; p.dt_bias = (const float*)d_in[9]; p.gdn_norm = (const float*)d_in[10]; p.rpb = (const float*)d_in[11];
    p.gla_w2 = (const float*)d_in[12]; p.gla_b2 = (const float*)d_in[13]; p.gla_norm = (const float*)d_in[14]; p.w_out = (const float*)d_in[15];
    p.ln_g = (const float*)d_in[16]; p.ln_b = (const float*)d_in[17];
    p.out = (float*)d_out;
    unsigned char* w = (unsigned char*)d_ws;
    size_t off = 0;
    auto take = [&](size_t bytes) { unsigned char* r = w + off; off += (bytes + 255) & ~(size_t)255; return r; };
    p.ctl = (unsigned*)take(16384);
    p.mods = (float*)take((size_t)2 * 9 * 3072 * 4);
    p.xc1 = (float*)take((size_t)BATCH * CTX * D * 4);
    p.wi_t = (bf16*)take((size_t)2 * NPAD * D * 2);
    p.wo_t = (bf16*)take((size_t)2 * D * D * 2);
    p.rest = (bf16*)take((size_t)ROWS * NREST * 2);
    p.raw = (bf16*)take((size_t)ROWS * NRAW * 2);
    p.qkvn = (bf16*)take((size_t)ROWS * NRAW * 2);
    p.mix = p.qkvn;
    p.oa = (bf16*)take((size_t)2 * ROWS * 512 * 2);
    p.oc = (bf16*)take((size_t)2 * ROWS * 256 * 2);
    p.ml = p.oa;
    p.vf = (bf16*)take((size_t)ROWS * 256 * 2);
    p.kf = (bf16*)take((size_t)ROWS * 256 * 2);
    p.stats = (float*)take(256);
    static int grid_blocks = 0;
    if (!grid_blocks) {
        if (off > ws_size) { fprintf(stderr, "workspace too small: need %zu have %zu\n", off, ws_size); grid_blocks = -1; return; }
        int dev = 0, cus = 0, per_cu = 0;
        hipGetDevice(&dev);
        hipDeviceGetAttribute(&cus, hipDeviceAttributeMultiprocessorCount, dev);
        if (hipFuncSetAttribute((const void*)k_mega, hipFuncAttributeMaxDynamicSharedMemorySize, LDS_BYTES) != hipSuccess) { fprintf(stderr, "hipFuncSetAttribute failed\n"); grid_blocks = -1; return; }
        hipOccupancyMaxActiveBlocksPerMultiprocessor(&per_cu, (const void*)k_mega, NTHREADS, LDS_BYTES);
        if (per_cu < 1) { fprintf(stderr, "occupancy query says %d blocks per CU\n", per_cu); grid_blocks = -1; return; }
        grid_blocks = cus;
    }
    if (grid_blocks < 0) return;
    if (hipMemsetAsync(p.ctl, 0, 16384, stream) != hipSuccess) { fprintf(stderr, "memset of the barrier words failed\n"); return; }
    void* args[] = {&p};
    hipError_t e = hipLaunchCooperativeKernel((void*)k_mega, dim3(grid_blocks), dim3(NTHREADS), args, LDS_BYTES, stream);
    if (e != hipSuccess) fprintf(stderr, "cooperative launch failed: %s (grid %d)\n", hipGetErrorString(e), grid_blocks);
}
```

```cpp
#include <hip/hip_runtime.h>
#include <hip/hip_cooperative_groups.h>
#include <cstdio>
#include <cstdint>
namespace cg = cooperative_groups;
#ifndef PROBE
#define PROBE 0
#endif
#ifndef TPROBE
#define TPROBE -1
#endif
#ifndef TSHIFT
#define TSHIFT 0
#endif

constexpr int D = 1024, BATCH = 8, SEQ = 4096, CTX = 256, TOK = 4352, NPROJ = 3888;
constexpr int ROWS = BATCH * TOK;
constexpr int NRAW = 1536, NREST = 2096, NPAD = 4096;
constexpr int NTHREADS = 512, NWAVES = 8;
constexpr int LDS_BYTES = 147456;
constexpr float ALPHA = 1.4142135623730951f;
constexpr int RC_AB = 0, RC_AZ = 16, RC_BQ = 528, RC_BV = 784, RC_BZ = 1040, RC_CQ = 1296, RC_CK = 1424, RC_CV = 1552, RC_CR = 1808, RC_CZ = 1840;
constexpr int PC_BK = 2320, PC_BV = 2576;

typedef unsigned short bf16;
typedef float f32x4_t __attribute__((ext_vector_type(4)));

struct P {
    const float *x, *c, *ctx, *c_ctx, *w_mod, *b_mod, *w_in, *conv_w, *a_log, *dt_bias, *gdn_norm, *rpb,
        *gla_w2, *gla_b2, *gla_norm, *w_out, *ln_g, *ln_b;
    float* out;
    float *mods, *xc1, *stats, *cst; unsigned* ctl;
    bf16 *wi_t, *wo_t, *rest, *raw, *qkvn, *mix, *ml, *oa, *oc, *vf, *kf;
};

__device__ __forceinline__ float bf2f(unsigned short u) { return __uint_as_float((unsigned)u << 16); }
typedef float f32x2_t __attribute__((ext_vector_type(2)));
typedef __bf16 bf16x2_t __attribute__((ext_vector_type(2)));
__device__ __forceinline__ unsigned cvtpk(float lo, float hi) { f32x2_t v = {lo, hi}; bf16x2_t q = __builtin_convertvector(v, bf16x2_t); return __builtin_bit_cast(unsigned, q); }
__device__ __forceinline__ unsigned short f2bf(float f) { return (unsigned short)cvtpk(f, f); }
__device__ __forceinline__ unsigned pk2(float lo, float hi) { return cvtpk(lo, hi); }
__device__ __forceinline__ float bflo(unsigned w) { return __uint_as_float(w << 16); }
__device__ __forceinline__ float bfhi(unsigned w) { return __uint_as_float(w & 0xffff0000u); }
__device__ __forceinline__ void unpack8(uint4 w, float* f) {
    f[0] = bflo(w.x); f[1] = bfhi(w.x); f[2] = bflo(w.y); f[3] = bfhi(w.y); f[4] = bflo(w.z); f[5] = bfhi(w.z); f[6] = bflo(w.w); f[7] = bfhi(w.w);
}
__device__ __forceinline__ float silu_f(float x) { return x * __builtin_amdgcn_rcpf(1.f + __builtin_amdgcn_exp2f(-1.4426950408889634f * x)); }
__device__ __forceinline__ float wave_sum(float v) {
#pragma unroll
    for (int o = 32; o > 0; o >>= 1) v += __shfl_xor(v, o);
    return v;
}
__device__ __forceinline__ float wave_max(float v) {
#pragma unroll
    for (int o = 32; o > 0; o >>= 1) v = fmaxf(v, __shfl_xor(v, o));
    return v;
}
__device__ __forceinline__ int mk_tid() { int t = threadIdx.x; asm volatile("" : "+v"(t)); return t; }
__device__ __forceinline__ int tok_of(int dir, int s) { return dir == 0 ? s : (s < CTX ? CTX - 1 - s : TOK + CTX - 1 - s); }

namespace pg8 {
#define PG8_LAS __attribute__((address_space(3)))
typedef unsigned short bf16_t;
typedef short bf16x8 __attribute__((ext_vector_type(8)));
typedef float f32x4 __attribute__((ext_vector_type(4)));
typedef unsigned u32x4 __attribute__((ext_vector_type(4)));
constexpr int BM = 256, BK = 64, HALF = 128, HTB = HALF * BK * 2  , STAGE_BYTES = 8 * HTB, NXCD = 8, WGM = 8;

__host__ __device__ __forceinline__ int lds_byte(int r, int c) { const int st = (r >> 4) * 2 + (c >> 5), rr = r & 15, cc = c & 31, ob = rr * 64 + cc * 2; return st * 1024 + (ob ^ (((ob >> 9) & 1) << 5)); }
__host__ __device__ __forceinline__ void stage_rc(int b, int& R, int& C) { const int st = b / 1024, sb = b % 1024, swz = sb ^ (((sb >> 9) & 1) << 5); R = (st >> 1) * 16 + swz / 64; C = (st & 1) * 32 + (swz % 64) / 2; }
__host__ __device__ __forceinline__ int perm32(int rho) { const int n = rho >> 4, i = rho & 15; return 8 * (i >> 2) + 4 * n + (i & 3); }

struct Unit { int pm, pn; };
struct Gemm { const bf16_t* A; const bf16_t* Bt; int M, N, K; int ld = 0; };

struct StaticOrder {
    int nM, nN, nwg, G, c;
    __host__ __device__ void init(int M, int N, int G_, int c_) { nM = M / BM; nN = N / BM; nwg = nM * nN; G = G_; c = c_; }
    __host__ __device__ bool next(int i, Unit& u) const {
        const long L = (long)i * G + c; if (L >= nwg) return false;
        int wgid = (int)L; { const int q = nwg / NXCD, r = nwg % NXCD, xcd = wgid % NXCD, off = wgid / NXCD; wgid = (xcd < r ? xcd * (q + 1) : r * (q + 1) + (xcd - r) * q) + off; }
        const int nig = WGM * nN, gid = wgid / nig, fm = gid * WGM, gsz = (nM - fm) < WGM ? (nM - fm) : WGM;
        u.pm = fm + ((wgid % nig) % gsz); u.pn = (wgid % nig) / gsz; return true;
    }
    __device__ __forceinline__ void a_ready(const Unit&) const {}
    __device__ __forceinline__ void done(const Unit&) const {}
};

__device__ __forceinline__ unsigned cvt_pk_bf16(float lo, float hi) { unsigned r; asm volatile("v_cvt_pk_bf16_f32 %0, %1, %2" : "=v"(r) : "v"(lo), "v"(hi)); return r; }
template <class Epi, class Sched, bool ALIGN_EPI = false, bool SP2 = false>
__device__ __forceinline__ void gemm_phase(PG8_LAS unsigned char* lds, const Gemm g, const Sched& S, const Epi& E) {
    const int tid = mk_tid(), wid = __builtin_amdgcn_readfirstlane(tid >> 6), lane = tid & 63, wr = wid >> 2, wc = wid & 3, fr = lane & 15, fq = lane >> 4;
    const int K = g.ld ? g.ld : g.K, nt = g.K / BK;
    unsigned voffA[2], voffB[2];
#pragma unroll
    for (int i = 0; i < 2; ++i) { int R, C; stage_rc(tid * 16 + i * 8192, R, C); const int Rb = Epi::PERM ? ((R & ~31) + perm32(R & 31)) : R;
        voffA[i] = (unsigned)(R * K + C) * 2u; voffB[i] = (unsigned)(Rb * K + C) * 2u; }
    const size_t kstep = (size_t)(BK * 2);
    const size_t hstep = (size_t)HALF * K * 2;
    const size_t tstep = 2 * hstep;
    const unsigned ldsw = (unsigned)wid * 1024u;
    const int aoff = lds_byte(wr * 64 + fr, fq * 8), boff = lds_byte(wc * 32 + fr, fq * 8);
#define PG8_SA(b, h) (((b) * 2 + (h)) * HTB)
#define PG8_SB(b, h) ((4 + (b) * 2 + (h)) * HTB)
#define PG8_STAGE(bufoff, gbase, voff) do { _Pragma("unroll") for (int _i = 0; _i < 2; ++_i) \
        __builtin_amdgcn_global_load_lds((const unsigned*)((const char*)(gbase) + (voff)[_i]), (PG8_LAS unsigned*)(lds + (bufoff) + ldsw + _i * 8192), 16, 0, 0); } while (0)
#define PG8_LDA(dst, b, h) do { _Pragma("unroll") for (int m = 0; m < 4; ++m) _Pragma("unroll") for (int k = 0; k < 2; ++k) dst[m][k] = *(const PG8_LAS bf16x8*)(lds + PG8_SA(b, h) + aoff + m * 2048 + k * 1024); } while (0)
#define PG8_LDB(dst, b, h) do { _Pragma("unroll") for (int n = 0; n < 2; ++n) _Pragma("unroll") for (int k = 0; k < 2; ++k) dst[n][k] = *(const PG8_LAS bf16x8*)(lds + PG8_SB(b, h) + boff + n * 2048 + k * 1024); } while (0)
#define PG8_MMA(ai, bj, At, Bt) do { __builtin_amdgcn_s_setprio(1); _Pragma("unroll") for (int m = 0; m < 4; ++m) _Pragma("unroll") for (int n = 0; n < 2; ++n) _Pragma("unroll") for (int k = 0; k < 2; ++k) \
        acc[ai][bj][m][n] = __builtin_amdgcn_mfma_f32_16x16x32_bf16(Bt[n][k], At[m][k], acc[ai][bj][m][n], 0, 0, 0); __builtin_amdgcn_s_setprio(0); } while (0)
#define PG8_WAIT_V(n) asm volatile("s_waitcnt vmcnt(" #n ")" ::: "memory")
#define PG8_WAIT_L(n) asm volatile("s_waitcnt lgkmcnt(" #n ")" ::: "memory")
#define PG8_BAR __builtin_amdgcn_s_barrier()
#define PG8_SCHED __builtin_amdgcn_sched_barrier(0)
    Unit cur, nxt; int ui = 0;
    if (!S.next(0, cur)) return;
    f32x4 acc[2][2][4][2];
#pragma unroll
    for (int a = 0; a < 2; ++a)
#pragma unroll
        for (int b = 0; b < 2; ++b)
#pragma unroll
            for (int m = 0; m < 4; ++m)
#pragma unroll
                for (int n = 0; n < 2; ++n) acc[a][b][m][n] = (f32x4){0.f, 0.f, 0.f, 0.f};
    bf16x8 At[4][2], B0[2][2], B1[2][2];
    const char* cA = (const char*)g.A + (size_t)cur.pm * tstep; const char* cB = (const char*)g.Bt + (size_t)cur.pn * tstep;
    S.a_ready(cur);
    if constexpr (SP2) {
        PG8_STAGE(PG8_SB(0, 0), cB, voffB); PG8_STAGE(PG8_SB(0, 1), cB + hstep, voffB); PG8_STAGE(PG8_SA(0, 0), cA, voffA); PG8_STAGE(PG8_SA(0, 1), cA + hstep, voffA);
        if (wr == 1) PG8_BAR;
        PG8_WAIT_V(2); PG8_BAR;
        PG8_STAGE(PG8_SB(1, 0), cB + kstep, voffB); PG8_STAGE(PG8_SA(1, 0), cA + kstep, voffA); PG8_STAGE(PG8_SB(1, 1), cB + hstep + kstep, voffB);
        PG8_WAIT_V(6); PG8_BAR;
    } else {
        PG8_STAGE(PG8_SB(0, 0), cB, voffB); PG8_STAGE(PG8_SA(0, 0), cA, voffA); PG8_STAGE(PG8_SB(0, 1), cB + hstep, voffB); PG8_STAGE(PG8_SA(0, 1), cA + hstep, voffA);
        if (wr == 1) PG8_BAR;
        PG8_WAIT_V(4); PG8_BAR;
        PG8_STAGE(PG8_SB(1, 0), cB + kstep, voffB); PG8_STAGE(PG8_SA(1, 0), cA + kstep, voffA); PG8_STAGE(PG8_SB(1, 1), cB + hstep + kstep, voffB);
        PG8_WAIT_V(6); PG8_BAR;
    }
    for (;;) {
        const bool has_next = S.next(ui + 1, nxt);
        const char* nA = has_next ? (const char*)g.A + (size_t)nxt.pm * tstep : cA; const char* nB = has_next ? (const char*)g.Bt + (size_t)nxt.pn * tstep : cB;
        for (int t = 0; t < nt; t += 2) {
            const bool last = (t == nt - 2);
            const char* a1 = cA + (size_t)(t + 1) * kstep;
            const char* a2 = last ? nA : cA + (size_t)(t + 2) * kstep; const char* b2 = last ? nB : cB + (size_t)(t + 2) * kstep;
            const char* a3 = a2 + kstep; const char* b3 = b2 + kstep;
            if (last && has_next) S.a_ready(nxt);
            if constexpr (SP2) {
            PG8_LDB(B0, 0, 0); PG8_LDB(B1, 0, 1); PG8_SCHED; PG8_LDA(At, 0, 0); PG8_STAGE(PG8_SA(1, 1), a1 + hstep, voffA);
            PG8_WAIT_V(8); PG8_WAIT_L(0); PG8_BAR; PG8_MMA(0, 0, At, B0); PG8_MMA(0, 1, At, B1); PG8_BAR; PG8_SCHED;
            PG8_LDA(At, 0, 1); PG8_STAGE(PG8_SB(0, 0), b2, voffB); PG8_STAGE(PG8_SB(0, 1), b2 + hstep, voffB); PG8_STAGE(PG8_SA(0, 0), a2, voffA);
            PG8_WAIT_V(8); PG8_WAIT_L(0); PG8_BAR; PG8_MMA(1, 0, At, B0); PG8_MMA(1, 1, At, B1); PG8_BAR; PG8_SCHED;
            PG8_LDB(B0, 1, 0); PG8_LDB(B1, 1, 1); PG8_SCHED; PG8_LDA(At, 1, 0); PG8_STAGE(PG8_SA(0, 1), a2 + hstep, voffA);
            PG8_WAIT_V(8); PG8_WAIT_L(0); PG8_BAR; PG8_MMA(0, 0, At, B0); PG8_MMA(0, 1, At, B1); PG8_BAR; PG8_SCHED;
            PG8_LDA(At, 1, 1); PG8_STAGE(PG8_SB(1, 0), b3, voffB); PG8_STAGE(PG8_SB(1, 1), b3 + hstep, voffB); PG8_STAGE(PG8_SA(1, 0), a3, voffA);
            PG8_WAIT_V(8); PG8_WAIT_L(0); PG8_BAR; PG8_MMA(1, 0, At, B0); PG8_MMA(1, 1, At, B1); PG8_BAR; PG8_SCHED;
            } else {
            PG8_LDB(B0, 0, 0); PG8_SCHED; PG8_LDA(At, 0, 0); PG8_STAGE(PG8_SA(1, 1), a1 + hstep, voffA);
            PG8_WAIT_L(8); PG8_BAR; PG8_WAIT_L(0); PG8_MMA(0, 0, At, B0); PG8_BAR; PG8_SCHED;
            PG8_LDB(B1, 0, 1); PG8_STAGE(PG8_SB(0, 0), b2, voffB);
            PG8_BAR; PG8_WAIT_L(0); PG8_MMA(0, 1, At, B1); PG8_BAR;
            PG8_LDA(At, 0, 1); PG8_STAGE(PG8_SA(0, 0), a2, voffA);
            PG8_BAR; PG8_WAIT_L(0); PG8_MMA(1, 0, At, B0); PG8_BAR; PG8_SCHED;
            PG8_STAGE(PG8_SB(0, 1), b2 + hstep, voffB);
            PG8_WAIT_V(6); PG8_BAR; PG8_MMA(1, 1, At, B1); PG8_BAR;
            PG8_LDB(B0, 1, 0); PG8_SCHED; PG8_LDA(At, 1, 0); PG8_STAGE(PG8_SA(0, 1), a2 + hstep, voffA);
            PG8_WAIT_L(8); PG8_BAR; PG8_WAIT_L(0); PG8_MMA(0, 0, At, B0); PG8_BAR; PG8_SCHED;
            PG8_LDB(B1, 1, 1); PG8_STAGE(PG8_SB(1, 0), b3, voffB);
            PG8_BAR; PG8_WAIT_L(0); PG8_MMA(0, 1, At, B1); PG8_BAR;
            PG8_LDA(At, 1, 1); PG8_STAGE(PG8_SA(1, 0), a3, voffA);
            PG8_BAR; PG8_WAIT_L(0); PG8_MMA(1, 0, At, B0); PG8_BAR; PG8_SCHED;
            PG8_STAGE(PG8_SB(1, 1), b3 + hstep, voffB);
            PG8_WAIT_V(6); PG8_BAR; PG8_MMA(1, 1, At, B1); PG8_BAR;
            }
        }
        if constexpr (ALIGN_EPI) { if (wr == 0) PG8_BAR; }
        if constexpr (!Epi::AFTER_DRAIN) { E(acc, cur, wr, wc, fr, fq); S.done(cur); }
        if (!has_next) break;
#pragma unroll
        for (int a = 0; a < 2; ++a)
#pragma unroll
            for (int b = 0; b < 2; ++b)
#pragma unroll
                for (int m = 0; m < 4; ++m)
#pragma unroll
                    for (int n = 0; n < 2; ++n) acc[a][b][m][n] = (f32x4){0.f, 0.f, 0.f, 0.f};
        cur = nxt; cA = nA; cB = nB; ++ui;
        if constexpr (ALIGN_EPI) { if (wr == 1) PG8_BAR; }
    }
    PG8_WAIT_V(0);
    if constexpr (!ALIGN_EPI) { if (wr == 0) PG8_BAR; }
    PG8_BAR;
    if constexpr (Epi::AFTER_DRAIN) { E.fused(acc, cur, wr, wc, fr, fq, lds, wid, lane); S.done(cur); }
#undef PG8_SA
#undef PG8_SB
#undef PG8_STAGE
#undef PG8_LDA
#undef PG8_LDB
#undef PG8_MMA
#undef PG8_WAIT_V
#undef PG8_WAIT_L
#undef PG8_BAR
#undef PG8_SCHED
}
}

#define LASP __attribute__((address_space(3)))
constexpr int NCHK = TOK / 32;

struct LatentOrder {
    pg8::StaticOrder S;
    __device__ __forceinline__ bool next(int i, pg8::Unit& u) const { if (!S.next(i, u)) return false; u.pm = 17 * (u.pm >> 4) + 1 + (u.pm & 15); return true; }
    __device__ __forceinline__ void a_ready(const pg8::Unit&) const {}
    __device__ __forceinline__ void done(const pg8::Unit&) const {}
};
struct EpiProj {
    static constexpr bool PERM = true, AFTER_DRAIN = false;
    bf16* raw; bf16* rest; bf16* kf;
    __device__ __forceinline__ void operator()(const pg8::f32x4 (&acc)[2][2][4][2], const pg8::Unit& u, int wr, int wc, int fr, int fq) const {
        const int row0 = u.pm * 256 + wr * 64 + fr;
        const int colb = u.pn * 256 + wc * 32 + 8 * fq;
#pragma unroll
        for (int bj = 0; bj < 2; ++bj) {
            const int col = colb + bj * 128;
            if (col >= NPROJ) continue;
            const bool iskf = col >= PC_BK && col < PC_BV;
            bf16* base; int ld;
            if (col < NRAW) { base = raw + col; ld = NRAW; }
            else if (col < PC_BK) { base = rest + (col - NRAW); ld = NREST; }
            else { base = rest + (col - NRAW - 256); ld = NREST; }
            const int hd = col - PC_BK, hk = hd >> 6, dk = hd & 63;
#pragma unroll
            for (int ai = 0; ai < 2; ++ai)
#pragma unroll
                for (int m = 0; m < 4; ++m) {
                    const pg8::f32x4 v0 = acc[ai][bj][m][0], v1 = acc[ai][bj][m][1];
                    pg8::u32x4 w; w.x = pg8::cvt_pk_bf16(v0[0], v0[1]); w.y = pg8::cvt_pk_bf16(v0[2], v0[3]); w.z = pg8::cvt_pk_bf16(v1[0], v1[1]); w.w = pg8::cvt_pk_bf16(v1[2], v1[3]);
                    const int row = row0 + ai * 128 + m * 16;
                    if (iskf) {
                        const int bb = row / TOK, t = row - bb * TOK;
                        *(pg8::u32x4*)(kf + ((((size_t)(bb * 4 + hk) * NCHK + (t >> 5)) * 4 + (dk >> 4)) * 64 + ((dk >> 3) & 1) * 32 + (t & 31)) * 8) = w;
                    } else *(pg8::u32x4*)(base + (size_t)row * ld) = w;
                }
        }
    }
};
struct EpiY {
    static constexpr bool PERM = true, AFTER_DRAIN = false;
    bf16* y;
    __device__ __forceinline__ void operator()(const pg8::f32x4 (&acc)[2][2][4][2], const pg8::Unit& u, int wr, int wc, int fr, int fq) const {
        const int row0 = u.pm * 256 + wr * 64 + fr;
        const int colb = u.pn * 256 + wc * 32 + 8 * fq;
#pragma unroll
        for (int bj = 0; bj < 2; ++bj)
#pragma unroll
            for (int ai = 0; ai < 2; ++ai)
#pragma unroll
                for (int m = 0; m < 4; ++m) {
                    const pg8::f32x4 v0 = acc[ai][bj][m][0], v1 = acc[ai][bj][m][1];
                    pg8::u32x4 w; w.x = pg8::cvt_pk_bf16(v0[0], v0[1]); w.y = pg8::cvt_pk_bf16(v0[2], v0[3]); w.z = pg8::cvt_pk_bf16(v1[0], v1[1]); w.w = pg8::cvt_pk_bf16(v1[2], v1[3]);
                    *(pg8::u32x4*)(y + (size_t)(row0 + ai * 128 + m * 16) * D + colb + bj * 128) = w;
                }
    }
};

struct OneUnit {
    int pm, pn; bool valid;
    __device__ __forceinline__ bool next(int i, pg8::Unit& u) const { if (i != 0 || !valid) return false; u.pm = pm; u.pn = pn; return true; }
    __device__ __forceinline__ void a_ready(const pg8::Unit&) const {}
    __device__ __forceinline__ void done(const pg8::Unit&) const {}
};
struct EpiYc {
    static constexpr bool PERM = true, AFTER_DRAIN = false;
    bf16* yc;
    __device__ __forceinline__ void operator()(const pg8::f32x4 (&acc)[2][2][4][2], const pg8::Unit& u, int wr, int wc, int fr, int fq) const {
        const int row0 = (u.pm / 17) * 256 + wr * 64 + fr;
        const int colb = u.pn * 256 + wc * 32 + 8 * fq;
#pragma unroll
        for (int bj = 0; bj < 2; ++bj)
#pragma unroll
            for (int ai = 0; ai < 2; ++ai)
#pragma unroll
                for (int m = 0; m < 4; ++m) {
                    const pg8::f32x4 v0 = acc[ai][bj][m][0], v1 = acc[ai][bj][m][1];
                    pg8::u32x4 w; w.x = pg8::cvt_pk_bf16(v0[0], v0[1]); w.y = pg8::cvt_pk_bf16(v0[2], v0[3]); w.z = pg8::cvt_pk_bf16(v1[0], v1[1]); w.w = pg8::cvt_pk_bf16(v1[2], v1[3]);
                    *(pg8::u32x4*)(yc + (size_t)(row0 + ai * 128 + m * 16) * D + colb + bj * 128) = w;
                }
    }
};
constexpr size_t YC_STRIDE = (size_t)BATCH * CTX * D;

__device__ __forceinline__ void transpose_item(const float* W, int K, int N, bf16* WT, LASP float* scr, int item, int lane) {
    const int nblk = (N + 31) / 32, kb = item / nblk, nb = item % nblk, k0 = 64 * kb, n0 = 32 * nb;
    const bool nok = (n0 + (lane & 31)) < N;
#pragma unroll 8
    for (int i = 0; i < 32; ++i) { const int kk = 2 * i + (lane >> 5); scr[kk * 33 + (lane & 31)] = nok ? W[(size_t)(k0 + kk) * N + n0 + (lane & 31)] : 0.f; }
    asm volatile("s_waitcnt lgkmcnt(0)" ::: "memory");
    const int c = lane & 7;
#pragma unroll
    for (int j = 0; j < 4; ++j) {
        const int n = (lane >> 3) + 8 * j; const LASP float* s = scr + (8 * c) * 33 + n;
        uint4 o; o.x = pk2(s[0 * 33], s[1 * 33]); o.y = pk2(s[2 * 33], s[3 * 33]); o.z = pk2(s[4 * 33], s[5 * 33]); o.w = pk2(s[6 * 33], s[7 * 33]);
        *(uint4*)(WT + (size_t)(n0 + n) * K + k0 + 8 * c) = o;
    }
    asm volatile("s_waitcnt lgkmcnt(0)" ::: "memory");
}

__device__ void ph_prologue(const P& p, LASP unsigned char* lds, int bid, int nblk) {
    const int tid = mk_tid(), lane = tid & 63, wave = tid >> 6;
    LASP float* sm = (LASP float*)lds;
    if (bid < 192) {
        for (int i = tid; i < 9 * 1024; i += NTHREADS) {
            int s = i >> 10, d = i & 1023;
            float cv = s < 8 ? p.c[s * 1024 + d] : p.c_ctx[d];
            sm[i] = silu_f(cv);
        }
        __syncthreads();
        const int l = bid / 96, col = lane & 31, kh = lane >> 5, j = (bid % 96) * 32 + col;
        const float* w = p.w_mod + (size_t)l * 1024 * 3072 + j;
        float acc[9];
#pragma unroll
        for (int s = 0; s < 9; ++s) acc[s] = 0.f;
        const int ib = wave * 128 + kh * 64;
#pragma unroll 1
        for (int i0 = ib; i0 < ib + 64; i0 += 16) {
            float wv[16];
#pragma unroll
            for (int u = 0; u < 16; ++u) wv[u] = w[(size_t)(i0 + u) * 3072];
#pragma unroll
            for (int u = 0; u < 16; ++u)
#pragma unroll
                for (int s = 0; s < 9; ++s) acc[s] += sm[s * 1024 + i0 + u] * wv[u];
        }
        LASP float* red = sm + 9 * 1024;
#pragma unroll
        for (int s = 0; s < 9; ++s) { acc[s] += __shfl_xor(acc[s], 32); if (kh == 0) red[(wave * 9 + s) * 32 + col] = acc[s]; }
        __syncthreads();
        for (int o = tid; o < 9 * 32; o += NTHREADS) {
            const int s = o >> 5, c = o & 31;
            float t = 0.f;
#pragma unroll
            for (int ww = 0; ww < 8; ++ww) t += red[(ww * 9 + s) * 32 + c];
            const int jj = (bid % 96) * 32 + c;
            p.mods[(size_t)(l * 9 + s) * 3072 + jj] = t + p.b_mod[l * 3072 + jj];
        }
        __syncthreads();
    }
    if (bid == nblk - 1) {
        const int pos = tid >> 3, f = tid & 7;
        const float ang = (float)pos * powf(10000.f, -(float)f / 8.f);
        p.cst[tid * 2] = cosf(ang); p.cst[tid * 2 + 1] = sinf(ang);
    }
#if PROBE
    if (bid == 0 && tid < 4) p.stats[tid] = 0.f;
#endif
}
__device__ void ph_transposes(const P& p, LASP unsigned char* lds, int bid, int nblk) {
    const int tid = mk_tid(), lane = tid & 63, wave = tid >> 6;
    LASP float* scr = (LASP float*)(lds + 57344 + wave * 8704);
    const int gw = (nblk - 1 - bid) * NWAVES + wave, NGW = nblk * NWAVES;
    constexpr int I_IN = 16 * 122, I_OUT = 16 * 32;
    for (int it = gw; it < 2 * (I_IN + I_OUT); it += NGW) {
        int l = it / (I_IN + I_OUT), r = it % (I_IN + I_OUT);
        if (r < I_IN) transpose_item(p.w_in + (size_t)l * D * NPROJ, D, NPROJ, p.wi_t + (size_t)l * NPAD * D, scr, r, lane);
        else transpose_item(p.w_out + (size_t)l * D * D, D, D, p.wo_t + (size_t)l * D * D, scr, r - I_IN, lane);
    }
    for (int i = bid * NTHREADS + tid; i < 2 * 192 * 128; i += nblk * NTHREADS) {
        int l = i / (192 * 128), r = i % (192 * 128);
        unsigned z; asm volatile("v_mov_b32 %0, 0" : "=v"(z));
        *(uint4*)(p.wi_t + (size_t)l * NPAD * D + (size_t)3904 * D + (size_t)r * 8) = make_uint4(z, z, z, z);
    }
}

__device__ void ph_lnpass(const P& p, int mode, int bid, int nblk) {
    const int tid = mk_tid();
    const int lane = tid & 63, wave = tid >> 6;
    for (int r = bid * NWAVES + wave; r < ROWS; r += nblk * NWAVES) {
        const int b = r / TOK, t = r - b * TOK;
        const bool isc = t < CTX;
        if (mode == 2 && isc) continue;
        float* buf; const float* src; int s;
        if (isc) { buf = p.xc1 + ((size_t)b * CTX + t) * D; src = p.ctx + ((size_t)b * CTX + t) * D; s = 8; }
        else { buf = p.out + ((size_t)b * SEQ + (t - CTX)) * D; src = (mode == 2) ? buf : p.x + ((size_t)b * SEQ + (t - CTX)) * D; s = b; }
        f32x4_t v[4];
#pragma unroll
        for (int j = 0; j < 4; ++j) v[j] = *(const f32x4_t*)(src + 256 * j + 4 * lane);
        if (mode >= 1) {
            const int lp = mode - 1;
            const float* gt = p.mods + (size_t)(lp * 9 + s) * 3072 + 2048;
            f32x4_t yq[4];
            if (isc) {
                const bf16* yc = p.oc + ((size_t)b * CTX + t) * D + 4 * lane;
                uint2 yp[4][4];
#pragma unroll
                for (int j = 0; j < 4; ++j)
#pragma unroll
                    for (int q = 0; q < 4; ++q) yp[j][q] = *(const uint2*)(yc + q * YC_STRIDE + 256 * j);
#pragma unroll
                for (int j = 0; j < 4; ++j)
                    yq[j] = (f32x4_t){(bflo(yp[j][0].x) + bflo(yp[j][1].x)) + (bflo(yp[j][2].x) + bflo(yp[j][3].x)), (bfhi(yp[j][0].x) + bfhi(yp[j][1].x)) + (bfhi(yp[j][2].x) + bfhi(yp[j][3].x)),
                                      (bflo(yp[j][0].y) + bflo(yp[j][1].y)) + (bflo(yp[j][2].y) + bflo(yp[j][3].y)), (bfhi(yp[j][0].y) + bfhi(yp[j][1].y)) + (bfhi(yp[j][2].y) + bfhi(yp[j][3].y))};
            } else {
                uint2 yw[4];
#pragma unroll
                for (int j = 0; j < 4; ++j) yw[j] = *(const uint2*)(p.ml + (size_t)r * D + 256 * j + 4 * lane);
#pragma unroll
                for (int j = 0; j < 4; ++j) yq[j] = (f32x4_t){bflo(yw[j].x), bfhi(yw[j].x), bflo(yw[j].y), bfhi(yw[j].y)};
            }
#pragma unroll
            for (int j = 0; j < 4; ++j) {
                const f32x4_t g = *(const f32x4_t*)(gt + 256 * j + 4 * lane);
                const f32x4_t yv = yq[j];
                v[j] = v[j] * ALPHA + g * yv;
            }
            float sum = 0.f;
#pragma unroll
            for (int j = 0; j < 4; ++j) sum += (v[j].x + v[j].y) + (v[j].z + v[j].w);
            const float mu = wave_sum(sum) * (1.f / 1024.f);
            float sq = 0.f;
#pragma unroll
            for (int j = 0; j < 4; ++j) { v[j] = v[j] - mu; sq += (v[j].x * v[j].x + v[j].y * v[j].y) + (v[j].z * v[j].z + v[j].w * v[j].w); }
            const float rs = __builtin_amdgcn_rsqf(wave_sum(sq) * (1.f / 1024.f) + 1e-6f);
#pragma unroll
            for (int j = 0; j < 4; ++j) {
                const f32x4_t g = *(const f32x4_t*)(p.ln_g + lp * 1024 + 256 * j + 4 * lane), bb = *(const f32x4_t*)(p.ln_b + lp * 1024 + 256 * j + 4 * lane);
                v[j] = v[j] * rs * g + bb;
#if PROBE
                if (mode == 2) v[j] = v[j] + (p.stats[0] / fmaxf(p.stats[1], 1e-20f));
#endif
#if TPROBE >= 0
                if (mode == 2) v[j] = v[j] + exp2f((rintf(log2f(fmaxf(p.stats[2], 1.f)) * 6.f + TSHIFT * 0.5f) - TSHIFT * 0.5f) * (1.f / 6.f)) * 1e-4f;
#endif
                *(f32x4_t*)(buf + 256 * j + 4 * lane) = v[j];
            }
            if (mode == 2) continue;
        }
        const int l = mode;
        float sum = 0.f;
#pragma unroll
        for (int j = 0; j < 4; ++j) sum += (v[j].x + v[j].y) + (v[j].z + v[j].w);
        const float mu = wave_sum(sum) * (1.f / 1024.f);
        float sq = 0.f;
#pragma unroll
        for (int j = 0; j < 4; ++j) { v[j] = v[j] - mu; sq += (v[j].x * v[j].x + v[j].y * v[j].y) + (v[j].z * v[j].z + v[j].w * v[j].w); }
        const float rs = __builtin_amdgcn_rsqf(wave_sum(sq) * (1.f / 1024.f) + 1e-6f);
        const float* md = p.mods + (size_t)(l * 9 + s) * 3072;
#pragma unroll
        for (int j = 0; j < 4; ++j) {
            const f32x4_t sh = *(const f32x4_t*)(md + 256 * j + 4 * lane), sc = *(const f32x4_t*)(md + 1024 + 256 * j + 4 * lane);
            const f32x4_t o = v[j] * rs * (sc + 1.f) + sh;
            uint2 w; w.x = pk2(o.x, o.y); w.y = pk2(o.z, o.w);
            *(uint2*)(p.ml + (size_t)r * D + 256 * j + 4 * lane) = w;
        }
    }
}

__device__ void ph_conv(const P& p, int l, int bid, int nblk) {
    const int tid = mk_tid();
    const int lane = tid & 63, wave = tid >> 6;
    const float* cw = p.conv_w + (size_t)l * 5 * 1536;
    constexpr int SL = 17, NSTRIP = TOK / SL;
    static_assert(NSTRIP * SL == TOK && (CTX / SL) * SL + 1 == CTX, "strip geometry: the straddling strip starts at the last context token");
    for (int it = bid * NWAVES + wave; it < BATCH * NSTRIP * 3; it += nblk * NWAVES) {
        const int third = it % 3, rest_i = it / 3, strip = rest_i % NSTRIP, b = rest_i / NSTRIP;
        const int t0 = strip * SL;
        const bool strad = t0 == CTX - 1;
        const int lo = strad ? 0 : (t0 < CTX ? 0 : CTX), hi = strad ? TOK : (t0 < CTX ? CTX : TOK);
        const int ch = third * 512 + lane * 8;
        float w[5][8];
#pragma unroll
        for (int j = 0; j < 5; ++j) {
            const f32x4_t a = *(const f32x4_t*)(cw + j * 1536 + ch), c = *(const f32x4_t*)(cw + j * 1536 + ch + 4);
            w[j][0] = a.x; w[j][1] = a.y; w[j][2] = a.z; w[j][3] = a.w; w[j][4] = c.x; w[j][5] = c.y; w[j][6] = c.z; w[j][7] = c.w;
        }
        const bf16* src = p.raw + ((size_t)b * TOK + t0) * NRAW + ch;
        bf16* dst = p.qkvn + ((size_t)b * TOK + t0) * NRAW + ch;
        uint4 rw[SL + 4];
#pragma unroll
        for (int i = 0; i < SL + 4; ++i) {
            const int tt = t0 + i - 2;
            rw[i] = (tt >= lo && tt < hi) ? *(const uint4*)(src + (ptrdiff_t)(i - 2) * NRAW) : make_uint4(0, 0, 0, 0);
        }
        const int g = (ch >> 7);
        const float qs = g < 4 ? 0.08838834764831845f : 1.f;
#pragma unroll
        for (int n = 0; n < SL; ++n) {
            float acc[8];
#pragma unroll
            for (int e = 0; e < 8; ++e) acc[e] = 0.f;
#pragma unroll
            for (int j = 0; j < 5; ++j) {
                float f[8]; unpack8(rw[n + j], f);
                const bool cross = (n == 0) ? (n + j >= 3) : (n + j <= 2);
                if (cross && n <= 2) {
#pragma unroll
                    for (int e = 0; e < 8; ++e) f[e] = strad ? 0.f : f[e];
                }
#pragma unroll
                for (int e = 0; e < 8; ++e) acc[e] += w[j][e] * f[e];
            }
            float ss = 0.f;
#pragma unroll
            for (int e = 0; e < 8; ++e) { acc[e] = silu_f(acc[e]); ss += acc[e] * acc[e]; }
            if (g < 8) {
#pragma unroll
                for (int m = 8; m > 0; m >>= 1) ss += __shfl_xor(ss, m);
                const float sc = qs * __builtin_amdgcn_rsqf(ss + 1e-6f);
#pragma unroll
                for (int e = 0; e < 8; ++e) acc[e] *= sc;
            }
            uint4 o; o.x = pk2(acc[0], acc[1]); o.y = pk2(acc[2], acc[3]); o.z = pk2(acc[4], acc[5]); o.w = pk2(acc[6], acc[7]);
            *(uint4*)(dst + (size_t)n * NRAW) = o;
        }
    }
}

typedef short bf16x8_t __attribute__((ext_vector_type(8)));
typedef float f32x16_t __attribute__((ext_vector_type(16)));
typedef unsigned u32x4_t __attribute__((ext_vector_type(4)));
#define MFMA32(a, b, c) __builtin_amdgcn_mfma_f32_32x32x16_bf16((a), (b), (c), 0, 0, 0)
__device__ __forceinline__ int crow(int reg, int h) { return (reg & 3) + 8 * (reg >> 2) + 4 * h; }
__device__ __forceinline__ int perm16(int a) { const int x = a & 15; return (a & ~15) + (x < 4 ? x : x < 8 ? x + 4 : x < 12 ? x - 4 : x); }
#define PACK8(x, s) __builtin_bit_cast(bf16x8_t, (u32x4_t){cvtpk((x)[8 * (s)], (x)[8 * (s) + 1]), cvtpk((x)[8 * (s) + 2], (x)[8 * (s) + 3]), cvtpk((x)[8 * (s) + 4], (x)[8 * (s) + 5]), cvtpk((x)[8 * (s) + 6], (x)[8 * (s) + 7])})
constexpr int GCH = 32, NCH = TOK / GCH;
constexpr int GP_ITEM = 4416;

__device__ void ph_gdnprep(const P& p, LASP unsigned char* lds, int l, int bid, int nblk, int tid) {
    const int lane = tid & 63, wave = tid >> 6, r = lane & 31, hh = lane >> 5;
    LASP float* Lm = (LASP float*)(lds + wave * 16384);
    LASP float* Xs = Lm + 2048;
    for (int it = bid * NWAVES + wave; it < BATCH * 4 * NCH; it += nblk * NWAVES) {
        const int c = it % NCH, bh = it / NCH, h = bh & 3, b = bh >> 2;
        const size_t row0 = (size_t)b * TOK + (size_t)c * GCH;
        f32x16_t KK, QK;
#pragma unroll
        for (int i = 0; i < 16; ++i) { KK[i] = 0.f; QK[i] = 0.f; }
        const bf16* kbase = p.qkvn + (row0 + r) * NRAW + 512 + h * 128 + 8 * hh;
        const bf16* qbase = p.qkvn + (row0 + r) * NRAW + h * 128 + 8 * hh;
#pragma unroll
        for (int s = 0; s < 8; ++s) {
            const bf16x8_t kf = *(const bf16x8_t*)(kbase + 16 * s), qf = *(const bf16x8_t*)(qbase + 16 * s);
            KK = MFMA32(kf, kf, KK);
            QK = MFMA32(qf, kf, QK);
        }
        float Gd, bd;
        {
            const bf16* ab = p.rest + (row0 + r) * NREST + RC_AB;
            const float a = bf2f(ab[hh * 4 + h]) + p.dt_bias[(l * 2 + hh) * 4 + h];
            const float sp = fmaxf(a, 0.f) + 0.6931471805599453f * __builtin_amdgcn_logf(1.f + __builtin_amdgcn_exp2f(-1.4426950408889634f * fabsf(a)));
            Gd = -__builtin_amdgcn_exp2f(1.4426950408889634f * p.a_log[(l * 2 + hh) * 4 + h]) * sp;
            bd = __builtin_amdgcn_rcpf(1.f + __builtin_amdgcn_exp2f(-1.4426950408889634f * bf2f(ab[(2 + hh) * 4 + h])));
        }
#pragma unroll
        for (int off = 1; off < 32; off <<= 1) {
            const float up = __shfl_up(Gd, off, 32), dn = __shfl_down(Gd, off, 32);
            if (hh == 0) { if (r >= off) Gd += up; } else { if (r + off < 32) Gd += dn; }
        }
        unsigned char* gout = (unsigned char*)p.raw + ((size_t)(bh * 2) * NCH + c) * GP_ITEM;
        {
            const float Glast = __shfl(Gd, hh == 0 ? 31 : 32);
            float* sc = (float*)(gout + (size_t)hh * NCH * GP_ITEM + 4096);
            sc[r] = __builtin_amdgcn_exp2f(1.4426950408889634f * Gd); sc[32 + r] = __builtin_amdgcn_exp2f(1.4426950408889634f * (Glast - Gd));
            if (r == 0) sc[64] = __builtin_amdgcn_exp2f(1.4426950408889634f * Glast);
        }
        asm volatile("s_waitcnt lgkmcnt(0)" ::: "memory");
        LASP unsigned short* qkt = (LASP unsigned short*)Xs;
        LASP float* bs = (LASP float*)(lds + 135168 + wave * 256);
        bs[lane] = bd;
#pragma unroll
        for (int d = 0; d < 2; ++d) {
            const float Gcol = __shfl(Gd, d * 32 + r);
#pragma unroll
            for (int i = 0; i < 16; ++i) {
                const int n = crow(i, hh);
                const float Grow = __shfl(Gd, d * 32 + n), brow = __shfl(bd, d * 32 + n);
                const bool incl = d == 0 ? (r <= n) : (r >= n), strict = d == 0 ? (r < n) : (r > n);
                const float dec = __builtin_amdgcn_exp2f((incl ? Grow - Gcol : 0.f) * 1.4426950408889634f);
                const float lv = strict ? brow * KK[i] * dec : 0.f;
                const float qv = incl ? QK[i] * dec : 0.f;
                const int n2 = d == 0 ? n : 31 - n, m2 = d == 0 ? r : 31 - r;
                Lm[(d * 32 + n2) * 32 + m2] = lv;
                qkt[(d * 32 + n) * 40 + perm16(r)] = f2bf(qv);
                if ((i & 3) == 3) __builtin_amdgcn_sched_barrier(0);
            }
        }
        asm volatile("s_waitcnt lgkmcnt(0)" ::: "memory");
#pragma unroll
        for (int d = 0; d < 2; ++d)
#pragma unroll
            for (int k = 0; k < 2; ++k) {
                const int q = lane + 64 * k, row = q >> 2, ch = q & 3;
                *(u32x4_t*)(gout + (size_t)d * NCH * GP_ITEM + 2048 + row * 64 + ch * 16) = *(const LASP u32x4_t*)((const LASP unsigned char*)qkt + (d * 32 + row) * 80 + ch * 16);
            }
        asm volatile("s_waitcnt lgkmcnt(0)" ::: "memory");
        {
            const LASP float* Lr = Lm + hh * 1024;
            LASP float* xc = Xs + lane;
            float x[32];
#pragma unroll
            for (int n = 0; n < 32; ++n) x[n] = 0.f;
#pragma unroll
            for (int n = 0; n < 32; ++n) {
                f32x4_t lc[8];
#pragma unroll
                for (int jb = 0; jb < 8; ++jb) if (4 * jb < n) lc[jb] = *(const LASP f32x4_t*)(Lr + n * 32 + 4 * jb);
                float a0 = (n == r) ? 1.f : 0.f, a1 = 0.f;
#pragma unroll
                for (int jb = 0; jb < 8; ++jb) if (4 * jb < n) { a0 -= lc[jb].x * x[4 * jb]; a1 -= lc[jb].y * x[4 * jb + 1]; a0 -= lc[jb].z * x[4 * jb + 2]; a1 -= lc[jb].w * x[4 * jb + 3]; }
                x[n] = a0 + a1;
                xc[n * 64] = x[n];
                if ((n & 1) == 1) __builtin_amdgcn_sched_barrier(0);
            }
        }
        asm volatile("s_waitcnt lgkmcnt(0)" ::: "memory");
#pragma unroll
        for (int d = 0; d < 2; ++d)
#pragma unroll
            for (int k = 0; k < 2; ++k) {
                const int q = lane + 64 * k, row = q >> 2, ch = q & 3;
                const int nn = d == 0 ? row : 31 - row;
                float v[8];
#pragma unroll
                for (int e = 0; e < 8; ++e) {
                    const int m = perm16(ch * 8 + e);
                    const int lidx = d == 0 ? m : 32 + 31 - m;
                    v[e] = Xs[nn * 64 + lidx] * bs[d * 32 + m];
                }
                *(u32x4_t*)(gout + (size_t)d * NCH * GP_ITEM + row * 64 + ch * 16) = (u32x4_t){cvtpk(v[0], v[1]), cvtpk(v[2], v[3]), cvtpk(v[4], v[5]), cvtpk(v[6], v[7])};
            }
        asm volatile("s_waitcnt lgkmcnt(0)" ::: "memory");
    }
}

constexpr int ST_KA = 0, ST_QA = 8704, ST_KN = 17408, ST_V = 27648, ST_TP = 37888, ST_QK = 40448, ST_GL = 43008, ST_BYTES = 43328;
constexpr int GDN_OST = 2 * ST_BYTES, GDN_OST_BYTES = 32 * 272;
typedef unsigned u32x2_t __attribute__((ext_vector_type(2)));
typedef short s16x4_t __attribute__((ext_vector_type(4)));
struct GSlot { u32x4_t k0, k1, q0, q1, v0, v1, t; f32x4_t sc; };

__device__ __forceinline__ int gdn_chunk(int dir, int s) { return dir == 0 ? s : (s < 8 ? 7 - s : 143 - s); }
__device__ __forceinline__ void gdn_issue(const P& p, GSlot& g, int b, int h, int dir, int step, int tl) {
    const int c = gdn_chunk(dir, step);
    const size_t row0 = (size_t)b * TOK + (size_t)c * GCH;
    const int r0 = tl >> 4, c16 = tl & 15;
    const bf16* a0 = p.qkvn + (row0 + r0) * NRAW + h * 128 + 8 * c16;
    const bf16* a1 = a0 + (size_t)16 * NRAW;
    g.q0 = *(const u32x4_t*)a0; g.q1 = *(const u32x4_t*)a1;
    g.k0 = *(const u32x4_t*)(a0 + 512); g.k1 = *(const u32x4_t*)(a1 + 512);
    g.v0 = *(const u32x4_t*)(a0 + 1024); g.v1 = *(const u32x4_t*)(a1 + 1024);
    const unsigned char* gp = (const unsigned char*)p.raw + ((size_t)((b * 4 + h) * 2 + dir) * NCH + c) * GP_ITEM;
    g.t = *(const u32x4_t*)(gp + tl * 16);
    g.sc = *(const f32x4_t*)(gp + 4096 + (tl < 20 ? tl : 0) * 16);
}
__device__ __forceinline__ u32x4_t scale8(u32x4_t x, float s) {
    return (u32x4_t){cvtpk(bflo(x.x) * s, bfhi(x.x) * s), cvtpk(bflo(x.y) * s, bfhi(x.y) * s), cvtpk(bflo(x.z) * s, bfhi(x.z) * s), cvtpk(bflo(x.w) * s, bfhi(x.w) * s)};
}
__device__ __forceinline__ void gdn_put_rows(LASP unsigned char* st, int row, int c16, u32x4_t kq, int off) {
    const int g = c16 >> 1, odd = c16 & 1;
    *(LASP u32x2_t*)(st + off + row * 272 + (16 * g + (odd ? 4 : 0)) * 2) = (u32x2_t){kq.x, kq.y};
    *(LASP u32x2_t*)(st + off + row * 272 + (16 * g + (odd ? 12 : 8)) * 2) = (u32x2_t){kq.z, kq.w};
}
__device__ __forceinline__ void gdn_write(LASP unsigned char* st, const GSlot& g, int tl) {
    const int r0 = tl >> 4, c16 = tl & 15;
    gdn_put_rows(st, r0, c16, g.k0, ST_KA); gdn_put_rows(st, r0 + 16, c16, g.k1, ST_KA);
    gdn_put_rows(st, r0, c16, g.q0, ST_QA); gdn_put_rows(st, r0 + 16, c16, g.q1, ST_QA);
    *(LASP u32x4_t*)(st + ST_KN + r0 * 320 + c16 * 16) = g.k0;
    *(LASP u32x4_t*)(st + ST_KN + (r0 + 16) * 320 + c16 * 16) = g.k1;
    *(LASP u32x4_t*)(st + ST_V + r0 * 320 + c16 * 16) = g.v0;
    *(LASP u32x4_t*)(st + ST_V + (r0 + 16) * 320 + c16 * 16) = g.v1;
    { const int t2 = tl & 127; *(LASP u32x4_t*)(st + (tl < 128 ? ST_TP : ST_QK) + (t2 >> 2) * 80 + (t2 & 3) * 16) = g.t; }
    if (tl < 20) *(LASP f32x4_t*)(st + ST_GL + tl * 16) = g.sc;
}
__device__ __forceinline__ void gdn_flush(const P& p, LASP unsigned char* lds, int b, int h, int dir, int step, int tl) {
    const int c = gdn_chunk(dir, step);
    const LASP unsigned char* ost = lds + GDN_OST + (step & 1) * GDN_OST_BYTES;
    bf16* op = p.oa + ((size_t)dir * ROWS + (size_t)b * TOK + (size_t)c * GCH) * 512 + h * 128;
#pragma unroll
    for (int k = 0; k < 2; ++k) { const int idx = tl + 256 * k, row = idx >> 4, ch = idx & 15; *(u32x4_t*)(op + (size_t)row * 512 + ch * 8) = *(const LASP u32x4_t*)(ost + row * 272 + ch * 16); }
}
__device__ __forceinline__ s16x4_t trd(const LASP unsigned char* q) {
    typedef short v4i16_t __attribute__((ext_vector_type(4)));
    return __builtin_bit_cast(s16x4_t, __builtin_amdgcn_ds_read_tr16_b64_v4i16((LASP v4i16_t*)q));
}
#define TRFRAG(base) __builtin_shufflevector(trd(base), trd((base) + 8 * 320), 0, 1, 2, 3, 4, 5, 6, 7)

#if TPROBE == 60
#define GDN_SYNC_C() do { unsigned long long t_ = __builtin_amdgcn_s_memrealtime(); __syncthreads(); if (chain == 0 && tid == 0) p.stats[2] += (float)(__builtin_amdgcn_s_memrealtime() - t_) * 0.01f; } while (0)
#define GDN_SYNC_L() __syncthreads()
#elif TPROBE == 61
#define GDN_SYNC_L() do { unsigned long long t_ = __builtin_amdgcn_s_memrealtime(); __syncthreads(); if (chain == 0 && tid == 256) p.stats[2] += (float)(__builtin_amdgcn_s_memrealtime() - t_) * 0.01f; } while (0)
#define GDN_SYNC_C() __syncthreads()
#else
#define GDN_SYNC_C() __syncthreads()
#define GDN_SYNC_L() __syncthreads()
#endif
__device__ __forceinline__ float lm_(float a, float b) { float t = a * b; asm("" : "+v"(t)); return t; }
__device__ void gdn_scan_fast(const P& p, LASP unsigned char* lds, int chain) {
    const int tid = mk_tid();
    const int lane = tid & 63, wave = __builtin_amdgcn_readfirstlane(tid >> 6);
    const int dir = chain & 1, h = (chain >> 1) & 3, b = chain >> 3;
    constexpr int NS = NCH;
    if (wave >= 4) {
        const int tl = tid - 256;
        GSlot g0, g1, g2, g3;
        gdn_issue(p, g0, b, h, dir, 0, tl); gdn_issue(p, g1, b, h, dir, 1, tl); gdn_issue(p, g2, b, h, dir, 2, tl); gdn_issue(p, g3, b, h, dir, 3, tl);
        gdn_write(lds, g0, tl); gdn_issue(p, g0, b, h, dir, 4, tl);
        __syncthreads();
#pragma unroll 1
        for (int s = 0; s < NS; s += 4) {
            if (s > 0) gdn_flush(p, lds, b, h, dir, s - 1, tl);
            gdn_write(lds + ((s + 1) & 1) * ST_BYTES, g1, tl); gdn_issue(p, g1, b, h, dir, min(s + 5, NS - 1), tl);
            GDN_SYNC_L();
            gdn_flush(p, lds, b, h, dir, s, tl);
            gdn_write(lds + ((s + 2) & 1) * ST_BYTES, g2, tl); gdn_issue(p, g2, b, h, dir, min(s + 6, NS - 1), tl);
            GDN_SYNC_L();
            gdn_flush(p, lds, b, h, dir, s + 1, tl);
            gdn_write(lds + ((s + 3) & 1) * ST_BYTES, g3, tl); gdn_issue(p, g3, b, h, dir, min(s + 7, NS - 1), tl);
            GDN_SYNC_L();
            gdn_flush(p, lds, b, h, dir, s + 2, tl);
            gdn_write(lds + ((s + 4) & 1) * ST_BYTES, g0, tl); gdn_issue(p, g0, b, h, dir, min(s + 8, NS - 1), tl);
            GDN_SYNC_L();
        }
        gdn_flush(p, lds, b, h, dir, NS - 1, tl);
    } else {
        const int r = lane & 31, hh = lane >> 5, w = wave;
        f32x16_t S0, S1, S2, S3;
#pragma unroll
        for (int i = 0; i < 16; ++i) { S0[i] = 0.f; S1[i] = 0.f; S2[i] = 0.f; S3[i] = 0.f; }
        const int troff = (4 * hh + ((lane & 15) >> 2)) * 320 + (16 * ((lane >> 4) & 1) + 4 * (lane & 3)) * 2;
        __syncthreads();
#pragma unroll 1
        for (int s = 0; s < NS; ++s) {
            LASP unsigned char* st = lds + (s & 1) * ST_BYTES;
            const LASP float* sc = (const LASP float*)(st + ST_GL);
            const float gl = sc[64];
            const LASP unsigned char* tp = st + ST_TP + r * 80 + hh * 16;
            const bf16x8_t T0 = *(const LASP bf16x8_t*)(tp), T1 = *(const LASP bf16x8_t*)(tp + 32);
            const LASP unsigned char* vbase = st + ST_V + troff + 64 * w;
            const bf16x8_t vB0 = TRFRAG(vbase), vB1 = TRFRAG(vbase + 16 * 320);
            const LASP unsigned char* ka = st + ST_KA + r * 272 + hh * 16;
            const LASP unsigned char* qa = st + ST_QA + r * 272 + hh * 16;
            const bf16x8_t kA0 = *(const LASP bf16x8_t*)(ka), qA0 = *(const LASP bf16x8_t*)(qa), kA1 = *(const LASP bf16x8_t*)(ka + 32), qA1 = *(const LASP bf16x8_t*)(qa + 32);
            __builtin_amdgcn_sched_barrier(0);
            f32x16_t ak, aq, vn;
#pragma unroll
            for (int i = 0; i < 16; ++i) { ak[i] = 0.f; aq[i] = 0.f; vn[i] = 0.f; }
#define GDN_KQ(KA, QA, SX, u) { const bf16x8_t SB = PACK8(SX, u); ak = MFMA32(KA, SB, ak); aq = MFMA32(QA, SB, aq); \
                                 f32x4_t a_ = {lm_(SX[8 * u], gl), lm_(SX[8 * u + 1], gl), lm_(SX[8 * u + 2], gl), lm_(SX[8 * u + 3], gl)}, b_ = {lm_(SX[8 * u + 4], gl), lm_(SX[8 * u + 5], gl), lm_(SX[8 * u + 6], gl), lm_(SX[8 * u + 7], gl)}; \
                                 asm volatile("" : "+v"(a_), "+v"(b_));        \
                                 SX[8 * u] = a_.x; SX[8 * u + 1] = a_.y; SX[8 * u + 2] = a_.z; SX[8 * u + 3] = a_.w; SX[8 * u + 4] = b_.x; SX[8 * u + 5] = b_.y; SX[8 * u + 6] = b_.z; SX[8 * u + 7] = b_.w; }
            const bf16x8_t kA2 = *(const LASP bf16x8_t*)(ka + 64), qA2 = *(const LASP bf16x8_t*)(qa + 64), kA3 = *(const LASP bf16x8_t*)(ka + 96), qA3 = *(const LASP bf16x8_t*)(qa + 96);
            vn = MFMA32(T0, vB0, vn); vn = MFMA32(T1, vB1, vn);
            GDN_KQ(kA0, qA0, S0, 0) GDN_KQ(kA1, qA1, S0, 1)
            __builtin_amdgcn_sched_barrier(0);
            const bf16x8_t kA4 = *(const LASP bf16x8_t*)(ka + 128), qA4 = *(const LASP bf16x8_t*)(qa + 128), kA5 = *(const LASP bf16x8_t*)(ka + 160), qA5 = *(const LASP bf16x8_t*)(qa + 160);
            GDN_KQ(kA2, qA2, S1, 0) GDN_KQ(kA3, qA3, S1, 1)
            __builtin_amdgcn_sched_barrier(0);
            const bf16x8_t kA6 = *(const LASP bf16x8_t*)(ka + 192), qA6 = *(const LASP bf16x8_t*)(qa + 192), kA7 = *(const LASP bf16x8_t*)(ka + 224), qA7 = *(const LASP bf16x8_t*)(qa + 224);
            GDN_KQ(kA4, qA4, S2, 0) GDN_KQ(kA5, qA5, S2, 1)
            __builtin_amdgcn_sched_barrier(0);
            const LASP unsigned char* qk = st + ST_QK + r * 80 + hh * 16;
            const bf16x8_t Q0 = *(const LASP bf16x8_t*)(qk), Q1 = *(const LASP bf16x8_t*)(qk + 32);
            const f32x4_t e0 = *(const LASP f32x4_t*)(sc + 4 * hh), e1 = *(const LASP f32x4_t*)(sc + 8 + 4 * hh), e2 = *(const LASP f32x4_t*)(sc + 16 + 4 * hh), e3 = *(const LASP f32x4_t*)(sc + 24 + 4 * hh);
            const f32x4_t f0 = *(const LASP f32x4_t*)(sc + 32 + 4 * hh), f1 = *(const LASP f32x4_t*)(sc + 40 + 4 * hh), f2 = *(const LASP f32x4_t*)(sc + 48 + 4 * hh), f3 = *(const LASP f32x4_t*)(sc + 56 + 4 * hh);
            GDN_KQ(kA6, qA6, S3, 0) GDN_KQ(kA7, qA7, S3, 1)
#undef GDN_KQ
            __builtin_amdgcn_sched_barrier(0);
            const LASP unsigned char* kn = st + ST_KN + troff;
            const bf16x8_t N00 = TRFRAG(kn), N01 = TRFRAG(kn + 16 * 320), N10 = TRFRAG(kn + 64), N11 = TRFRAG(kn + 64 + 16 * 320);
            const bf16x8_t N20 = TRFRAG(kn + 128), N21 = TRFRAG(kn + 128 + 16 * 320), N30 = TRFRAG(kn + 192), N31 = TRFRAG(kn + 192 + 16 * 320);
            __builtin_amdgcn_sched_barrier(0);
#define ROWSCALE(X, sgn) { X[0] *= sgn e0.x; X[1] *= sgn e0.y; X[2] *= sgn e0.z; X[3] *= sgn e0.w; X[4] *= sgn e1.x; X[5] *= sgn e1.y; X[6] *= sgn e1.z; X[7] *= sgn e1.w; \
                           X[8] *= sgn e2.x; X[9] *= sgn e2.y; X[10] *= sgn e2.z; X[11] *= sgn e2.w; X[12] *= sgn e3.x; X[13] *= sgn e3.y; X[14] *= sgn e3.z; X[15] *= sgn e3.w; }
            ROWSCALE(ak, -) ROWSCALE(aq, +)
#undef ROWSCALE
            const bf16x8_t ab0 = PACK8(ak, 0), ab1 = PACK8(ak, 1);
            vn = MFMA32(T0, ab0, vn); vn = MFMA32(T1, ab1, vn);
            const bf16x8_t vb0 = PACK8(vn, 0), vb1 = PACK8(vn, 1);
            f32x16_t vf;
            vf[0] = vn[0] * f0.x; vf[1] = vn[1] * f0.y; vf[2] = vn[2] * f0.z; vf[3] = vn[3] * f0.w; vf[4] = vn[4] * f1.x; vf[5] = vn[5] * f1.y; vf[6] = vn[6] * f1.z; vf[7] = vn[7] * f1.w;
            vf[8] = vn[8] * f2.x; vf[9] = vn[9] * f2.y; vf[10] = vn[10] * f2.z; vf[11] = vn[11] * f2.w; vf[12] = vn[12] * f3.x; vf[13] = vn[13] * f3.y; vf[14] = vn[14] * f3.z; vf[15] = vn[15] * f3.w;
            const bf16x8_t fb0 = PACK8(vf, 0), fb1 = PACK8(vf, 1);
            S0 = MFMA32(N00, fb0, S0); S1 = MFMA32(N10, fb0, S1); S2 = MFMA32(N20, fb0, S2); S3 = MFMA32(N30, fb0, S3);
            S0 = MFMA32(N01, fb1, S0); S1 = MFMA32(N11, fb1, S1); S2 = MFMA32(N21, fb1, S2); S3 = MFMA32(N31, fb1, S3);
            aq = MFMA32(Q0, vb0, aq); aq = MFMA32(Q1, vb1, aq);
            {
                LASP unsigned short* ost = (LASP unsigned short*)(lds + GDN_OST + (s & 1) * GDN_OST_BYTES) + 32 * w + r;
#pragma unroll
                for (int i = 0; i < 16; i += 2) { const unsigned pk = cvtpk(aq[i], aq[i + 1]); ost[crow(i, hh) * 136] = (unsigned short)pk; ost[(crow(i, hh) + 1) * 136] = (unsigned short)(pk >> 16); }
            }
            GDN_SYNC_C();
        }
    }
}

constexpr int GL_ITEM = 6272;
constexpr size_t GLA_PREP_OFF = (size_t)BATCH * 4 * 2 * NCH * GP_ITEM;

struct GlaRaw { unsigned short q[16], k[16]; };
__device__ __forceinline__ void gla_prep_load(const P& p, GlaRaw& g, int it, int lane) {
    const int r = lane & 31, hh = lane >> 5;
    const int c = it % NCH, bh = it / NCH, h = bh & 3, b = bh >> 2;
    const size_t row0 = (size_t)b * TOK + (size_t)c * GCH;
    const bf16* qb = p.rest + (row0 + 4 * hh) * NREST + RC_CQ + h * 32 + r;
#pragma unroll
    for (int i = 0; i < 16; ++i) { const int no = (i & 3) + 8 * (i >> 2); g.q[i] = qb[(size_t)no * NREST]; g.k[i] = qb[(size_t)no * NREST + 128]; }
}
__device__ __forceinline__ void gla_prep_item(const P& p, LASP unsigned char* wl, const LASP float* cstab, int l, int it, int lane, const GlaRaw& g) {
    const int r = lane & 31, hh = lane >> 5;
    const int c = it % NCH, bh = it / NCH, h = bh & 3, b = bh >> 2;
    const size_t row0 = (size_t)b * TOK + (size_t)c * GCH;
    float qv[16], kv[16];
#pragma unroll
    for (int i = 0; i < 16; ++i) { qv[i] = bf2f(g.q[i]); kv[i] = bf2f(g.k[i]); }
    if (c >= 8) {
        const int dd = r & 15, f = dd & 7;
        const int prow = (c - 8) >> 1, pcol0 = 32 * ((c - 8) & 1);
#pragma unroll
        for (int i = 0; i < 16; ++i) {
            const int n = crow(i, hh);
            const int pos = r < 16 ? prow : pcol0 + n;
            const float cs = cstab[(pos * 8 + f) * 2], sn = cstab[(pos * 8 + f) * 2 + 1];
            const float qp = __shfl_xor(qv[i], 8), kp = __shfl_xor(kv[i], 8);
            if (dd < 8) { qv[i] = qv[i] * cs - qp * sn; kv[i] = kv[i] * cs - kp * sn; }
            else { qv[i] = qp * sn + qv[i] * cs; kv[i] = kp * sn + kv[i] * cs; }
        }
    }
#pragma unroll
    for (int i = 0; i < 16; ++i) qv[i] *= 0.17677669529663687f;
#pragma unroll 1
    for (int dir = 0; dir < 2; ++dir) {
        f32x16_t X;
#pragma unroll
        for (int i = 0; i < 16; ++i) X[i] = 0.f;
        {
            const bf16x8_t A = *(const bf16x8_t*)(p.rest + (row0 + r) * NREST + RC_CR + dir * 16 + 8 * hh);
            const float* w2p = p.gla_w2 + ((size_t)(l * 2 + dir) * 16 + 8 * hh) * 128 + h * 32 + r;
            const bf16x8_t Bf = __builtin_bit_cast(bf16x8_t, (u32x4_t){cvtpk(w2p[0], w2p[128]), cvtpk(w2p[256], w2p[384]), cvtpk(w2p[512], w2p[640]), cvtpk(w2p[768], w2p[896])});
            X = MFMA32(A, Bf, X);
        }
        const float b2v = p.gla_b2[(l * 2 + dir) * 128 + h * 32 + r];
        float Bc[16];
#pragma unroll
        for (int i = 0; i < 16; ++i) { const float xg = X[i] + b2v; Bc[i] = (fminf(xg, 0.f) - 0.6931471805599453f * __builtin_amdgcn_logf(1.f + __builtin_amdgcn_exp2f(-1.4426950408889634f * fabsf(xg)))) * (1.f / 16.f); }
        float tot;
        {
            float sg[4], ps[4];
#pragma unroll
            for (int g = 0; g < 4; ++g) { sg[g] = (Bc[4 * g] + Bc[4 * g + 1]) + (Bc[4 * g + 2] + Bc[4 * g + 3]); ps[g] = __shfl_xor(sg[g], 32); }
            tot = ((sg[0] + ps[0]) + (sg[1] + ps[1])) + ((sg[2] + ps[2]) + (sg[3] + ps[3]));
            if (dir == 0) {
                float base = 0.f;
#pragma unroll
                for (int g = 0; g < 4; ++g) {
                    float o = base + (hh ? ps[g] : 0.f);
#pragma unroll
                    for (int k = 0; k < 4; ++k) { o += Bc[4 * g + k]; Bc[4 * g + k] = o; }
                    base += sg[g] + ps[g];
                }
            } else {
                float base = 0.f;
#pragma unroll
                for (int g = 3; g >= 0; --g) {
                    float o = base + (hh ? 0.f : ps[g]);
#pragma unroll
                    for (int k = 3; k >= 0; --k) { o += Bc[4 * g + k]; Bc[4 * g + k] = o; }
                    base += sg[g] + ps[g];
                }
            }
        }
        unsigned char* gout = (unsigned char*)p.raw + GLA_PREP_OFF + ((size_t)(bh * 2 + dir) * NCH + c) * GL_ITEM;
        LASP bf16* ql = (LASP bf16*)wl;
        LASP bf16* kl = ql + 32 * 40;
        {
            bf16* qpo = (bf16*)gout + perm16(r);
            bf16* kdo = (bf16*)(gout + 4096) + r * 32;
#pragma unroll
            for (int g = 0; g < 4; ++g) {
                float kd[4];
#pragma unroll
                for (int k = 0; k < 4; ++k) {
                    const int i = 4 * g + k, n = crow(i, hh);
                    const float eb = __builtin_amdgcn_exp2f(1.4426950408889634f * Bc[i]);
                    const float qs = qv[i] * eb, ks = kv[i] * __builtin_amdgcn_rcpf(eb);
                    kd[k] = kv[i] * __builtin_amdgcn_exp2f(1.4426950408889634f * (tot - Bc[i]));
                    const bf16 qsb = f2bf(qs);
                    qpo[n * 32] = qsb;
                    ql[n * 40 + r] = qsb; kl[n * 40 + r] = f2bf(ks);
                }
                *(u32x2_t*)(kdo + perm16(8 * g + 4 * hh)) = (u32x2_t){cvtpk(kd[0], kd[1]), cvtpk(kd[2], kd[3])};
            }
            if (hh == 0) ((float*)(gout + 6144))[r] = __builtin_amdgcn_exp2f(1.4426950408889634f * tot);
        }
        asm volatile("s_waitcnt lgkmcnt(0)" ::: "memory");
        f32x16_t AT;
#pragma unroll
        for (int i = 0; i < 16; ++i) AT[i] = 0.f;
        AT = MFMA32(*(const LASP bf16x8_t*)((const LASP unsigned char*)kl + r * 80 + hh * 16), *(const LASP bf16x8_t*)((const LASP unsigned char*)ql + r * 80 + hh * 16), AT);
        AT = MFMA32(*(const LASP bf16x8_t*)((const LASP unsigned char*)kl + r * 80 + hh * 16 + 32), *(const LASP bf16x8_t*)((const LASP unsigned char*)ql + r * 80 + hh * 16 + 32), AT);
        {
            bf16* amo = (bf16*)(gout + 2048) + r * 32;
#pragma unroll
            for (int g = 0; g < 4; ++g) {
                float a[4];
#pragma unroll
                for (int k = 0; k < 4; ++k) { const int m = crow(4 * g + k, hh); const bool keep = dir == 0 ? (m <= r) : (m >= r); a[k] = keep ? AT[4 * g + k] : 0.f; }
                *(u32x2_t*)(amo + perm16(8 * g + 4 * hh)) = (u32x2_t){cvtpk(a[0], a[1]), cvtpk(a[2], a[3])};
            }
        }
        asm volatile("s_waitcnt lgkmcnt(0)" ::: "memory");
    }
}

constexpr int LS_QP = 0, LS_AM = 2560, LS_KD = 5120, LS_V = 7680, LS_GL = 13824, LS_BYTES = 13952;
constexpr int GLA_OST = 4 * LS_BYTES, GLA_OST_BYTES = 32 * 144;
struct LSlot { u32x4_t a0, a1, a2, v0, v1; f32x4_t gl; };
__device__ __forceinline__ void gla_issue(const P& p, LSlot& g, int b, int h, int dir, int step, int t2) {
    const int c = gdn_chunk(dir, step);
    const unsigned char* gp = (const unsigned char*)p.raw + GLA_PREP_OFF + ((size_t)((b * 4 + h) * 2 + dir) * NCH + c) * GL_ITEM;
    g.a0 = *(const u32x4_t*)(gp + t2 * 16); g.a1 = *(const u32x4_t*)(gp + 2048 + t2 * 16); g.a2 = *(const u32x4_t*)(gp + 4096 + t2 * 16);
    g.gl = *(const f32x4_t*)(gp + 6144 + (t2 < 8 ? t2 : 0) * 16);
    const size_t row0 = (size_t)b * TOK + (size_t)c * GCH;
    const bf16* vp = p.rest + (row0 + (t2 >> 3)) * NREST + RC_CV + h * 64 + 8 * (t2 & 7);
    g.v0 = *(const u32x4_t*)vp; g.v1 = *(const u32x4_t*)(vp + (size_t)16 * NREST);
}
__device__ __forceinline__ void gla_write(LASP unsigned char* st, const LSlot& g, int t2) {
    const int row = t2 >> 2, ch = t2 & 3;
    *(LASP u32x4_t*)(st + LS_QP + row * 80 + ch * 16) = g.a0;
    *(LASP u32x4_t*)(st + LS_AM + row * 80 + ch * 16) = g.a1;
    *(LASP u32x4_t*)(st + LS_KD + row * 80 + ch * 16) = g.a2;
    if (t2 < 8) *(LASP f32x4_t*)(st + LS_GL + t2 * 16) = g.gl;
    *(LASP u32x4_t*)(st + LS_V + (t2 >> 3) * 192 + (t2 & 7) * 16) = g.v0; *(LASP u32x4_t*)(st + LS_V + (16 + (t2 >> 3)) * 192 + (t2 & 7) * 16) = g.v1;
}
__device__ __forceinline__ void gla_flush(const P& p, LASP unsigned char* lds, int b, int h, int dir, int step, int t2) {
    const int c = gdn_chunk(dir, step);
    const LASP unsigned char* ost = lds + GLA_OST + (dir * 2 + (step & 1)) * GLA_OST_BYTES;
    bf16* op = p.oc + ((size_t)dir * ROWS + (size_t)b * TOK + (size_t)c * GCH) * 256 + h * 64;
#pragma unroll
    for (int k = 0; k < 2; ++k) { const int idx = t2 + 128 * k, row = idx >> 3, ch = idx & 7; *(u32x4_t*)(op + (size_t)row * 256 + ch * 8) = *(const LASP u32x4_t*)(ost + row * 144 + ch * 16); }
}
#if TPROBE == 62
#define GLA_SYNC_C() do { unsigned long long t_ = __builtin_amdgcn_s_memrealtime(); __syncthreads(); if (bh == 0 && tid == 0) p.stats[2] += (float)(__builtin_amdgcn_s_memrealtime() - t_) * 0.01f; } while (0)
#define GLA_SYNC_L() __syncthreads()
#elif TPROBE == 63
#define GLA_SYNC_L() do { unsigned long long t_ = __builtin_amdgcn_s_memrealtime(); __syncthreads(); if (bh == 0 && tid == 256) p.stats[2] += (float)(__builtin_amdgcn_s_memrealtime() - t_) * 0.01f; } while (0)
#define GLA_SYNC_C() __syncthreads()
#else
#define GLA_SYNC_C() __syncthreads()
#define GLA_SYNC_L() __syncthreads()
#endif
__device__ void gla_scan_fast(const P& p, LASP unsigned char* lds, int bh) {
    const int tid = mk_tid();
    const int lane = tid & 63, wave = __builtin_amdgcn_readfirstlane(tid >> 6);
    const int h = bh & 3, b = bh >> 2;
    constexpr int NS = NCH;
    if (wave >= 4) {
        const int dir = (wave - 4) >> 1, t2 = tid & 127;
        LASP unsigned char* base = lds + dir * 2 * LS_BYTES;
        LSlot g0, g1, g2, g3, g4, g5, g6, g7;
        gla_issue(p, g0, b, h, dir, 0, t2); gla_issue(p, g1, b, h, dir, 1, t2); gla_issue(p, g2, b, h, dir, 2, t2); gla_issue(p, g3, b, h, dir, 3, t2);
        gla_issue(p, g4, b, h, dir, 4, t2); gla_issue(p, g5, b, h, dir, 5, t2); gla_issue(p, g6, b, h, dir, 6, t2); gla_issue(p, g7, b, h, dir, 7, t2);
        gla_write(base, g0, t2); gla_issue(p, g0, b, h, dir, 8, t2);
        __syncthreads();
        static_assert(NS % 8 == 0, "the loader loop is unrolled by its eight slots");
#define GLA_STEP(u, G) { gla_write(base + ((s + u + 1) & 1) * LS_BYTES, G, t2); gla_issue(p, G, b, h, dir, min(s + u + 9, NS - 1), t2); GLA_SYNC_L(); }
#pragma unroll 1
        for (int s = 0; s < NS; s += 8) { GLA_STEP(0, g1) GLA_STEP(1, g2) GLA_STEP(2, g3) GLA_STEP(3, g4) GLA_STEP(4, g5) GLA_STEP(5, g6) GLA_STEP(6, g7) GLA_STEP(7, g0) }
#undef GLA_STEP
    } else {
        const int r = lane & 31, hh = lane >> 5, dir = wave >> 1, blk = wave & 1;
        const int t2c = blk * 64 + lane;
        LASP unsigned char* base = lds + dir * 2 * LS_BYTES;
        f32x16_t S;
#pragma unroll
        for (int i = 0; i < 16; ++i) S[i] = 0.f;
        __syncthreads();
        const int troff = (4 * hh + ((lane & 15) >> 2)) * 192 + (16 * ((lane >> 4) & 1) + 4 * (lane & 3)) * 2 + 64 * blk;
#define TRFRAG192(bs) __builtin_shufflevector(trd(bs), trd((bs) + 8 * 192), 0, 1, 2, 3, 4, 5, 6, 7)
#pragma unroll 1
        for (int s = 0; s < NS; ++s) {
            const LASP unsigned char* st = base + (s & 1) * LS_BYTES;
#if TPROBE == 64 || TPROBE == 65
            const unsigned long long ttop_ = __builtin_amdgcn_s_memrealtime();
            __builtin_amdgcn_sched_barrier(0);
#endif
            const LASP unsigned char* qp = st + LS_QP + r * 80 + hh * 16;
            const LASP unsigned char* am = st + LS_AM + r * 80 + hh * 16;
            const LASP unsigned char* kd = st + LS_KD + r * 80 + hh * 16;
            const bf16x8_t QP0 = *(const LASP bf16x8_t*)(qp), QP1 = *(const LASP bf16x8_t*)(qp + 32);
            const bf16x8_t AM0 = *(const LASP bf16x8_t*)(am), AM1 = *(const LASP bf16x8_t*)(am + 32);
            const bf16x8_t KD0 = *(const LASP bf16x8_t*)(kd), KD1 = *(const LASP bf16x8_t*)(kd + 32);
            const LASP unsigned char* vb = st + LS_V + troff;
            const bf16x8_t V0 = TRFRAG192(vb), V1 = TRFRAG192(vb + 16 * 192);
            const LASP float* glp = (const LASP float*)(st + LS_GL);
            const f32x4_t g0 = *(const LASP f32x4_t*)(glp + 4 * hh), g1 = *(const LASP f32x4_t*)(glp + 8 + 4 * hh), g2 = *(const LASP f32x4_t*)(glp + 16 + 4 * hh), g3 = *(const LASP f32x4_t*)(glp + 24 + 4 * hh);
            if (s > 0) gla_flush(p, lds, b, h, dir, s - 1, t2c);
            __builtin_amdgcn_sched_barrier(0);
#if TPROBE == 64 || TPROBE == 65
            asm volatile("s_waitcnt lgkmcnt(0)" ::: "memory");
            const unsigned long long tmid_ = __builtin_amdgcn_s_memrealtime();
            if (TPROBE == 64 && bh == 0 && tid == 0) p.stats[2] += (float)(tmid_ - ttop_) * 0.01f;
            __builtin_amdgcn_sched_barrier(0);
#endif
            const bf16x8_t Sb0 = PACK8(S, 0), Sb1 = PACK8(S, 1);
            f32x16_t oT;
#pragma unroll
            for (int i = 0; i < 16; ++i) oT[i] = 0.f;
            oT = MFMA32(V0, AM0, oT); oT = MFMA32(V1, AM1, oT);
            oT = MFMA32(Sb0, QP0, oT); oT = MFMA32(Sb1, QP1, oT);
            S[0] *= g0.x; S[1] *= g0.y; S[2] *= g0.z; S[3] *= g0.w; S[4] *= g1.x; S[5] *= g1.y; S[6] *= g1.z; S[7] *= g1.w;
            S[8] *= g2.x; S[9] *= g2.y; S[10] *= g2.z; S[11] *= g2.w; S[12] *= g3.x; S[13] *= g3.y; S[14] *= g3.z; S[15] *= g3.w;
            S = MFMA32(KD0, V0, S);
            S = MFMA32(KD1, V1, S);
            {
                LASP unsigned char* ost = lds + GLA_OST + (dir * 2 + (s & 1)) * GLA_OST_BYTES + r * 144 + (32 * blk + 4 * hh) * 2;
#pragma unroll
                for (int g = 0; g < 4; ++g) *(LASP u32x2_t*)(ost + 16 * g) = (u32x2_t){cvtpk(oT[4 * g], oT[4 * g + 1]), cvtpk(oT[4 * g + 2], oT[4 * g + 3])};
            }
#if TPROBE == 65
            __builtin_amdgcn_sched_barrier(0);
            asm volatile("s_nop 15\n\ts_nop 15" ::: "memory");
            if (bh == 0 && tid == 0) p.stats[2] += (float)(__builtin_amdgcn_s_memrealtime() - tmid_) * 0.01f;
#endif
            GLA_SYNC_C();
        }
        gla_flush(p, lds, b, h, dir, NS - 1, t2c);
    }
}


__device__ __forceinline__ void vf_items(const P& p, LASP unsigned char* wl, int it0, int stride, int lane) {
    const int r = lane & 31, hh = lane >> 5;
    constexpr int NIT = BATCH * 4 * NCH;
    u32x4_t ld[3][4];
#pragma unroll
    for (int k = 0; k < 3; ++k) {
        const int it = it0 + k * stride;
        if (it < NIT) {
            const int kb = it % NCH, bh = it / NCH, h = bh & 3, b = bh >> 2;
            const bf16* vp = p.rest + ((size_t)b * TOK + 32 * kb + r) * NREST + RC_BV + h * 64 + 32 * hh;
#pragma unroll
            for (int q = 0; q < 4; ++q) ld[k][q] = *(const u32x4_t*)(vp + 8 * q);
        }
    }
#pragma unroll
    for (int k = 0; k < 3; ++k) {
        const int it = it0 + k * stride;
        if (it < NIT) {
#pragma unroll
            for (int q = 0; q < 4; ++q) *(LASP u32x4_t*)(wl + k * 5120 + r * 160 + (32 * hh + 8 * q) * 2) = ld[k][q];
        }
    }
    asm volatile("s_waitcnt lgkmcnt(0)" ::: "memory");
    const int troff = (4 * hh + ((lane & 15) >> 2)) * 160 + (16 * ((lane >> 4) & 1) + 4 * (lane & 3)) * 2;
#pragma unroll
    for (int k = 0; k < 3; ++k) {
        const int it = it0 + k * stride;
        if (it < NIT) {
            const int kb = it % NCH, bh = it / NCH;
            bf16* op = p.vf + ((size_t)(bh * NCH + kb) * 4) * 512 + lane * 8;
#pragma unroll
            for (int dvb = 0; dvb < 2; ++dvb)
#pragma unroll
                for (int u = 0; u < 2; ++u) {
                    const LASP unsigned char* bs = wl + k * 5120 + troff + 64 * dvb + (16 * u) * 160;
                    const bf16x8_t f = __builtin_shufflevector(trd(bs), trd(bs + 8 * 160), 0, 1, 2, 3, 4, 5, 6, 7);
                    *(bf16x8_t*)(op + (dvb * 2 + u) * 512) = f;
                }
        }
    }
    asm volatile("s_waitcnt lgkmcnt(0)" ::: "memory");
}

__device__ __forceinline__ void na_item(const P& p, const LASP float* rpbL, int it, int lane) {
    const int r = lane & 31, hh = lane >> 5;
    int b, h, ry, qb; bool lat;
    if (it < 4096) { lat = true; qb = it & 1; ry = (it >> 1) & 63; h = (it >> 7) & 3; b = it >> 9; }
    else { const int j = it - 4096; lat = false; qb = j & 7; h = (j >> 3) & 3; b = j >> 5; ry = 0; }
    const size_t brow = (size_t)b * TOK;
    const int q0 = lat ? CTX + ry * 64 + qb * 32 : qb * 32;
    bf16* qp = p.rest + (brow + q0 + r) * NREST + RC_BQ + h * 64;
    bf16x8_t Qf0 = *(const bf16x8_t*)(qp + 8 * hh), Qf1 = *(const bf16x8_t*)(qp + 16 + 8 * hh), Qf2 = *(const bf16x8_t*)(qp + 32 + 8 * hh), Qf3 = *(const bf16x8_t*)(qp + 48 + 8 * hh);
    f32x16_t O0, O1;
#pragma unroll
    for (int i = 0; i < 16; ++i) { O0[i] = 0.f; O1[i] = 0.f; }
    float m = -1e30f, lsum = 0.f;
    const bf16* kfb = p.kf + ((size_t)(b * 4 + h) * NCH) * 2048 + lane * 8;
    const bf16* vfb = p.vf + ((size_t)(b * 4 + h) * NCH) * 2048 + lane * 8;
    const int nkb = lat ? 24 : 8;
    const int c = qb * 32 + r, c0 = min(max(c - 8, 0), 48), r0 = min(max(ry - 4, 0), 56);
    constexpr float SC = 0.125f * 1.4426950408889634f;
    struct KV { bf16x8_t k0, k1, k2, k3, v00, v01, v10, v11; };
    KV fA, fB;
#define NA_KBIDX(kq) ((kq) < 8 ? (kq) : 8 + (r0 + (((kq) - 8) >> 1)) * 2 + (((kq) - 8) & 1))
#define NA_LOAD(F, kq) { const size_t o_ = (size_t)NA_KBIDX(min((kq), nkb - 1)) * 2048; const bf16* kp = kfb + o_; const bf16* vp = vfb + o_; \
        F.k0 = *(const bf16x8_t*)(kp); F.k1 = *(const bf16x8_t*)(kp + 512); F.k2 = *(const bf16x8_t*)(kp + 1024); F.k3 = *(const bf16x8_t*)(kp + 1536); \
        F.v00 = *(const bf16x8_t*)(vp); F.v01 = *(const bf16x8_t*)(vp + 512); F.v10 = *(const bf16x8_t*)(vp + 1024); F.v11 = *(const bf16x8_t*)(vp + 1536); }
    NA_LOAD(fA, 0) NA_LOAD(fB, 1)
#define NA_BLOCK(F, kq) { \
        const int kb_ = (kq); int ky = 0, cb = 0; const bool win = kb_ >= 8; \
        if (win) { const int w_ = kb_ - 8; ky = r0 + (w_ >> 1); cb = w_ & 1; } \
        f32x16_t S; _Pragma("unroll") for (int i = 0; i < 16; ++i) S[i] = 0.f; \
        S = MFMA32(F.k0, Qf0, S); S = MFMA32(F.k1, Qf1, S); S = MFMA32(F.k2, Qf2, S); S = MFMA32(F.k3, Qf3, S); \
        const bf16x8_t V00 = F.v00, V01 = F.v01, V10 = F.v10, V11 = F.v11; \
        NA_LOAD(F, kb_ + 2) \
        float bm = -1e30f; \
        if (win) { \
            const LASP float* rb = rpbL + (h * 15 + (ky - ry + 7)) * 31 + 15 - c; \
            _Pragma("unroll") for (int i = 0; i < 16; ++i) { \
                const int kc = cb * 32 + crow(i, hh); \
                const bool valid = (kc >= c0) && (kc < c0 + 16); \
                const float bias = rb[valid ? kc : c]; \
                S[i] = valid ? S[i] * SC + bias : -1e30f; \
                bm = fmaxf(bm, S[i]); } \
        } else { _Pragma("unroll") for (int i = 0; i < 16; ++i) { S[i] *= SC; bm = fmaxf(bm, S[i]); } } \
        bm = fmaxf(bm, __shfl_xor(bm, 32)); \
        const float mn = fmaxf(m, bm); \
        float ps = 0.f; \
        _Pragma("unroll") for (int i = 0; i < 16; ++i) { S[i] = __builtin_amdgcn_exp2f(S[i] - mn); ps += S[i]; } \
        if (__builtin_amdgcn_ballot_w64(bm > m) != 0ull) {        \
            const float alpha = __builtin_amdgcn_exp2f(m - mn); \
            lsum *= alpha; \
            _Pragma("unroll") for (int i = 0; i < 16; ++i) { O0[i] *= alpha; O1[i] *= alpha; } \
        } \
        m = mn; \
        lsum += ps; \
        const bf16x8_t Pb0 = PACK8(S, 0), Pb1 = PACK8(S, 1); \
        O0 = MFMA32(V00, Pb0, O0); O0 = MFMA32(V01, Pb1, O0); \
        O1 = MFMA32(V10, Pb0, O1); O1 = MFMA32(V11, Pb1, O1); }
#pragma unroll 1
    for (int kb = 0; kb < nkb; kb += 2) { NA_BLOCK(fA, kb) NA_BLOCK(fB, kb + 1) }
#undef NA_BLOCK
#undef NA_LOAD
#undef NA_KBIDX
    const float inv = 1.f / (lsum + __shfl_xor(lsum, 32));
    bf16* op = qp + 4 * hh;
#pragma unroll
    for (int g = 0; g < 4; ++g) {
        *(u32x2_t*)(op + 8 * g) = (u32x2_t){cvtpk(O0[4 * g] * inv, O0[4 * g + 1] * inv), cvtpk(O0[4 * g + 2] * inv, O0[4 * g + 3] * inv)};
        *(u32x2_t*)(op + 32 + 8 * g) = (u32x2_t){cvtpk(O1[4 * g] * inv, O1[4 * g + 1] * inv), cvtpk(O1[4 * g + 2] * inv, O1[4 * g + 3] * inv)};
    }
}

__device__ void ph_prep_early(const P& p, LASP unsigned char* lds, int l, int bid, int nblk) {
    const int tid = mk_tid();
    const int lane = tid & 63, wave = tid >> 6;
    for (int it0 = bid * NWAVES + wave; it0 < BATCH * 4 * NCH; it0 += 3 * nblk * NWAVES) vf_items(p, lds + wave * 16384, it0, nblk * NWAVES, lane);
}
constexpr int GLA_EARLY = 1280;
__device__ __forceinline__ void gla_cstab(const P& p, LASP float* cstab, int tid) {
    const f32x2_t v = *(const f32x2_t*)(p.cst + tid * 2);
    cstab[tid * 2] = v.x; cstab[tid * 2 + 1] = v.y;
}
__device__ void ph_prep(const P& p, LASP unsigned char* lds, int l, int bid, int nblk) {
    const int tid = mk_tid();
    LASP float* cstab = (LASP float*)(lds + 131072);
    gla_cstab(p, cstab, tid);
    __syncthreads();
    ph_gdnprep(p, lds, l, bid, nblk, tid);
    const int tid2 = mk_tid();
    const int lane = tid2 & 63, wave = tid2 >> 6;
    const int it = (bid - 32) * NWAVES + wave;
    if (it >= 0 && it < GLA_EARLY) { GlaRaw g; gla_prep_load(p, g, it, lane); gla_prep_item(p, lds + wave * 16384, cstab, l, it, lane, g); }
}
__device__ void ph_glaprep(const P& p, LASP unsigned char* lds, int l, int sb, int ns) {
    const int tid = mk_tid();
    LASP float* cstab = (LASP float*)(lds + 131072);
    gla_cstab(p, cstab, tid);
    __syncthreads();
    const int lane = tid & 63, wave = tid >> 6;
    const int NIT = BATCH * 4 * NCH, st = ns * NWAVES;
    for (int it = GLA_EARLY + sb * NWAVES + wave; it < NIT; it += 2 * st) {
        GlaRaw g0, g1;
        gla_prep_load(p, g0, it, lane);
        const bool two = it + st < NIT;
        if (two) gla_prep_load(p, g1, it + st, lane);
        gla_prep_item(p, lds + wave * 16384, cstab, l, it, lane, g0);
        if (two) gla_prep_item(p, lds + wave * 16384, cstab, l, it + st, lane, g1);
    }
}

constexpr int NGDN_BLOCKS = BATCH * 4 * 2;
__device__ void ph_mix(const P& p, LASP unsigned char* lds, int l, int bid, int nblk) {
    constexpr int NGDN = NGDN_BLOCKS;
    constexpr int NGLA = BATCH * 4;
    if (bid < NGDN) { gdn_scan_fast(p, lds, bid); return; }
    if (bid < NGDN + NGLA) { gla_scan_fast(p, lds, bid - NGDN); return; }
    const int tid = mk_tid();
    const int lane = tid & 63, wave = tid >> 6;
    LASP float* rpbL = (LASP float*)lds;
    for (int i = tid; i < 4 * 15 * 31; i += NTHREADS) rpbL[i] = p.rpb[(size_t)l * 4 * 15 * 31 + i] * 1.4426950408889634f;
    __syncthreads();
    const int total = 4096 + (l == 0 ? 256 : 0);
    const int nb = bid - NGDN - NGLA;
    const int nna = nblk - NGDN - NGLA, vb = nna == 160 ? (nb & 7) * 20 + (nb >> 3) : nb;
    for (int it = vb * NWAVES + wave; it < total; it += nna * NWAVES) na_item(p, rpbL, it, lane);
}

__device__ void ph_gate(const P& p, int l, int bid, int nblk) {
    const int tid = mk_tid();
    const int tq = tid & 127, rsub = tid >> 7;
    const int kind = tq < 64 ? 0 : (tq < 96 ? 1 : 2);
    const int cb = kind == 0 ? tq * 8 : (kind == 1 ? (tq - 64) * 8 : (tq - 96) * 8);
    const int zoff = kind == 0 ? RC_AZ + cb : (kind == 1 ? RC_BZ + cb : RC_CZ + cb);
    const int oc = kind == 0 ? cb : (kind == 1 ? 512 + cb : 768 + cb);
    float nw[8];
#pragma unroll
    for (int e = 0; e < 8; ++e) nw[e] = kind == 0 ? p.gdn_norm[l * 128 + ((cb + e) & 127)] : (kind == 2 ? p.gla_norm[l * 64 + ((cb + e) & 63)] : 1.f);
    const bool lat = l == 1;
    const int ngrp = lat ? BATCH * SEQ / 16 : ROWS / 16, nfull = ngrp / nblk, nrem = ngrp - nfull * nblk;
    const bool halves = 2 * nrem == nblk;
    for (int k = 0; k < nfull + 1; ++k) {
        int g = k * nblk + bid, nj = 4, sub = 0;
        if (k == nfull) {
            if (halves) { g = nfull * nblk + (bid >> 1); sub = 8 * (bid & 1); nj = 2; }
            else if (bid >= nrem) break;
        }
        const int r0 = (lat ? (g / (SEQ / 16)) * (TOK / 16) + CTX / 16 + g % (SEQ / 16) : g) * 16 + sub;
        uint4 a[4], bb[4], zz[4];
#pragma unroll
        for (int j = 0; j < 4; ++j) if (j < nj) {
            const size_t r = (size_t)(r0 + rsub + 4 * j);
            const bf16* pr = p.rest + r * NREST;
            zz[j] = *(const uint4*)(pr + zoff);
            if (kind == 0) { a[j] = *(const uint4*)(p.oa + r * 512 + cb); bb[j] = *(const uint4*)(p.oa + ((size_t)ROWS + r) * 512 + cb); }
            else if (kind == 1) { a[j] = *(const uint4*)(pr + RC_BQ + cb); bb[j] = make_uint4(0, 0, 0, 0); }
            else { a[j] = *(const uint4*)(p.oc + r * 256 + cb); bb[j] = *(const uint4*)(p.oc + ((size_t)ROWS + r) * 256 + cb); }
        }
#pragma unroll
        for (int j = 0; j < 4; ++j) if (j < nj) {
            float fa[8], fb[8], z[8], o[8];
            unpack8(a[j], fa); unpack8(bb[j], fb); unpack8(zz[j], z);
            float ss = 0.f;
#pragma unroll
            for (int e = 0; e < 8; ++e) { o[e] = fa[e] + fb[e]; ss += o[e] * o[e]; }
            float rs = 1.f;
            if (kind == 0) {
#pragma unroll
                for (int m = 8; m > 0; m >>= 1) ss += __shfl_xor(ss, m);
                rs = __builtin_amdgcn_rsqf(ss * (1.f / 128.f) + 1e-6f);
            } else if (kind == 2) {
#pragma unroll
                for (int m = 4; m > 0; m >>= 1) ss += __shfl_xor(ss, m);
                rs = __builtin_amdgcn_rsqf(ss * (1.f / 64.f) + 1e-6f);
            }
            float res[8];
#pragma unroll
            for (int e = 0; e < 8; ++e) res[e] = o[e] * rs * nw[e] * silu_f(z[e]);
            uint4 w; w.x = pk2(res[0], res[1]); w.y = pk2(res[2], res[3]); w.z = pk2(res[4], res[5]); w.w = pk2(res[6], res[7]);
            *(uint4*)(p.mix + (size_t)(r0 + rsub + 4 * j) * D + oc) = w;
        }
    }
}

#if PROBE
__device__ void gdn_scan_naive(const P& p, LASP float* sm, int l, int b, int hp, bf16* nb) {
    const int tid = mk_tid();
    LASP float* skq = sm;
    LASP float* sv = sm + 4 * 16 * 256;
    LASP float* sg = sv + 4 * 16 * 128;
    LASP float* sb = sg + 64;
    const int sub = tid >> 7, col = tid & 127, dir = sub & 1, h = hp * 2 + (sub >> 1);
    float S[128];
#pragma unroll
    for (int i = 0; i < 128; ++i) S[i] = 0.f;
    for (int s0 = 0; s0 < TOK; s0 += 16) {
        __syncthreads();
        for (int i = tid; i < 4 * 16 * 48; i += NTHREADS) {
            const int su = i / (16 * 48), rem = i % (16 * 48), j = rem / 48, chunk = rem % 48;
            const int sd = su & 1, hh = hp * 2 + (su >> 1);
            const int t = tok_of(sd, s0 + j);
            const size_t row = (size_t)b * TOK + t;
            const int part = chunk >> 4, c8 = chunk & 15;
            const uint4 w = *(const uint4*)(p.qkvn + row * NRAW + part * 512 + hh * 128 + c8 * 8);
            float f[8]; unpack8(w, f);
            LASP float* dst = (part < 2) ? skq + (su * 16 + j) * 256 + part * 128 + c8 * 8 : sv + (su * 16 + j) * 128 + c8 * 8;
#pragma unroll
            for (int e = 0; e < 8; ++e) dst[e] = f[e];
        }
        if (tid < 64) {
            const int su = tid >> 4, j = tid & 15, sd = su & 1, hh = hp * 2 + (su >> 1);
            const int t = tok_of(sd, s0 + j);
            const bf16* ab = p.rest + ((size_t)b * TOK + t) * NREST + RC_AB;
            const float a = bf2f(ab[sd * 4 + hh]) + p.dt_bias[(l * 2 + sd) * 4 + hh];
            const float sp = fmaxf(a, 0.f) + log1pf(expf(-fabsf(a)));
            const float g = -expf(p.a_log[(l * 2 + sd) * 4 + hh]) * sp;
            sg[su * 16 + j] = expf(g);
            const float bx = bf2f(ab[(2 + sd) * 4 + hh]);
            sb[su * 16 + j] = 1.f / (1.f + expf(-bx));
        }
        __syncthreads();
#pragma unroll 1
        for (int j = 0; j < 16; ++j) {
            const LASP float* qp = skq + (sub * 16 + j) * 256;
            const LASP float* kp = qp + 128;
            const float dec = sg[sub * 16 + j], bt = sb[sub * 16 + j];
            const float v = sv[(sub * 16 + j) * 128 + col];
            float d0 = 0.f, d1 = 0.f, d2 = 0.f, d3 = 0.f;
#pragma unroll
            for (int k4 = 0; k4 < 32; ++k4) {
                const f32x4_t kv = *(const LASP f32x4_t*)(kp + k4 * 4);
                d0 += S[k4 * 4] * kv.x; d1 += S[k4 * 4 + 1] * kv.y; d2 += S[k4 * 4 + 2] * kv.z; d3 += S[k4 * 4 + 3] * kv.w;
                if ((k4 & 7) == 7) __builtin_amdgcn_sched_barrier(0);
            }
            const float dot = (d0 + d1) + (d2 + d3);
            const float vn = bt * (v - dec * dot);
            float o0 = 0.f, o1 = 0.f, o2 = 0.f, o3 = 0.f;
#pragma unroll
            for (int k4 = 0; k4 < 32; ++k4) {
                const f32x4_t kv = *(const LASP f32x4_t*)(kp + k4 * 4);
                const f32x4_t qv = *(const LASP f32x4_t*)(qp + k4 * 4);
                S[k4 * 4] = dec * S[k4 * 4] + kv.x * vn; o0 += S[k4 * 4] * qv.x;
                S[k4 * 4 + 1] = dec * S[k4 * 4 + 1] + kv.y * vn; o1 += S[k4 * 4 + 1] * qv.y;
                S[k4 * 4 + 2] = dec * S[k4 * 4 + 2] + kv.z * vn; o2 += S[k4 * 4 + 2] * qv.z;
                S[k4 * 4 + 3] = dec * S[k4 * 4 + 3] + kv.w * vn; o3 += S[k4 * 4 + 3] * qv.w;
                if ((k4 & 3) == 3) __builtin_amdgcn_sched_barrier(0);
            }
            const int t = tok_of(dir, s0 + j);
            nb[((size_t)dir * TOK + t) * 256 + (h & 1) * 128 + col] = f2bf((o0 + o1) + (o2 + o3));
        }
    }
    __syncthreads();
}

__device__ void gla_scan_naive(const P& p, LASP float* sm, int l, int b, bf16* nb) {
    const int tid = mk_tid();
    LASP float* sq = sm;
    LASP float* sv = sm + 8 * 16 * 96;
    const int grp = tid >> 6, lane = tid & 63, h = grp >> 1, dir = grp & 1;
    const int d = lane & 31, par = lane >> 5;
    float w2c[16];
#pragma unroll
    for (int j = 0; j < 16; ++j) w2c[j] = p.gla_w2[((size_t)(l * 2 + dir) * 16 + j) * 128 + h * 32 + d];
    const float b2v = p.gla_b2[(l * 2 + dir) * 128 + h * 32 + d];
    const int dd = d & 15, f = dd & 7;
    const float inv = powf(10000.f, -(float)f / 8.f);
    const int pd = dd < 8 ? d + 8 : d - 8;
    float S[32];
#pragma unroll
    for (int i = 0; i < 32; ++i) S[i] = 0.f;
    for (int s0 = 0; s0 < TOK; s0 += 16) {
        __syncthreads();
#pragma unroll 1
        for (int jj = 0; jj < 8; ++jj) {
            const int j = par + 2 * jj;
            const int t = tok_of(dir, s0 + j);
            const bf16* base = p.rest + ((size_t)b * TOK + t) * NREST;
            float qv = bf2f(base[RC_CQ + h * 32 + d]), kv = bf2f(base[RC_CK + h * 32 + d]);
            if (t >= CTX) {
                const int pidx = t - CTX;
                const int pos = d < 16 ? (pidx >> 6) : (pidx & 63);
                const float ang = (float)pos * inv;
                const float cs = cosf(ang), sn = sinf(ang);
                const float qp = bf2f(base[RC_CQ + h * 32 + pd]), kp = bf2f(base[RC_CK + h * 32 + pd]);
                if (dd < 8) { qv = qv * cs - qp * sn; kv = kv * cs - kp * sn; }
                else { qv = qp * sn + qv * cs; kv = kp * sn + kv * cs; }
            }
            qv *= 0.17677669529663687f;
            float xg = b2v;
#pragma unroll
            for (int jr = 0; jr < 16; ++jr) xg += bf2f(base[RC_CR + dir * 16 + jr]) * w2c[jr];
            const float ls = fminf(xg, 0.f) - log1pf(expf(-fabsf(xg)));
            LASP float* dst = sq + (grp * 16 + j) * 96;
            dst[d] = qv; dst[32 + d] = kv; dst[64 + d] = expf(ls * (1.f / 16.f));
        }
        for (int i = lane; i < 16 * 64; i += 64) {
            const int j = i >> 6, c = i & 63;
            const int t = tok_of(dir, s0 + j);
            sv[(grp * 16 + j) * 64 + c] = bf2f(p.rest[((size_t)b * TOK + t) * NREST + RC_CV + h * 64 + c]);
        }
        __syncthreads();
#pragma unroll 1
        for (int j = 0; j < 16; ++j) {
            const LASP float* qp = sq + (grp * 16 + j) * 96;
            const LASP float* kp = qp + 32;
            const LASP float* dp = qp + 64;
            const float v = sv[(grp * 16 + j) * 64 + lane];
            float o0 = 0.f, o1 = 0.f;
#pragma unroll
            for (int e = 0; e < 32; e += 2) {
                S[e] = dp[e] * S[e] + kp[e] * v; o0 += S[e] * qp[e];
                S[e + 1] = dp[e + 1] * S[e + 1] + kp[e + 1] * v; o1 += S[e + 1] * qp[e + 1];
            }
            const int t = tok_of(dir, s0 + j);
            nb[((size_t)dir * TOK + t) * 256 + h * 64 + lane] = f2bf(o0 + o1);
        }
    }
    __syncthreads();
}

__device__ void na_query_naive(const P& p, LASP float* sm, int l, int b, int t0, bf16* nb) {
    const int tid = mk_tid();
    const int wave = tid >> 6, lane = tid & 63, h = wave & 3, t = t0 + (wave >> 2);
    LASP float* pw = sm + wave * 384;
    const size_t rowq = (size_t)b * TOK + t;
    float qv[64];
    {
        const bf16* qs = p.rest + rowq * NREST + RC_BQ + h * 64;
#pragma unroll
        for (int i = 0; i < 8; ++i) {
            float f[8]; unpack8(*(const uint4*)(qs + i * 8), f);
#pragma unroll
            for (int e = 0; e < 8; ++e) qv[i * 8 + e] = f[e] * 0.125f;
        }
    }
    const bool lat = t >= CTX;
    const int nk = lat ? 384 : 256;
    int r = 0, c = 0, r0 = 0, c0 = 0;
    if (lat) { int pi = t - CTX; r = pi >> 6; c = pi & 63; r0 = min(max(r - 4, 0), 56); c0 = min(max(c - 8, 0), 48); }
    float m = -1e30f;
    __syncthreads();
#pragma unroll 1
    for (int j = 0; j < 6; ++j) {
        const int idx = lane + 64 * j;
        float s = -1e30f;
        if (idx < nk) {
            int tk; float bias = 0.f;
            if (lat && idx < 128) {
                const int i = idx >> 4, kc = c0 + (idx & 15);
                tk = CTX + (r0 + i) * 64 + kc;
                bias = p.rpb[((size_t)(l * 4 + h) * 15 + (r0 + i - r + 7)) * 31 + (kc - c + 15)];
            } else tk = lat ? idx - 128 : idx;
            const bf16* ks = p.kf + (((size_t)(b * 4 + h) * NCH + (tk >> 5)) * 4 * 64 + (tk & 31)) * 8;
            float d0 = 0.f, d1 = 0.f;
#pragma unroll
            for (int i = 0; i < 8; ++i) {
                float f[8]; unpack8(*(const uint4*)(ks + ((i >> 1) * 64 + (i & 1) * 32) * 8), f);
#pragma unroll
                for (int e = 0; e < 8; e += 2) { d0 += qv[i * 8 + e] * f[e]; d1 += qv[i * 8 + e + 1] * f[e + 1]; }
            }
            s = d0 + d1 + bias;
        }
        pw[idx] = s;
        m = fmaxf(m, s);
    }
    m = wave_max(m);
    float sum = 0.f;
#pragma unroll 1
    for (int j = 0; j < 6; ++j) { const float e = expf(pw[lane + 64 * j] - m); pw[lane + 64 * j] = e; sum += e; }
    sum = wave_sum(sum);
    const float inv = 1.f / sum;
    __syncthreads();
    float o0 = 0.f, o1 = 0.f;
    for (int idx = 0; idx < nk; idx += 2) {
        int tk0;
        if (lat && idx < 128) tk0 = CTX + (r0 + (idx >> 4)) * 64 + c0 + (idx & 15);
        else tk0 = lat ? idx - 128 : idx;
        o0 += pw[idx] * bf2f(p.rest[((size_t)b * TOK + tk0) * NREST + RC_BV + h * 64 + lane]);
        o1 += pw[idx + 1] * bf2f(p.rest[((size_t)b * TOK + tk0 + 1) * NREST + RC_BV + h * 64 + lane]);
    }
    nb[(size_t)t * 256 + h * 64 + lane] = f2bf((o0 + o1) * inv);
}


__device__ void ph_probe_naive(const P& p, LASP float* sm, int l, int bid, int nblk) {
    bf16* nb = (bf16*)p.xc1;
    if (PROBE == 1) { if (bid == 0) gdn_scan_naive(p, sm, l, 0, 0, nb); }
    else if (PROBE == 3) { if (bid == 0) gla_scan_naive(p, sm, l, 0, nb); }
    else { for (int it = bid; it < TOK / 2; it += nblk) na_query_naive(p, sm, l, 0, it * 2, nb); }
}
__device__ void ph_probe_cmp(const P& p, int bid, int nblk) {
    const int tid = mk_tid();
    const bf16* nb = (const bf16*)p.xc1;
    float md = 0.f, mr = 0.f;
    const int n = (PROBE == 2) ? TOK * 256 : 2 * TOK * 256;
    for (int i = bid * NTHREADS + tid; i < n; i += nblk * NTHREADS) {
        float a, r = bf2f(nb[i]);
        if (PROBE == 1) { const int dir = i / (TOK * 256), rem = i % (TOK * 256), t = rem >> 8, c = rem & 255; a = bf2f(p.oa[((size_t)dir * ROWS + t) * 512 + c]); }
        else if (PROBE == 3) { const int dir = i / (TOK * 256), rem = i % (TOK * 256); a = bf2f(p.oc[(size_t)dir * ROWS * 256 + rem]); }
        else { const int t = i >> 8, c = i & 255; a = bf2f(p.rest[(size_t)t * NREST + RC_BQ + c]); }
        md = fmaxf(md, fabsf(a - r)); mr = fmaxf(mr, fabsf(r));
    }
    md = wave_max(md); mr = wave_max(mr);
    if ((tid & 63) == 0) { atomicMax((unsigned*)p.stats, __float_as_uint(md)); atomicMax((unsigned*)p.stats + 1, __float_as_uint(mr)); }
}
#endif

#define XB_TMO      128
#define XB_XCNT(j)  (256  + 64 * (j))
#define XB_XSUB(j)  (1280 + 64 * (j))
#define XB_XGEN(j)  (2304 + 64 * (j))
#define XB_TOP      3328
#define XB_TOPGEN   3392
#define XCD_BAR_WORDS 3456
#define XB_SPIN_CAP (1u << 18)

__device__ __forceinline__ unsigned xb_ld(unsigned* p)              { return __hip_atomic_load(p, __ATOMIC_RELAXED, __HIP_MEMORY_SCOPE_AGENT); }
__device__ __forceinline__ unsigned xb_add(unsigned* p, unsigned v) { return __hip_atomic_fetch_add(p, v, __ATOMIC_RELAXED, __HIP_MEMORY_SCOPE_AGENT); }
__device__ __forceinline__ unsigned xb_xcc_id() { return (unsigned)__builtin_amdgcn_s_getreg((3 << 11) | 20) & 0xFu; }
#define XB_SPIN(cond, bar) do { unsigned _sp = 0; while (cond) { __builtin_amdgcn_s_sleep(1); \
    if ((++_sp & 255u) == 0u) { if (xb_ld(&(bar)[XB_TMO])) break; if (_sp > XB_SPIN_CAP) { atomicAdd(&(bar)[XB_TMO], 1u); break; } } } } while (0)

struct XcdBarrier {
    unsigned* bar; unsigned x; unsigned G;
    volatile LASP unsigned* st;
};

__device__ __forceinline__ XcdBarrier xcd_barrier_post(unsigned* bar, volatile LASP unsigned* st) {
    XcdBarrier b; b.bar = bar; b.x = xb_xcc_id(); b.st = st; b.G = gridDim.x;
    if ((int)threadIdx.x == 0) (void)xb_add(&bar[XB_XCNT(b.x)], 1u);
    return b;
}
__device__ __forceinline__ void xcd_barrier_complete(unsigned* bar, unsigned x, unsigned& nloc, unsigned& nx, unsigned G) {
    unsigned sum, cnt, mine, sp = 0u;
    for (;;) {
        sum = 0u; cnt = 0u; mine = 0u;
#pragma unroll
        for (unsigned j = 0; j < 16; ++j) { const unsigned c = xb_ld(&bar[XB_XCNT(j)]); sum += c; cnt += (c > 0u) ? 1u : 0u; mine = (j == x) ? c : mine; }
        if (sum == G) break;
        __builtin_amdgcn_s_sleep(1);
        if ((++sp & 255u) == 0u) { if (xb_ld(&bar[XB_TMO])) break; if (sp > XB_SPIN_CAP) { atomicAdd(&bar[XB_TMO], 1u); break; } }
    }
    nloc = mine > 0u ? mine : 1u; nx = cnt > 0u ? cnt : 1u;
}

__device__ __forceinline__ void xcd_barrier(const XcdBarrier& b) {
    asm volatile("s_waitcnt vmcnt(0)" ::: "memory");
    __syncthreads();
    if ((int)threadIdx.x == 0) {
        unsigned* bar = b.bar;
        __builtin_amdgcn_s_waitcnt(0);
        unsigned nloc = b.st[0], nx = b.st[1];
        if (nloc == 0u) { xcd_barrier_complete(bar, b.x, nloc, nx, b.G); b.st[0] = nloc; b.st[1] = nx; }
        const unsigned old = xb_add(&bar[XB_XSUB(b.x)], 1u);
        const unsigned gen = old / nloc;
        if (old + 1u == (gen + 1u) * nloc) {
            __builtin_amdgcn_fence(__ATOMIC_RELEASE, "agent");
            asm volatile("s_waitcnt vmcnt(0)" ::: "memory");
            const unsigned og = xb_add(&bar[XB_TOP], 1u);
            const unsigned tg = og / nx;
            if (og + 1u == (tg + 1u) * nx) xb_add(&bar[XB_TOPGEN], 1u);
            else XB_SPIN(xb_ld(&bar[XB_TOPGEN]) == tg, bar);
            __builtin_amdgcn_fence(__ATOMIC_ACQUIRE, "agent");
            xb_add(&bar[XB_XGEN(b.x)], 1u);
            asm volatile("s_waitcnt vmcnt(0)" ::: "memory");
        } else {
            XB_SPIN(xb_ld(&bar[XB_XGEN(b.x)]) == gen, bar);
            __builtin_amdgcn_fence(__ATOMIC_ACQUIRE, "agent");
            asm volatile("s_waitcnt vmcnt(0)" ::: "memory");
        }
    }
    __syncthreads();
}


constexpr int NSTEP = 1 + 2 * 7 + 1;
__global__ void __launch_bounds__(NTHREADS, 2) k_mega(P p) {
    extern __shared__ __attribute__((aligned(16))) unsigned char lds_raw[];
    LASP unsigned char* lds = (LASP unsigned char*)lds_raw;
    const int bid = blockIdx.x, nblk = gridDim.x;
    volatile LASP unsigned* bst = (volatile LASP unsigned*)(lds + LDS_BYTES - 64);
    if (threadIdx.x < 16) bst[threadIdx.x] = 0u;
    __syncthreads();
    { const XcdBarrier b0 = xcd_barrier_post((unsigned*)p.ctl, bst); if (threadIdx.x == 0) { bst[2] = b0.x; if (bid >= NGDN_BLOCKS) (void)xb_add(&((unsigned*)p.ctl)[4096 + XB_XCNT(b0.x)], 1u); } }
    __syncthreads();
    ph_prologue(p, lds, bid, nblk);
    { XcdBarrier bar; bar.bar = (unsigned*)p.ctl; bar.x = (unsigned)__builtin_amdgcn_readfirstlane((int)bst[2]); bar.st = bst; bar.G = (unsigned)nblk; xcd_barrier(bar); }
    const int bid_k = bid, nblk_k = nblk;
#pragma unroll 1
    for (int step = 1; step < NSTEP; ++step) {
        int ph = 0, l = 0;
        { const int s1 = step - 1; l = s1 / 7; ph = 1 + s1 % 7; }
        int bid = bid_k, nblk = nblk_k; asm volatile("" : "+s"(bid), "+s"(nblk));
#if TPROBE >= 0
        if (bid == 0 && threadIdx.x == 0) { if (step == 1) p.stats[2] = 0.f; const unsigned long long t_ = __builtin_amdgcn_s_memrealtime(); bst[4] = (unsigned)t_; bst[5] = (unsigned)(t_ >> 32); }
#endif
        if (ph == 1) {
            if (l == 0 && ((__builtin_amdgcn_readfirstlane((int)threadIdx.x >> 6)) & 1)) { ph_lnpass(p, l, bid, nblk); ph_transposes(p, lds, bid, nblk); }
            else { if (l == 0) ph_transposes(p, lds, bid, nblk); ph_lnpass(p, l, bid, nblk); }
        }
        else if (l < 2) {
            if (ph == 2) {
                pg8::Gemm g{p.ml, p.wi_t + (size_t)l * NPAD * D, ROWS, NPAD, D}; pg8::StaticOrder S; S.init(ROWS, NPAD, nblk, bid);
                EpiProj E{p.raw, p.rest, p.kf};
                pg8::gemm_phase<EpiProj, pg8::StaticOrder, true, true>(lds, g, S, E);
            } else if (ph == 3) { ph_prep_early(p, lds, l, bid, nblk); ph_conv(p, l, bid, nblk); }
            else if (ph == 4) ph_prep(p, lds, l, bid, nblk);
            else if (ph == 5) {
#if PROBE
                if (l == 0) { ph_probe_naive(p, (LASP float*)lds, l, bid, nblk); XcdBarrier bar; bar.bar = (unsigned*)p.ctl; bar.x = (unsigned)__builtin_amdgcn_readfirstlane((int)bst[2]); bar.st = bst; bar.G = (unsigned)nblk; xcd_barrier(bar); }
#endif
#if TPROBE >= 50
                const bool inrole = TPROBE == 50 ? (bid < 64) : (TPROBE == 51 ? (bid >= 64 && bid < 96) : (bid >= 96));
                const float rscale = TPROBE == 50 ? (1.f / 64.f) : (TPROBE == 51 ? (1.f / 32.f) : (1.f / 160.f));
                if (inrole && threadIdx.x == 0) { const unsigned long long t_ = __builtin_amdgcn_s_memrealtime(); bst[6] = (unsigned)t_; bst[7] = (unsigned)(t_ >> 32); }
#endif
                if (bid >= NGDN_BLOCKS) {
                    ph_glaprep(p, lds, l, bid - NGDN_BLOCKS, nblk - NGDN_BLOCKS);
                    XcdBarrier bar; bar.bar = (unsigned*)p.ctl + 4096; bar.x = (unsigned)__builtin_amdgcn_readfirstlane((int)bst[2]); bar.st = bst + 8; bar.G = (unsigned)(nblk - NGDN_BLOCKS); xcd_barrier(bar);
                }
                ph_mix(p, lds, l, bid, nblk);
#if TPROBE >= 50
                if (inrole && threadIdx.x == 0) { const unsigned long long tr0 = (unsigned long long)bst[6] | ((unsigned long long)bst[7] << 32); atomicAdd(&p.stats[2], (float)(__builtin_amdgcn_s_memrealtime() - tr0) * 0.01f * rscale); }
#endif
#if PROBE
                if (l == 0) { XcdBarrier bar; bar.bar = (unsigned*)p.ctl; bar.x = (unsigned)__builtin_amdgcn_readfirstlane((int)bst[2]); bar.st = bst; bar.G = (unsigned)nblk; xcd_barrier(bar); ph_probe_cmp(p, bid, nblk); }
#endif
            }
            else if (ph == 6) ph_gate(p, l, bid, nblk);
            else if (ph == 7) {
                pg8::Gemm g{p.mix, p.wo_t + (size_t)l * D * D, ROWS, D, D};
                EpiY E{p.ml};
                { LatentOrder S; S.S.init(BATCH * SEQ, D, nblk, bid); pg8::gemm_phase<EpiY, LatentOrder, true, true>(lds, g, S, E); }
                if (l == 0) {
                    const int j = bid, kq = j & 3, pn = (j >> 2) & 3, cb = j >> 4;
                    pg8::Gemm gq{p.mix + kq * 256, p.wo_t + kq * 256, ROWS, D, 256, D};
                    OneUnit S1{17 * cb, pn, j < 128};
                    EpiYc E1{p.oc + (size_t)kq * YC_STRIDE};
                    pg8::gemm_phase<EpiYc, OneUnit, true, true>(lds, gq, S1, E1);
                }
            }
        }
        { XcdBarrier bar; bar.bar = (unsigned*)p.ctl; bar.x = (unsigned)__builtin_amdgcn_readfirstlane((int)bst[2]); bar.st = bst; bar.G = (unsigned)nblk; xcd_barrier(bar); }
#if TPROBE >= 0
        if (bid == 0 && threadIdx.x == 0 && ph == TPROBE) { const unsigned long long tp0 = (unsigned long long)bst[4] | ((unsigned long long)bst[5] << 32); p.stats[2] += (float)(__builtin_amdgcn_s_memrealtime() - tp0) * 0.01f; }
#endif
    }
}

extern "C" void kernel_launch(void* const* d_in, const int* in_sizes, int n_in, void* d_out, int out_size, void* d_ws, size_t ws_size,
                              hipStream_t stream) {
    P p{};
    p.x = (const float*)d_in[0]; p.c = (const float*)d_in[1]; p.ctx = (const float*)d_in[2]; p.c_ctx = (const float*)d_in[3];
    p.w_mod = (const float*)d_in[4]; p.b_mod = (const float*)d_in[5]; p.w_in = (const float*)d_in[6]; p.conv_w = (const float*)d_in[7];
    p.a_log = (const float*)d_in[8]; p.dt_bias = (const float*)d_in[9]; p.gdn_norm = (const float*)d_in[10]; p.rpb = (const float*)d_in[11];
    p.gla_w2 = (const float*)d_in[12]; p.gla_b2 = (const float*)d_in[13]; p.gla_norm = (const float*)d_in[14]; p.w_out = (const float*)d_in[15];
    p.ln_g = (const float*)d_in[16]; p.ln_b = (const float*)d_in[17];
    p.out = (float*)d_out;
    unsigned char* w = (unsigned char*)d_ws;
    size_t off = 0;
    auto take = [&](size_t bytes) { unsigned char* r = w + off; off += (bytes + 255) & ~(size_t)255; return r; };
    p.ctl = (unsigned*)take(32768);
    p.mods = (float*)take((size_t)2 * 9 * 3072 * 4);
    p.xc1 = (float*)take((size_t)BATCH * CTX * D * 4);
    p.wi_t = (bf16*)take((size_t)2 * NPAD * D * 2);
    p.wo_t = (bf16*)take((size_t)2 * D * D * 2);
    p.rest = (bf16*)take((size_t)ROWS * NREST * 2);
    p.raw = (bf16*)take((size_t)ROWS * NRAW * 2);
    p.qkvn = (bf16*)take((size_t)ROWS * NRAW * 2);
    p.mix = p.qkvn;
    p.oa = (bf16*)take((size_t)2 * ROWS * 512 * 2);
    p.oc = (bf16*)take((size_t)2 * ROWS * 256 * 2);
    p.ml = p.oa;
    p.vf = (bf16*)take((size_t)ROWS * 256 * 2);
    p.kf = (bf16*)take((size_t)ROWS * 256 * 2);
    p.stats = (float*)take(256);
    p.cst = (float*)take(4096);
    static int grid_blocks = 0;
    if (!grid_blocks) {
        if (off > ws_size) { fprintf(stderr, "workspace too small: need %zu have %zu\n", off, ws_size); grid_blocks = -1; return; }
        int dev = 0, cus = 0, per_cu = 0;
        hipGetDevice(&dev);
        hipDeviceGetAttribute(&cus, hipDeviceAttributeMultiprocessorCount, dev);
        if (hipFuncSetAttribute((const void*)k_mega, hipFuncAttributeMaxDynamicSharedMemorySize, LDS_BYTES) != hipSuccess) { fprintf(stderr, "hipFuncSetAttribute failed\n"); grid_blocks = -1; return; }
        hipOccupancyMaxActiveBlocksPerMultiprocessor(&per_cu, (const void*)k_mega, NTHREADS, LDS_BYTES);
        if (per_cu < 1) { fprintf(stderr, "occupancy query says %d blocks per CU\n", per_cu); grid_blocks = -1; return; }
        grid_blocks = cus;
    }
    if (grid_blocks < 0) return;
    if (hipMemsetAsync(p.ctl, 0, 32768, stream) != hipSuccess) { fprintf(stderr, "memset of the barrier words failed\n"); return; }
    void* args[] = {&p};
    hipError_t e = hipLaunchCooperativeKernel((void*)k_mega, dim3(grid_blocks), dim3(NTHREADS), args, LDS_BYTES, stream);
    if (e != hipSuccess) fprintf(stderr, "cooperative launch failed: %s (grid %d)\n", hipGetErrorString(e), grid_blocks);
}
```

```cpp
#include <hip/hip_runtime.h>
#include <hip/hip_cooperative_groups.h>
#include <cstdio>
#include <cstdint>
namespace cg = cooperative_groups;
#ifndef PROBE
#define PROBE 0
#endif
#ifndef TPROBE
#define TPROBE -1
#endif
#ifndef TSHIFT
#define TSHIFT 0
#endif

constexpr int D = 1024, BATCH = 8, SEQ = 4096, CTX = 256, TOK = 4352, NPROJ = 3888;
constexpr int ROWS = BATCH * TOK;
constexpr int NRAW = 1536, NREST = 2112, NPAD = 4096;
constexpr int NTHREADS = 512, NWAVES = 8;
constexpr int LDS_BYTES = 147456;
constexpr float ALPHA = 1.4142135623730951f;
constexpr int RC_AZ = 0, RC_BQ = 512, RC_BV = 768, RC_BZ = 1024, RC_CQ = 1280, RC_CK = 1408, RC_CV = 1536, RC_CR = 1792, RC_CZ = 1824, RC_AB = 2080;
constexpr int PC_BK = 2304, PC_BV = 2560;
__host__ __device__ constexpr int gemm_col(int c) { return c < 1536 ? c : (c < 1552 ? c + 2336 : (c < 3888 ? c - 16 : c)); }

typedef unsigned short bf16;
typedef float f32x4_t __attribute__((ext_vector_type(4)));

struct P {
    const float *x, *c, *ctx, *c_ctx, *w_mod, *b_mod, *w_in, *conv_w, *a_log, *dt_bias, *gdn_norm, *rpb,
        *gla_w2, *gla_b2, *gla_norm, *w_out, *ln_g, *ln_b;
    float* out;
    float *mods, *xc1, *stats, *cst; unsigned* ctl;
    bf16 *wi_t, *wo_t, *rest, *raw, *qkvn, *mix, *ml, *oa, *oc, *vf, *kf;
};

__device__ __forceinline__ float bf2f(unsigned short u) { return __uint_as_float((unsigned)u << 16); }
typedef float f32x2_t __attribute__((ext_vector_type(2)));
typedef __bf16 bf16x2_t __attribute__((ext_vector_type(2)));
__device__ __forceinline__ unsigned cvtpk(float lo, float hi) { f32x2_t v = {lo, hi}; bf16x2_t q = __builtin_convertvector(v, bf16x2_t); return __builtin_bit_cast(unsigned, q); }
__device__ __forceinline__ unsigned short f2bf(float f) { return (unsigned short)cvtpk(f, f); }
__device__ __forceinline__ unsigned pk2(float lo, float hi) { return cvtpk(lo, hi); }
__device__ __forceinline__ float bflo(unsigned w) { return __uint_as_float(w << 16); }
__device__ __forceinline__ float bfhi(unsigned w) { return __uint_as_float(w & 0xffff0000u); }
__device__ __forceinline__ void unpack8(uint4 w, float* f) {
    f[0] = bflo(w.x); f[1] = bfhi(w.x); f[2] = bflo(w.y); f[3] = bfhi(w.y); f[4] = bflo(w.z); f[5] = bfhi(w.z); f[6] = bflo(w.w); f[7] = bfhi(w.w);
}
__device__ __forceinline__ float silu_f(float x) { return x * __builtin_amdgcn_rcpf(1.f + __builtin_amdgcn_exp2f(-1.4426950408889634f * x)); }
__device__ __forceinline__ float wave_sum(float v) {
#pragma unroll
    for (int o = 32; o > 0; o >>= 1) v += __shfl_xor(v, o);
    return v;
}
__device__ __forceinline__ float wave_max(float v) {
#pragma unroll
    for (int o = 32; o > 0; o >>= 1) v = fmaxf(v, __shfl_xor(v, o));
    return v;
}
__device__ __forceinline__ int mk_tid() { int t = threadIdx.x; asm volatile("" : "+v"(t)); return t; }
__device__ __forceinline__ int tok_of(int dir, int s) { return dir == 0 ? s : (s < CTX ? CTX - 1 - s : TOK + CTX - 1 - s); }

namespace pg8 {
#define PG8_LAS __attribute__((address_space(3)))
typedef unsigned short bf16_t;
typedef short bf16x8 __attribute__((ext_vector_type(8)));
typedef float f32x4 __attribute__((ext_vector_type(4)));
typedef unsigned u32x4 __attribute__((ext_vector_type(4)));
constexpr int BM = 256, BK = 64, HALF = 128, HTB = HALF * BK * 2  , STAGE_BYTES = 8 * HTB, NXCD = 8, WGM = 8;

__host__ __device__ __forceinline__ int lds_byte(int r, int c) { const int st = (r >> 4) * 2 + (c >> 5), rr = r & 15, cc = c & 31, ob = rr * 64 + cc * 2; return st * 1024 + (ob ^ (((ob >> 9) & 1) << 5)); }
__host__ __device__ __forceinline__ void stage_rc(int b, int& R, int& C) { const int st = b / 1024, sb = b % 1024, swz = sb ^ (((sb >> 9) & 1) << 5); R = (st >> 1) * 16 + swz / 64; C = (st & 1) * 32 + (swz % 64) / 2; }
__host__ __device__ __forceinline__ int perm32(int rho) { const int n = rho >> 4, i = rho & 15; return 8 * (i >> 2) + 4 * n + (i & 3); }

struct Unit { int pm, pn; };
struct Gemm { const bf16_t* A; const bf16_t* Bt; int M, N, K; int ld = 0; };

struct StaticOrder {
    int nM, nN, nwg, G, c;
    __host__ __device__ void init(int M, int N, int G_, int c_) { nM = M / BM; nN = N / BM; nwg = nM * nN; G = G_; c = c_; }
    __host__ __device__ bool next(int i, Unit& u) const {
        const long L = (long)i * G + c; if (L >= nwg) return false;
        int wgid = (int)L; { const int q = nwg / NXCD, r = nwg % NXCD, xcd = wgid % NXCD, off = wgid / NXCD; wgid = (xcd < r ? xcd * (q + 1) : r * (q + 1) + (xcd - r) * q) + off; }
        const int nig = WGM * nN, gid = wgid / nig, fm = gid * WGM, gsz = (nM - fm) < WGM ? (nM - fm) : WGM;
        u.pm = fm + ((wgid % nig) % gsz); u.pn = (wgid % nig) / gsz; return true;
    }
    __device__ __forceinline__ void a_ready(const Unit&) const {}
    __device__ __forceinline__ void done(const Unit&) const {}
};

__device__ __forceinline__ unsigned cvt_pk_bf16(float lo, float hi) { unsigned r; asm volatile("v_cvt_pk_bf16_f32 %0, %1, %2" : "=v"(r) : "v"(lo), "v"(hi)); return r; }
template <class Epi, class Sched, bool ALIGN_EPI = false, bool SP2 = false>
__device__ __forceinline__ void gemm_phase(PG8_LAS unsigned char* lds, const Gemm g, const Sched& S, const Epi& E) {
    const int tid = mk_tid(), wid = __builtin_amdgcn_readfirstlane(tid >> 6), lane = tid & 63, wr = wid >> 2, wc = wid & 3, fr = lane & 15, fq = lane >> 4;
    const int K = g.ld ? g.ld : g.K, nt = g.K / BK;
    unsigned voffA[2], voffB[2];
#pragma unroll
    for (int i = 0; i < 2; ++i) { int R, C; stage_rc(tid * 16 + i * 8192, R, C); const int Rb = Epi::PERM ? ((R & ~31) + perm32(R & 31)) : R;
        voffA[i] = (unsigned)(R * K + C) * 2u; voffB[i] = (unsigned)(Rb * K + C) * 2u; }
    const size_t kstep = (size_t)(BK * 2);
    const size_t hstep = (size_t)HALF * K * 2;
    const size_t tstep = 2 * hstep;
    const unsigned ldsw = (unsigned)wid * 1024u;
    const int aoff = lds_byte(wr * 64 + fr, fq * 8), boff = lds_byte(wc * 32 + fr, fq * 8);
#define PG8_SA(b, h) (((b) * 2 + (h)) * HTB)
#define PG8_SB(b, h) ((4 + (b) * 2 + (h)) * HTB)
#define PG8_STAGE(bufoff, gbase, voff) do { _Pragma("unroll") for (int _i = 0; _i < 2; ++_i) \
        __builtin_amdgcn_global_load_lds((const unsigned*)((const char*)(gbase) + (voff)[_i]), (PG8_LAS unsigned*)(lds + (bufoff) + ldsw + _i * 8192), 16, 0, 0); } while (0)
#define PG8_LDA(dst, b, h) do { _Pragma("unroll") for (int m = 0; m < 4; ++m) _Pragma("unroll") for (int k = 0; k < 2; ++k) dst[m][k] = *(const PG8_LAS bf16x8*)(lds + PG8_SA(b, h) + aoff + m * 2048 + k * 1024); } while (0)
#define PG8_LDB(dst, b, h) do { _Pragma("unroll") for (int n = 0; n < 2; ++n) _Pragma("unroll") for (int k = 0; k < 2; ++k) dst[n][k] = *(const PG8_LAS bf16x8*)(lds + PG8_SB(b, h) + boff + n * 2048 + k * 1024); } while (0)
#define PG8_MMA(ai, bj, At, Bt) do { __builtin_amdgcn_s_setprio(1); _Pragma("unroll") for (int m = 0; m < 4; ++m) _Pragma("unroll") for (int n = 0; n < 2; ++n) _Pragma("unroll") for (int k = 0; k < 2; ++k) \
        acc[ai][bj][m][n] = __builtin_amdgcn_mfma_f32_16x16x32_bf16(Bt[n][k], At[m][k], acc[ai][bj][m][n], 0, 0, 0); __builtin_amdgcn_s_setprio(0); } while (0)
#define PG8_WAIT_V(n) asm volatile("s_waitcnt vmcnt(" #n ")" ::: "memory")
#define PG8_WAIT_L(n) asm volatile("s_waitcnt lgkmcnt(" #n ")" ::: "memory")
#define PG8_BAR __builtin_amdgcn_s_barrier()
#define PG8_SCHED __builtin_amdgcn_sched_barrier(0)
    Unit cur, nxt; int ui = 0;
    if (!S.next(0, cur)) return;
    f32x4 acc[2][2][4][2];
#pragma unroll
    for (int a = 0; a < 2; ++a)
#pragma unroll
        for (int b = 0; b < 2; ++b)
#pragma unroll
            for (int m = 0; m < 4; ++m)
#pragma unroll
                for (int n = 0; n < 2; ++n) acc[a][b][m][n] = (f32x4){0.f, 0.f, 0.f, 0.f};
    bf16x8 At[4][2], B0[2][2], B1[2][2];
    const char* cA = (const char*)g.A + (size_t)cur.pm * tstep; const char* cB = (const char*)g.Bt + (size_t)cur.pn * tstep;
    S.a_ready(cur);
    if constexpr (SP2) {
        PG8_STAGE(PG8_SB(0, 0), cB, voffB); PG8_STAGE(PG8_SB(0, 1), cB + hstep, voffB); PG8_STAGE(PG8_SA(0, 0), cA, voffA); PG8_STAGE(PG8_SA(0, 1), cA + hstep, voffA);
        if (wr == 1) PG8_BAR;
        PG8_WAIT_V(2); PG8_BAR;
        PG8_STAGE(PG8_SB(1, 0), cB + kstep, voffB); PG8_STAGE(PG8_SA(1, 0), cA + kstep, voffA); PG8_STAGE(PG8_SB(1, 1), cB + hstep + kstep, voffB);
        PG8_WAIT_V(6); PG8_BAR;
    } else {
        PG8_STAGE(PG8_SB(0, 0), cB, voffB); PG8_STAGE(PG8_SA(0, 0), cA, voffA); PG8_STAGE(PG8_SB(0, 1), cB + hstep, voffB); PG8_STAGE(PG8_SA(0, 1), cA + hstep, voffA);
        if (wr == 1) PG8_BAR;
        PG8_WAIT_V(4); PG8_BAR;
        PG8_STAGE(PG8_SB(1, 0), cB + kstep, voffB); PG8_STAGE(PG8_SA(1, 0), cA + kstep, voffA); PG8_STAGE(PG8_SB(1, 1), cB + hstep + kstep, voffB);
        PG8_WAIT_V(6); PG8_BAR;
    }
    for (;;) {
        const bool has_next = S.next(ui + 1, nxt);
        const char* nA = has_next ? (const char*)g.A + (size_t)nxt.pm * tstep : cA; const char* nB = has_next ? (const char*)g.Bt + (size_t)nxt.pn * tstep : cB;
        for (int t = 0; t < nt; t += 2) {
            const bool last = (t == nt - 2);
            const char* a1 = cA + (size_t)(t + 1) * kstep;
            const char* a2 = last ? nA : cA + (size_t)(t + 2) * kstep; const char* b2 = last ? nB : cB + (size_t)(t + 2) * kstep;
            const char* a3 = a2 + kstep; const char* b3 = b2 + kstep;
            if (last && has_next) S.a_ready(nxt);
            if constexpr (SP2) {
            PG8_LDB(B0, 0, 0); PG8_LDB(B1, 0, 1); PG8_SCHED; PG8_LDA(At, 0, 0); PG8_STAGE(PG8_SA(1, 1), a1 + hstep, voffA);
            PG8_WAIT_V(8); PG8_WAIT_L(0); PG8_BAR; PG8_MMA(0, 0, At, B0); PG8_MMA(0, 1, At, B1); PG8_BAR; PG8_SCHED;
            PG8_LDA(At, 0, 1); PG8_STAGE(PG8_SB(0, 0), b2, voffB); PG8_STAGE(PG8_SB(0, 1), b2 + hstep, voffB); PG8_STAGE(PG8_SA(0, 0), a2, voffA);
            PG8_WAIT_V(8); PG8_WAIT_L(0); PG8_BAR; PG8_MMA(1, 0, At, B0); PG8_MMA(1, 1, At, B1); PG8_BAR; PG8_SCHED;
            PG8_LDB(B0, 1, 0); PG8_LDB(B1, 1, 1); PG8_SCHED; PG8_LDA(At, 1, 0); PG8_STAGE(PG8_SA(0, 1), a2 + hstep, voffA);
            PG8_WAIT_V(8); PG8_WAIT_L(0); PG8_BAR; PG8_MMA(0, 0, At, B0); PG8_MMA(0, 1, At, B1); PG8_BAR; PG8_SCHED;
            PG8_LDA(At, 1, 1); PG8_STAGE(PG8_SB(1, 0), b3, voffB); PG8_STAGE(PG8_SB(1, 1), b3 + hstep, voffB); PG8_STAGE(PG8_SA(1, 0), a3, voffA);
            PG8_WAIT_V(8); PG8_WAIT_L(0); PG8_BAR; PG8_MMA(1, 0, At, B0); PG8_MMA(1, 1, At, B1); PG8_BAR; PG8_SCHED;
            } else {
            PG8_LDB(B0, 0, 0); PG8_SCHED; PG8_LDA(At, 0, 0); PG8_STAGE(PG8_SA(1, 1), a1 + hstep, voffA);
            PG8_WAIT_L(8); PG8_BAR; PG8_WAIT_L(0); PG8_MMA(0, 0, At, B0); PG8_BAR; PG8_SCHED;
            PG8_LDB(B1, 0, 1); PG8_STAGE(PG8_SB(0, 0), b2, voffB);
            PG8_BAR; PG8_WAIT_L(0); PG8_MMA(0, 1, At, B1); PG8_BAR;
            PG8_LDA(At, 0, 1); PG8_STAGE(PG8_SA(0, 0), a2, voffA);
            PG8_BAR; PG8_WAIT_L(0); PG8_MMA(1, 0, At, B0); PG8_BAR; PG8_SCHED;
            PG8_STAGE(PG8_SB(0, 1), b2 + hstep, voffB);
            PG8_WAIT_V(6); PG8_BAR; PG8_MMA(1, 1, At, B1); PG8_BAR;
            PG8_LDB(B0, 1, 0); PG8_SCHED; PG8_LDA(At, 1, 0); PG8_STAGE(PG8_SA(0, 1), a2 + hstep, voffA);
            PG8_WAIT_L(8); PG8_BAR; PG8_WAIT_L(0); PG8_MMA(0, 0, At, B0); PG8_BAR; PG8_SCHED;
            PG8_LDB(B1, 1, 1); PG8_STAGE(PG8_SB(1, 0), b3, voffB);
            PG8_BAR; PG8_WAIT_L(0); PG8_MMA(0, 1, At, B1); PG8_BAR;
            PG8_LDA(At, 1, 1); PG8_STAGE(PG8_SA(1, 0), a3, voffA);
            PG8_BAR; PG8_WAIT_L(0); PG8_MMA(1, 0, At, B0); PG8_BAR; PG8_SCHED;
            PG8_STAGE(PG8_SB(1, 1), b3 + hstep, voffB);
            PG8_WAIT_V(6); PG8_BAR; PG8_MMA(1, 1, At, B1); PG8_BAR;
            }
        }
        if constexpr (ALIGN_EPI) { if (wr == 0) PG8_BAR; }
        if constexpr (!Epi::AFTER_DRAIN) { E(acc, cur, wr, wc, fr, fq); S.done(cur); }
        if (!has_next) break;
#pragma unroll
        for (int a = 0; a < 2; ++a)
#pragma unroll
            for (int b = 0; b < 2; ++b)
#pragma unroll
                for (int m = 0; m < 4; ++m)
#pragma unroll
                    for (int n = 0; n < 2; ++n) acc[a][b][m][n] = (f32x4){0.f, 0.f, 0.f, 0.f};
        cur = nxt; cA = nA; cB = nB; ++ui;
        if constexpr (ALIGN_EPI) { if (wr == 1) PG8_BAR; }
    }
    PG8_WAIT_V(0);
    if constexpr (!ALIGN_EPI) { if (wr == 0) PG8_BAR; }
    PG8_BAR;
    if constexpr (Epi::AFTER_DRAIN) { E.fused(acc, cur, wr, wc, fr, fq, lds, wid, lane); S.done(cur); }
#undef PG8_SA
#undef PG8_SB
#undef PG8_STAGE
#undef PG8_LDA
#undef PG8_LDB
#undef PG8_MMA
#undef PG8_WAIT_V
#undef PG8_WAIT_L
#undef PG8_BAR
#undef PG8_SCHED
}
}

#define LASP __attribute__((address_space(3)))
constexpr int NCHK = TOK / 32;

struct LatentOrder {
    pg8::StaticOrder S;
    __device__ __forceinline__ bool next(int i, pg8::Unit& u) const { if (!S.next(i, u)) return false; u.pm = 17 * (u.pm >> 4) + 1 + (u.pm & 15); return true; }
    __device__ __forceinline__ void a_ready(const pg8::Unit&) const {}
    __device__ __forceinline__ void done(const pg8::Unit&) const {}
};
struct EpiProj {
    static constexpr bool PERM = true, AFTER_DRAIN = false;
    bf16* raw; bf16* rest; bf16* kf;
    __device__ __forceinline__ void operator()(const pg8::f32x4 (&acc)[2][2][4][2], const pg8::Unit& u, int wr, int wc, int fr, int fq) const {
        const int row0 = u.pm * 256 + wr * 64 + fr;
        const int colb = u.pn * 256 + wc * 32 + 8 * fq;
        if (u.pn == PC_BK / 256) {
#pragma unroll
            for (int bj = 0; bj < 2; ++bj) {
                const int hd = wc * 32 + 8 * fq + bj * 128, hk = hd >> 6, dk = hd & 63;
#pragma unroll
                for (int ai = 0; ai < 2; ++ai)
#pragma unroll
                    for (int m = 0; m < 4; ++m) {
                        const pg8::f32x4 v0 = acc[ai][bj][m][0], v1 = acc[ai][bj][m][1];
                        pg8::u32x4 w; w.x = pg8::cvt_pk_bf16(v0[0], v0[1]); w.y = pg8::cvt_pk_bf16(v0[2], v0[3]); w.z = pg8::cvt_pk_bf16(v1[0], v1[1]); w.w = pg8::cvt_pk_bf16(v1[2], v1[3]);
                        const int row = row0 + ai * 128 + m * 16;
                        const int bb = row / TOK, t = row - bb * TOK;
                        *(pg8::u32x4*)(kf + ((((size_t)(bb * 4 + hk) * NCHK + (t >> 5)) * 4 + (dk >> 4)) * 64 + ((dk >> 3) & 1) * 32 + (t & 31)) * 8) = w;
                    }
            }
            return;
        }
        bf16* base; int ld;
        if (u.pn < NRAW / 256) { base = raw + colb; ld = NRAW; }
        else { base = rest + (colb - NRAW - (u.pn > PC_BK / 256 ? 256 : 0)); ld = NREST; }
#pragma unroll
        for (int bj = 0; bj < 2; ++bj) {
            if (colb + bj * 128 >= NPROJ) continue;
#pragma unroll
            for (int ai = 0; ai < 2; ++ai)
#pragma unroll
                for (int m = 0; m < 4; ++m) {
                    const pg8::f32x4 v0 = acc[ai][bj][m][0], v1 = acc[ai][bj][m][1];
                    pg8::u32x4 w; w.x = pg8::cvt_pk_bf16(v0[0], v0[1]); w.y = pg8::cvt_pk_bf16(v0[2], v0[3]); w.z = pg8::cvt_pk_bf16(v1[0], v1[1]); w.w = pg8::cvt_pk_bf16(v1[2], v1[3]);
                    *(pg8::u32x4*)(base + (size_t)(row0 + ai * 128 + m * 16) * ld + bj * 128) = w;
                }
        }
    }
};
struct EpiY {
    static constexpr bool PERM = true, AFTER_DRAIN = false;
    bf16* y;
    __device__ __forceinline__ void operator()(const pg8::f32x4 (&acc)[2][2][4][2], const pg8::Unit& u, int wr, int wc, int fr, int fq) const {
        const int row0 = u.pm * 256 + wr * 64 + fr;
        const int colb = u.pn * 256 + wc * 32 + 8 * fq;
#pragma unroll
        for (int bj = 0; bj < 2; ++bj)
#pragma unroll
            for (int ai = 0; ai < 2; ++ai)
#pragma unroll
                for (int m = 0; m < 4; ++m) {
                    const pg8::f32x4 v0 = acc[ai][bj][m][0], v1 = acc[ai][bj][m][1];
                    pg8::u32x4 w; w.x = pg8::cvt_pk_bf16(v0[0], v0[1]); w.y = pg8::cvt_pk_bf16(v0[2], v0[3]); w.z = pg8::cvt_pk_bf16(v1[0], v1[1]); w.w = pg8::cvt_pk_bf16(v1[2], v1[3]);
                    *(pg8::u32x4*)(y + (size_t)(row0 + ai * 128 + m * 16) * D + colb + bj * 128) = w;
                }
    }
};

struct OneUnit {
    int pm, pn; bool valid;
    __device__ __forceinline__ bool next(int i, pg8::Unit& u) const { if (i != 0 || !valid) return false; u.pm = pm; u.pn = pn; return true; }
    __device__ __forceinline__ void a_ready(const pg8::Unit&) const {}
    __device__ __forceinline__ void done(const pg8::Unit&) const {}
};
struct EpiYc {
    static constexpr bool PERM = true, AFTER_DRAIN = false;
    bf16* yc;
    __device__ __forceinline__ void operator()(const pg8::f32x4 (&acc)[2][2][4][2], const pg8::Unit& u, int wr, int wc, int fr, int fq) const {
        const int row0 = (u.pm / 17) * 256 + wr * 64 + fr;
        const int colb = u.pn * 256 + wc * 32 + 8 * fq;
#pragma unroll
        for (int bj = 0; bj < 2; ++bj)
#pragma unroll
            for (int ai = 0; ai < 2; ++ai)
#pragma unroll
                for (int m = 0; m < 4; ++m) {
                    const pg8::f32x4 v0 = acc[ai][bj][m][0], v1 = acc[ai][bj][m][1];
                    pg8::u32x4 w; w.x = pg8::cvt_pk_bf16(v0[0], v0[1]); w.y = pg8::cvt_pk_bf16(v0[2], v0[3]); w.z = pg8::cvt_pk_bf16(v1[0], v1[1]); w.w = pg8::cvt_pk_bf16(v1[2], v1[3]);
                    *(pg8::u32x4*)(yc + (size_t)(row0 + ai * 128 + m * 16) * D + colb + bj * 128) = w;
                }
    }
};
constexpr size_t YC_STRIDE = (size_t)BATCH * CTX * D;

template <bool PERMW> __device__ __forceinline__ void transpose_item(const float* W, int K, int N, bf16* WT, LASP float* scr, int item, int lane) {
    const int nblk = (N + 31) / 32, kb = item / nblk, nb = item % nblk, k0 = 64 * kb, n0 = 32 * nb;
    const bool nok = (n0 + (lane & 31)) < N;
#pragma unroll 8
    for (int i = 0; i < 32; ++i) { const int kk = 2 * i + (lane >> 5); scr[kk * 33 + (lane & 31)] = nok ? W[(size_t)(k0 + kk) * N + n0 + (lane & 31)] : 0.f; }
    asm volatile("s_waitcnt lgkmcnt(0)" ::: "memory");
    const int c = lane & 7;
#pragma unroll
    for (int j = 0; j < 4; ++j) {
        const int n = (lane >> 3) + 8 * j; const LASP float* s = scr + (8 * c) * 33 + n;
        uint4 o; o.x = pk2(s[0 * 33], s[1 * 33]); o.y = pk2(s[2 * 33], s[3 * 33]); o.z = pk2(s[4 * 33], s[5 * 33]); o.w = pk2(s[6 * 33], s[7 * 33]);
        *(uint4*)(WT + (size_t)(PERMW ? gemm_col(n0 + n) : n0 + n) * K + k0 + 8 * c) = o;
    }
    asm volatile("s_waitcnt lgkmcnt(0)" ::: "memory");
}

__device__ void ph_prologue(const P& p, LASP unsigned char* lds, int bid, int nblk) {
    const int tid = mk_tid(), lane = tid & 63, wave = tid >> 6;
    LASP float* sm = (LASP float*)lds;
    if (bid < 192) {
        for (int i = tid; i < 9 * 1024; i += NTHREADS) {
            int s = i >> 10, d = i & 1023;
            float cv = s < 8 ? p.c[s * 1024 + d] : p.c_ctx[d];
            sm[i] = silu_f(cv);
        }
        __syncthreads();
        const int l = bid / 96, col = lane & 31, kh = lane >> 5, j = (bid % 96) * 32 + col;
        const float* w = p.w_mod + (size_t)l * 1024 * 3072 + j;
        float acc[9];
#pragma unroll
        for (int s = 0; s < 9; ++s) acc[s] = 0.f;
        const int ib = wave * 128 + kh * 64;
#pragma unroll 1
        for (int i0 = ib; i0 < ib + 64; i0 += 16) {
            float wv[16];
#pragma unroll
            for (int u = 0; u < 16; ++u) wv[u] = w[(size_t)(i0 + u) * 3072];
#pragma unroll
            for (int u = 0; u < 16; ++u)
#pragma unroll
                for (int s = 0; s < 9; ++s) acc[s] += sm[s * 1024 + i0 + u] * wv[u];
        }
        LASP float* red = sm + 9 * 1024;
#pragma unroll
        for (int s = 0; s < 9; ++s) { acc[s] += __shfl_xor(acc[s], 32); if (kh == 0) red[(wave * 9 + s) * 32 + col] = acc[s]; }
        __syncthreads();
        for (int o = tid; o < 9 * 32; o += NTHREADS) {
            const int s = o >> 5, c = o & 31;
            float t = 0.f;
#pragma unroll
            for (int ww = 0; ww < 8; ++ww) t += red[(ww * 9 + s) * 32 + c];
            const int jj = (bid % 96) * 32 + c;
            p.mods[(size_t)(l * 9 + s) * 3072 + jj] = t + p.b_mod[l * 3072 + jj];
        }
        __syncthreads();
    }
    if (bid == nblk - 1) {
        const int pos = tid >> 3, f = tid & 7;
        const float ang = (float)pos * powf(10000.f, -(float)f / 8.f);
        p.cst[tid * 2] = cosf(ang); p.cst[tid * 2 + 1] = sinf(ang);
    }
#if PROBE
    if (bid == 0 && tid < 4) p.stats[tid] = 0.f;
#endif
}
__device__ void ph_transposes(const P& p, LASP unsigned char* lds, int bid, int nblk) {
    const int tid = mk_tid(), lane = tid & 63, wave = tid >> 6;
    LASP float* scr = (LASP float*)(lds + 57344 + wave * 8704);
    const int gw = (nblk - 1 - bid) * NWAVES + wave, NGW = nblk * NWAVES;
    constexpr int I_IN = 16 * 122, I_OUT = 16 * 32;
    for (int it = gw; it < 2 * (I_IN + I_OUT); it += NGW) {
        int l = it / (I_IN + I_OUT), r = it % (I_IN + I_OUT);
        if (r < I_IN) transpose_item<true>(p.w_in + (size_t)l * D * NPROJ, D, NPROJ, p.wi_t + (size_t)l * NPAD * D, scr, r, lane);
        else transpose_item<false>(p.w_out + (size_t)l * D * D, D, D, p.wo_t + (size_t)l * D * D, scr, r - I_IN, lane);
    }
    for (int i = bid * NTHREADS + tid; i < 2 * 192 * 128; i += nblk * NTHREADS) {
        int l = i / (192 * 128), r = i % (192 * 128);
        unsigned z; asm volatile("v_mov_b32 %0, 0" : "=v"(z));
        *(uint4*)(p.wi_t + (size_t)l * NPAD * D + (size_t)3904 * D + (size_t)r * 8) = make_uint4(z, z, z, z);
    }
}

__device__ void ph_lnpass(const P& p, int mode, int bid, int nblk) {
    const int tid = mk_tid();
    const int lane = tid & 63, wave = tid >> 6;
    for (int r = bid * NWAVES + wave; r < ROWS; r += nblk * NWAVES) {
        const int b = r / TOK, t = r - b * TOK;
        const bool isc = t < CTX;
        if (mode == 2 && isc) continue;
        float* buf; const float* src; int s;
        if (isc) { buf = p.xc1 + ((size_t)b * CTX + t) * D; src = p.ctx + ((size_t)b * CTX + t) * D; s = 8; }
        else { buf = p.out + ((size_t)b * SEQ + (t - CTX)) * D; src = (mode == 2) ? buf : p.x + ((size_t)b * SEQ + (t - CTX)) * D; s = b; }
        f32x4_t v[4];
#pragma unroll
        for (int j = 0; j < 4; ++j) v[j] = *(const f32x4_t*)(src + 256 * j + 4 * lane);
        if (mode >= 1) {
            const int lp = mode - 1;
            const float* gt = p.mods + (size_t)(lp * 9 + s) * 3072 + 2048;
            f32x4_t yq[4];
            if (isc) {
                const bf16* yc = p.oc + ((size_t)b * CTX + t) * D + 4 * lane;
                uint2 yp[4][4];
#pragma unroll
                for (int j = 0; j < 4; ++j)
#pragma unroll
                    for (int q = 0; q < 4; ++q) yp[j][q] = *(const uint2*)(yc + q * YC_STRIDE + 256 * j);
#pragma unroll
                for (int j = 0; j < 4; ++j)
                    yq[j] = (f32x4_t){(bflo(yp[j][0].x) + bflo(yp[j][1].x)) + (bflo(yp[j][2].x) + bflo(yp[j][3].x)), (bfhi(yp[j][0].x) + bfhi(yp[j][1].x)) + (bfhi(yp[j][2].x) + bfhi(yp[j][3].x)),
                                      (bflo(yp[j][0].y) + bflo(yp[j][1].y)) + (bflo(yp[j][2].y) + bflo(yp[j][3].y)), (bfhi(yp[j][0].y) + bfhi(yp[j][1].y)) + (bfhi(yp[j][2].y) + bfhi(yp[j][3].y))};
            } else {
                uint2 yw[4];
#pragma unroll
                for (int j = 0; j < 4; ++j) yw[j] = *(const uint2*)(p.ml + (size_t)r * D + 256 * j + 4 * lane);
#pragma unroll
                for (int j = 0; j < 4; ++j) yq[j] = (f32x4_t){bflo(yw[j].x), bfhi(yw[j].x), bflo(yw[j].y), bfhi(yw[j].y)};
            }
#pragma unroll
            for (int j = 0; j < 4; ++j) {
                const f32x4_t g = *(const f32x4_t*)(gt + 256 * j + 4 * lane);
                const f32x4_t yv = yq[j];
                v[j] = v[j] * ALPHA + g * yv;
            }
            float sum = 0.f;
#pragma unroll
            for (int j = 0; j < 4; ++j) sum += (v[j].x + v[j].y) + (v[j].z + v[j].w);
            const float mu = wave_sum(sum) * (1.f / 1024.f);
            float sq = 0.f;
#pragma unroll
            for (int j = 0; j < 4; ++j) { v[j] = v[j] - mu; sq += (v[j].x * v[j].x + v[j].y * v[j].y) + (v[j].z * v[j].z + v[j].w * v[j].w); }
            const float rs = __builtin_amdgcn_rsqf(wave_sum(sq) * (1.f / 1024.f) + 1e-6f);
#pragma unroll
            for (int j = 0; j < 4; ++j) {
                const f32x4_t g = *(const f32x4_t*)(p.ln_g + lp * 1024 + 256 * j + 4 * lane), bb = *(const f32x4_t*)(p.ln_b + lp * 1024 + 256 * j + 4 * lane);
                v[j] = v[j] * rs * g + bb;
#if PROBE
                if (mode == 2) v[j] = v[j] + (p.stats[0] / fmaxf(p.stats[1], 1e-20f));
#endif
#if TPROBE >= 0
                if (mode == 2) v[j] = v[j] + exp2f((rintf(log2f(fmaxf(p.stats[2], 1.f)) * 6.f + TSHIFT * 0.5f) - TSHIFT * 0.5f) * (1.f / 6.f)) * 1e-4f;
#endif
                *(f32x4_t*)(buf + 256 * j + 4 * lane) = v[j];
            }
            if (mode == 2) continue;
        }
        const int l = mode;
        float sum = 0.f;
#pragma unroll
        for (int j = 0; j < 4; ++j) sum += (v[j].x + v[j].y) + (v[j].z + v[j].w);
        const float mu = wave_sum(sum) * (1.f / 1024.f);
        float sq = 0.f;
#pragma unroll
        for (int j = 0; j < 4; ++j) { v[j] = v[j] - mu; sq += (v[j].x * v[j].x + v[j].y * v[j].y) + (v[j].z * v[j].z + v[j].w * v[j].w); }
        const float rs = __builtin_amdgcn_rsqf(wave_sum(sq) * (1.f / 1024.f) + 1e-6f);
        const float* md = p.mods + (size_t)(l * 9 + s) * 3072;
#pragma unroll
        for (int j = 0; j < 4; ++j) {
            const f32x4_t sh = *(const f32x4_t*)(md + 256 * j + 4 * lane), sc = *(const f32x4_t*)(md + 1024 + 256 * j + 4 * lane);
            const f32x4_t o = v[j] * rs * (sc + 1.f) + sh;
            uint2 w; w.x = pk2(o.x, o.y); w.y = pk2(o.z, o.w);
            *(uint2*)(p.ml + (size_t)r * D + 256 * j + 4 * lane) = w;
        }
    }
}

__device__ void ph_conv(const P& p, int l, int bid, int nblk) {
    const int tid = mk_tid();
    const int lane = tid & 63, wave = tid >> 6;
    const float* cw = p.conv_w + (size_t)l * 5 * 1536;
    constexpr int SL = 17, NSTRIP = TOK / SL;
    static_assert(NSTRIP * SL == TOK && (CTX / SL) * SL + 1 == CTX, "strip geometry: the straddling strip starts at the last context token");
    for (int it = bid * NWAVES + wave; it < BATCH * NSTRIP * 3; it += nblk * NWAVES) {
        const int third = it % 3, rest_i = it / 3, strip = rest_i % NSTRIP, b = rest_i / NSTRIP;
        const int t0 = strip * SL;
        const bool strad = t0 == CTX - 1;
        const int lo = strad ? 0 : (t0 < CTX ? 0 : CTX), hi = strad ? TOK : (t0 < CTX ? CTX : TOK);
        const int ch = third * 512 + lane * 8;
        float w[5][8];
#pragma unroll
        for (int j = 0; j < 5; ++j) {
            const f32x4_t a = *(const f32x4_t*)(cw + j * 1536 + ch), c = *(const f32x4_t*)(cw + j * 1536 + ch + 4);
            w[j][0] = a.x; w[j][1] = a.y; w[j][2] = a.z; w[j][3] = a.w; w[j][4] = c.x; w[j][5] = c.y; w[j][6] = c.z; w[j][7] = c.w;
        }
        const bf16* src = p.raw + ((size_t)b * TOK + t0) * NRAW + ch;
        bf16* dst = p.qkvn + ((size_t)b * TOK + t0) * NRAW + ch;
        uint4 rw[SL + 4];
#pragma unroll
        for (int i = 0; i < SL + 4; ++i) {
            const int tt = t0 + i - 2;
            rw[i] = (tt >= lo && tt < hi) ? *(const uint4*)(src + (ptrdiff_t)(i - 2) * NRAW) : make_uint4(0, 0, 0, 0);
        }
        const int g = (ch >> 7);
        const float qs = g < 4 ? 0.08838834764831845f : 1.f;
#pragma unroll
        for (int n = 0; n < SL; ++n) {
            float acc[8];
#pragma unroll
            for (int e = 0; e < 8; ++e) acc[e] = 0.f;
#pragma unroll
            for (int j = 0; j < 5; ++j) {
                float f[8]; unpack8(rw[n + j], f);
                const bool cross = (n == 0) ? (n + j >= 3) : (n + j <= 2);
                if (cross && n <= 2) {
#pragma unroll
                    for (int e = 0; e < 8; ++e) f[e] = strad ? 0.f : f[e];
                }
#pragma unroll
                for (int e = 0; e < 8; ++e) acc[e] += w[j][e] * f[e];
            }
            float ss = 0.f;
#pragma unroll
            for (int e = 0; e < 8; ++e) { acc[e] = silu_f(acc[e]); ss += acc[e] * acc[e]; }
            if (g < 8) {
#pragma unroll
                for (int m = 8; m > 0; m >>= 1) ss += __shfl_xor(ss, m);
                const float sc = qs * __builtin_amdgcn_rsqf(ss + 1e-6f);
#pragma unroll
                for (int e = 0; e < 8; ++e) acc[e] *= sc;
            }
            uint4 o; o.x = pk2(acc[0], acc[1]); o.y = pk2(acc[2], acc[3]); o.z = pk2(acc[4], acc[5]); o.w = pk2(acc[6], acc[7]);
            *(uint4*)(dst + (size_t)n * NRAW) = o;
        }
    }
}

typedef short bf16x8_t __attribute__((ext_vector_type(8)));
typedef float f32x16_t __attribute__((ext_vector_type(16)));
typedef unsigned u32x4_t __attribute__((ext_vector_type(4)));
#define MFMA32(a, b, c) __builtin_amdgcn_mfma_f32_32x32x16_bf16((a), (b), (c), 0, 0, 0)
__device__ __forceinline__ int crow(int reg, int h) { return (reg & 3) + 8 * (reg >> 2) + 4 * h; }
__device__ __forceinline__ int perm16(int a) { const int x = a & 15; return (a & ~15) + (x < 4 ? x : x < 8 ? x + 4 : x < 12 ? x - 4 : x); }
#define PACK8(x, s) __builtin_bit_cast(bf16x8_t, (u32x4_t){cvtpk((x)[8 * (s)], (x)[8 * (s) + 1]), cvtpk((x)[8 * (s) + 2], (x)[8 * (s) + 3]), cvtpk((x)[8 * (s) + 4], (x)[8 * (s) + 5]), cvtpk((x)[8 * (s) + 6], (x)[8 * (s) + 7])})
constexpr int GCH = 32, NCH = TOK / GCH;
constexpr int GP_ITEM = 4416;

__device__ void ph_gdnprep(const P& p, LASP unsigned char* lds, int l, int bid, int nblk, int tid) {
    const int lane = tid & 63, wave = tid >> 6, r = lane & 31, hh = lane >> 5;
    LASP float* Lm = (LASP float*)(lds + wave * 16384);
    LASP float* Xs = Lm + 2048;
    for (int it = bid * NWAVES + wave; it < BATCH * 4 * NCH; it += nblk * NWAVES) {
        const int c = it % NCH, bh = it / NCH, h = bh & 3, b = bh >> 2;
        const size_t row0 = (size_t)b * TOK + (size_t)c * GCH;
        f32x16_t KK, QK;
#pragma unroll
        for (int i = 0; i < 16; ++i) { KK[i] = 0.f; QK[i] = 0.f; }
        const bf16* kbase = p.qkvn + (row0 + r) * NRAW + 512 + h * 128 + 8 * hh;
        const bf16* qbase = p.qkvn + (row0 + r) * NRAW + h * 128 + 8 * hh;
#pragma unroll
        for (int s = 0; s < 8; ++s) {
            const bf16x8_t kf = *(const bf16x8_t*)(kbase + 16 * s), qf = *(const bf16x8_t*)(qbase + 16 * s);
            KK = MFMA32(kf, kf, KK);
            QK = MFMA32(qf, kf, QK);
        }
        float Gd, bd;
        {
            const bf16* ab = p.rest + (row0 + r) * NREST + RC_AB;
            const float a = bf2f(ab[hh * 4 + h]) + p.dt_bias[(l * 2 + hh) * 4 + h];
            const float sp = fmaxf(a, 0.f) + 0.6931471805599453f * __builtin_amdgcn_logf(1.f + __builtin_amdgcn_exp2f(-1.4426950408889634f * fabsf(a)));
            Gd = -__builtin_amdgcn_exp2f(1.4426950408889634f * p.a_log[(l * 2 + hh) * 4 + h]) * sp;
            bd = __builtin_amdgcn_rcpf(1.f + __builtin_amdgcn_exp2f(-1.4426950408889634f * bf2f(ab[(2 + hh) * 4 + h])));
        }
#pragma unroll
        for (int off = 1; off < 32; off <<= 1) {
            const float up = __shfl_up(Gd, off, 32), dn = __shfl_down(Gd, off, 32);
            if (hh == 0) { if (r >= off) Gd += up; } else { if (r + off < 32) Gd += dn; }
        }
        unsigned char* gout = (unsigned char*)p.raw + ((size_t)(bh * 2) * NCH + c) * GP_ITEM;
        {
            const float Glast = __shfl(Gd, hh == 0 ? 31 : 32);
            float* sc = (float*)(gout + (size_t)hh * NCH * GP_ITEM + 4096);
            sc[r] = __builtin_amdgcn_exp2f(1.4426950408889634f * Gd); sc[32 + r] = __builtin_amdgcn_exp2f(1.4426950408889634f * (Glast - Gd));
            if (r == 0) sc[64] = __builtin_amdgcn_exp2f(1.4426950408889634f * Glast);
        }
        asm volatile("s_waitcnt lgkmcnt(0)" ::: "memory");
        LASP unsigned short* qkt = (LASP unsigned short*)Xs;
        LASP float* bs = (LASP float*)(lds + 135168 + wave * 256);
        bs[lane] = bd;
#pragma unroll
        for (int d = 0; d < 2; ++d) {
            const float Gcol = __shfl(Gd, d * 32 + r);
#pragma unroll
            for (int i = 0; i < 16; ++i) {
                const int n = crow(i, hh);
                const float Grow = __shfl(Gd, d * 32 + n), brow = __shfl(bd, d * 32 + n);
                const bool incl = d == 0 ? (r <= n) : (r >= n), strict = d == 0 ? (r < n) : (r > n);
                const float dec = __builtin_amdgcn_exp2f((incl ? Grow - Gcol : 0.f) * 1.4426950408889634f);
                const float lv = strict ? brow * KK[i] * dec : 0.f;
                const float qv = incl ? QK[i] * dec : 0.f;
                const int n2 = d == 0 ? n : 31 - n, m2 = d == 0 ? r : 31 - r;
                Lm[(d * 32 + n2) * 32 + m2] = lv;
                qkt[(d * 32 + n) * 40 + perm16(r)] = f2bf(qv);
                if ((i & 3) == 3) __builtin_amdgcn_sched_barrier(0);
            }
        }
        asm volatile("s_waitcnt lgkmcnt(0)" ::: "memory");
#pragma unroll
        for (int d = 0; d < 2; ++d)
#pragma unroll
            for (int k = 0; k < 2; ++k) {
                const int q = lane + 64 * k, row = q >> 2, ch = q & 3;
                *(u32x4_t*)(gout + (size_t)d * NCH * GP_ITEM + 2048 + row * 64 + ch * 16) = *(const LASP u32x4_t*)((const LASP unsigned char*)qkt + (d * 32 + row) * 80 + ch * 16);
            }
        asm volatile("s_waitcnt lgkmcnt(0)" ::: "memory");
        {
            const LASP float* Lr = Lm + hh * 1024;
            LASP float* xc = Xs + lane;
            float x[32];
#pragma unroll
            for (int n = 0; n < 32; ++n) x[n] = 0.f;
#pragma unroll
            for (int n = 0; n < 32; ++n) {
                f32x4_t lc[8];
#pragma unroll
                for (int jb = 0; jb < 8; ++jb) if (4 * jb < n) lc[jb] = *(const LASP f32x4_t*)(Lr + n * 32 + 4 * jb);
                float a0 = (n == r) ? 1.f : 0.f, a1 = 0.f;
#pragma unroll
                for (int jb = 0; jb < 8; ++jb) if (4 * jb < n) { a0 -= lc[jb].x * x[4 * jb]; a1 -= lc[jb].y * x[4 * jb + 1]; a0 -= lc[jb].z * x[4 * jb + 2]; a1 -= lc[jb].w * x[4 * jb + 3]; }
                x[n] = a0 + a1;
                xc[n * 64] = x[n];
                if ((n & 1) == 1) __builtin_amdgcn_sched_barrier(0);
            }
        }
        asm volatile("s_waitcnt lgkmcnt(0)" ::: "memory");
#pragma unroll
        for (int d = 0; d < 2; ++d)
#pragma unroll
            for (int k = 0; k < 2; ++k) {
                const int q = lane + 64 * k, row = q >> 2, ch = q & 3;
                const int nn = d == 0 ? row : 31 - row;
                float v[8];
#pragma unroll
                for (int e = 0; e < 8; ++e) {
                    const int m = perm16(ch * 8 + e);
                    const int lidx = d == 0 ? m : 32 + 31 - m;
                    v[e] = Xs[nn * 64 + lidx] * bs[d * 32 + m];
                }
                *(u32x4_t*)(gout + (size_t)d * NCH * GP_ITEM + row * 64 + ch * 16) = (u32x4_t){cvtpk(v[0], v[1]), cvtpk(v[2], v[3]), cvtpk(v[4], v[5]), cvtpk(v[6], v[7])};
            }
        asm volatile("s_waitcnt lgkmcnt(0)" ::: "memory");
    }
}

constexpr int ST_KA = 0, ST_QA = 8704, ST_KN = 17408, ST_V = 27648, ST_TP = 37888, ST_QK = 40448, ST_GL = 43008, ST_BYTES = 43328;
constexpr int GDN_OST = 2 * ST_BYTES, GDN_OST_BYTES = 32 * 272;
typedef unsigned u32x2_t __attribute__((ext_vector_type(2)));
typedef short s16x4_t __attribute__((ext_vector_type(4)));
struct GSlot { u32x4_t k0, k1, q0, q1, v0, v1, t; f32x4_t sc; };

__device__ __forceinline__ int gdn_chunk(int dir, int s) { return dir == 0 ? s : (s < 8 ? 7 - s : 143 - s); }
__device__ __forceinline__ void gdn_issue(const P& p, GSlot& g, int b, int h, int dir, int step, int tl) {
    const int c = gdn_chunk(dir, step);
    const size_t row0 = (size_t)b * TOK + (size_t)c * GCH;
    const int r0 = tl >> 4, c16 = tl & 15;
    const bf16* a0 = p.qkvn + (row0 + r0) * NRAW + h * 128 + 8 * c16;
    const bf16* a1 = a0 + (size_t)16 * NRAW;
    g.q0 = *(const u32x4_t*)a0; g.q1 = *(const u32x4_t*)a1;
    g.k0 = *(const u32x4_t*)(a0 + 512); g.k1 = *(const u32x4_t*)(a1 + 512);
    g.v0 = *(const u32x4_t*)(a0 + 1024); g.v1 = *(const u32x4_t*)(a1 + 1024);
    const unsigned char* gp = (const unsigned char*)p.raw + ((size_t)((b * 4 + h) * 2 + dir) * NCH + c) * GP_ITEM;
    g.t = *(const u32x4_t*)(gp + tl * 16);
    g.sc = *(const f32x4_t*)(gp + 4096 + (tl < 20 ? tl : 0) * 16);
}
__device__ __forceinline__ u32x4_t scale8(u32x4_t x, float s) {
    return (u32x4_t){cvtpk(bflo(x.x) * s, bfhi(x.x) * s), cvtpk(bflo(x.y) * s, bfhi(x.y) * s), cvtpk(bflo(x.z) * s, bfhi(x.z) * s), cvtpk(bflo(x.w) * s, bfhi(x.w) * s)};
}
__device__ __forceinline__ void gdn_put_rows(LASP unsigned char* st, int row, int c16, u32x4_t kq, int off) {
    const int g = c16 >> 1, odd = c16 & 1;
    *(LASP u32x2_t*)(st + off + row * 272 + (16 * g + (odd ? 4 : 0)) * 2) = (u32x2_t){kq.x, kq.y};
    *(LASP u32x2_t*)(st + off + row * 272 + (16 * g + (odd ? 12 : 8)) * 2) = (u32x2_t){kq.z, kq.w};
}
__device__ __forceinline__ void gdn_write(LASP unsigned char* st, const GSlot& g, int tl) {
    const int r0 = tl >> 4, c16 = tl & 15;
    gdn_put_rows(st, r0, c16, g.k0, ST_KA); gdn_put_rows(st, r0 + 16, c16, g.k1, ST_KA);
    gdn_put_rows(st, r0, c16, g.q0, ST_QA); gdn_put_rows(st, r0 + 16, c16, g.q1, ST_QA);
    *(LASP u32x4_t*)(st + ST_KN + r0 * 320 + c16 * 16) = g.k0;
    *(LASP u32x4_t*)(st + ST_KN + (r0 + 16) * 320 + c16 * 16) = g.k1;
    *(LASP u32x4_t*)(st + ST_V + r0 * 320 + c16 * 16) = g.v0;
    *(LASP u32x4_t*)(st + ST_V + (r0 + 16) * 320 + c16 * 16) = g.v1;
    { const int t2 = tl & 127; *(LASP u32x4_t*)(st + (tl < 128 ? ST_TP : ST_QK) + (t2 >> 2) * 80 + (t2 & 3) * 16) = g.t; }
    if (tl < 20) *(LASP f32x4_t*)(st + ST_GL + tl * 16) = g.sc;
}
__device__ __forceinline__ void gdn_flush(const P& p, LASP unsigned char* lds, int b, int h, int dir, int step, int tl) {
    const int c = gdn_chunk(dir, step);
    const LASP unsigned char* ost = lds + GDN_OST + (step & 1) * GDN_OST_BYTES;
    bf16* op = p.oa + ((size_t)dir * ROWS + (size_t)b * TOK + (size_t)c * GCH) * 512 + h * 128;
#pragma unroll
    for (int k = 0; k < 2; ++k) { const int idx = tl + 256 * k, row = idx >> 4, ch = idx & 15; *(u32x4_t*)(op + (size_t)row * 512 + ch * 8) = *(const LASP u32x4_t*)(ost + row * 272 + ch * 16); }
}
__device__ __forceinline__ s16x4_t trd(const LASP unsigned char* q) {
    typedef short v4i16_t __attribute__((ext_vector_type(4)));
    return __builtin_bit_cast(s16x4_t, __builtin_amdgcn_ds_read_tr16_b64_v4i16((LASP v4i16_t*)q));
}
#define TRFRAG(base) __builtin_shufflevector(trd(base), trd((base) + 8 * 320), 0, 1, 2, 3, 4, 5, 6, 7)

#if TPROBE == 60
#define GDN_SYNC_C() do { unsigned long long t_ = __builtin_amdgcn_s_memrealtime(); __syncthreads(); if (chain == 0 && tid == 0) p.stats[2] += (float)(__builtin_amdgcn_s_memrealtime() - t_) * 0.01f; } while (0)
#define GDN_SYNC_L() __syncthreads()
#elif TPROBE == 61
#define GDN_SYNC_L() do { unsigned long long t_ = __builtin_amdgcn_s_memrealtime(); __syncthreads(); if (chain == 0 && tid == 256) p.stats[2] += (float)(__builtin_amdgcn_s_memrealtime() - t_) * 0.01f; } while (0)
#define GDN_SYNC_C() __syncthreads()
#else
#define GDN_SYNC_C() __syncthreads()
#define GDN_SYNC_L() __syncthreads()
#endif
__device__ __forceinline__ float lm_(float a, float b) { float t = a * b; asm("" : "+v"(t)); return t; }
__device__ void gdn_scan_fast(const P& p, LASP unsigned char* lds, int chain) {
    const int tid = mk_tid();
    const int lane = tid & 63, wave = __builtin_amdgcn_readfirstlane(tid >> 6);
    const int dir = chain & 1, h = (chain >> 1) & 3, b = chain >> 3;
    constexpr int NS = NCH;
    if (wave >= 4) {
        const int tl = tid - 256;
        GSlot g0, g1, g2, g3;
        gdn_issue(p, g0, b, h, dir, 0, tl); gdn_issue(p, g1, b, h, dir, 1, tl); gdn_issue(p, g2, b, h, dir, 2, tl); gdn_issue(p, g3, b, h, dir, 3, tl);
        gdn_write(lds, g0, tl); gdn_issue(p, g0, b, h, dir, 4, tl);
        __syncthreads();
#pragma unroll 1
        for (int s = 0; s < NS; s += 4) {
            if (s > 0) gdn_flush(p, lds, b, h, dir, s - 1, tl);
            gdn_write(lds + ((s + 1) & 1) * ST_BYTES, g1, tl); gdn_issue(p, g1, b, h, dir, min(s + 5, NS - 1), tl);
            GDN_SYNC_L();
            gdn_flush(p, lds, b, h, dir, s, tl);
            gdn_write(lds + ((s + 2) & 1) * ST_BYTES, g2, tl); gdn_issue(p, g2, b, h, dir, min(s + 6, NS - 1), tl);
            GDN_SYNC_L();
            gdn_flush(p, lds, b, h, dir, s + 1, tl);
            gdn_write(lds + ((s + 3) & 1) * ST_BYTES, g3, tl); gdn_issue(p, g3, b, h, dir, min(s + 7, NS - 1), tl);
            GDN_SYNC_L();
            gdn_flush(p, lds, b, h, dir, s + 2, tl);
            gdn_write(lds + ((s + 4) & 1) * ST_BYTES, g0, tl); gdn_issue(p, g0, b, h, dir, min(s + 8, NS - 1), tl);
            GDN_SYNC_L();
        }
        gdn_flush(p, lds, b, h, dir, NS - 1, tl);
    } else {
        const int r = lane & 31, hh = lane >> 5, w = wave;
        f32x16_t S0, S1, S2, S3;
#pragma unroll
        for (int i = 0; i < 16; ++i) { S0[i] = 0.f; S1[i] = 0.f; S2[i] = 0.f; S3[i] = 0.f; }
        const int troff = (4 * hh + ((lane & 15) >> 2)) * 320 + (16 * ((lane >> 4) & 1) + 4 * (lane & 3)) * 2;
        __syncthreads();
#pragma unroll 1
        for (int s = 0; s < NS; ++s) {
            LASP unsigned char* st = lds + (s & 1) * ST_BYTES;
            const LASP float* sc = (const LASP float*)(st + ST_GL);
            const float gl = sc[64];
            const LASP unsigned char* tp = st + ST_TP + r * 80 + hh * 16;
            const bf16x8_t T0 = *(const LASP bf16x8_t*)(tp), T1 = *(const LASP bf16x8_t*)(tp + 32);
            const LASP unsigned char* vbase = st + ST_V + troff + 64 * w;
            const bf16x8_t vB0 = TRFRAG(vbase), vB1 = TRFRAG(vbase + 16 * 320);
            const LASP unsigned char* ka = st + ST_KA + r * 272 + hh * 16;
            const LASP unsigned char* qa = st + ST_QA + r * 272 + hh * 16;
            const bf16x8_t kA0 = *(const LASP bf16x8_t*)(ka), qA0 = *(const LASP bf16x8_t*)(qa), kA1 = *(const LASP bf16x8_t*)(ka + 32), qA1 = *(const LASP bf16x8_t*)(qa + 32);
            __builtin_amdgcn_sched_barrier(0);
            f32x16_t ak, aq, vn;
#pragma unroll
            for (int i = 0; i < 16; ++i) { ak[i] = 0.f; aq[i] = 0.f; vn[i] = 0.f; }
#define GDN_KQ(KA, QA, SX, u) { const bf16x8_t SB = PACK8(SX, u); ak = MFMA32(KA, SB, ak); aq = MFMA32(QA, SB, aq); \
                                 f32x4_t a_ = {lm_(SX[8 * u], gl), lm_(SX[8 * u + 1], gl), lm_(SX[8 * u + 2], gl), lm_(SX[8 * u + 3], gl)}, b_ = {lm_(SX[8 * u + 4], gl), lm_(SX[8 * u + 5], gl), lm_(SX[8 * u + 6], gl), lm_(SX[8 * u + 7], gl)}; \
                                 asm volatile("" : "+v"(a_), "+v"(b_));        \
                                 SX[8 * u] = a_.x; SX[8 * u + 1] = a_.y; SX[8 * u + 2] = a_.z; SX[8 * u + 3] = a_.w; SX[8 * u + 4] = b_.x; SX[8 * u + 5] = b_.y; SX[8 * u + 6] = b_.z; SX[8 * u + 7] = b_.w; }
            const bf16x8_t kA2 = *(const LASP bf16x8_t*)(ka + 64), qA2 = *(const LASP bf16x8_t*)(qa + 64), kA3 = *(const LASP bf16x8_t*)(ka + 96), qA3 = *(const LASP bf16x8_t*)(qa + 96);
            vn = MFMA32(T0, vB0, vn); vn = MFMA32(T1, vB1, vn);
            GDN_KQ(kA0, qA0, S0, 0) GDN_KQ(kA1, qA1, S0, 1)
            __builtin_amdgcn_sched_barrier(0);
            const bf16x8_t kA4 = *(const LASP bf16x8_t*)(ka + 128), qA4 = *(const LASP bf16x8_t*)(qa + 128), kA5 = *(const LASP bf16x8_t*)(ka + 160), qA5 = *(const LASP bf16x8_t*)(qa + 160);
            GDN_KQ(kA2, qA2, S1, 0) GDN_KQ(kA3, qA3, S1, 1)
            __builtin_amdgcn_sched_barrier(0);
            const bf16x8_t kA6 = *(const LASP bf16x8_t*)(ka + 192), qA6 = *(const LASP bf16x8_t*)(qa + 192), kA7 = *(const LASP bf16x8_t*)(ka + 224), qA7 = *(const LASP bf16x8_t*)(qa + 224);
            GDN_KQ(kA4, qA4, S2, 0) GDN_KQ(kA5, qA5, S2, 1)
            __builtin_amdgcn_sched_barrier(0);
            const LASP unsigned char* qk = st + ST_QK + r * 80 + hh * 16;
            const bf16x8_t Q0 = *(const LASP bf16x8_t*)(qk), Q1 = *(const LASP bf16x8_t*)(qk + 32);
            const f32x4_t e0 = *(const LASP f32x4_t*)(sc + 4 * hh), e1 = *(const LASP f32x4_t*)(sc + 8 + 4 * hh), e2 = *(const LASP f32x4_t*)(sc + 16 + 4 * hh), e3 = *(const LASP f32x4_t*)(sc + 24 + 4 * hh);
            const f32x4_t f0 = *(const LASP f32x4_t*)(sc + 32 + 4 * hh), f1 = *(const LASP f32x4_t*)(sc + 40 + 4 * hh), f2 = *(const LASP f32x4_t*)(sc + 48 + 4 * hh), f3 = *(const LASP f32x4_t*)(sc + 56 + 4 * hh);
            GDN_KQ(kA6, qA6, S3, 0) GDN_KQ(kA7, qA7, S3, 1)
#undef GDN_KQ
            __builtin_amdgcn_sched_barrier(0);
            const LASP unsigned char* kn = st + ST_KN + troff;
            const bf16x8_t N00 = TRFRAG(kn), N01 = TRFRAG(kn + 16 * 320), N10 = TRFRAG(kn + 64), N11 = TRFRAG(kn + 64 + 16 * 320);
            const bf16x8_t N20 = TRFRAG(kn + 128), N21 = TRFRAG(kn + 128 + 16 * 320), N30 = TRFRAG(kn + 192), N31 = TRFRAG(kn + 192 + 16 * 320);
            __builtin_amdgcn_sched_barrier(0);
#define ROWSCALE(X, sgn) { X[0] *= sgn e0.x; X[1] *= sgn e0.y; X[2] *= sgn e0.z; X[3] *= sgn e0.w; X[4] *= sgn e1.x; X[5] *= sgn e1.y; X[6] *= sgn e1.z; X[7] *= sgn e1.w; \
                           X[8] *= sgn e2.x; X[9] *= sgn e2.y; X[10] *= sgn e2.z; X[11] *= sgn e2.w; X[12] *= sgn e3.x; X[13] *= sgn e3.y; X[14] *= sgn e3.z; X[15] *= sgn e3.w; }
            ROWSCALE(ak, -) ROWSCALE(aq, +)
#undef ROWSCALE
            const bf16x8_t ab0 = PACK8(ak, 0), ab1 = PACK8(ak, 1);
            vn = MFMA32(T0, ab0, vn); vn = MFMA32(T1, ab1, vn);
            const bf16x8_t vb0 = PACK8(vn, 0), vb1 = PACK8(vn, 1);
            f32x16_t vf;
            vf[0] = vn[0] * f0.x; vf[1] = vn[1] * f0.y; vf[2] = vn[2] * f0.z; vf[3] = vn[3] * f0.w; vf[4] = vn[4] * f1.x; vf[5] = vn[5] * f1.y; vf[6] = vn[6] * f1.z; vf[7] = vn[7] * f1.w;
            vf[8] = vn[8] * f2.x; vf[9] = vn[9] * f2.y; vf[10] = vn[10] * f2.z; vf[11] = vn[11] * f2.w; vf[12] = vn[12] * f3.x; vf[13] = vn[13] * f3.y; vf[14] = vn[14] * f3.z; vf[15] = vn[15] * f3.w;
            const bf16x8_t fb0 = PACK8(vf, 0), fb1 = PACK8(vf, 1);
            S0 = MFMA32(N00, fb0, S0); S1 = MFMA32(N10, fb0, S1); S2 = MFMA32(N20, fb0, S2); S3 = MFMA32(N30, fb0, S3);
            S0 = MFMA32(N01, fb1, S0); S1 = MFMA32(N11, fb1, S1); S2 = MFMA32(N21, fb1, S2); S3 = MFMA32(N31, fb1, S3);
            aq = MFMA32(Q0, vb0, aq); aq = MFMA32(Q1, vb1, aq);
            {
                LASP unsigned short* ost = (LASP unsigned short*)(lds + GDN_OST + (s & 1) * GDN_OST_BYTES) + 32 * w + r;
#pragma unroll
                for (int i = 0; i < 16; i += 2) { const unsigned pk = cvtpk(aq[i], aq[i + 1]); ost[crow(i, hh) * 136] = (unsigned short)pk; ost[(crow(i, hh) + 1) * 136] = (unsigned short)(pk >> 16); }
            }
            GDN_SYNC_C();
        }
    }
}

constexpr int GL_ITEM = 6272;
constexpr size_t GLA_PREP_OFF = (size_t)BATCH * 4 * 2 * NCH * GP_ITEM;

struct GlaRaw { unsigned short q[16], k[16]; };
__device__ __forceinline__ void gla_prep_load(const P& p, GlaRaw& g, int it, int lane) {
    const int r = lane & 31, hh = lane >> 5;
    const int c = it % NCH, bh = it / NCH, h = bh & 3, b = bh >> 2;
    const size_t row0 = (size_t)b * TOK + (size_t)c * GCH;
    const bf16* qb = p.rest + (row0 + 4 * hh) * NREST + RC_CQ + h * 32 + r;
#pragma unroll
    for (int i = 0; i < 16; ++i) { const int no = (i & 3) + 8 * (i >> 2); g.q[i] = qb[(size_t)no * NREST]; g.k[i] = qb[(size_t)no * NREST + 128]; }
}
__device__ __forceinline__ void gla_prep_item(const P& p, LASP unsigned char* wl, const LASP float* cstab, int l, int it, int lane, const GlaRaw& g) {
    const int r = lane & 31, hh = lane >> 5;
    const int c = it % NCH, bh = it / NCH, h = bh & 3, b = bh >> 2;
    const size_t row0 = (size_t)b * TOK + (size_t)c * GCH;
    float qv[16], kv[16];
#pragma unroll
    for (int i = 0; i < 16; ++i) { qv[i] = bf2f(g.q[i]); kv[i] = bf2f(g.k[i]); }
    if (c >= 8) {
        const int dd = r & 15, f = dd & 7;
        const int prow = (c - 8) >> 1, pcol0 = 32 * ((c - 8) & 1);
#pragma unroll
        for (int i = 0; i < 16; ++i) {
            const int n = crow(i, hh);
            const int pos = r < 16 ? prow : pcol0 + n;
            const float cs = cstab[(pos * 8 + f) * 2], sn = cstab[(pos * 8 + f) * 2 + 1];
            const float qp = __shfl_xor(qv[i], 8), kp = __shfl_xor(kv[i], 8);
            if (dd < 8) { qv[i] = qv[i] * cs - qp * sn; kv[i] = kv[i] * cs - kp * sn; }
            else { qv[i] = qp * sn + qv[i] * cs; kv[i] = kp * sn + kv[i] * cs; }
        }
    }
#pragma unroll
    for (int i = 0; i < 16; ++i) qv[i] *= 0.17677669529663687f;
#pragma unroll 1
    for (int dir = 0; dir < 2; ++dir) {
        f32x16_t X;
#pragma unroll
        for (int i = 0; i < 16; ++i) X[i] = 0.f;
        {
            const bf16x8_t A = *(const bf16x8_t*)(p.rest + (row0 + r) * NREST + RC_CR + dir * 16 + 8 * hh);
            const float* w2p = p.gla_w2 + ((size_t)(l * 2 + dir) * 16 + 8 * hh) * 128 + h * 32 + r;
            const bf16x8_t Bf = __builtin_bit_cast(bf16x8_t, (u32x4_t){cvtpk(w2p[0], w2p[128]), cvtpk(w2p[256], w2p[384]), cvtpk(w2p[512], w2p[640]), cvtpk(w2p[768], w2p[896])});
            X = MFMA32(A, Bf, X);
        }
        const float b2v = p.gla_b2[(l * 2 + dir) * 128 + h * 32 + r];
        float Bc[16];
#pragma unroll
        for (int i = 0; i < 16; ++i) { const float xg = X[i] + b2v; Bc[i] = (fminf(xg, 0.f) - 0.6931471805599453f * __builtin_amdgcn_logf(1.f + __builtin_amdgcn_exp2f(-1.4426950408889634f * fabsf(xg)))) * (1.f / 16.f); }
        float tot;
        {
            float sg[4], ps[4];
#pragma unroll
            for (int g = 0; g < 4; ++g) { sg[g] = (Bc[4 * g] + Bc[4 * g + 1]) + (Bc[4 * g + 2] + Bc[4 * g + 3]); ps[g] = __shfl_xor(sg[g], 32); }
            tot = ((sg[0] + ps[0]) + (sg[1] + ps[1])) + ((sg[2] + ps[2]) + (sg[3] + ps[3]));
            if (dir == 0) {
                float base = 0.f;
#pragma unroll
                for (int g = 0; g < 4; ++g) {
                    float o = base + (hh ? ps[g] : 0.f);
#pragma unroll
                    for (int k = 0; k < 4; ++k) { o += Bc[4 * g + k]; Bc[4 * g + k] = o; }
                    base += sg[g] + ps[g];
                }
            } else {
                float base = 0.f;
#pragma unroll
                for (int g = 3; g >= 0; --g) {
                    float o = base + (hh ? 0.f : ps[g]);
#pragma unroll
                    for (int k = 3; k >= 0; --k) { o += Bc[4 * g + k]; Bc[4 * g + k] = o; }
                    base += sg[g] + ps[g];
                }
            }
        }
        unsigned char* gout = (unsigned char*)p.raw + GLA_PREP_OFF + ((size_t)(bh * 2 + dir) * NCH + c) * GL_ITEM;
        LASP bf16* ql = (LASP bf16*)wl;
        LASP bf16* kl = ql + 32 * 40;
        {
            bf16* qpo = (bf16*)gout + perm16(r);
            bf16* kdo = (bf16*)(gout + 4096) + r * 32;
#pragma unroll
            for (int g = 0; g < 4; ++g) {
                float kd[4];
#pragma unroll
                for (int k = 0; k < 4; ++k) {
                    const int i = 4 * g + k, n = crow(i, hh);
                    const float eb = __builtin_amdgcn_exp2f(1.4426950408889634f * Bc[i]);
                    const float qs = qv[i] * eb, ks = kv[i] * __builtin_amdgcn_rcpf(eb);
                    kd[k] = kv[i] * __builtin_amdgcn_exp2f(1.4426950408889634f * (tot - Bc[i]));
                    const bf16 qsb = f2bf(qs);
                    qpo[n * 32] = qsb;
                    ql[n * 40 + r] = qsb; kl[n * 40 + r] = f2bf(ks);
                }
                *(u32x2_t*)(kdo + perm16(8 * g + 4 * hh)) = (u32x2_t){cvtpk(kd[0], kd[1]), cvtpk(kd[2], kd[3])};
            }
            if (hh == 0) ((float*)(gout + 6144))[r] = __builtin_amdgcn_exp2f(1.4426950408889634f * tot);
        }
        asm volatile("s_waitcnt lgkmcnt(0)" ::: "memory");
        f32x16_t AT;
#pragma unroll
        for (int i = 0; i < 16; ++i) AT[i] = 0.f;
        AT = MFMA32(*(const LASP bf16x8_t*)((const LASP unsigned char*)kl + r * 80 + hh * 16), *(const LASP bf16x8_t*)((const LASP unsigned char*)ql + r * 80 + hh * 16), AT);
        AT = MFMA32(*(const LASP bf16x8_t*)((const LASP unsigned char*)kl + r * 80 + hh * 16 + 32), *(const LASP bf16x8_t*)((const LASP unsigned char*)ql + r * 80 + hh * 16 + 32), AT);
        {
            bf16* amo = (bf16*)(gout + 2048) + r * 32;
#pragma unroll
            for (int g = 0; g < 4; ++g) {
                float a[4];
#pragma unroll
                for (int k = 0; k < 4; ++k) { const int m = crow(4 * g + k, hh); const bool keep = dir == 0 ? (m <= r) : (m >= r); a[k] = keep ? AT[4 * g + k] : 0.f; }
                *(u32x2_t*)(amo + perm16(8 * g + 4 * hh)) = (u32x2_t){cvtpk(a[0], a[1]), cvtpk(a[2], a[3])};
            }
        }
        asm volatile("s_waitcnt lgkmcnt(0)" ::: "memory");
    }
}

constexpr int LS_QP = 0, LS_AM = 2560, LS_KD = 5120, LS_V = 7680, LS_GL = 13824, LS_BYTES = 13952;
constexpr int GLA_OST = 4 * LS_BYTES, GLA_OST_BYTES = 32 * 144;
struct LSlot { u32x4_t a0, a1, a2, v0, v1; f32x4_t gl; };
__device__ __forceinline__ void gla_issue(const P& p, LSlot& g, int b, int h, int dir, int step, int t2) {
    const int c = gdn_chunk(dir, step);
    const unsigned char* gp = (const unsigned char*)p.raw + GLA_PREP_OFF + ((size_t)((b * 4 + h) * 2 + dir) * NCH + c) * GL_ITEM;
    g.a0 = *(const u32x4_t*)(gp + t2 * 16); g.a1 = *(const u32x4_t*)(gp + 2048 + t2 * 16); g.a2 = *(const u32x4_t*)(gp + 4096 + t2 * 16);
    g.gl = *(const f32x4_t*)(gp + 6144 + (t2 < 8 ? t2 : 0) * 16);
    const size_t row0 = (size_t)b * TOK + (size_t)c * GCH;
    const bf16* vp = p.rest + (row0 + (t2 >> 3)) * NREST + RC_CV + h * 64 + 8 * (t2 & 7);
    g.v0 = *(const u32x4_t*)vp; g.v1 = *(const u32x4_t*)(vp + (size_t)16 * NREST);
}
__device__ __forceinline__ void gla_write(LASP unsigned char* st, const LSlot& g, int t2) {
    const int row = t2 >> 2, ch = t2 & 3;
    *(LASP u32x4_t*)(st + LS_QP + row * 80 + ch * 16) = g.a0;
    *(LASP u32x4_t*)(st + LS_AM + row * 80 + ch * 16) = g.a1;
    *(LASP u32x4_t*)(st + LS_KD + row * 80 + ch * 16) = g.a2;
    if (t2 < 8) *(LASP f32x4_t*)(st + LS_GL + t2 * 16) = g.gl;
    *(LASP u32x4_t*)(st + LS_V + (t2 >> 3) * 192 + (t2 & 7) * 16) = g.v0; *(LASP u32x4_t*)(st + LS_V + (16 + (t2 >> 3)) * 192 + (t2 & 7) * 16) = g.v1;
}
__device__ __forceinline__ void gla_flush(const P& p, LASP unsigned char* lds, int b, int h, int dir, int step, int t2) {
    const int c = gdn_chunk(dir, step);
    const LASP unsigned char* ost = lds + GLA_OST + (dir * 2 + (step & 1)) * GLA_OST_BYTES;
    bf16* op = p.oc + ((size_t)dir * ROWS + (size_t)b * TOK + (size_t)c * GCH) * 256 + h * 64;
#pragma unroll
    for (int k = 0; k < 2; ++k) { const int idx = t2 + 128 * k, row = idx >> 3, ch = idx & 7; *(u32x4_t*)(op + (size_t)row * 256 + ch * 8) = *(const LASP u32x4_t*)(ost + row * 144 + ch * 16); }
}
#if TPROBE == 62
#define GLA_SYNC_C() do { unsigned long long t_ = __builtin_amdgcn_s_memrealtime(); __syncthreads(); if (bh == 0 && tid == 0) p.stats[2] += (float)(__builtin_amdgcn_s_memrealtime() - t_) * 0.01f; } while (0)
#define GLA_SYNC_L() __syncthreads()
#elif TPROBE == 63
#define GLA_SYNC_L() do { unsigned long long t_ = __builtin_amdgcn_s_memrealtime(); __syncthreads(); if (bh == 0 && tid == 256) p.stats[2] += (float)(__builtin_amdgcn_s_memrealtime() - t_) * 0.01f; } while (0)
#define GLA_SYNC_C() __syncthreads()
#else
#define GLA_SYNC_C() __syncthreads()
#define GLA_SYNC_L() __syncthreads()
#endif
__device__ void gla_scan_fast(const P& p, LASP unsigned char* lds, int bh) {
    const int tid = mk_tid();
    const int lane = tid & 63, wave = __builtin_amdgcn_readfirstlane(tid >> 6);
    const int h = bh & 3, b = bh >> 2;
    constexpr int NS = NCH;
    if (wave >= 4) {
        const int dir = (wave - 4) >> 1, t2 = tid & 127;
        LASP unsigned char* base = lds + dir * 2 * LS_BYTES;
        LSlot g0, g1, g2, g3, g4, g5, g6, g7;
        gla_issue(p, g0, b, h, dir, 0, t2); gla_issue(p, g1, b, h, dir, 1, t2); gla_issue(p, g2, b, h, dir, 2, t2); gla_issue(p, g3, b, h, dir, 3, t2);
        gla_issue(p, g4, b, h, dir, 4, t2); gla_issue(p, g5, b, h, dir, 5, t2); gla_issue(p, g6, b, h, dir, 6, t2); gla_issue(p, g7, b, h, dir, 7, t2);
        gla_write(base, g0, t2); gla_issue(p, g0, b, h, dir, 8, t2);
        __syncthreads();
        static_assert(NS % 8 == 0, "the loader loop is unrolled by its eight slots");
#define GLA_STEP(u, G) { gla_write(base + ((s + u + 1) & 1) * LS_BYTES, G, t2); gla_issue(p, G, b, h, dir, min(s + u + 9, NS - 1), t2); GLA_SYNC_L(); }
#pragma unroll 1
        for (int s = 0; s < NS; s += 8) { GLA_STEP(0, g1) GLA_STEP(1, g2) GLA_STEP(2, g3) GLA_STEP(3, g4) GLA_STEP(4, g5) GLA_STEP(5, g6) GLA_STEP(6, g7) GLA_STEP(7, g0) }
#undef GLA_STEP
    } else {
        const int r = lane & 31, hh = lane >> 5, dir = wave >> 1, blk = wave & 1;
        const int t2c = blk * 64 + lane;
        LASP unsigned char* base = lds + dir * 2 * LS_BYTES;
        f32x16_t S;
#pragma unroll
        for (int i = 0; i < 16; ++i) S[i] = 0.f;
        __syncthreads();
        const int troff = (4 * hh + ((lane & 15) >> 2)) * 192 + (16 * ((lane >> 4) & 1) + 4 * (lane & 3)) * 2 + 64 * blk;
#define TRFRAG192(bs) __builtin_shufflevector(trd(bs), trd((bs) + 8 * 192), 0, 1, 2, 3, 4, 5, 6, 7)
#pragma unroll 1
        for (int s = 0; s < NS; ++s) {
            const LASP unsigned char* st = base + (s & 1) * LS_BYTES;
#if TPROBE == 64 || TPROBE == 65
            const unsigned long long ttop_ = __builtin_amdgcn_s_memrealtime();
            __builtin_amdgcn_sched_barrier(0);
#endif
            const LASP unsigned char* qp = st + LS_QP + r * 80 + hh * 16;
            const LASP unsigned char* am = st + LS_AM + r * 80 + hh * 16;
            const LASP unsigned char* kd = st + LS_KD + r * 80 + hh * 16;
            const bf16x8_t QP0 = *(const LASP bf16x8_t*)(qp), QP1 = *(const LASP bf16x8_t*)(qp + 32);
            const bf16x8_t AM0 = *(const LASP bf16x8_t*)(am), AM1 = *(const LASP bf16x8_t*)(am + 32);
            const bf16x8_t KD0 = *(const LASP bf16x8_t*)(kd), KD1 = *(const LASP bf16x8_t*)(kd + 32);
            const LASP unsigned char* vb = st + LS_V + troff;
            const bf16x8_t V0 = TRFRAG192(vb), V1 = TRFRAG192(vb + 16 * 192);
            const LASP float* glp = (const LASP float*)(st + LS_GL);
            const f32x4_t g0 = *(const LASP f32x4_t*)(glp + 4 * hh), g1 = *(const LASP f32x4_t*)(glp + 8 + 4 * hh), g2 = *(const LASP f32x4_t*)(glp + 16 + 4 * hh), g3 = *(const LASP f32x4_t*)(glp + 24 + 4 * hh);
            if (s > 0) gla_flush(p, lds, b, h, dir, s - 1, t2c);
            __builtin_amdgcn_sched_barrier(0);
#if TPROBE == 64 || TPROBE == 65
            asm volatile("s_waitcnt lgkmcnt(0)" ::: "memory");
            const unsigned long long tmid_ = __builtin_amdgcn_s_memrealtime();
            if (TPROBE == 64 && bh == 0 && tid == 0) p.stats[2] += (float)(tmid_ - ttop_) * 0.01f;
            __builtin_amdgcn_sched_barrier(0);
#endif
            const bf16x8_t Sb0 = PACK8(S, 0), Sb1 = PACK8(S, 1);
            f32x16_t oT;
#pragma unroll
            for (int i = 0; i < 16; ++i) oT[i] = 0.f;
            oT = MFMA32(V0, AM0, oT); oT = MFMA32(V1, AM1, oT);
            oT = MFMA32(Sb0, QP0, oT); oT = MFMA32(Sb1, QP1, oT);
            S[0] *= g0.x; S[1] *= g0.y; S[2] *= g0.z; S[3] *= g0.w; S[4] *= g1.x; S[5] *= g1.y; S[6] *= g1.z; S[7] *= g1.w;
            S[8] *= g2.x; S[9] *= g2.y; S[10] *= g2.z; S[11] *= g2.w; S[12] *= g3.x; S[13] *= g3.y; S[14] *= g3.z; S[15] *= g3.w;
            S = MFMA32(KD0, V0, S);
            S = MFMA32(KD1, V1, S);
            {
                LASP unsigned char* ost = lds + GLA_OST + (dir * 2 + (s & 1)) * GLA_OST_BYTES + r * 144 + (32 * blk + 4 * hh) * 2;
#pragma unroll
                for (int g = 0; g < 4; ++g) *(LASP u32x2_t*)(ost + 16 * g) = (u32x2_t){cvtpk(oT[4 * g], oT[4 * g + 1]), cvtpk(oT[4 * g + 2], oT[4 * g + 3])};
            }
#if TPROBE == 65
            __builtin_amdgcn_sched_barrier(0);
            asm volatile("s_nop 15\n\ts_nop 15" ::: "memory");
            if (bh == 0 && tid == 0) p.stats[2] += (float)(__builtin_amdgcn_s_memrealtime() - tmid_) * 0.01f;
#endif
            GLA_SYNC_C();
        }
        gla_flush(p, lds, b, h, dir, NS - 1, t2c);
    }
}


__device__ __forceinline__ void vf_items(const P& p, LASP unsigned char* wl, int it0, int stride, int lane) {
    const int r = lane & 31, hh = lane >> 5;
    constexpr int NIT = BATCH * 4 * NCH;
    u32x4_t ld[3][4];
#pragma unroll
    for (int k = 0; k < 3; ++k) {
        const int it = it0 + k * stride;
        if (it < NIT) {
            const int kb = it % NCH, bh = it / NCH, h = bh & 3, b = bh >> 2;
            const bf16* vp = p.rest + ((size_t)b * TOK + 32 * kb + r) * NREST + RC_BV + h * 64 + 32 * hh;
#pragma unroll
            for (int q = 0; q < 4; ++q) ld[k][q] = *(const u32x4_t*)(vp + 8 * q);
        }
    }
#pragma unroll
    for (int k = 0; k < 3; ++k) {
        const int it = it0 + k * stride;
        if (it < NIT) {
#pragma unroll
            for (int q = 0; q < 4; ++q) *(LASP u32x4_t*)(wl + k * 5120 + r * 160 + (32 * hh + 8 * q) * 2) = ld[k][q];
        }
    }
    asm volatile("s_waitcnt lgkmcnt(0)" ::: "memory");
    const int troff = (4 * hh + ((lane & 15) >> 2)) * 160 + (16 * ((lane >> 4) & 1) + 4 * (lane & 3)) * 2;
#pragma unroll
    for (int k = 0; k < 3; ++k) {
        const int it = it0 + k * stride;
        if (it < NIT) {
            const int kb = it % NCH, bh = it / NCH;
            bf16* op = p.vf + ((size_t)(bh * NCH + kb) * 4) * 512 + lane * 8;
#pragma unroll
            for (int dvb = 0; dvb < 2; ++dvb)
#pragma unroll
                for (int u = 0; u < 2; ++u) {
                    const LASP unsigned char* bs = wl + k * 5120 + troff + 64 * dvb + (16 * u) * 160;
                    const bf16x8_t f = __builtin_shufflevector(trd(bs), trd(bs + 8 * 160), 0, 1, 2, 3, 4, 5, 6, 7);
                    *(bf16x8_t*)(op + (dvb * 2 + u) * 512) = f;
                }
        }
    }
    asm volatile("s_waitcnt lgkmcnt(0)" ::: "memory");
}

__device__ __forceinline__ void na_item(const P& p, const LASP float* rpbL, int it, int lane) {
    const int r = lane & 31, hh = lane >> 5;
    int b, h, ry, qb; bool lat;
    if (it < 4096) { lat = true; qb = it & 1; ry = (it >> 1) & 63; h = (it >> 7) & 3; b = it >> 9; }
    else { const int j = it - 4096; lat = false; qb = j & 7; h = (j >> 3) & 3; b = j >> 5; ry = 0; }
    const size_t brow = (size_t)b * TOK;
    const int q0 = lat ? CTX + ry * 64 + qb * 32 : qb * 32;
    bf16* qp = p.rest + (brow + q0 + r) * NREST + RC_BQ + h * 64;
    bf16x8_t Qf0 = *(const bf16x8_t*)(qp + 8 * hh), Qf1 = *(const bf16x8_t*)(qp + 16 + 8 * hh), Qf2 = *(const bf16x8_t*)(qp + 32 + 8 * hh), Qf3 = *(const bf16x8_t*)(qp + 48 + 8 * hh);
    f32x16_t O0, O1;
#pragma unroll
    for (int i = 0; i < 16; ++i) { O0[i] = 0.f; O1[i] = 0.f; }
    float m = -1e30f, lsum = 0.f;
    const bf16* kfb = p.kf + ((size_t)(b * 4 + h) * NCH) * 2048 + lane * 8;
    const bf16* vfb = p.vf + ((size_t)(b * 4 + h) * NCH) * 2048 + lane * 8;
    const int nkb = lat ? 24 : 8;
    const int c = qb * 32 + r, c0 = min(max(c - 8, 0), 48), r0 = min(max(ry - 4, 0), 56);
    constexpr float SC = 0.125f * 1.4426950408889634f;
    struct KV { bf16x8_t k0, k1, k2, k3, v00, v01, v10, v11; };
    KV fA, fB;
#define NA_KBIDX(kq) ((kq) < 8 ? (kq) : 8 + (r0 + (((kq) - 8) >> 1)) * 2 + (((kq) - 8) & 1))
#define NA_LOAD(F, kq) { const size_t o_ = (size_t)NA_KBIDX(min((kq), nkb - 1)) * 2048; const bf16* kp = kfb + o_; const bf16* vp = vfb + o_; \
        F.k0 = *(const bf16x8_t*)(kp); F.k1 = *(const bf16x8_t*)(kp + 512); F.k2 = *(const bf16x8_t*)(kp + 1024); F.k3 = *(const bf16x8_t*)(kp + 1536); \
        F.v00 = *(const bf16x8_t*)(vp); F.v01 = *(const bf16x8_t*)(vp + 512); F.v10 = *(const bf16x8_t*)(vp + 1024); F.v11 = *(const bf16x8_t*)(vp + 1536); }
    NA_LOAD(fA, 0) NA_LOAD(fB, 1)
#define NA_BLOCK(F, kq) { \
        const int kb_ = (kq); int ky = 0, cb = 0; const bool win = kb_ >= 8; \
        if (win) { const int w_ = kb_ - 8; ky = r0 + (w_ >> 1); cb = w_ & 1; } \
        f32x16_t S; _Pragma("unroll") for (int i = 0; i < 16; ++i) S[i] = 0.f; \
        S = MFMA32(F.k0, Qf0, S); S = MFMA32(F.k1, Qf1, S); S = MFMA32(F.k2, Qf2, S); S = MFMA32(F.k3, Qf3, S); \
        const bf16x8_t V00 = F.v00, V01 = F.v01, V10 = F.v10, V11 = F.v11; \
        NA_LOAD(F, kb_ + 2) \
        float bm = -1e30f; \
        if (win) { \
            const LASP float* rb = rpbL + (h * 15 + (ky - ry + 7)) * 31 + 15 - c; \
            _Pragma("unroll") for (int i = 0; i < 16; ++i) { \
                const int kc = cb * 32 + crow(i, hh); \
                const bool valid = (kc >= c0) && (kc < c0 + 16); \
                const float bias = rb[valid ? kc : c]; \
                S[i] = valid ? S[i] * SC + bias : -1e30f; \
                bm = fmaxf(bm, S[i]); } \
        } else { _Pragma("unroll") for (int i = 0; i < 16; ++i) { S[i] *= SC; bm = fmaxf(bm, S[i]); } } \
        bm = fmaxf(bm, __shfl_xor(bm, 32)); \
        const float mn = fmaxf(m, bm); \
        float ps = 0.f; \
        _Pragma("unroll") for (int i = 0; i < 16; ++i) { S[i] = __builtin_amdgcn_exp2f(S[i] - mn); ps += S[i]; } \
        if (__builtin_amdgcn_ballot_w64(bm > m) != 0ull) {        \
            const float alpha = __builtin_amdgcn_exp2f(m - mn); \
            lsum *= alpha; \
            _Pragma("unroll") for (int i = 0; i < 16; ++i) { O0[i] *= alpha; O1[i] *= alpha; } \
        } \
        m = mn; \
        lsum += ps; \
        const bf16x8_t Pb0 = PACK8(S, 0), Pb1 = PACK8(S, 1); \
        O0 = MFMA32(V00, Pb0, O0); O0 = MFMA32(V01, Pb1, O0); \
        O1 = MFMA32(V10, Pb0, O1); O1 = MFMA32(V11, Pb1, O1); }
#pragma unroll 1
    for (int kb = 0; kb < nkb; kb += 2) { NA_BLOCK(fA, kb) NA_BLOCK(fB, kb + 1) }
#undef NA_BLOCK
#undef NA_LOAD
#undef NA_KBIDX
    const float inv = 1.f / (lsum + __shfl_xor(lsum, 32));
    bf16* op = qp + 4 * hh;
#pragma unroll
    for (int g = 0; g < 4; ++g) {
        *(u32x2_t*)(op + 8 * g) = (u32x2_t){cvtpk(O0[4 * g] * inv, O0[4 * g + 1] * inv), cvtpk(O0[4 * g + 2] * inv, O0[4 * g + 3] * inv)};
        *(u32x2_t*)(op + 32 + 8 * g) = (u32x2_t){cvtpk(O1[4 * g] * inv, O1[4 * g + 1] * inv), cvtpk(O1[4 * g + 2] * inv, O1[4 * g + 3] * inv)};
    }
}

__device__ void ph_prep_early(const P& p, LASP unsigned char* lds, int l, int bid, int nblk) {
    const int tid = mk_tid();
    const int lane = tid & 63, wave = tid >> 6;
    for (int it0 = bid * NWAVES + wave; it0 < BATCH * 4 * NCH; it0 += 3 * nblk * NWAVES) vf_items(p, lds + wave * 16384, it0, nblk * NWAVES, lane);
}
constexpr int GLA_EARLY = 1280;
__device__ __forceinline__ void gla_cstab(const P& p, LASP float* cstab, int tid) {
    const f32x2_t v = *(const f32x2_t*)(p.cst + tid * 2);
    cstab[tid * 2] = v.x; cstab[tid * 2 + 1] = v.y;
}
__device__ void ph_prep(const P& p, LASP unsigned char* lds, int l, int bid, int nblk) {
    const int tid = mk_tid();
    LASP float* cstab = (LASP float*)(lds + 131072);
    gla_cstab(p, cstab, tid);
    __syncthreads();
    ph_gdnprep(p, lds, l, bid, nblk, tid);
    const int tid2 = mk_tid();
    const int lane = tid2 & 63, wave = tid2 >> 6;
    const int it = (bid - 32) * NWAVES + wave;
    if (it >= 0 && it < GLA_EARLY) { GlaRaw g; gla_prep_load(p, g, it, lane); gla_prep_item(p, lds + wave * 16384, cstab, l, it, lane, g); }
}
__device__ void ph_glaprep(const P& p, LASP unsigned char* lds, int l, int sb, int ns) {
    const int tid = mk_tid();
    LASP float* cstab = (LASP float*)(lds + 131072);
    gla_cstab(p, cstab, tid);
    __syncthreads();
    const int lane = tid & 63, wave = tid >> 6;
    const int NIT = BATCH * 4 * NCH, st = ns * NWAVES;
    for (int it = GLA_EARLY + sb * NWAVES + wave; it < NIT; it += 2 * st) {
        GlaRaw g0, g1;
        gla_prep_load(p, g0, it, lane);
        const bool two = it + st < NIT;
        if (two) gla_prep_load(p, g1, it + st, lane);
        gla_prep_item(p, lds + wave * 16384, cstab, l, it, lane, g0);
        if (two) gla_prep_item(p, lds + wave * 16384, cstab, l, it + st, lane, g1);
    }
}

constexpr int NGDN_BLOCKS = BATCH * 4 * 2;
__device__ void ph_mix(const P& p, LASP unsigned char* lds, int l, int bid, int nblk) {
    constexpr int NGDN = NGDN_BLOCKS;
    constexpr int NGLA = BATCH * 4;
    if (bid < NGDN) { gdn_scan_fast(p, lds, bid); return; }
    if (bid < NGDN + NGLA) { gla_scan_fast(p, lds, bid - NGDN); return; }
    const int tid = mk_tid();
    const int lane = tid & 63, wave = tid >> 6;
    LASP float* rpbL = (LASP float*)lds;
    for (int i = tid; i < 4 * 15 * 31; i += NTHREADS) rpbL[i] = p.rpb[(size_t)l * 4 * 15 * 31 + i] * 1.4426950408889634f;
    __syncthreads();
    const int total = 4096 + (l == 0 ? 256 : 0);
    const int nb = bid - NGDN - NGLA;
    const int nna = nblk - NGDN - NGLA, vb = nna == 160 ? (nb & 7) * 20 + (nb >> 3) : nb;
    for (int it = vb * NWAVES + wave; it < total; it += nna * NWAVES) na_item(p, rpbL, it, lane);
}

__device__ void ph_gate(const P& p, int l, int bid, int nblk) {
    const int tid = mk_tid();
    const int tq = tid & 127, rsub = tid >> 7;
    const int kind = tq < 64 ? 0 : (tq < 96 ? 1 : 2);
    const int cb = kind == 0 ? tq * 8 : (kind == 1 ? (tq - 64) * 8 : (tq - 96) * 8);
    const int zoff = kind == 0 ? RC_AZ + cb : (kind == 1 ? RC_BZ + cb : RC_CZ + cb);
    const int oc = kind == 0 ? cb : (kind == 1 ? 512 + cb : 768 + cb);
    float nw[8];
#pragma unroll
    for (int e = 0; e < 8; ++e) nw[e] = kind == 0 ? p.gdn_norm[l * 128 + ((cb + e) & 127)] : (kind == 2 ? p.gla_norm[l * 64 + ((cb + e) & 63)] : 1.f);
    const bool lat = l == 1;
    const int ngrp = lat ? BATCH * SEQ / 16 : ROWS / 16, nfull = ngrp / nblk, nrem = ngrp - nfull * nblk;
    const bool halves = 2 * nrem == nblk;
    for (int k = 0; k < nfull + 1; ++k) {
        int g = k * nblk + bid, nj = 4, sub = 0;
        if (k == nfull) {
            if (halves) { g = nfull * nblk + (bid >> 1); sub = 8 * (bid & 1); nj = 2; }
            else if (bid >= nrem) break;
        }
        const int r0 = (lat ? (g / (SEQ / 16)) * (TOK / 16) + CTX / 16 + g % (SEQ / 16) : g) * 16 + sub;
        uint4 a[4], bb[4], zz[4];
#pragma unroll
        for (int j = 0; j < 4; ++j) if (j < nj) {
            const size_t r = (size_t)(r0 + rsub + 4 * j);
            const bf16* pr = p.rest + r * NREST;
            zz[j] = *(const uint4*)(pr + zoff);
            if (kind == 0) { a[j] = *(const uint4*)(p.oa + r * 512 + cb); bb[j] = *(const uint4*)(p.oa + ((size_t)ROWS + r) * 512 + cb); }
            else if (kind == 1) { a[j] = *(const uint4*)(pr + RC_BQ + cb); bb[j] = make_uint4(0, 0, 0, 0); }
            else { a[j] = *(const uint4*)(p.oc + r * 256 + cb); bb[j] = *(const uint4*)(p.oc + ((size_t)ROWS + r) * 256 + cb); }
        }
#pragma unroll
        for (int j = 0; j < 4; ++j) if (j < nj) {
            float fa[8], fb[8], z[8], o[8];
            unpack8(a[j], fa); unpack8(bb[j], fb); unpack8(zz[j], z);
            float ss = 0.f;
#pragma unroll
            for (int e = 0; e < 8; ++e) { o[e] = fa[e] + fb[e]; ss += o[e] * o[e]; }
            float rs = 1.f;
            if (kind == 0) {
#pragma unroll
                for (int m = 8; m > 0; m >>= 1) ss += __shfl_xor(ss, m);
                rs = __builtin_amdgcn_rsqf(ss * (1.f / 128.f) + 1e-6f);
            } else if (kind == 2) {
#pragma unroll
                for (int m = 4; m > 0; m >>= 1) ss += __shfl_xor(ss, m);
                rs = __builtin_amdgcn_rsqf(ss * (1.f / 64.f) + 1e-6f);
            }
            float res[8];
#pragma unroll
            for (int e = 0; e < 8; ++e) res[e] = o[e] * rs * nw[e] * silu_f(z[e]);
            uint4 w; w.x = pk2(res[0], res[1]); w.y = pk2(res[2], res[3]); w.z = pk2(res[4], res[5]); w.w = pk2(res[6], res[7]);
            *(uint4*)(p.mix + (size_t)(r0 + rsub + 4 * j) * D + oc) = w;
        }
    }
}

#if PROBE
__device__ void gdn_scan_naive(const P& p, LASP float* sm, int l, int b, int hp, bf16* nb) {
    const int tid = mk_tid();
    LASP float* skq = sm;
    LASP float* sv = sm + 4 * 16 * 256;
    LASP float* sg = sv + 4 * 16 * 128;
    LASP float* sb = sg + 64;
    const int sub = tid >> 7, col = tid & 127, dir = sub & 1, h = hp * 2 + (sub >> 1);
    float S[128];
#pragma unroll
    for (int i = 0; i < 128; ++i) S[i] = 0.f;
    for (int s0 = 0; s0 < TOK; s0 += 16) {
        __syncthreads();
        for (int i = tid; i < 4 * 16 * 48; i += NTHREADS) {
            const int su = i / (16 * 48), rem = i % (16 * 48), j = rem / 48, chunk = rem % 48;
            const int sd = su & 1, hh = hp * 2 + (su >> 1);
            const int t = tok_of(sd, s0 + j);
            const size_t row = (size_t)b * TOK + t;
            const int part = chunk >> 4, c8 = chunk & 15;
            const uint4 w = *(const uint4*)(p.qkvn + row * NRAW + part * 512 + hh * 128 + c8 * 8);
            float f[8]; unpack8(w, f);
            LASP float* dst = (part < 2) ? skq + (su * 16 + j) * 256 + part * 128 + c8 * 8 : sv + (su * 16 + j) * 128 + c8 * 8;
#pragma unroll
            for (int e = 0; e < 8; ++e) dst[e] = f[e];
        }
        if (tid < 64) {
            const int su = tid >> 4, j = tid & 15, sd = su & 1, hh = hp * 2 + (su >> 1);
            const int t = tok_of(sd, s0 + j);
            const bf16* ab = p.rest + ((size_t)b * TOK + t) * NREST + RC_AB;
            const float a = bf2f(ab[sd * 4 + hh]) + p.dt_bias[(l * 2 + sd) * 4 + hh];
            const float sp = fmaxf(a, 0.f) + log1pf(expf(-fabsf(a)));
            const float g = -expf(p.a_log[(l * 2 + sd) * 4 + hh]) * sp;
            sg[su * 16 + j] = expf(g);
            const float bx = bf2f(ab[(2 + sd) * 4 + hh]);
            sb[su * 16 + j] = 1.f / (1.f + expf(-bx));
        }
        __syncthreads();
#pragma unroll 1
        for (int j = 0; j < 16; ++j) {
            const LASP float* qp = skq + (sub * 16 + j) * 256;
            const LASP float* kp = qp + 128;
            const float dec = sg[sub * 16 + j], bt = sb[sub * 16 + j];
            const float v = sv[(sub * 16 + j) * 128 + col];
            float d0 = 0.f, d1 = 0.f, d2 = 0.f, d3 = 0.f;
#pragma unroll
            for (int k4 = 0; k4 < 32; ++k4) {
                const f32x4_t kv = *(const LASP f32x4_t*)(kp + k4 * 4);
                d0 += S[k4 * 4] * kv.x; d1 += S[k4 * 4 + 1] * kv.y; d2 += S[k4 * 4 + 2] * kv.z; d3 += S[k4 * 4 + 3] * kv.w;
                if ((k4 & 7) == 7) __builtin_amdgcn_sched_barrier(0);
            }
            const float dot = (d0 + d1) + (d2 + d3);
            const float vn = bt * (v - dec * dot);
            float o0 = 0.f, o1 = 0.f, o2 = 0.f, o3 = 0.f;
#pragma unroll
            for (int k4 = 0; k4 < 32; ++k4) {
                const f32x4_t kv = *(const LASP f32x4_t*)(kp + k4 * 4);
                const f32x4_t qv = *(const LASP f32x4_t*)(qp + k4 * 4);
                S[k4 * 4] = dec * S[k4 * 4] + kv.x * vn; o0 += S[k4 * 4] * qv.x;
                S[k4 * 4 + 1] = dec * S[k4 * 4 + 1] + kv.y * vn; o1 += S[k4 * 4 + 1] * qv.y;
                S[k4 * 4 + 2] = dec * S[k4 * 4 + 2] + kv.z * vn; o2 += S[k4 * 4 + 2] * qv.z;
                S[k4 * 4 + 3] = dec * S[k4 * 4 + 3] + kv.w * vn; o3 += S[k4 * 4 + 3] * qv.w;
                if ((k4 & 3) == 3) __builtin_amdgcn_sched_barrier(0);
            }
            const int t = tok_of(dir, s0 + j);
            nb[((size_t)dir * TOK + t) * 256 + (h & 1) * 128 + col] = f2bf((o0 + o1) + (o2 + o3));
        }
    }
    __syncthreads();
}

__device__ void gla_scan_naive(const P& p, LASP float* sm, int l, int b, bf16* nb) {
    const int tid = mk_tid();
    LASP float* sq = sm;
    LASP float* sv = sm + 8 * 16 * 96;
    const int grp = tid >> 6, lane = tid & 63, h = grp >> 1, dir = grp & 1;
    const int d = lane & 31, par = lane >> 5;
    float w2c[16];
#pragma unroll
    for (int j = 0; j < 16; ++j) w2c[j] = p.gla_w2[((size_t)(l * 2 + dir) * 16 + j) * 128 + h * 32 + d];
    const float b2v = p.gla_b2[(l * 2 + dir) * 128 + h * 32 + d];
    const int dd = d & 15, f = dd & 7;
    const float inv = powf(10000.f, -(float)f / 8.f);
    const int pd = dd < 8 ? d + 8 : d - 8;
    float S[32];
#pragma unroll
    for (int i = 0; i < 32; ++i) S[i] = 0.f;
    for (int s0 = 0; s0 < TOK; s0 += 16) {
        __syncthreads();
#pragma unroll 1
        for (int jj = 0; jj < 8; ++jj) {
            const int j = par + 2 * jj;
            const int t = tok_of(dir, s0 + j);
            const bf16* base = p.rest + ((size_t)b * TOK + t) * NREST;
            float qv = bf2f(base[RC_CQ + h * 32 + d]), kv = bf2f(base[RC_CK + h * 32 + d]);
            if (t >= CTX) {
                const int pidx = t - CTX;
                const int pos = d < 16 ? (pidx >> 6) : (pidx & 63);
                const float ang = (float)pos * inv;
                const float cs = cosf(ang), sn = sinf(ang);
                const float qp = bf2f(base[RC_CQ + h * 32 + pd]), kp = bf2f(base[RC_CK + h * 32 + pd]);
                if (dd < 8) { qv = qv * cs - qp * sn; kv = kv * cs - kp * sn; }
                else { qv = qp * sn + qv * cs; kv = kp * sn + kv * cs; }
            }
            qv *= 0.17677669529663687f;
            float xg = b2v;
#pragma unroll
            for (int jr = 0; jr < 16; ++jr) xg += bf2f(base[RC_CR + dir * 16 + jr]) * w2c[jr];
            const float ls = fminf(xg, 0.f) - log1pf(expf(-fabsf(xg)));
            LASP float* dst = sq + (grp * 16 + j) * 96;
            dst[d] = qv; dst[32 + d] = kv; dst[64 + d] = expf(ls * (1.f / 16.f));
        }
        for (int i = lane; i < 16 * 64; i += 64) {
            const int j = i >> 6, c = i & 63;
            const int t = tok_of(dir, s0 + j);
            sv[(grp * 16 + j) * 64 + c] = bf2f(p.rest[((size_t)b * TOK + t) * NREST + RC_CV + h * 64 + c]);
        }
        __syncthreads();
#pragma unroll 1
        for (int j = 0; j < 16; ++j) {
            const LASP float* qp = sq + (grp * 16 + j) * 96;
            const LASP float* kp = qp + 32;
            const LASP float* dp = qp + 64;
            const float v = sv[(grp * 16 + j) * 64 + lane];
            float o0 = 0.f, o1 = 0.f;
#pragma unroll
            for (int e = 0; e < 32; e += 2) {
                S[e] = dp[e] * S[e] + kp[e] * v; o0 += S[e] * qp[e];
                S[e + 1] = dp[e + 1] * S[e + 1] + kp[e + 1] * v; o1 += S[e + 1] * qp[e + 1];
            }
            const int t = tok_of(dir, s0 + j);
            nb[((size_t)dir * TOK + t) * 256 + h * 64 + lane] = f2bf(o0 + o1);
        }
    }
    __syncthreads();
}

__device__ void na_query_naive(const P& p, LASP float* sm, int l, int b, int t0, bf16* nb) {
    const int tid = mk_tid();
    const int wave = tid >> 6, lane = tid & 63, h = wave & 3, t = t0 + (wave >> 2);
    LASP float* pw = sm + wave * 384;
    const size_t rowq = (size_t)b * TOK + t;
    float qv[64];
    {
        const bf16* qs = p.rest + rowq * NREST + RC_BQ + h * 64;
#pragma unroll
        for (int i = 0; i < 8; ++i) {
            float f[8]; unpack8(*(const uint4*)(qs + i * 8), f);
#pragma unroll
            for (int e = 0; e < 8; ++e) qv[i * 8 + e] = f[e] * 0.125f;
        }
    }
    const bool lat = t >= CTX;
    const int nk = lat ? 384 : 256;
    int r = 0, c = 0, r0 = 0, c0 = 0;
    if (lat) { int pi = t - CTX; r = pi >> 6; c = pi & 63; r0 = min(max(r - 4, 0), 56); c0 = min(max(c - 8, 0), 48); }
    float m = -1e30f;
    __syncthreads();
#pragma unroll 1
    for (int j = 0; j < 6; ++j) {
        const int idx = lane + 64 * j;
        float s = -1e30f;
        if (idx < nk) {
            int tk; float bias = 0.f;
            if (lat && idx < 128) {
                const int i = idx >> 4, kc = c0 + (idx & 15);
                tk = CTX + (r0 + i) * 64 + kc;
                bias = p.rpb[((size_t)(l * 4 + h) * 15 + (r0 + i - r + 7)) * 31 + (kc - c + 15)];
            } else tk = lat ? idx - 128 : idx;
            const bf16* ks = p.kf + (((size_t)(b * 4 + h) * NCH + (tk >> 5)) * 4 * 64 + (tk & 31)) * 8;
            float d0 = 0.f, d1 = 0.f;
#pragma unroll
            for (int i = 0; i < 8; ++i) {
                float f[8]; unpack8(*(const uint4*)(ks + ((i >> 1) * 64 + (i & 1) * 32) * 8), f);
#pragma unroll
                for (int e = 0; e < 8; e += 2) { d0 += qv[i * 8 + e] * f[e]; d1 += qv[i * 8 + e + 1] * f[e + 1]; }
            }
            s = d0 + d1 + bias;
        }
        pw[idx] = s;
        m = fmaxf(m, s);
    }
    m = wave_max(m);
    float sum = 0.f;
#pragma unroll 1
    for (int j = 0; j < 6; ++j) { const float e = expf(pw[lane + 64 * j] - m); pw[lane + 64 * j] = e; sum += e; }
    sum = wave_sum(sum);
    const float inv = 1.f / sum;
    __syncthreads();
    float o0 = 0.f, o1 = 0.f;
    for (int idx = 0; idx < nk; idx += 2) {
        int tk0;
        if (lat && idx < 128) tk0 = CTX + (r0 + (idx >> 4)) * 64 + c0 + (idx & 15);
        else tk0 = lat ? idx - 128 : idx;
        o0 += pw[idx] * bf2f(p.rest[((size_t)b * TOK + tk0) * NREST + RC_BV + h * 64 + lane]);
        o1 += pw[idx + 1] * bf2f(p.rest[((size_t)b * TOK + tk0 + 1) * NREST + RC_BV + h * 64 + lane]);
    }
    nb[(size_t)t * 256 + h * 64 + lane] = f2bf((o0 + o1) * inv);
}


__device__ void ph_probe_naive(const P& p, LASP float* sm, int l, int bid, int nblk) {
    bf16* nb = (bf16*)p.xc1;
    if (PROBE == 1) { if (bid == 0) gdn_scan_naive(p, sm, l, 0, 0, nb); }
    else if (PROBE == 3) { if (bid == 0) gla_scan_naive(p, sm, l, 0, nb); }
    else { for (int it = bid; it < TOK / 2; it += nblk) na_query_naive(p, sm, l, 0, it * 2, nb); }
}
__device__ void ph_probe_cmp(const P& p, int bid, int nblk) {
    const int tid = mk_tid();
    const bf16* nb = (const bf16*)p.xc1;
    float md = 0.f, mr = 0.f;
    const int n = (PROBE == 2) ? TOK * 256 : 2 * TOK * 256;
    for (int i = bid * NTHREADS + tid; i < n; i += nblk * NTHREADS) {
        float a, r = bf2f(nb[i]);
        if (PROBE == 1) { const int dir = i / (TOK * 256), rem = i % (TOK * 256), t = rem >> 8, c = rem & 255; a = bf2f(p.oa[((size_t)dir * ROWS + t) * 512 + c]); }
        else if (PROBE == 3) { const int dir = i / (TOK * 256), rem = i % (TOK * 256); a = bf2f(p.oc[(size_t)dir * ROWS * 256 + rem]); }
        else { const int t = i >> 8, c = i & 255; a = bf2f(p.rest[(size_t)t * NREST + RC_BQ + c]); }
        md = fmaxf(md, fabsf(a - r)); mr = fmaxf(mr, fabsf(r));
    }
    md = wave_max(md); mr = wave_max(mr);
    if ((tid & 63) == 0) { atomicMax((unsigned*)p.stats, __float_as_uint(md)); atomicMax((unsigned*)p.stats + 1, __float_as_uint(mr)); }
}
#endif

#define XB_TMO      128
#define XB_XCNT(j)  (256  + 64 * (j))
#define XB_XSUB(j)  (1280 + 64 * (j))
#define XB_XGEN(j)  (2304 + 64 * (j))
#define XB_TOP      3328
#define XB_TOPGEN   3392
#define XCD_BAR_WORDS 3456
#define XB_SPIN_CAP (1u << 18)

__device__ __forceinline__ unsigned xb_ld(unsigned* p)              { return __hip_atomic_load(p, __ATOMIC_RELAXED, __HIP_MEMORY_SCOPE_AGENT); }
__device__ __forceinline__ unsigned xb_add(unsigned* p, unsigned v) { return __hip_atomic_fetch_add(p, v, __ATOMIC_RELAXED, __HIP_MEMORY_SCOPE_AGENT); }
__device__ __forceinline__ unsigned xb_xcc_id() { return (unsigned)__builtin_amdgcn_s_getreg((3 << 11) | 20) & 0xFu; }
#define XB_SPIN(cond, bar) do { unsigned _sp = 0; while (cond) { __builtin_amdgcn_s_sleep(1); \
    if ((++_sp & 255u) == 0u) { if (xb_ld(&(bar)[XB_TMO])) break; if (_sp > XB_SPIN_CAP) { atomicAdd(&(bar)[XB_TMO], 1u); break; } } } } while (0)

struct XcdBarrier {
    unsigned* bar; unsigned x; unsigned G;
    volatile LASP unsigned* st;
};

__device__ __forceinline__ XcdBarrier xcd_barrier_post(unsigned* bar, volatile LASP unsigned* st) {
    XcdBarrier b; b.bar = bar; b.x = xb_xcc_id(); b.st = st; b.G = gridDim.x;
    if ((int)threadIdx.x == 0) (void)xb_add(&bar[XB_XCNT(b.x)], 1u);
    return b;
}
__device__ __forceinline__ void xcd_barrier_complete(unsigned* bar, unsigned x, unsigned& nloc, unsigned& nx, unsigned G) {
    unsigned sum, cnt, mine, sp = 0u;
    for (;;) {
        sum = 0u; cnt = 0u; mine = 0u;
#pragma unroll
        for (unsigned j = 0; j < 16; ++j) { const unsigned c = xb_ld(&bar[XB_XCNT(j)]); sum += c; cnt += (c > 0u) ? 1u : 0u; mine = (j == x) ? c : mine; }
        if (sum == G) break;
        __builtin_amdgcn_s_sleep(1);
        if ((++sp & 255u) == 0u) { if (xb_ld(&bar[XB_TMO])) break; if (sp > XB_SPIN_CAP) { atomicAdd(&bar[XB_TMO], 1u); break; } }
    }
    nloc = mine > 0u ? mine : 1u; nx = cnt > 0u ? cnt : 1u;
}

__device__ __forceinline__ void xcd_barrier(const XcdBarrier& b) {
    asm volatile("s_waitcnt vmcnt(0)" ::: "memory");
    __syncthreads();
    if ((int)threadIdx.x == 0) {
        unsigned* bar = b.bar;
        __builtin_amdgcn_s_waitcnt(0);
        unsigned nloc = b.st[0], nx = b.st[1];
        if (nloc == 0u) { xcd_barrier_complete(bar, b.x, nloc, nx, b.G); b.st[0] = nloc; b.st[1] = nx; }
        const unsigned old = xb_add(&bar[XB_XSUB(b.x)], 1u);
        const unsigned gen = old / nloc;
        if (old + 1u == (gen + 1u) * nloc) {
            __builtin_amdgcn_fence(__ATOMIC_RELEASE, "agent");
            asm volatile("s_waitcnt vmcnt(0)" ::: "memory");
            const unsigned og = xb_add(&bar[XB_TOP], 1u);
            const unsigned tg = og / nx;
            if (og + 1u == (tg + 1u) * nx) xb_add(&bar[XB_TOPGEN], 1u);
            else XB_SPIN(xb_ld(&bar[XB_TOPGEN]) == tg, bar);
            __builtin_amdgcn_fence(__ATOMIC_ACQUIRE, "agent");
            xb_add(&bar[XB_XGEN(b.x)], 1u);
            asm volatile("s_waitcnt vmcnt(0)" ::: "memory");
        } else {
            XB_SPIN(xb_ld(&bar[XB_XGEN(b.x)]) == gen, bar);
            __builtin_amdgcn_fence(__ATOMIC_ACQUIRE, "agent");
            asm volatile("s_waitcnt vmcnt(0)" ::: "memory");
        }
    }
    __syncthreads();
}


constexpr int NSTEP = 1 + 2 * 7 + 1;
__global__ void __launch_bounds__(NTHREADS, 2) k_mega(P p) {
    extern __shared__ __attribute__((aligned(16))) unsigned char lds_raw[];
    LASP unsigned char* lds = (LASP unsigned char*)lds_raw;
    const int bid = blockIdx.x, nblk = gridDim.x;
    volatile LASP unsigned* bst = (volatile LASP unsigned*)(lds + LDS_BYTES - 64);
    if (threadIdx.x < 16) bst[threadIdx.x] = 0u;
    __syncthreads();
    { const XcdBarrier b0 = xcd_barrier_post((unsigned*)p.ctl, bst); if (threadIdx.x == 0) { bst[2] = b0.x; if (bid >= NGDN_BLOCKS) (void)xb_add(&((unsigned*)p.ctl)[4096 + XB_XCNT(b0.x)], 1u); } }
    __syncthreads();
    ph_prologue(p, lds, bid, nblk);
    { XcdBarrier bar; bar.bar = (unsigned*)p.ctl; bar.x = (unsigned)__builtin_amdgcn_readfirstlane((int)bst[2]); bar.st = bst; bar.G = (unsigned)nblk; xcd_barrier(bar); }
    const int bid_k = bid, nblk_k = nblk;
#pragma unroll 1
    for (int step = 1; step < NSTEP; ++step) {
        int ph = 0, l = 0;
        { const int s1 = step - 1; l = s1 / 7; ph = 1 + s1 % 7; }
        int bid = bid_k, nblk = nblk_k; asm volatile("" : "+s"(bid), "+s"(nblk));
#if TPROBE >= 0
        if (bid == 0 && threadIdx.x == 0) { if (step == 1) p.stats[2] = 0.f; const unsigned long long t_ = __builtin_amdgcn_s_memrealtime(); bst[4] = (unsigned)t_; bst[5] = (unsigned)(t_ >> 32); }
#endif
        if (ph == 1) { if (l == 0) ph_transposes(p, lds, bid, nblk); ph_lnpass(p, l, bid, nblk); }
        else if (l < 2) {
            if (ph == 2) {
                pg8::Gemm g{p.ml, p.wi_t + (size_t)l * NPAD * D, ROWS, NPAD, D}; pg8::StaticOrder S; S.init(ROWS, NPAD, nblk, bid);
                EpiProj E{p.raw, p.rest, p.kf};
                pg8::gemm_phase<EpiProj, pg8::StaticOrder, true, true>(lds, g, S, E);
            } else if (ph == 3) { ph_prep_early(p, lds, l, bid, nblk); ph_conv(p, l, bid, nblk); }
            else if (ph == 4) ph_prep(p, lds, l, bid, nblk);
            else if (ph == 5) {
#if PROBE
                if (l == 0) { ph_probe_naive(p, (LASP float*)lds, l, bid, nblk); XcdBarrier bar; bar.bar = (unsigned*)p.ctl; bar.x = (unsigned)__builtin_amdgcn_readfirstlane((int)bst[2]); bar.st = bst; bar.G = (unsigned)nblk; xcd_barrier(bar); }
#endif
#if TPROBE >= 50
                const bool inrole = TPROBE == 50 ? (bid < 64) : (TPROBE == 51 ? (bid >= 64 && bid < 96) : (bid >= 96));
                const float rscale = TPROBE == 50 ? (1.f / 64.f) : (TPROBE == 51 ? (1.f / 32.f) : (1.f / 160.f));
                if (inrole && threadIdx.x == 0) { const unsigned long long t_ = __builtin_amdgcn_s_memrealtime(); bst[6] = (unsigned)t_; bst[7] = (unsigned)(t_ >> 32); }
#endif
                if (bid >= NGDN_BLOCKS) {
                    ph_glaprep(p, lds, l, bid - NGDN_BLOCKS, nblk - NGDN_BLOCKS);
                    XcdBarrier bar; bar.bar = (unsigned*)p.ctl + 4096; bar.x = (unsigned)__builtin_amdgcn_readfirstlane((int)bst[2]); bar.st = bst + 8; bar.G = (unsigned)(nblk - NGDN_BLOCKS); xcd_barrier(bar);
                }
                ph_mix(p, lds, l, bid, nblk);
#if TPROBE >= 50
                if (inrole && threadIdx.x == 0) { const unsigned long long tr0 = (unsigned long long)bst[6] | ((unsigned long long)bst[7] << 32); atomicAdd(&p.stats[2], (float)(__builtin_amdgcn_s_memrealtime() - tr0) * 0.01f * rscale); }
#endif
#if PROBE
                if (l == 0) { XcdBarrier bar; bar.bar = (unsigned*)p.ctl; bar.x = (unsigned)__builtin_amdgcn_readfirstlane((int)bst[2]); bar.st = bst; bar.G = (unsigned)nblk; xcd_barrier(bar); ph_probe_cmp(p, bid, nblk); }
#endif
            }
            else if (ph == 6) ph_gate(p, l, bid, nblk);
            else if (ph == 7) {
                pg8::Gemm g{p.mix, p.wo_t + (size_t)l * D * D, ROWS, D, D};
                EpiY E{p.ml};
                { LatentOrder S; S.S.init(BATCH * SEQ, D, nblk, bid); pg8::gemm_phase<EpiY, LatentOrder, true, true>(lds, g, S, E); }
                if (l == 0) {
                    const int j = bid, kq = j & 3, pn = (j >> 2) & 3, cb = j >> 4;
                    pg8::Gemm gq{p.mix + kq * 256, p.wo_t + kq * 256, ROWS, D, 256, D};
                    OneUnit S1{17 * cb, pn, j < 128};
                    EpiYc E1{p.oc + (size_t)kq * YC_STRIDE};
                    pg8::gemm_phase<EpiYc, OneUnit, true, true>(lds, gq, S1, E1);
                }
            }
        }
        { XcdBarrier bar; bar.bar = (unsigned*)p.ctl; bar.x = (unsigned)__builtin_amdgcn_readfirstlane((int)bst[2]); bar.st = bst; bar.G = (unsigned)nblk; xcd_barrier(bar); }
#if TPROBE >= 0
        if (bid == 0 && threadIdx.x == 0 && ph == TPROBE) { const unsigned long long tp0 = (unsigned long long)bst[4] | ((unsigned long long)bst[5] << 32); p.stats[2] += (float)(__builtin_amdgcn_s_memrealtime() - tp0) * 0.01f; }
#endif
    }
}

extern "C" void kernel_launch(void* const* d_in, const int* in_sizes, int n_in, void* d_out, int out_size, void* d_ws, size_t ws_size,
                              hipStream_t stream) {
    P p{};
    p.x = (const float*)d_in[0]; p.c = (const float*)d_in[1]; p.ctx = (const float*)d_in[2]; p.c_ctx = (const float*)d_in[3];
    p.w_mod = (const float*)d_in[4]; p.b_mod = (const float*)d_in[5]; p.w_in = (const float*)d_in[6]; p.conv_w = (const float*)d_in[7];
    p.a_log = (const float*)d_in[8]; p.dt_bias = (const float*)d_in[9]; p.gdn_norm = (const float*)d_in[10]; p.rpb = (const float*)d_in[11];
    p.gla_w2 = (const float*)d_in[12]; p.gla_b2 = (const float*)d_in[13]; p.gla_norm = (const float*)d_in[14]; p.w_out = (const float*)d_in[15];
    p.ln_g = (const float*)d_in[16]; p.ln_b = (const float*)d_in[17];
    p.out = (float*)d_out;
    unsigned char* w = (unsigned char*)d_ws;
    size_t off = 0;
    auto take = [&](size_t bytes) { unsigned char* r = w + off; off += (bytes + 255) & ~(size_t)255; return r; };
    p.ctl = (unsigned*)take(32768);
    p.mods = (float*)take((size_t)2 * 9 * 3072 * 4);
    p.xc1 = (float*)take((size_t)BATCH * CTX * D * 4);
    p.wi_t = (bf16*)take((size_t)2 * NPAD * D * 2);
    p.wo_t = (bf16*)take((size_t)2 * D * D * 2);
    p.rest = (bf16*)take((size_t)ROWS * NREST * 2);
    p.raw = (bf16*)take((size_t)ROWS * NRAW * 2);
    p.qkvn = (bf16*)take((size_t)ROWS * NRAW * 2);
    p.mix = p.qkvn;
    p.oa = (bf16*)take((size_t)2 * ROWS * 512 * 2);
    p.oc = (bf16*)take((size_t)2 * ROWS * 256 * 2);
    p.ml = p.oa;
    p.vf = (bf16*)take((size_t)ROWS * 256 * 2);
    p.kf = (bf16*)take((size_t)ROWS * 256 * 2);
    p.stats = (float*)take(256);
    p.cst = (float*)take(4096);
    static int grid_blocks = 0;
    if (!grid_blocks) {
        if (off > ws_size) { fprintf(stderr, "workspace too small: need %zu have %zu\n", off, ws_size); grid_blocks = -1; return; }
        int dev = 0, cus = 0, per_cu = 0;
        hipGetDevice(&dev);
        hipDeviceGetAttribute(&cus, hipDeviceAttributeMultiprocessorCount, dev);
        if (hipFuncSetAttribute((const void*)k_mega, hipFuncAttributeMaxDynamicSharedMemorySize, LDS_BYTES) != hipSuccess) { fprintf(stderr, "hipFuncSetAttribute failed\n"); grid_blocks = -1; return; }
        hipOccupancyMaxActiveBlocksPerMultiprocessor(&per_cu, (const void*)k_mega, NTHREADS, LDS_BYTES);
        if (per_cu < 1) { fprintf(stderr, "occupancy query says %d blocks per CU\n", per_cu); grid_blocks = -1; return; }
        grid_blocks = cus;
    }
    if (grid_blocks < 0) return;
    if (hipMemsetAsync(p.ctl, 0, 32768, stream) != hipSuccess) { fprintf(stderr, "memset of the barrier words failed\n"); return; }
    void* args[] = {&p};
    hipError_t e = hipLaunchCooperativeKernel((void*)k_mega, dim3(grid_blocks), dim3(NTHREADS), args, LDS_BYTES, stream);
    if (e != hipSuccess) fprintf(stderr, "cooperative launch failed: %s (grid %d)\n", hipGetErrorString(e), grid_blocks);
}
```

```cpp
#include <hip/hip_runtime.h>
#include <hip/hip_cooperative_groups.h>
#include <cstdio>
#include <cstdint>
namespace cg = cooperative_groups;
#ifndef PROBE
#define PROBE 0
#endif
#ifndef TPROBE
#define TPROBE -1
#endif
#ifndef TSHIFT
#define TSHIFT 0
#endif

constexpr int D = 1024, BATCH = 8, SEQ = 4096, CTX = 256, TOK = 4352, NPROJ = 3888;
constexpr int ROWS = BATCH * TOK;
constexpr int NRAW = 1536, NREST = 2112, NPAD = 4096;
constexpr int NTHREADS = 512, NWAVES = 8;
constexpr int LDS_BYTES = 147456;
constexpr float ALPHA = 1.4142135623730951f;
constexpr int RC_AZ = 0, RC_BQ = 512, RC_BV = 768, RC_BZ = 1024, RC_CQ = 1280, RC_CK = 1408, RC_CV = 1536, RC_CR = 1792, RC_CZ = 1824, RC_AB = 2080;
constexpr int PC_BK = 2304, PC_BV = 2560;
__host__ __device__ constexpr int gemm_col(int c) { return c < 1536 ? c : (c < 1552 ? c + 2336 : (c < 3888 ? c - 16 : c)); }

typedef unsigned short bf16;
typedef float f32x4_t __attribute__((ext_vector_type(4)));

struct P {
    const float *x, *c, *ctx, *c_ctx, *w_mod, *b_mod, *w_in, *conv_w, *a_log, *dt_bias, *gdn_norm, *rpb,
        *gla_w2, *gla_b2, *gla_norm, *w_out, *ln_g, *ln_b;
    float* out;
    float *mods, *xc1, *stats, *cst; unsigned* ctl;
    bf16 *wi_t, *wo_t, *rest, *raw, *qkvn, *mix, *ml, *oa, *oc, *vf, *kf;
};

__device__ __forceinline__ float bf2f(unsigned short u) { return __uint_as_float((unsigned)u << 16); }
typedef float f32x2_t __attribute__((ext_vector_type(2)));
typedef __bf16 bf16x2_t __attribute__((ext_vector_type(2)));
__device__ __forceinline__ unsigned cvtpk(float lo, float hi) { f32x2_t v = {lo, hi}; bf16x2_t q = __builtin_convertvector(v, bf16x2_t); return __builtin_bit_cast(unsigned, q); }
__device__ __forceinline__ unsigned short f2bf(float f) { return (unsigned short)cvtpk(f, f); }
__device__ __forceinline__ unsigned pk2(float lo, float hi) { return cvtpk(lo, hi); }
__device__ __forceinline__ float bflo(unsigned w) { return __uint_as_float(w << 16); }
__device__ __forceinline__ float bfhi(unsigned w) { return __uint_as_float(w & 0xffff0000u); }
__device__ __forceinline__ void unpack8(uint4 w, float* f) {
    f[0] = bflo(w.x); f[1] = bfhi(w.x); f[2] = bflo(w.y); f[3] = bfhi(w.y); f[4] = bflo(w.z); f[5] = bfhi(w.z); f[6] = bflo(w.w); f[7] = bfhi(w.w);
}
__device__ __forceinline__ float silu_f(float x) { return x * __builtin_amdgcn_rcpf(1.f + __builtin_amdgcn_exp2f(-1.4426950408889634f * x)); }
__device__ __forceinline__ float wave_sum(float v) {
#pragma unroll
    for (int o = 32; o > 0; o >>= 1) v += __shfl_xor(v, o);
    return v;
}
__device__ __forceinline__ float wave_max(float v) {
#pragma unroll
    for (int o = 32; o > 0; o >>= 1) v = fmaxf(v, __shfl_xor(v, o));
    return v;
}
__device__ __forceinline__ int mk_tid() { int t = threadIdx.x; asm volatile("" : "+v"(t)); return t; }
__device__ __forceinline__ int tok_of(int dir, int s) { return dir == 0 ? s : (s < CTX ? CTX - 1 - s : TOK + CTX - 1 - s); }

namespace pg8 {
#define PG8_LAS __attribute__((address_space(3)))
typedef unsigned short bf16_t;
typedef short bf16x8 __attribute__((ext_vector_type(8)));
typedef float f32x4 __attribute__((ext_vector_type(4)));
typedef unsigned u32x4 __attribute__((ext_vector_type(4)));
constexpr int BM = 256, BK = 64, HALF = 128, HTB = HALF * BK * 2  , STAGE_BYTES = 8 * HTB, NXCD = 8, WGM = 8;

__host__ __device__ __forceinline__ int lds_byte(int r, int c) { const int st = (r >> 4) * 2 + (c >> 5), rr = r & 15, cc = c & 31, ob = rr * 64 + cc * 2; return st * 1024 + (ob ^ (((ob >> 9) & 1) << 5)); }
__host__ __device__ __forceinline__ void stage_rc(int b, int& R, int& C) { const int st = b / 1024, sb = b % 1024, swz = sb ^ (((sb >> 9) & 1) << 5); R = (st >> 1) * 16 + swz / 64; C = (st & 1) * 32 + (swz % 64) / 2; }
__host__ __device__ __forceinline__ int perm32(int rho) { const int n = rho >> 4, i = rho & 15; return 8 * (i >> 2) + 4 * n + (i & 3); }

struct Unit { int pm, pn; };
struct Gemm { const bf16_t* A; const bf16_t* Bt; int M, N, K; int ld = 0; };

struct StaticOrder {
    int nM, nN, nwg, G, c;
    __host__ __device__ void init(int M, int N, int G_, int c_) { nM = M / BM; nN = N / BM; nwg = nM * nN; G = G_; c = c_; }
    __host__ __device__ bool next(int i, Unit& u) const {
        const long L = (long)i * G + c; if (L >= nwg) return false;
        int wgid = (int)L; { const int q = nwg / NXCD, r = nwg % NXCD, xcd = wgid % NXCD, off = wgid / NXCD; wgid = (xcd < r ? xcd * (q + 1) : r * (q + 1) + (xcd - r) * q) + off; }
        const int nig = WGM * nN, gid = wgid / nig, fm = gid * WGM, gsz = (nM - fm) < WGM ? (nM - fm) : WGM;
        u.pm = fm + ((wgid % nig) % gsz); u.pn = (wgid % nig) / gsz; return true;
    }
    __device__ __forceinline__ void a_ready(const Unit&) const {}
    __device__ __forceinline__ void done(const Unit&) const {}
};

__device__ __forceinline__ unsigned cvt_pk_bf16(float lo, float hi) { unsigned r; asm volatile("v_cvt_pk_bf16_f32 %0, %1, %2" : "=v"(r) : "v"(lo), "v"(hi)); return r; }
template <class Epi, class Sched, bool ALIGN_EPI = false, bool SP2 = false>
__device__ __forceinline__ void gemm_phase(PG8_LAS unsigned char* lds, const Gemm g, const Sched& S, const Epi& E) {
    const int tid = mk_tid(), wid = __builtin_amdgcn_readfirstlane(tid >> 6), lane = tid & 63, wr = wid >> 2, wc = wid & 3, fr = lane & 15, fq = lane >> 4;
    const int K = g.ld ? g.ld : g.K, nt = g.K / BK;
    unsigned voffA[2], voffB[2];
#pragma unroll
    for (int i = 0; i < 2; ++i) { int R, C; stage_rc(tid * 16 + i * 8192, R, C); const int Rb = Epi::PERM ? ((R & ~31) + perm32(R & 31)) : R;
        voffA[i] = (unsigned)(R * K + C) * 2u; voffB[i] = (unsigned)(Rb * K + C) * 2u; }
    const size_t kstep = (size_t)(BK * 2);
    const size_t hstep = (size_t)HALF * K * 2;
    const size_t tstep = 2 * hstep;
    const unsigned ldsw = (unsigned)wid * 1024u;
    const int aoff = lds_byte(wr * 64 + fr, fq * 8), boff = lds_byte(wc * 32 + fr, fq * 8);
#define PG8_SA(b, h) (((b) * 2 + (h)) * HTB)
#define PG8_SB(b, h) ((4 + (b) * 2 + (h)) * HTB)
#define PG8_STAGE(bufoff, gbase, voff) do { _Pragma("unroll") for (int _i = 0; _i < 2; ++_i) \
        __builtin_amdgcn_global_load_lds((const unsigned*)((const char*)(gbase) + (voff)[_i]), (PG8_LAS unsigned*)(lds + (bufoff) + ldsw + _i * 8192), 16, 0, 0); } while (0)
#define PG8_LDA(dst, b, h) do { _Pragma("unroll") for (int m = 0; m < 4; ++m) _Pragma("unroll") for (int k = 0; k < 2; ++k) dst[m][k] = *(const PG8_LAS bf16x8*)(lds + PG8_SA(b, h) + aoff + m * 2048 + k * 1024); } while (0)
#define PG8_LDB(dst, b, h) do { _Pragma("unroll") for (int n = 0; n < 2; ++n) _Pragma("unroll") for (int k = 0; k < 2; ++k) dst[n][k] = *(const PG8_LAS bf16x8*)(lds + PG8_SB(b, h) + boff + n * 2048 + k * 1024); } while (0)
#define PG8_MMA(ai, bj, At, Bt) do { __builtin_amdgcn_s_setprio(1); _Pragma("unroll") for (int m = 0; m < 4; ++m) _Pragma("unroll") for (int n = 0; n < 2; ++n) _Pragma("unroll") for (int k = 0; k < 2; ++k) \
        acc[ai][bj][m][n] = __builtin_amdgcn_mfma_f32_16x16x32_bf16(Bt[n][k], At[m][k], acc[ai][bj][m][n], 0, 0, 0); __builtin_amdgcn_s_setprio(0); } while (0)
#define PG8_WAIT_V(n) asm volatile("s_waitcnt vmcnt(" #n ")" ::: "memory")
#define PG8_WAIT_L(n) asm volatile("s_waitcnt lgkmcnt(" #n ")" ::: "memory")
#define PG8_BAR __builtin_amdgcn_s_barrier()
#define PG8_SCHED __builtin_amdgcn_sched_barrier(0)
    Unit cur, nxt; int ui = 0;
    if (!S.next(0, cur)) return;
    f32x4 acc[2][2][4][2];
#pragma unroll
    for (int a = 0; a < 2; ++a)
#pragma unroll
        for (int b = 0; b < 2; ++b)
#pragma unroll
            for (int m = 0; m < 4; ++m)
#pragma unroll
                for (int n = 0; n < 2; ++n) acc[a][b][m][n] = (f32x4){0.f, 0.f, 0.f, 0.f};
    bf16x8 At[4][2], B0[2][2], B1[2][2];
    const char* cA = (const char*)g.A + (size_t)cur.pm * tstep; const char* cB = (const char*)g.Bt + (size_t)cur.pn * tstep;
    S.a_ready(cur);
    if constexpr (SP2) {
        PG8_STAGE(PG8_SB(0, 0), cB, voffB); PG8_STAGE(PG8_SB(0, 1), cB + hstep, voffB); PG8_STAGE(PG8_SA(0, 0), cA, voffA); PG8_STAGE(PG8_SA(0, 1), cA + hstep, voffA);
        if (wr == 1) PG8_BAR;
        PG8_WAIT_V(2); PG8_BAR;
        PG8_STAGE(PG8_SB(1, 0), cB + kstep, voffB); PG8_STAGE(PG8_SA(1, 0), cA + kstep, voffA); PG8_STAGE(PG8_SB(1, 1), cB + hstep + kstep, voffB);
        PG8_WAIT_V(6); PG8_BAR;
    } else {
        PG8_STAGE(PG8_SB(0, 0), cB, voffB); PG8_STAGE(PG8_SA(0, 0), cA, voffA); PG8_STAGE(PG8_SB(0, 1), cB + hstep, voffB); PG8_STAGE(PG8_SA(0, 1), cA + hstep, voffA);
        if (wr == 1) PG8_BAR;
        PG8_WAIT_V(4); PG8_BAR;
        PG8_STAGE(PG8_SB(1, 0), cB + kstep, voffB); PG8_STAGE(PG8_SA(1, 0), cA + kstep, voffA); PG8_STAGE(PG8_SB(1, 1), cB + hstep + kstep, voffB);
        PG8_WAIT_V(6); PG8_BAR;
    }
    for (;;) {
        const bool has_next = S.next(ui + 1, nxt);
        const char* nA = has_next ? (const char*)g.A + (size_t)nxt.pm * tstep : cA; const char* nB = has_next ? (const char*)g.Bt + (size_t)nxt.pn * tstep : cB;
        for (int t = 0; t < nt; t += 2) {
            const bool last = (t == nt - 2);
            const char* a1 = cA + (size_t)(t + 1) * kstep;
            const char* a2 = last ? nA : cA + (size_t)(t + 2) * kstep; const char* b2 = last ? nB : cB + (size_t)(t + 2) * kstep;
            const char* a3 = a2 + kstep; const char* b3 = b2 + kstep;
            if (last && has_next) S.a_ready(nxt);
            if constexpr (SP2) {
            PG8_LDB(B0, 0, 0); PG8_LDB(B1, 0, 1); PG8_SCHED; PG8_LDA(At, 0, 0); PG8_STAGE(PG8_SA(1, 1), a1 + hstep, voffA);
            PG8_WAIT_V(8); PG8_WAIT_L(0); PG8_BAR; PG8_MMA(0, 0, At, B0); PG8_MMA(0, 1, At, B1); PG8_BAR; PG8_SCHED;
            PG8_LDA(At, 0, 1); PG8_STAGE(PG8_SB(0, 0), b2, voffB); PG8_STAGE(PG8_SB(0, 1), b2 + hstep, voffB); PG8_STAGE(PG8_SA(0, 0), a2, voffA);
            PG8_WAIT_V(8); PG8_WAIT_L(0); PG8_BAR; PG8_MMA(1, 0, At, B0); PG8_MMA(1, 1, At, B1); PG8_BAR; PG8_SCHED;
            PG8_LDB(B0, 1, 0); PG8_LDB(B1, 1, 1); PG8_SCHED; PG8_LDA(At, 1, 0); PG8_STAGE(PG8_SA(0, 1), a2 + hstep, voffA);
            PG8_WAIT_V(8); PG8_WAIT_L(0); PG8_BAR; PG8_MMA(0, 0, At, B0); PG8_MMA(0, 1, At, B1); PG8_BAR; PG8_SCHED;
            PG8_LDA(At, 1, 1); PG8_STAGE(PG8_SB(1, 0), b3, voffB); PG8_STAGE(PG8_SB(1, 1), b3 + hstep, voffB); PG8_STAGE(PG8_SA(1, 0), a3, voffA);
            PG8_WAIT_V(8); PG8_WAIT_L(0); PG8_BAR; PG8_MMA(1, 0, At, B0); PG8_MMA(1, 1, At, B1); PG8_BAR; PG8_SCHED;
            } else {
            PG8_LDB(B0, 0, 0); PG8_SCHED; PG8_LDA(At, 0, 0); PG8_STAGE(PG8_SA(1, 1), a1 + hstep, voffA);
            PG8_WAIT_L(8); PG8_BAR; PG8_WAIT_L(0); PG8_MMA(0, 0, At, B0); PG8_BAR; PG8_SCHED;
            PG8_LDB(B1, 0, 1); PG8_STAGE(PG8_SB(0, 0), b2, voffB);
            PG8_BAR; PG8_WAIT_L(0); PG8_MMA(0, 1, At, B1); PG8_BAR;
            PG8_LDA(At, 0, 1); PG8_STAGE(PG8_SA(0, 0), a2, voffA);
            PG8_BAR; PG8_WAIT_L(0); PG8_MMA(1, 0, At, B0); PG8_BAR; PG8_SCHED;
            PG8_STAGE(PG8_SB(0, 1), b2 + hstep, voffB);
            PG8_WAIT_V(6); PG8_BAR; PG8_MMA(1, 1, At, B1); PG8_BAR;
            PG8_LDB(B0, 1, 0); PG8_SCHED; PG8_LDA(At, 1, 0); PG8_STAGE(PG8_SA(0, 1), a2 + hstep, voffA);
            PG8_WAIT_L(8); PG8_BAR; PG8_WAIT_L(0); PG8_MMA(0, 0, At, B0); PG8_BAR; PG8_SCHED;
            PG8_LDB(B1, 1, 1); PG8_STAGE(PG8_SB(1, 0), b3, voffB);
            PG8_BAR; PG8_WAIT_L(0); PG8_MMA(0, 1, At, B1); PG8_BAR;
            PG8_LDA(At, 1, 1); PG8_STAGE(PG8_SA(1, 0), a3, voffA);
            PG8_BAR; PG8_WAIT_L(0); PG8_MMA(1, 0, At, B0); PG8_BAR; PG8_SCHED;
            PG8_STAGE(PG8_SB(1, 1), b3 + hstep, voffB);
            PG8_WAIT_V(6); PG8_BAR; PG8_MMA(1, 1, At, B1); PG8_BAR;
            }
        }
        if constexpr (ALIGN_EPI) { if (wr == 0) PG8_BAR; }
        if constexpr (!Epi::AFTER_DRAIN) { E(acc, cur, wr, wc, fr, fq); S.done(cur); }
        if (!has_next) break;
#pragma unroll
        for (int a = 0; a < 2; ++a)
#pragma unroll
            for (int b = 0; b < 2; ++b)
#pragma unroll
                for (int m = 0; m < 4; ++m)
#pragma unroll
                    for (int n = 0; n < 2; ++n) acc[a][b][m][n] = (f32x4){0.f, 0.f, 0.f, 0.f};
        cur = nxt; cA = nA; cB = nB; ++ui;
        if constexpr (ALIGN_EPI) { if (wr == 1) PG8_BAR; }
    }
    PG8_WAIT_V(0);
    if constexpr (!ALIGN_EPI) { if (wr == 0) PG8_BAR; }
    PG8_BAR;
    if constexpr (Epi::AFTER_DRAIN) { E.fused(acc, cur, wr, wc, fr, fq, lds, wid, lane); S.done(cur); }
#undef PG8_SA
#undef PG8_SB
#undef PG8_STAGE
#undef PG8_LDA
#undef PG8_LDB
#undef PG8_MMA
#undef PG8_WAIT_V
#undef PG8_WAIT_L
#undef PG8_BAR
#undef PG8_SCHED
}
}

#define LASP __attribute__((address_space(3)))
constexpr int NCHK = TOK / 32;

struct LatentOrder {
    pg8::StaticOrder S;
    __device__ __forceinline__ bool next(int i, pg8::Unit& u) const { if (!S.next(i, u)) return false; u.pm = 17 * (u.pm >> 4) + 1 + (u.pm & 15); return true; }
    __device__ __forceinline__ void a_ready(const pg8::Unit&) const {}
    __device__ __forceinline__ void done(const pg8::Unit&) const {}
};
struct EpiProj {
    static constexpr bool PERM = true, AFTER_DRAIN = false;
    bf16* raw; bf16* rest; bf16* kf;
    __device__ __forceinline__ void operator()(const pg8::f32x4 (&acc)[2][2][4][2], const pg8::Unit& u, int wr, int wc, int fr, int fq) const {
        const int row0 = u.pm * 256 + wr * 64 + fr;
        const int colb = u.pn * 256 + wc * 32 + 8 * fq;
        if (u.pn == PC_BK / 256) {
#pragma unroll
            for (int bj = 0; bj < 2; ++bj) {
                const int hd = wc * 32 + 8 * fq + bj * 128, hk = hd >> 6, dk = hd & 63;
#pragma unroll
                for (int ai = 0; ai < 2; ++ai)
#pragma unroll
                    for (int m = 0; m < 4; ++m) {
                        const pg8::f32x4 v0 = acc[ai][bj][m][0], v1 = acc[ai][bj][m][1];
                        pg8::u32x4 w; w.x = pg8::cvt_pk_bf16(v0[0], v0[1]); w.y = pg8::cvt_pk_bf16(v0[2], v0[3]); w.z = pg8::cvt_pk_bf16(v1[0], v1[1]); w.w = pg8::cvt_pk_bf16(v1[2], v1[3]);
                        const int row = row0 + ai * 128 + m * 16;
                        const int bb = row / TOK, t = row - bb * TOK;
                        *(pg8::u32x4*)(kf + ((((size_t)(bb * 4 + hk) * NCHK + (t >> 5)) * 4 + (dk >> 4)) * 64 + ((dk >> 3) & 1) * 32 + (t & 31)) * 8) = w;
                    }
            }
            return;
        }
        bf16* base; int ld;
        if (u.pn < NRAW / 256) { base = raw + colb; ld = NRAW; }
        else { base = rest + (colb - NRAW - (u.pn > PC_BK / 256 ? 256 : 0)); ld = NREST; }
#pragma unroll
        for (int bj = 0; bj < 2; ++bj) {
            if (colb + bj * 128 >= NPROJ) continue;
#pragma unroll
            for (int ai = 0; ai < 2; ++ai)
#pragma unroll
                for (int m = 0; m < 4; ++m) {
                    const pg8::f32x4 v0 = acc[ai][bj][m][0], v1 = acc[ai][bj][m][1];
                    pg8::u32x4 w; w.x = pg8::cvt_pk_bf16(v0[0], v0[1]); w.y = pg8::cvt_pk_bf16(v0[2], v0[3]); w.z = pg8::cvt_pk_bf16(v1[0], v1[1]); w.w = pg8::cvt_pk_bf16(v1[2], v1[3]);
                    *(pg8::u32x4*)(base + (size_t)(row0 + ai * 128 + m * 16) * ld + bj * 128) = w;
                }
        }
    }
};
struct EpiY {
    static constexpr bool PERM = true, AFTER_DRAIN = false;
    bf16* y;
    __device__ __forceinline__ void operator()(const pg8::f32x4 (&acc)[2][2][4][2], const pg8::Unit& u, int wr, int wc, int fr, int fq) const {
        const int row0 = u.pm * 256 + wr * 64 + fr;
        const int colb = u.pn * 256 + wc * 32 + 8 * fq;
#pragma unroll
        for (int bj = 0; bj < 2; ++bj)
#pragma unroll
            for (int ai = 0; ai < 2; ++ai)
#pragma unroll
                for (int m = 0; m < 4; ++m) {
                    const pg8::f32x4 v0 = acc[ai][bj][m][0], v1 = acc[ai][bj][m][1];
                    pg8::u32x4 w; w.x = pg8::cvt_pk_bf16(v0[0], v0[1]); w.y = pg8::cvt_pk_bf16(v0[2], v0[3]); w.z = pg8::cvt_pk_bf16(v1[0], v1[1]); w.w = pg8::cvt_pk_bf16(v1[2], v1[3]);
                    *(pg8::u32x4*)(y + (size_t)(row0 + ai * 128 + m * 16) * D + colb + bj * 128) = w;
                }
    }
};

struct OneUnit {
    int pm, pn; bool valid;
    __device__ __forceinline__ bool next(int i, pg8::Unit& u) const { if (i != 0 || !valid) return false; u.pm = pm; u.pn = pn; return true; }
    __device__ __forceinline__ void a_ready(const pg8::Unit&) const {}
    __device__ __forceinline__ void done(const pg8::Unit&) const {}
};
struct EpiYc {
    static constexpr bool PERM = true, AFTER_DRAIN = false;
    bf16* yc;
    __device__ __forceinline__ void operator()(const pg8::f32x4 (&acc)[2][2][4][2], const pg8::Unit& u, int wr, int wc, int fr, int fq) const {
        const int row0 = (u.pm / 17) * 256 + wr * 64 + fr;
        const int colb = u.pn * 256 + wc * 32 + 8 * fq;
#pragma unroll
        for (int bj = 0; bj < 2; ++bj)
#pragma unroll
            for (int ai = 0; ai < 2; ++ai)
#pragma unroll
                for (int m = 0; m < 4; ++m) {
                    const pg8::f32x4 v0 = acc[ai][bj][m][0], v1 = acc[ai][bj][m][1];
                    pg8::u32x4 w; w.x = pg8::cvt_pk_bf16(v0[0], v0[1]); w.y = pg8::cvt_pk_bf16(v0[2], v0[3]); w.z = pg8::cvt_pk_bf16(v1[0], v1[1]); w.w = pg8::cvt_pk_bf16(v1[2], v1[3]);
                    *(pg8::u32x4*)(yc + (size_t)(row0 + ai * 128 + m * 16) * D + colb + bj * 128) = w;
                }
    }
};
constexpr size_t YC_STRIDE = (size_t)BATCH * CTX * D;

template <bool PERMW> __device__ __forceinline__ void transpose_item(const float* W, int K, int N, bf16* WT, LASP float* scr, int item, int lane) {
    const int nblk = (N + 31) / 32, kb = item / nblk, nb = item % nblk, k0 = 64 * kb, n0 = 32 * nb;
    const bool nok = (n0 + (lane & 31)) < N;
#pragma unroll 8
    for (int i = 0; i < 32; ++i) { const int kk = 2 * i + (lane >> 5); scr[kk * 33 + (lane & 31)] = nok ? W[(size_t)(k0 + kk) * N + n0 + (lane & 31)] : 0.f; }
    asm volatile("s_waitcnt lgkmcnt(0)" ::: "memory");
    const int c = lane & 7;
#pragma unroll
    for (int j = 0; j < 4; ++j) {
        const int n = (lane >> 3) + 8 * j; const LASP float* s = scr + (8 * c) * 33 + n;
        uint4 o; o.x = pk2(s[0 * 33], s[1 * 33]); o.y = pk2(s[2 * 33], s[3 * 33]); o.z = pk2(s[4 * 33], s[5 * 33]); o.w = pk2(s[6 * 33], s[7 * 33]);
        *(uint4*)(WT + (size_t)(PERMW ? gemm_col(n0 + n) : n0 + n) * K + k0 + 8 * c) = o;
    }
    asm volatile("s_waitcnt lgkmcnt(0)" ::: "memory");
}

__device__ void ph_prologue(const P& p, LASP unsigned char* lds, int bid, int nblk) {
    const int tid = mk_tid(), lane = tid & 63, wave = tid >> 6;
    LASP float* sm = (LASP float*)lds;
    if (bid < 192) {
        for (int i = tid; i < 9 * 1024; i += NTHREADS) {
            int s = i >> 10, d = i & 1023;
            float cv = s < 8 ? p.c[s * 1024 + d] : p.c_ctx[d];
            sm[i] = silu_f(cv);
        }
        __syncthreads();
        const int l = bid / 96, col = lane & 31, kh = lane >> 5, j = (bid % 96) * 32 + col;
        const float* w = p.w_mod + (size_t)l * 1024 * 3072 + j;
        float acc[9];
#pragma unroll
        for (int s = 0; s < 9; ++s) acc[s] = 0.f;
        const int ib = wave * 128 + kh * 64;
#pragma unroll 1
        for (int i0 = ib; i0 < ib + 64; i0 += 16) {
            float wv[16];
#pragma unroll
            for (int u = 0; u < 16; ++u) wv[u] = w[(size_t)(i0 + u) * 3072];
#pragma unroll
            for (int u = 0; u < 16; ++u)
#pragma unroll
                for (int s = 0; s < 9; ++s) acc[s] += sm[s * 1024 + i0 + u] * wv[u];
        }
        LASP float* red = sm + 9 * 1024;
#pragma unroll
        for (int s = 0; s < 9; ++s) { acc[s] += __shfl_xor(acc[s], 32); if (kh == 0) red[(wave * 9 + s) * 32 + col] = acc[s]; }
        __syncthreads();
        for (int o = tid; o < 9 * 32; o += NTHREADS) {
            const int s = o >> 5, c = o & 31;
            float t = 0.f;
#pragma unroll
            for (int ww = 0; ww < 8; ++ww) t += red[(ww * 9 + s) * 32 + c];
            const int jj = (bid % 96) * 32 + c;
            p.mods[(size_t)(l * 9 + s) * 3072 + jj] = t + p.b_mod[l * 3072 + jj];
        }
        __syncthreads();
    }
    if (bid == nblk - 1) {
        const int pos = tid >> 3, f = tid & 7;
        const float ang = (float)pos * powf(10000.f, -(float)f / 8.f);
        p.cst[tid * 2] = cosf(ang); p.cst[tid * 2 + 1] = sinf(ang);
    }
#if PROBE
    if (bid == 0 && tid < 4) p.stats[tid] = 0.f;
#endif
}
__device__ void ph_transposes(const P& p, LASP unsigned char* lds, int bid, int nblk) {
    const int tid = mk_tid(), lane = tid & 63, wave = tid >> 6;
    LASP float* scr = (LASP float*)(lds + 57344 + wave * 8704);
    const int gw = (nblk - 1 - bid) * NWAVES + wave, NGW = nblk * NWAVES;
    constexpr int I_IN = 16 * 122, I_OUT = 16 * 32;
    for (int it = gw; it < 2 * (I_IN + I_OUT); it += NGW) {
        int l = it / (I_IN + I_OUT), r = it % (I_IN + I_OUT);
        if (r < I_IN) transpose_item<true>(p.w_in + (size_t)l * D * NPROJ, D, NPROJ, p.wi_t + (size_t)l * NPAD * D, scr, r, lane);
        else transpose_item<false>(p.w_out + (size_t)l * D * D, D, D, p.wo_t + (size_t)l * D * D, scr, r - I_IN, lane);
    }
    for (int i = bid * NTHREADS + tid; i < 2 * 192 * 128; i += nblk * NTHREADS) {
        int l = i / (192 * 128), r = i % (192 * 128);
        unsigned z; asm volatile("v_mov_b32 %0, 0" : "=v"(z));
        *(uint4*)(p.wi_t + (size_t)l * NPAD * D + (size_t)3904 * D + (size_t)r * 8) = make_uint4(z, z, z, z);
    }
}

__device__ void ph_lnpass(const P& p, int mode, int bid, int nblk) {
    const int tid = mk_tid();
    const int lane = tid & 63, wave = tid >> 6;
    for (int r = bid * NWAVES + wave; r < ROWS; r += nblk * NWAVES) {
        const int b = r / TOK, t = r - b * TOK;
        const bool isc = t < CTX;
        if (mode == 2 && isc) continue;
        float* buf; const float* src; int s;
        if (isc) { buf = p.xc1 + ((size_t)b * CTX + t) * D; src = p.ctx + ((size_t)b * CTX + t) * D; s = 8; }
        else { buf = p.out + ((size_t)b * SEQ + (t - CTX)) * D; src = (mode == 2) ? buf : p.x + ((size_t)b * SEQ + (t - CTX)) * D; s = b; }
        f32x4_t v[4];
#pragma unroll
        for (int j = 0; j < 4; ++j) v[j] = *(const f32x4_t*)(src + 256 * j + 4 * lane);
        if (mode >= 1) {
            const int lp = mode - 1;
            const float* gt = p.mods + (size_t)(lp * 9 + s) * 3072 + 2048;
            f32x4_t yq[4];
            if (isc) {
                const bf16* yc = p.oc + ((size_t)b * CTX + t) * D + 4 * lane;
                uint2 yp[4][4];
#pragma unroll
                for (int j = 0; j < 4; ++j)
#pragma unroll
                    for (int q = 0; q < 4; ++q) yp[j][q] = *(const uint2*)(yc + q * YC_STRIDE + 256 * j);
#pragma unroll
                for (int j = 0; j < 4; ++j)
                    yq[j] = (f32x4_t){(bflo(yp[j][0].x) + bflo(yp[j][1].x)) + (bflo(yp[j][2].x) + bflo(yp[j][3].x)), (bfhi(yp[j][0].x) + bfhi(yp[j][1].x)) + (bfhi(yp[j][2].x) + bfhi(yp[j][3].x)),
                                      (bflo(yp[j][0].y) + bflo(yp[j][1].y)) + (bflo(yp[j][2].y) + bflo(yp[j][3].y)), (bfhi(yp[j][0].y) + bfhi(yp[j][1].y)) + (bfhi(yp[j][2].y) + bfhi(yp[j][3].y))};
            } else {
                uint2 yw[4];
#pragma unroll
                for (int j = 0; j < 4; ++j) yw[j] = *(const uint2*)(p.ml + (size_t)r * D + 256 * j + 4 * lane);
#pragma unroll
                for (int j = 0; j < 4; ++j) yq[j] = (f32x4_t){bflo(yw[j].x), bfhi(yw[j].x), bflo(yw[j].y), bfhi(yw[j].y)};
            }
#pragma unroll
            for (int j = 0; j < 4; ++j) {
                const f32x4_t g = *(const f32x4_t*)(gt + 256 * j + 4 * lane);
                const f32x4_t yv = yq[j];
                v[j] = v[j] * ALPHA + g * yv;
            }
            float sum = 0.f;
#pragma unroll
            for (int j = 0; j < 4; ++j) sum += (v[j].x + v[j].y) + (v[j].z + v[j].w);
            const float mu = wave_sum(sum) * (1.f / 1024.f);
            float sq = 0.f;
#pragma unroll
            for (int j = 0; j < 4; ++j) { v[j] = v[j] - mu; sq += (v[j].x * v[j].x + v[j].y * v[j].y) + (v[j].z * v[j].z + v[j].w * v[j].w); }
            const float rs = __builtin_amdgcn_rsqf(wave_sum(sq) * (1.f / 1024.f) + 1e-6f);
#pragma unroll
            for (int j = 0; j < 4; ++j) {
                const f32x4_t g = *(const f32x4_t*)(p.ln_g + lp * 1024 + 256 * j + 4 * lane), bb = *(const f32x4_t*)(p.ln_b + lp * 1024 + 256 * j + 4 * lane);
                v[j] = v[j] * rs * g + bb;
#if PROBE
                if (mode == 2) v[j] = v[j] + (p.stats[0] / fmaxf(p.stats[1], 1e-20f));
#endif
#if TPROBE >= 0
                if (mode == 2) v[j] = v[j] + exp2f((rintf(log2f(fmaxf(p.stats[2], 1.f)) * 6.f + TSHIFT * 0.5f) - TSHIFT * 0.5f) * (1.f / 6.f)) * 1e-4f;
#endif
                *(f32x4_t*)(buf + 256 * j + 4 * lane) = v[j];
            }
            if (mode == 2) continue;
        }
        const int l = mode;
        float sum = 0.f;
#pragma unroll
        for (int j = 0; j < 4; ++j) sum += (v[j].x + v[j].y) + (v[j].z + v[j].w);
        const float mu = wave_sum(sum) * (1.f / 1024.f);
        float sq = 0.f;
#pragma unroll
        for (int j = 0; j < 4; ++j) { v[j] = v[j] - mu; sq += (v[j].x * v[j].x + v[j].y * v[j].y) + (v[j].z * v[j].z + v[j].w * v[j].w); }
        const float rs = __builtin_amdgcn_rsqf(wave_sum(sq) * (1.f / 1024.f) + 1e-6f);
        const float* md = p.mods + (size_t)(l * 9 + s) * 3072;
#pragma unroll
        for (int j = 0; j < 4; ++j) {
            const f32x4_t sh = *(const f32x4_t*)(md + 256 * j + 4 * lane), sc = *(const f32x4_t*)(md + 1024 + 256 * j + 4 * lane);
            const f32x4_t o = v[j] * rs * (sc + 1.f) + sh;
            uint2 w; w.x = pk2(o.x, o.y); w.y = pk2(o.z, o.w);
            *(uint2*)(p.ml + (size_t)r * D + 256 * j + 4 * lane) = w;
        }
    }
}

__device__ void ph_conv(const P& p, int l, int bid, int nblk) {
    const int tid = mk_tid();
    const int lane = tid & 63, wave = tid >> 6;
    const float* cw = p.conv_w + (size_t)l * 5 * 1536;
    constexpr int SL = 17, NSTRIP = TOK / SL;
    static_assert(NSTRIP * SL == TOK && (CTX / SL) * SL + 1 == CTX, "strip geometry: the straddling strip starts at the last context token");
    for (int it = bid * NWAVES + wave; it < BATCH * NSTRIP * 3; it += nblk * NWAVES) {
        const int third = it % 3, rest_i = it / 3, strip = rest_i % NSTRIP, b = rest_i / NSTRIP;
        const int t0 = strip * SL;
        const bool strad = t0 == CTX - 1;
        const int lo = strad ? 0 : (t0 < CTX ? 0 : CTX), hi = strad ? TOK : (t0 < CTX ? CTX : TOK);
        const int ch = third * 512 + lane * 8;
        float w[5][8];
#pragma unroll
        for (int j = 0; j < 5; ++j) {
            const f32x4_t a = *(const f32x4_t*)(cw + j * 1536 + ch), c = *(const f32x4_t*)(cw + j * 1536 + ch + 4);
            w[j][0] = a.x; w[j][1] = a.y; w[j][2] = a.z; w[j][3] = a.w; w[j][4] = c.x; w[j][5] = c.y; w[j][6] = c.z; w[j][7] = c.w;
        }
        const bf16* src = p.raw + ((size_t)b * TOK + t0) * NRAW + ch;
        bf16* dst = p.qkvn + ((size_t)b * TOK + t0) * NRAW + ch;
        uint4 rw[SL + 4];
#pragma unroll
        for (int i = 0; i < SL + 4; ++i) {
            const int tt = t0 + i - 2;
            rw[i] = (tt >= lo && tt < hi) ? *(const uint4*)(src + (ptrdiff_t)(i - 2) * NRAW) : make_uint4(0, 0, 0, 0);
        }
        const int g = (ch >> 7);
        const float qs = g < 4 ? 0.08838834764831845f : 1.f;
#pragma unroll
        for (int n = 0; n < SL; ++n) {
            float acc[8];
#pragma unroll
            for (int e = 0; e < 8; ++e) acc[e] = 0.f;
#pragma unroll
            for (int j = 0; j < 5; ++j) {
                float f[8]; unpack8(rw[n + j], f);
                const bool cross = (n == 0) ? (n + j >= 3) : (n + j <= 2);
                if (cross && n <= 2) {
#pragma unroll
                    for (int e = 0; e < 8; ++e) f[e] = strad ? 0.f : f[e];
                }
#pragma unroll
                for (int e = 0; e < 8; ++e) acc[e] += w[j][e] * f[e];
            }
            float ss = 0.f;
#pragma unroll
            for (int e = 0; e < 8; ++e) { acc[e] = silu_f(acc[e]); ss += acc[e] * acc[e]; }
            if (g < 8) {
#pragma unroll
                for (int m = 8; m > 0; m >>= 1) ss += __shfl_xor(ss, m);
                const float sc = qs * __builtin_amdgcn_rsqf(ss + 1e-6f);
#pragma unroll
                for (int e = 0; e < 8; ++e) acc[e] *= sc;
            }
            uint4 o; o.x = pk2(acc[0], acc[1]); o.y = pk2(acc[2], acc[3]); o.z = pk2(acc[4], acc[5]); o.w = pk2(acc[6], acc[7]);
            *(uint4*)(dst + (size_t)n * NRAW) = o;
        }
    }
}

typedef short bf16x8_t __attribute__((ext_vector_type(8)));
typedef float f32x16_t __attribute__((ext_vector_type(16)));
typedef unsigned u32x4_t __attribute__((ext_vector_type(4)));
#define MFMA32(a, b, c) __builtin_amdgcn_mfma_f32_32x32x16_bf16((a), (b), (c), 0, 0, 0)
__device__ __forceinline__ int crow(int reg, int h) { return (reg & 3) + 8 * (reg >> 2) + 4 * h; }
__device__ __forceinline__ int perm16(int a) { const int x = a & 15; return (a & ~15) + (x < 4 ? x : x < 8 ? x + 4 : x < 12 ? x - 4 : x); }
#define PACK8(x, s) __builtin_bit_cast(bf16x8_t, (u32x4_t){cvtpk((x)[8 * (s)], (x)[8 * (s) + 1]), cvtpk((x)[8 * (s) + 2], (x)[8 * (s) + 3]), cvtpk((x)[8 * (s) + 4], (x)[8 * (s) + 5]), cvtpk((x)[8 * (s) + 6], (x)[8 * (s) + 7])})
constexpr int GCH = 32, NCH = TOK / GCH;
constexpr int GP_ITEM = 4416;

__device__ void ph_gdnprep(const P& p, LASP unsigned char* lds, int l, int bid, int nblk, int tid) {
    const int lane = tid & 63, wave = tid >> 6, r = lane & 31, hh = lane >> 5;
    LASP float* Lm = (LASP float*)(lds + wave * 16384);
    LASP float* Xs = Lm + 2048;
    for (int it = bid * NWAVES + wave; it < BATCH * 4 * NCH; it += nblk * NWAVES) {
        const int c = it % NCH, bh = it / NCH, h = bh & 3, b = bh >> 2;
        const size_t row0 = (size_t)b * TOK + (size_t)c * GCH;
        f32x16_t KK, QK;
#pragma unroll
        for (int i = 0; i < 16; ++i) { KK[i] = 0.f; QK[i] = 0.f; }
        const bf16* kbase = p.qkvn + (row0 + r) * NRAW + 512 + h * 128 + 8 * hh;
        const bf16* qbase = p.qkvn + (row0 + r) * NRAW + h * 128 + 8 * hh;
#pragma unroll
        for (int s = 0; s < 8; ++s) {
            const bf16x8_t kf = *(const bf16x8_t*)(kbase + 16 * s), qf = *(const bf16x8_t*)(qbase + 16 * s);
            KK = MFMA32(kf, kf, KK);
            QK = MFMA32(qf, kf, QK);
        }
        float Gd, bd;
        {
            const bf16* ab = p.rest + (row0 + r) * NREST + RC_AB;
            const float a = bf2f(ab[hh * 4 + h]) + p.dt_bias[(l * 2 + hh) * 4 + h];
            const float sp = fmaxf(a, 0.f) + 0.6931471805599453f * __builtin_amdgcn_logf(1.f + __builtin_amdgcn_exp2f(-1.4426950408889634f * fabsf(a)));
            Gd = -__builtin_amdgcn_exp2f(1.4426950408889634f * p.a_log[(l * 2 + hh) * 4 + h]) * sp;
            bd = __builtin_amdgcn_rcpf(1.f + __builtin_amdgcn_exp2f(-1.4426950408889634f * bf2f(ab[(2 + hh) * 4 + h])));
        }
#pragma unroll
        for (int off = 1; off < 32; off <<= 1) {
            const float up = __shfl_up(Gd, off, 32), dn = __shfl_down(Gd, off, 32);
            if (hh == 0) { if (r >= off) Gd += up; } else { if (r + off < 32) Gd += dn; }
        }
        unsigned char* gout = (unsigned char*)p.raw + ((size_t)(bh * 2) * NCH + c) * GP_ITEM;
        {
            const float Glast = __shfl(Gd, hh == 0 ? 31 : 32);
            float* sc = (float*)(gout + (size_t)hh * NCH * GP_ITEM + 4096);
            sc[r] = __builtin_amdgcn_exp2f(1.4426950408889634f * Gd); sc[32 + r] = __builtin_amdgcn_exp2f(1.4426950408889634f * (Glast - Gd));
            if (r == 0) sc[64] = __builtin_amdgcn_exp2f(1.4426950408889634f * Glast);
        }
        asm volatile("s_waitcnt lgkmcnt(0)" ::: "memory");
        LASP unsigned short* qkt = (LASP unsigned short*)Xs;
        LASP float* bs = (LASP float*)(lds + 135168 + wave * 256);
        bs[lane] = bd;
#pragma unroll
        for (int d = 0; d < 2; ++d) {
            const float Gcol = __shfl(Gd, d * 32 + r);
#pragma unroll
            for (int i = 0; i < 16; ++i) {
                const int n = crow(i, hh);
                const float Grow = __shfl(Gd, d * 32 + n), brow = __shfl(bd, d * 32 + n);
                const bool incl = d == 0 ? (r <= n) : (r >= n), strict = d == 0 ? (r < n) : (r > n);
                const float dec = __builtin_amdgcn_exp2f((incl ? Grow - Gcol : 0.f) * 1.4426950408889634f);
                const float lv = strict ? brow * KK[i] * dec : 0.f;
                const float qv = incl ? QK[i] * dec : 0.f;
                const int n2 = d == 0 ? n : 31 - n, m2 = d == 0 ? r : 31 - r;
                Lm[(d * 32 + n2) * 32 + m2] = lv;
                qkt[(d * 32 + n) * 40 + perm16(r)] = f2bf(qv);
                if ((i & 3) == 3) __builtin_amdgcn_sched_barrier(0);
            }
        }
        asm volatile("s_waitcnt lgkmcnt(0)" ::: "memory");
#pragma unroll
        for (int d = 0; d < 2; ++d)
#pragma unroll
            for (int k = 0; k < 2; ++k) {
                const int q = lane + 64 * k, row = q >> 2, ch = q & 3;
                *(u32x4_t*)(gout + (size_t)d * NCH * GP_ITEM + 2048 + row * 64 + ch * 16) = *(const LASP u32x4_t*)((const LASP unsigned char*)qkt + (d * 32 + row) * 80 + ch * 16);
            }
        asm volatile("s_waitcnt lgkmcnt(0)" ::: "memory");
        {
            const LASP float* Lr = Lm + hh * 1024;
            LASP float* xc = Xs + lane;
            float x[32];
#pragma unroll
            for (int n = 0; n < 32; ++n) x[n] = 0.f;
#pragma unroll
            for (int n = 0; n < 32; ++n) {
                f32x4_t lc[8];
#pragma unroll
                for (int jb = 0; jb < 8; ++jb) if (4 * jb < n) lc[jb] = *(const LASP f32x4_t*)(Lr + n * 32 + 4 * jb);
                float a0 = (n == r) ? 1.f : 0.f, a1 = 0.f;
#pragma unroll
                for (int jb = 0; jb < 8; ++jb) if (4 * jb < n) { a0 -= lc[jb].x * x[4 * jb]; a1 -= lc[jb].y * x[4 * jb + 1]; a0 -= lc[jb].z * x[4 * jb + 2]; a1 -= lc[jb].w * x[4 * jb + 3]; }
                x[n] = a0 + a1;
                xc[n * 64] = x[n];
                if ((n & 1) == 1) __builtin_amdgcn_sched_barrier(0);
            }
        }
        asm volatile("s_waitcnt lgkmcnt(0)" ::: "memory");
#pragma unroll
        for (int d = 0; d < 2; ++d)
#pragma unroll
            for (int k = 0; k < 2; ++k) {
                const int q = lane + 64 * k, row = q >> 2, ch = q & 3;
                const int nn = d == 0 ? row : 31 - row;
                float v[8];
#pragma unroll
                for (int e = 0; e < 8; ++e) {
                    const int m = perm16(ch * 8 + e);
                    const int lidx = d == 0 ? m : 32 + 31 - m;
                    v[e] = Xs[nn * 64 + lidx] * bs[d * 32 + m];
                }
                *(u32x4_t*)(gout + (size_t)d * NCH * GP_ITEM + row * 64 + ch * 16) = (u32x4_t){cvtpk(v[0], v[1]), cvtpk(v[2], v[3]), cvtpk(v[4], v[5]), cvtpk(v[6], v[7])};
            }
        asm volatile("s_waitcnt lgkmcnt(0)" ::: "memory");
    }
}

constexpr int ST_KA = 0, ST_QA = 8704, ST_KN = 17408, ST_V = 27648, ST_TP = 37888, ST_QK = 40448, ST_GL = 43008, ST_BYTES = 43328;
constexpr int GDN_OST = 2 * ST_BYTES, GDN_OST_BYTES = 32 * 272;
typedef unsigned u32x2_t __attribute__((ext_vector_type(2)));
typedef short s16x4_t __attribute__((ext_vector_type(4)));
struct GSlot { u32x4_t k0, k1, q0, q1, v0, v1, t; f32x4_t sc; };

__device__ __forceinline__ int gdn_chunk(int dir, int s) { return dir == 0 ? s : (s < 8 ? 7 - s : 143 - s); }
__device__ __forceinline__ void gdn_issue(const P& p, GSlot& g, int b, int h, int dir, int step, int tl) {
    const int c = gdn_chunk(dir, step);
    const size_t row0 = (size_t)b * TOK + (size_t)c * GCH;
    const int r0 = tl >> 4, c16 = tl & 15;
    const bf16* a0 = p.qkvn + (row0 + r0) * NRAW + h * 128 + 8 * c16;
    const bf16* a1 = a0 + (size_t)16 * NRAW;
    g.q0 = *(const u32x4_t*)a0; g.q1 = *(const u32x4_t*)a1;
    g.k0 = *(const u32x4_t*)(a0 + 512); g.k1 = *(const u32x4_t*)(a1 + 512);
    g.v0 = *(const u32x4_t*)(a0 + 1024); g.v1 = *(const u32x4_t*)(a1 + 1024);
    const unsigned char* gp = (const unsigned char*)p.raw + ((size_t)((b * 4 + h) * 2 + dir) * NCH + c) * GP_ITEM;
    g.t = *(const u32x4_t*)(gp + tl * 16);
    g.sc = *(const f32x4_t*)(gp + 4096 + (tl < 20 ? tl : 0) * 16);
}
__device__ __forceinline__ u32x4_t scale8(u32x4_t x, float s) {
    return (u32x4_t){cvtpk(bflo(x.x) * s, bfhi(x.x) * s), cvtpk(bflo(x.y) * s, bfhi(x.y) * s), cvtpk(bflo(x.z) * s, bfhi(x.z) * s), cvtpk(bflo(x.w) * s, bfhi(x.w) * s)};
}
__device__ __forceinline__ void gdn_put_rows(LASP unsigned char* st, int row, int c16, u32x4_t kq, int off) {
    const int g = c16 >> 1, odd = c16 & 1;
    *(LASP u32x2_t*)(st + off + row * 272 + (16 * g + (odd ? 4 : 0)) * 2) = (u32x2_t){kq.x, kq.y};
    *(LASP u32x2_t*)(st + off + row * 272 + (16 * g + (odd ? 12 : 8)) * 2) = (u32x2_t){kq.z, kq.w};
}
__device__ __forceinline__ void gdn_write(LASP unsigned char* st, const GSlot& g, int tl) {
    const int r0 = tl >> 4, c16 = tl & 15;
    gdn_put_rows(st, r0, c16, g.k0, ST_KA); gdn_put_rows(st, r0 + 16, c16, g.k1, ST_KA);
    gdn_put_rows(st, r0, c16, g.q0, ST_QA); gdn_put_rows(st, r0 + 16, c16, g.q1, ST_QA);
    *(LASP u32x4_t*)(st + ST_KN + r0 * 320 + c16 * 16) = g.k0;
    *(LASP u32x4_t*)(st + ST_KN + (r0 + 16) * 320 + c16 * 16) = g.k1;
    *(LASP u32x4_t*)(st + ST_V + r0 * 320 + c16 * 16) = g.v0;
    *(LASP u32x4_t*)(st + ST_V + (r0 + 16) * 320 + c16 * 16) = g.v1;
    { const int t2 = tl & 127; *(LASP u32x4_t*)(st + (tl < 128 ? ST_TP : ST_QK) + (t2 >> 2) * 80 + (t2 & 3) * 16) = g.t; }
    if (tl < 20) *(LASP f32x4_t*)(st + ST_GL + tl * 16) = g.sc;
}
__device__ __forceinline__ void gdn_flush(const P& p, LASP unsigned char* lds, int b, int h, int dir, int step, int tl) {
    const int c = gdn_chunk(dir, step);
    const LASP unsigned char* ost = lds + GDN_OST + (step & 1) * GDN_OST_BYTES;
    bf16* op = p.oa + ((size_t)dir * ROWS + (size_t)b * TOK + (size_t)c * GCH) * 512 + h * 128;
#pragma unroll
    for (int k = 0; k < 2; ++k) { const int idx = tl + 256 * k, row = idx >> 4, ch = idx & 15; *(u32x4_t*)(op + (size_t)row * 512 + ch * 8) = *(const LASP u32x4_t*)(ost + row * 272 + ch * 16); }
}
__device__ __forceinline__ s16x4_t trd(const LASP unsigned char* q) {
    typedef short v4i16_t __attribute__((ext_vector_type(4)));
    return __builtin_bit_cast(s16x4_t, __builtin_amdgcn_ds_read_tr16_b64_v4i16((LASP v4i16_t*)q));
}
#define TRFRAG(base) __builtin_shufflevector(trd(base), trd((base) + 8 * 320), 0, 1, 2, 3, 4, 5, 6, 7)

#if TPROBE == 60
#define GDN_SYNC_C() do { unsigned long long t_ = __builtin_amdgcn_s_memrealtime(); __syncthreads(); if (chain == 0 && tid == 0) p.stats[2] += (float)(__builtin_amdgcn_s_memrealtime() - t_) * 0.01f; } while (0)
#define GDN_SYNC_L() __syncthreads()
#elif TPROBE == 61
#define GDN_SYNC_L() do { unsigned long long t_ = __builtin_amdgcn_s_memrealtime(); __syncthreads(); if (chain == 0 && tid == 256) p.stats[2] += (float)(__builtin_amdgcn_s_memrealtime() - t_) * 0.01f; } while (0)
#define GDN_SYNC_C() __syncthreads()
#else
#define GDN_SYNC_C() __syncthreads()
#define GDN_SYNC_L() __syncthreads()
#endif
__device__ __forceinline__ float lm_(float a, float b) { float t = a * b; asm("" : "+v"(t)); return t; }
__device__ void gdn_scan_fast(const P& p, LASP unsigned char* lds, int chain) {
    const int tid = mk_tid();
    const int lane = tid & 63, wave = __builtin_amdgcn_readfirstlane(tid >> 6);
    const int dir = chain & 1, h = (chain >> 1) & 3, b = chain >> 3;
    constexpr int NS = NCH;
    if (wave >= 4) {
        const int tl = tid - 256;
        GSlot g0, g1, g2, g3;
        gdn_issue(p, g0, b, h, dir, 0, tl); gdn_issue(p, g1, b, h, dir, 1, tl); gdn_issue(p, g2, b, h, dir, 2, tl); gdn_issue(p, g3, b, h, dir, 3, tl);
        gdn_write(lds, g0, tl); gdn_issue(p, g0, b, h, dir, 4, tl);
        __syncthreads();
#pragma unroll 1
        for (int s = 0; s < NS; s += 4) {
            if (s > 0) gdn_flush(p, lds, b, h, dir, s - 1, tl);
            gdn_write(lds + ((s + 1) & 1) * ST_BYTES, g1, tl); gdn_issue(p, g1, b, h, dir, min(s + 5, NS - 1), tl);
            GDN_SYNC_L();
            gdn_flush(p, lds, b, h, dir, s, tl);
            gdn_write(lds + ((s + 2) & 1) * ST_BYTES, g2, tl); gdn_issue(p, g2, b, h, dir, min(s + 6, NS - 1), tl);
            GDN_SYNC_L();
            gdn_flush(p, lds, b, h, dir, s + 1, tl);
            gdn_write(lds + ((s + 3) & 1) * ST_BYTES, g3, tl); gdn_issue(p, g3, b, h, dir, min(s + 7, NS - 1), tl);
            GDN_SYNC_L();
            gdn_flush(p, lds, b, h, dir, s + 2, tl);
            gdn_write(lds + ((s + 4) & 1) * ST_BYTES, g0, tl); gdn_issue(p, g0, b, h, dir, min(s + 8, NS - 1), tl);
            GDN_SYNC_L();
        }
        gdn_flush(p, lds, b, h, dir, NS - 1, tl);
    } else {
        const int r = lane & 31, hh = lane >> 5, w = wave;
        f32x16_t S0, S1, S2, S3;
#pragma unroll
        for (int i = 0; i < 16; ++i) { S0[i] = 0.f; S1[i] = 0.f; S2[i] = 0.f; S3[i] = 0.f; }
        const int troff = (4 * hh + ((lane & 15) >> 2)) * 320 + (16 * ((lane >> 4) & 1) + 4 * (lane & 3)) * 2;
        __syncthreads();
#pragma unroll 1
        for (int s = 0; s < NS; ++s) {
            LASP unsigned char* st = lds + (s & 1) * ST_BYTES;
            const LASP float* sc = (const LASP float*)(st + ST_GL);
            const float gl = sc[64];
            const LASP unsigned char* tp = st + ST_TP + r * 80 + hh * 16;
            const bf16x8_t T0 = *(const LASP bf16x8_t*)(tp), T1 = *(const LASP bf16x8_t*)(tp + 32);
            const LASP unsigned char* vbase = st + ST_V + troff + 64 * w;
            const bf16x8_t vB0 = TRFRAG(vbase), vB1 = TRFRAG(vbase + 16 * 320);
            const LASP unsigned char* ka = st + ST_KA + r * 272 + hh * 16;
            const LASP unsigned char* qa = st + ST_QA + r * 272 + hh * 16;
            const bf16x8_t kA0 = *(const LASP bf16x8_t*)(ka), qA0 = *(const LASP bf16x8_t*)(qa), kA1 = *(const LASP bf16x8_t*)(ka + 32), qA1 = *(const LASP bf16x8_t*)(qa + 32);
            __builtin_amdgcn_sched_barrier(0);
            f32x16_t ak, aq, vn;
#pragma unroll
            for (int i = 0; i < 16; ++i) { ak[i] = 0.f; aq[i] = 0.f; vn[i] = 0.f; }
#define GDN_KQ(KA, QA, SX, u) { const bf16x8_t SB = PACK8(SX, u); ak = MFMA32(KA, SB, ak); aq = MFMA32(QA, SB, aq); \
                                 f32x4_t a_ = {lm_(SX[8 * u], gl), lm_(SX[8 * u + 1], gl), lm_(SX[8 * u + 2], gl), lm_(SX[8 * u + 3], gl)}, b_ = {lm_(SX[8 * u + 4], gl), lm_(SX[8 * u + 5], gl), lm_(SX[8 * u + 6], gl), lm_(SX[8 * u + 7], gl)}; \
                                 asm volatile("" : "+v"(a_), "+v"(b_));        \
                                 SX[8 * u] = a_.x; SX[8 * u + 1] = a_.y; SX[8 * u + 2] = a_.z; SX[8 * u + 3] = a_.w; SX[8 * u + 4] = b_.x; SX[8 * u + 5] = b_.y; SX[8 * u + 6] = b_.z; SX[8 * u + 7] = b_.w; }
            const bf16x8_t kA2 = *(const LASP bf16x8_t*)(ka + 64), qA2 = *(const LASP bf16x8_t*)(qa + 64), kA3 = *(const LASP bf16x8_t*)(ka + 96), qA3 = *(const LASP bf16x8_t*)(qa + 96);
            vn = MFMA32(T0, vB0, vn); vn = MFMA32(T1, vB1, vn);
            GDN_KQ(kA0, qA0, S0, 0) GDN_KQ(kA1, qA1, S0, 1)
            __builtin_amdgcn_sched_barrier(0);
            const bf16x8_t kA4 = *(const LASP bf16x8_t*)(ka + 128), qA4 = *(const LASP bf16x8_t*)(qa + 128), kA5 = *(const LASP bf16x8_t*)(ka + 160), qA5 = *(const LASP bf16x8_t*)(qa + 160);
            GDN_KQ(kA2, qA2, S1, 0) GDN_KQ(kA3, qA3, S1, 1)
            __builtin_amdgcn_sched_barrier(0);
            const bf16x8_t kA6 = *(const LASP bf16x8_t*)(ka + 192), qA6 = *(const LASP bf16x8_t*)(qa + 192), kA7 = *(const LASP bf16x8_t*)(ka + 224), qA7 = *(const LASP bf16x8_t*)(qa + 224);
            GDN_KQ(kA4, qA4, S2, 0) GDN_KQ(kA5, qA5, S2, 1)
            __builtin_amdgcn_sched_barrier(0);
            const LASP unsigned char* qk = st + ST_QK + r * 80 + hh * 16;
            const bf16x8_t Q0 = *(const LASP bf16x8_t*)(qk), Q1 = *(const LASP bf16x8_t*)(qk + 32);
            const f32x4_t e0 = *(const LASP f32x4_t*)(sc + 4 * hh), e1 = *(const LASP f32x4_t*)(sc + 8 + 4 * hh), e2 = *(const LASP f32x4_t*)(sc + 16 + 4 * hh), e3 = *(const LASP f32x4_t*)(sc + 24 + 4 * hh);
            const f32x4_t f0 = *(const LASP f32x4_t*)(sc + 32 + 4 * hh), f1 = *(const LASP f32x4_t*)(sc + 40 + 4 * hh), f2 = *(const LASP f32x4_t*)(sc + 48 + 4 * hh), f3 = *(const LASP f32x4_t*)(sc + 56 + 4 * hh);
            GDN_KQ(kA6, qA6, S3, 0) GDN_KQ(kA7, qA7, S3, 1)
#undef GDN_KQ
            __builtin_amdgcn_sched_barrier(0);
            const LASP unsigned char* kn = st + ST_KN + troff;
            const bf16x8_t N00 = TRFRAG(kn), N01 = TRFRAG(kn + 16 * 320), N10 = TRFRAG(kn + 64), N11 = TRFRAG(kn + 64 + 16 * 320);
            const bf16x8_t N20 = TRFRAG(kn + 128), N21 = TRFRAG(kn + 128 + 16 * 320), N30 = TRFRAG(kn + 192), N31 = TRFRAG(kn + 192 + 16 * 320);
            __builtin_amdgcn_sched_barrier(0);
#define ROWSCALE(X, sgn) { X[0] *= sgn e0.x; X[1] *= sgn e0.y; X[2] *= sgn e0.z; X[3] *= sgn e0.w; X[4] *= sgn e1.x; X[5] *= sgn e1.y; X[6] *= sgn e1.z; X[7] *= sgn e1.w; \
                           X[8] *= sgn e2.x; X[9] *= sgn e2.y; X[10] *= sgn e2.z; X[11] *= sgn e2.w; X[12] *= sgn e3.x; X[13] *= sgn e3.y; X[14] *= sgn e3.z; X[15] *= sgn e3.w; }
            ROWSCALE(ak, -) ROWSCALE(aq, +)
#undef ROWSCALE
            const bf16x8_t ab0 = PACK8(ak, 0), ab1 = PACK8(ak, 1);
            vn = MFMA32(T0, ab0, vn); vn = MFMA32(T1, ab1, vn);
            const bf16x8_t vb0 = PACK8(vn, 0), vb1 = PACK8(vn, 1);
            f32x16_t vf;
            vf[0] = vn[0] * f0.x; vf[1] = vn[1] * f0.y; vf[2] = vn[2] * f0.z; vf[3] = vn[3] * f0.w; vf[4] = vn[4] * f1.x; vf[5] = vn[5] * f1.y; vf[6] = vn[6] * f1.z; vf[7] = vn[7] * f1.w;
            vf[8] = vn[8] * f2.x; vf[9] = vn[9] * f2.y; vf[10] = vn[10] * f2.z; vf[11] = vn[11] * f2.w; vf[12] = vn[12] * f3.x; vf[13] = vn[13] * f3.y; vf[14] = vn[14] * f3.z; vf[15] = vn[15] * f3.w;
            const bf16x8_t fb0 = PACK8(vf, 0), fb1 = PACK8(vf, 1);
            S0 = MFMA32(N00, fb0, S0); S1 = MFMA32(N10, fb0, S1); S2 = MFMA32(N20, fb0, S2); S3 = MFMA32(N30, fb0, S3);
            S0 = MFMA32(N01, fb1, S0); S1 = MFMA32(N11, fb1, S1); S2 = MFMA32(N21, fb1, S2); S3 = MFMA32(N31, fb1, S3);
            aq = MFMA32(Q0, vb0, aq); aq = MFMA32(Q1, vb1, aq);
            {
                LASP unsigned short* ost = (LASP unsigned short*)(lds + GDN_OST + (s & 1) * GDN_OST_BYTES) + 32 * w + r;
#pragma unroll
                for (int i = 0; i < 16; i += 2) { const unsigned pk = cvtpk(aq[i], aq[i + 1]); ost[crow(i, hh) * 136] = (unsigned short)pk; ost[(crow(i, hh) + 1) * 136] = (unsigned short)(pk >> 16); }
            }
            GDN_SYNC_C();
        }
    }
}

constexpr int GL_ITEM = 6272;
constexpr size_t GLA_PREP_OFF = (size_t)BATCH * 4 * 2 * NCH * GP_ITEM;

struct GlaRaw { unsigned short q[16], k[16]; };
__device__ __forceinline__ void gla_prep_load(const P& p, GlaRaw& g, int it, int lane) {
    const int r = lane & 31, hh = lane >> 5;
    const int c = it % NCH, bh = it / NCH, h = bh & 3, b = bh >> 2;
    const size_t row0 = (size_t)b * TOK + (size_t)c * GCH;
    const bf16* qb = p.rest + (row0 + 4 * hh) * NREST + RC_CQ + h * 32 + r;
#pragma unroll
    for (int i = 0; i < 16; ++i) { const int no = (i & 3) + 8 * (i >> 2); g.q[i] = qb[(size_t)no * NREST]; g.k[i] = qb[(size_t)no * NREST + 128]; }
}
__device__ __forceinline__ void gla_prep_item(const P& p, LASP unsigned char* wl, const LASP float* cstab, int l, int it, int lane, const GlaRaw& g) {
    const int r = lane & 31, hh = lane >> 5;
    const int c = it % NCH, bh = it / NCH, h = bh & 3, b = bh >> 2;
    const size_t row0 = (size_t)b * TOK + (size_t)c * GCH;
    float qv[16], kv[16];
#pragma unroll
    for (int i = 0; i < 16; ++i) { qv[i] = bf2f(g.q[i]); kv[i] = bf2f(g.k[i]); }
    if (c >= 8) {
        const int dd = r & 15, f = dd & 7;
        const int prow = (c - 8) >> 1, pcol0 = 32 * ((c - 8) & 1);
#pragma unroll
        for (int i = 0; i < 16; ++i) {
            const int n = crow(i, hh);
            const int pos = r < 16 ? prow : pcol0 + n;
            const float cs = cstab[(pos * 8 + f) * 2], sn = cstab[(pos * 8 + f) * 2 + 1];
            const float qp = __shfl_xor(qv[i], 8), kp = __shfl_xor(kv[i], 8);
            if (dd < 8) { qv[i] = qv[i] * cs - qp * sn; kv[i] = kv[i] * cs - kp * sn; }
            else { qv[i] = qp * sn + qv[i] * cs; kv[i] = kp * sn + kv[i] * cs; }
        }
    }
#pragma unroll
    for (int i = 0; i < 16; ++i) qv[i] *= 0.17677669529663687f;
#pragma unroll 1
    for (int dir = 0; dir < 2; ++dir) {
        f32x16_t X;
#pragma unroll
        for (int i = 0; i < 16; ++i) X[i] = 0.f;
        {
            const bf16x8_t A = *(const bf16x8_t*)(p.rest + (row0 + r) * NREST + RC_CR + dir * 16 + 8 * hh);
            const float* w2p = p.gla_w2 + ((size_t)(l * 2 + dir) * 16 + 8 * hh) * 128 + h * 32 + r;
            const bf16x8_t Bf = __builtin_bit_cast(bf16x8_t, (u32x4_t){cvtpk(w2p[0], w2p[128]), cvtpk(w2p[256], w2p[384]), cvtpk(w2p[512], w2p[640]), cvtpk(w2p[768], w2p[896])});
            X = MFMA32(A, Bf, X);
        }
        const float b2v = p.gla_b2[(l * 2 + dir) * 128 + h * 32 + r];
        float Bc[16];
#pragma unroll
        for (int i = 0; i < 16; ++i) { const float xg = X[i] + b2v; Bc[i] = (fminf(xg, 0.f) - 0.6931471805599453f * __builtin_amdgcn_logf(1.f + __builtin_amdgcn_exp2f(-1.4426950408889634f * fabsf(xg)))) * (1.f / 16.f); }
        float tot;
        {
            float sg[4], ps[4];
#pragma unroll
            for (int g = 0; g < 4; ++g) { sg[g] = (Bc[4 * g] + Bc[4 * g + 1]) + (Bc[4 * g + 2] + Bc[4 * g + 3]); ps[g] = __shfl_xor(sg[g], 32); }
            tot = ((sg[0] + ps[0]) + (sg[1] + ps[1])) + ((sg[2] + ps[2]) + (sg[3] + ps[3]));
            if (dir == 0) {
                float base = 0.f;
#pragma unroll
                for (int g = 0; g < 4; ++g) {
                    float o = base + (hh ? ps[g] : 0.f);
#pragma unroll
                    for (int k = 0; k < 4; ++k) { o += Bc[4 * g + k]; Bc[4 * g + k] = o; }
                    base += sg[g] + ps[g];
                }
            } else {
                float base = 0.f;
#pragma unroll
                for (int g = 3; g >= 0; --g) {
                    float o = base + (hh ? 0.f : ps[g]);
#pragma unroll
                    for (int k = 3; k >= 0; --k) { o += Bc[4 * g + k]; Bc[4 * g + k] = o; }
                    base += sg[g] + ps[g];
                }
            }
        }
        unsigned char* gout = (unsigned char*)p.raw + GLA_PREP_OFF + ((size_t)(bh * 2 + dir) * NCH + c) * GL_ITEM;
        LASP bf16* ql = (LASP bf16*)wl;
        LASP bf16* kl = ql + 32 * 40;
        {
            bf16* qpo = (bf16*)gout + perm16(r);
            bf16* kdo = (bf16*)(gout + 4096) + r * 32;
#pragma unroll
            for (int g = 0; g < 4; ++g) {
                float kd[4];
#pragma unroll
                for (int k = 0; k < 4; ++k) {
                    const int i = 4 * g + k, n = crow(i, hh);
                    const float eb = __builtin_amdgcn_exp2f(1.4426950408889634f * Bc[i]);
                    const float qs = qv[i] * eb, ks = kv[i] * __builtin_amdgcn_rcpf(eb);
                    kd[k] = kv[i] * __builtin_amdgcn_exp2f(1.4426950408889634f * (tot - Bc[i]));
                    const bf16 qsb = f2bf(qs);
                    qpo[n * 32] = qsb;
                    ql[n * 40 + r] = qsb; kl[n * 40 + r] = f2bf(ks);
                }
                *(u32x2_t*)(kdo + perm16(8 * g + 4 * hh)) = (u32x2_t){cvtpk(kd[0], kd[1]), cvtpk(kd[2], kd[3])};
            }
            if (hh == 0) ((float*)(gout + 6144))[r] = __builtin_amdgcn_exp2f(1.4426950408889634f * tot);
        }
        asm volatile("s_waitcnt lgkmcnt(0)" ::: "memory");
        f32x16_t AT;
#pragma unroll
        for (int i = 0; i < 16; ++i) AT[i] = 0.f;
        AT = MFMA32(*(const LASP bf16x8_t*)((const LASP unsigned char*)kl + r * 80 + hh * 16), *(const LASP bf16x8_t*)((const LASP unsigned char*)ql + r * 80 + hh * 16), AT);
        AT = MFMA32(*(const LASP bf16x8_t*)((const LASP unsigned char*)kl + r * 80 + hh * 16 + 32), *(const LASP bf16x8_t*)((const LASP unsigned char*)ql + r * 80 + hh * 16 + 32), AT);
        {
            bf16* amo = (bf16*)(gout + 2048) + r * 32;
#pragma unroll
            for (int g = 0; g < 4; ++g) {
                float a[4];
#pragma unroll
                for (int k = 0; k < 4; ++k) { const int m = crow(4 * g + k, hh); const bool keep = dir == 0 ? (m <= r) : (m >= r); a[k] = keep ? AT[4 * g + k] : 0.f; }
                *(u32x2_t*)(amo + perm16(8 * g + 4 * hh)) = (u32x2_t){cvtpk(a[0], a[1]), cvtpk(a[2], a[3])};
            }
        }
        asm volatile("s_waitcnt lgkmcnt(0)" ::: "memory");
    }
}

constexpr int LS_QP = 0, LS_AM = 2560, LS_KD = 5120, LS_V = 7680, LS_GL = 13824, LS_BYTES = 13952;
constexpr int GLA_OST = 4 * LS_BYTES, GLA_OST_BYTES = 32 * 144;
struct LSlot { u32x4_t a0, a1, a2, v0, v1; f32x4_t gl; };
__device__ __forceinline__ void gla_issue(const P& p, LSlot& g, int b, int h, int dir, int step, int t2) {
    const int c = gdn_chunk(dir, step);
    const unsigned char* gp = (const unsigned char*)p.raw + GLA_PREP_OFF + ((size_t)((b * 4 + h) * 2 + dir) * NCH + c) * GL_ITEM;
    g.a0 = *(const u32x4_t*)(gp + t2 * 16); g.a1 = *(const u32x4_t*)(gp + 2048 + t2 * 16); g.a2 = *(const u32x4_t*)(gp + 4096 + t2 * 16);
    g.gl = *(const f32x4_t*)(gp + 6144 + (t2 < 8 ? t2 : 0) * 16);
    const size_t row0 = (size_t)b * TOK + (size_t)c * GCH;
    const bf16* vp = p.rest + (row0 + (t2 >> 3)) * NREST + RC_CV + h * 64 + 8 * (t2 & 7);
    g.v0 = *(const u32x4_t*)vp; g.v1 = *(const u32x4_t*)(vp + (size_t)16 * NREST);
}
__device__ __forceinline__ void gla_write(LASP unsigned char* st, const LSlot& g, int t2) {
    const int row = t2 >> 2, ch = t2 & 3;
    *(LASP u32x4_t*)(st + LS_QP + row * 80 + ch * 16) = g.a0;
    *(LASP u32x4_t*)(st + LS_AM + row * 80 + ch * 16) = g.a1;
    *(LASP u32x4_t*)(st + LS_KD + row * 80 + ch * 16) = g.a2;
    if (t2 < 8) *(LASP f32x4_t*)(st + LS_GL + t2 * 16) = g.gl;
    *(LASP u32x4_t*)(st + LS_V + (t2 >> 3) * 192 + (t2 & 7) * 16) = g.v0; *(LASP u32x4_t*)(st + LS_V + (16 + (t2 >> 3)) * 192 + (t2 & 7) * 16) = g.v1;
}
__device__ __forceinline__ void gla_flush(const P& p, LASP unsigned char* lds, int b, int h, int dir, int step, int t2) {
    const int c = gdn_chunk(dir, step);
    const LASP unsigned char* ost = lds + GLA_OST + (dir * 2 + (step & 1)) * GLA_OST_BYTES;
    bf16* op = p.oc + ((size_t)dir * ROWS + (size_t)b * TOK + (size_t)c * GCH) * 256 + h * 64;
#pragma unroll
    for (int k = 0; k < 2; ++k) { const int idx = t2 + 128 * k, row = idx >> 3, ch = idx & 7; *(u32x4_t*)(op + (size_t)row * 256 + ch * 8) = *(const LASP u32x4_t*)(ost + row * 144 + ch * 16); }
}
#if TPROBE == 62
#define GLA_SYNC_C() do { unsigned long long t_ = __builtin_amdgcn_s_memrealtime(); __syncthreads(); if (bh == 0 && tid == 0) p.stats[2] += (float)(__builtin_amdgcn_s_memrealtime() - t_) * 0.01f; } while (0)
#define GLA_SYNC_L() __syncthreads()
#elif TPROBE == 63
#define GLA_SYNC_L() do { unsigned long long t_ = __builtin_amdgcn_s_memrealtime(); __syncthreads(); if (bh == 0 && tid == 256) p.stats[2] += (float)(__builtin_amdgcn_s_memrealtime() - t_) * 0.01f; } while (0)
#define GLA_SYNC_C() __syncthreads()
#else
#define GLA_SYNC_C() __syncthreads()
#define GLA_SYNC_L() __syncthreads()
#endif
__device__ void gla_scan_fast(const P& p, LASP unsigned char* lds, int bh) {
    const int tid = mk_tid();
    const int lane = tid & 63, wave = __builtin_amdgcn_readfirstlane(tid >> 6);
    const int h = bh & 3, b = bh >> 2;
    constexpr int NS = NCH;
    if (wave >= 4) {
        const int dir = (wave - 4) >> 1, t2 = tid & 127;
        LASP unsigned char* base = lds + dir * 2 * LS_BYTES;
        LSlot g0, g1, g2, g3, g4, g5, g6, g7;
        gla_issue(p, g0, b, h, dir, 0, t2); gla_issue(p, g1, b, h, dir, 1, t2); gla_issue(p, g2, b, h, dir, 2, t2); gla_issue(p, g3, b, h, dir, 3, t2);
        gla_issue(p, g4, b, h, dir, 4, t2); gla_issue(p, g5, b, h, dir, 5, t2); gla_issue(p, g6, b, h, dir, 6, t2); gla_issue(p, g7, b, h, dir, 7, t2);
        gla_write(base, g0, t2); gla_issue(p, g0, b, h, dir, 8, t2);
        __syncthreads();
        static_assert(NS % 8 == 0, "the loader loop is unrolled by its eight slots");
#define GLA_STEP(u, G) { gla_write(base + ((s + u + 1) & 1) * LS_BYTES, G, t2); gla_issue(p, G, b, h, dir, min(s + u + 9, NS - 1), t2); GLA_SYNC_L(); }
#pragma unroll 1
        for (int s = 0; s < NS; s += 8) { GLA_STEP(0, g1) GLA_STEP(1, g2) GLA_STEP(2, g3) GLA_STEP(3, g4) GLA_STEP(4, g5) GLA_STEP(5, g6) GLA_STEP(6, g7) GLA_STEP(7, g0) }
#undef GLA_STEP
    } else {
        const int r = lane & 31, hh = lane >> 5, dir = wave >> 1, blk = wave & 1;
        const int t2c = blk * 64 + lane;
        LASP unsigned char* base = lds + dir * 2 * LS_BYTES;
        f32x16_t S;
#pragma unroll
        for (int i = 0; i < 16; ++i) S[i] = 0.f;
        __syncthreads();
        const int troff = (4 * hh + ((lane & 15) >> 2)) * 192 + (16 * ((lane >> 4) & 1) + 4 * (lane & 3)) * 2 + 64 * blk;
#define TRFRAG192(bs) __builtin_shufflevector(trd(bs), trd((bs) + 8 * 192), 0, 1, 2, 3, 4, 5, 6, 7)
#pragma unroll 1
        for (int s = 0; s < NS; ++s) {
            const LASP unsigned char* st = base + (s & 1) * LS_BYTES;
#if TPROBE == 64 || TPROBE == 65
            const unsigned long long ttop_ = __builtin_amdgcn_s_memrealtime();
            __builtin_amdgcn_sched_barrier(0);
#endif
            const LASP unsigned char* qp = st + LS_QP + r * 80 + hh * 16;
            const LASP unsigned char* am = st + LS_AM + r * 80 + hh * 16;
            const LASP unsigned char* kd = st + LS_KD + r * 80 + hh * 16;
            const bf16x8_t QP0 = *(const LASP bf16x8_t*)(qp), QP1 = *(const LASP bf16x8_t*)(qp + 32);
            const bf16x8_t AM0 = *(const LASP bf16x8_t*)(am), AM1 = *(const LASP bf16x8_t*)(am + 32);
            const bf16x8_t KD0 = *(const LASP bf16x8_t*)(kd), KD1 = *(const LASP bf16x8_t*)(kd + 32);
            const LASP unsigned char* vb = st + LS_V + troff;
            const bf16x8_t V0 = TRFRAG192(vb), V1 = TRFRAG192(vb + 16 * 192);
            const LASP float* glp = (const LASP float*)(st + LS_GL);
            const f32x4_t g0 = *(const LASP f32x4_t*)(glp + 4 * hh), g1 = *(const LASP f32x4_t*)(glp + 8 + 4 * hh), g2 = *(const LASP f32x4_t*)(glp + 16 + 4 * hh), g3 = *(const LASP f32x4_t*)(glp + 24 + 4 * hh);
            if (s > 0) gla_flush(p, lds, b, h, dir, s - 1, t2c);
            __builtin_amdgcn_sched_barrier(0);
#if TPROBE == 64 || TPROBE == 65
            asm volatile("s_waitcnt lgkmcnt(0)" ::: "memory");
            const unsigned long long tmid_ = __builtin_amdgcn_s_memrealtime();
            if (TPROBE == 64 && bh == 0 && tid == 0) p.stats[2] += (float)(tmid_ - ttop_) * 0.01f;
            __builtin_amdgcn_sched_barrier(0);
#endif
            const bf16x8_t Sb0 = PACK8(S, 0), Sb1 = PACK8(S, 1);
            f32x16_t oT;
#pragma unroll
            for (int i = 0; i < 16; ++i) oT[i] = 0.f;
            oT = MFMA32(V0, AM0, oT); oT = MFMA32(V1, AM1, oT);
            oT = MFMA32(Sb0, QP0, oT); oT = MFMA32(Sb1, QP1, oT);
            S[0] *= g0.x; S[1] *= g0.y; S[2] *= g0.z; S[3] *= g0.w; S[4] *= g1.x; S[5] *= g1.y; S[6] *= g1.z; S[7] *= g1.w;
            S[8] *= g2.x; S[9] *= g2.y; S[10] *= g2.z; S[11] *= g2.w; S[12] *= g3.x; S[13] *= g3.y; S[14] *= g3.z; S[15] *= g3.w;
            S = MFMA32(KD0, V0, S);
            S = MFMA32(KD1, V1, S);
            {
                LASP unsigned char* ost = lds + GLA_OST + (dir * 2 + (s & 1)) * GLA_OST_BYTES + r * 144 + (32 * blk + 4 * hh) * 2;
#pragma unroll
                for (int g = 0; g < 4; ++g) *(LASP u32x2_t*)(ost + 16 * g) = (u32x2_t){cvtpk(oT[4 * g], oT[4 * g + 1]), cvtpk(oT[4 * g + 2], oT[4 * g + 3])};
            }
#if TPROBE == 65
            __builtin_amdgcn_sched_barrier(0);
            asm volatile("s_nop 15\n\ts_nop 15" ::: "memory");
            if (bh == 0 && tid == 0) p.stats[2] += (float)(__builtin_amdgcn_s_memrealtime() - tmid_) * 0.01f;
#endif
            GLA_SYNC_C();
        }
        gla_flush(p, lds, b, h, dir, NS - 1, t2c);
    }
}


__device__ __forceinline__ void vf_items(const P& p, LASP unsigned char* wl, int it0, int stride, int lane) {
    const int r = lane & 31, hh = lane >> 5;
    constexpr int NIT = BATCH * 4 * NCH;
    u32x4_t ld[3][4];
#pragma unroll
    for (int k = 0; k < 3; ++k) {
        const int it = it0 + k * stride;
        if (it < NIT) {
            const int kb = it % NCH, bh = it / NCH, h = bh & 3, b = bh >> 2;
            const bf16* vp = p.rest + ((size_t)b * TOK + 32 * kb + r) * NREST + RC_BV + h * 64 + 32 * hh;
#pragma unroll
            for (int q = 0; q < 4; ++q) ld[k][q] = *(const u32x4_t*)(vp + 8 * q);
        }
    }
#pragma unroll
    for (int k = 0; k < 3; ++k) {
        const int it = it0 + k * stride;
        if (it < NIT) {
#pragma unroll
            for (int q = 0; q < 4; ++q) *(LASP u32x4_t*)(wl + k * 5120 + r * 160 + (32 * hh + 8 * q) * 2) = ld[k][q];
        }
    }
    asm volatile("s_waitcnt lgkmcnt(0)" ::: "memory");
    const int troff = (4 * hh + ((lane & 15) >> 2)) * 160 + (16 * ((lane >> 4) & 1) + 4 * (lane & 3)) * 2;
#pragma unroll
    for (int k = 0; k < 3; ++k) {
        const int it = it0 + k * stride;
        if (it < NIT) {
            const int kb = it % NCH, bh = it / NCH;
            bf16* op = p.vf + ((size_t)(bh * NCH + kb) * 4) * 512 + lane * 8;
#pragma unroll
            for (int dvb = 0; dvb < 2; ++dvb)
#pragma unroll
                for (int u = 0; u < 2; ++u) {
                    const LASP unsigned char* bs = wl + k * 5120 + troff + 64 * dvb + (16 * u) * 160;
                    const bf16x8_t f = __builtin_shufflevector(trd(bs), trd(bs + 8 * 160), 0, 1, 2, 3, 4, 5, 6, 7);
                    *(bf16x8_t*)(op + (dvb * 2 + u) * 512) = f;
                }
        }
    }
    asm volatile("s_waitcnt lgkmcnt(0)" ::: "memory");
}

__device__ __forceinline__ void na_item(const P& p, const LASP float* rpbL, int it, int lane) {
    const int r = lane & 31, hh = lane >> 5;
    int b, h, ry, qb; bool lat;
    if (it < 4096) { lat = true; qb = it & 1; ry = (it >> 1) & 63; h = (it >> 7) & 3; b = it >> 9; }
    else { const int j = it - 4096; lat = false; qb = j & 7; h = (j >> 3) & 3; b = j >> 5; ry = 0; }
    const size_t brow = (size_t)b * TOK;
    const int q0 = lat ? CTX + ry * 64 + qb * 32 : qb * 32;
    bf16* qp = p.rest + (brow + q0 + r) * NREST + RC_BQ + h * 64;
    bf16x8_t Qf0 = *(const bf16x8_t*)(qp + 8 * hh), Qf1 = *(const bf16x8_t*)(qp + 16 + 8 * hh), Qf2 = *(const bf16x8_t*)(qp + 32 + 8 * hh), Qf3 = *(const bf16x8_t*)(qp + 48 + 8 * hh);
    f32x16_t O0, O1;
#pragma unroll
    for (int i = 0; i < 16; ++i) { O0[i] = 0.f; O1[i] = 0.f; }
    float m = -1e30f, lsum = 0.f;
    const bf16* kfb = p.kf + ((size_t)(b * 4 + h) * NCH) * 2048 + lane * 8;
    const bf16* vfb = p.vf + ((size_t)(b * 4 + h) * NCH) * 2048 + lane * 8;
    const int nkb = lat ? 24 : 8;
    const int c = qb * 32 + r, c0 = min(max(c - 8, 0), 48), r0 = min(max(ry - 4, 0), 56);
    constexpr float SC = 0.125f * 1.4426950408889634f;
    struct KV { bf16x8_t k0, k1, k2, k3, v00, v01, v10, v11; };
    KV fA, fB;
#define NA_KBIDX(kq) ((kq) < 8 ? (kq) : 8 + (r0 + (((kq) - 8) >> 1)) * 2 + (((kq) - 8) & 1))
#define NA_LOAD(F, kq) { const size_t o_ = (size_t)NA_KBIDX(min((kq), nkb - 1)) * 2048; const bf16* kp = kfb + o_; const bf16* vp = vfb + o_; \
        F.k0 = *(const bf16x8_t*)(kp); F.k1 = *(const bf16x8_t*)(kp + 512); F.k2 = *(const bf16x8_t*)(kp + 1024); F.k3 = *(const bf16x8_t*)(kp + 1536); \
        F.v00 = *(const bf16x8_t*)(vp); F.v01 = *(const bf16x8_t*)(vp + 512); F.v10 = *(const bf16x8_t*)(vp + 1024); F.v11 = *(const bf16x8_t*)(vp + 1536); }
    NA_LOAD(fA, 0) NA_LOAD(fB, 1)
#define NA_BLOCK(F, kq) { \
        const int kb_ = (kq); int ky = 0, cb = 0; const bool win = kb_ >= 8; \
        if (win) { const int w_ = kb_ - 8; ky = r0 + (w_ >> 1); cb = w_ & 1; } \
        f32x16_t S; _Pragma("unroll") for (int i = 0; i < 16; ++i) S[i] = 0.f; \
        S = MFMA32(F.k0, Qf0, S); S = MFMA32(F.k1, Qf1, S); S = MFMA32(F.k2, Qf2, S); S = MFMA32(F.k3, Qf3, S); \
        const bf16x8_t V00 = F.v00, V01 = F.v01, V10 = F.v10, V11 = F.v11; \
        NA_LOAD(F, kb_ + 2) \
        float bm = -1e30f; \
        if (win) { \
            const LASP float* rb = rpbL + (h * 15 + (ky - ry + 7)) * 31 + 15 - c; \
            _Pragma("unroll") for (int i = 0; i < 16; ++i) { \
                const int kc = cb * 32 + crow(i, hh); \
                const bool valid = (kc >= c0) && (kc < c0 + 16); \
                const float bias = rb[valid ? kc : c]; \
                S[i] = valid ? S[i] * SC + bias : -1e30f; \
                bm = fmaxf(bm, S[i]); } \
        } else { _Pragma("unroll") for (int i = 0; i < 16; ++i) { S[i] *= SC; bm = fmaxf(bm, S[i]); } } \
        bm = fmaxf(bm, __shfl_xor(bm, 32)); \
        const float mn = fmaxf(m, bm); \
        float ps = 0.f; \
        _Pragma("unroll") for (int i = 0; i < 16; ++i) { S[i] = __builtin_amdgcn_exp2f(S[i] - mn); ps += S[i]; } \
        if (__builtin_amdgcn_ballot_w64(bm > m) != 0ull) {        \
            const float alpha = __builtin_amdgcn_exp2f(m - mn); \
            lsum *= alpha; \
            _Pragma("unroll") for (int i = 0; i < 16; ++i) { O0[i] *= alpha; O1[i] *= alpha; } \
        } \
        m = mn; \
        lsum += ps; \
        const bf16x8_t Pb0 = PACK8(S, 0), Pb1 = PACK8(S, 1); \
        O0 = MFMA32(V00, Pb0, O0); O0 = MFMA32(V01, Pb1, O0); \
        O1 = MFMA32(V10, Pb0, O1); O1 = MFMA32(V11, Pb1, O1); }
#pragma unroll 1
    for (int kb = 0; kb < nkb; kb += 2) { NA_BLOCK(fA, kb) NA_BLOCK(fB, kb + 1) }
#undef NA_BLOCK
#undef NA_LOAD
#undef NA_KBIDX
    const float inv = 1.f / (lsum + __shfl_xor(lsum, 32));
    bf16* op = qp + 4 * hh;
#pragma unroll
    for (int g = 0; g < 4; ++g) {
        *(u32x2_t*)(op + 8 * g) = (u32x2_t){cvtpk(O0[4 * g] * inv, O0[4 * g + 1] * inv), cvtpk(O0[4 * g + 2] * inv, O0[4 * g + 3] * inv)};
        *(u32x2_t*)(op + 32 + 8 * g) = (u32x2_t){cvtpk(O1[4 * g] * inv, O1[4 * g + 1] * inv), cvtpk(O1[4 * g + 2] * inv, O1[4 * g + 3] * inv)};
    }
}

__device__ void ph_prep_early(const P& p, LASP unsigned char* lds, int l, int bid, int nblk) {
    const int tid = mk_tid();
    const int lane = tid & 63, wave = tid >> 6;
    for (int it0 = bid * NWAVES + wave; it0 < BATCH * 4 * NCH; it0 += 3 * nblk * NWAVES) vf_items(p, lds + wave * 16384, it0, nblk * NWAVES, lane);
}
constexpr int GLA_EARLY = 1280;
__device__ __forceinline__ void gla_cstab(const P& p, LASP float* cstab, int tid) {
    const f32x2_t v = *(const f32x2_t*)(p.cst + tid * 2);
    cstab[tid * 2] = v.x; cstab[tid * 2 + 1] = v.y;
}
__device__ void ph_prep(const P& p, LASP unsigned char* lds, int l, int bid, int nblk) {
    const int tid = mk_tid();
    LASP float* cstab = (LASP float*)(lds + 131072);
    gla_cstab(p, cstab, tid);
    __syncthreads();
    ph_gdnprep(p, lds, l, bid, nblk, tid);
    const int tid2 = mk_tid();
    const int lane = tid2 & 63, wave = tid2 >> 6;
    const int it = (bid - 32) * NWAVES + wave;
    if (it >= 0 && it < GLA_EARLY) { GlaRaw g; gla_prep_load(p, g, it, lane); gla_prep_item(p, lds + wave * 16384, cstab, l, it, lane, g); }
}
__device__ void ph_glaprep(const P& p, LASP unsigned char* lds, int l, int sb, int ns) {
    const int tid = mk_tid();
    LASP float* cstab = (LASP float*)(lds + 131072);
    gla_cstab(p, cstab, tid);
    __syncthreads();
    const int lane = tid & 63, wave = tid >> 6;
    const int NIT = BATCH * 4 * NCH, st = ns * NWAVES;
    for (int it = GLA_EARLY + sb * NWAVES + wave; it < NIT; it += 2 * st) {
        GlaRaw g0, g1;
        gla_prep_load(p, g0, it, lane);
        const bool two = it + st < NIT;
        if (two) gla_prep_load(p, g1, it + st, lane);
        gla_prep_item(p, lds + wave * 16384, cstab, l, it, lane, g0);
        if (two) gla_prep_item(p, lds + wave * 16384, cstab, l, it + st, lane, g1);
    }
}

constexpr int NGDN_BLOCKS = BATCH * 4 * 2;
__device__ void ph_mix(const P& p, LASP unsigned char* lds, int l, int bid, int nblk) {
    constexpr int NGDN = NGDN_BLOCKS;
    constexpr int NGLA = BATCH * 4;
    if (bid < NGDN) { gdn_scan_fast(p, lds, bid); return; }
    if (bid < NGDN + NGLA) { gla_scan_fast(p, lds, bid - NGDN); return; }
    const int tid = mk_tid();
    const int lane = tid & 63, wave = tid >> 6;
    LASP float* rpbL = (LASP float*)lds;
    for (int i = tid; i < 4 * 15 * 31; i += NTHREADS) rpbL[i] = p.rpb[(size_t)l * 4 * 15 * 31 + i] * 1.4426950408889634f;
    __syncthreads();
    const int total = 4096 + (l == 0 ? 256 : 0);
    const int nb = bid - NGDN - NGLA;
    const int nna = nblk - NGDN - NGLA, vb = nna == 160 ? (nb & 7) * 20 + (nb >> 3) : nb;
    for (int it = vb * NWAVES + wave; it < total; it += nna * NWAVES) na_item(p, rpbL, it, lane);
}

__device__ void ph_gate(const P& p, int l, int bid, int nblk) {
    const int tid = mk_tid();
    const int tq = tid & 127, rsub = tid >> 7;
    const int kind = tq < 64 ? 0 : (tq < 96 ? 1 : 2);
    const int cb = kind == 0 ? tq * 8 : (kind == 1 ? (tq - 64) * 8 : (tq - 96) * 8);
    const int zoff = kind == 0 ? RC_AZ + cb : (kind == 1 ? RC_BZ + cb : RC_CZ + cb);
    const int oc = kind == 0 ? cb : (kind == 1 ? 512 + cb : 768 + cb);
    float nw[8];
#pragma unroll
    for (int e = 0; e < 8; ++e) nw[e] = kind == 0 ? p.gdn_norm[l * 128 + ((cb + e) & 127)] : (kind == 2 ? p.gla_norm[l * 64 + ((cb + e) & 63)] : 1.f);
    const bool lat = l == 1;
    const int ngrp = lat ? BATCH * SEQ / 16 : ROWS / 16, nfull = ngrp / nblk, nrem = ngrp - nfull * nblk;
    const bool halves = 2 * nrem == nblk;
    for (int k = 0; k < nfull + 1; ++k) {
        int g = k * nblk + bid, nj = 4, sub = 0;
        if (k == nfull) {
            if (halves) { g = nfull * nblk + (bid >> 1); sub = 8 * (bid & 1); nj = 2; }
            else if (bid >= nrem) break;
        }
        const int r0 = (lat ? (g / (SEQ / 16)) * (TOK / 16) + CTX / 16 + g % (SEQ / 16) : g) * 16 + sub;
        uint4 a[4], bb[4], zz[4];
#pragma unroll
        for (int j = 0; j < 4; ++j) if (j < nj) {
            const size_t r = (size_t)(r0 + rsub + 4 * j);
            const bf16* pr = p.rest + r * NREST;
            zz[j] = *(const uint4*)(pr + zoff);
            if (kind == 0) { a[j] = *(const uint4*)(p.oa + r * 512 + cb); bb[j] = *(const uint4*)(p.oa + ((size_t)ROWS + r) * 512 + cb); }
            else if (kind == 1) { a[j] = *(const uint4*)(pr + RC_BQ + cb); bb[j] = make_uint4(0, 0, 0, 0); }
            else { a[j] = *(const uint4*)(p.oc + r * 256 + cb); bb[j] = *(const uint4*)(p.oc + ((size_t)ROWS + r) * 256 + cb); }
        }
#pragma unroll
        for (int j = 0; j < 4; ++j) if (j < nj) {
            float fa[8], fb[8], z[8], o[8];
            unpack8(a[j], fa); unpack8(bb[j], fb); unpack8(zz[j], z);
            float ss = 0.f;
#pragma unroll
            for (int e = 0; e < 8; ++e) { o[e] = fa[e] + fb[e]; ss += o[e] * o[e]; }
            float rs = 1.f;
            if (kind == 0) {
#pragma unroll
                for (int m = 8; m > 0; m >>= 1) ss += __shfl_xor(ss, m);
                rs = __builtin_amdgcn_rsqf(ss * (1.f / 128.f) + 1e-6f);
            } else if (kind == 2) {
#pragma unroll
                for (int m = 4; m > 0; m >>= 1) ss += __shfl_xor(ss, m);
                rs = __builtin_amdgcn_rsqf(ss * (1.f / 64.f) + 1e-6f);
            }
            float res[8];
#pragma unroll
            for (int e = 0; e < 8; ++e) res[e] = o[e] * rs * nw[e] * silu_f(z[e]);
            uint4 w; w.x = pk2(res[0], res[1]); w.y = pk2(res[2], res[3]); w.z = pk2(res[4], res[5]); w.w = pk2(res[6], res[7]);
            *(uint4*)(p.mix + (size_t)(r0 + rsub + 4 * j) * D + oc) = w;
        }
    }
}

#if PROBE
__device__ void gdn_scan_naive(const P& p, LASP float* sm, int l, int b, int hp, bf16* nb) {
    const int tid = mk_tid();
    LASP float* skq = sm;
    LASP float* sv = sm + 4 * 16 * 256;
    LASP float* sg = sv + 4 * 16 * 128;
    LASP float* sb = sg + 64;
    const int sub = tid >> 7, col = tid & 127, dir = sub & 1, h = hp * 2 + (sub >> 1);
    float S[128];
#pragma unroll
    for (int i = 0; i < 128; ++i) S[i] = 0.f;
    for (int s0 = 0; s0 < TOK; s0 += 16) {
        __syncthreads();
        for (int i = tid; i < 4 * 16 * 48; i += NTHREADS) {
            const int su = i / (16 * 48), rem = i % (16 * 48), j = rem / 48, chunk = rem % 48;
            const int sd = su & 1, hh = hp * 2 + (su >> 1);
            const int t = tok_of(sd, s0 + j);
            const size_t row = (size_t)b * TOK + t;
            const int part = chunk >> 4, c8 = chunk & 15;
            const uint4 w = *(const uint4*)(p.qkvn + row * NRAW + part * 512 + hh * 128 + c8 * 8);
            float f[8]; unpack8(w, f);
            LASP float* dst = (part < 2) ? skq + (su * 16 + j) * 256 + part * 128 + c8 * 8 : sv + (su * 16 + j) * 128 + c8 * 8;
#pragma unroll
            for (int e = 0; e < 8; ++e) dst[e] = f[e];
        }
        if (tid < 64) {
            const int su = tid >> 4, j = tid & 15, sd = su & 1, hh = hp * 2 + (su >> 1);
            const int t = tok_of(sd, s0 + j);
            const bf16* ab = p.rest + ((size_t)b * TOK + t) * NREST + RC_AB;
            const float a = bf2f(ab[sd * 4 + hh]) + p.dt_bias[(l * 2 + sd) * 4 + hh];
            const float sp = fmaxf(a, 0.f) + log1pf(expf(-fabsf(a)));
            const float g = -expf(p.a_log[(l * 2 + sd) * 4 + hh]) * sp;
            sg[su * 16 + j] = expf(g);
            const float bx = bf2f(ab[(2 + sd) * 4 + hh]);
            sb[su * 16 + j] = 1.f / (1.f + expf(-bx));
        }
        __syncthreads();
#pragma unroll 1
        for (int j = 0; j < 16; ++j) {
            const LASP float* qp = skq + (sub * 16 + j) * 256;
            const LASP float* kp = qp + 128;
            const float dec = sg[sub * 16 + j], bt = sb[sub * 16 + j];
            const float v = sv[(sub * 16 + j) * 128 + col];
            float d0 = 0.f, d1 = 0.f, d2 = 0.f, d3 = 0.f;
#pragma unroll
            for (int k4 = 0; k4 < 32; ++k4) {
                const f32x4_t kv = *(const LASP f32x4_t*)(kp + k4 * 4);
                d0 += S[k4 * 4] * kv.x; d1 += S[k4 * 4 + 1] * kv.y; d2 += S[k4 * 4 + 2] * kv.z; d3 += S[k4 * 4 + 3] * kv.w;
                if ((k4 & 7) == 7) __builtin_amdgcn_sched_barrier(0);
            }
            const float dot = (d0 + d1) + (d2 + d3);
            const float vn = bt * (v - dec * dot);
            float o0 = 0.f, o1 = 0.f, o2 = 0.f, o3 = 0.f;
#pragma unroll
            for (int k4 = 0; k4 < 32; ++k4) {
                const f32x4_t kv = *(const LASP f32x4_t*)(kp + k4 * 4);
                const f32x4_t qv = *(const LASP f32x4_t*)(qp + k4 * 4);
                S[k4 * 4] = dec * S[k4 * 4] + kv.x * vn; o0 += S[k4 * 4] * qv.x;
                S[k4 * 4 + 1] = dec * S[k4 * 4 + 1] + kv.y * vn; o1 += S[k4 * 4 + 1] * qv.y;
                S[k4 * 4 + 2] = dec * S[k4 * 4 + 2] + kv.z * vn; o2 += S[k4 * 4 + 2] * qv.z;
                S[k4 * 4 + 3] = dec * S[k4 * 4 + 3] + kv.w * vn; o3 += S[k4 * 4 + 3] * qv.w;
                if ((k4 & 3) == 3) __builtin_amdgcn_sched_barrier(0);
            }
            const int t = tok_of(dir, s0 + j);
            nb[((size_t)dir * TOK + t) * 256 + (h & 1) * 128 + col] = f2bf((o0 + o1) + (o2 + o3));
        }
    }
    __syncthreads();
}

__device__ void gla_scan_naive(const P& p, LASP float* sm, int l, int b, bf16* nb) {
    const int tid = mk_tid();
    LASP float* sq = sm;
    LASP float* sv = sm + 8 * 16 * 96;
    const int grp = tid >> 6, lane = tid & 63, h = grp >> 1, dir = grp & 1;
    const int d = lane & 31, par = lane >> 5;
    float w2c[16];
#pragma unroll
    for (int j = 0; j < 16; ++j) w2c[j] = p.gla_w2[((size_t)(l * 2 + dir) * 16 + j) * 128 + h * 32 + d];
    const float b2v = p.gla_b2[(l * 2 + dir) * 128 + h * 32 + d];
    const int dd = d & 15, f = dd & 7;
    const float inv = powf(10000.f, -(float)f / 8.f);
    const int pd = dd < 8 ? d + 8 : d - 8;
    float S[32];
#pragma unroll
    for (int i = 0; i < 32; ++i) S[i] = 0.f;
    for (int s0 = 0; s0 < TOK; s0 += 16) {
        __syncthreads();
#pragma unroll 1
        for (int jj = 0; jj < 8; ++jj) {
            const int j = par + 2 * jj;
            const int t = tok_of(dir, s0 + j);
            const bf16* base = p.rest + ((size_t)b * TOK + t) * NREST;
            float qv = bf2f(base[RC_CQ + h * 32 + d]), kv = bf2f(base[RC_CK + h * 32 + d]);
            if (t >= CTX) {
                const int pidx = t - CTX;
                const int pos = d < 16 ? (pidx >> 6) : (pidx & 63);
                const float ang = (float)pos * inv;
                const float cs = cosf(ang), sn = sinf(ang);
                const float qp = bf2f(base[RC_CQ + h * 32 + pd]), kp = bf2f(base[RC_CK + h * 32 + pd]);
                if (dd < 8) { qv = qv * cs - qp * sn; kv = kv * cs - kp * sn; }
                else { qv = qp * sn + qv * cs; kv = kp * sn + kv * cs; }
            }
            qv *= 0.17677669529663687f;
            float xg = b2v;
#pragma unroll
            for (int jr = 0; jr < 16; ++jr) xg += bf2f(base[RC_CR + dir * 16 + jr]) * w2c[jr];
            const float ls = fminf(xg, 0.f) - log1pf(expf(-fabsf(xg)));
            LASP float* dst = sq + (grp * 16 + j) * 96;
            dst[d] = qv; dst[32 + d] = kv; dst[64 + d] = expf(ls * (1.f / 16.f));
        }
        for (int i = lane; i < 16 * 64; i += 64) {
            const int j = i >> 6, c = i & 63;
            const int t = tok_of(dir, s0 + j);
            sv[(grp * 16 + j) * 64 + c] = bf2f(p.rest[((size_t)b * TOK + t) * NREST + RC_CV + h * 64 + c]);
        }
        __syncthreads();
#pragma unroll 1
        for (int j = 0; j < 16; ++j) {
            const LASP float* qp = sq + (grp * 16 + j) * 96;
            const LASP float* kp = qp + 32;
            const LASP float* dp = qp + 64;
            const float v = sv[(grp * 16 + j) * 64 + lane];
            float o0 = 0.f, o1 = 0.f;
#pragma unroll
            for (int e = 0; e < 32; e += 2) {
                S[e] = dp[e] * S[e] + kp[e] * v; o0 += S[e] * qp[e];
                S[e + 1] = dp[e + 1] * S[e + 1] + kp[e + 1] * v; o1 += S[e + 1] * qp[e + 1];
            }
            const int t = tok_of(dir, s0 + j);
            nb[((size_t)dir * TOK + t) * 256 + h * 64 + lane] = f2bf(o0 + o1);
        }
    }
    __syncthreads();
}

__device__ void na_query_naive(const P& p, LASP float* sm, int l, int b, int t0, bf16* nb) {
    const int tid = mk_tid();
    const int wave = tid >> 6, lane = tid & 63, h = wave & 3, t = t0 + (wave >> 2);
    LASP float* pw = sm + wave * 384;
    const size_t rowq = (size_t)b * TOK + t;
    float qv[64];
    {
        const bf16* qs = p.rest + rowq * NREST + RC_BQ + h * 64;
#pragma unroll
        for (int i = 0; i < 8; ++i) {
            float f[8]; unpack8(*(const uint4*)(qs + i * 8), f);
#pragma unroll
            for (int e = 0; e < 8; ++e) qv[i * 8 + e] = f[e] * 0.125f;
        }
    }
    const bool lat = t >= CTX;
    const int nk = lat ? 384 : 256;
    int r = 0, c = 0, r0 = 0, c0 = 0;
    if (lat) { int pi = t - CTX; r = pi >> 6; c = pi & 63; r0 = min(max(r - 4, 0), 56); c0 = min(max(c - 8, 0), 48); }
    float m = -1e30f;
    __syncthreads();
#pragma unroll 1
    for (int j = 0; j < 6; ++j) {
        const int idx = lane + 64 * j;
        float s = -1e30f;
        if (idx < nk) {
            int tk; float bias = 0.f;
            if (lat && idx < 128) {
                const int i = idx >> 4, kc = c0 + (idx & 15);
                tk = CTX + (r0 + i) * 64 + kc;
                bias = p.rpb[((size_t)(l * 4 + h) * 15 + (r0 + i - r + 7)) * 31 + (kc - c + 15)];
            } else tk = lat ? idx - 128 : idx;
            const bf16* ks = p.kf + (((size_t)(b * 4 + h) * NCH + (tk >> 5)) * 4 * 64 + (tk & 31)) * 8;
            float d0 = 0.f, d1 = 0.f;
#pragma unroll
            for (int i = 0; i < 8; ++i) {
                float f[8]; unpack8(*(const uint4*)(ks + ((i >> 1) * 64 + (i & 1) * 32) * 8), f);
#pragma unroll
                for (int e = 0; e < 8; e += 2) { d0 += qv[i * 8 + e] * f[e]; d1 += qv[i * 8 + e + 1] * f[e + 1]; }
            }
            s = d0 + d1 + bias;
        }
        pw[idx] = s;
        m = fmaxf(m, s);
    }
    m = wave_max(m);
    float sum = 0.f;
#pragma unroll 1
    for (int j = 0; j < 6; ++j) { const float e = expf(pw[lane + 64 * j] - m); pw[lane + 64 * j] = e; sum += e; }
    sum = wave_sum(sum);
    const float inv = 1.f / sum;
    __syncthreads();
    float o0 = 0.f, o1 = 0.f;
    for (int idx = 0; idx < nk; idx += 2) {
        int tk0;
        if (lat && idx < 128) tk0 = CTX + (r0 + (idx >> 4)) * 64 + c0 + (idx & 15);
        else tk0 = lat ? idx - 128 : idx;
        o0 += pw[idx] * bf2f(p.rest[((size_t)b * TOK + tk0) * NREST + RC_BV + h * 64 + lane]);
        o1 += pw[idx + 1] * bf2f(p.rest[((size_t)b * TOK + tk0 + 1) * NREST + RC_BV + h * 64 + lane]);
    }
    nb[(size_t)t * 256 + h * 64 + lane] = f2bf((o0 + o1) * inv);
}


__device__ void ph_probe_naive(const P& p, LASP float* sm, int l, int bid, int nblk) {
    bf16* nb = (bf16*)p.xc1;
    if (PROBE == 1) { if (bid == 0) gdn_scan_naive(p, sm, l, 0, 0, nb); }
    else if (PROBE == 3) { if (bid == 0) gla_scan_naive(p, sm, l, 0, nb); }
    else { for (int it = bid; it < TOK / 2; it += nblk) na_query_naive(p, sm, l, 0, it * 2, nb); }
}
__device__ void ph_probe_cmp(const P& p, int bid, int nblk) {
    const int tid = mk_tid();
    const bf16* nb = (const bf16*)p.xc1;
    float md = 0.f, mr = 0.f;
    const int n = (PROBE == 2) ? TOK * 256 : 2 * TOK * 256;
    for (int i = bid * NTHREADS + tid; i < n; i += nblk * NTHREADS) {
        float a, r = bf2f(nb[i]);
        if (PROBE == 1) { const int dir = i / (TOK * 256), rem = i % (TOK * 256), t = rem >> 8, c = rem & 255; a = bf2f(p.oa[((size_t)dir * ROWS + t) * 512 + c]); }
        else if (PROBE == 3) { const int dir = i / (TOK * 256), rem = i % (TOK * 256); a = bf2f(p.oc[(size_t)dir * ROWS * 256 + rem]); }
        else { const int t = i >> 8, c = i & 255; a = bf2f(p.rest[(size_t)t * NREST + RC_BQ + c]); }
        md = fmaxf(md, fabsf(a - r)); mr = fmaxf(mr, fabsf(r));
    }
    md = wave_max(md); mr = wave_max(mr);
    if ((tid & 63) == 0) { atomicMax((unsigned*)p.stats, __float_as_uint(md)); atomicMax((unsigned*)p.stats + 1, __float_as_uint(mr)); }
}
#endif

#define XB_TMO      128
#define XB_XCNT(j)  (256  + 64 * (j))
#define XB_XSUB(j)  (1280 + 64 * (j))
#define XB_XGEN(j)  (2304 + 64 * (j))
#define XB_TOP      3328
#define XB_TOPGEN   3392
#define XCD_BAR_WORDS 3456
#define XB_SPIN_CAP (1u << 18)

__device__ __forceinline__ unsigned xb_ld(unsigned* p)              { return __hip_atomic_load(p, __ATOMIC_RELAXED, __HIP_MEMORY_SCOPE_AGENT); }
__device__ __forceinline__ unsigned xb_add(unsigned* p, unsigned v) { return __hip_atomic_fetch_add(p, v, __ATOMIC_RELAXED, __HIP_MEMORY_SCOPE_AGENT); }
__device__ __forceinline__ unsigned xb_xcc_id() { return (unsigned)__builtin_amdgcn_s_getreg((3 << 11) | 20) & 0xFu; }
#define XB_SPIN(cond, bar) do { unsigned _sp = 0; while (cond) { __builtin_amdgcn_s_sleep(1); \
    if ((++_sp & 255u) == 0u) { if (xb_ld(&(bar)[XB_TMO])) break; if (_sp > XB_SPIN_CAP) { atomicAdd(&(bar)[XB_TMO], 1u); break; } } } } while (0)

struct XcdBarrier {
    unsigned* bar; unsigned x; unsigned G;
    volatile LASP unsigned* st;
};

__device__ __forceinline__ XcdBarrier xcd_barrier_post(unsigned* bar, volatile LASP unsigned* st) {
    XcdBarrier b; b.bar = bar; b.x = xb_xcc_id(); b.st = st; b.G = gridDim.x;
    if ((int)threadIdx.x == 0) (void)xb_add(&bar[XB_XCNT(b.x)], 1u);
    return b;
}
__device__ __forceinline__ void xcd_barrier_complete(unsigned* bar, unsigned x, unsigned& nloc, unsigned& nx, unsigned G) {
    unsigned sum, cnt, mine, sp = 0u;
    for (;;) {
        sum = 0u; cnt = 0u; mine = 0u;
#pragma unroll
        for (unsigned j = 0; j < 16; ++j) { const unsigned c = xb_ld(&bar[XB_XCNT(j)]); sum += c; cnt += (c > 0u) ? 1u : 0u; mine = (j == x) ? c : mine; }
        if (sum == G) break;
        __builtin_amdgcn_s_sleep(1);
        if ((++sp & 255u) == 0u) { if (xb_ld(&bar[XB_TMO])) break; if (sp > XB_SPIN_CAP) { atomicAdd(&bar[XB_TMO], 1u); break; } }
    }
    nloc = mine > 0u ? mine : 1u; nx = cnt > 0u ? cnt : 1u;
}

__device__ __forceinline__ void xcd_barrier(const XcdBarrier& b) {
    asm volatile("s_waitcnt vmcnt(0)" ::: "memory");
    __syncthreads();
    if ((int)threadIdx.x == 0) {
        unsigned* bar = b.bar;
        __builtin_amdgcn_s_waitcnt(0);
        unsigned nloc = b.st[0], nx = b.st[1];
        if (nloc == 0u) { xcd_barrier_complete(bar, b.x, nloc, nx, b.G); b.st[0] = nloc; b.st[1] = nx; }
        const unsigned old = xb_add(&bar[XB_XSUB(b.x)], 1u);
        const unsigned gen = old / nloc;
        if (old + 1u == (gen + 1u) * nloc) {
            __builtin_amdgcn_fence(__ATOMIC_RELEASE, "agent");
            asm volatile("s_waitcnt vmcnt(0)" ::: "memory");
            const unsigned og = xb_add(&bar[XB_TOP], 1u);
            const unsigned tg = og / nx;
            if (og + 1u == (tg + 1u) * nx) xb_add(&bar[XB_TOPGEN], 1u);
            else XB_SPIN(xb_ld(&bar[XB_TOPGEN]) == tg, bar);
            __builtin_amdgcn_fence(__ATOMIC_ACQUIRE, "agent");
            xb_add(&bar[XB_XGEN(b.x)], 1u);
            asm volatile("s_waitcnt vmcnt(0)" ::: "memory");
        } else {
            XB_SPIN(xb_ld(&bar[XB_XGEN(b.x)]) == gen, bar);
            __builtin_amdgcn_fence(__ATOMIC_ACQUIRE, "agent");
            asm volatile("s_waitcnt vmcnt(0)" ::: "memory");
        }
    }
    __syncthreads();
}


constexpr int NSTEP = 1 + 2 * 7 + 1;
__global__ void __launch_bounds__(NTHREADS, 2) k_mega(P p) {
    extern __shared__ __attribute__((aligned(16))) unsigned char lds_raw[];
    LASP unsigned char* lds = (LASP unsigned char*)lds_raw;
    const int bid = blockIdx.x, nblk = gridDim.x;
    volatile LASP unsigned* bst = (volatile LASP unsigned*)(lds + LDS_BYTES - 64);
    if (threadIdx.x < 16) bst[threadIdx.x] = 0u;
    __syncthreads();
    { const XcdBarrier b0 = xcd_barrier_post((unsigned*)p.ctl, bst); if (threadIdx.x == 0) { bst[2] = b0.x; if (bid >= NGDN_BLOCKS) (void)xb_add(&((unsigned*)p.ctl)[4096 + XB_XCNT(b0.x)], 1u); } }
    __syncthreads();
    ph_prologue(p, lds, bid, nblk);
    { XcdBarrier bar; bar.bar = (unsigned*)p.ctl; bar.x = (unsigned)__builtin_amdgcn_readfirstlane((int)bst[2]); bar.st = bst; bar.G = (unsigned)nblk; xcd_barrier(bar); }
    const int bid_k = bid, nblk_k = nblk;
#pragma unroll 1
    for (int step = 1; step < NSTEP; ++step) {
        int ph = 0, l = 0;
        { const int s1 = step - 1; l = s1 / 7; ph = 1 + s1 % 7; }
        int bid = bid_k, nblk = nblk_k; asm volatile("" : "+s"(bid), "+s"(nblk));
#if TPROBE >= 0
        if (bid == 0 && threadIdx.x == 0) { if (step == 1) p.stats[2] = 0.f; const unsigned long long t_ = __builtin_amdgcn_s_memrealtime(); bst[4] = (unsigned)t_; bst[5] = (unsigned)(t_ >> 32); }
#endif
        if (ph == 1) { if (l == 0) ph_transposes(p, lds, bid, nblk); ph_lnpass(p, l, bid, nblk); }
        else if (l < 2) {
            if (ph == 2) {
                pg8::Gemm g{p.ml, p.wi_t + (size_t)l * NPAD * D, ROWS, NPAD, D}; pg8::StaticOrder S; S.init(ROWS, NPAD, nblk, bid);
                EpiProj E{p.raw, p.rest, p.kf};
                pg8::gemm_phase<EpiProj, pg8::StaticOrder, true, true>(lds, g, S, E);
            } else if (ph == 3) { ph_conv(p, l, bid, nblk); ph_prep_early(p, lds, l, bid, nblk); }
            else if (ph == 4) ph_prep(p, lds, l, bid, nblk);
            else if (ph == 5) {
#if PROBE
                if (l == 0) { ph_probe_naive(p, (LASP float*)lds, l, bid, nblk); XcdBarrier bar; bar.bar = (unsigned*)p.ctl; bar.x = (unsigned)__builtin_amdgcn_readfirstlane((int)bst[2]); bar.st = bst; bar.G = (unsigned)nblk; xcd_barrier(bar); }
#endif
#if TPROBE >= 50
                const bool inrole = TPROBE == 50 ? (bid < 64) : (TPROBE == 51 ? (bid >= 64 && bid < 96) : (bid >= 96));
                const float rscale = TPROBE == 50 ? (1.f / 64.f) : (TPROBE == 51 ? (1.f / 32.f) : (1.f / 160.f));
                if (inrole && threadIdx.x == 0) { const unsigned long long t_ = __builtin_amdgcn_s_memrealtime(); bst[6] = (unsigned)t_; bst[7] = (unsigned)(t_ >> 32); }
#endif
                if (bid >= NGDN_BLOCKS) {
                    ph_glaprep(p, lds, l, bid - NGDN_BLOCKS, nblk - NGDN_BLOCKS);
                    XcdBarrier bar; bar.bar = (unsigned*)p.ctl + 4096; bar.x = (unsigned)__builtin_amdgcn_readfirstlane((int)bst[2]); bar.st = bst + 8; bar.G = (unsigned)(nblk - NGDN_BLOCKS); xcd_barrier(bar);
                }
                ph_mix(p, lds, l, bid, nblk);
#if TPROBE >= 50
                if (inrole && threadIdx.x == 0) { const unsigned long long tr0 = (unsigned long long)bst[6] | ((unsigned long long)bst[7] << 32); atomicAdd(&p.stats[2], (float)(__builtin_amdgcn_s_memrealtime() - tr0) * 0.01f * rscale); }
#endif
#if PROBE
                if (l == 0) { XcdBarrier bar; bar.bar = (unsigned*)p.ctl; bar.x = (unsigned)__builtin_amdgcn_readfirstlane((int)bst[2]); bar.st = bst; bar.G = (unsigned)nblk; xcd_barrier(bar); ph_probe_cmp(p, bid, nblk); }
#endif
            }
            else if (ph == 6) ph_gate(p, l, bid, nblk);
            else if (ph == 7) {
                pg8::Gemm g{p.mix, p.wo_t + (size_t)l * D * D, ROWS, D, D};
                EpiY E{p.ml};
                { LatentOrder S; S.S.init(BATCH * SEQ, D, nblk, bid); pg8::gemm_phase<EpiY, LatentOrder, true, true>(lds, g, S, E); }
                if (l == 0) {
                    const int j = bid, kq = j & 3, pn = (j >> 2) & 3, cb = j >> 4;
                    pg8::Gemm gq{p.mix + kq * 256, p.wo_t + kq * 256, ROWS, D, 256, D};
                    OneUnit S1{17 * cb, pn, j < 128};
                    EpiYc E1{p.oc + (size_t)kq * YC_STRIDE};
                    pg8::gemm_phase<EpiYc, OneUnit, true, true>(lds, gq, S1, E1);
                }
            }
        }
        { XcdBarrier bar; bar.bar = (unsigned*)p.ctl; bar.x = (unsigned)__builtin_amdgcn_readfirstlane((int)bst[2]); bar.st = bst; bar.G = (unsigned)nblk; xcd_barrier(bar); }
#if TPROBE >= 0
        if (bid == 0 && threadIdx.x == 0 && ph == TPROBE) { const unsigned long long tp0 = (unsigned long long)bst[4] | ((unsigned long long)bst[5] << 32); p.stats[2] += (float)(__builtin_amdgcn_s_memrealtime() - tp0) * 0.01f; }
#endif
    }
}

extern "C" void kernel_launch(void* const* d_in, const int* in_sizes, int n_in, void* d_out, int out_size, void* d_ws, size_t ws_size,
                              hipStream_t stream) {
    P p{};
    p.x = (const float*)d_in[0]; p.c = (const float*)d_in[1]; p.ctx = (const float*)d_in[2]; p.c_ctx = (const float*)d_in[3];
    p.w_mod = (const float*)d_in[4]; p.b_mod = (const float*)d_in[5]; p.w_in = (const float*)d_in[6]; p.conv_w = (const float*)d_in[7];
    p.a_log = (const float*)d_in[8]; p.dt_bias = (const float*)d_in[9]; p.gdn_norm = (const float*)d_in[10]; p.rpb = (const float*)d_in[11];
    p.gla_w2 = (const float*)d_in[12]; p.gla_b2 = (const float*)d_in[13]; p.gla_norm = (const float*)d_in[14]; p.w_out = (const float*)d_in[15];
    p.ln_g = (const float*)d_in[16]; p.ln_b = (const float*)d_in[17];
    p.out = (float*)d_out;
    unsigned char* w = (unsigned char*)d_ws;
    size_t off = 0;
    auto take = [&](size_t bytes) { unsigned char* r = w + off; off += (bytes + 255) & ~(size_t)255; return r; };
    p.ctl = (unsigned*)take(32768);
    p.mods = (float*)take((size_t)2 * 9 * 3072 * 4);
    p.xc1 = (float*)take((size_t)BATCH * CTX * D * 4);
    p.wi_t = (bf16*)take((size_t)2 * NPAD * D * 2);
    p.wo_t = (bf16*)take((size_t)2 * D * D * 2);
    p.rest = (bf16*)take((size_t)ROWS * NREST * 2);
    p.raw = (bf16*)take((size_t)ROWS * NRAW * 2);
    p.qkvn = (bf16*)take((size_t)ROWS * NRAW * 2);
    p.mix = p.qkvn;
    p.oa = (bf16*)take((size_t)2 * ROWS * 512 * 2);
    p.oc = (bf16*)take((size_t)2 * ROWS * 256 * 2);
    p.ml = p.oa;
    p.vf = (bf16*)take((size_t)ROWS * 256 * 2);
    p.kf = (bf16*)take((size_t)ROWS * 256 * 2);
    p.stats = (float*)take(256);
    p.cst = (float*)take(4096);
    static int grid_blocks = 0;
    if (!grid_blocks) {
        if (off > ws_size) { fprintf(stderr, "workspace too small: need %zu have %zu\n", off, ws_size); grid_blocks = -1; return; }
        int dev = 0, cus = 0, per_cu = 0;
        hipGetDevice(&dev);
        hipDeviceGetAttribute(&cus, hipDeviceAttributeMultiprocessorCount, dev);
        if (hipFuncSetAttribute((const void*)k_mega, hipFuncAttributeMaxDynamicSharedMemorySize, LDS_BYTES) != hipSuccess) { fprintf(stderr, "hipFuncSetAttribute failed\n"); grid_blocks = -1; return; }
        hipOccupancyMaxActiveBlocksPerMultiprocessor(&per_cu, (const void*)k_mega, NTHREADS, LDS_BYTES);
        if (per_cu < 1) { fprintf(stderr, "occupancy query says %d blocks per CU\n", per_cu); grid_blocks = -1; return; }
        grid_blocks = cus;
    }
    if (grid_blocks < 0) return;
    if (hipMemsetAsync(p.ctl, 0, 32768, stream) != hipSuccess) { fprintf(stderr, "memset of the barrier words failed\n"); return; }
    void* args[] = {&p};
    hipError_t e = hipLaunchCooperativeKernel((void*)k_mega, dim3(grid_blocks), dim3(NTHREADS), args, LDS_BYTES, stream);
    if (e != hipSuccess) fprintf(stderr, "cooperative launch failed: %s (grid %d)\n", hipGetErrorString(e), grid_blocks);
}
```
